# Optimizing an MI355X kernel written in HIP

```python
import jax, jax.numpy as jnp
from jax import lax
import numpy as np

D_MODEL = 2048
BATCH = 4
SEQ = 4096
DEPTH = 2

GRID_W = 64
NA_HEADS = 8
NA_HEAD_DIM = 128
NA_WIDTH = NA_HEADS * NA_HEAD_DIM
NA_KR_MAX = 8
NA_KC = 16
ML_HEADS = 4
ML_QK_DIM = 128
ML_V_DIM = 256
ML_QK_WIDTH = ML_HEADS * ML_QK_DIM
ML_V_WIDTH = ML_HEADS * ML_V_DIM
ML_CHUNK = 64
CONV_W = 5
N_GATES = 4 * ML_HEADS
D_MIX = NA_WIDTH + ML_V_WIDTH
N_IN = 3 * NA_WIDTH + 2 * ML_QK_WIDTH + 2 * ML_V_WIDTH + N_GATES
IN_SPLITS = (NA_WIDTH, 2 * NA_WIDTH, 3 * NA_WIDTH,
             3 * NA_WIDTH + ML_QK_WIDTH,
             3 * NA_WIDTH + 2 * ML_QK_WIDTH,
             3 * NA_WIDTH + 2 * ML_QK_WIDTH + ML_V_WIDTH,
             3 * NA_WIDTH + 2 * ML_QK_WIDTH + 2 * ML_V_WIDTH)
N_EXPERTS = 16
CAPACITY_FACTOR = 2
D_EXPERT = 1024
EPS = 1e-6

kernel_name = 'hybrid_na_mlstm_ec_encoder'


def rmsnorm(x, g):
    xf = x.astype(jnp.float32)
    y = xf * lax.rsqrt(jnp.mean(xf * xf, axis=-1, keepdims=True) + EPS)
    return (y * g.astype(jnp.float32)).astype(x.dtype)


def neighbourhood_attention(q, k, v, rpb):
    B, S, _ = q.shape
    H, d = NA_HEADS, NA_HEAD_DIM
    rows = S // GRID_W
    kr = min(NA_KR_MAX, rows)
    r = np.arange(rows)
    row_start = np.clip(r - kr // 2, 0, rows - kr)
    key_rows = row_start[:, None] + np.arange(kr)[None, :]
    c = np.arange(GRID_W)
    col_start = np.clip(c - NA_KC // 2, 0, GRID_W - NA_KC)
    col_in = (c[None, :] >= col_start[:, None]) & (c[None, :] < col_start[:, None] + NA_KC)
    dr = key_rows - r[:, None] + (NA_KR_MAX - 1)
    dc = np.clip(c[None, :] - c[:, None] + (NA_KC - 1), 0, 2 * NA_KC - 2)

    qg = q.reshape(B, rows, GRID_W, H, d)
    kg = k.reshape(B, rows, GRID_W, H, d)[:, key_rows]
    vg = v.reshape(B, rows, GRID_W, H, d)[:, key_rows]
    s = jnp.einsum('brqhd,brakhd->bhrqak', qg, kg,
                   preferred_element_type=jnp.float32) * (d ** -0.5)
    bias = rpb[:, dr[:, None, :, None], dc[None, :, None, :]]
    s = s + bias[None].astype(jnp.float32)
    s = jnp.where(col_in[None, None, None, :, None, :], s, -jnp.inf)
    p = jax.nn.softmax(s.reshape(B, H, rows, GRID_W, kr * GRID_W), axis=-1).reshape(s.shape)
    o = jnp.einsum('bhrqak,brakhd->brqhd', p.astype(v.dtype), vg)
    return o.reshape(B, S, H * d)


def mlstm_chunkwise(q, k, v, i_pre, f_pre):
    B, H, S, dk = q.shape
    dv = v.shape[-1]
    L = ML_CHUNK
    nc = S // L
    q = q * (dk ** -0.5)
    log_f = jax.nn.log_sigmoid(f_pre)

    def to_chunks(a):
        return jnp.moveaxis(a.reshape((B, H, nc, L) + a.shape[3:]), 2, 0)

    xs = (to_chunks(q), to_chunks(k), to_chunks(v), to_chunks(i_pre), to_chunks(log_f))
    lower = jnp.tril(jnp.ones((L, L), dtype=bool))

    def step(carry, inp):
        C, n, m = carry
        qb, kb, vb, ib, fb = inp
        b = jnp.cumsum(fb, axis=-1)
        dmat = b[..., :, None] - b[..., None, :] + ib[..., None, :]
        dmat = jnp.where(lower, dmat, -jnp.inf)
        m_inter = b + m[..., None]
        m_j = jnp.maximum(m_inter, jnp.max(dmat, axis=-1))
        w = jnp.exp(dmat - m_j[..., None])
        inter = jnp.exp(m_inter - m_j)
        qk = jnp.einsum('bhjd,bhsd->bhjs', qb, kb) * w
        num = inter[..., None] * jnp.einsum('bhjd,bhde->bhje', qb, C) + jnp.einsum('bhjs,bhse->bhje', qk, vb)
        den = inter * jnp.einsum('bhjd,bhd->bhj', qb, n) + jnp.sum(qk, axis=-1)
        h = num / jnp.maximum(jnp.abs(den), jnp.exp(-m_j))[..., None]
        b_last = b[..., -1]
        g = b_last[..., None] - b + ib
        m_new = jnp.maximum(b_last + m, jnp.max(g, axis=-1))
        decay = jnp.exp(b_last + m - m_new)
        wk = jnp.exp(g - m_new[..., None])
        C_new = decay[..., None, None] * C + jnp.einsum('bhs,bhsd,bhse->bhde', wk, kb, vb)
        n_new = decay[..., None] * n + jnp.einsum('bhs,bhsd->bhd', wk, kb)
        return (C_new, n_new, m_new), h

    init = (jnp.zeros((B, H, dk, dv), jnp.float32),
            jnp.zeros((B, H, dk), jnp.float32),
            jnp.zeros((B, H), jnp.float32))
    _, hs = lax.scan(step, init, xs)
    return jnp.moveaxis(hs, 0, 2).reshape(B, H, S, dv)


def mlstm_mixer(ml_q, ml_k, ml_v, ml_o, gates, b_gates, conv_w, conv_b, norm_g):
    B, S, _ = ml_q.shape
    H = ML_HEADS
    qk = jnp.concatenate([ml_q, ml_k], axis=-1)
    qk = lax.conv_general_dilated(qk, conv_w[:, None, :], (1,), [(CONV_W // 2, CONV_W // 2)],
                                  dimension_numbers=('NWC', 'WIO', 'NWC'),
                                  feature_group_count=2 * ML_QK_WIDTH) + conv_b
    qk = jax.nn.silu(qk)
    q, k = jnp.split(qk, 2, axis=-1)

    def heads(a, dh):
        return jnp.transpose(a.reshape(B, S, H, dh), (0, 2, 1, 3)).astype(jnp.float32)

    q, k, v = heads(q, ML_QK_DIM), heads(k, ML_QK_DIM), heads(ml_v, ML_V_DIM)
    g = gates.astype(jnp.float32) + b_gates.astype(jnp.float32)
    g = jnp.transpose(g.reshape(B, S, 4, H), (2, 0, 3, 1))
    h_fwd = mlstm_chunkwise(q, k, v, g[0], g[1])
    flip = lambda a: jnp.flip(a, axis=2)
    h_bwd = flip(mlstm_chunkwise(flip(q), flip(k), flip(v), flip(g[2]), flip(g[3])))
    h = h_fwd + h_bwd
    h = h * lax.rsqrt(jnp.mean(h * h, axis=-1, keepdims=True) + EPS)
    h = jnp.transpose(h, (0, 2, 1, 3)).reshape(B, S, ML_V_WIDTH) * norm_g.astype(jnp.float32)
    return (h * jax.nn.sigmoid(ml_o.astype(jnp.float32))).astype(ml_v.dtype)


def expert_choice_ffn(h, w_router, w_gate, w_up, w_down):
    B, S, _ = h.shape
    cap = CAPACITY_FACTOR * S // N_EXPERTS
    logits = jnp.einsum('bsd,de->bse', h, w_router, preferred_element_type=jnp.float32)
    aff = jax.nn.softmax(logits, axis=-1)
    gate, tok = lax.top_k(jnp.swapaxes(aff, 1, 2), cap)
    bidx = jnp.arange(B)[:, None, None]
    xin = h[bidx, tok]
    a = jnp.einsum('becd,edf->becf', xin, w_gate)
    u = jnp.einsum('becd,edf->becf', xin, w_up)
    y = jnp.einsum('becf,efd->becd', jax.nn.silu(a) * u, w_down)
    y = y * gate[..., None].astype(y.dtype)
    return jnp.zeros_like(h).at[bidx, tok].add(y)


def setup_inputs(seed: int = 0) -> dict:
    key = jax.random.key(seed)
    ks = jax.random.split(key, 16)
    f32 = jnp.float32

    def nrm(k, shape, scale):
        return jax.random.normal(k, shape, f32) * scale

    fb = jnp.linspace(3.0, 6.0, ML_HEADS, dtype=f32)
    zb = jnp.zeros((ML_HEADS,), f32)
    gate_base = jnp.concatenate([zb, fb, zb, fb])
    return {
        'x': nrm(ks[0], (BATCH, SEQ, D_MODEL), 1.0),
        'norm_mix_g': 1.0 + nrm(ks[1], (DEPTH, D_MODEL), 0.02),
        'w_in': nrm(ks[2], (DEPTH, D_MODEL, N_IN), D_MODEL ** -0.5),
        'b_gates': gate_base[None, :] + nrm(ks[3], (DEPTH, N_GATES), 0.1),
        'conv_w': nrm(ks[4], (DEPTH, CONV_W, 2 * ML_QK_WIDTH), CONV_W ** -0.5),
        'conv_b': nrm(ks[5], (DEPTH, 2 * ML_QK_WIDTH), 0.02),
        'na_rpb': nrm(ks[6], (DEPTH, NA_HEADS, 2 * NA_KR_MAX - 1, 2 * NA_KC - 1), 0.1),
        'na_norm_g': 1.0 + nrm(ks[7], (DEPTH, NA_WIDTH), 0.02),
        'ml_norm_g': 1.0 + nrm(ks[8], (DEPTH, ML_V_WIDTH), 0.02),
        'w_out': nrm(ks[9], (DEPTH, D_MIX, D_MODEL), D_MIX ** -0.5),
        'norm_ffn_g': 1.0 + nrm(ks[10], (DEPTH, D_MODEL), 0.02),
        'w_router': nrm(ks[11], (DEPTH, D_MODEL, N_EXPERTS), D_MODEL ** -0.5),
        'w_gate': nrm(ks[12], (DEPTH, N_EXPERTS, D_MODEL, D_EXPERT), D_MODEL ** -0.5),
        'w_up': nrm(ks[13], (DEPTH, N_EXPERTS, D_MODEL, D_EXPERT), D_MODEL ** -0.5),
        'w_down': nrm(ks[14], (DEPTH, N_EXPERTS, D_EXPERT, D_MODEL), D_EXPERT ** -0.5),
        'final_norm_g': 1.0 + nrm(ks[15], (D_MODEL,), 0.02),
    }


def reference(x, norm_mix_g, w_in, b_gates, conv_w, conv_b, na_rpb, na_norm_g, ml_norm_g,
              w_out, norm_ffn_g, w_router, w_gate, w_up, w_down, final_norm_g):
    for l in range(DEPTH):
        h = rmsnorm(x, norm_mix_g[l])
        proj = jnp.einsum('bsd,dn->bsn', h, w_in[l])
        na_q, na_k, na_v, ml_q, ml_k, ml_v, ml_o, gates = jnp.split(proj, IN_SPLITS, axis=-1)
        na_out = rmsnorm(neighbourhood_attention(na_q, na_k, na_v, na_rpb[l]), na_norm_g[l])
        ml_out = mlstm_mixer(ml_q, ml_k, ml_v, ml_o, gates, b_gates[l], conv_w[l], conv_b[l], ml_norm_g[l])
        mix = jnp.concatenate([na_out, ml_out], axis=-1)
        x = x + jnp.einsum('bsm,md->bsd', mix, w_out[l])
        h = rmsnorm(x, norm_ffn_g[l])
        x = x + expert_choice_ffn(h, w_router[l], w_gate[l], w_up[l], w_down[l])
    return rmsnorm(x, final_norm_g)
```

```cpp
#include <hip/hip_runtime.h>
#include <stdint.h>
#include <stdio.h>
#include <string.h>

namespace pg8 {
#define PG8_LAS __attribute__((address_space(3)))
typedef unsigned short bf16_t;
typedef short bf16x8 __attribute__((ext_vector_type(8)));
typedef float f32x4 __attribute__((ext_vector_type(4)));
typedef unsigned u32x4 __attribute__((ext_vector_type(4)));
constexpr int BM = 256, BK = 64, HALF = 128, HTB = HALF * BK * 2  , STAGE_BYTES = 8 * HTB, NXCD = 8, WGM = 8;

__host__ __device__ __forceinline__ int lds_byte(int r, int c) { const int st = (r >> 4) * 2 + (c >> 5), rr = r & 15, cc = c & 31, ob = rr * 64 + cc * 2; return st * 1024 + (ob ^ (((ob >> 9) & 1) << 5)); }
__host__ __device__ __forceinline__ void stage_rc(int b, int& R, int& C) { const int st = b / 1024, sb = b % 1024, swz = sb ^ (((sb >> 9) & 1) << 5); R = (st >> 1) * 16 + swz / 64; C = (st & 1) * 32 + (swz % 64) / 2; }
__host__ __device__ __forceinline__ int perm32(int rho) { const int n = rho >> 4, i = rho & 15; return 8 * (i >> 2) + 4 * n + (i & 3); }

struct Unit { int pm, pn; };
struct Gemm { const bf16_t* A; const bf16_t* Bt; int M, N, K, pad; };

struct StaticOrder {
    int nM, nN, nwg, G, c, pad;
    __host__ __device__ void init(int M, int N, int G_, int c_) { nM = M / BM; nN = N / BM; nwg = nM * nN; G = G_; c = c_; pad = 0; }
    __host__ __device__ bool next(int i, Unit& u) const {
        const long L = (long)i * G + c; if (L >= nwg) return false;
        int wgid = (int)L; { const int q = nwg / NXCD, r = nwg % NXCD, xcd = wgid % NXCD, off = wgid / NXCD; wgid = (xcd < r ? xcd * (q + 1) : r * (q + 1) + (xcd - r) * q) + off; }
        const int nig = WGM * nN, gid = wgid / nig, fm = gid * WGM, gsz = (nM - fm) < WGM ? (nM - fm) : WGM;
        u.pm = fm + ((wgid % nig) % gsz); u.pn = (wgid % nig) / gsz; return true;
    }
    __device__ __forceinline__ void a_ready(const Unit&) const {}
    __device__ __forceinline__ void done(const Unit&) const {}
};


__device__ __forceinline__ unsigned cvt_pk_bf16(float lo, float hi) { unsigned r; asm volatile("v_cvt_pk_bf16_f32 %0, %1, %2" : "=v"(r) : "v"(lo), "v"(hi)); return r; }
typedef unsigned u32x2 __attribute__((ext_vector_type(2)));

struct EpiRowScaleBf16 {
    static constexpr bool PERM = true, AFTER_DRAIN = false;
    bf16_t* O; const float* rowscale; const int* rowmap; int ldc; int pn_mod;
    __device__ __forceinline__ void operator()(const f32x4 (&acc)[2][2][4][2], const Unit& u, int wr, int wc, int fr, int fq) const {
        const int row0 = u.pm * BM + wr * 64 + fr; const int pnl = pn_mod ? (u.pn % pn_mod) : u.pn;
        const int col0 = pnl * BM + wc * 32 + 8 * fq;
#pragma unroll
        for (int ai = 0; ai < 2; ++ai)
#pragma unroll
            for (int m = 0; m < 4; ++m) { const int row = row0 + ai * HALF + m * 16; const float sc = rowscale[rowmap ? rowmap[row] : row];
                bf16_t* rowp = O + (size_t)row * ldc + col0;
#pragma unroll
                for (int bj = 0; bj < 2; ++bj) { const f32x4 v0 = acc[ai][bj][m][0] * sc, v1 = acc[ai][bj][m][1] * sc;
                    u32x4 w; w.x = cvt_pk_bf16(v0[0], v0[1]); w.y = cvt_pk_bf16(v0[2], v0[3]); w.z = cvt_pk_bf16(v1[0], v1[1]); w.w = cvt_pk_bf16(v1[2], v1[3]);
                    *(u32x4*)(rowp + bj * HALF) = w; } }
    }
};
struct EpiResidF32 {
    static constexpr bool PERM = false, AFTER_DRAIN = false;
    float* C; const float* R; int ldc; int pad;
    __device__ __forceinline__ void operator()(const f32x4 (&acc)[2][2][4][2], const Unit& u, int wr, int wc, int fr, int fq) const {
        const int row0 = u.pm * BM + wr * 64 + fr, col0 = u.pn * BM + wc * 32 + 4 * fq;
#pragma unroll
        for (int ai = 0; ai < 2; ++ai)
#pragma unroll
            for (int m = 0; m < 4; ++m) { const size_t off = (size_t)(row0 + ai * HALF + m * 16) * ldc + col0;
#pragma unroll
                for (int bj = 0; bj < 2; ++bj)
#pragma unroll
                    for (int n = 0; n < 2; ++n) { const f32x4 r = *(const f32x4*)(R + off + bj * HALF + n * 16); *(f32x4*)(C + off + bj * HALF + n * 16) = r + acc[ai][bj][m][n]; }
                asm volatile("" ::: "memory"); }
    }
};
struct EpiSwiGLU {
    static constexpr bool PERM = false, AFTER_DRAIN = false;
    bf16_t* O; const float* rowscale; const int* rowmap; int ldc; int pn_mod;
    __device__ __forceinline__ void operator()(const f32x4 (&acc)[2][2][4][2], const Unit& u, int wr, int wc, int fr, int fq) const {
        const int row0 = u.pm * BM + wr * 64 + fr; const int pnl = u.pn % pn_mod;
        const int col0 = pnl * 128 + wc * 16 + 4 * fq;
#pragma unroll
        for (int ai = 0; ai < 2; ++ai)
#pragma unroll
            for (int m = 0; m < 4; ++m) { const int row = row0 + ai * HALF + m * 16; const float sc = rowscale[rowmap[row]];
                bf16_t* rowp = O + (size_t)row * ldc + col0;
#pragma unroll
                for (int bj = 0; bj < 2; ++bj) { const f32x4 a = acc[ai][bj][m][0] * sc, up = acc[ai][bj][m][1] * sc; f32x4 r;
#pragma unroll
                    for (int j = 0; j < 4; ++j) r[j] = a[j] * up[j] * __builtin_amdgcn_rcpf(1.0f + __builtin_amdgcn_exp2f(-1.4426950408889634f * a[j]));
                    u32x2 w; w.x = cvt_pk_bf16(r[0], r[1]); w.y = cvt_pk_bf16(r[2], r[3]);
                    *(u32x2*)(rowp + bj * 64) = w; } }
    }
};
struct GroupedOrder {
    int G, c;
    __device__ __forceinline__ bool next(int i, Unit& u) const {
        const int L = i * G + c; if (L >= 1024) return false;
        const int e = L >> 6, w = L & 63; u.pm = e * 8 + (w & 7); u.pn = e * 8 + (w >> 3); return true;
    }
    __device__ __forceinline__ void a_ready(const Unit&) const {}
    __device__ __forceinline__ void done(const Unit&) const {}
};
template <class Epi, class Sched, bool ALIGN_EPI = false, bool SP2 = false>
__device__ __forceinline__ void gemm_phase(PG8_LAS unsigned char* lds, const Gemm g, const Sched& S, const Epi& E) {
    const int tid = threadIdx.x, wid = __builtin_amdgcn_readfirstlane(tid >> 6), lane = tid & 63, wr = wid >> 2, wc = wid & 3, fr = lane & 15, fq = lane >> 4;
    const int K = g.K, nt = K / BK;
    unsigned voffA[2], voffB[2];
#pragma unroll
    for (int i = 0; i < 2; ++i) { int R, C; stage_rc(tid * 16 + i * 8192, R, C); const int Rb = Epi::PERM ? ((R & ~31) + perm32(R & 31)) : R;
        voffA[i] = (unsigned)(R * K + C) * 2u; voffB[i] = (unsigned)(Rb * K + C) * 2u; }
    const size_t kstep = (size_t)(BK * 2);
    const size_t hstep = (size_t)HALF * K * 2;
    const size_t tstep = 2 * hstep;
    const unsigned ldsw = (unsigned)wid * 1024u;
    const int aoff = lds_byte(wr * 64 + fr, fq * 8), boff = lds_byte(wc * 32 + fr, fq * 8);
#define PG8_SA(b, h) (((b) * 2 + (h)) * HTB)
#define PG8_SB(b, h) ((4 + (b) * 2 + (h)) * HTB)
#define PG8_STAGE(bufoff, gbase, voff) do { _Pragma("unroll") for (int _i = 0; _i < 2; ++_i) \
        __builtin_amdgcn_global_load_lds((const unsigned*)((const char*)(gbase) + (voff)[_i]), (PG8_LAS unsigned*)(lds + (bufoff) + ldsw + _i * 8192), 16, 0, 0); } while (0)
#define PG8_LDA(dst, b, h) do { _Pragma("unroll") for (int m = 0; m < 4; ++m) _Pragma("unroll") for (int k = 0; k < 2; ++k) dst[m][k] = *(const PG8_LAS bf16x8*)(lds + PG8_SA(b, h) + aoff + m * 2048 + k * 1024); } while (0)
#define PG8_LDB(dst, b, h) do { _Pragma("unroll") for (int n = 0; n < 2; ++n) _Pragma("unroll") for (int k = 0; k < 2; ++k) dst[n][k] = *(const PG8_LAS bf16x8*)(lds + PG8_SB(b, h) + boff + n * 2048 + k * 1024); } while (0)
#define PG8_MMA(ai, bj, At, Bt) do { __builtin_amdgcn_s_setprio(1); _Pragma("unroll") for (int m = 0; m < 4; ++m) _Pragma("unroll") for (int n = 0; n < 2; ++n) _Pragma("unroll") for (int k = 0; k < 2; ++k) \
        acc[ai][bj][m][n] = __builtin_amdgcn_mfma_f32_16x16x32_bf16(Bt[n][k], At[m][k], acc[ai][bj][m][n], 0, 0, 0); __builtin_amdgcn_s_setprio(0); } while (0)
#define PG8_WAIT_V(n) asm volatile("s_waitcnt vmcnt(" #n ")" ::: "memory")
#define PG8_WAIT_L(n) asm volatile("s_waitcnt lgkmcnt(" #n ")" ::: "memory")
#define PG8_BAR __builtin_amdgcn_s_barrier()
#define PG8_SCHED __builtin_amdgcn_sched_barrier(0)
    Unit cur, nxt; int ui = 0;
    if (!S.next(0, cur)) return;
    f32x4 acc[2][2][4][2];
#pragma unroll
    for (int a = 0; a < 2; ++a)
#pragma unroll
        for (int b = 0; b < 2; ++b)
#pragma unroll
            for (int m = 0; m < 4; ++m)
#pragma unroll
                for (int n = 0; n < 2; ++n) acc[a][b][m][n] = (f32x4){0.f, 0.f, 0.f, 0.f};
    bf16x8 At[4][2], B0[2][2], B1[2][2];
    const char* cA = (const char*)g.A + (size_t)cur.pm * tstep; const char* cB = (const char*)g.Bt + (size_t)cur.pn * tstep;
    S.a_ready(cur);
    if constexpr (SP2) {
        PG8_STAGE(PG8_SB(0, 0), cB, voffB); PG8_STAGE(PG8_SB(0, 1), cB + hstep, voffB); PG8_STAGE(PG8_SA(0, 0), cA, voffA); PG8_STAGE(PG8_SA(0, 1), cA + hstep, voffA);
        if (wr == 1) PG8_BAR;
        PG8_WAIT_V(2); PG8_BAR;
        PG8_STAGE(PG8_SB(1, 0), cB + kstep, voffB); PG8_STAGE(PG8_SA(1, 0), cA + kstep, voffA); PG8_STAGE(PG8_SB(1, 1), cB + hstep + kstep, voffB);
        PG8_WAIT_V(6); PG8_BAR;
    } else {
        PG8_STAGE(PG8_SB(0, 0), cB, voffB); PG8_STAGE(PG8_SA(0, 0), cA, voffA); PG8_STAGE(PG8_SB(0, 1), cB + hstep, voffB); PG8_STAGE(PG8_SA(0, 1), cA + hstep, voffA);
        if (wr == 1) PG8_BAR;
        PG8_WAIT_V(4); PG8_BAR;
        PG8_STAGE(PG8_SB(1, 0), cB + kstep, voffB); PG8_STAGE(PG8_SA(1, 0), cA + kstep, voffA); PG8_STAGE(PG8_SB(1, 1), cB + hstep + kstep, voffB);
        PG8_WAIT_V(6); PG8_BAR;
    }
    for (;;) {
        const bool has_next = S.next(ui + 1, nxt);
        const char* nA = has_next ? (const char*)g.A + (size_t)nxt.pm * tstep : cA; const char* nB = has_next ? (const char*)g.Bt + (size_t)nxt.pn * tstep : cB;
        for (int t = 0; t < nt; t += 2) {
            const bool last = (t == nt - 2);
            const char* a1 = cA + (size_t)(t + 1) * kstep;
            const char* a2 = last ? nA : cA + (size_t)(t + 2) * kstep; const char* b2 = last ? nB : cB + (size_t)(t + 2) * kstep;
            const char* a3 = a2 + kstep; const char* b3 = b2 + kstep;
            if (last && has_next) S.a_ready(nxt);
            if constexpr (SP2) {
            PG8_LDB(B0, 0, 0); PG8_LDB(B1, 0, 1); PG8_SCHED; PG8_LDA(At, 0, 0); PG8_STAGE(PG8_SA(1, 1), a1 + hstep, voffA);
            PG8_WAIT_V(8); PG8_WAIT_L(0); PG8_BAR; PG8_MMA(0, 0, At, B0); PG8_MMA(0, 1, At, B1); PG8_BAR; PG8_SCHED;
            PG8_LDA(At, 0, 1); PG8_STAGE(PG8_SB(0, 0), b2, voffB); PG8_STAGE(PG8_SB(0, 1), b2 + hstep, voffB); PG8_STAGE(PG8_SA(0, 0), a2, voffA);
            PG8_WAIT_V(8); PG8_WAIT_L(0); PG8_BAR; PG8_MMA(1, 0, At, B0); PG8_MMA(1, 1, At, B1); PG8_BAR; PG8_SCHED;
            PG8_LDB(B0, 1, 0); PG8_LDB(B1, 1, 1); PG8_SCHED; PG8_LDA(At, 1, 0); PG8_STAGE(PG8_SA(0, 1), a2 + hstep, voffA);
            PG8_WAIT_V(8); PG8_WAIT_L(0); PG8_BAR; PG8_MMA(0, 0, At, B0); PG8_MMA(0, 1, At, B1); PG8_BAR; PG8_SCHED;
            PG8_LDA(At, 1, 1); PG8_STAGE(PG8_SB(1, 0), b3, voffB); PG8_STAGE(PG8_SB(1, 1), b3 + hstep, voffB); PG8_STAGE(PG8_SA(1, 0), a3, voffA);
            PG8_WAIT_V(8); PG8_WAIT_L(0); PG8_BAR; PG8_MMA(1, 0, At, B0); PG8_MMA(1, 1, At, B1); PG8_BAR; PG8_SCHED;
            } else {
            PG8_LDB(B0, 0, 0); PG8_SCHED; PG8_LDA(At, 0, 0); PG8_STAGE(PG8_SA(1, 1), a1 + hstep, voffA);
            PG8_WAIT_L(8); PG8_BAR; PG8_WAIT_L(0); PG8_MMA(0, 0, At, B0); PG8_BAR; PG8_SCHED;
            PG8_LDB(B1, 0, 1); PG8_STAGE(PG8_SB(0, 0), b2, voffB);
            PG8_BAR; PG8_WAIT_L(0); PG8_MMA(0, 1, At, B1); PG8_BAR;
            PG8_LDA(At, 0, 1); PG8_STAGE(PG8_SA(0, 0), a2, voffA);
            PG8_BAR; PG8_WAIT_L(0); PG8_MMA(1, 0, At, B0); PG8_BAR; PG8_SCHED;
            PG8_STAGE(PG8_SB(0, 1), b2 + hstep, voffB);
            PG8_WAIT_V(6); PG8_BAR; PG8_MMA(1, 1, At, B1); PG8_BAR;
            PG8_LDB(B0, 1, 0); PG8_SCHED; PG8_LDA(At, 1, 0); PG8_STAGE(PG8_SA(0, 1), a2 + hstep, voffA);
            PG8_WAIT_L(8); PG8_BAR; PG8_WAIT_L(0); PG8_MMA(0, 0, At, B0); PG8_BAR; PG8_SCHED;
            PG8_LDB(B1, 1, 1); PG8_STAGE(PG8_SB(1, 0), b3, voffB);
            PG8_BAR; PG8_WAIT_L(0); PG8_MMA(0, 1, At, B1); PG8_BAR;
            PG8_LDA(At, 1, 1); PG8_STAGE(PG8_SA(1, 0), a3, voffA);
            PG8_BAR; PG8_WAIT_L(0); PG8_MMA(1, 0, At, B0); PG8_BAR; PG8_SCHED;
            PG8_STAGE(PG8_SB(1, 1), b3 + hstep, voffB);
            PG8_WAIT_V(6); PG8_BAR; PG8_MMA(1, 1, At, B1); PG8_BAR;
            }
        }
        if constexpr (ALIGN_EPI) { if (wr == 0) PG8_BAR; }
        if constexpr (!Epi::AFTER_DRAIN) { E(acc, cur, wr, wc, fr, fq); S.done(cur); }
        if (!has_next) break;
#pragma unroll
        for (int a = 0; a < 2; ++a)
#pragma unroll
            for (int b = 0; b < 2; ++b)
#pragma unroll
                for (int m = 0; m < 4; ++m)
#pragma unroll
                    for (int n = 0; n < 2; ++n) acc[a][b][m][n] = (f32x4){0.f, 0.f, 0.f, 0.f};
        cur = nxt; cA = nA; cB = nB; ++ui;
        if constexpr (ALIGN_EPI) { if (wr == 1) PG8_BAR; }
    }
    PG8_WAIT_V(0);
    if constexpr (!ALIGN_EPI) { if (wr == 0) PG8_BAR; }
    PG8_BAR;
    if constexpr (Epi::AFTER_DRAIN) { E.fused(acc, cur, wr, wc, fr, fq, lds, wid, lane); S.done(cur); }
#undef PG8_SA
#undef PG8_SB
#undef PG8_STAGE
#undef PG8_LDA
#undef PG8_LDB
#undef PG8_MMA
#undef PG8_WAIT_V
#undef PG8_WAIT_L
#undef PG8_BAR
#undef PG8_SCHED
}
}

constexpr int D = 2048, BATCH = 4, SEQ = 4096, MTOK = BATCH * SEQ, DEPTH = 2;
constexpr int NIN = 6160, NPROJ = 6144;
constexpr int C_NAQ = 0, C_NAK = 1024, C_NAV = 2048, C_MLQ = 3072, C_MLK = 3584, C_MLV = 4096, C_MLO = 5120, C_GATES = 6144;
constexpr int NE = 16, CAP = 512, DE = 1024, MR = NE * BATCH * CAP;
constexpr float EPS = 1e-6f;

typedef unsigned short bf16;
typedef float f32x4 __attribute__((ext_vector_type(4)));
typedef unsigned v4u __attribute__((ext_vector_type(4)));
typedef unsigned v2u __attribute__((ext_vector_type(2)));
#define LAS __attribute__((address_space(3)))

constexpr size_t MiB = 1u << 20;
constexpr size_t WS_CTL = 0;
constexpr size_t WS_RSTD = 1 * MiB;
constexpr size_t WS_GATES = 2 * MiB;
constexpr size_t WS_AFF = 3 * MiB;
constexpr size_t WS_TOK = 4 * MiB;
constexpr size_t WS_GATEV = 4 * MiB + 512 * 1024;
constexpr size_t WS_SEL = 5 * MiB;
constexpr size_t WS_WIN = 8 * MiB;
constexpr size_t WS_WOUT = 56 * MiB;
constexpr size_t WS_WGU = 72 * MiB;
constexpr size_t WS_WD = 328 * MiB;
constexpr size_t WS_XB = 456 * MiB;
constexpr size_t WS_MIX = 520 * MiB;
constexpr size_t WS_P = 584 * MiB;
constexpr size_t WS_NAO = 776 * MiB;
constexpr size_t WS_HF = 840 * MiB;
constexpr size_t WS_HB = 904 * MiB;
constexpr size_t WS_QKC = 968 * MiB;
constexpr size_t WS_XIN = 584 * MiB;
constexpr size_t WS_ACT = 712 * MiB;
constexpr size_t WS_Y = 776 * MiB;
constexpr size_t WS_END = 1000 * MiB;

__device__ __forceinline__ unsigned f2bf(float f) { unsigned u = __builtin_bit_cast(unsigned, f); return (u + 0x7fffu + ((u >> 16) & 1u)) >> 16; }
__device__ __forceinline__ unsigned pk2(float lo, float hi) { return f2bf(lo) | (f2bf(hi) << 16); }
__device__ __forceinline__ float bf2f(unsigned short b) { return __builtin_bit_cast(float, ((unsigned)b) << 16); }
__device__ __forceinline__ float bflo(unsigned w) { return __builtin_bit_cast(float, w << 16); }
__device__ __forceinline__ float bfhi(unsigned w) { return __builtin_bit_cast(float, w & 0xffff0000u); }
__device__ __forceinline__ float wave_sum(float v) {
#pragma unroll
    for (int o = 1; o < 64; o <<= 1) v += __shfl_xor(v, o);
    return v;
}
__device__ __forceinline__ float wave_max(float v) {
#pragma unroll
    for (int o = 1; o < 64; o <<= 1) v = fmaxf(v, __shfl_xor(v, o));
    return v;
}

__device__ __forceinline__ void transpose_item(const float* W, int ldw, const float* gk, bf16* WT, int K, int k0, int n0, int dmode, LAS float* scr, int lane) {
#pragma unroll 8
    for (int i = 0; i < 32; ++i) { const int kk = 2 * i + (lane >> 5); float w = W[(size_t)(k0 + kk) * ldw + n0 + (lane & 31)]; if (gk) w *= gk[k0 + kk]; scr[kk * 33 + (lane & 31)] = w; }
    asm volatile("s_waitcnt lgkmcnt(0)" ::: "memory");
    const int c = lane & 7;
#pragma unroll
    for (int j = 0; j < 4; ++j) { const int n = (lane >> 3) + 8 * j; const LAS float* s = scr + (8 * c) * 33 + n;
        v4u o; o.x = pk2(s[0 * 33], s[1 * 33]); o.y = pk2(s[2 * 33], s[3 * 33]); o.z = pk2(s[4 * 33], s[5 * 33]); o.w = pk2(s[6 * 33], s[7 * 33]);
        const int ng = n0 + n; const int drow = dmode == 0 ? ng : ((ng >> 4) * 32 + (ng & 15) + (dmode == 2 ? 16 : 0));
        *(v4u*)(WT + (size_t)drow * K + k0 + 8 * c) = o; }
    asm volatile("s_waitcnt lgkmcnt(0)" ::: "memory");
}
struct ConvArgs { const float *w_in, *w_out, *w_gate, *w_up, *w_down, *norm_mix_g, *norm_ffn_g; unsigned char* ws; };
constexpr int CI_IN = 32 * 192, CI_OUT = 32 * 64, CI_G = 16 * 32 * 32, CI_D = 16 * 16 * 64, CI_LAYER = CI_IN + CI_OUT + 2 * CI_G + CI_D;
__device__ __forceinline__ void convert_item(const ConvArgs& a, int it, LAS float* scr, int lane) {
    const int l = it / CI_LAYER; int r = it % CI_LAYER;
    if (r < CI_IN) { const int kb = r / 192, nb = r % 192;
        transpose_item(a.w_in + (size_t)l * D * NIN, NIN, a.norm_mix_g + l * D, (bf16*)(a.ws + WS_WIN) + (size_t)l * NPROJ * D, D, 64 * kb, 32 * nb, 0, scr, lane); return; }
    r -= CI_IN;
    if (r < CI_OUT) { const int kb = r / 64, nb = r % 64;
        transpose_item(a.w_out + (size_t)l * D * D, D, nullptr, (bf16*)(a.ws + WS_WOUT) + (size_t)l * D * D, D, 64 * kb, 32 * nb, 0, scr, lane); return; }
    r -= CI_OUT;
    if (r < 2 * CI_G) { const int up = r >= CI_G; if (up) r -= CI_G; const int e = r / 1024, q = r % 1024, kb = q / 32, nb = q % 32;
        transpose_item((up ? a.w_up : a.w_gate) + ((size_t)l * NE + e) * D * DE, DE, a.norm_ffn_g + l * D, (bf16*)(a.ws + WS_WGU) + ((size_t)l * NE + e) * 2048 * D, D, 64 * kb, 32 * nb, up ? 2 : 1, scr, lane); return; }
    r -= 2 * CI_G;
    { const int e = r / 1024, q = r % 1024, kb = q / 64, nb = q % 64;
        transpose_item(a.w_down + ((size_t)l * NE + e) * DE * D, D, nullptr, (bf16*)(a.ws + WS_WD) + ((size_t)l * NE + e) * D * DE, DE, 64 * kb, 32 * nb, 0, scr, lane); }
}
__global__ void __launch_bounds__(256) k_convert(ConvArgs a) {
    __shared__ float scr_all[4][64 * 33];
    const int wave = threadIdx.x >> 6, lane = threadIdx.x & 63;
    LAS float* scr = (LAS float*)scr_all[wave];
    for (int it = blockIdx.x * 4 + wave; it < DEPTH * CI_LAYER; it += gridDim.x * 4) convert_item(a, it, scr, lane);
}

struct RowArgs { const float* src; float* xout; const int* sel; const bf16* Y; bf16* XB; float* RSTD; const float* g; const float* W16; const float* bias; float* GATES; float* AFF; float* out; int ldw; int mode; };
__global__ void __launch_bounds__(256) k_rowpass(RowArgs a) {
    const int lane = threadIdx.x & 63; const int row = blockIdx.x * 4 + (threadIdx.x >> 6);
    if (row >= MTOK) return;
    const int b = row / SEQ, s = row % SEQ;
    f32x4 v[8];
#pragma unroll
    for (int j = 0; j < 8; ++j) v[j] = *(const f32x4*)(a.src + (size_t)row * D + 4 * lane + 256 * j);
    if (a.sel) {
        for (int e = 0; e < NE; ++e) { const int c = a.sel[row * 16 + e];
            if (c >= 0) { const bf16* y = a.Y + (size_t)(e * 2048 + b * 512 + c) * D + 4 * lane;
#pragma unroll
                for (int j = 0; j < 8; ++j) { const v2u w = *(const v2u*)(y + 256 * j); v[j][0] += bflo(w.x); v[j][1] += bfhi(w.x); v[j][2] += bflo(w.y); v[j][3] += bfhi(w.y); } } }
#pragma unroll
        for (int j = 0; j < 8; ++j) *(f32x4*)(a.xout + (size_t)row * D + 4 * lane + 256 * j) = v[j];
    }
    float ss = 0.f;
#pragma unroll
    for (int j = 0; j < 8; ++j) ss += (v[j][0] * v[j][0] + v[j][1] * v[j][1]) + (v[j][2] * v[j][2] + v[j][3] * v[j][3]);
    ss = wave_sum(ss);
    const float rstd = 1.0f / sqrtf(ss * (1.0f / D) + EPS);
    if (a.mode == 2) {
#pragma unroll
        for (int j = 0; j < 8; ++j) { const f32x4 g = *(const f32x4*)(a.g + 4 * lane + 256 * j); *(f32x4*)(a.out + (size_t)row * D + 4 * lane + 256 * j) = v[j] * rstd * g; }
        return;
    }
#pragma unroll
    for (int j = 0; j < 8; ++j) { v2u w; w.x = pk2(v[j][0], v[j][1]); w.y = pk2(v[j][2], v[j][3]); *(v2u*)(a.XB + (size_t)row * D + 4 * lane + 256 * j) = w; }
    if (lane == 0) a.RSTD[row] = rstd;
    float d[16];
#pragma unroll
    for (int n = 0; n < 16; ++n) d[n] = 0.f;
#pragma unroll
    for (int j = 0; j < 8; ++j) { const f32x4 g = *(const f32x4*)(a.g + 4 * lane + 256 * j);
#pragma unroll
        for (int i = 0; i < 4; ++i) { const int k = 4 * lane + 256 * j + i; const float xv = v[j][i] * g[i]; const f32x4* w = (const f32x4*)(a.W16 + (size_t)k * a.ldw);
#pragma unroll
            for (int q = 0; q < 4; ++q) { const f32x4 ww = w[q]; d[4 * q + 0] += xv * ww[0]; d[4 * q + 1] += xv * ww[1]; d[4 * q + 2] += xv * ww[2]; d[4 * q + 3] += xv * ww[3]; } } }
#pragma unroll
    for (int n = 0; n < 16; ++n) d[n] = wave_sum(d[n]) * rstd;
    if (a.mode == 0) { if (lane < 16) { float x = 0.f;
#pragma unroll
            for (int n = 0; n < 16; ++n) x = (lane == n) ? d[n] : x;
            a.GATES[row * 16 + lane] = x + a.bias[lane]; } }
    else { float mx = d[0];
#pragma unroll
        for (int n = 1; n < 16; ++n) mx = fmaxf(mx, d[n]);
        float sum = 0.f;
#pragma unroll
        for (int n = 0; n < 16; ++n) { d[n] = __expf(d[n] - mx); sum += d[n]; }
        const float inv = 1.0f / sum;
        if (lane < 16) { float x = 0.f;
#pragma unroll
            for (int n = 0; n < 16; ++n) x = (lane == n) ? d[n] : x;
            a.AFF[((size_t)b * NE + lane) * SEQ + s] = x * inv; } }
}

__global__ void __launch_bounds__(256) k_conv(const bf16* P, const float* cw, const float* cb, bf16* QKC) {
    const int idx = blockIdx.x * 256 + threadIdx.x;
    const int t = idx >> 7, c0 = (idx & 127) * 8; if (t >= MTOK) return;
    const int s = t % SEQ;
    float acc[8];
#pragma unroll
    for (int i = 0; i < 8; ++i) acc[i] = cb[c0 + i];
#pragma unroll
    for (int j = 0; j < 5; ++j) { const int ss = s + j - 2; if (ss < 0 || ss >= SEQ) continue;
        const v4u w = *(const v4u*)(P + (size_t)(t + j - 2) * NPROJ + C_MLQ + c0);
        const float x[8] = {bflo(w.x), bfhi(w.x), bflo(w.y), bfhi(w.y), bflo(w.z), bfhi(w.z), bflo(w.w), bfhi(w.w)};
#pragma unroll
        for (int i = 0; i < 8; ++i) acc[i] += cw[j * 1024 + c0 + i] * x[i]; }
    const float qs = c0 < 512 ? 0.08838834764831845f : 1.0f;
#pragma unroll
    for (int i = 0; i < 8; ++i) acc[i] = acc[i] / (1.0f + __expf(-acc[i])) * qs;
    v4u o; o.x = pk2(acc[0], acc[1]); o.y = pk2(acc[2], acc[3]); o.z = pk2(acc[4], acc[5]); o.w = pk2(acc[6], acc[7]);
    *(v4u*)(QKC + (size_t)t * 1024 + c0) = o;
}

__global__ void __launch_bounds__(256) k_na_naive(const bf16* P, const float* rpb, float* NAO) {
    const int lane = threadIdx.x & 63; const int wv = blockIdx.x * 4 + (threadIdx.x >> 6);
    const int t = wv >> 3, h = wv & 7; if (t >= MTOK) return;
    const int b = t / SEQ, s = t % SEQ, r = s >> 6, c = s & 63;
    const int rs = min(max(r - 4, 0), 56), cs = min(max(c - 8, 0), 48);
    int kt[2]; float sc[2];
#pragma unroll
    for (int u = 0; u < 2; ++u) { const int kk = lane + 64 * u, aa = kk >> 4, jj = kk & 15; kt[u] = b * SEQ + (rs + aa) * 64 + cs + jj;
        const int dr = rs + aa - r + 7, dc = cs + jj - c + 15; sc[u] = rpb[(h * 15 + dr) * 31 + dc]; }
    float dot[2] = {0.f, 0.f};
    const bf16* qp = P + (size_t)t * NPROJ + C_NAQ + h * 128;
    for (int d0 = 0; d0 < 128; d0 += 8) { const v4u qw = *(const v4u*)(qp + d0);
        const float q[8] = {bflo(qw.x), bfhi(qw.x), bflo(qw.y), bfhi(qw.y), bflo(qw.z), bfhi(qw.z), bflo(qw.w), bfhi(qw.w)};
#pragma unroll
        for (int u = 0; u < 2; ++u) { const v4u kw = *(const v4u*)(P + (size_t)kt[u] * NPROJ + C_NAK + h * 128 + d0);
            const float k[8] = {bflo(kw.x), bfhi(kw.x), bflo(kw.y), bfhi(kw.y), bflo(kw.z), bfhi(kw.z), bflo(kw.w), bfhi(kw.w)};
#pragma unroll
            for (int i = 0; i < 8; ++i) dot[u] += q[i] * k[i]; } }
    const float s0 = dot[0] * 0.08838834764831845f + sc[0], s1 = dot[1] * 0.08838834764831845f + sc[1];
    const float mx = wave_max(fmaxf(s0, s1));
    float p0 = __expf(s0 - mx), p1 = __expf(s1 - mx);
    const float inv = 1.0f / wave_sum(p0 + p1); p0 *= inv; p1 *= inv;
    float o0 = 0.f, o1 = 0.f;
    for (int kk = 0; kk < 128; ++kk) { const float p = kk < 64 ? __shfl(p0, kk) : __shfl(p1, kk - 64); const int aa = kk >> 4, jj = kk & 15; const int ktok = b * SEQ + (rs + aa) * 64 + cs + jj;
        const unsigned w = *(const unsigned*)(P + (size_t)ktok * NPROJ + C_NAV + h * 128 + 2 * lane); o0 += p * bflo(w); o1 += p * bfhi(w); }
    float* op = NAO + (size_t)t * 1024 + h * 128 + 2 * lane; op[0] = o0; op[1] = o1;
}
__global__ void __launch_bounds__(256) k_na_norm(const float* NAO, const float* g, bf16* MIX) {
    const int lane = threadIdx.x & 63; const int t = blockIdx.x * 4 + (threadIdx.x >> 6); if (t >= MTOK) return;
    f32x4 v[4]; float ss = 0.f;
#pragma unroll
    for (int j = 0; j < 4; ++j) { v[j] = *(const f32x4*)(NAO + (size_t)t * 1024 + 4 * lane + 256 * j); ss += (v[j][0] * v[j][0] + v[j][1] * v[j][1]) + (v[j][2] * v[j][2] + v[j][3] * v[j][3]); }
    const float rstd = 1.0f / sqrtf(wave_sum(ss) * (1.0f / 1024.0f) + EPS);
#pragma unroll
    for (int j = 0; j < 4; ++j) { const f32x4 gg = *(const f32x4*)(g + 4 * lane + 256 * j); const f32x4 o = v[j] * rstd * gg; v2u w; w.x = pk2(o[0], o[1]); w.y = pk2(o[2], o[3]);
        *(v2u*)(MIX + (size_t)t * D + 4 * lane + 256 * j) = w; }
}

__global__ void __launch_bounds__(64) k_mlstm_naive(const bf16* QKC, const bf16* P, const float* GATES, float* HF, float* HB) {
    const int lane = threadIdx.x; const int eb = blockIdx.x & 31; const int chain = blockIdx.x >> 5;
    const int dir = chain & 1, h = (chain >> 1) & 3, b = chain >> 3;
    const int ei = lane & 7, dg = lane >> 3;
    float C[16], nn[16];
#pragma unroll
    for (int i = 0; i < 16; ++i) { C[i] = 0.f; nn[i] = 0.f; }
    float* H = dir ? HB : HF;
    const int icol = dir * 8 + h, fcol = dir * 8 + 4 + h;
    for (int st = 0; st < SEQ; ++st) { const int s = dir ? (SEQ - 1 - st) : st; const int t = b * SEQ + s;
        const float ip = GATES[t * 16 + icol], fp = GATES[t * 16 + fcol];
        const float fg = 1.0f / (1.0f + __expf(-fp)), ig = __expf(ip);
        const v4u q0 = *(const v4u*)(QKC + (size_t)t * 1024 + h * 128 + dg * 16), q1 = *(const v4u*)(QKC + (size_t)t * 1024 + h * 128 + dg * 16 + 8);
        const v4u k0 = *(const v4u*)(QKC + (size_t)t * 1024 + 512 + h * 128 + dg * 16), k1 = *(const v4u*)(QKC + (size_t)t * 1024 + 512 + h * 128 + dg * 16 + 8);
        const float q[16] = {bflo(q0.x), bfhi(q0.x), bflo(q0.y), bfhi(q0.y), bflo(q0.z), bfhi(q0.z), bflo(q0.w), bfhi(q0.w), bflo(q1.x), bfhi(q1.x), bflo(q1.y), bfhi(q1.y), bflo(q1.z), bfhi(q1.z), bflo(q1.w), bfhi(q1.w)};
        const float k[16] = {bflo(k0.x), bfhi(k0.x), bflo(k0.y), bfhi(k0.y), bflo(k0.z), bfhi(k0.z), bflo(k0.w), bfhi(k0.w), bflo(k1.x), bfhi(k1.x), bflo(k1.y), bfhi(k1.y), bflo(k1.z), bfhi(k1.z), bflo(k1.w), bfhi(k1.w)};
        const float vv = bf2f(P[(size_t)t * NPROJ + C_MLV + h * 256 + eb * 8 + ei]);
        float pn = 0.f, pd = 0.f;
#pragma unroll
        for (int i = 0; i < 16; ++i) { const float ik = ig * k[i]; C[i] = fg * C[i] + ik * vv; nn[i] = fg * nn[i] + ik; pn += q[i] * C[i]; pd += q[i] * nn[i]; }
        pn += __shfl_xor(pn, 8); pn += __shfl_xor(pn, 16); pn += __shfl_xor(pn, 32);
        pd += __shfl_xor(pd, 8); pd += __shfl_xor(pd, 16); pd += __shfl_xor(pd, 32);
        if (dg == 0) H[(size_t)t * 1024 + h * 256 + eb * 8 + ei] = pn / fmaxf(fabsf(pd), 1.0f);
    }
}
__global__ void __launch_bounds__(256) k_ml_final(const float* HF, const float* HB, const bf16* P, const float* g, bf16* MIX) {
    const int lane = threadIdx.x & 63; const int wv = blockIdx.x * 4 + (threadIdx.x >> 6); const int t = wv >> 2, h = wv & 3; if (t >= MTOK) return;
    const size_t off = (size_t)t * 1024 + h * 256 + 4 * lane;
    const f32x4 v = *(const f32x4*)(HF + off) + *(const f32x4*)(HB + off);
    const float ss = wave_sum((v[0] * v[0] + v[1] * v[1]) + (v[2] * v[2] + v[3] * v[3]));
    const float rstd = 1.0f / sqrtf(ss * (1.0f / 256.0f) + EPS);
    const f32x4 gg = *(const f32x4*)(g + h * 256 + 4 * lane);
    const v2u ow = *(const v2u*)(P + (size_t)t * NPROJ + C_MLO + h * 256 + 4 * lane);
    const float o[4] = {bflo(ow.x), bfhi(ow.x), bflo(ow.y), bfhi(ow.y)};
    float r[4];
#pragma unroll
    for (int i = 0; i < 4; ++i) r[i] = v[i] * rstd * gg[i] / (1.0f + __expf(-o[i]));
    v2u w; w.x = pk2(r[0], r[1]); w.y = pk2(r[2], r[3]);
    *(v2u*)(MIX + (size_t)t * D + 1024 + h * 256 + 4 * lane) = w;
}

__device__ __forceinline__ int block_sum_512(int v, LAS int* red, int wave, int lane) {
#pragma unroll
    for (int o = 1; o < 64; o <<= 1) v += __shfl_xor(v, o);
    __syncthreads();
    if (lane == 0) red[wave] = v;
    __syncthreads();
    int s = 0;
#pragma unroll
    for (int w = 0; w < 8; ++w) s += red[w];
    return s;
}
__device__ __forceinline__ int block_excl_scan_512(int v, LAS int* red, int wave, int lane) {
    int inc = v;
#pragma unroll
    for (int o = 1; o < 64; o <<= 1) { const int t = __shfl_up(inc, o); if (lane >= o) inc += t; }
    __syncthreads();
    if (lane == 63) red[wave] = inc;
    __syncthreads();
    int base = 0;
#pragma unroll
    for (int w = 0; w < 8; ++w) base += (w < wave) ? red[w] : 0;
    return base + inc - v;
}
__device__ __forceinline__ void topk_unit(int be, const float* AFF, int* TOK, float* GATEV, int* SEL, LAS int* red) {
    const int tid = threadIdx.x, lane = tid & 63, wave = tid >> 6;
    const int b = be >> 4, e = be & 15;
    const float* a = AFF + (size_t)be * SEQ + tid * 8;
    const f32x4 a0 = *(const f32x4*)a, a1 = *(const f32x4*)(a + 4);
    unsigned key[8] = {__float_as_uint(a0.x), __float_as_uint(a0.y), __float_as_uint(a0.z), __float_as_uint(a0.w),
                       __float_as_uint(a1.x), __float_as_uint(a1.y), __float_as_uint(a1.z), __float_as_uint(a1.w)};
    unsigned T = 0u;
    for (int bit = 30; bit >= 0; --bit) { const unsigned cand = T | (1u << bit); int c = 0;
#pragma unroll
        for (int i = 0; i < 8; ++i) c += key[i] >= cand ? 1 : 0;
        if (block_sum_512(c, red, wave, lane) >= CAP) T = cand; }
    int cgt = 0, ceq = 0;
#pragma unroll
    for (int i = 0; i < 8; ++i) { cgt += key[i] > T ? 1 : 0; ceq += key[i] == T ? 1 : 0; }
    const int need_eq = CAP - block_sum_512(cgt, red, wave, lane);
    int eqrank = block_excl_scan_512(ceq, red, wave, lane);
    int selm = 0, csel = 0;
#pragma unroll
    for (int i = 0; i < 8; ++i) { bool sel = key[i] > T; if (key[i] == T) { sel = eqrank < need_eq; ++eqrank; } if (sel) { selm |= 1 << i; ++csel; } }
    int slot = block_excl_scan_512(csel, red, wave, lane);
#pragma unroll
    for (int i = 0; i < 8; ++i) { const int sidx = tid * 8 + i; const int tok = b * SEQ + sidx;
        if (selm & (1 << i)) { const int R = e * 2048 + b * 512 + slot; TOK[R] = tok; GATEV[R] = __uint_as_float(key[i]); SEL[tok * 16 + e] = slot; ++slot; }
        else SEL[tok * 16 + e] = -1; }
    __syncthreads();
}
__global__ void __launch_bounds__(512) k_topk(const float* AFF, int* TOK, float* GATEV, int* SEL) {
    __shared__ int red[8];
    topk_unit(blockIdx.x, AFF, TOK, GATEV, SEL, (LAS int*)red);
}
__global__ void __launch_bounds__(256) k_gather(const bf16* XB, const int* TOK, bf16* XIN) {
    const int lane = threadIdx.x & 63; const int R = blockIdx.x * 4 + (threadIdx.x >> 6); if (R >= MR) return;
    const v4u* src = (const v4u*)(XB + (size_t)TOK[R] * D); v4u* dst = (v4u*)(XIN + (size_t)R * D);
#pragma unroll
    for (int j = 0; j < 4; ++j) dst[lane + 64 * j] = src[lane + 64 * j];
}

template <class Epi, class Sched> struct GemmArgs { pg8::Gemm g; Epi E; Sched S; };
template <class Epi, class Sched> __global__ void __launch_bounds__(512, 2) k_gemm(GemmArgs<Epi, Sched> a) {
    extern __shared__ __attribute__((aligned(16))) unsigned char shm[];
    Sched S2 = a.S; S2.c = (int)blockIdx.x;
    pg8::gemm_phase<Epi, Sched, true, true>((PG8_LAS unsigned char*)shm, a.g, S2, a.E);
}
template <class Epi, class Sched> static void launch_gemm(const pg8::Gemm& g, const Epi& E, const Sched& S, int grid, hipStream_t st) {
    static_assert(sizeof(GemmArgs<Epi, Sched>) == sizeof(pg8::Gemm) + sizeof(Epi) + sizeof(Sched) && sizeof(GemmArgs<Epi, Sched>) % 8 == 0, "no holes in the argument struct");
    static bool attr = false; if (!attr) { (void)hipFuncSetAttribute((const void*)k_gemm<Epi, Sched>, hipFuncAttributeMaxDynamicSharedMemorySize, pg8::STAGE_BYTES); attr = true; }
    GemmArgs<Epi, Sched> a; memset(&a, 0, sizeof(a)); a.g = g; a.E = E; a.S = S;
    hipLaunchKernelGGL((k_gemm<Epi, Sched>), dim3(grid), dim3(512), pg8::STAGE_BYTES, st, a);
}

extern "C" void kernel_launch(void* const* d_in, const int* in_sizes, int n_in, void* d_out, int out_size, void* d_ws, size_t ws_size, hipStream_t stream) {
    if (n_in != 16 || ws_size < WS_END) { fprintf(stderr, "kernel_launch: unexpected n_in %d or ws_size %zu\n", n_in, ws_size); return; }
    const float* x = (const float*)d_in[0]; const float* norm_mix_g = (const float*)d_in[1]; const float* w_in = (const float*)d_in[2]; const float* b_gates = (const float*)d_in[3];
    const float* conv_w = (const float*)d_in[4]; const float* conv_b = (const float*)d_in[5]; const float* na_rpb = (const float*)d_in[6]; const float* na_norm_g = (const float*)d_in[7];
    const float* ml_norm_g = (const float*)d_in[8]; const float* w_out = (const float*)d_in[9]; const float* norm_ffn_g = (const float*)d_in[10]; const float* w_router = (const float*)d_in[11];
    const float* w_gate = (const float*)d_in[12]; const float* w_up = (const float*)d_in[13]; const float* w_down = (const float*)d_in[14]; const float* final_norm_g = (const float*)d_in[15];
    unsigned char* ws = (unsigned char*)d_ws; float* X = (float*)d_out;
    float* RSTD = (float*)(ws + WS_RSTD); float* GATES = (float*)(ws + WS_GATES); float* AFF = (float*)(ws + WS_AFF); int* TOK = (int*)(ws + WS_TOK); float* GATEV = (float*)(ws + WS_GATEV); int* SEL = (int*)(ws + WS_SEL);
    bf16* XB = (bf16*)(ws + WS_XB); bf16* MIX = (bf16*)(ws + WS_MIX); bf16* P = (bf16*)(ws + WS_P); float* NAO = (float*)(ws + WS_NAO); float* HF = (float*)(ws + WS_HF); float* HB = (float*)(ws + WS_HB);
    bf16* QKC = (bf16*)(ws + WS_QKC); bf16* XIN = (bf16*)(ws + WS_XIN); bf16* ACT = (bf16*)(ws + WS_ACT); bf16* Y = (bf16*)(ws + WS_Y);
    static int grid = 0;
    if (!grid) { int dev = 0, cus = 0; (void)hipGetDevice(&dev); (void)hipDeviceGetAttribute(&cus, hipDeviceAttributeMultiprocessorCount, dev); grid = cus > 0 ? cus : 256; }

    ConvArgs ca; memset(&ca, 0, sizeof(ca)); ca.w_in = w_in; ca.w_out = w_out; ca.w_gate = w_gate; ca.w_up = w_up; ca.w_down = w_down; ca.norm_mix_g = norm_mix_g; ca.norm_ffn_g = norm_ffn_g; ca.ws = ws;
    hipLaunchKernelGGL(k_convert, dim3(2048), dim3(256), 0, stream, ca);

    for (int l = 0; l < DEPTH; ++l) {
        const bf16* WinT = (const bf16*)(ws + WS_WIN) + (size_t)l * NPROJ * D; const bf16* WoutT = (const bf16*)(ws + WS_WOUT) + (size_t)l * D * D;
        const bf16* WguT = (const bf16*)(ws + WS_WGU) + (size_t)l * NE * 2048 * D; const bf16* WdT = (const bf16*)(ws + WS_WD) + (size_t)l * NE * D * DE;
        { RowArgs a; memset(&a, 0, sizeof(a)); a.src = l == 0 ? x : X; a.xout = X; a.sel = l == 0 ? nullptr : SEL; a.Y = Y; a.XB = XB; a.RSTD = RSTD; a.g = norm_mix_g + l * D; a.W16 = w_in + (size_t)l * D * NIN + C_GATES; a.ldw = NIN;
          a.bias = b_gates + l * 16; a.GATES = GATES; a.mode = 0; hipLaunchKernelGGL(k_rowpass, dim3(MTOK / 4), dim3(256), 0, stream, a); }
        { pg8::Gemm g{XB, WinT, MTOK, NPROJ, D, 0}; pg8::StaticOrder S; S.init(MTOK, NPROJ, grid, 0); pg8::EpiRowScaleBf16 E{P, RSTD, nullptr, NPROJ, 0};
          launch_gemm(g, E, S, grid, stream); }
        hipLaunchKernelGGL(k_na_naive, dim3(MTOK * 8 / 4), dim3(256), 0, stream, P, na_rpb + (size_t)l * 8 * 15 * 31, NAO);
        hipLaunchKernelGGL(k_na_norm, dim3(MTOK / 4), dim3(256), 0, stream, NAO, na_norm_g + l * 1024, MIX);
        hipLaunchKernelGGL(k_conv, dim3(MTOK * 128 / 256), dim3(256), 0, stream, P, conv_w + (size_t)l * 5 * 1024, conv_b + l * 1024, QKC);
        hipLaunchKernelGGL(k_mlstm_naive, dim3(32 * 32), dim3(64), 0, stream, QKC, P, GATES, HF, HB);
        hipLaunchKernelGGL(k_ml_final, dim3(MTOK * 4 / 4), dim3(256), 0, stream, HF, HB, P, ml_norm_g + l * 1024, MIX);
        { pg8::Gemm g{MIX, WoutT, MTOK, D, D, 0}; pg8::StaticOrder S; S.init(MTOK, D, grid, 0); pg8::EpiResidF32 E{X, l == 0 ? x : X, D, 0};
          launch_gemm(g, E, S, grid, stream); }
        { RowArgs a; memset(&a, 0, sizeof(a)); a.src = X; a.xout = X; a.sel = nullptr; a.Y = Y; a.XB = XB; a.RSTD = RSTD; a.g = norm_ffn_g + l * D; a.W16 = w_router + (size_t)l * D * NE; a.ldw = NE;
          a.AFF = AFF; a.mode = 1; hipLaunchKernelGGL(k_rowpass, dim3(MTOK / 4), dim3(256), 0, stream, a); }
        hipLaunchKernelGGL(k_topk, dim3(BATCH * NE), dim3(512), 0, stream, AFF, TOK, GATEV, SEL);
        hipLaunchKernelGGL(k_gather, dim3(MR / 4), dim3(256), 0, stream, XB, TOK, XIN);
        { pg8::Gemm g{XIN, WguT, MR, 2048, D, 0}; pg8::GroupedOrder S{grid, 0}; pg8::EpiSwiGLU E{ACT, RSTD, TOK, DE, 8};
          launch_gemm(g, E, S, grid, stream); }
        { pg8::Gemm g{ACT, WdT, MR, 2048, DE, 0}; pg8::GroupedOrder S{grid, 0}; pg8::EpiRowScaleBf16 E{Y, GATEV, nullptr, D, 8};
          launch_gemm(g, E, S, grid, stream); }
    }
    { RowArgs a; memset(&a, 0, sizeof(a)); a.src = X; a.xout = X; a.sel = SEL; a.Y = Y; a.g = final_norm_g; a.out = X; a.mode = 2; hipLaunchKernelGGL(k_rowpass, dim3(MTOK / 4), dim3(256), 0, stream, a); }
}
```

```cpp
#include <hip/hip_runtime.h>
#include <stdint.h>
#include <stdio.h>
#include <string.h>

namespace pg8 {
#define PG8_LAS __attribute__((address_space(3)))
typedef unsigned short bf16_t;
typedef short bf16x8 __attribute__((ext_vector_type(8)));
typedef float f32x4 __attribute__((ext_vector_type(4)));
typedef unsigned u32x4 __attribute__((ext_vector_type(4)));
typedef int v4i32 __attribute__((ext_vector_type(4)));
typedef int v8i32 __attribute__((ext_vector_type(8)));
constexpr int BM = 256, BK = 64, HALF = 128, HTB = HALF * BK * 2  , STAGE_BYTES = 8 * HTB, NXCD = 8, WGM = 8;

__host__ __device__ __forceinline__ int lds_byte(int r, int c) { const int st = (r >> 4) * 2 + (c >> 5), rr = r & 15, cc = c & 31, ob = rr * 64 + cc * 2; return st * 1024 + (ob ^ (((ob >> 9) & 1) << 5)); }
__host__ __device__ __forceinline__ void stage_rc(int b, int& R, int& C) { const int st = b / 1024, sb = b % 1024, swz = sb ^ (((sb >> 9) & 1) << 5); R = (st >> 1) * 16 + swz / 64; C = (st & 1) * 32 + (swz % 64) / 2; }
__host__ __device__ __forceinline__ int perm32(int rho) { const int n = rho >> 4, i = rho & 15; return 8 * (i >> 2) + 4 * n + (i & 3); }

struct Unit { int pm, pn; };
struct Gemm { const bf16_t* A; const bf16_t* Bt; int M, N, K, pad; };

struct StaticOrder {
    static constexpr bool GATHER = false;
    int nM, nN, nwg, G, c, pad;
    __host__ __device__ void init(int M, int N, int G_, int c_) { nM = M / BM; nN = N / BM; nwg = nM * nN; G = G_; c = c_; pad = 0; }
    __host__ __device__ bool next(int i, Unit& u) const {
        const long L = (long)i * G + c; if (L >= nwg) return false;
        int wgid = (int)L; { const int q = nwg / NXCD, r = nwg % NXCD, xcd = wgid % NXCD, off = wgid / NXCD; wgid = (xcd < r ? xcd * (q + 1) : r * (q + 1) + (xcd - r) * q) + off; }
        const int nig = WGM * nN, gid = wgid / nig, fm = gid * WGM, gsz = (nM - fm) < WGM ? (nM - fm) : WGM;
        u.pm = fm + ((wgid % nig) % gsz); u.pn = (wgid % nig) / gsz; return true;
    }
    __device__ __forceinline__ void a_ready(const Unit&) const {}
    __device__ __forceinline__ void done(const Unit&) const {}
};


__device__ __forceinline__ unsigned cvt_pk_bf16(float lo, float hi) { unsigned r; asm volatile("v_cvt_pk_bf16_f32 %0, %1, %2" : "=v"(r) : "v"(lo), "v"(hi)); return r; }
typedef unsigned u32x2 __attribute__((ext_vector_type(2)));

struct EpiRowScaleBf16 {
    static constexpr bool PERM = true, AFTER_DRAIN = false;
    bf16_t* O; const float* rowscale; const int* rowmap; int ldc; int pn_mod; float mul; int pad;
    __device__ __forceinline__ void operator()(const f32x4 (&acc)[2][2][4][2], const Unit& u, int wr, int wc, int fr, int fq) const {
        const int row0 = u.pm * BM + wr * 64 + fr; const int pnl = pn_mod ? (u.pn % pn_mod) : u.pn;
        const int col0 = pnl * BM + wc * 32 + 8 * fq;
#pragma unroll
        for (int ai = 0; ai < 2; ++ai)
#pragma unroll
            for (int m = 0; m < 4; ++m) { const int row = row0 + ai * HALF + m * 16; const float sc = rowscale ? rowscale[rowmap ? rowmap[row] : row] * mul : mul;
                bf16_t* rowp = O + (size_t)row * ldc + col0;
#pragma unroll
                for (int bj = 0; bj < 2; ++bj) { const f32x4 v0 = acc[ai][bj][m][0] * sc, v1 = acc[ai][bj][m][1] * sc;
                    u32x4 w; w.x = cvt_pk_bf16(v0[0], v0[1]); w.y = cvt_pk_bf16(v0[2], v0[3]); w.z = cvt_pk_bf16(v1[0], v1[1]); w.w = cvt_pk_bf16(v1[2], v1[3]);
                    *(u32x4*)(rowp + bj * HALF) = w; } }
    }
};
__device__ __forceinline__ unsigned pk4_fp8(float a, float b, float c, float d) { int p = __builtin_amdgcn_cvt_pk_fp8_f32(a, b, 0, false); p = __builtin_amdgcn_cvt_pk_fp8_f32(c, d, p, true); return (unsigned)p; }
struct EpiSwiGLU8 {
    static constexpr bool PERM = false, AFTER_DRAIN = false;
    unsigned char* O; const float* rowscale; const int* rowmap; int ldc; int pn_mod; float mul; int pad;
    __device__ __forceinline__ void operator()(const f32x4 (&acc)[2][2][4][2], const Unit& u, int wr, int wc, int fr, int fq) const {
        const int row0 = u.pm * BM + wr * 64 + fr; const int pnl = u.pn % pn_mod;
        const int col0 = pnl * 128 + wc * 16 + 4 * fq;
#pragma unroll
        for (int ai = 0; ai < 2; ++ai)
#pragma unroll
            for (int m = 0; m < 4; ++m) { const int row = row0 + ai * HALF + m * 16; const float sc = rowscale[rowmap[row]] * mul;
                unsigned char* rowp = O + (size_t)row * ldc + col0;
#pragma unroll
                for (int bj = 0; bj < 2; ++bj) { const f32x4 a = acc[ai][bj][m][0] * sc, up = acc[ai][bj][m][1] * sc; f32x4 r;
#pragma unroll
                    for (int j = 0; j < 4; ++j) r[j] = a[j] * up[j] * __builtin_amdgcn_rcpf(1.0f + __builtin_amdgcn_exp2f(-1.4426950408889634f * a[j]));
                    *(unsigned*)(rowp + bj * 64) = pk4_fp8(r[0], r[1], r[2], r[3]); } }
    }
};

struct EpiRowScaleF8 {
    static constexpr bool PERM = true, AFTER_DRAIN = false;
    unsigned char* O; const float* rowscale; int ldc; int pn_mod; float mul; int pad;
    __device__ __forceinline__ void operator()(const f32x4 (&acc)[2][2][4][2], const Unit& u, int wr, int wc, int fr, int fq) const {
        const int row0 = u.pm * BM + wr * 64 + fr; const int pnl = pn_mod ? (u.pn % pn_mod) : u.pn;
        const int col0 = pnl * BM + wc * 32 + 8 * fq;
#pragma unroll
        for (int ai = 0; ai < 2; ++ai)
#pragma unroll
            for (int m = 0; m < 4; ++m) { const int row = row0 + ai * HALF + m * 16; const float sc = rowscale[row] * mul;
                unsigned char* rowp = O + (size_t)row * ldc + col0;
#pragma unroll
                for (int bj = 0; bj < 2; ++bj) { const f32x4 v0 = acc[ai][bj][m][0] * sc, v1 = acc[ai][bj][m][1] * sc;
                    u32x2 w; w.x = pk4_fp8(v0[0], v0[1], v0[2], v0[3]); w.y = pk4_fp8(v1[0], v1[1], v1[2], v1[3]);
                    *(u32x2*)(rowp + bj * HALF) = w; } }
    }
};

struct EpiResidBf16 {
    static constexpr bool PERM = true, AFTER_DRAIN = false;
    bf16_t* XB; int ldc; int pad;
    __device__ __forceinline__ void operator()(const f32x4 (&acc)[2][2][4][2], const Unit& u, int wr, int wc, int fr, int fq) const {
        const int row0 = u.pm * BM + wr * 64 + fr, col0 = u.pn * BM + wc * 32 + 8 * fq;
#pragma unroll
        for (int ai = 0; ai < 2; ++ai)
#pragma unroll
            for (int m = 0; m < 4; ++m) { bf16_t* rowp = XB + (size_t)(row0 + ai * HALF + m * 16) * ldc + col0;
#pragma unroll
                for (int bj = 0; bj < 2; ++bj) { const u32x4 x = *(const u32x4*)(rowp + bj * HALF); const f32x4 v0 = acc[ai][bj][m][0], v1 = acc[ai][bj][m][1];
                    u32x4 w; w.x = cvt_pk_bf16(__uint_as_float(x.x << 16) + v0[0], __uint_as_float(x.x & 0xffff0000u) + v0[1]); w.y = cvt_pk_bf16(__uint_as_float(x.y << 16) + v0[2], __uint_as_float(x.y & 0xffff0000u) + v0[3]);
                    w.z = cvt_pk_bf16(__uint_as_float(x.z << 16) + v1[0], __uint_as_float(x.z & 0xffff0000u) + v1[1]); w.w = cvt_pk_bf16(__uint_as_float(x.w << 16) + v1[2], __uint_as_float(x.w & 0xffff0000u) + v1[3]);
                    *(u32x4*)(rowp + bj * HALF) = w; } }
    }
};
template <bool GATHER_> struct GroupedOrderT {
    static constexpr bool GATHER = GATHER_;
    const int* rowmap; int G, c;
    __device__ __forceinline__ bool next(int i, Unit& u) const {
        const int L = i * G + c; if (L >= 1024) return false;
        const int e = L >> 6, w = L & 63; u.pm = e * 8 + (w & 7); u.pn = e * 8 + (w >> 3); return true;
    }
    __device__ __forceinline__ void a_ready(const Unit&) const {}
    __device__ __forceinline__ void done(const Unit&) const {}
};
typedef GroupedOrderT<false> GroupedOrder; typedef GroupedOrderT<true> GroupedGatherOrder;
template <class Epi, class Sched, bool ALIGN_EPI = false, bool SP2 = false, bool F8 = false>
__device__ __forceinline__ void gemm_phase(PG8_LAS unsigned char* lds, const Gemm g, const Sched& S, const Epi& E) {
    int tid_ = threadIdx.x; asm volatile("" : "+v"(tid_));
    const int tid = tid_, wid = __builtin_amdgcn_readfirstlane(tid >> 6), lane = tid & 63, wr = wid >> 2, wc = wid & 3, fr = lane & 15, fq = lane >> 4;
    const int K = g.K, nt = K / BK;
    unsigned voffA[2], voffB[2];
#pragma unroll
    for (int i = 0; i < 2; ++i) { int R, C; stage_rc(tid * 16 + i * 8192, R, C); const int Rb = Epi::PERM ? ((R & ~31) + perm32(R & 31)) : R;
        voffA[i] = (unsigned)(R * K + C) * 2u; voffB[i] = (unsigned)(Rb * K + C) * 2u; }
    const size_t kstep = (size_t)(BK * 2);
    const size_t hstep = (size_t)HALF * K * 2;
    const size_t tstep = 2 * hstep;
    const unsigned ldsw = (unsigned)wid * 1024u;
    const int aoff = lds_byte(wr * 64 + fr, fq * 8), boff = lds_byte(wc * 32 + fr, fq * 8);
#define PG8_SA(b, h) (((b) * 2 + (h)) * HTB)
#define PG8_SB(b, h) ((4 + (b) * 2 + (h)) * HTB)
#define PG8_STAGE(bufoff, gbase, voff) do { _Pragma("unroll") for (int _i = 0; _i < 2; ++_i) \
        __builtin_amdgcn_global_load_lds((const unsigned*)((const char*)(gbase) + (voff)[_i]), (PG8_LAS unsigned*)(lds + (bufoff) + ldsw + _i * 8192), 16, 0, 0); } while (0)
#define PG8_LDA(dst, b, h) do { if constexpr (F8) { _Pragma("unroll") for (int m = 0; m < 4; ++m) dst##8[m] = __builtin_shufflevector(*(const PG8_LAS v4i32*)(lds + PG8_SA(b, h) + aoff + m * 2048), *(const PG8_LAS v4i32*)(lds + PG8_SA(b, h) + aoff + m * 2048 + 1024), 0, 1, 2, 3, 4, 5, 6, 7); } \
    else { _Pragma("unroll") for (int m = 0; m < 4; ++m) _Pragma("unroll") for (int k = 0; k < 2; ++k) dst[m][k] = *(const PG8_LAS bf16x8*)(lds + PG8_SA(b, h) + aoff + m * 2048 + k * 1024); } } while (0)
#define PG8_LDB(dst, b, h) do { if constexpr (F8) { _Pragma("unroll") for (int n = 0; n < 2; ++n) dst##8[n] = __builtin_shufflevector(*(const PG8_LAS v4i32*)(lds + PG8_SB(b, h) + boff + n * 2048), *(const PG8_LAS v4i32*)(lds + PG8_SB(b, h) + boff + n * 2048 + 1024), 0, 1, 2, 3, 4, 5, 6, 7); } \
    else { _Pragma("unroll") for (int n = 0; n < 2; ++n) _Pragma("unroll") for (int k = 0; k < 2; ++k) dst[n][k] = *(const PG8_LAS bf16x8*)(lds + PG8_SB(b, h) + boff + n * 2048 + k * 1024); } } while (0)
#define PG8_MMA(ai, bj, At, Bt) do { __builtin_amdgcn_s_setprio(1); _Pragma("unroll") for (int m = 0; m < 4; ++m) _Pragma("unroll") for (int n = 0; n < 2; ++n) { \
        if constexpr (F8) asm volatile("v_mfma_scale_f32_16x16x128_f8f6f4 %0, %1, %2, %0, %3, %3 op_sel_hi:[0,0,0]" : "+v"(acc[ai][bj][m][n]) : "v"(Bt##8[n]), "v"(At##8[m]), "v"(f8scale));   \
        else { _Pragma("unroll") for (int k = 0; k < 2; ++k) acc[ai][bj][m][n] = __builtin_amdgcn_mfma_f32_16x16x32_bf16(Bt[n][k], At[m][k], acc[ai][bj][m][n], 0, 0, 0); } } \
        __builtin_amdgcn_s_setprio(0); } while (0)
#define PG8_WAIT_V(n) asm volatile("s_waitcnt vmcnt(" #n ")" ::: "memory")
#define PG8_WAIT_L(n) asm volatile("s_waitcnt lgkmcnt(" #n ")" ::: "memory")
#define PG8_BAR __builtin_amdgcn_s_barrier()
#define PG8_SCHED __builtin_amdgcn_sched_barrier(0)
    Unit cur, nxt; int ui = 0;
    if (!S.next(0, cur)) return;
    f32x4 acc[2][2][4][2];
#pragma unroll
    for (int a = 0; a < 2; ++a)
#pragma unroll
        for (int b = 0; b < 2; ++b)
#pragma unroll
            for (int m = 0; m < 4; ++m)
#pragma unroll
                for (int n = 0; n < 2; ++n) acc[a][b][m][n] = (f32x4){0.f, 0.f, 0.f, 0.f};
    bf16x8 At[4][2], B0[2][2], B1[2][2]; v8i32 At8[4], B08[2], B18[2];
    const int f8scale = 0x7F7F7F7F; (void)f8scale;
    const char* cA = (const char*)g.A + (size_t)cur.pm * tstep; const char* cB = (const char*)g.Bt + (size_t)cur.pn * tstep;
    S.a_ready(cur);
    if constexpr (SP2) {
        PG8_STAGE(PG8_SB(0, 0), cB, voffB); PG8_STAGE(PG8_SB(0, 1), cB + hstep, voffB); PG8_STAGE(PG8_SA(0, 0), cA, voffA); PG8_STAGE(PG8_SA(0, 1), cA + hstep, voffA);
        if (wr == 1) PG8_BAR;
        PG8_WAIT_V(2); PG8_BAR;
        PG8_STAGE(PG8_SB(1, 0), cB + kstep, voffB); PG8_STAGE(PG8_SA(1, 0), cA + kstep, voffA); PG8_STAGE(PG8_SB(1, 1), cB + hstep + kstep, voffB);
        PG8_WAIT_V(6); PG8_BAR;
    } else {
        PG8_STAGE(PG8_SB(0, 0), cB, voffB); PG8_STAGE(PG8_SA(0, 0), cA, voffA); PG8_STAGE(PG8_SB(0, 1), cB + hstep, voffB); PG8_STAGE(PG8_SA(0, 1), cA + hstep, voffA);
        if (wr == 1) PG8_BAR;
        PG8_WAIT_V(4); PG8_BAR;
        PG8_STAGE(PG8_SB(1, 0), cB + kstep, voffB); PG8_STAGE(PG8_SA(1, 0), cA + kstep, voffA); PG8_STAGE(PG8_SB(1, 1), cB + hstep + kstep, voffB);
        PG8_WAIT_V(6); PG8_BAR;
    }
    for (;;) {
        const bool has_next = S.next(ui + 1, nxt);
        const char* nA = has_next ? (const char*)g.A + (size_t)nxt.pm * tstep : cA; const char* nB = has_next ? (const char*)g.Bt + (size_t)nxt.pn * tstep : cB;
        for (int t = 0; t < nt; t += 2) {
            const bool last = (t == nt - 2);
            const char* a1 = cA + (size_t)(t + 1) * kstep;
            const char* a2 = last ? nA : cA + (size_t)(t + 2) * kstep; const char* b2 = last ? nB : cB + (size_t)(t + 2) * kstep;
            const char* a3 = a2 + kstep; const char* b3 = b2 + kstep;
            if (last && has_next) S.a_ready(nxt);
            if constexpr (SP2) {
            PG8_LDB(B0, 0, 0); PG8_LDB(B1, 0, 1); PG8_SCHED; PG8_LDA(At, 0, 0); PG8_STAGE(PG8_SA(1, 1), a1 + hstep, voffA);
            PG8_WAIT_V(8); PG8_WAIT_L(0); PG8_BAR; PG8_MMA(0, 0, At, B0); PG8_MMA(0, 1, At, B1); PG8_BAR; PG8_SCHED;
            PG8_LDA(At, 0, 1); PG8_STAGE(PG8_SB(0, 0), b2, voffB); PG8_STAGE(PG8_SB(0, 1), b2 + hstep, voffB); PG8_STAGE(PG8_SA(0, 0), a2, voffA);
            PG8_WAIT_V(8); PG8_WAIT_L(0); PG8_BAR; PG8_MMA(1, 0, At, B0); PG8_MMA(1, 1, At, B1); PG8_BAR; PG8_SCHED;
            PG8_LDB(B0, 1, 0); PG8_LDB(B1, 1, 1); PG8_SCHED; PG8_LDA(At, 1, 0); PG8_STAGE(PG8_SA(0, 1), a2 + hstep, voffA);
            PG8_WAIT_V(8); PG8_WAIT_L(0); PG8_BAR; PG8_MMA(0, 0, At, B0); PG8_MMA(0, 1, At, B1); PG8_BAR; PG8_SCHED;
            PG8_LDA(At, 1, 1); PG8_STAGE(PG8_SB(1, 0), b3, voffB); PG8_STAGE(PG8_SB(1, 1), b3 + hstep, voffB); PG8_STAGE(PG8_SA(1, 0), a3, voffA);
            PG8_WAIT_V(8); PG8_WAIT_L(0); PG8_BAR; PG8_MMA(1, 0, At, B0); PG8_MMA(1, 1, At, B1); PG8_BAR; PG8_SCHED;
            } else {
            PG8_LDB(B0, 0, 0); PG8_SCHED; PG8_LDA(At, 0, 0); PG8_STAGE(PG8_SA(1, 1), a1 + hstep, voffA);
            PG8_WAIT_L(8); PG8_BAR; PG8_WAIT_L(0); PG8_MMA(0, 0, At, B0); PG8_BAR; PG8_SCHED;
            PG8_LDB(B1, 0, 1); PG8_STAGE(PG8_SB(0, 0), b2, voffB);
            PG8_BAR; PG8_WAIT_L(0); PG8_MMA(0, 1, At, B1); PG8_BAR;
            PG8_LDA(At, 0, 1); PG8_STAGE(PG8_SA(0, 0), a2, voffA);
            PG8_BAR; PG8_WAIT_L(0); PG8_MMA(1, 0, At, B0); PG8_BAR; PG8_SCHED;
            PG8_STAGE(PG8_SB(0, 1), b2 + hstep, voffB);
            PG8_WAIT_V(6); PG8_BAR; PG8_MMA(1, 1, At, B1); PG8_BAR;
            PG8_LDB(B0, 1, 0); PG8_SCHED; PG8_LDA(At, 1, 0); PG8_STAGE(PG8_SA(0, 1), a2 + hstep, voffA);
            PG8_WAIT_L(8); PG8_BAR; PG8_WAIT_L(0); PG8_MMA(0, 0, At, B0); PG8_BAR; PG8_SCHED;
            PG8_LDB(B1, 1, 1); PG8_STAGE(PG8_SB(1, 0), b3, voffB);
            PG8_BAR; PG8_WAIT_L(0); PG8_MMA(0, 1, At, B1); PG8_BAR;
            PG8_LDA(At, 1, 1); PG8_STAGE(PG8_SA(1, 0), a3, voffA);
            PG8_BAR; PG8_WAIT_L(0); PG8_MMA(1, 0, At, B0); PG8_BAR; PG8_SCHED;
            PG8_STAGE(PG8_SB(1, 1), b3 + hstep, voffB);
            PG8_WAIT_V(6); PG8_BAR; PG8_MMA(1, 1, At, B1); PG8_BAR;
            }
        }
        if constexpr (F8) asm volatile("s_nop 15\n\ts_nop 15" ::: "memory");
        if constexpr (ALIGN_EPI) { if (wr == 0) PG8_BAR; }
        if constexpr (!Epi::AFTER_DRAIN) { E(acc, cur, wr, wc, fr, fq); S.done(cur); }
        if (!has_next) break;
#pragma unroll
        for (int a = 0; a < 2; ++a)
#pragma unroll
            for (int b = 0; b < 2; ++b)
#pragma unroll
                for (int m = 0; m < 4; ++m)
#pragma unroll
                    for (int n = 0; n < 2; ++n) acc[a][b][m][n] = (f32x4){0.f, 0.f, 0.f, 0.f};
        cur = nxt; cA = nA; cB = nB; ++ui;
        if constexpr (ALIGN_EPI) { if (wr == 1) PG8_BAR; }
    }
    PG8_WAIT_V(0);
    if constexpr (!ALIGN_EPI) { if (wr == 0) PG8_BAR; }
    PG8_BAR;
    if constexpr (Epi::AFTER_DRAIN) { E.fused(acc, cur, wr, wc, fr, fq, lds, wid, lane); S.done(cur); }
#undef PG8_SA
#undef PG8_SB
#undef PG8_STAGE
#undef PG8_LDA
#undef PG8_LDB
#undef PG8_MMA
#undef PG8_WAIT_V
#undef PG8_WAIT_L
#undef PG8_BAR
#undef PG8_SCHED
}

template <class Epi, class Sched, bool ALIGN_EPI = false, bool SP2 = false, bool F8 = false>
__device__ __forceinline__ void gemm_phase_gather(PG8_LAS unsigned char* lds, const Gemm g, const Sched& S, const Epi& E) {
    int tid_ = threadIdx.x; asm volatile("" : "+v"(tid_));
    const int tid = tid_, wid = __builtin_amdgcn_readfirstlane(tid >> 6), lane = tid & 63, wr = wid >> 2, wc = wid & 3, fr = lane & 15, fq = lane >> 4;
    static_assert(SP2 || !Sched::GATHER, "gathered A rows: SP2 loop only");
    const int K = g.K, nt = K / BK;
    unsigned voffA[2], voffB[2];
#pragma unroll
    for (int i = 0; i < 2; ++i) { int R, C; stage_rc(tid * 16 + i * 8192, R, C); const int Rb = Epi::PERM ? ((R & ~31) + perm32(R & 31)) : R;
        voffA[i] = (unsigned)(R * K + C) * 2u; voffB[i] = (unsigned)(Rb * K + C) * 2u; }
    constexpr bool GATHER = Sched::GATHER;
    int RA[2], CA[2];
#pragma unroll
    for (int i = 0; i < 2; ++i) stage_rc(tid * 16 + i * 8192, RA[i], CA[i]);
    const size_t kstep = (size_t)(BK * 2);
    const size_t hstep = (size_t)HALF * K * 2;
    const size_t tstep = 2 * hstep;
    const unsigned ldsw = (unsigned)wid * 1024u;
    const int aoff = lds_byte(wr * 64 + fr, fq * 8), boff = lds_byte(wc * 32 + fr, fq * 8);
#define PG8_SA(b, h) (((b) * 2 + (h)) * HTB)
#define PG8_SB(b, h) ((4 + (b) * 2 + (h)) * HTB)
#define PG8_STAGE(bufoff, gbase, voff) do { _Pragma("unroll") for (int _i = 0; _i < 2; ++_i) \
        __builtin_amdgcn_global_load_lds((const unsigned*)((const char*)(gbase) + (voff)[_i]), (PG8_LAS unsigned*)(lds + (bufoff) + ldsw + _i * 8192), 16, 0, 0); } while (0)
#define PG8_LDA(dst, b, h) do { if constexpr (F8) { _Pragma("unroll") for (int m = 0; m < 4; ++m) dst##8[m] = __builtin_shufflevector(*(const PG8_LAS v4i32*)(lds + PG8_SA(b, h) + aoff + m * 2048), *(const PG8_LAS v4i32*)(lds + PG8_SA(b, h) + aoff + m * 2048 + 1024), 0, 1, 2, 3, 4, 5, 6, 7); } \
    else { _Pragma("unroll") for (int m = 0; m < 4; ++m) _Pragma("unroll") for (int k = 0; k < 2; ++k) dst[m][k] = *(const PG8_LAS bf16x8*)(lds + PG8_SA(b, h) + aoff + m * 2048 + k * 1024); } } while (0)
#define PG8_LDB(dst, b, h) do { if constexpr (F8) { _Pragma("unroll") for (int n = 0; n < 2; ++n) dst##8[n] = __builtin_shufflevector(*(const PG8_LAS v4i32*)(lds + PG8_SB(b, h) + boff + n * 2048), *(const PG8_LAS v4i32*)(lds + PG8_SB(b, h) + boff + n * 2048 + 1024), 0, 1, 2, 3, 4, 5, 6, 7); } \
    else { _Pragma("unroll") for (int n = 0; n < 2; ++n) _Pragma("unroll") for (int k = 0; k < 2; ++k) dst[n][k] = *(const PG8_LAS bf16x8*)(lds + PG8_SB(b, h) + boff + n * 2048 + k * 1024); } } while (0)
#define PG8_MMA(ai, bj, At, Bt) do { __builtin_amdgcn_s_setprio(1); _Pragma("unroll") for (int m = 0; m < 4; ++m) _Pragma("unroll") for (int n = 0; n < 2; ++n) { \
        if constexpr (F8) asm volatile("v_mfma_scale_f32_16x16x128_f8f6f4 %0, %1, %2, %0, %3, %3 op_sel_hi:[0,0,0]" : "+v"(acc[ai][bj][m][n]) : "v"(Bt##8[n]), "v"(At##8[m]), "v"(f8scale));   \
        else { _Pragma("unroll") for (int k = 0; k < 2; ++k) acc[ai][bj][m][n] = __builtin_amdgcn_mfma_f32_16x16x32_bf16(Bt[n][k], At[m][k], acc[ai][bj][m][n], 0, 0, 0); } } \
        __builtin_amdgcn_s_setprio(0); } while (0)
#define PG8_WAIT_V(n) asm volatile("s_waitcnt vmcnt(" #n ")" ::: "memory")
#define PG8_WAIT_L(n) asm volatile("s_waitcnt lgkmcnt(" #n ")" ::: "memory")
#define PG8_BAR __builtin_amdgcn_s_barrier()
#define PG8_SCHED __builtin_amdgcn_sched_barrier(0)
    Unit cur, nxt; int ui = 0;
    if (!S.next(0, cur)) return;
    f32x4 acc[2][2][4][2];
#pragma unroll
    for (int a = 0; a < 2; ++a)
#pragma unroll
        for (int b = 0; b < 2; ++b)
#pragma unroll
            for (int m = 0; m < 4; ++m)
#pragma unroll
                for (int n = 0; n < 2; ++n) acc[a][b][m][n] = (f32x4){0.f, 0.f, 0.f, 0.f};
    bf16x8 At[4][2], B0[2][2], B1[2][2]; v8i32 At8[4], B08[2], B18[2];
    const int f8scale = 0x7F7F7F7F; (void)f8scale;
    const char* cA = GATHER ? (const char*)g.A : (const char*)g.A + (size_t)cur.pm * tstep; const char* cB = (const char*)g.Bt + (size_t)cur.pn * tstep;
    unsigned offC[2][2], offN[2][2];
#define PG8_SETOFF(o, u) do { _Pragma("unroll") for (int _h = 0; _h < 2; ++_h) _Pragma("unroll") for (int _i = 0; _i < 2; ++_i) { \
        if constexpr (GATHER) o[_h][_i] = (unsigned)S.rowmap[(u).pm * BM + _h * HALF + RA[_i]] * (unsigned)(K * 2) + (unsigned)(CA[_i] * 2); \
        else o[_h][_i] = voffA[_i] + (unsigned)(_h * (int)hstep); } } while (0)
    PG8_SETOFF(offC, cur);
#pragma unroll
    for (int _h = 0; _h < 2; ++_h) { offN[_h][0] = offC[_h][0]; offN[_h][1] = offC[_h][1]; }
    S.a_ready(cur);
    if constexpr (SP2) {
        PG8_STAGE(PG8_SB(0, 0), cB, voffB); PG8_STAGE(PG8_SB(0, 1), cB + hstep, voffB); PG8_STAGE(PG8_SA(0, 0), cA, offC[0]); PG8_STAGE(PG8_SA(0, 1), cA, offC[1]);
        if (wr == 1) PG8_BAR;
        PG8_WAIT_V(2); PG8_BAR;
        PG8_STAGE(PG8_SB(1, 0), cB + kstep, voffB); PG8_STAGE(PG8_SA(1, 0), cA + kstep, offC[0]); PG8_STAGE(PG8_SB(1, 1), cB + hstep + kstep, voffB);
        PG8_WAIT_V(6); PG8_BAR;
    } else {
        PG8_STAGE(PG8_SB(0, 0), cB, voffB); PG8_STAGE(PG8_SA(0, 0), cA, voffA); PG8_STAGE(PG8_SB(0, 1), cB + hstep, voffB); PG8_STAGE(PG8_SA(0, 1), cA + hstep, voffA);
        if (wr == 1) PG8_BAR;
        PG8_WAIT_V(4); PG8_BAR;
        PG8_STAGE(PG8_SB(1, 0), cB + kstep, voffB); PG8_STAGE(PG8_SA(1, 0), cA + kstep, voffA); PG8_STAGE(PG8_SB(1, 1), cB + hstep + kstep, voffB);
        PG8_WAIT_V(6); PG8_BAR;
    }
    for (;;) {
        const bool has_next = S.next(ui + 1, nxt);
        const char* nA = GATHER ? cA : (has_next ? (const char*)g.A + (size_t)nxt.pm * tstep : cA); const char* nB = has_next ? (const char*)g.Bt + (size_t)nxt.pn * tstep : cB;
        if constexpr (GATHER) { if (has_next) PG8_SETOFF(offN, nxt); }
        for (int t = 0; t < nt; t += 2) {
            const bool last = (t == nt - 2);
            const char* a1 = cA + (size_t)(t + 1) * kstep;
            const char* a2 = last ? nA : cA + (size_t)(t + 2) * kstep; const char* b2 = last ? nB : cB + (size_t)(t + 2) * kstep;
            const char* a3 = a2 + kstep; const char* b3 = b2 + kstep;
            if (last && has_next) S.a_ready(nxt);
            unsigned o2[2][2];
#pragma unroll
            for (int _h = 0; _h < 2; ++_h)
#pragma unroll
                for (int _i = 0; _i < 2; ++_i) o2[_h][_i] = (GATHER && last) ? offN[_h][_i] : offC[_h][_i];
            if constexpr (SP2) {
            PG8_LDB(B0, 0, 0); PG8_LDB(B1, 0, 1); PG8_SCHED; PG8_LDA(At, 0, 0); PG8_STAGE(PG8_SA(1, 1), a1, offC[1]);
            PG8_WAIT_V(8); PG8_WAIT_L(0); PG8_BAR; PG8_MMA(0, 0, At, B0); PG8_MMA(0, 1, At, B1); PG8_BAR; PG8_SCHED;
            PG8_LDA(At, 0, 1); PG8_STAGE(PG8_SB(0, 0), b2, voffB); PG8_STAGE(PG8_SB(0, 1), b2 + hstep, voffB); PG8_STAGE(PG8_SA(0, 0), a2, o2[0]);
            PG8_WAIT_V(8); PG8_WAIT_L(0); PG8_BAR; PG8_MMA(1, 0, At, B0); PG8_MMA(1, 1, At, B1); PG8_BAR; PG8_SCHED;
            PG8_LDB(B0, 1, 0); PG8_LDB(B1, 1, 1); PG8_SCHED; PG8_LDA(At, 1, 0); PG8_STAGE(PG8_SA(0, 1), a2, o2[1]);
            PG8_WAIT_V(8); PG8_WAIT_L(0); PG8_BAR; PG8_MMA(0, 0, At, B0); PG8_MMA(0, 1, At, B1); PG8_BAR; PG8_SCHED;
            PG8_LDA(At, 1, 1); PG8_STAGE(PG8_SB(1, 0), b3, voffB); PG8_STAGE(PG8_SB(1, 1), b3 + hstep, voffB); PG8_STAGE(PG8_SA(1, 0), a3, o2[0]);
            PG8_WAIT_V(8); PG8_WAIT_L(0); PG8_BAR; PG8_MMA(1, 0, At, B0); PG8_MMA(1, 1, At, B1); PG8_BAR; PG8_SCHED;
            } else {
            PG8_LDB(B0, 0, 0); PG8_SCHED; PG8_LDA(At, 0, 0); PG8_STAGE(PG8_SA(1, 1), a1 + hstep, voffA);
            PG8_WAIT_L(8); PG8_BAR; PG8_WAIT_L(0); PG8_MMA(0, 0, At, B0); PG8_BAR; PG8_SCHED;
            PG8_LDB(B1, 0, 1); PG8_STAGE(PG8_SB(0, 0), b2, voffB);
            PG8_BAR; PG8_WAIT_L(0); PG8_MMA(0, 1, At, B1); PG8_BAR;
            PG8_LDA(At, 0, 1); PG8_STAGE(PG8_SA(0, 0), a2, voffA);
            PG8_BAR; PG8_WAIT_L(0); PG8_MMA(1, 0, At, B0); PG8_BAR; PG8_SCHED;
            PG8_STAGE(PG8_SB(0, 1), b2 + hstep, voffB);
            PG8_WAIT_V(6); PG8_BAR; PG8_MMA(1, 1, At, B1); PG8_BAR;
            PG8_LDB(B0, 1, 0); PG8_SCHED; PG8_LDA(At, 1, 0); PG8_STAGE(PG8_SA(0, 1), a2 + hstep, voffA);
            PG8_WAIT_L(8); PG8_BAR; PG8_WAIT_L(0); PG8_MMA(0, 0, At, B0); PG8_BAR; PG8_SCHED;
            PG8_LDB(B1, 1, 1); PG8_STAGE(PG8_SB(1, 0), b3, voffB);
            PG8_BAR; PG8_WAIT_L(0); PG8_MMA(0, 1, At, B1); PG8_BAR;
            PG8_LDA(At, 1, 1); PG8_STAGE(PG8_SA(1, 0), a3, voffA);
            PG8_BAR; PG8_WAIT_L(0); PG8_MMA(1, 0, At, B0); PG8_BAR; PG8_SCHED;
            PG8_STAGE(PG8_SB(1, 1), b3 + hstep, voffB);
            PG8_WAIT_V(6); PG8_BAR; PG8_MMA(1, 1, At, B1); PG8_BAR;
            }
        }
        if constexpr (F8) asm volatile("s_nop 15\n\ts_nop 15" ::: "memory");
        if constexpr (ALIGN_EPI) { if (wr == 0) PG8_BAR; }
        if constexpr (!Epi::AFTER_DRAIN) { E(acc, cur, wr, wc, fr, fq); S.done(cur); }
        if (!has_next) break;
#pragma unroll
        for (int a = 0; a < 2; ++a)
#pragma unroll
            for (int b = 0; b < 2; ++b)
#pragma unroll
                for (int m = 0; m < 4; ++m)
#pragma unroll
                    for (int n = 0; n < 2; ++n) acc[a][b][m][n] = (f32x4){0.f, 0.f, 0.f, 0.f};
        cur = nxt; cA = nA; cB = nB; ++ui;
#pragma unroll
        for (int _h = 0; _h < 2; ++_h) { offC[_h][0] = offN[_h][0]; offC[_h][1] = offN[_h][1]; }
        if constexpr (ALIGN_EPI) { if (wr == 1) PG8_BAR; }
    }
    PG8_WAIT_V(0);
    if constexpr (!ALIGN_EPI) { if (wr == 0) PG8_BAR; }
    PG8_BAR;
    if constexpr (Epi::AFTER_DRAIN) { E.fused(acc, cur, wr, wc, fr, fq, lds, wid, lane); S.done(cur); }
#undef PG8_SETOFF
#undef PG8_SA
#undef PG8_SB
#undef PG8_STAGE
#undef PG8_LDA
#undef PG8_LDB
#undef PG8_MMA
#undef PG8_WAIT_V
#undef PG8_WAIT_L
#undef PG8_BAR
#undef PG8_SCHED
}
}

constexpr int D = 2048, BATCH = 4, SEQ = 4096, MTOK = BATCH * SEQ, DEPTH = 2;
constexpr int NIN = 6160, NPROJ = 6144;
constexpr int C_NAQ = 0, C_NAK = 1024, C_NAV = 2048, C_MLQ = 3072, C_MLK = 3584, C_MLV = 4096, C_MLO = 5120, C_GATES = 6144;
constexpr int NE = 16, CAP = 512, DE = 1024, MR = NE * BATCH * CAP;
constexpr float EPS = 1e-6f;

typedef unsigned short bf16;
typedef float f32x4 __attribute__((ext_vector_type(4)));
typedef unsigned v4u __attribute__((ext_vector_type(4)));
typedef unsigned v2u __attribute__((ext_vector_type(2)));
#define LAS __attribute__((address_space(3)))
typedef short bf16x8v __attribute__((ext_vector_type(8)));
typedef short s16x4 __attribute__((ext_vector_type(4)));
constexpr size_t WS_XB8 = 968 * (size_t)(1u << 20);
constexpr size_t WS_W16F_OFF = 7 * (1u << 20) + 256 * 1024;

constexpr size_t MiB = 1u << 20;
constexpr size_t WS_CTL = 0;
constexpr size_t WS_RSTD = 1 * MiB;
constexpr size_t WS_GATES = 2 * MiB;
constexpr size_t WS_AFF = 3 * MiB;
constexpr size_t WS_TOK = 4 * MiB;
constexpr size_t WS_GATEV = 4 * MiB + 512 * 1024;
constexpr size_t WS_SEL = 5 * MiB;
constexpr size_t WS_WIN = 8 * MiB;
constexpr size_t WS_WOUT = 56 * MiB;
constexpr size_t WS_WGU = 72 * MiB;
constexpr size_t WS_WD = 328 * MiB;
constexpr size_t WS_XB = 456 * MiB;
constexpr size_t WS_MIX = 520 * MiB;
constexpr size_t WS_P = 584 * MiB;
constexpr size_t WS_NAO = 776 * MiB;
constexpr size_t WS_HF = 840 * MiB;
constexpr size_t WS_ACT = 712 * MiB;
constexpr size_t WS_Y = 776 * MiB;
constexpr size_t WS_END = 1000 * MiB;

__device__ __forceinline__ unsigned f2bf(float f) { unsigned u = __builtin_bit_cast(unsigned, f); return (u + 0x7fffu + ((u >> 16) & 1u)) >> 16; }
__device__ __forceinline__ unsigned pk2(float lo, float hi) { return f2bf(lo) | (f2bf(hi) << 16); }
__device__ __forceinline__ float bf2f(unsigned short b) { return __builtin_bit_cast(float, ((unsigned)b) << 16); }
__device__ __forceinline__ float bflo(unsigned w) { return __builtin_bit_cast(float, w << 16); }
__device__ __forceinline__ float bfhi(unsigned w) { return __builtin_bit_cast(float, w & 0xffff0000u); }
__device__ __forceinline__ float wave_sum(float v) {
#pragma unroll
    for (int o = 1; o < 64; o <<= 1) v += __shfl_xor(v, o);
    return v;
}
__device__ __forceinline__ float wave_max(float v) {
#pragma unroll
    for (int o = 1; o < 64; o <<= 1) v = fmaxf(v, __shfl_xor(v, o));
    return v;
}

__device__ __forceinline__ void transpose_item(const float* W, int ldw, const float* gk, bf16* WT, int K, int k0, int n0, int dmode, LAS float* scr, int lane, bool f8 = false, float wmul = 1.0f) {
    float wv[32];
#pragma unroll
    for (int i = 0; i < 32; ++i) wv[i] = W[(size_t)(k0 + 2 * i + (lane >> 5)) * ldw + n0 + (lane & 31)];
#pragma unroll
    for (int i = 0; i < 32; ++i) { const int kk = 2 * i + (lane >> 5); float w = wv[i]; if (gk) w *= gk[k0 + kk]; scr[kk * 33 + (lane & 31)] = w; }
    asm volatile("s_waitcnt lgkmcnt(0)" ::: "memory");
    const int c = lane & 7;
#pragma unroll
    for (int j = 0; j < 4; ++j) { const int n = (lane >> 3) + 8 * j; const LAS float* s = scr + (8 * c) * 33 + n;
        v4u o; o.x = pk2(s[0 * 33], s[1 * 33]); o.y = pk2(s[2 * 33], s[3 * 33]); o.z = pk2(s[4 * 33], s[5 * 33]); o.w = pk2(s[6 * 33], s[7 * 33]);
        const int ng = n0 + n; const int drow = dmode == 0 ? ng : ((ng >> 4) * 32 + (ng & 15) + (dmode == 2 ? 16 : 0));
        if (f8) { v2u o8; int p = __builtin_amdgcn_cvt_pk_fp8_f32(s[0 * 33] * wmul, s[1 * 33] * wmul, 0, false); p = __builtin_amdgcn_cvt_pk_fp8_f32(s[2 * 33] * wmul, s[3 * 33] * wmul, p, true); o8.x = (unsigned)p;
            p = __builtin_amdgcn_cvt_pk_fp8_f32(s[4 * 33] * wmul, s[5 * 33] * wmul, 0, false); p = __builtin_amdgcn_cvt_pk_fp8_f32(s[6 * 33] * wmul, s[7 * 33] * wmul, p, true); o8.y = (unsigned)p;
            *(v2u*)((unsigned char*)WT + (size_t)drow * K + k0 + 8 * c) = o8; }
        else *(v4u*)(WT + (size_t)drow * K + k0 + 8 * c) = o; }
    asm volatile("s_waitcnt lgkmcnt(0)" ::: "memory");
}
constexpr float Y8_SCALE = 16.0f;
typedef float f32x2 __attribute__((ext_vector_type(2)));
constexpr int NPROJ16 = 5120;
constexpr float W8_SCALE = 64.0f;
struct ConvArgs { const float *w_in, *w_out, *w_gate, *w_up, *w_down, *norm_mix_g, *norm_ffn_g; unsigned char* ws; };
constexpr int CI_IN = 32 * 192, CI_OUT = 32 * 64, CI_G = 16 * 32 * 32, CI_D = 16 * 16 * 64, CI_LAYER = CI_IN + CI_OUT + 2 * CI_G + CI_D;
__device__ __forceinline__ void convert_item(const ConvArgs& a, int it, LAS float* scr, int lane) {
    const int l = it / CI_LAYER; int r = it % CI_LAYER;
    if (r < CI_IN) { const int kb = r / 192, nb = r % 192;
        if (32 * nb < NPROJ16) transpose_item(a.w_in + (size_t)l * D * NIN, NIN, a.norm_mix_g + l * D, (bf16*)(a.ws + WS_WIN) + (size_t)l * NPROJ * D, D, 64 * kb, 32 * nb, 0, scr, lane);
        else transpose_item(a.w_in + (size_t)l * D * NIN + NPROJ16, NIN, a.norm_mix_g + l * D, (bf16*)(a.ws + WS_WIN + ((size_t)l * NPROJ + NPROJ16) * D * 2), D, 64 * kb, 32 * nb - NPROJ16, 0, scr, lane, true, W8_SCALE);
        return; }
    r -= CI_IN;
    if (r < CI_OUT) { const int kb = r / 64, nb = r % 64;
        transpose_item(a.w_out + (size_t)l * D * D, D, nullptr, (bf16*)(a.ws + WS_WOUT) + (size_t)l * D * D, D, 64 * kb, 32 * nb, 0, scr, lane); return; }
    r -= CI_OUT;
    if (r < 2 * CI_G) { const int up = r >= CI_G; if (up) r -= CI_G; const int e = r / 1024, q = r % 1024, kb = q / 32, nb = q % 32;
        transpose_item((up ? a.w_up : a.w_gate) + ((size_t)l * NE + e) * D * DE, DE, a.norm_ffn_g + l * D, (bf16*)(a.ws + WS_WGU + ((size_t)l * NE + e) * 2048 * D), D, 64 * kb, 32 * nb, up ? 2 : 1, scr, lane, true, W8_SCALE); return; }
    r -= 2 * CI_G;
    { const int e = r / 1024, q = r % 1024, kb = q / 64, nb = q % 64;
        transpose_item(a.w_down + ((size_t)l * NE + e) * DE * D, D, nullptr, (bf16*)(a.ws + WS_WD + ((size_t)l * NE + e) * D * DE), DE, 64 * kb, 32 * nb, 0, scr, lane, true, W8_SCALE); }
}

#define XB_TMO      128
#define XB_XCNT(j)  (256  + 64 * (j))
#define XB_XSUB(j)  (1280 + 64 * (j))
#define XB_XGEN(j)  (2304 + 64 * (j))
#define XB_TOP      3328
#define XB_TOPGEN   3392
#define XCD_BAR_WORDS 3456
#define XB_SPIN_CAP (1u << 18)

__device__ __forceinline__ unsigned xb_ld(unsigned* p)              { return __hip_atomic_load(p, __ATOMIC_RELAXED, __HIP_MEMORY_SCOPE_AGENT); }
__device__ __forceinline__ unsigned xb_add(unsigned* p, unsigned v) { return __hip_atomic_fetch_add(p, v, __ATOMIC_RELAXED, __HIP_MEMORY_SCOPE_AGENT); }
__device__ __forceinline__ unsigned xb_xcc_id() { return (unsigned)__builtin_amdgcn_s_getreg((3 << 11) | 20) & 0xFu; }
#define XB_SPIN(cond, bar) do { unsigned _sp = 0; while (cond) { __builtin_amdgcn_s_sleep(1); \
    if ((++_sp & 255u) == 0u) { if (xb_ld(&(bar)[XB_TMO])) break; if (_sp > XB_SPIN_CAP) { atomicAdd(&(bar)[XB_TMO], 1u); break; } } } } while (0)

struct XcdBarrier {
    unsigned* bar; unsigned x;
    volatile LAS unsigned* st;
};

__device__ __forceinline__ XcdBarrier xcd_barrier_post(unsigned* bar, volatile LAS unsigned* st) {
    XcdBarrier b; b.bar = bar; b.x = xb_xcc_id(); b.st = st;
    if (threadIdx.x == 0) (void)xb_add(&bar[XB_XCNT(b.x)], 1u);
    return b;
}
__device__ __forceinline__ void xcd_barrier_complete(unsigned* bar, unsigned x, unsigned& nloc, unsigned& nx) {
    const unsigned G = gridDim.x * gridDim.y * gridDim.z;
    unsigned sum, cnt, mine, sp = 0u;
    for (;;) {
        sum = 0u; cnt = 0u; mine = 0u;
#pragma unroll
        for (unsigned j = 0; j < 16; ++j) { const unsigned c = xb_ld(&bar[XB_XCNT(j)]); sum += c; cnt += (c > 0u) ? 1u : 0u; mine = (j == x) ? c : mine; }
        if (sum == G) break;
        __builtin_amdgcn_s_sleep(1);
        if ((++sp & 255u) == 0u) { if (xb_ld(&bar[XB_TMO])) break; if (sp > XB_SPIN_CAP) { atomicAdd(&bar[XB_TMO], 1u); break; } }
    }
    nloc = mine > 0u ? mine : 1u; nx = cnt > 0u ? cnt : 1u;
}

__device__ __forceinline__ void xcd_barrier(const XcdBarrier& b) {
    asm volatile("s_waitcnt vmcnt(0)" ::: "memory");
    __syncthreads();
    if (threadIdx.x == 0) {
        unsigned* bar = b.bar;
        __builtin_amdgcn_s_waitcnt(0);
        unsigned nloc = b.st[0], nx = b.st[1];
        if (nloc == 0u) { xcd_barrier_complete(bar, b.x, nloc, nx); b.st[0] = nloc; b.st[1] = nx; }
        const unsigned old = xb_add(&bar[XB_XSUB(b.x)], 1u);
        const unsigned gen = old / nloc;
        if (old + 1u == (gen + 1u) * nloc) {
            __builtin_amdgcn_fence(__ATOMIC_RELEASE, "agent");
            asm volatile("s_waitcnt vmcnt(0)" ::: "memory");
            const unsigned og = xb_add(&bar[XB_TOP], 1u);
            const unsigned tg = og / nx;
            if (og + 1u == (tg + 1u) * nx) xb_add(&bar[XB_TOPGEN], 1u);
            else XB_SPIN(xb_ld(&bar[XB_TOPGEN]) == tg, bar);
            __builtin_amdgcn_fence(__ATOMIC_ACQUIRE, "agent");
            xb_add(&bar[XB_XGEN(b.x)], 1u);
            asm volatile("s_waitcnt vmcnt(0)" ::: "memory");
        } else {
            XB_SPIN(xb_ld(&bar[XB_XGEN(b.x)]) == gen, bar);
            __builtin_amdgcn_fence(__ATOMIC_ACQUIRE, "agent");
            asm volatile("s_waitcnt vmcnt(0)" ::: "memory");
        }
    }
    __syncthreads();
}

struct RowArgs { const float* src32; const bf16* srcb; const int* sel; const unsigned char* Y; bf16* XB; unsigned char* XB8; float* RSTD; const float* g; const bf16* W16F; const float* bias; float* GATES; float* AFF; float* out; int mode; int wrxb; };
__device__ __forceinline__ void rowpass_finish(const RowArgs& a, int row, int rr, int s0, int s1, f32x4 (&v)[8], int lane) {
    const int b = row / SEQ;
    if (a.sel) {
        const int sw = rr < 4 ? s0 : s1;
        for (int e = 0; e < NE; ++e) { const int c = __builtin_amdgcn_readlane(sw, ((rr & 3) << 4) + e);
            if (c >= 0) { const unsigned char* y = a.Y + (size_t)(e * 2048 + b * 512 + c) * D + 4 * lane;
#pragma unroll
                for (int j = 0; j < 8; ++j) { const int w = *(const int*)(y + 256 * j); const f32x2 lo = __builtin_amdgcn_cvt_pk_f32_fp8(w, false), hi = __builtin_amdgcn_cvt_pk_f32_fp8(w, true);
                    v[j][0] += lo[0] * (1.0f / Y8_SCALE); v[j][1] += lo[1] * (1.0f / Y8_SCALE); v[j][2] += hi[0] * (1.0f / Y8_SCALE); v[j][3] += hi[1] * (1.0f / Y8_SCALE); } } }
    }
    float ss = 0.f;
#pragma unroll
    for (int j = 0; j < 8; ++j) ss += (v[j][0] * v[j][0] + v[j][1] * v[j][1]) + (v[j][2] * v[j][2] + v[j][3] * v[j][3]);
    ss = wave_sum(ss);
    const float rstd = 1.0f / sqrtf(ss * (1.0f / D) + EPS);
    if (a.mode == 2) {
#pragma unroll
        for (int j = 0; j < 8; ++j) { const f32x4 g = *(const f32x4*)(a.g + 4 * lane + 256 * j); *(f32x4*)(a.out + (size_t)row * D + 4 * lane + 256 * j) = v[j] * rstd * g; }
        return;
    }
    if (a.wrxb) {
#pragma unroll
        for (int j = 0; j < 8; ++j) { v2u w; w.x = pk2(v[j][0], v[j][1]); w.y = pk2(v[j][2], v[j][3]); *(v2u*)(a.XB + (size_t)row * D + 4 * lane + 256 * j) = w; } }
    if (a.XB8) {
#pragma unroll
        for (int j = 0; j < 8; ++j) *(unsigned*)(a.XB8 + (size_t)row * D + 4 * lane + 256 * j) = pg8::pk4_fp8(v[j][0], v[j][1], v[j][2], v[j][3]); }
    if (lane == 0) a.RSTD[row] = rstd;
}
template <bool SRC32> __device__ __forceinline__ void rowpass_group(const RowArgs& a, int grp, int lane_) {
    int lane = lane_; asm volatile("" : "+v"(lane));
    int s0 = -1, s1 = -1; if (a.sel) { s0 = a.sel[grp * 128 + lane]; s1 = a.sel[grp * 128 + 64 + lane]; }
    f32x4 v[8];
    if constexpr (SRC32) {
        f32x4 vn[8];
#pragma unroll
        for (int j = 0; j < 8; ++j) v[j] = *(const f32x4*)(a.src32 + (size_t)(8 * grp) * D + 4 * lane + 256 * j);
#pragma unroll 1
        for (int rr = 0; rr < 8; ++rr) { const int row = 8 * grp + rr;
            if (rr < 7) {
#pragma unroll
                for (int j = 0; j < 8; ++j) vn[j] = *(const f32x4*)(a.src32 + (size_t)(row + 1) * D + 4 * lane + 256 * j); }
            rowpass_finish(a, row, rr, s0, s1, v, lane);
#pragma unroll
            for (int j = 0; j < 8; ++j) v[j] = vn[j]; }
    } else {
        v2u w[8], wn[8];
#pragma unroll
        for (int j = 0; j < 8; ++j) w[j] = *(const v2u*)(a.srcb + (size_t)(8 * grp) * D + 4 * lane + 256 * j);
#pragma unroll 1
        for (int rr = 0; rr < 8; ++rr) { const int row = 8 * grp + rr;
            if (rr < 7) {
#pragma unroll
                for (int j = 0; j < 8; ++j) wn[j] = *(const v2u*)(a.srcb + (size_t)(row + 1) * D + 4 * lane + 256 * j); }
#pragma unroll
            for (int j = 0; j < 8; ++j) v[j] = (f32x4){bflo(w[j].x), bfhi(w[j].x), bflo(w[j].y), bfhi(w[j].y)};
            rowpass_finish(a, row, rr, s0, s1, v, lane);
#pragma unroll
            for (int j = 0; j < 8; ++j) w[j] = wn[j]; }
    }
    if (a.mode == 2) return;
    asm volatile("s_waitcnt vmcnt(0)" ::: "memory");
    const int g = lane >> 4, lc = lane & 15;
    f32x4 acc = (f32x4){0.f, 0.f, 0.f, 0.f};
    const bf16* xr = a.XB + (size_t)(8 * grp + (lc & 7)) * D + 8 * g; const bf16* wf = a.W16F + lane * 8;
#pragma unroll 8
    for (int s = 0; s < 64; ++s) { bf16x8v af = *(const bf16x8v*)(xr + 32 * s); if (lc >= 8) af = (bf16x8v){0, 0, 0, 0, 0, 0, 0, 0};
        const bf16x8v bf = *(const bf16x8v*)(wf + s * 512); acc = __builtin_amdgcn_mfma_f32_16x16x32_bf16(af, bf, acc, 0, 0, 0); }
    float rs[4];
#pragma unroll
    for (int r = 0; r < 4; ++r) rs[r] = a.RSTD[8 * grp + 4 * (g & 1) + r];
    if (a.mode == 0) { const float bs = a.bias[lc];
#pragma unroll
        for (int r = 0; r < 4; ++r) { const float rstd = rs[r]; if (g < 2) a.GATES[(size_t)(8 * grp + 4 * g + r) * 16 + lc] = acc[r] * rstd + bs; } }
    else {
#pragma unroll
        for (int r = 0; r < 4; ++r) { const float rstd = rs[r]; const float lg = acc[r] * rstd; float mx = lg;
#pragma unroll
            for (int o = 1; o < 16; o <<= 1) mx = fmaxf(mx, __shfl_xor(mx, o));
            const float p = __expf(lg - mx); float sum = p;
#pragma unroll
            for (int o = 1; o < 16; o <<= 1) sum += __shfl_xor(sum, o);
            const int row = 8 * grp + 4 * g + r; if (g < 2) a.AFF[((size_t)(row / SEQ) * NE + lc) * SEQ + (row % SEQ)] = p / sum; } }
}
__device__ __forceinline__ void w16f_item(const float* W, int ldw, const float* gk, bf16* WF, int s, int lane) {
    const int g = lane >> 4, lc = lane & 15; float v[8];
#pragma unroll
    for (int i = 0; i < 8; ++i) { const int k = 32 * s + 8 * g + i; v[i] = W[(size_t)k * ldw + lc] * gk[k]; }
    v4u o; o.x = pk2(v[0], v[1]); o.y = pk2(v[2], v[3]); o.z = pk2(v[4], v[5]); o.w = pk2(v[6], v[7]);
    *(v4u*)(WF + (size_t)(s * 64 + lane) * 8) = o;
}

__device__ __forceinline__ void na_norm_item(const bf16* NAO, const float* g, bf16* MIX, int t, int lane) {
    f32x4 v[4]; float ss = 0.f;
#pragma unroll
    for (int j = 0; j < 4; ++j) { const v2u w = *(const v2u*)(NAO + (size_t)t * 1024 + 4 * lane + 256 * j); v[j] = (f32x4){bflo(w.x), bfhi(w.x), bflo(w.y), bfhi(w.y)}; ss += (v[j][0] * v[j][0] + v[j][1] * v[j][1]) + (v[j][2] * v[j][2] + v[j][3] * v[j][3]); }
    const float rstd = 1.0f / sqrtf(wave_sum(ss) * (1.0f / 1024.0f) + EPS);
#pragma unroll
    for (int j = 0; j < 4; ++j) { const f32x4 gg = *(const f32x4*)(g + 4 * lane + 256 * j); const f32x4 o = v[j] * rstd * gg; v2u w; w.x = pk2(o[0], o[1]); w.y = pk2(o[2], o[3]);
        *(v2u*)(MIX + (size_t)t * D + 4 * lane + 256 * j) = w; }
}

__device__ __forceinline__ int block_sum_512(int v, LAS int* red, int wave, int lane) {
#pragma unroll
    for (int o = 1; o < 64; o <<= 1) v += __shfl_xor(v, o);
    __syncthreads();
    if (lane == 0) red[wave] = v;
    __syncthreads();
    int s = 0;
#pragma unroll
    for (int w = 0; w < 8; ++w) s += red[w];
    return s;
}
__device__ __forceinline__ int block_excl_scan_512(int v, LAS int* red, int wave, int lane) {
    int inc = v;
#pragma unroll
    for (int o = 1; o < 64; o <<= 1) { const int t = __shfl_up(inc, o); if (lane >= o) inc += t; }
    __syncthreads();
    if (lane == 63) red[wave] = inc;
    __syncthreads();
    int base = 0;
#pragma unroll
    for (int w = 0; w < 8; ++w) base += (w < wave) ? red[w] : 0;
    return base + inc - v;
}
__device__ __forceinline__ void topk_unit(int be, const float* AFF, int* TOK, float* GATEV, int* SEL, LAS int* red) {
    int tid_ = threadIdx.x; asm volatile("" : "+v"(tid_)); const int tid = tid_, lane = tid & 63, wave = tid >> 6;
    const int b = be >> 4, e = be & 15;
    const float* a = AFF + (size_t)be * SEQ + tid * 8;
    const f32x4 a0 = *(const f32x4*)a, a1 = *(const f32x4*)(a + 4);
    unsigned key[8] = {__float_as_uint(a0.x), __float_as_uint(a0.y), __float_as_uint(a0.z), __float_as_uint(a0.w),
                       __float_as_uint(a1.x), __float_as_uint(a1.y), __float_as_uint(a1.z), __float_as_uint(a1.w)};
    LAS int* hist = red + 16;
    unsigned T = 0u; int need = CAP;
#pragma unroll 1
    for (int pass = 0; pass < 4; ++pass) { const int shift = 24 - 8 * pass; const unsigned mhi = pass == 0 ? 0u : (0xFFFFFFFFu << (shift + 8));
        __syncthreads();
        if (tid < 256) hist[tid] = 0;
        __syncthreads();
#pragma unroll
        for (int i = 0; i < 8; ++i) if ((key[i] & mhi) == T) (void)__hip_atomic_fetch_add(&hist[(key[i] >> shift) & 255u], 1, __ATOMIC_RELAXED, __HIP_MEMORY_SCOPE_WORKGROUP);
        __syncthreads();
        if (wave == 0) { const int c0 = hist[4 * lane], c1 = hist[4 * lane + 1], c2 = hist[4 * lane + 2], c3 = hist[4 * lane + 3]; const int t = c0 + c1 + c2 + c3; int inc = t;
#pragma unroll
            for (int o = 1; o < 64; o <<= 1) { const int v = __shfl_down(inc, o); if (lane + o < 64) inc += v; }
            const int ab3 = inc - t, ab2 = ab3 + c3, ab1 = ab2 + c2, ab0 = ab1 + c1;
            if (ab3 < need && need <= ab3 + c3) { red[8] = 4 * lane + 3; red[9] = ab3; }
            if (ab2 < need && need <= ab2 + c2) { red[8] = 4 * lane + 2; red[9] = ab2; }
            if (ab1 < need && need <= ab1 + c1) { red[8] = 4 * lane + 1; red[9] = ab1; }
            if (ab0 < need && need <= ab0 + c0) { red[8] = 4 * lane + 0; red[9] = ab0; } }
        __syncthreads();
        T |= (unsigned)red[8] << shift; need -= red[9]; }
    int ceq = 0;
#pragma unroll
    for (int i = 0; i < 8; ++i) ceq += key[i] == T ? 1 : 0;
    const int need_eq = need;
    int eqrank = block_excl_scan_512(ceq, red, wave, lane);
    int selm = 0, csel = 0;
#pragma unroll
    for (int i = 0; i < 8; ++i) { bool sel = key[i] > T; if (key[i] == T) { sel = eqrank < need_eq; ++eqrank; } if (sel) { selm |= 1 << i; ++csel; } }
    int slot = block_excl_scan_512(csel, red, wave, lane);
#pragma unroll
    for (int i = 0; i < 8; ++i) { const int sidx = tid * 8 + i; const int tok = b * SEQ + sidx;
        if (selm & (1 << i)) { const int R = e * 2048 + b * 512 + slot; TOK[R] = tok; GATEV[R] = __uint_as_float(key[i]); SEL[tok * 16 + e] = slot; ++slot; }
        else SEL[tok * 16 + e] = -1; }
    __syncthreads();
}

typedef short bf16x8v __attribute__((ext_vector_type(8)));
typedef short s16x4 __attribute__((ext_vector_type(4)));
constexpr int ML_L = 128, ML_NC = SEQ / ML_L;
constexpr int KP = 272, VP = 528;
constexpr int ML_T0 = 0, ML_T1 = 128 * KP, ML_V = 2 * 128 * KP;
constexpr int ML_AR = ML_V + 128 * VP;
constexpr int ML_END = ML_AR + 24 * 512;
static_assert(ML_AR % 16 == 0, "LDS map");
constexpr size_t WS_UC = WS_HF;
constexpr size_t WS_NU = 6 * MiB;
constexpr size_t WS_SC = 7 * MiB;

__device__ __forceinline__ s16x4 lds_tr(LAS unsigned char* p) { return __builtin_amdgcn_ds_read_tr16_b64_v4i16((LAS s16x4*)p); }
__device__ __forceinline__ bf16x8v frag_tr(LAS unsigned char* tile, int pitch, int k0, int n0, int lane) {
    const int g = lane >> 4, q = (lane & 15) >> 2, p = lane & 3;
    LAS unsigned char* a = tile + (k0 + 8 * g + q) * pitch + (n0 + 4 * p) * 2;
    const s16x4 lo = lds_tr(a), hi = lds_tr(a + 4 * pitch);
    return (bf16x8v){lo[0], lo[1], lo[2], lo[3], hi[0], hi[1], hi[2], hi[3]};
}
__device__ __forceinline__ bf16x8v frag_row(LAS unsigned char* tile, int pitch, int m0, int k0, int lane) {
    return *(LAS bf16x8v*)(tile + (m0 + (lane & 15)) * pitch + (k0 + 8 * (lane >> 4)) * 2);
}
__device__ __forceinline__ float log_sigmoid_f(float f) { return fminf(f, 0.f) - log1pf(__expf(-fabsf(f))); }
__device__ __forceinline__ float shfl_up_f(float v, int o, int lane, float ident) { const float t = __shfl_up(v, o); return lane >= o ? t : ident; }

__device__ __forceinline__ void chunk_gates(const float* GATES, int t0, int h, int dir, int lane, int& s0, int& s1, float& i0, float& i1, float& b0, float& b1, float& btot) {
    const int p0 = 2 * lane, p1 = p0 + 1; s0 = dir ? 127 - p0 : p0; s1 = dir ? 127 - p1 : p1;
    const int icol = dir * 8 + h, fcol = icol + 4;
    const float* gp = GATES + (size_t)t0 * 16;
    const float f0 = log_sigmoid_f(gp[s0 * 16 + fcol]), f1 = log_sigmoid_f(gp[s1 * 16 + fcol]);
    i0 = gp[s0 * 16 + icol]; i1 = gp[s1 * 16 + icol];
    const float s = f0 + f1; float inc = s;
#pragma unroll
    for (int o = 1; o < 64; o <<= 1) inc += shfl_up_f(inc, o, lane, 0.f);
    const float excl = inc - s; b0 = excl + f0; b1 = excl + s; btot = __shfl(inc, 63);
}


__device__ __forceinline__ void conv_chunk4(const bf16* P, const float* cw, const float* cb, int b, int sq0, int chan0, float (&o)[4][8]) {
    const bf16* pc = P + ((size_t)b * SEQ + sq0) * NPROJ + C_MLQ + chan0;
    v4u w[8];
#pragma unroll
    for (int j = 0; j < 8; ++j) { const int ss = sq0 + j - 2; w[j] = (ss >= 0 && ss < SEQ) ? *(const v4u*)(pc + (ptrdiff_t)(j - 2) * NPROJ) : (v4u){0u, 0u, 0u, 0u}; }
    const f32x4 b0 = *(const f32x4*)(cb + chan0), b1 = *(const f32x4*)(cb + chan0 + 4);
#pragma unroll
    for (int t = 0; t < 4; ++t) { o[t][0] = b0[0]; o[t][1] = b0[1]; o[t][2] = b0[2]; o[t][3] = b0[3]; o[t][4] = b1[0]; o[t][5] = b1[1]; o[t][6] = b1[2]; o[t][7] = b1[3]; }
#pragma unroll
    for (int j = 0; j < 5; ++j) { const f32x4 c0 = *(const f32x4*)(cw + j * 1024 + chan0), c1 = *(const f32x4*)(cw + j * 1024 + chan0 + 4);
#pragma unroll
        for (int t = 0; t < 4; ++t) { const v4u x = w[t + j];
            o[t][0] += c0[0] * bflo(x.x); o[t][1] += c0[1] * bfhi(x.x); o[t][2] += c0[2] * bflo(x.y); o[t][3] += c0[3] * bfhi(x.y);
            o[t][4] += c1[0] * bflo(x.z); o[t][5] += c1[1] * bfhi(x.z); o[t][6] += c1[2] * bflo(x.w); o[t][7] += c1[3] * bfhi(x.w); } }
#pragma unroll
    for (int t = 0; t < 4; ++t)
#pragma unroll
        for (int i = 0; i < 8; ++i) o[t][i] = o[t][i] / (1.0f + __expf(-o[t][i]));
}

__device__ __forceinline__ void mlstm_m1_unit(int u, const float* cw, const float* cb, const bf16* P, const float* GATES, bf16* UC, float* NU, float* SC, LAS unsigned char* lds, int tid_, int wave) {
    int tid = tid_; asm volatile("" : "+v"(tid)); const int lane = tid & 63;
    const int c = u & 31, h = (u >> 5) & 3, b = u >> 7; const int t0 = b * SEQ + c * ML_L;
    LAS float* WK = (LAS float*)(lds + ML_AR);
    LAS float* NRED = WK + 256;
    __syncthreads();
    if (wave < 2) { const int dir = wave; int s0, s1; float i0, i1, b0, b1, btot;
        chunk_gates(GATES, t0, h, dir, lane, s0, s1, i0, i1, b0, b1, btot);
        const float g0 = btot - b0 + i0, g1 = btot - b1 + i1; const float mloc = wave_max(fmaxf(g0, g1));
        WK[dir * 128 + s0] = __expf(g0 - mloc); WK[dir * 128 + s1] = __expf(g1 - mloc);
        if (lane == 0) { float* sc = SC + (size_t)((((b * 4 + h) * 2 + dir) * 32) + c) * 4; sc[0] = btot; sc[1] = mloc; } }
#pragma unroll
    for (int i = 0; i < 8; ++i) { const int id = tid + 512 * i, s = id >> 5, ch = id & 31;
        *(LAS v4u*)(lds + ML_V + s * VP + ch * 16) = *(const v4u*)(P + (size_t)(t0 + s) * NPROJ + C_MLV + h * 256 + ch * 8); }
    float k4[4][8]; conv_chunk4(P, cw, cb, b, c * ML_L + 4 * (tid >> 4), 512 + h * 128 + (tid & 15) * 8, k4);
    __syncthreads();
    { float nf[8], nb[8];
#pragma unroll
      for (int j = 0; j < 8; ++j) { nf[j] = 0.f; nb[j] = 0.f; }
#pragma unroll
      for (int i = 0; i < 4; ++i) { const int s = 4 * (tid >> 4) + i, ch = tid & 15; const float (&k)[8] = k4[i];
        const float wf = WK[s], wb = WK[128 + s];
        v4u of, ob; of.x = pk2(k[0] * wf, k[1] * wf); of.y = pk2(k[2] * wf, k[3] * wf); of.z = pk2(k[4] * wf, k[5] * wf); of.w = pk2(k[6] * wf, k[7] * wf);
        ob.x = pk2(k[0] * wb, k[1] * wb); ob.y = pk2(k[2] * wb, k[3] * wb); ob.z = pk2(k[4] * wb, k[5] * wb); ob.w = pk2(k[6] * wb, k[7] * wb);
        *(LAS v4u*)(lds + ML_T0 + s * KP + ch * 16) = of; *(LAS v4u*)(lds + ML_T1 + s * KP + ch * 16) = ob;
#pragma unroll
        for (int j = 0; j < 8; ++j) { nf[j] += k[j] * wf; nb[j] += k[j] * wb; } }
#pragma unroll
      for (int j = 0; j < 8; ++j) { nf[j] += __shfl_xor(nf[j], 16); nf[j] += __shfl_xor(nf[j], 32); nb[j] += __shfl_xor(nb[j], 16); nb[j] += __shfl_xor(nb[j], 32); }
      if ((lane >> 4) == 0) {
#pragma unroll
          for (int j = 0; j < 8; ++j) { NRED[wave * 256 + (lane & 15) * 8 + j] = nf[j]; NRED[wave * 256 + 128 + (lane & 15) * 8 + j] = nb[j]; } } }
    __syncthreads();
    if (tid < 256) { const int dir = tid >> 7, d = tid & 127; float sum = 0.f;
#pragma unroll
        for (int w = 0; w < 8; ++w) sum += NRED[w * 256 + tid];
        NU[(size_t)((((b * 4 + h) * 2 + dir) * 32) + c) * 128 + d] = sum; }
    const int g = lane >> 4;
#pragma unroll 1
    for (int dir = 0; dir < 2; ++dir) {
        LAS unsigned char* Kt = lds + (dir ? ML_T1 : ML_T0);
        f32x4 acc[8][2];
#pragma unroll
        for (int mb = 0; mb < 8; ++mb) { acc[mb][0] = (f32x4){0.f, 0.f, 0.f, 0.f}; acc[mb][1] = (f32x4){0.f, 0.f, 0.f, 0.f}; }
#pragma unroll
        for (int ks = 0; ks < 4; ++ks) {
            const bf16x8v b0 = frag_tr(lds + ML_V, VP, 32 * ks, 32 * wave, lane), b1 = frag_tr(lds + ML_V, VP, 32 * ks, 32 * wave + 16, lane);
#pragma unroll
            for (int mb = 0; mb < 8; ++mb) { const bf16x8v a = frag_tr(Kt, KP, 32 * ks, 16 * mb, lane);
                acc[mb][0] = __builtin_amdgcn_mfma_f32_16x16x32_bf16(a, b0, acc[mb][0], 0, 0, 0); acc[mb][1] = __builtin_amdgcn_mfma_f32_16x16x32_bf16(a, b1, acc[mb][1], 0, 0, 0); } }
        bf16* uc = UC + (size_t)((((b * 4 + h) * 2 + dir) * 32) + c) * 32768;
#pragma unroll
        for (int mb = 0; mb < 8; ++mb)
#pragma unroll
            for (int nb = 0; nb < 2; ++nb) { const int e = 32 * wave + 16 * nb + (lane & 15), d0 = 16 * mb + 4 * g; v2u w; w.x = pk2(acc[mb][nb][0], acc[mb][nb][1]); w.y = pk2(acc[mb][nb][2], acc[mb][nb][3]);
                *(v2u*)(uc + e * 128 + d0) = w; }
    }
}

__device__ __forceinline__ void mlstm_m2(bf16* UC, float* NU, float* SC, int gtid, int nthreads) {
    for (int vid = gtid; vid < 32 * 4096; vid += nthreads) { const int chain = vid >> 12, within = vid & 4095, dir = chain & 1;
        float st[8]; float m = 0.f;
#pragma unroll
        for (int i = 0; i < 8; ++i) st[i] = 0.f;
#pragma unroll 4
        for (int step = 0; step < ML_NC; ++step) { const int c = dir ? ML_NC - 1 - step : step;
            float* sc = SC + (size_t)(chain * 32 + c) * 4; const float btot = sc[0], mloc = sc[1];
            v4u* p = (v4u*)(UC + ((size_t)(chain * 32 + c) * 4096 + within) * 8);
            const v4u uw = *p;
            v4u cw; cw.x = pk2(st[0], st[1]); cw.y = pk2(st[2], st[3]); cw.z = pk2(st[4], st[5]); cw.w = pk2(st[6], st[7]);
            *p = cw;
            if (within == 0) sc[2] = m;
            const float mn = fmaxf(btot + m, mloc), dC = __expf(btot + m - mn), dU = __expf(mloc - mn);
            const float uu[8] = {bflo(uw.x), bfhi(uw.x), bflo(uw.y), bfhi(uw.y), bflo(uw.z), bfhi(uw.z), bflo(uw.w), bfhi(uw.w)};
#pragma unroll
            for (int i = 0; i < 8; ++i) st[i] = dC * st[i] + dU * uu[i];
            m = mn; } }
    for (int nid = gtid; nid < 32 * 128; nid += nthreads) { const int chain = nid >> 7, d = nid & 127, dir = chain & 1; float st = 0.f, m = 0.f;
        for (int step = 0; step < ML_NC; ++step) { const int c = dir ? ML_NC - 1 - step : step;
            const float* sc = SC + (size_t)(chain * 32 + c) * 4; const float btot = sc[0], mloc = sc[1];
            float* p = NU + (size_t)(chain * 32 + c) * 128 + d; const float uu = *p; *p = st;
            const float mn = fmaxf(btot + m, mloc); st = __expf(btot + m - mn) * st + __expf(mloc - mn) * uu; m = mn; } }
}

__device__ __forceinline__ void mlstm_m3_unit(int u, const float* cw, const float* cb, const bf16* P, const float* GATES, const bf16* UC, const float* NU, const float* SC, const float* mlg, bf16* MIX, LAS unsigned char* lds, int tid_, int wave) {
    int tid = tid_; asm volatile("" : "+v"(tid)); const int lane = tid & 63;
    const int c = u & 31, h = (u >> 5) & 3, b = u >> 7; const int t0 = b * SEQ + c * ML_L;
    LAS float* AR = (LAS float*)(lds + ML_AR);
    LAS float* CS = AR; LAS float* RR = AR + 256; LAS float* INTER = AR + 512; LAS float* EM = AR + 768; LAS float* ALPHA = AR + 1024; LAS float* SS = AR + 1280;
    const int g = lane >> 4, lc = lane & 15;
    const int chain0 = (b * 4 + h) * 2;
    __syncthreads();
    if (wave < 2) { const int dir = wave; int s0, s1; float i0, i1, b0, b1, btot;
        chunk_gates(GATES, t0, h, dir, lane, s0, s1, i0, i1, b0, b1, btot);
        const float cs0 = i0 - b0, cs1 = i1 - b1;
        float pmx = fmaxf(cs0, cs1);
#pragma unroll
        for (int o = 1; o < 64; o <<= 1) pmx = fmaxf(pmx, shfl_up_f(pmx, o, lane, -3.0e38f));
        const float ex = shfl_up_f(pmx, 1, lane, -3.0e38f);
        const float pm0 = fmaxf(ex, cs0), pm1 = fmaxf(pm0, cs1);
        const float m_in = SC[(size_t)((chain0 + dir) * 32 + c) * 4 + 2];
        const float M0 = b0 + fmaxf(m_in, pm0), M1 = b1 + fmaxf(m_in, pm1);
        CS[dir * 128 + s0] = cs0; CS[dir * 128 + s1] = cs1; RR[dir * 128 + s0] = b0 - M0; RR[dir * 128 + s1] = b1 - M1;
        INTER[dir * 128 + s0] = __expf(b0 + m_in - M0); INTER[dir * 128 + s1] = __expf(b1 + m_in - M1); EM[dir * 128 + s0] = __expf(-M0); EM[dir * 128 + s1] = __expf(-M1); }
    { const int s0 = 4 * (tid >> 4), ch = tid & 15; float x4[4][8];
      conv_chunk4(P, cw, cb, b, c * ML_L + s0, h * 128 + ch * 8, x4);
      const float qs = 0.08838834764831845f;
#pragma unroll
      for (int i = 0; i < 4; ++i) { v4u oq; oq.x = pk2(x4[i][0] * qs, x4[i][1] * qs); oq.y = pk2(x4[i][2] * qs, x4[i][3] * qs); oq.z = pk2(x4[i][4] * qs, x4[i][5] * qs); oq.w = pk2(x4[i][6] * qs, x4[i][7] * qs);
          *(LAS v4u*)(lds + ML_T0 + (s0 + i) * KP + ch * 16) = oq; }
      conv_chunk4(P, cw, cb, b, c * ML_L + s0, 512 + h * 128 + ch * 8, x4);
#pragma unroll
      for (int i = 0; i < 4; ++i) { v4u ok; ok.x = pk2(x4[i][0], x4[i][1]); ok.y = pk2(x4[i][2], x4[i][3]); ok.z = pk2(x4[i][4], x4[i][5]); ok.w = pk2(x4[i][6], x4[i][7]);
          *(LAS v4u*)(lds + ML_T1 + (s0 + i) * KP + ch * 16) = ok; } }
#pragma unroll
    for (int i = 0; i < 8; ++i) { const int id = tid + 512 * i, s = id >> 5, ch = id & 31;
        *(LAS v4u*)(lds + ML_V + s * VP + ch * 16) = *(const v4u*)(P + (size_t)(t0 + s) * NPROJ + C_MLV + h * 256 + ch * 8); }
    __syncthreads();
    f32x4 S[8], qn = (f32x4){0.f, 0.f, 0.f, 0.f};
#pragma unroll
    for (int nb = 0; nb < 8; ++nb) S[nb] = (f32x4){0.f, 0.f, 0.f, 0.f};
#pragma unroll
    for (int ks = 0; ks < 4; ++ks) { const bf16x8v a = frag_row(lds + ML_T0, KP, 16 * wave, 32 * ks, lane);
        bf16x8v nf = (bf16x8v){0, 0, 0, 0, 0, 0, 0, 0};
        if (lc < 2) { const float* np = NU + (size_t)((chain0 + lc) * 32 + c) * 128 + 32 * ks + 8 * g; const f32x4 n0 = *(const f32x4*)np, n1 = *(const f32x4*)(np + 4);
            const unsigned w0 = pk2(n0[0], n0[1]), w1 = pk2(n0[2], n0[3]), w2 = pk2(n1[0], n1[1]), w3 = pk2(n1[2], n1[3]);
            nf = (bf16x8v){(short)(w0 & 0xffff), (short)(w0 >> 16), (short)(w1 & 0xffff), (short)(w1 >> 16), (short)(w2 & 0xffff), (short)(w2 >> 16), (short)(w3 & 0xffff), (short)(w3 >> 16)}; }
        qn = __builtin_amdgcn_mfma_f32_16x16x32_bf16(a, nf, qn, 0, 0, 0);
#pragma unroll
        for (int nb = 0; nb < 8; ++nb) { const bf16x8v kb = frag_row(lds + ML_T1, KP, 16 * nb, 32 * ks, lane); S[nb] = __builtin_amdgcn_mfma_f32_16x16x32_bf16(a, kb, S[nb], 0, 0, 0); } }
    float csf[8], csb[8];
#pragma unroll
    for (int nb = 0; nb < 8; ++nb) { csf[nb] = CS[16 * nb + lc]; csb[nb] = CS[128 + 16 * nb + lc]; }
    float pc[8][4];
#pragma unroll
    for (int r = 0; r < 4; ++r) { const int j = 16 * wave + 4 * g + r; const float Rf = RR[j], Rb = RR[128 + j];
        const float qnf = __shfl(qn[r], 16 * g), qnb = __shfl(qn[r], 16 * g + 1);
        float sf[8], sb[8], rsf = 0.f, rsb = 0.f;
#pragma unroll
        for (int nb = 0; nb < 8; ++nb) { const int s = 16 * nb + lc; const float wf = s <= j ? __expf(Rf + csf[nb]) : 0.f, wb = s >= j ? __expf(Rb + csb[nb]) : 0.f;
            sf[nb] = S[nb][r] * wf; sb[nb] = S[nb][r] * wb; rsf += sf[nb]; rsb += sb[nb]; }
#pragma unroll
        for (int o = 1; o < 16; o <<= 1) { rsf += __shfl_xor(rsf, o); rsb += __shfl_xor(rsb, o); }
        const float inf_ = INTER[j], inb_ = INTER[128 + j];
        const float ivf = 1.0f / fmaxf(fabsf(inf_ * qnf + rsf), EM[j]), ivb = 1.0f / fmaxf(fabsf(inb_ * qnb + rsb), EM[128 + j]);
#pragma unroll
        for (int nb = 0; nb < 8; ++nb) pc[nb][r] = sf[nb] * ivf + sb[nb] * ivb;
        if (lc == 0) { ALPHA[j] = inf_ * ivf; ALPHA[128 + j] = inb_ * ivb; } }
    __syncthreads();
#pragma unroll
    for (int r = 0; r < 4; ++r) { const int j = 16 * wave + 4 * g + r;
#pragma unroll
        for (int nb = 0; nb < 8; ++nb) *(LAS unsigned short*)(lds + ML_T1 + j * KP + (16 * nb + lc) * 2) = (unsigned short)f2bf(pc[nb][r]); }
    __syncthreads();
    f32x4 acc[2][8], acc2[2][8];
#pragma unroll
    for (int mb = 0; mb < 2; ++mb)
#pragma unroll
        for (int nb = 0; nb < 8; ++nb) { acc[mb][nb] = (f32x4){0.f, 0.f, 0.f, 0.f}; acc2[mb][nb] = (f32x4){0.f, 0.f, 0.f, 0.f}; }
    const bf16* ucf = UC + (size_t)((chain0 + 0) * 32 + c) * 32768 + (size_t)(32 * wave + lc) * 128 + 8 * g;
    const bf16* ucb = UC + (size_t)((chain0 + 1) * 32 + c) * 32768 + (size_t)(32 * wave + lc) * 128 + 8 * g;
#pragma unroll
    for (int ks = 0; ks < 4; ++ks) {
        const bf16x8v af0 = *(const bf16x8v*)(ucf + 32 * ks), af1 = *(const bf16x8v*)(ucf + 16 * 128 + 32 * ks), ab0 = *(const bf16x8v*)(ucb + 32 * ks), ab1 = *(const bf16x8v*)(ucb + 16 * 128 + 32 * ks);
#pragma unroll
        for (int nb = 0; nb < 8; ++nb) { const bf16x8v qb = frag_row(lds + ML_T0, KP, 16 * nb, 32 * ks, lane);
            acc[0][nb] = __builtin_amdgcn_mfma_f32_16x16x32_bf16(af0, qb, acc[0][nb], 0, 0, 0); acc[1][nb] = __builtin_amdgcn_mfma_f32_16x16x32_bf16(af1, qb, acc[1][nb], 0, 0, 0);
            acc2[0][nb] = __builtin_amdgcn_mfma_f32_16x16x32_bf16(ab0, qb, acc2[0][nb], 0, 0, 0); acc2[1][nb] = __builtin_amdgcn_mfma_f32_16x16x32_bf16(ab1, qb, acc2[1][nb], 0, 0, 0); } }
#pragma unroll
    for (int nb = 0; nb < 8; ++nb) { const float af = ALPHA[16 * nb + lc], ab = ALPHA[128 + 16 * nb + lc];
        acc[0][nb] = acc[0][nb] * af + acc2[0][nb] * ab; acc[1][nb] = acc[1][nb] * af + acc2[1][nb] * ab; }
#pragma unroll
    for (int ks = 0; ks < 4; ++ks) {
        const bf16x8v v0 = frag_tr(lds + ML_V, VP, 32 * ks, 32 * wave, lane), v1 = frag_tr(lds + ML_V, VP, 32 * ks, 32 * wave + 16, lane);
#pragma unroll
        for (int nb = 0; nb < 8; ++nb) { const bf16x8v pb = frag_row(lds + ML_T1, KP, 16 * nb, 32 * ks, lane);
            acc[0][nb] = __builtin_amdgcn_mfma_f32_16x16x32_bf16(v0, pb, acc[0][nb], 0, 0, 0); acc[1][nb] = __builtin_amdgcn_mfma_f32_16x16x32_bf16(v1, pb, acc[1][nb], 0, 0, 0); } }
#pragma unroll
    for (int nb = 0; nb < 8; ++nb) { float ss = 0.f;
#pragma unroll
        for (int mb = 0; mb < 2; ++mb) ss += (acc[mb][nb][0] * acc[mb][nb][0] + acc[mb][nb][1] * acc[mb][nb][1]) + (acc[mb][nb][2] * acc[mb][nb][2] + acc[mb][nb][3] * acc[mb][nb][3]);
        ss += __shfl_xor(ss, 16); ss += __shfl_xor(ss, 32);
        if (g == 0) SS[wave * 128 + 16 * nb + lc] = ss; }
    __syncthreads();
#pragma unroll
    for (int nb = 0; nb < 8; ++nb) { const int j = 16 * nb + lc; float tot = 0.f;
#pragma unroll
        for (int w = 0; w < 8; ++w) tot += SS[w * 128 + j];
        const float rstd = 1.0f / sqrtf(tot * (1.0f / 256.0f) + EPS);
#pragma unroll
        for (int mb = 0; mb < 2; ++mb) { const int e0 = 32 * wave + 16 * mb + 4 * g; const size_t t = (size_t)(t0 + j);
            const v2u ow = *(const v2u*)(P + t * NPROJ + C_MLO + h * 256 + e0); const f32x4 gg = *(const f32x4*)(mlg + h * 256 + e0);
            const float o[4] = {bflo(ow.x), bfhi(ow.x), bflo(ow.y), bfhi(ow.y)}; float rr[4];
#pragma unroll
            for (int r = 0; r < 4; ++r) rr[r] = acc[mb][nb][r] * rstd * gg[r] / (1.0f + __expf(-o[r]));
            v2u w; w.x = pk2(rr[0], rr[1]); w.y = pk2(rr[2], rr[3]);
            *(v2u*)(MIX + t * D + 1024 + h * 256 + e0) = w; } }
}


constexpr int NA_TILE = 64 * KP, NA_BUF = 2 * NA_TILE, NA_RPB = 2 * NA_BUF;
static_assert(NA_RPB + 15 * 128 * 4 <= ML_END, "LDS map");
__device__ __forceinline__ bf16x8v frag_tr2(LAS unsigned char* tile, int pitch, int row0, int row1, int n0, int lane) {
    const int q = (lane & 15) >> 2, p = lane & 3;
    const s16x4 lo = lds_tr(tile + (row0 + q) * pitch + (n0 + 4 * p) * 2), hi = lds_tr(tile + (row1 + q) * pitch + (n0 + 4 * p) * 2);
    return (bf16x8v){lo[0], lo[1], lo[2], lo[3], hi[0], hi[1], hi[2], hi[3]};
}
__device__ __forceinline__ void na_unit(int u, const bf16* P, const float* rpb, bf16* NAO, LAS unsigned char* lds, int tid_, int wave) {
    int tid = tid_; asm volatile("" : "+v"(tid)); const int lane = tid & 63, g = lane >> 4, lc = lane & 15;
    const int r4 = u & 15, h = (u >> 4) & 7, b = u >> 7;
    const int r0 = 4 * r4, r = r0 + (wave >> 1), qh = wave & 1;
    const int rs = min(max(r - 4, 0), 56), rs0 = min(max(r0 - 4, 0), 56), nk = min(max(r0 + 3 - 4, 0), 56) + 8 - rs0;
    LAS float* RPB = (LAS float*)(lds + NA_RPB);
    const int sA = tid >> 4, chA = tid & 15, sB = sA + 32;
    const bf16* gsrc = P + ((size_t)b * SEQ + rs0 * 64) * NPROJ + h * 128 + chA * 8;
    v4u pk0, pk1, pv0, pv1;
#define NA_LOAD(j) do { const bf16* s_ = gsrc + (size_t)(j) * 64 * NPROJ; pk0 = *(const v4u*)(s_ + (size_t)sA * NPROJ + C_NAK); pk1 = *(const v4u*)(s_ + (size_t)sB * NPROJ + C_NAK); \
        pv0 = *(const v4u*)(s_ + (size_t)sA * NPROJ + C_NAV); pv1 = *(const v4u*)(s_ + (size_t)sB * NPROJ + C_NAV); } while (0)
#define NA_STORE(buf) do { LAS unsigned char* t_ = lds + (buf) * NA_BUF; *(LAS v4u*)(t_ + sA * KP + chA * 16) = pk0; *(LAS v4u*)(t_ + sB * KP + chA * 16) = pk1; \
        *(LAS v4u*)(t_ + NA_TILE + sA * KP + chA * 16) = pv0; *(LAS v4u*)(t_ + NA_TILE + sB * KP + chA * 16) = pv1; } while (0)
    NA_LOAD(0);
    __syncthreads();
    for (int i = tid; i < 15 * 128; i += 512) { const int dr = i >> 7, x = (i & 127) - 48; RPB[i] = (x >= 0 && x < 31) ? rpb[h * 465 + dr * 31 + x] * 1.4426950408889634f : 0.f; }
    NA_STORE(0);
    bf16x8v qf[2][4]; int cq[2], cs[2], boff[2]; float m[2], l[2]; f32x4 O[2][8]; f32x4 madd[2][4];
#pragma unroll
    for (int qi = 0; qi < 2; ++qi) { cq[qi] = 32 * qh + 16 * qi + lc; cs[qi] = min(max(cq[qi] - 8, 0), 48); m[qi] = -1.0e30f; l[qi] = 0.f; boff[qi] = 63 - cq[qi] + 4 * g;
#pragma unroll
        for (int kb = 0; kb < 4; ++kb)
#pragma unroll
            for (int rr = 0; rr < 4; ++rr) { const int kc = 16 * kb + 4 * g + rr; madd[qi][kb][rr] = (kc >= cs[qi] && kc < cs[qi] + 16) ? 0.f : -1.0e30f; }
        const bf16* qp = P + ((size_t)b * SEQ + r * 64 + cq[qi]) * NPROJ + C_NAQ + h * 128 + 8 * g;
#pragma unroll
        for (int ks = 0; ks < 4; ++ks) qf[qi][ks] = *(const bf16x8v*)(qp + 32 * ks);
#pragma unroll
        for (int db = 0; db < 8; ++db) O[qi][db] = (f32x4){0.f, 0.f, 0.f, 0.f}; }
    __syncthreads();
#pragma unroll 1
    for (int j = 0; j < nk; ++j) {
        const int kr = rs0 + j;
        if (j + 1 < nk) NA_LOAD(j + 1);
        if (kr >= rs && kr < rs + 8) {
            LAS unsigned char* Kt = lds + (j & 1) * NA_BUF; LAS unsigned char* Vt = Kt + NA_TILE;
            const LAS float* brow = RPB + (kr - r + 7) * 128;
            const int kb0a = qh ? 1 : 0, kb1a = qh ? 3 : 1, kb0b = qh ? 2 : 0, kb1b = qh ? 3 : 2;
            f32x4 s[2][4];
#pragma unroll
            for (int kb = 0; kb < 4; ++kb) { s[0][kb] = (f32x4){0.f, 0.f, 0.f, 0.f}; s[1][kb] = (f32x4){0.f, 0.f, 0.f, 0.f}; }
#pragma unroll
            for (int kb = 0; kb < 4; ++kb) { const bool ua = kb >= kb0a && kb <= kb1a, ub = kb >= kb0b && kb <= kb1b;
                if (ua || ub) {
#pragma unroll
                    for (int ks = 0; ks < 4; ++ks) { const bf16x8v ka = frag_row(Kt, KP, 16 * kb, 32 * ks, lane);
                        if (ua) s[0][kb] = __builtin_amdgcn_mfma_f32_16x16x32_bf16(ka, qf[0][ks], s[0][kb], 0, 0, 0);
                        if (ub) s[1][kb] = __builtin_amdgcn_mfma_f32_16x16x32_bf16(ka, qf[1][ks], s[1][kb], 0, 0, 0); } } }
            bf16x8v pb[2][2];
#pragma unroll
            for (int qi = 0; qi < 2; ++qi) {
                const int k0 = qi ? kb0b : kb0a, k1 = qi ? kb1b : kb1a; const LAS float* bq = brow + boff[qi];
                float mx = -1.0e30f;
#pragma unroll
                for (int kb = 0; kb < 4; ++kb) if (kb >= k0 && kb <= k1) {
#pragma unroll
                    for (int rr = 0; rr < 4; ++rr) { const float v = s[qi][kb][rr] * 0.12753785f + bq[16 * kb + rr] + madd[qi][kb][rr]; s[qi][kb][rr] = v; mx = fmaxf(mx, v); } }
                mx = fmaxf(mx, __shfl_xor(mx, 16)); mx = fmaxf(mx, __shfl_xor(mx, 32));
                const float mn = fmaxf(m[qi], mx); float ls = 0.f;
#pragma unroll
                for (int kb = 0; kb < 4; ++kb) { if (kb >= k0 && kb <= k1) {
#pragma unroll
                    for (int rr = 0; rr < 4; ++rr) { const float p = __builtin_amdgcn_exp2f(s[qi][kb][rr] - mn); s[qi][kb][rr] = p; ls += p; } } else s[qi][kb] = (f32x4){0.f, 0.f, 0.f, 0.f}; }
                ls += __shfl_xor(ls, 16); ls += __shfl_xor(ls, 32);
                if (!__all(mn == m[qi])) { const float corr = __builtin_amdgcn_exp2f(m[qi] - mn); l[qi] *= corr;
#pragma unroll
                    for (int db = 0; db < 8; ++db) O[qi][db] = O[qi][db] * corr; }
                l[qi] += ls; m[qi] = mn;
#pragma unroll
                for (int t = 0; t < 2; ++t) { v4u pw; pw.x = pk2(s[qi][2 * t][0], s[qi][2 * t][1]); pw.y = pk2(s[qi][2 * t][2], s[qi][2 * t][3]); pw.z = pk2(s[qi][2 * t + 1][0], s[qi][2 * t + 1][1]); pw.w = pk2(s[qi][2 * t + 1][2], s[qi][2 * t + 1][3]);
                    pb[qi][t] = __builtin_bit_cast(bf16x8v, pw); }
            }
#pragma unroll
            for (int t = 0; t < 2; ++t) { const bool ua = 2 * t + 1 >= kb0a && 2 * t <= kb1a, ub = 2 * t + 1 >= kb0b && 2 * t <= kb1b;
                if (ua || ub) {
#pragma unroll
                    for (int db = 0; db < 8; ++db) { const bf16x8v va = frag_tr2(Vt, KP, 32 * t + 4 * g, 32 * t + 16 + 4 * g, 16 * db, lane);
                        if (ua) O[0][db] = __builtin_amdgcn_mfma_f32_16x16x32_bf16(va, pb[0][t], O[0][db], 0, 0, 0);
                        if (ub) O[1][db] = __builtin_amdgcn_mfma_f32_16x16x32_bf16(va, pb[1][t], O[1][db], 0, 0, 0); } } }
        }
        if (j + 1 < nk) NA_STORE((j + 1) & 1);
        __syncthreads();
    }
#pragma unroll
    for (int qi = 0; qi < 2; ++qi) { const float inv = 1.0f / l[qi]; bf16* op = NAO + ((size_t)b * SEQ + r * 64 + cq[qi]) * 1024 + h * 128 + 4 * g;
#pragma unroll
        for (int db = 0; db < 8; ++db) { const f32x4 o = O[qi][db] * inv; v2u w; w.x = pk2(o[0], o[1]); w.y = pk2(o[2], o[3]); *(v2u*)(op + 16 * db) = w; } }
#undef NA_LOAD
#undef NA_STORE
}


constexpr int NWAVES = 8;
constexpr int RING_BYTES = 131072;
constexpr int LDSCTL_OFF = ML_END, MISC_OFF = LDSCTL_OFF + 320;
constexpr int LDS_BYTES = LDSCTL_OFF + 1024;
static_assert(ML_END >= RING_BYTES && LDS_BYTES <= 163840, "LDS map");
constexpr int CW_BAR = 4096;
constexpr size_t CTL_ZERO_BYTES = 65536;
static_assert((CW_BAR + XCD_BAR_WORDS) * 4 <= (int)CTL_ZERO_BYTES, "barrier words inside the memset region");

struct MKArgs { const float* in[16]; float* out; unsigned char* ws; };
__global__ void __launch_bounds__(NWAVES * 64, 2) mk_fwd(MKArgs args) {
    extern __shared__ __attribute__((aligned(16))) unsigned char lds_raw[];
    LAS unsigned char* lds = (LAS unsigned char*)lds_raw;
    volatile LAS unsigned* MISC = (volatile LAS unsigned*)(lds + MISC_OFF);
    const int tid = threadIdx.x, lane0 = tid & 63, wave = __builtin_amdgcn_readfirstlane(tid >> 6);
    const int G = gridDim.x; const int bx = blockIdx.x; const int vcu = (G % 8 == 0) ? (bx % 8) * (G / 8) + bx / 8 : bx;
    const int gw0 = vcu * NWAVES + wave, ngw = G * NWAVES;
    unsigned char* ws = args.ws;
    for (int u = tid; u < (LDS_BYTES - LDSCTL_OFF) / 4; u += NWAVES * 64) ((LAS unsigned*)(lds + LDSCTL_OFF))[u] = 0u;
    __syncthreads();
    XcdBarrier bar = xcd_barrier_post((unsigned*)(ws + WS_CTL) + CW_BAR, MISC + 8);
#define GRID_BAR() do { XcdBarrier b_ = bar; asm volatile("" : "+s"(b_.bar), "+s"(b_.x)); xcd_barrier(b_); } while (0)
    const float* x = args.in[0]; const float* norm_mix_g = args.in[1]; const float* w_in = args.in[2]; const float* b_gates = args.in[3];
    const float* conv_w = args.in[4]; const float* conv_b = args.in[5]; const float* na_rpb = args.in[6]; const float* na_norm_g = args.in[7];
    const float* ml_norm_g = args.in[8]; const float* w_out = args.in[9]; const float* norm_ffn_g = args.in[10]; const float* w_router = args.in[11];
    const float* w_gate = args.in[12]; const float* w_up = args.in[13]; const float* w_down = args.in[14]; const float* final_norm_g = args.in[15];
#define WSPTRS(wsl, Xl) float* X = (Xl); float* RSTD = (float*)((wsl) + WS_RSTD); float* GATES = (float*)((wsl) + WS_GATES); float* AFF = (float*)((wsl) + WS_AFF); int* TOK = (int*)((wsl) + WS_TOK); float* GATEV = (float*)((wsl) + WS_GATEV); int* SEL = (int*)((wsl) + WS_SEL); \
    bf16* XB = (bf16*)((wsl) + WS_XB); bf16* MIX = (bf16*)((wsl) + WS_MIX); bf16* P = (bf16*)((wsl) + WS_P); bf16* NAO = (bf16*)((wsl) + WS_NAO); bf16* ACT = (bf16*)((wsl) + WS_ACT); bf16* Y = (bf16*)((wsl) + WS_Y); \
    (void)X; (void)RSTD; (void)GATES; (void)AFF; (void)TOK; (void)GATEV; (void)SEL; (void)XB; (void)MIX; (void)P; (void)NAO; (void)ACT; (void)Y;
#define LAUNDER(p) asm volatile("" : "+s"(p))
#ifndef REP_MASK
#define REP_MASK 0
#endif
#if (REP_MASK >> 0) & 1
#define REP0 for (int rep_ = 0; rep_ < 2; ++rep_)
#else
#define REP0
#endif
#if (REP_MASK >> 1) & 1
#define REP1 for (int rep_ = 0; rep_ < 2; ++rep_)
#else
#define REP1
#endif
#if (REP_MASK >> 2) & 1
#define REP2 for (int rep_ = 0; rep_ < 2; ++rep_)
#else
#define REP2
#endif
#if (REP_MASK >> 3) & 1
#define REP3 for (int rep_ = 0; rep_ < 2; ++rep_)
#else
#define REP3
#endif
#if (REP_MASK >> 4) & 1
#define REP4 for (int rep_ = 0; rep_ < 2; ++rep_)
#else
#define REP4
#endif
#if (REP_MASK >> 5) & 1
#define REP5 for (int rep_ = 0; rep_ < 2; ++rep_)
#else
#define REP5
#endif
#if (REP_MASK >> 6) & 1
#define REP6 for (int rep_ = 0; rep_ < 2; ++rep_)
#else
#define REP6
#endif
#if (REP_MASK >> 7) & 1
#define REP7 for (int rep_ = 0; rep_ < 2; ++rep_)
#else
#define REP7
#endif
#if (REP_MASK >> 8) & 1
#define REP8 for (int rep_ = 0; rep_ < 2; ++rep_)
#else
#define REP8
#endif
#if (REP_MASK >> 9) & 1
#define REP9 for (int rep_ = 0; rep_ < 2; ++rep_)
#else
#define REP9
#endif
#if (REP_MASK >> 10) & 1
#define REP10 for (int rep_ = 0; rep_ < 2; ++rep_)
#else
#define REP10
#endif
#if (REP_MASK >> 11) & 1
#define REP11 for (int rep_ = 0; rep_ < 2; ++rep_)
#else
#define REP11
#endif
#if (REP_MASK >> 12) & 1
#define REP12 for (int rep_ = 0; rep_ < 2; ++rep_)
#else
#define REP12
#endif
#if (REP_MASK >> 13) & 1
#define REP13 for (int rep_ = 0; rep_ < 2; ++rep_)
#else
#define REP13
#endif

    { WSPTRS(ws, args.out)
      const int lane = lane0, gw = gw0;
    REP0 { ConvArgs ca; ca.w_in = w_in; ca.w_out = w_out; ca.w_gate = w_gate; ca.w_up = w_up; ca.w_down = w_down; ca.norm_mix_g = norm_mix_g; ca.norm_ffn_g = norm_ffn_g; ca.ws = ws;
      LAS float* scr = (LAS float*)(lds + wave * 16384);
      for (int it = gw; it < DEPTH * CI_LAYER; it += ngw) convert_item(ca, it, scr, lane); }
    { bf16* W16F = (bf16*)(ws + WS_W16F_OFF);
      for (int it = gw; it < DEPTH * 2 * 64; it += ngw) { const int mi = it >> 6, s = it & 63, l = mi >> 1;
          if (mi & 1) w16f_item(w_router + (size_t)l * D * NE, NE, norm_ffn_g + l * D, W16F + (size_t)mi * 32768, s, lane);
          else w16f_item(w_in + (size_t)l * D * NIN + C_GATES, NIN, norm_mix_g + l * D, W16F + (size_t)mi * 32768, s, lane); } }
    GRID_BAR();
    REP1 { RowArgs a; a.src32 = x; a.srcb = nullptr; a.sel = nullptr; a.Y = nullptr; a.XB = XB; a.XB8 = ws + WS_XB8; a.RSTD = RSTD; a.g = norm_mix_g; a.W16F = (const bf16*)(ws + WS_W16F_OFF); a.bias = b_gates; a.GATES = GATES; a.AFF = AFF; a.out = X; a.mode = 0; a.wrxb = 1;
      for (int grp = gw; grp < MTOK / 8; grp += ngw) rowpass_group<true>(a, grp, lane); } }
    GRID_BAR();

    for (int l = 0; l < DEPTH; ++l) {
        unsigned char* wsl = ws; float* Xl = args.out; LAUNDER(wsl); LAUNDER(Xl);
        WSPTRS(wsl, Xl)
        int lane = lane0, gw = gw0; asm volatile("" : "+v"(lane)); LAUNDER(gw);
        const bf16* WinT = (const bf16*)(wsl + WS_WIN) + (size_t)l * NPROJ * D; const bf16* WoutT = (const bf16*)(wsl + WS_WOUT) + (size_t)l * D * D;
        const bf16* WguT = (const bf16*)(wsl + WS_WGU) + (size_t)l * NE * 2048 * D; const bf16* WdT = (const bf16*)(wsl + WS_WD) + (size_t)l * NE * D * DE;
        REP2 { pg8::Gemm g{XB, WinT, MTOK, NPROJ16, D, 0}; pg8::StaticOrder S; S.init(MTOK, NPROJ16, G, bx); pg8::EpiRowScaleBf16 E{P, RSTD, nullptr, NPROJ, 0, 1.0f, 0};
          pg8::gemm_phase<pg8::EpiRowScaleBf16, pg8::StaticOrder, true, true>(lds, g, S, E); }
        { pg8::Gemm g{(const bf16*)(wsl + WS_XB8), (const bf16*)(wsl + WS_WIN + ((size_t)l * NPROJ + NPROJ16) * D * 2), MTOK, NPROJ - NPROJ16, D / 2, 0}; pg8::StaticOrder S; S.init(MTOK, NPROJ - NPROJ16, G, bx);
          pg8::EpiRowScaleBf16 E{P + NPROJ16, RSTD, nullptr, NPROJ, 0, 1.0f / W8_SCALE, 0};
          pg8::gemm_phase<pg8::EpiRowScaleBf16, pg8::StaticOrder, true, true, true>(lds, g, S, E); }
        GRID_BAR();
        REP4 for (int u = vcu; u < 512; u += G) na_unit(u, P, na_rpb + (size_t)l * 8 * 15 * 31, NAO, lds, tid, wave);
        { bf16* UC = (bf16*)(wsl + WS_UC); float* NU = (float*)(wsl + WS_NU); float* SC = (float*)(wsl + WS_SC); const float* cwl = conv_w + (size_t)l * 5 * 1024; const float* cbl = conv_b + l * 1024;
          int tidl = tid; asm volatile("" : "+v"(tidl));
          REP5 for (int u = bx; u < 512; u += G) mlstm_m1_unit(u, cwl, cbl, P, GATES, UC, NU, SC, lds, tidl, wave);
          GRID_BAR();
          mlstm_m2(UC, NU, SC, vcu * 512 + tidl, G * 512);
          REP6 for (int t = gw; t < MTOK; t += ngw) na_norm_item(NAO, na_norm_g + l * 1024, MIX, t, lane);
          GRID_BAR();
          REP7 for (int u = bx; u < 512; u += G) mlstm_m3_unit(u, cwl, cbl, P, GATES, UC, NU, SC, ml_norm_g + l * 1024, MIX, lds, tidl, wave); }
        GRID_BAR();
#if (REP_MASK >> 8) & 1
        for (int rep_ = 0; rep_ < (l == 0 ? 2 : 1); ++rep_)
#endif
        { pg8::Gemm g{MIX, WoutT, MTOK, D, D, 0}; pg8::StaticOrder S; S.init(MTOK, D, G, bx); pg8::EpiResidBf16 E{XB, D, 0};
          pg8::gemm_phase<pg8::EpiResidBf16, pg8::StaticOrder, true, true>(lds, g, S, E); }
        GRID_BAR();
        REP9 { RowArgs a; a.src32 = nullptr; a.srcb = XB; a.sel = nullptr; a.Y = nullptr; a.XB = XB; a.XB8 = wsl + WS_XB8; a.RSTD = RSTD; a.g = norm_ffn_g + l * D; a.W16F = (const bf16*)(wsl + WS_W16F_OFF) + (size_t)(2 * l + 1) * 32768; a.bias = b_gates; a.GATES = GATES; a.AFF = AFF; a.out = X; a.mode = 1; a.wrxb = 0;
          for (int grp = gw; grp < MTOK / 8; grp += ngw) rowpass_group<false>(a, grp, lane); }
        GRID_BAR();
        REP10 for (int be = bx; be < BATCH * NE; be += G) topk_unit(be, AFF, TOK, GATEV, SEL, (LAS int*)lds);
        GRID_BAR();
        REP12 { pg8::Gemm g{(const bf16*)(wsl + WS_XB8), (const bf16*)(wsl + WS_WGU + (size_t)l * NE * 2048 * D), MR, 2048, D / 2, 0}; pg8::GroupedGatherOrder S{TOK, G, bx};
          pg8::EpiSwiGLU8 E{(unsigned char*)ACT, RSTD, TOK, DE, 8, 1.0f / W8_SCALE, 0};
          pg8::gemm_phase_gather<pg8::EpiSwiGLU8, pg8::GroupedGatherOrder, true, true, true>(lds, g, S, E); }
        GRID_BAR();
        REP13 { pg8::Gemm g{ACT, (const bf16*)(wsl + WS_WD + (size_t)l * NE * D * DE), MR, 2048, DE / 2, 0}; pg8::GroupedOrder S{nullptr, G, bx}; pg8::EpiRowScaleF8 E{(unsigned char*)Y, GATEV, D, 8, Y8_SCALE / W8_SCALE, 0};
          pg8::gemm_phase<pg8::EpiRowScaleF8, pg8::GroupedOrder, true, true, true>(lds, g, S, E); }
        GRID_BAR();
        { RowArgs a; a.src32 = nullptr; a.srcb = XB; a.sel = SEL; a.Y = (const unsigned char*)Y; a.XB = XB; a.XB8 = wsl + WS_XB8; a.RSTD = RSTD; a.bias = b_gates + (l + 1 < DEPTH ? (l + 1) * 16 : 0); a.GATES = GATES; a.AFF = AFF; a.out = X; a.wrxb = 1;
          a.W16F = (const bf16*)(wsl + WS_W16F_OFF) + (size_t)(2 * (l + 1 < DEPTH ? l + 1 : 0)) * 32768;
          if (l + 1 < DEPTH) { a.g = norm_mix_g + (l + 1) * D; a.mode = 0; }
          else { a.g = final_norm_g; a.mode = 2; }
          for (int grp = gw; grp < MTOK / 8; grp += ngw) rowpass_group<false>(a, grp, lane); }
        if (l + 1 < DEPTH) GRID_BAR();
    }
#undef GRID_BAR
#undef WSPTRS
}

extern "C" void kernel_launch(void* const* d_in, const int* in_sizes, int n_in, void* d_out, int out_size, void* d_ws, size_t ws_size, hipStream_t stream) {
    static int grid = 0;
    if (grid == 0) {
        if (n_in != 16 || ws_size < WS_END) { fprintf(stderr, "kernel_launch: unexpected n_in %d or ws_size %zu\n", n_in, ws_size); grid = -1; return; }
        int dev = 0, cus = 0, per_cu = 0;
        if (hipGetDevice(&dev) != hipSuccess || hipDeviceGetAttribute(&cus, hipDeviceAttributeMultiprocessorCount, dev) != hipSuccess) { grid = -1; return; }
        if (hipFuncSetAttribute((const void*)mk_fwd, hipFuncAttributeMaxDynamicSharedMemorySize, LDS_BYTES) != hipSuccess) { fprintf(stderr, "kernel_launch: hipFuncSetAttribute failed\n"); grid = -1; return; }
        if (hipOccupancyMaxActiveBlocksPerMultiprocessor(&per_cu, (const void*)mk_fwd, NWAVES * 64, LDS_BYTES) != hipSuccess || per_cu < 1) fprintf(stderr, "kernel_launch: occupancy query reports %d blocks per CU\n", per_cu);
        (void)hipGetLastError();
        grid = cus;
    }
    if (grid < 0) return;
    if (hipMemsetAsync((char*)d_ws + WS_CTL, 0, CTL_ZERO_BYTES, stream) != hipSuccess) return;
    MKArgs a; memset(&a, 0, sizeof(a));
    for (int i = 0; i < 16; ++i) a.in[i] = (const float*)d_in[i];
    a.out = (float*)d_out; a.ws = (unsigned char*)d_ws;
    hipLaunchKernelGGL(mk_fwd, dim3(grid), dim3(NWAVES * 64), LDS_BYTES, stream, a);
}
```

```cpp
#include <hip/hip_runtime.h>
#include <stdint.h>
#include <stdio.h>
#include <string.h>

namespace pg8 {
#define PG8_LAS __attribute__((address_space(3)))
typedef unsigned short bf16_t;
typedef short bf16x8 __attribute__((ext_vector_type(8)));
typedef float f32x4 __attribute__((ext_vector_type(4)));
typedef unsigned u32x4 __attribute__((ext_vector_type(4)));
typedef int v4i32 __attribute__((ext_vector_type(4)));
typedef int v8i32 __attribute__((ext_vector_type(8)));
constexpr int BM = 256, BK = 64, HALF = 128, HTB = HALF * BK * 2  , STAGE_BYTES = 8 * HTB, NXCD = 8, WGM = 8;

__host__ __device__ __forceinline__ int lds_byte(int r, int c) { const int st = (r >> 4) * 2 + (c >> 5), rr = r & 15, cc = c & 31, ob = rr * 64 + cc * 2; return st * 1024 + (ob ^ (((ob >> 9) & 1) << 5)); }
__host__ __device__ __forceinline__ void stage_rc(int b, int& R, int& C) { const int st = b / 1024, sb = b % 1024, swz = sb ^ (((sb >> 9) & 1) << 5); R = (st >> 1) * 16 + swz / 64; C = (st & 1) * 32 + (swz % 64) / 2; }
__host__ __device__ __forceinline__ int perm32(int rho) { const int n = rho >> 4, i = rho & 15; return 8 * (i >> 2) + 4 * n + (i & 3); }

struct Unit { int pm, pn; };
struct Gemm { const bf16_t* A; const bf16_t* Bt; int M, N, K, pad; };

struct StaticOrder {
    static constexpr bool GATHER = false;
    int nM, nN, nwg, G, c, pad;
    __host__ __device__ void init(int M, int N, int G_, int c_) { nM = M / BM; nN = N / BM; nwg = nM * nN; G = G_; c = c_; pad = 0; }
    __host__ __device__ bool next(int i, Unit& u) const {
        const long L = (long)i * G + c; if (L >= nwg) return false;
        int wgid = (int)L; { const int q = nwg / NXCD, r = nwg % NXCD, xcd = wgid % NXCD, off = wgid / NXCD; wgid = (xcd < r ? xcd * (q + 1) : r * (q + 1) + (xcd - r) * q) + off; }
        const int nig = WGM * nN, gid = wgid / nig, fm = gid * WGM, gsz = (nM - fm) < WGM ? (nM - fm) : WGM;
        u.pm = fm + ((wgid % nig) % gsz); u.pn = (wgid % nig) / gsz; return true;
    }
    __device__ __forceinline__ void a_ready(const Unit&) const {}
    __device__ __forceinline__ void done(const Unit&) const {}
};


__device__ __forceinline__ unsigned cvt_pk_bf16(float lo, float hi) { unsigned r; asm volatile("v_cvt_pk_bf16_f32 %0, %1, %2" : "=v"(r) : "v"(lo), "v"(hi)); return r; }
typedef unsigned u32x2 __attribute__((ext_vector_type(2)));

struct EpiRowScaleBf16 {
    static constexpr bool PERM = true, AFTER_DRAIN = false;
    bf16_t* O; const float* rowscale; const int* rowmap; int ldc; int pn_mod; float mul; int pad;
    __device__ __forceinline__ void operator()(const f32x4 (&acc)[2][2][4][2], const Unit& u, int wr, int wc, int fr, int fq) const {
        const int row0 = u.pm * BM + wr * 64 + fr; const int pnl = pn_mod ? (u.pn % pn_mod) : u.pn;
        const int col0 = pnl * BM + wc * 32 + 8 * fq;
#pragma unroll
        for (int ai = 0; ai < 2; ++ai)
#pragma unroll
            for (int m = 0; m < 4; ++m) { const int row = row0 + ai * HALF + m * 16; const float sc = rowscale ? rowscale[rowmap ? rowmap[row] : row] * mul : mul;
                bf16_t* rowp = O + (size_t)row * ldc + col0;
#pragma unroll
                for (int bj = 0; bj < 2; ++bj) { const f32x4 v0 = acc[ai][bj][m][0] * sc, v1 = acc[ai][bj][m][1] * sc;
                    u32x4 w; w.x = cvt_pk_bf16(v0[0], v0[1]); w.y = cvt_pk_bf16(v0[2], v0[3]); w.z = cvt_pk_bf16(v1[0], v1[1]); w.w = cvt_pk_bf16(v1[2], v1[3]);
                    *(u32x4*)(rowp + bj * HALF) = w; } }
    }
};
__device__ __forceinline__ unsigned pk4_fp8(float a, float b, float c, float d) { int p = __builtin_amdgcn_cvt_pk_fp8_f32(a, b, 0, false); p = __builtin_amdgcn_cvt_pk_fp8_f32(c, d, p, true); return (unsigned)p; }
struct EpiSwiGLU8 {
    static constexpr bool PERM = false, AFTER_DRAIN = false;
    unsigned char* O; const float* rowscale; const int* rowmap; int ldc; int pn_mod; float mul; int pad;
    __device__ __forceinline__ void operator()(const f32x4 (&acc)[2][2][4][2], const Unit& u, int wr, int wc, int fr, int fq) const {
        const int row0 = u.pm * BM + wr * 64 + fr; const int pnl = u.pn % pn_mod;
        const int col0 = pnl * 128 + wc * 16 + 4 * fq;
#pragma unroll
        for (int ai = 0; ai < 2; ++ai)
#pragma unroll
            for (int m = 0; m < 4; ++m) { const int row = row0 + ai * HALF + m * 16; const float sc = rowscale[rowmap[row]] * mul;
                unsigned char* rowp = O + (size_t)row * ldc + col0;
#pragma unroll
                for (int bj = 0; bj < 2; ++bj) { const f32x4 a = acc[ai][bj][m][0] * sc, up = acc[ai][bj][m][1] * sc; f32x4 r;
#pragma unroll
                    for (int j = 0; j < 4; ++j) r[j] = a[j] * up[j] * __builtin_amdgcn_rcpf(1.0f + __builtin_amdgcn_exp2f(-1.4426950408889634f * a[j]));
                    *(unsigned*)(rowp + bj * 64) = pk4_fp8(r[0], r[1], r[2], r[3]); } }
    }
};

struct EpiRowScaleF8 {
    static constexpr bool PERM = true, AFTER_DRAIN = false;
    unsigned char* O; const float* rowscale; int ldc; int pn_mod; float mul; int pad;
    __device__ __forceinline__ void operator()(const f32x4 (&acc)[2][2][4][2], const Unit& u, int wr, int wc, int fr, int fq) const {
        const int row0 = u.pm * BM + wr * 64 + fr; const int pnl = pn_mod ? (u.pn % pn_mod) : u.pn;
        const int col0 = pnl * BM + wc * 32 + 8 * fq;
#pragma unroll
        for (int ai = 0; ai < 2; ++ai)
#pragma unroll
            for (int m = 0; m < 4; ++m) { const int row = row0 + ai * HALF + m * 16; const float sc = rowscale[row] * mul;
                unsigned char* rowp = O + (size_t)row * ldc + col0;
#pragma unroll
                for (int bj = 0; bj < 2; ++bj) { const f32x4 v0 = acc[ai][bj][m][0] * sc, v1 = acc[ai][bj][m][1] * sc;
                    u32x2 w; w.x = pk4_fp8(v0[0], v0[1], v0[2], v0[3]); w.y = pk4_fp8(v1[0], v1[1], v1[2], v1[3]);
                    *(u32x2*)(rowp + bj * HALF) = w; } }
    }
};

struct EpiResidBf16 {
    static constexpr bool PERM = true, AFTER_DRAIN = false;
    bf16_t* XB; const float* rowscale; int ldc; int pad;
    __device__ __forceinline__ void operator()(const f32x4 (&acc)[2][2][4][2], const Unit& u, int wr, int wc, int fr, int fq) const {
        const int row0 = u.pm * BM + wr * 64 + fr, col0 = u.pn * BM + wc * 32 + 8 * fq;
#pragma unroll
        for (int ai = 0; ai < 2; ++ai)
#pragma unroll
            for (int m = 0; m < 4; ++m) { const int row = row0 + ai * HALF + m * 16; const float sc = rowscale[row]; bf16_t* rowp = XB + (size_t)row * ldc + col0;
#pragma unroll
                for (int bj = 0; bj < 2; ++bj) { const u32x4 x = *(const u32x4*)(rowp + bj * HALF); const f32x4 v0 = acc[ai][bj][m][0] * sc, v1 = acc[ai][bj][m][1] * sc;
                    u32x4 w; w.x = cvt_pk_bf16(__uint_as_float(x.x << 16) + v0[0], __uint_as_float(x.x & 0xffff0000u) + v0[1]); w.y = cvt_pk_bf16(__uint_as_float(x.y << 16) + v0[2], __uint_as_float(x.y & 0xffff0000u) + v0[3]);
                    w.z = cvt_pk_bf16(__uint_as_float(x.z << 16) + v1[0], __uint_as_float(x.z & 0xffff0000u) + v1[1]); w.w = cvt_pk_bf16(__uint_as_float(x.w << 16) + v1[2], __uint_as_float(x.w & 0xffff0000u) + v1[3]);
                    *(u32x4*)(rowp + bj * HALF) = w; } }
    }
};
template <bool GATHER_> struct GroupedOrderT {
    static constexpr bool GATHER = GATHER_;
    const int* rowmap; int G, c;
    __device__ __forceinline__ bool next(int i, Unit& u) const {
        const int L = i * G + c; if (L >= 1024) return false;
        const int e = L >> 6, w = L & 63; u.pm = e * 8 + (w & 7); u.pn = e * 8 + (w >> 3); return true;
    }
    __device__ __forceinline__ void a_ready(const Unit&) const {}
    __device__ __forceinline__ void done(const Unit&) const {}
};
typedef GroupedOrderT<false> GroupedOrder; typedef GroupedOrderT<true> GroupedGatherOrder;
template <class Epi, class Sched, bool ALIGN_EPI = false, bool SP2 = false, bool F8 = false>
__device__ __forceinline__ void gemm_phase(PG8_LAS unsigned char* lds, const Gemm g, const Sched& S, const Epi& E) {
    int tid_ = threadIdx.x; asm volatile("" : "+v"(tid_));
    const int tid = tid_, wid = __builtin_amdgcn_readfirstlane(tid >> 6), lane = tid & 63, wr = wid >> 2, wc = wid & 3, fr = lane & 15, fq = lane >> 4;
    const int K = g.K, nt = K / BK;
    unsigned voffA[2], voffB[2];
#pragma unroll
    for (int i = 0; i < 2; ++i) { int R, C; stage_rc(tid * 16 + i * 8192, R, C); const int Rb = Epi::PERM ? ((R & ~31) + perm32(R & 31)) : R;
        voffA[i] = (unsigned)(R * K + C) * 2u; voffB[i] = (unsigned)(Rb * K + C) * 2u; }
    const size_t kstep = (size_t)(BK * 2);
    const size_t hstep = (size_t)HALF * K * 2;
    const size_t tstep = 2 * hstep;
    const unsigned ldsw = (unsigned)wid * 1024u;
    const int aoff = lds_byte(wr * 64 + fr, fq * 8), boff = lds_byte(wc * 32 + fr, fq * 8);
#define PG8_SA(b, h) (((b) * 2 + (h)) * HTB)
#define PG8_SB(b, h) ((4 + (b) * 2 + (h)) * HTB)
#define PG8_STAGE(bufoff, gbase, voff) do { _Pragma("unroll") for (int _i = 0; _i < 2; ++_i) \
        __builtin_amdgcn_global_load_lds((const unsigned*)((const char*)(gbase) + (voff)[_i]), (PG8_LAS unsigned*)(lds + (bufoff) + ldsw + _i * 8192), 16, 0, 0); } while (0)
#define PG8_LDA(dst, b, h) do { if constexpr (F8) { _Pragma("unroll") for (int m = 0; m < 4; ++m) dst##8[m] = __builtin_shufflevector(*(const PG8_LAS v4i32*)(lds + PG8_SA(b, h) + aoff + m * 2048), *(const PG8_LAS v4i32*)(lds + PG8_SA(b, h) + aoff + m * 2048 + 1024), 0, 1, 2, 3, 4, 5, 6, 7); } \
    else { _Pragma("unroll") for (int m = 0; m < 4; ++m) _Pragma("unroll") for (int k = 0; k < 2; ++k) dst[m][k] = *(const PG8_LAS bf16x8*)(lds + PG8_SA(b, h) + aoff + m * 2048 + k * 1024); } } while (0)
#define PG8_LDB(dst, b, h) do { if constexpr (F8) { _Pragma("unroll") for (int n = 0; n < 2; ++n) dst##8[n] = __builtin_shufflevector(*(const PG8_LAS v4i32*)(lds + PG8_SB(b, h) + boff + n * 2048), *(const PG8_LAS v4i32*)(lds + PG8_SB(b, h) + boff + n * 2048 + 1024), 0, 1, 2, 3, 4, 5, 6, 7); } \
    else { _Pragma("unroll") for (int n = 0; n < 2; ++n) _Pragma("unroll") for (int k = 0; k < 2; ++k) dst[n][k] = *(const PG8_LAS bf16x8*)(lds + PG8_SB(b, h) + boff + n * 2048 + k * 1024); } } while (0)
#define PG8_MMA(ai, bj, At, Bt) do { __builtin_amdgcn_s_setprio(1); _Pragma("unroll") for (int m = 0; m < 4; ++m) _Pragma("unroll") for (int n = 0; n < 2; ++n) { \
        if constexpr (F8) asm volatile("v_mfma_scale_f32_16x16x128_f8f6f4 %0, %1, %2, %0, %3, %3 op_sel_hi:[0,0,0]" : "+v"(acc[ai][bj][m][n]) : "v"(Bt##8[n]), "v"(At##8[m]), "v"(f8scale));   \
        else { _Pragma("unroll") for (int k = 0; k < 2; ++k) acc[ai][bj][m][n] = __builtin_amdgcn_mfma_f32_16x16x32_bf16(Bt[n][k], At[m][k], acc[ai][bj][m][n], 0, 0, 0); } } \
        __builtin_amdgcn_s_setprio(0); } while (0)
#define PG8_WAIT_V(n) asm volatile("s_waitcnt vmcnt(" #n ")" ::: "memory")
#define PG8_WAIT_L(n) asm volatile("s_waitcnt lgkmcnt(" #n ")" ::: "memory")
#define PG8_BAR __builtin_amdgcn_s_barrier()
#define PG8_SCHED __builtin_amdgcn_sched_barrier(0)
    Unit cur, nxt; int ui = 0;
    if (!S.next(0, cur)) return;
    f32x4 acc[2][2][4][2];
#pragma unroll
    for (int a = 0; a < 2; ++a)
#pragma unroll
        for (int b = 0; b < 2; ++b)
#pragma unroll
            for (int m = 0; m < 4; ++m)
#pragma unroll
                for (int n = 0; n < 2; ++n) acc[a][b][m][n] = (f32x4){0.f, 0.f, 0.f, 0.f};
    bf16x8 At[4][2], B0[2][2], B1[2][2]; v8i32 At8[4], B08[2], B18[2];
    const int f8scale = 0x7F7F7F7F; (void)f8scale;
    const char* cA = (const char*)g.A + (size_t)cur.pm * tstep; const char* cB = (const char*)g.Bt + (size_t)cur.pn * tstep;
    S.a_ready(cur);
    if constexpr (SP2) {
        PG8_STAGE(PG8_SB(0, 0), cB, voffB); PG8_STAGE(PG8_SB(0, 1), cB + hstep, voffB); PG8_STAGE(PG8_SA(0, 0), cA, voffA); PG8_STAGE(PG8_SA(0, 1), cA + hstep, voffA);
        if (wr == 1) PG8_BAR;
        PG8_WAIT_V(2); PG8_BAR;
        PG8_STAGE(PG8_SB(1, 0), cB + kstep, voffB); PG8_STAGE(PG8_SA(1, 0), cA + kstep, voffA); PG8_STAGE(PG8_SB(1, 1), cB + hstep + kstep, voffB);
        PG8_WAIT_V(6); PG8_BAR;
    } else {
        PG8_STAGE(PG8_SB(0, 0), cB, voffB); PG8_STAGE(PG8_SA(0, 0), cA, voffA); PG8_STAGE(PG8_SB(0, 1), cB + hstep, voffB); PG8_STAGE(PG8_SA(0, 1), cA + hstep, voffA);
        if (wr == 1) PG8_BAR;
        PG8_WAIT_V(4); PG8_BAR;
        PG8_STAGE(PG8_SB(1, 0), cB + kstep, voffB); PG8_STAGE(PG8_SA(1, 0), cA + kstep, voffA); PG8_STAGE(PG8_SB(1, 1), cB + hstep + kstep, voffB);
        PG8_WAIT_V(6); PG8_BAR;
    }
    for (;;) {
        const bool has_next = S.next(ui + 1, nxt);
        const char* nA = has_next ? (const char*)g.A + (size_t)nxt.pm * tstep : cA; const char* nB = has_next ? (const char*)g.Bt + (size_t)nxt.pn * tstep : cB;
        for (int t = 0; t < nt; t += 2) {
            const bool last = (t == nt - 2);
            const char* a1 = cA + (size_t)(t + 1) * kstep;
            const char* a2 = last ? nA : cA + (size_t)(t + 2) * kstep; const char* b2 = last ? nB : cB + (size_t)(t + 2) * kstep;
            const char* a3 = a2 + kstep; const char* b3 = b2 + kstep;
            if (last && has_next) S.a_ready(nxt);
            if constexpr (SP2) {
            PG8_LDB(B0, 0, 0); PG8_LDB(B1, 0, 1); PG8_SCHED; PG8_LDA(At, 0, 0); PG8_STAGE(PG8_SA(1, 1), a1 + hstep, voffA);
            PG8_WAIT_V(8); PG8_WAIT_L(0); PG8_BAR; PG8_MMA(0, 0, At, B0); PG8_MMA(0, 1, At, B1); PG8_BAR; PG8_SCHED;
            PG8_LDA(At, 0, 1); PG8_STAGE(PG8_SB(0, 0), b2, voffB); PG8_STAGE(PG8_SB(0, 1), b2 + hstep, voffB); PG8_STAGE(PG8_SA(0, 0), a2, voffA);
            PG8_WAIT_V(8); PG8_WAIT_L(0); PG8_BAR; PG8_MMA(1, 0, At, B0); PG8_MMA(1, 1, At, B1); PG8_BAR; PG8_SCHED;
            PG8_LDB(B0, 1, 0); PG8_LDB(B1, 1, 1); PG8_SCHED; PG8_LDA(At, 1, 0); PG8_STAGE(PG8_SA(0, 1), a2 + hstep, voffA);
            PG8_WAIT_V(8); PG8_WAIT_L(0); PG8_BAR; PG8_MMA(0, 0, At, B0); PG8_MMA(0, 1, At, B1); PG8_BAR; PG8_SCHED;
            PG8_LDA(At, 1, 1); PG8_STAGE(PG8_SB(1, 0), b3, voffB); PG8_STAGE(PG8_SB(1, 1), b3 + hstep, voffB); PG8_STAGE(PG8_SA(1, 0), a3, voffA);
            PG8_WAIT_V(8); PG8_WAIT_L(0); PG8_BAR; PG8_MMA(1, 0, At, B0); PG8_MMA(1, 1, At, B1); PG8_BAR; PG8_SCHED;
            } else {
            PG8_LDB(B0, 0, 0); PG8_SCHED; PG8_LDA(At, 0, 0); PG8_STAGE(PG8_SA(1, 1), a1 + hstep, voffA);
            PG8_WAIT_L(8); PG8_BAR; PG8_WAIT_L(0); PG8_MMA(0, 0, At, B0); PG8_BAR; PG8_SCHED;
            PG8_LDB(B1, 0, 1); PG8_STAGE(PG8_SB(0, 0), b2, voffB);
            PG8_BAR; PG8_WAIT_L(0); PG8_MMA(0, 1, At, B1); PG8_BAR;
            PG8_LDA(At, 0, 1); PG8_STAGE(PG8_SA(0, 0), a2, voffA);
            PG8_BAR; PG8_WAIT_L(0); PG8_MMA(1, 0, At, B0); PG8_BAR; PG8_SCHED;
            PG8_STAGE(PG8_SB(0, 1), b2 + hstep, voffB);
            PG8_WAIT_V(6); PG8_BAR; PG8_MMA(1, 1, At, B1); PG8_BAR;
            PG8_LDB(B0, 1, 0); PG8_SCHED; PG8_LDA(At, 1, 0); PG8_STAGE(PG8_SA(0, 1), a2 + hstep, voffA);
            PG8_WAIT_L(8); PG8_BAR; PG8_WAIT_L(0); PG8_MMA(0, 0, At, B0); PG8_BAR; PG8_SCHED;
            PG8_LDB(B1, 1, 1); PG8_STAGE(PG8_SB(1, 0), b3, voffB);
            PG8_BAR; PG8_WAIT_L(0); PG8_MMA(0, 1, At, B1); PG8_BAR;
            PG8_LDA(At, 1, 1); PG8_STAGE(PG8_SA(1, 0), a3, voffA);
            PG8_BAR; PG8_WAIT_L(0); PG8_MMA(1, 0, At, B0); PG8_BAR; PG8_SCHED;
            PG8_STAGE(PG8_SB(1, 1), b3 + hstep, voffB);
            PG8_WAIT_V(6); PG8_BAR; PG8_MMA(1, 1, At, B1); PG8_BAR;
            }
        }
        if constexpr (F8) asm volatile("s_nop 15\n\ts_nop 15" ::: "memory");
        if constexpr (ALIGN_EPI) { if (wr == 0) PG8_BAR; }
        if constexpr (!Epi::AFTER_DRAIN) { E(acc, cur, wr, wc, fr, fq); S.done(cur); }
        if (!has_next) break;
#pragma unroll
        for (int a = 0; a < 2; ++a)
#pragma unroll
            for (int b = 0; b < 2; ++b)
#pragma unroll
                for (int m = 0; m < 4; ++m)
#pragma unroll
                    for (int n = 0; n < 2; ++n) acc[a][b][m][n] = (f32x4){0.f, 0.f, 0.f, 0.f};
        cur = nxt; cA = nA; cB = nB; ++ui;
        if constexpr (ALIGN_EPI) { if (wr == 1) PG8_BAR; }
    }
    PG8_WAIT_V(0);
    if constexpr (!ALIGN_EPI) { if (wr == 0) PG8_BAR; }
    PG8_BAR;
    if constexpr (Epi::AFTER_DRAIN) { E.fused(acc, cur, wr, wc, fr, fq, lds, wid, lane); S.done(cur); }
#undef PG8_SA
#undef PG8_SB
#undef PG8_STAGE
#undef PG8_LDA
#undef PG8_LDB
#undef PG8_MMA
#undef PG8_WAIT_V
#undef PG8_WAIT_L
#undef PG8_BAR
#undef PG8_SCHED
}

template <class Epi, class Sched, bool ALIGN_EPI = false, bool SP2 = false, bool F8 = false>
__device__ __forceinline__ void gemm_phase_gather(PG8_LAS unsigned char* lds, const Gemm g, const Sched& S, const Epi& E) {
    int tid_ = threadIdx.x; asm volatile("" : "+v"(tid_));
    const int tid = tid_, wid = __builtin_amdgcn_readfirstlane(tid >> 6), lane = tid & 63, wr = wid >> 2, wc = wid & 3, fr = lane & 15, fq = lane >> 4;
    static_assert(SP2 || !Sched::GATHER, "gathered A rows: SP2 loop only");
    const int K = g.K, nt = K / BK;
    unsigned voffA[2], voffB[2];
#pragma unroll
    for (int i = 0; i < 2; ++i) { int R, C; stage_rc(tid * 16 + i * 8192, R, C); const int Rb = Epi::PERM ? ((R & ~31) + perm32(R & 31)) : R;
        voffA[i] = (unsigned)(R * K + C) * 2u; voffB[i] = (unsigned)(Rb * K + C) * 2u; }
    constexpr bool GATHER = Sched::GATHER;
    int RA[2], CA[2];
#pragma unroll
    for (int i = 0; i < 2; ++i) stage_rc(tid * 16 + i * 8192, RA[i], CA[i]);
    const size_t kstep = (size_t)(BK * 2);
    const size_t hstep = (size_t)HALF * K * 2;
    const size_t tstep = 2 * hstep;
    const unsigned ldsw = (unsigned)wid * 1024u;
    const int aoff = lds_byte(wr * 64 + fr, fq * 8), boff = lds_byte(wc * 32 + fr, fq * 8);
#define PG8_SA(b, h) (((b) * 2 + (h)) * HTB)
#define PG8_SB(b, h) ((4 + (b) * 2 + (h)) * HTB)
#define PG8_STAGE(bufoff, gbase, voff) do { _Pragma("unroll") for (int _i = 0; _i < 2; ++_i) \
        __builtin_amdgcn_global_load_lds((const unsigned*)((const char*)(gbase) + (voff)[_i]), (PG8_LAS unsigned*)(lds + (bufoff) + ldsw + _i * 8192), 16, 0, 0); } while (0)
#define PG8_LDA(dst, b, h) do { if constexpr (F8) { _Pragma("unroll") for (int m = 0; m < 4; ++m) dst##8[m] = __builtin_shufflevector(*(const PG8_LAS v4i32*)(lds + PG8_SA(b, h) + aoff + m * 2048), *(const PG8_LAS v4i32*)(lds + PG8_SA(b, h) + aoff + m * 2048 + 1024), 0, 1, 2, 3, 4, 5, 6, 7); } \
    else { _Pragma("unroll") for (int m = 0; m < 4; ++m) _Pragma("unroll") for (int k = 0; k < 2; ++k) dst[m][k] = *(const PG8_LAS bf16x8*)(lds + PG8_SA(b, h) + aoff + m * 2048 + k * 1024); } } while (0)
#define PG8_LDB(dst, b, h) do { if constexpr (F8) { _Pragma("unroll") for (int n = 0; n < 2; ++n) dst##8[n] = __builtin_shufflevector(*(const PG8_LAS v4i32*)(lds + PG8_SB(b, h) + boff + n * 2048), *(const PG8_LAS v4i32*)(lds + PG8_SB(b, h) + boff + n * 2048 + 1024), 0, 1, 2, 3, 4, 5, 6, 7); } \
    else { _Pragma("unroll") for (int n = 0; n < 2; ++n) _Pragma("unroll") for (int k = 0; k < 2; ++k) dst[n][k] = *(const PG8_LAS bf16x8*)(lds + PG8_SB(b, h) + boff + n * 2048 + k * 1024); } } while (0)
#define PG8_MMA(ai, bj, At, Bt) do { __builtin_amdgcn_s_setprio(1); _Pragma("unroll") for (int m = 0; m < 4; ++m) _Pragma("unroll") for (int n = 0; n < 2; ++n) { \
        if constexpr (F8) asm volatile("v_mfma_scale_f32_16x16x128_f8f6f4 %0, %1, %2, %0, %3, %3 op_sel_hi:[0,0,0]" : "+v"(acc[ai][bj][m][n]) : "v"(Bt##8[n]), "v"(At##8[m]), "v"(f8scale));   \
        else { _Pragma("unroll") for (int k = 0; k < 2; ++k) acc[ai][bj][m][n] = __builtin_amdgcn_mfma_f32_16x16x32_bf16(Bt[n][k], At[m][k], acc[ai][bj][m][n], 0, 0, 0); } } \
        __builtin_amdgcn_s_setprio(0); } while (0)
#define PG8_WAIT_V(n) asm volatile("s_waitcnt vmcnt(" #n ")" ::: "memory")
#define PG8_WAIT_L(n) asm volatile("s_waitcnt lgkmcnt(" #n ")" ::: "memory")
#define PG8_BAR __builtin_amdgcn_s_barrier()
#define PG8_SCHED __builtin_amdgcn_sched_barrier(0)
    Unit cur, nxt; int ui = 0;
    if (!S.next(0, cur)) return;
    f32x4 acc[2][2][4][2];
#pragma unroll
    for (int a = 0; a < 2; ++a)
#pragma unroll
        for (int b = 0; b < 2; ++b)
#pragma unroll
            for (int m = 0; m < 4; ++m)
#pragma unroll
                for (int n = 0; n < 2; ++n) acc[a][b][m][n] = (f32x4){0.f, 0.f, 0.f, 0.f};
    bf16x8 At[4][2], B0[2][2], B1[2][2]; v8i32 At8[4], B08[2], B18[2];
    const int f8scale = 0x7F7F7F7F; (void)f8scale;
    const char* cA = GATHER ? (const char*)g.A : (const char*)g.A + (size_t)cur.pm * tstep; const char* cB = (const char*)g.Bt + (size_t)cur.pn * tstep;
    unsigned offC[2][2], offN[2][2];
#define PG8_SETOFF(o, u) do { _Pragma("unroll") for (int _h = 0; _h < 2; ++_h) _Pragma("unroll") for (int _i = 0; _i < 2; ++_i) { \
        if constexpr (GATHER) o[_h][_i] = (unsigned)S.rowmap[(u).pm * BM + _h * HALF + RA[_i]] * (unsigned)(K * 2) + (unsigned)(CA[_i] * 2); \
        else o[_h][_i] = voffA[_i] + (unsigned)(_h * (int)hstep); } } while (0)
    PG8_SETOFF(offC, cur);
#pragma unroll
    for (int _h = 0; _h < 2; ++_h) { offN[_h][0] = offC[_h][0]; offN[_h][1] = offC[_h][1]; }
    S.a_ready(cur);
    if constexpr (SP2) {
        PG8_STAGE(PG8_SB(0, 0), cB, voffB); PG8_STAGE(PG8_SB(0, 1), cB + hstep, voffB); PG8_STAGE(PG8_SA(0, 0), cA, offC[0]); PG8_STAGE(PG8_SA(0, 1), cA, offC[1]);
        if (wr == 1) PG8_BAR;
        PG8_WAIT_V(2); PG8_BAR;
        PG8_STAGE(PG8_SB(1, 0), cB + kstep, voffB); PG8_STAGE(PG8_SA(1, 0), cA + kstep, offC[0]); PG8_STAGE(PG8_SB(1, 1), cB + hstep + kstep, voffB);
        PG8_WAIT_V(6); PG8_BAR;
    } else {
        PG8_STAGE(PG8_SB(0, 0), cB, voffB); PG8_STAGE(PG8_SA(0, 0), cA, voffA); PG8_STAGE(PG8_SB(0, 1), cB + hstep, voffB); PG8_STAGE(PG8_SA(0, 1), cA + hstep, voffA);
        if (wr == 1) PG8_BAR;
        PG8_WAIT_V(4); PG8_BAR;
        PG8_STAGE(PG8_SB(1, 0), cB + kstep, voffB); PG8_STAGE(PG8_SA(1, 0), cA + kstep, voffA); PG8_STAGE(PG8_SB(1, 1), cB + hstep + kstep, voffB);
        PG8_WAIT_V(6); PG8_BAR;
    }
    for (;;) {
        const bool has_next = S.next(ui + 1, nxt);
        const char* nA = GATHER ? cA : (has_next ? (const char*)g.A + (size_t)nxt.pm * tstep : cA); const char* nB = has_next ? (const char*)g.Bt + (size_t)nxt.pn * tstep : cB;
        if constexpr (GATHER) { if (has_next) PG8_SETOFF(offN, nxt); }
        for (int t = 0; t < nt; t += 2) {
            const bool last = (t == nt - 2);
            const char* a1 = cA + (size_t)(t + 1) * kstep;
            const char* a2 = last ? nA : cA + (size_t)(t + 2) * kstep; const char* b2 = last ? nB : cB + (size_t)(t + 2) * kstep;
            const char* a3 = a2 + kstep; const char* b3 = b2 + kstep;
            if (last && has_next) S.a_ready(nxt);
            unsigned o2[2][2];
#pragma unroll
            for (int _h = 0; _h < 2; ++_h)
#pragma unroll
                for (int _i = 0; _i < 2; ++_i) o2[_h][_i] = (GATHER && last) ? offN[_h][_i] : offC[_h][_i];
            if constexpr (SP2) {
            PG8_LDB(B0, 0, 0); PG8_LDB(B1, 0, 1); PG8_SCHED; PG8_LDA(At, 0, 0); PG8_STAGE(PG8_SA(1, 1), a1, offC[1]);
            PG8_WAIT_V(8); PG8_WAIT_L(0); PG8_BAR; PG8_MMA(0, 0, At, B0); PG8_MMA(0, 1, At, B1); PG8_BAR; PG8_SCHED;
            PG8_LDA(At, 0, 1); PG8_STAGE(PG8_SB(0, 0), b2, voffB); PG8_STAGE(PG8_SB(0, 1), b2 + hstep, voffB); PG8_STAGE(PG8_SA(0, 0), a2, o2[0]);
            PG8_WAIT_V(8); PG8_WAIT_L(0); PG8_BAR; PG8_MMA(1, 0, At, B0); PG8_MMA(1, 1, At, B1); PG8_BAR; PG8_SCHED;
            PG8_LDB(B0, 1, 0); PG8_LDB(B1, 1, 1); PG8_SCHED; PG8_LDA(At, 1, 0); PG8_STAGE(PG8_SA(0, 1), a2, o2[1]);
            PG8_WAIT_V(8); PG8_WAIT_L(0); PG8_BAR; PG8_MMA(0, 0, At, B0); PG8_MMA(0, 1, At, B1); PG8_BAR; PG8_SCHED;
            PG8_LDA(At, 1, 1); PG8_STAGE(PG8_SB(1, 0), b3, voffB); PG8_STAGE(PG8_SB(1, 1), b3 + hstep, voffB); PG8_STAGE(PG8_SA(1, 0), a3, o2[0]);
            PG8_WAIT_V(8); PG8_WAIT_L(0); PG8_BAR; PG8_MMA(1, 0, At, B0); PG8_MMA(1, 1, At, B1); PG8_BAR; PG8_SCHED;
            } else {
            PG8_LDB(B0, 0, 0); PG8_SCHED; PG8_LDA(At, 0, 0); PG8_STAGE(PG8_SA(1, 1), a1 + hstep, voffA);
            PG8_WAIT_L(8); PG8_BAR; PG8_WAIT_L(0); PG8_MMA(0, 0, At, B0); PG8_BAR; PG8_SCHED;
            PG8_LDB(B1, 0, 1); PG8_STAGE(PG8_SB(0, 0), b2, voffB);
            PG8_BAR; PG8_WAIT_L(0); PG8_MMA(0, 1, At, B1); PG8_BAR;
            PG8_LDA(At, 0, 1); PG8_STAGE(PG8_SA(0, 0), a2, voffA);
            PG8_BAR; PG8_WAIT_L(0); PG8_MMA(1, 0, At, B0); PG8_BAR; PG8_SCHED;
            PG8_STAGE(PG8_SB(0, 1), b2 + hstep, voffB);
            PG8_WAIT_V(6); PG8_BAR; PG8_MMA(1, 1, At, B1); PG8_BAR;
            PG8_LDB(B0, 1, 0); PG8_SCHED; PG8_LDA(At, 1, 0); PG8_STAGE(PG8_SA(0, 1), a2 + hstep, voffA);
            PG8_WAIT_L(8); PG8_BAR; PG8_WAIT_L(0); PG8_MMA(0, 0, At, B0); PG8_BAR; PG8_SCHED;
            PG8_LDB(B1, 1, 1); PG8_STAGE(PG8_SB(1, 0), b3, voffB);
            PG8_BAR; PG8_WAIT_L(0); PG8_MMA(0, 1, At, B1); PG8_BAR;
            PG8_LDA(At, 1, 1); PG8_STAGE(PG8_SA(1, 0), a3, voffA);
            PG8_BAR; PG8_WAIT_L(0); PG8_MMA(1, 0, At, B0); PG8_BAR; PG8_SCHED;
            PG8_STAGE(PG8_SB(1, 1), b3 + hstep, voffB);
            PG8_WAIT_V(6); PG8_BAR; PG8_MMA(1, 1, At, B1); PG8_BAR;
            }
        }
        if constexpr (F8) asm volatile("s_nop 15\n\ts_nop 15" ::: "memory");
        if constexpr (ALIGN_EPI) { if (wr == 0) PG8_BAR; }
        if constexpr (!Epi::AFTER_DRAIN) { E(acc, cur, wr, wc, fr, fq); S.done(cur); }
        if (!has_next) break;
#pragma unroll
        for (int a = 0; a < 2; ++a)
#pragma unroll
            for (int b = 0; b < 2; ++b)
#pragma unroll
                for (int m = 0; m < 4; ++m)
#pragma unroll
                    for (int n = 0; n < 2; ++n) acc[a][b][m][n] = (f32x4){0.f, 0.f, 0.f, 0.f};
        cur = nxt; cA = nA; cB = nB; ++ui;
#pragma unroll
        for (int _h = 0; _h < 2; ++_h) { offC[_h][0] = offN[_h][0]; offC[_h][1] = offN[_h][1]; }
        if constexpr (ALIGN_EPI) { if (wr == 1) PG8_BAR; }
    }
    PG8_WAIT_V(0);
    if constexpr (!ALIGN_EPI) { if (wr == 0) PG8_BAR; }
    PG8_BAR;
    if constexpr (Epi::AFTER_DRAIN) { E.fused(acc, cur, wr, wc, fr, fq, lds, wid, lane); S.done(cur); }
#undef PG8_SETOFF
#undef PG8_SA
#undef PG8_SB
#undef PG8_STAGE
#undef PG8_LDA
#undef PG8_LDB
#undef PG8_MMA
#undef PG8_WAIT_V
#undef PG8_WAIT_L
#undef PG8_BAR
#undef PG8_SCHED
}
}

constexpr int D = 2048, BATCH = 4, SEQ = 4096, MTOK = BATCH * SEQ, DEPTH = 2;
constexpr int NIN = 6160, NPROJ = 6144;
constexpr int C_NAQ = 0, C_NAK = 1024, C_NAV = 2048, C_MLQ = 3072, C_MLK = 3584, C_MLV = 4096, C_MLO = 5120, C_GATES = 6144;
constexpr int NE = 16, CAP = 512, DE = 1024, MR = NE * BATCH * CAP;
constexpr float EPS = 1e-6f;

typedef unsigned short bf16;
typedef float f32x4 __attribute__((ext_vector_type(4)));
typedef unsigned v4u __attribute__((ext_vector_type(4)));
typedef unsigned v2u __attribute__((ext_vector_type(2)));
#define LAS __attribute__((address_space(3)))
typedef short bf16x8v __attribute__((ext_vector_type(8)));
typedef short s16x4 __attribute__((ext_vector_type(4)));
constexpr size_t WS_XB8 = 968 * (size_t)(1u << 20);
constexpr size_t WS_SSQ = 6 * (size_t)(1u << 20) + 512 * 1024;
constexpr size_t WS_RSNA = 7 * (size_t)(1u << 20) + 64 * 1024;
constexpr size_t WS_W16F_OFF = 7 * (1u << 20) + 256 * 1024;

constexpr size_t MiB = 1u << 20;
constexpr size_t WS_CTL = 0;
constexpr size_t WS_RSTD = 1 * MiB;
constexpr size_t WS_GATES = 2 * MiB;
constexpr size_t WS_AFF = 3 * MiB;
constexpr size_t WS_TOK = 4 * MiB;
constexpr size_t WS_GATEV = 4 * MiB + 512 * 1024;
constexpr size_t WS_SEL = 5 * MiB;
constexpr size_t WS_WIN = 8 * MiB;
constexpr size_t WS_WOUT = 56 * MiB;
constexpr size_t WS_WGU = 72 * MiB;
constexpr size_t WS_WD = 328 * MiB;
constexpr size_t WS_XB = 456 * MiB;
constexpr size_t WS_MIX = 520 * MiB;
constexpr size_t WS_P = 584 * MiB;
constexpr size_t WS_NAO = 776 * MiB;
constexpr size_t WS_HF = 840 * MiB;
constexpr size_t WS_ACT = 712 * MiB;
constexpr size_t WS_Y = 776 * MiB;
constexpr size_t WS_END = 1000 * MiB;

__device__ __forceinline__ unsigned f2bf(float f) { unsigned u = __builtin_bit_cast(unsigned, f); return (u + 0x7fffu + ((u >> 16) & 1u)) >> 16; }
__device__ __forceinline__ unsigned pk2(float lo, float hi) { return f2bf(lo) | (f2bf(hi) << 16); }
__device__ __forceinline__ float bf2f(unsigned short b) { return __builtin_bit_cast(float, ((unsigned)b) << 16); }
__device__ __forceinline__ float bflo(unsigned w) { return __builtin_bit_cast(float, w << 16); }
__device__ __forceinline__ float bfhi(unsigned w) { return __builtin_bit_cast(float, w & 0xffff0000u); }
__device__ __forceinline__ float wave_sum(float v) {
#pragma unroll
    for (int o = 1; o < 64; o <<= 1) v += __shfl_xor(v, o);
    return v;
}
__device__ __forceinline__ float wave_max(float v) {
#pragma unroll
    for (int o = 1; o < 64; o <<= 1) v = fmaxf(v, __shfl_xor(v, o));
    return v;
}

struct ConvItem { const float* W; const float* gk; bf16* WT; int ldw, K, k0, n0, dmode, f8; float wmul; };
__device__ __forceinline__ void ti_load(const ConvItem& d, int lane, f32x4 (&wv)[16]) {
    const int r4 = lane >> 4, c4 = (lane & 15) * 4;
#pragma unroll
    for (int i = 0; i < 16; ++i) wv[i] = *(const f32x4*)(d.W + (size_t)(d.k0 + 4 * i + r4) * d.ldw + d.n0 + c4);
}
__device__ __forceinline__ void ti_finish(const ConvItem& d, int lane, const f32x4 (&wv)[16], LAS float* scr) {
    const int r4 = lane >> 4, c4 = (lane & 15) * 4;
#pragma unroll
    for (int i = 0; i < 16; ++i) { const int kk = 4 * i + r4; const float gg = d.gk ? d.gk[d.k0 + kk] : 1.0f; LAS float* p = scr + kk * 65 + c4; p[0] = wv[i][0] * gg; p[1] = wv[i][1] * gg; p[2] = wv[i][2] * gg; p[3] = wv[i][3] * gg; }
    asm volatile("s_waitcnt lgkmcnt(0)" ::: "memory");
    const int c = lane & 7; const float wmul = d.wmul;
#pragma unroll
    for (int j = 0; j < 8; ++j) { const int n = (lane >> 3) + 8 * j; const LAS float* s = scr + (8 * c) * 65 + n;
        const int ng = d.n0 + n; const int drow = d.dmode == 0 ? ng : ((ng >> 4) * 32 + (ng & 15) + (d.dmode == 2 ? 16 : 0));
        if (d.f8) { v2u o8; int p = __builtin_amdgcn_cvt_pk_fp8_f32(s[0 * 65] * wmul, s[1 * 65] * wmul, 0, false); p = __builtin_amdgcn_cvt_pk_fp8_f32(s[2 * 65] * wmul, s[3 * 65] * wmul, p, true); o8.x = (unsigned)p;
            p = __builtin_amdgcn_cvt_pk_fp8_f32(s[4 * 65] * wmul, s[5 * 65] * wmul, 0, false); p = __builtin_amdgcn_cvt_pk_fp8_f32(s[6 * 65] * wmul, s[7 * 65] * wmul, p, true); o8.y = (unsigned)p;
            *(v2u*)((unsigned char*)d.WT + (size_t)drow * d.K + d.k0 + 8 * c) = o8; }
        else { v4u o; o.x = pk2(s[0 * 65], s[1 * 65]); o.y = pk2(s[2 * 65], s[3 * 65]); o.z = pk2(s[4 * 65], s[5 * 65]); o.w = pk2(s[6 * 65], s[7 * 65]);
            *(v4u*)(d.WT + (size_t)drow * d.K + d.k0 + 8 * c) = o; } }
    asm volatile("s_waitcnt lgkmcnt(0)" ::: "memory");
}
constexpr int CONV_SCR_BYTES = 64 * 65 * 4;
constexpr float Y8_SCALE = 16.0f;
typedef float f32x2 __attribute__((ext_vector_type(2)));
constexpr int NPROJ16 = 5120;
constexpr float W8_SCALE = 64.0f;
struct ConvArgs { const float *w_in, *w_out, *w_gate, *w_up, *w_down, *norm_mix_g, *norm_ffn_g, *na_norm_g; unsigned char* ws; };
constexpr int CI_IN = 32 * 96, CI_OUT = 32 * 32, CI_G = 16 * 32 * 16, CI_D = 16 * 16 * 32, CI_LAYER = CI_IN + CI_OUT + 2 * CI_G + CI_D;
__device__ __forceinline__ ConvItem convert_decode(const ConvArgs& a, int it) {
    ConvItem d; d.f8 = 0; d.wmul = 1.0f; d.gk = nullptr; d.dmode = 0; d.K = D;
    const int l = it / CI_LAYER; int r = it % CI_LAYER;
    if (r < CI_IN) { const int kb = r / 96, nb = r % 96; d.ldw = NIN; d.gk = a.norm_mix_g + l * D; d.k0 = 64 * kb;
        if (64 * nb < NPROJ16) { d.W = a.w_in + (size_t)l * D * NIN; d.WT = (bf16*)(a.ws + WS_WIN) + (size_t)l * NPROJ * D; d.n0 = 64 * nb; }
        else { d.W = a.w_in + (size_t)l * D * NIN + NPROJ16; d.WT = (bf16*)(a.ws + WS_WIN + ((size_t)l * NPROJ + NPROJ16) * D * 2); d.n0 = 64 * nb - NPROJ16; d.f8 = 1; d.wmul = W8_SCALE; }
        return d; }
    r -= CI_IN;
    if (r < CI_OUT) { const int kb = r / 32, nb = r % 32; d.W = a.w_out + (size_t)l * D * D; d.ldw = D; if (64 * kb < 1024) d.gk = a.na_norm_g + l * 1024;
        d.WT = (bf16*)(a.ws + WS_WOUT) + (size_t)l * D * D; d.k0 = 64 * kb; d.n0 = 64 * nb; return d; }
    r -= CI_OUT;
    if (r < 2 * CI_G) { const int up = r >= CI_G; if (up) r -= CI_G; const int e = r / 512, q = r % 512, kb = q / 16, nb = q % 16;
        d.W = (up ? a.w_up : a.w_gate) + ((size_t)l * NE + e) * D * DE; d.ldw = DE; d.gk = a.norm_ffn_g + l * D; d.WT = (bf16*)(a.ws + WS_WGU + ((size_t)l * NE + e) * 2048 * D); d.k0 = 64 * kb; d.n0 = 64 * nb; d.dmode = up ? 2 : 1; d.f8 = 1; d.wmul = W8_SCALE; return d; }
    r -= 2 * CI_G;
    { const int e = r / 512, q = r % 512, kb = q / 32, nb = q % 32; d.W = a.w_down + ((size_t)l * NE + e) * DE * D; d.ldw = D; d.WT = (bf16*)(a.ws + WS_WD + ((size_t)l * NE + e) * D * DE); d.K = DE; d.k0 = 64 * kb; d.n0 = 64 * nb; d.f8 = 1; d.wmul = W8_SCALE; return d; }
}
__device__ __forceinline__ void convert_stream(const ConvArgs& a, int first, int stride, int end, LAS float* scr, int lane) {
    if (first >= end) return;
    f32x4 w0[16], w1[16]; ConvItem d0 = convert_decode(a, first), d1 = d0; ti_load(d0, lane, w0);
#pragma unroll 1
    for (int it = first; it < end; it += stride) { const bool hn = it + stride < end;
        if (hn) { d1 = convert_decode(a, it + stride); ti_load(d1, lane, w1); }
        ti_finish(d0, lane, w0, scr);
        d0 = d1;
#pragma unroll
        for (int i = 0; i < 16; ++i) w0[i] = w1[i]; }
}

#define XB_TMO      128
#define XB_XCNT(j)  (256  + 64 * (j))
#define XB_XSUB(j)  (1280 + 64 * (j))
#define XB_XGEN(j)  (2304 + 64 * (j))
#define XB_TOP      3328
#define XB_TOPGEN   3392
#define XCD_BAR_WORDS 3456
#define XB_SPIN_CAP (1u << 18)

__device__ __forceinline__ unsigned xb_ld(unsigned* p)              { return __hip_atomic_load(p, __ATOMIC_RELAXED, __HIP_MEMORY_SCOPE_AGENT); }
__device__ __forceinline__ unsigned xb_add(unsigned* p, unsigned v) { return __hip_atomic_fetch_add(p, v, __ATOMIC_RELAXED, __HIP_MEMORY_SCOPE_AGENT); }
__device__ __forceinline__ unsigned xb_xcc_id() { return (unsigned)__builtin_amdgcn_s_getreg((3 << 11) | 20) & 0xFu; }
#define XB_SPIN(cond, bar) do { unsigned _sp = 0; while (cond) { __builtin_amdgcn_s_sleep(1); \
    if ((++_sp & 255u) == 0u) { if (xb_ld(&(bar)[XB_TMO])) break; if (_sp > XB_SPIN_CAP) { atomicAdd(&(bar)[XB_TMO], 1u); break; } } } } while (0)

struct XcdBarrier {
    unsigned* bar; unsigned x;
    volatile LAS unsigned* st;
};

__device__ __forceinline__ XcdBarrier xcd_barrier_post(unsigned* bar, volatile LAS unsigned* st) {
    XcdBarrier b; b.bar = bar; b.x = xb_xcc_id(); b.st = st;
    if (threadIdx.x == 0) (void)xb_add(&bar[XB_XCNT(b.x)], 1u);
    return b;
}
__device__ __forceinline__ void xcd_barrier_complete(unsigned* bar, unsigned x, unsigned& nloc, unsigned& nx) {
    const unsigned G = gridDim.x * gridDim.y * gridDim.z;
    unsigned sum, cnt, mine, sp = 0u;
    for (;;) {
        sum = 0u; cnt = 0u; mine = 0u;
#pragma unroll
        for (unsigned j = 0; j < 16; ++j) { const unsigned c = xb_ld(&bar[XB_XCNT(j)]); sum += c; cnt += (c > 0u) ? 1u : 0u; mine = (j == x) ? c : mine; }
        if (sum == G) break;
        __builtin_amdgcn_s_sleep(1);
        if ((++sp & 255u) == 0u) { if (xb_ld(&bar[XB_TMO])) break; if (sp > XB_SPIN_CAP) { atomicAdd(&bar[XB_TMO], 1u); break; } }
    }
    nloc = mine > 0u ? mine : 1u; nx = cnt > 0u ? cnt : 1u;
}

__device__ __forceinline__ void xcd_barrier(const XcdBarrier& b) {
    asm volatile("s_waitcnt vmcnt(0)" ::: "memory");
    __syncthreads();
    if (threadIdx.x == 0) {
        unsigned* bar = b.bar;
        __builtin_amdgcn_s_waitcnt(0);
        unsigned nloc = b.st[0], nx = b.st[1];
        if (nloc == 0u) { xcd_barrier_complete(bar, b.x, nloc, nx); b.st[0] = nloc; b.st[1] = nx; }
        const unsigned old = xb_add(&bar[XB_XSUB(b.x)], 1u);
        const unsigned gen = old / nloc;
        if (old + 1u == (gen + 1u) * nloc) {
            __builtin_amdgcn_fence(__ATOMIC_RELEASE, "agent");
            asm volatile("s_waitcnt vmcnt(0)" ::: "memory");
            const unsigned og = xb_add(&bar[XB_TOP], 1u);
            const unsigned tg = og / nx;
            if (og + 1u == (tg + 1u) * nx) xb_add(&bar[XB_TOPGEN], 1u);
            else XB_SPIN(xb_ld(&bar[XB_TOPGEN]) == tg, bar);
            __builtin_amdgcn_fence(__ATOMIC_ACQUIRE, "agent");
            xb_add(&bar[XB_XGEN(b.x)], 1u);
            asm volatile("s_waitcnt vmcnt(0)" ::: "memory");
        } else {
            XB_SPIN(xb_ld(&bar[XB_XGEN(b.x)]) == gen, bar);
            __builtin_amdgcn_fence(__ATOMIC_ACQUIRE, "agent");
            asm volatile("s_waitcnt vmcnt(0)" ::: "memory");
        }
    }
    __syncthreads();
}

struct RowArgs { const float* src32; const bf16* srcb; const int* sel; const unsigned char* Y; bf16* XB; unsigned char* XB8; float* RSTD; const float* g; const bf16* W16F; const float* bias; float* GATES; float* AFF; float* out; int mode; int wrxb; };
__device__ __forceinline__ void rowpass_finish(const RowArgs& a, int row, int rr, int s0, int s1, f32x4 (&v)[8], int lane) {
    const int b = row / SEQ;
    if (a.sel) {
        const int sw = rr < 4 ? s0 : s1;
        for (int e = 0; e < NE; ++e) { const int c = __builtin_amdgcn_readlane(sw, ((rr & 3) << 4) + e);
            if (c >= 0) { const unsigned char* y = a.Y + (size_t)(e * 2048 + b * 512 + c) * D + 4 * lane;
#pragma unroll
                for (int j = 0; j < 8; ++j) { const int w = *(const int*)(y + 256 * j); const f32x2 lo = __builtin_amdgcn_cvt_pk_f32_fp8(w, false), hi = __builtin_amdgcn_cvt_pk_f32_fp8(w, true);
                    v[j][0] += lo[0] * (1.0f / Y8_SCALE); v[j][1] += lo[1] * (1.0f / Y8_SCALE); v[j][2] += hi[0] * (1.0f / Y8_SCALE); v[j][3] += hi[1] * (1.0f / Y8_SCALE); } } }
    }
    float ss = 0.f;
#pragma unroll
    for (int j = 0; j < 8; ++j) ss += (v[j][0] * v[j][0] + v[j][1] * v[j][1]) + (v[j][2] * v[j][2] + v[j][3] * v[j][3]);
    ss = wave_sum(ss);
    const float rstd = 1.0f / sqrtf(ss * (1.0f / D) + EPS);
    if (a.mode == 2) {
#pragma unroll
        for (int j = 0; j < 8; ++j) { const f32x4 g = *(const f32x4*)(a.g + 4 * lane + 256 * j); *(f32x4*)(a.out + (size_t)row * D + 4 * lane + 256 * j) = v[j] * rstd * g; }
        return;
    }
    if (a.wrxb) {
#pragma unroll
        for (int j = 0; j < 8; ++j) { v2u w; w.x = pk2(v[j][0], v[j][1]); w.y = pk2(v[j][2], v[j][3]); *(v2u*)(a.XB + (size_t)row * D + 4 * lane + 256 * j) = w; } }
    if (a.XB8) {
#pragma unroll
        for (int j = 0; j < 8; ++j) *(unsigned*)(a.XB8 + (size_t)row * D + 4 * lane + 256 * j) = pg8::pk4_fp8(v[j][0], v[j][1], v[j][2], v[j][3]); }
    if (lane == 0) a.RSTD[row] = rstd;
}
template <bool SRC32> __device__ __forceinline__ void rowpass_group(const RowArgs& a, int grp, int lane_) {
    int lane = lane_; asm volatile("" : "+v"(lane));
    int s0 = -1, s1 = -1; if (a.sel) { s0 = a.sel[grp * 128 + lane]; s1 = a.sel[grp * 128 + 64 + lane]; }
    f32x4 v[8];
    if constexpr (SRC32) {
        f32x4 vn[8];
#pragma unroll
        for (int j = 0; j < 8; ++j) v[j] = *(const f32x4*)(a.src32 + (size_t)(8 * grp) * D + 4 * lane + 256 * j);
#pragma unroll 1
        for (int rr = 0; rr < 8; ++rr) { const int row = 8 * grp + rr;
            if (rr < 7) {
#pragma unroll
                for (int j = 0; j < 8; ++j) vn[j] = *(const f32x4*)(a.src32 + (size_t)(row + 1) * D + 4 * lane + 256 * j); }
            rowpass_finish(a, row, rr, s0, s1, v, lane);
#pragma unroll
            for (int j = 0; j < 8; ++j) v[j] = vn[j]; }
    } else {
        v2u w[8], wn[8];
#pragma unroll
        for (int j = 0; j < 8; ++j) w[j] = *(const v2u*)(a.srcb + (size_t)(8 * grp) * D + 4 * lane + 256 * j);
#pragma unroll 1
        for (int rr = 0; rr < 8; ++rr) { const int row = 8 * grp + rr;
            if (rr < 7) {
#pragma unroll
                for (int j = 0; j < 8; ++j) wn[j] = *(const v2u*)(a.srcb + (size_t)(row + 1) * D + 4 * lane + 256 * j); }
#pragma unroll
            for (int j = 0; j < 8; ++j) v[j] = (f32x4){bflo(w[j].x), bfhi(w[j].x), bflo(w[j].y), bfhi(w[j].y)};
            rowpass_finish(a, row, rr, s0, s1, v, lane);
#pragma unroll
            for (int j = 0; j < 8; ++j) w[j] = wn[j]; }
    }
    if (a.mode == 2) return;
    asm volatile("s_waitcnt vmcnt(0)" ::: "memory");
    const int g = lane >> 4, lc = lane & 15;
    f32x4 acc = (f32x4){0.f, 0.f, 0.f, 0.f};
    const bf16* xr = a.XB + (size_t)(8 * grp + (lc & 7)) * D + 8 * g; const bf16* wf = a.W16F + lane * 8;
#pragma unroll 8
    for (int s = 0; s < 64; ++s) { bf16x8v af = *(const bf16x8v*)(xr + 32 * s); if (lc >= 8) af = (bf16x8v){0, 0, 0, 0, 0, 0, 0, 0};
        const bf16x8v bf = *(const bf16x8v*)(wf + s * 512); acc = __builtin_amdgcn_mfma_f32_16x16x32_bf16(af, bf, acc, 0, 0, 0); }
    float rs[4];
#pragma unroll
    for (int r = 0; r < 4; ++r) rs[r] = a.RSTD[8 * grp + 4 * (g & 1) + r];
    if (a.mode == 0) { const float bs = a.bias[lc];
#pragma unroll
        for (int r = 0; r < 4; ++r) { const float rstd = rs[r]; if (g < 2) a.GATES[(size_t)(8 * grp + 4 * g + r) * 16 + lc] = acc[r] * rstd + bs; } }
    else {
#pragma unroll
        for (int r = 0; r < 4; ++r) { const float rstd = rs[r]; const float lg = acc[r] * rstd; float mx = lg;
#pragma unroll
            for (int o = 1; o < 16; o <<= 1) mx = fmaxf(mx, __shfl_xor(mx, o));
            const float p = __expf(lg - mx); float sum = p;
#pragma unroll
            for (int o = 1; o < 16; o <<= 1) sum += __shfl_xor(sum, o);
            const int row = 8 * grp + 4 * g + r; if (g < 2) a.AFF[((size_t)(row / SEQ) * NE + lc) * SEQ + (row % SEQ)] = p / sum; } }
}
__device__ __forceinline__ void w16f_item(const float* W, int ldw, const float* gk, bf16* WF, int s, int lane) {
    const int g = lane >> 4, lc = lane & 15; float v[8];
#pragma unroll
    for (int i = 0; i < 8; ++i) { const int k = 32 * s + 8 * g + i; v[i] = W[(size_t)k * ldw + lc] * gk[k]; }
    v4u o; o.x = pk2(v[0], v[1]); o.y = pk2(v[2], v[3]); o.z = pk2(v[4], v[5]); o.w = pk2(v[6], v[7]);
    *(v4u*)(WF + (size_t)(s * 64 + lane) * 8) = o;
}

__device__ __forceinline__ void na_norm_item(const bf16* NAO, const float* g, bf16* MIX, int t, int lane) {
    f32x4 v[4]; float ss = 0.f;
#pragma unroll
    for (int j = 0; j < 4; ++j) { const v2u w = *(const v2u*)(NAO + (size_t)t * 1024 + 4 * lane + 256 * j); v[j] = (f32x4){bflo(w.x), bfhi(w.x), bflo(w.y), bfhi(w.y)}; ss += (v[j][0] * v[j][0] + v[j][1] * v[j][1]) + (v[j][2] * v[j][2] + v[j][3] * v[j][3]); }
    const float rstd = 1.0f / sqrtf(wave_sum(ss) * (1.0f / 1024.0f) + EPS);
#pragma unroll
    for (int j = 0; j < 4; ++j) { const f32x4 gg = *(const f32x4*)(g + 4 * lane + 256 * j); const f32x4 o = v[j] * rstd * gg; v2u w; w.x = pk2(o[0], o[1]); w.y = pk2(o[2], o[3]);
        *(v2u*)(MIX + (size_t)t * D + 4 * lane + 256 * j) = w; }
}

__device__ __forceinline__ int block_sum_512(int v, LAS int* red, int wave, int lane) {
#pragma unroll
    for (int o = 1; o < 64; o <<= 1) v += __shfl_xor(v, o);
    __syncthreads();
    if (lane == 0) red[wave] = v;
    __syncthreads();
    int s = 0;
#pragma unroll
    for (int w = 0; w < 8; ++w) s += red[w];
    return s;
}
__device__ __forceinline__ int block_excl_scan_512(int v, LAS int* red, int wave, int lane) {
    int inc = v;
#pragma unroll
    for (int o = 1; o < 64; o <<= 1) { const int t = __shfl_up(inc, o); if (lane >= o) inc += t; }
    __syncthreads();
    if (lane == 63) red[wave] = inc;
    __syncthreads();
    int base = 0;
#pragma unroll
    for (int w = 0; w < 8; ++w) base += (w < wave) ? red[w] : 0;
    return base + inc - v;
}
__device__ __forceinline__ void topk_unit(int be, const float* AFF, int* TOK, float* GATEV, int* SEL, LAS int* red) {
    int tid_ = threadIdx.x; asm volatile("" : "+v"(tid_)); const int tid = tid_, lane = tid & 63, wave = tid >> 6;
    const int b = be >> 4, e = be & 15;
    const float* a = AFF + (size_t)be * SEQ + tid * 8;
    const f32x4 a0 = *(const f32x4*)a, a1 = *(const f32x4*)(a + 4);
    unsigned key[8] = {__float_as_uint(a0.x), __float_as_uint(a0.y), __float_as_uint(a0.z), __float_as_uint(a0.w),
                       __float_as_uint(a1.x), __float_as_uint(a1.y), __float_as_uint(a1.z), __float_as_uint(a1.w)};
    LAS int* hist = red + 16;
    unsigned T = 0u; int need = CAP;
#pragma unroll 1
    for (int pass = 0; pass < 4; ++pass) { const int shift = 24 - 8 * pass; const unsigned mhi = pass == 0 ? 0u : (0xFFFFFFFFu << (shift + 8));
        __syncthreads();
        if (tid < 256) hist[tid] = 0;
        __syncthreads();
#pragma unroll
        for (int i = 0; i < 8; ++i) if ((key[i] & mhi) == T) (void)__hip_atomic_fetch_add(&hist[(key[i] >> shift) & 255u], 1, __ATOMIC_RELAXED, __HIP_MEMORY_SCOPE_WORKGROUP);
        __syncthreads();
        if (wave == 0) { const int c0 = hist[4 * lane], c1 = hist[4 * lane + 1], c2 = hist[4 * lane + 2], c3 = hist[4 * lane + 3]; const int t = c0 + c1 + c2 + c3; int inc = t;
#pragma unroll
            for (int o = 1; o < 64; o <<= 1) { const int v = __shfl_down(inc, o); if (lane + o < 64) inc += v; }
            const int ab3 = inc - t, ab2 = ab3 + c3, ab1 = ab2 + c2, ab0 = ab1 + c1;
            if (ab3 < need && need <= ab3 + c3) { red[8] = 4 * lane + 3; red[9] = ab3; }
            if (ab2 < need && need <= ab2 + c2) { red[8] = 4 * lane + 2; red[9] = ab2; }
            if (ab1 < need && need <= ab1 + c1) { red[8] = 4 * lane + 1; red[9] = ab1; }
            if (ab0 < need && need <= ab0 + c0) { red[8] = 4 * lane + 0; red[9] = ab0; } }
        __syncthreads();
        T |= (unsigned)red[8] << shift; need -= red[9]; }
    int ceq = 0;
#pragma unroll
    for (int i = 0; i < 8; ++i) ceq += key[i] == T ? 1 : 0;
    const int need_eq = need;
    int eqrank = block_excl_scan_512(ceq, red, wave, lane);
    int selm = 0, csel = 0;
#pragma unroll
    for (int i = 0; i < 8; ++i) { bool sel = key[i] > T; if (key[i] == T) { sel = eqrank < need_eq; ++eqrank; } if (sel) { selm |= 1 << i; ++csel; } }
    int slot = block_excl_scan_512(csel, red, wave, lane);
#pragma unroll
    for (int i = 0; i < 8; ++i) { const int sidx = tid * 8 + i; const int tok = b * SEQ + sidx;
        if (selm & (1 << i)) { const int R = e * 2048 + b * 512 + slot; TOK[R] = tok; GATEV[R] = __uint_as_float(key[i]); SEL[tok * 16 + e] = slot; ++slot; }
        else SEL[tok * 16 + e] = -1; }
    __syncthreads();
}

typedef short bf16x8v __attribute__((ext_vector_type(8)));
typedef short s16x4 __attribute__((ext_vector_type(4)));
constexpr int ML_L = 128, ML_NC = SEQ / ML_L;
constexpr int KP = 272, VP = 528;
constexpr int ML_T0 = 0, ML_T1 = 128 * KP, ML_V = 2 * 128 * KP;
constexpr int ML_AR = ML_V + 128 * VP;
constexpr int ML_END = ML_AR + 24 * 512;
static_assert(ML_AR % 16 == 0, "LDS map");
constexpr size_t WS_UC = WS_HF;
constexpr size_t WS_NU = 6 * MiB;
constexpr size_t WS_SC = 7 * MiB;

__device__ __forceinline__ s16x4 lds_tr(LAS unsigned char* p) { return __builtin_amdgcn_ds_read_tr16_b64_v4i16((LAS s16x4*)p); }
__device__ __forceinline__ bf16x8v frag_tr(LAS unsigned char* tile, int pitch, int k0, int n0, int lane) {
    const int g = lane >> 4, q = (lane & 15) >> 2, p = lane & 3;
    LAS unsigned char* a = tile + (k0 + 8 * g + q) * pitch + (n0 + 4 * p) * 2;
    const s16x4 lo = lds_tr(a), hi = lds_tr(a + 4 * pitch);
    return (bf16x8v){lo[0], lo[1], lo[2], lo[3], hi[0], hi[1], hi[2], hi[3]};
}
__device__ __forceinline__ bf16x8v frag_row(LAS unsigned char* tile, int pitch, int m0, int k0, int lane) {
    return *(LAS bf16x8v*)(tile + (m0 + (lane & 15)) * pitch + (k0 + 8 * (lane >> 4)) * 2);
}
__device__ __forceinline__ float log_sigmoid_f(float f) { return fminf(f, 0.f) - log1pf(__expf(-fabsf(f))); }
__device__ __forceinline__ float shfl_up_f(float v, int o, int lane, float ident) { const float t = __shfl_up(v, o); return lane >= o ? t : ident; }

__device__ __forceinline__ void chunk_gates(const float* GATES, int t0, int h, int dir, int lane, int& s0, int& s1, float& i0, float& i1, float& b0, float& b1, float& btot) {
    const int p0 = 2 * lane, p1 = p0 + 1; s0 = dir ? 127 - p0 : p0; s1 = dir ? 127 - p1 : p1;
    const int icol = dir * 8 + h, fcol = icol + 4;
    const float* gp = GATES + (size_t)t0 * 16;
    const float f0 = log_sigmoid_f(gp[s0 * 16 + fcol]), f1 = log_sigmoid_f(gp[s1 * 16 + fcol]);
    i0 = gp[s0 * 16 + icol]; i1 = gp[s1 * 16 + icol];
    const float s = f0 + f1; float inc = s;
#pragma unroll
    for (int o = 1; o < 64; o <<= 1) inc += shfl_up_f(inc, o, lane, 0.f);
    const float excl = inc - s; b0 = excl + f0; b1 = excl + s; btot = __shfl(inc, 63);
}


__device__ __forceinline__ void conv_chunk4(const bf16* P, const float* cw, const float* cb, int b, int sq0, int chan0, float (&o)[4][8]) {
    const bf16* pc = P + ((size_t)b * SEQ + sq0) * NPROJ + C_MLQ + chan0;
    v4u w[8];
#pragma unroll
    for (int j = 0; j < 8; ++j) { const int ss = sq0 + j - 2; w[j] = (ss >= 0 && ss < SEQ) ? *(const v4u*)(pc + (ptrdiff_t)(j - 2) * NPROJ) : (v4u){0u, 0u, 0u, 0u}; }
    const f32x4 b0 = *(const f32x4*)(cb + chan0), b1 = *(const f32x4*)(cb + chan0 + 4);
#pragma unroll
    for (int t = 0; t < 4; ++t) { o[t][0] = b0[0]; o[t][1] = b0[1]; o[t][2] = b0[2]; o[t][3] = b0[3]; o[t][4] = b1[0]; o[t][5] = b1[1]; o[t][6] = b1[2]; o[t][7] = b1[3]; }
#pragma unroll
    for (int j = 0; j < 5; ++j) { const f32x4 c0 = *(const f32x4*)(cw + j * 1024 + chan0), c1 = *(const f32x4*)(cw + j * 1024 + chan0 + 4);
#pragma unroll
        for (int t = 0; t < 4; ++t) { const v4u x = w[t + j];
            o[t][0] += c0[0] * bflo(x.x); o[t][1] += c0[1] * bfhi(x.x); o[t][2] += c0[2] * bflo(x.y); o[t][3] += c0[3] * bfhi(x.y);
            o[t][4] += c1[0] * bflo(x.z); o[t][5] += c1[1] * bfhi(x.z); o[t][6] += c1[2] * bflo(x.w); o[t][7] += c1[3] * bfhi(x.w); } }
#pragma unroll
    for (int t = 0; t < 4; ++t)
#pragma unroll
        for (int i = 0; i < 8; ++i) o[t][i] = o[t][i] / (1.0f + __expf(-o[t][i]));
}

__device__ __forceinline__ void mlstm_m1_unit(int u, const float* cw, const float* cb, const bf16* P, const float* GATES, bf16* UC, float* NU, float* SC, LAS unsigned char* lds, int tid_, int wave) {
    int tid = tid_; asm volatile("" : "+v"(tid)); const int lane = tid & 63;
    const int c = u & 31, h = (u >> 5) & 3, b = u >> 7; const int t0 = b * SEQ + c * ML_L;
    LAS float* WK = (LAS float*)(lds + ML_AR);
    LAS float* NRED = WK + 256;
    __syncthreads();
    if (wave < 2) { const int dir = wave; int s0, s1; float i0, i1, b0, b1, btot;
        chunk_gates(GATES, t0, h, dir, lane, s0, s1, i0, i1, b0, b1, btot);
        const float g0 = btot - b0 + i0, g1 = btot - b1 + i1; const float mloc = wave_max(fmaxf(g0, g1));
        WK[dir * 128 + s0] = __expf(g0 - mloc); WK[dir * 128 + s1] = __expf(g1 - mloc);
        if (lane == 0) { float* sc = SC + (size_t)((((b * 4 + h) * 2 + dir) * 32) + c) * 4; sc[0] = btot; sc[1] = mloc; } }
#pragma unroll
    for (int i = 0; i < 8; ++i) { const int id = tid + 512 * i, s = id >> 5, ch = id & 31;
        *(LAS v4u*)(lds + ML_V + s * VP + ch * 16) = *(const v4u*)(P + (size_t)(t0 + s) * NPROJ + C_MLV + h * 256 + ch * 8); }
    float k4[4][8]; conv_chunk4(P, cw, cb, b, c * ML_L + 4 * (tid >> 4), 512 + h * 128 + (tid & 15) * 8, k4);
    __syncthreads();
    { float nf[8], nb[8];
#pragma unroll
      for (int j = 0; j < 8; ++j) { nf[j] = 0.f; nb[j] = 0.f; }
#pragma unroll
      for (int i = 0; i < 4; ++i) { const int s = 4 * (tid >> 4) + i, ch = tid & 15; const float (&k)[8] = k4[i];
        const float wf = WK[s], wb = WK[128 + s];
        v4u of, ob; of.x = pk2(k[0] * wf, k[1] * wf); of.y = pk2(k[2] * wf, k[3] * wf); of.z = pk2(k[4] * wf, k[5] * wf); of.w = pk2(k[6] * wf, k[7] * wf);
        ob.x = pk2(k[0] * wb, k[1] * wb); ob.y = pk2(k[2] * wb, k[3] * wb); ob.z = pk2(k[4] * wb, k[5] * wb); ob.w = pk2(k[6] * wb, k[7] * wb);
        *(LAS v4u*)(lds + ML_T0 + s * KP + ch * 16) = of; *(LAS v4u*)(lds + ML_T1 + s * KP + ch * 16) = ob;
#pragma unroll
        for (int j = 0; j < 8; ++j) { nf[j] += k[j] * wf; nb[j] += k[j] * wb; } }
#pragma unroll
      for (int j = 0; j < 8; ++j) { nf[j] += __shfl_xor(nf[j], 16); nf[j] += __shfl_xor(nf[j], 32); nb[j] += __shfl_xor(nb[j], 16); nb[j] += __shfl_xor(nb[j], 32); }
      if ((lane >> 4) == 0) {
#pragma unroll
          for (int j = 0; j < 8; ++j) { NRED[wave * 256 + (lane & 15) * 8 + j] = nf[j]; NRED[wave * 256 + 128 + (lane & 15) * 8 + j] = nb[j]; } } }
    __syncthreads();
    if (tid < 256) { const int dir = tid >> 7, d = tid & 127; float sum = 0.f;
#pragma unroll
        for (int w = 0; w < 8; ++w) sum += NRED[w * 256 + tid];
        NU[(size_t)((((b * 4 + h) * 2 + dir) * 32) + c) * 128 + d] = sum; }
    const int g = lane >> 4;
#pragma unroll 1
    for (int dir = 0; dir < 2; ++dir) {
        LAS unsigned char* Kt = lds + (dir ? ML_T1 : ML_T0);
        f32x4 acc[8][2];
#pragma unroll
        for (int mb = 0; mb < 8; ++mb) { acc[mb][0] = (f32x4){0.f, 0.f, 0.f, 0.f}; acc[mb][1] = (f32x4){0.f, 0.f, 0.f, 0.f}; }
#pragma unroll
        for (int ks = 0; ks < 4; ++ks) {
            const bf16x8v b0 = frag_tr(lds + ML_V, VP, 32 * ks, 32 * wave, lane), b1 = frag_tr(lds + ML_V, VP, 32 * ks, 32 * wave + 16, lane);
#pragma unroll
            for (int mb = 0; mb < 8; ++mb) { const bf16x8v a = frag_tr(Kt, KP, 32 * ks, 16 * mb, lane);
                acc[mb][0] = __builtin_amdgcn_mfma_f32_16x16x32_bf16(a, b0, acc[mb][0], 0, 0, 0); acc[mb][1] = __builtin_amdgcn_mfma_f32_16x16x32_bf16(a, b1, acc[mb][1], 0, 0, 0); } }
        bf16* uc = UC + (size_t)((((b * 4 + h) * 2 + dir) * 32) + c) * 32768;
#pragma unroll
        for (int mb = 0; mb < 8; ++mb)
#pragma unroll
            for (int nb = 0; nb < 2; ++nb) { const int e = 32 * wave + 16 * nb + (lane & 15), d0 = 16 * mb + 4 * g; v2u w; w.x = pk2(acc[mb][nb][0], acc[mb][nb][1]); w.y = pk2(acc[mb][nb][2], acc[mb][nb][3]);
                *(v2u*)(uc + e * 128 + d0) = w; }
    }
}

__device__ __forceinline__ void mlstm_m2(bf16* UC, float* NU, float* SC, int gtid, int nthreads) {
    for (int vid = gtid; vid < 32 * 4096; vid += nthreads) { const int chain = vid >> 12, within = vid & 4095, dir = chain & 1;
        float st[8]; float m = 0.f;
#pragma unroll
        for (int i = 0; i < 8; ++i) st[i] = 0.f;
#pragma unroll 4
        for (int step = 0; step < ML_NC; ++step) { const int c = dir ? ML_NC - 1 - step : step;
            float* sc = SC + (size_t)(chain * 32 + c) * 4; const float btot = sc[0], mloc = sc[1];
            v4u* p = (v4u*)(UC + ((size_t)(chain * 32 + c) * 4096 + within) * 8);
            const v4u uw = *p;
            v4u cw; cw.x = pk2(st[0], st[1]); cw.y = pk2(st[2], st[3]); cw.z = pk2(st[4], st[5]); cw.w = pk2(st[6], st[7]);
            *p = cw;
            if (within == 0) sc[2] = m;
            const float mn = fmaxf(btot + m, mloc), dC = __expf(btot + m - mn), dU = __expf(mloc - mn);
            const float uu[8] = {bflo(uw.x), bfhi(uw.x), bflo(uw.y), bfhi(uw.y), bflo(uw.z), bfhi(uw.z), bflo(uw.w), bfhi(uw.w)};
#pragma unroll
            for (int i = 0; i < 8; ++i) st[i] = dC * st[i] + dU * uu[i];
            m = mn; } }
    for (int nid = gtid; nid < 32 * 128; nid += nthreads) { const int chain = nid >> 7, d = nid & 127, dir = chain & 1; float st = 0.f, m = 0.f;
        for (int step = 0; step < ML_NC; ++step) { const int c = dir ? ML_NC - 1 - step : step;
            const float* sc = SC + (size_t)(chain * 32 + c) * 4; const float btot = sc[0], mloc = sc[1];
            float* p = NU + (size_t)(chain * 32 + c) * 128 + d; const float uu = *p; *p = st;
            const float mn = fmaxf(btot + m, mloc); st = __expf(btot + m - mn) * st + __expf(mloc - mn) * uu; m = mn; } }
}

__device__ __forceinline__ void mlstm_m3_unit(int u, const float* cw, const float* cb, const bf16* P, const float* GATES, const bf16* UC, const float* NU, const float* SC, const float* mlg, const float* RSNA, bf16* MIX, LAS unsigned char* lds, int tid_, int wave) {
    int tid = tid_; asm volatile("" : "+v"(tid)); const int lane = tid & 63;
    const int c = u & 31, h = (u >> 5) & 3, b = u >> 7; const int t0 = b * SEQ + c * ML_L;
    LAS float* AR = (LAS float*)(lds + ML_AR);
    LAS float* CS = AR; LAS float* RR = AR + 256; LAS float* INTER = AR + 512; LAS float* EM = AR + 768; LAS float* ALPHA = AR + 1024; LAS float* SS = AR + 1280;
    const int g = lane >> 4, lc = lane & 15;
    const int chain0 = (b * 4 + h) * 2;
    __syncthreads();
    if (wave < 2) { const int dir = wave; int s0, s1; float i0, i1, b0, b1, btot;
        chunk_gates(GATES, t0, h, dir, lane, s0, s1, i0, i1, b0, b1, btot);
        const float cs0 = i0 - b0, cs1 = i1 - b1;
        float pmx = fmaxf(cs0, cs1);
#pragma unroll
        for (int o = 1; o < 64; o <<= 1) pmx = fmaxf(pmx, shfl_up_f(pmx, o, lane, -3.0e38f));
        const float ex = shfl_up_f(pmx, 1, lane, -3.0e38f);
        const float pm0 = fmaxf(ex, cs0), pm1 = fmaxf(pm0, cs1);
        const float m_in = SC[(size_t)((chain0 + dir) * 32 + c) * 4 + 2];
        const float M0 = b0 + fmaxf(m_in, pm0), M1 = b1 + fmaxf(m_in, pm1);
        CS[dir * 128 + s0] = cs0; CS[dir * 128 + s1] = cs1; RR[dir * 128 + s0] = b0 - M0; RR[dir * 128 + s1] = b1 - M1;
        INTER[dir * 128 + s0] = __expf(b0 + m_in - M0); INTER[dir * 128 + s1] = __expf(b1 + m_in - M1); EM[dir * 128 + s0] = __expf(-M0); EM[dir * 128 + s1] = __expf(-M1); }
    { const int s0 = 4 * (tid >> 4), ch = tid & 15; float x4[4][8];
      conv_chunk4(P, cw, cb, b, c * ML_L + s0, h * 128 + ch * 8, x4);
      const float qs = 0.08838834764831845f;
#pragma unroll
      for (int i = 0; i < 4; ++i) { v4u oq; oq.x = pk2(x4[i][0] * qs, x4[i][1] * qs); oq.y = pk2(x4[i][2] * qs, x4[i][3] * qs); oq.z = pk2(x4[i][4] * qs, x4[i][5] * qs); oq.w = pk2(x4[i][6] * qs, x4[i][7] * qs);
          *(LAS v4u*)(lds + ML_T0 + (s0 + i) * KP + ch * 16) = oq; }
      conv_chunk4(P, cw, cb, b, c * ML_L + s0, 512 + h * 128 + ch * 8, x4);
#pragma unroll
      for (int i = 0; i < 4; ++i) { v4u ok; ok.x = pk2(x4[i][0], x4[i][1]); ok.y = pk2(x4[i][2], x4[i][3]); ok.z = pk2(x4[i][4], x4[i][5]); ok.w = pk2(x4[i][6], x4[i][7]);
          *(LAS v4u*)(lds + ML_T1 + (s0 + i) * KP + ch * 16) = ok; } }
#pragma unroll
    for (int i = 0; i < 8; ++i) { const int id = tid + 512 * i, s = id >> 5, ch = id & 31;
        *(LAS v4u*)(lds + ML_V + s * VP + ch * 16) = *(const v4u*)(P + (size_t)(t0 + s) * NPROJ + C_MLV + h * 256 + ch * 8); }
    __syncthreads();
    f32x4 S[8], qn = (f32x4){0.f, 0.f, 0.f, 0.f};
#pragma unroll
    for (int nb = 0; nb < 8; ++nb) S[nb] = (f32x4){0.f, 0.f, 0.f, 0.f};
#pragma unroll
    for (int ks = 0; ks < 4; ++ks) { const bf16x8v a = frag_row(lds + ML_T0, KP, 16 * wave, 32 * ks, lane);
        bf16x8v nf = (bf16x8v){0, 0, 0, 0, 0, 0, 0, 0};
        if (lc < 2) { const float* np = NU + (size_t)((chain0 + lc) * 32 + c) * 128 + 32 * ks + 8 * g; const f32x4 n0 = *(const f32x4*)np, n1 = *(const f32x4*)(np + 4);
            const unsigned w0 = pk2(n0[0], n0[1]), w1 = pk2(n0[2], n0[3]), w2 = pk2(n1[0], n1[1]), w3 = pk2(n1[2], n1[3]);
            nf = (bf16x8v){(short)(w0 & 0xffff), (short)(w0 >> 16), (short)(w1 & 0xffff), (short)(w1 >> 16), (short)(w2 & 0xffff), (short)(w2 >> 16), (short)(w3 & 0xffff), (short)(w3 >> 16)}; }
        qn = __builtin_amdgcn_mfma_f32_16x16x32_bf16(a, nf, qn, 0, 0, 0);
#pragma unroll
        for (int nb = 0; nb < 8; ++nb) { const bf16x8v kb = frag_row(lds + ML_T1, KP, 16 * nb, 32 * ks, lane); S[nb] = __builtin_amdgcn_mfma_f32_16x16x32_bf16(a, kb, S[nb], 0, 0, 0); } }
    float csf[8], csb[8];
#pragma unroll
    for (int nb = 0; nb < 8; ++nb) { csf[nb] = CS[16 * nb + lc]; csb[nb] = CS[128 + 16 * nb + lc]; }
    float pc[8][4];
#pragma unroll
    for (int r = 0; r < 4; ++r) { const int j = 16 * wave + 4 * g + r; const float Rf = RR[j], Rb = RR[128 + j];
        const float qnf = __shfl(qn[r], 16 * g), qnb = __shfl(qn[r], 16 * g + 1);
        float sf[8], sb[8], rsf = 0.f, rsb = 0.f;
#pragma unroll
        for (int nb = 0; nb < 8; ++nb) { const int s = 16 * nb + lc; const float wf = s <= j ? __expf(Rf + csf[nb]) : 0.f, wb = s >= j ? __expf(Rb + csb[nb]) : 0.f;
            sf[nb] = S[nb][r] * wf; sb[nb] = S[nb][r] * wb; rsf += sf[nb]; rsb += sb[nb]; }
#pragma unroll
        for (int o = 1; o < 16; o <<= 1) { rsf += __shfl_xor(rsf, o); rsb += __shfl_xor(rsb, o); }
        const float inf_ = INTER[j], inb_ = INTER[128 + j];
        const float ivf = 1.0f / fmaxf(fabsf(inf_ * qnf + rsf), EM[j]), ivb = 1.0f / fmaxf(fabsf(inb_ * qnb + rsb), EM[128 + j]);
#pragma unroll
        for (int nb = 0; nb < 8; ++nb) pc[nb][r] = sf[nb] * ivf + sb[nb] * ivb;
        if (lc == 0) { ALPHA[j] = inf_ * ivf; ALPHA[128 + j] = inb_ * ivb; } }
    __syncthreads();
#pragma unroll
    for (int r = 0; r < 4; ++r) { const int j = 16 * wave + 4 * g + r;
#pragma unroll
        for (int nb = 0; nb < 8; ++nb) *(LAS unsigned short*)(lds + ML_T1 + j * KP + (16 * nb + lc) * 2) = (unsigned short)f2bf(pc[nb][r]); }
    __syncthreads();
    f32x4 acc[2][8], acc2[2][8];
#pragma unroll
    for (int mb = 0; mb < 2; ++mb)
#pragma unroll
        for (int nb = 0; nb < 8; ++nb) { acc[mb][nb] = (f32x4){0.f, 0.f, 0.f, 0.f}; acc2[mb][nb] = (f32x4){0.f, 0.f, 0.f, 0.f}; }
    const bf16* ucf = UC + (size_t)((chain0 + 0) * 32 + c) * 32768 + (size_t)(32 * wave + lc) * 128 + 8 * g;
    const bf16* ucb = UC + (size_t)((chain0 + 1) * 32 + c) * 32768 + (size_t)(32 * wave + lc) * 128 + 8 * g;
#pragma unroll
    for (int ks = 0; ks < 4; ++ks) {
        const bf16x8v af0 = *(const bf16x8v*)(ucf + 32 * ks), af1 = *(const bf16x8v*)(ucf + 16 * 128 + 32 * ks), ab0 = *(const bf16x8v*)(ucb + 32 * ks), ab1 = *(const bf16x8v*)(ucb + 16 * 128 + 32 * ks);
#pragma unroll
        for (int nb = 0; nb < 8; ++nb) { const bf16x8v qb = frag_row(lds + ML_T0, KP, 16 * nb, 32 * ks, lane);
            acc[0][nb] = __builtin_amdgcn_mfma_f32_16x16x32_bf16(af0, qb, acc[0][nb], 0, 0, 0); acc[1][nb] = __builtin_amdgcn_mfma_f32_16x16x32_bf16(af1, qb, acc[1][nb], 0, 0, 0);
            acc2[0][nb] = __builtin_amdgcn_mfma_f32_16x16x32_bf16(ab0, qb, acc2[0][nb], 0, 0, 0); acc2[1][nb] = __builtin_amdgcn_mfma_f32_16x16x32_bf16(ab1, qb, acc2[1][nb], 0, 0, 0); } }
#pragma unroll
    for (int nb = 0; nb < 8; ++nb) { const float af = ALPHA[16 * nb + lc], ab = ALPHA[128 + 16 * nb + lc];
        acc[0][nb] = acc[0][nb] * af + acc2[0][nb] * ab; acc[1][nb] = acc[1][nb] * af + acc2[1][nb] * ab; }
#pragma unroll
    for (int ks = 0; ks < 4; ++ks) {
        const bf16x8v v0 = frag_tr(lds + ML_V, VP, 32 * ks, 32 * wave, lane), v1 = frag_tr(lds + ML_V, VP, 32 * ks, 32 * wave + 16, lane);
#pragma unroll
        for (int nb = 0; nb < 8; ++nb) { const bf16x8v pb = frag_row(lds + ML_T1, KP, 16 * nb, 32 * ks, lane);
            acc[0][nb] = __builtin_amdgcn_mfma_f32_16x16x32_bf16(v0, pb, acc[0][nb], 0, 0, 0); acc[1][nb] = __builtin_amdgcn_mfma_f32_16x16x32_bf16(v1, pb, acc[1][nb], 0, 0, 0); } }
#pragma unroll
    for (int nb = 0; nb < 8; ++nb) { float ss = 0.f;
#pragma unroll
        for (int mb = 0; mb < 2; ++mb) ss += (acc[mb][nb][0] * acc[mb][nb][0] + acc[mb][nb][1] * acc[mb][nb][1]) + (acc[mb][nb][2] * acc[mb][nb][2] + acc[mb][nb][3] * acc[mb][nb][3]);
        ss += __shfl_xor(ss, 16); ss += __shfl_xor(ss, 32);
        if (g == 0) SS[wave * 128 + 16 * nb + lc] = ss; }
    __syncthreads();
#pragma unroll
    for (int nb = 0; nb < 8; ++nb) { const int j = 16 * nb + lc; float tot = 0.f;
#pragma unroll
        for (int w = 0; w < 8; ++w) tot += SS[w * 128 + j];
        const float rstd = 1.0f / (sqrtf(tot * (1.0f / 256.0f) + EPS) * RSNA[t0 + j]);
#pragma unroll
        for (int mb = 0; mb < 2; ++mb) { const int e0 = 32 * wave + 16 * mb + 4 * g; const size_t t = (size_t)(t0 + j);
            const v2u ow = *(const v2u*)(P + t * NPROJ + C_MLO + h * 256 + e0); const f32x4 gg = *(const f32x4*)(mlg + h * 256 + e0);
            const float o[4] = {bflo(ow.x), bfhi(ow.x), bflo(ow.y), bfhi(ow.y)}; float rr[4];
#pragma unroll
            for (int r = 0; r < 4; ++r) rr[r] = acc[mb][nb][r] * rstd * gg[r] / (1.0f + __expf(-o[r]));
            v2u w; w.x = pk2(rr[0], rr[1]); w.y = pk2(rr[2], rr[3]);
            *(v2u*)(MIX + t * D + 1024 + h * 256 + e0) = w; } }
}


constexpr int NA_TILE = 64 * KP, NA_BUF = 2 * NA_TILE, NA_RPB = 2 * NA_BUF;
static_assert(NA_RPB + 15 * 128 * 4 <= ML_END, "LDS map");
__device__ __forceinline__ bf16x8v frag_tr2(LAS unsigned char* tile, int pitch, int row0, int row1, int n0, int lane) {
    const int q = (lane & 15) >> 2, p = lane & 3;
    const s16x4 lo = lds_tr(tile + (row0 + q) * pitch + (n0 + 4 * p) * 2), hi = lds_tr(tile + (row1 + q) * pitch + (n0 + 4 * p) * 2);
    return (bf16x8v){lo[0], lo[1], lo[2], lo[3], hi[0], hi[1], hi[2], hi[3]};
}
__device__ __forceinline__ void na_unit(int u, const bf16* P, const float* rpb, bf16* MIX, float* SSQ, LAS unsigned char* lds, int tid_, int wave) {
    int tid = tid_; asm volatile("" : "+v"(tid)); const int lane = tid & 63, g = lane >> 4, lc = lane & 15;
    const int r4 = u & 15, h = (u >> 4) & 7, b = u >> 7;
    const int r0 = 4 * r4, r = r0 + (wave >> 1), qh = wave & 1;
    const int rs = min(max(r - 4, 0), 56), rs0 = min(max(r0 - 4, 0), 56), nk = min(max(r0 + 3 - 4, 0), 56) + 8 - rs0;
    LAS float* RPB = (LAS float*)(lds + NA_RPB);
    const int sA = tid >> 4, chA = tid & 15, sB = sA + 32;
    const bf16* gsrc = P + ((size_t)b * SEQ + rs0 * 64) * NPROJ + h * 128 + chA * 8;
    v4u pk0, pk1, pv0, pv1;
#define NA_LOAD(j) do { const bf16* s_ = gsrc + (size_t)(j) * 64 * NPROJ; pk0 = *(const v4u*)(s_ + (size_t)sA * NPROJ + C_NAK); pk1 = *(const v4u*)(s_ + (size_t)sB * NPROJ + C_NAK); \
        pv0 = *(const v4u*)(s_ + (size_t)sA * NPROJ + C_NAV); pv1 = *(const v4u*)(s_ + (size_t)sB * NPROJ + C_NAV); } while (0)
#define NA_STORE(buf) do { LAS unsigned char* t_ = lds + (buf) * NA_BUF; *(LAS v4u*)(t_ + sA * KP + chA * 16) = pk0; *(LAS v4u*)(t_ + sB * KP + chA * 16) = pk1; \
        *(LAS v4u*)(t_ + NA_TILE + sA * KP + chA * 16) = pv0; *(LAS v4u*)(t_ + NA_TILE + sB * KP + chA * 16) = pv1; } while (0)
    NA_LOAD(0);
    __syncthreads();
    for (int i = tid; i < 15 * 128; i += 512) { const int dr = i >> 7, x = (i & 127) - 48; RPB[i] = (x >= 0 && x < 31) ? rpb[h * 465 + dr * 31 + x] * 1.4426950408889634f : 0.f; }
    NA_STORE(0);
    bf16x8v qf[2][4]; int cq[2], cs[2], boff[2]; float m[2], l[2]; f32x4 O[2][8]; f32x4 madd[2][4];
#pragma unroll
    for (int qi = 0; qi < 2; ++qi) { cq[qi] = 32 * qh + 16 * qi + lc; cs[qi] = min(max(cq[qi] - 8, 0), 48); m[qi] = -1.0e30f; l[qi] = 0.f; boff[qi] = 63 - cq[qi] + 4 * g;
#pragma unroll
        for (int kb = 0; kb < 4; ++kb)
#pragma unroll
            for (int rr = 0; rr < 4; ++rr) { const int kc = 16 * kb + 4 * g + rr; madd[qi][kb][rr] = (kc >= cs[qi] && kc < cs[qi] + 16) ? 0.f : -1.0e30f; }
        const bf16* qp = P + ((size_t)b * SEQ + r * 64 + cq[qi]) * NPROJ + C_NAQ + h * 128 + 8 * g;
#pragma unroll
        for (int ks = 0; ks < 4; ++ks) qf[qi][ks] = *(const bf16x8v*)(qp + 32 * ks);
#pragma unroll
        for (int db = 0; db < 8; ++db) O[qi][db] = (f32x4){0.f, 0.f, 0.f, 0.f}; }
    __syncthreads();
#pragma unroll 1
    for (int j = 0; j < nk; ++j) {
        const int kr = rs0 + j;
        if (j + 1 < nk) NA_LOAD(j + 1);
        if (kr >= rs && kr < rs + 8) {
            LAS unsigned char* Kt = lds + (j & 1) * NA_BUF; LAS unsigned char* Vt = Kt + NA_TILE;
            const LAS float* brow = RPB + (kr - r + 7) * 128;
            const int kb0a = qh ? 1 : 0, kb1a = qh ? 3 : 1, kb0b = qh ? 2 : 0, kb1b = qh ? 3 : 2;
            f32x4 s[2][4];
#pragma unroll
            for (int kb = 0; kb < 4; ++kb) { s[0][kb] = (f32x4){0.f, 0.f, 0.f, 0.f}; s[1][kb] = (f32x4){0.f, 0.f, 0.f, 0.f}; }
#pragma unroll
            for (int kb = 0; kb < 4; ++kb) { const bool ua = kb >= kb0a && kb <= kb1a, ub = kb >= kb0b && kb <= kb1b;
                if (ua || ub) {
#pragma unroll
                    for (int ks = 0; ks < 4; ++ks) { const bf16x8v ka = frag_row(Kt, KP, 16 * kb, 32 * ks, lane);
                        if (ua) s[0][kb] = __builtin_amdgcn_mfma_f32_16x16x32_bf16(ka, qf[0][ks], s[0][kb], 0, 0, 0);
                        if (ub) s[1][kb] = __builtin_amdgcn_mfma_f32_16x16x32_bf16(ka, qf[1][ks], s[1][kb], 0, 0, 0); } } }
            bf16x8v pb[2][2];
#pragma unroll
            for (int qi = 0; qi < 2; ++qi) {
                const int k0 = qi ? kb0b : kb0a, k1 = qi ? kb1b : kb1a; const LAS float* bq = brow + boff[qi];
                float mx = -1.0e30f;
#pragma unroll
                for (int kb = 0; kb < 4; ++kb) if (kb >= k0 && kb <= k1) {
#pragma unroll
                    for (int rr = 0; rr < 4; ++rr) { const float v = s[qi][kb][rr] * 0.12753785f + bq[16 * kb + rr] + madd[qi][kb][rr]; s[qi][kb][rr] = v; mx = fmaxf(mx, v); } }
                mx = fmaxf(mx, __shfl_xor(mx, 16)); mx = fmaxf(mx, __shfl_xor(mx, 32));
                const float mn = fmaxf(m[qi], mx); float ls = 0.f;
#pragma unroll
                for (int kb = 0; kb < 4; ++kb) { if (kb >= k0 && kb <= k1) {
#pragma unroll
                    for (int rr = 0; rr < 4; ++rr) { const float p = __builtin_amdgcn_exp2f(s[qi][kb][rr] - mn); s[qi][kb][rr] = p; ls += p; } } else s[qi][kb] = (f32x4){0.f, 0.f, 0.f, 0.f}; }
                ls += __shfl_xor(ls, 16); ls += __shfl_xor(ls, 32);
                if (!__all(mn == m[qi])) { const float corr = __builtin_amdgcn_exp2f(m[qi] - mn); l[qi] *= corr;
#pragma unroll
                    for (int db = 0; db < 8; ++db) O[qi][db] = O[qi][db] * corr; }
                l[qi] += ls; m[qi] = mn;
#pragma unroll
                for (int t = 0; t < 2; ++t) { v4u pw; pw.x = pk2(s[qi][2 * t][0], s[qi][2 * t][1]); pw.y = pk2(s[qi][2 * t][2], s[qi][2 * t][3]); pw.z = pk2(s[qi][2 * t + 1][0], s[qi][2 * t + 1][1]); pw.w = pk2(s[qi][2 * t + 1][2], s[qi][2 * t + 1][3]);
                    pb[qi][t] = __builtin_bit_cast(bf16x8v, pw); }
            }
#pragma unroll
            for (int t = 0; t < 2; ++t) { const bool ua = 2 * t + 1 >= kb0a && 2 * t <= kb1a, ub = 2 * t + 1 >= kb0b && 2 * t <= kb1b;
                if (ua || ub) {
#pragma unroll
                    for (int db = 0; db < 8; ++db) { const bf16x8v va = frag_tr2(Vt, KP, 32 * t + 4 * g, 32 * t + 16 + 4 * g, 16 * db, lane);
                        if (ua) O[0][db] = __builtin_amdgcn_mfma_f32_16x16x32_bf16(va, pb[0][t], O[0][db], 0, 0, 0);
                        if (ub) O[1][db] = __builtin_amdgcn_mfma_f32_16x16x32_bf16(va, pb[1][t], O[1][db], 0, 0, 0); } } }
        }
        if (j + 1 < nk) NA_STORE((j + 1) & 1);
        __syncthreads();
    }
#pragma unroll
    for (int qi = 0; qi < 2; ++qi) { const float inv = 1.0f / l[qi]; const size_t t = (size_t)b * SEQ + r * 64 + cq[qi]; bf16* op = MIX + t * D + h * 128 + 4 * g; float ss = 0.f;
#pragma unroll
        for (int db = 0; db < 8; ++db) { const f32x4 o = O[qi][db] * inv; ss += (o[0] * o[0] + o[1] * o[1]) + (o[2] * o[2] + o[3] * o[3]); v2u w; w.x = pk2(o[0], o[1]); w.y = pk2(o[2], o[3]); *(v2u*)(op + 16 * db) = w; }
        ss += __shfl_xor(ss, 16); ss += __shfl_xor(ss, 32);
        if (g == 0) SSQ[t * 8 + h] = ss; }
#undef NA_LOAD
#undef NA_STORE
}


constexpr int NWAVES = 8;
constexpr int RING_BYTES = 131072;
constexpr int LDSCTL_OFF = ML_END, MISC_OFF = LDSCTL_OFF + 320;
constexpr int LDS_BYTES = LDSCTL_OFF + 1024;
static_assert(ML_END >= RING_BYTES && LDS_BYTES <= 163840, "LDS map");
constexpr int CW_BAR = 4096;
constexpr size_t CTL_ZERO_BYTES = 65536;
static_assert((CW_BAR + XCD_BAR_WORDS) * 4 <= (int)CTL_ZERO_BYTES, "barrier words inside the memset region");

struct MKArgs { const float* in[16]; float* out; unsigned char* ws; };
__global__ void __launch_bounds__(NWAVES * 64, 2) mk_fwd(MKArgs args) {
    extern __shared__ __attribute__((aligned(16))) unsigned char lds_raw[];
    LAS unsigned char* lds = (LAS unsigned char*)lds_raw;
    volatile LAS unsigned* MISC = (volatile LAS unsigned*)(lds + MISC_OFF);
    const int tid = threadIdx.x, lane0 = tid & 63, wave = __builtin_amdgcn_readfirstlane(tid >> 6);
    const int G = gridDim.x; const int bx = blockIdx.x; const int vcu = (G % 8 == 0) ? (bx % 8) * (G / 8) + bx / 8 : bx;
    const int gw0 = vcu * NWAVES + wave, ngw = G * NWAVES;
    unsigned char* ws = args.ws;
    for (int u = tid; u < (LDS_BYTES - LDSCTL_OFF) / 4; u += NWAVES * 64) ((LAS unsigned*)(lds + LDSCTL_OFF))[u] = 0u;
    __syncthreads();
    XcdBarrier bar = xcd_barrier_post((unsigned*)(ws + WS_CTL) + CW_BAR, MISC + 8);
#define GRID_BAR() do { XcdBarrier b_ = bar; asm volatile("" : "+s"(b_.bar), "+s"(b_.x)); xcd_barrier(b_); } while (0)
    const float* x = args.in[0]; const float* norm_mix_g = args.in[1]; const float* w_in = args.in[2]; const float* b_gates = args.in[3];
    const float* conv_w = args.in[4]; const float* conv_b = args.in[5]; const float* na_rpb = args.in[6]; const float* na_norm_g = args.in[7];
    const float* ml_norm_g = args.in[8]; const float* w_out = args.in[9]; const float* norm_ffn_g = args.in[10]; const float* w_router = args.in[11];
    const float* w_gate = args.in[12]; const float* w_up = args.in[13]; const float* w_down = args.in[14]; const float* final_norm_g = args.in[15];
#define WSPTRS(wsl, Xl) float* X = (Xl); float* RSTD = (float*)((wsl) + WS_RSTD); float* GATES = (float*)((wsl) + WS_GATES); float* AFF = (float*)((wsl) + WS_AFF); int* TOK = (int*)((wsl) + WS_TOK); float* GATEV = (float*)((wsl) + WS_GATEV); int* SEL = (int*)((wsl) + WS_SEL); \
    bf16* XB = (bf16*)((wsl) + WS_XB); bf16* MIX = (bf16*)((wsl) + WS_MIX); bf16* P = (bf16*)((wsl) + WS_P); bf16* NAO = (bf16*)((wsl) + WS_NAO); bf16* ACT = (bf16*)((wsl) + WS_ACT); bf16* Y = (bf16*)((wsl) + WS_Y); \
    (void)X; (void)RSTD; (void)GATES; (void)AFF; (void)TOK; (void)GATEV; (void)SEL; (void)XB; (void)MIX; (void)P; (void)NAO; (void)ACT; (void)Y;
#define LAUNDER(p) asm volatile("" : "+s"(p))
#ifndef REP_MASK
#define REP_MASK 0
#endif
#if (REP_MASK >> 0) & 1
#define REP0 for (int rep_ = 0; rep_ < 2; ++rep_)
#else
#define REP0
#endif
#if (REP_MASK >> 1) & 1
#define REP1 for (int rep_ = 0; rep_ < 2; ++rep_)
#else
#define REP1
#endif
#if (REP_MASK >> 2) & 1
#define REP2 for (int rep_ = 0; rep_ < 2; ++rep_)
#else
#define REP2
#endif
#if (REP_MASK >> 3) & 1
#define REP3 for (int rep_ = 0; rep_ < 2; ++rep_)
#else
#define REP3
#endif
#if (REP_MASK >> 4) & 1
#define REP4 for (int rep_ = 0; rep_ < 2; ++rep_)
#else
#define REP4
#endif
#if (REP_MASK >> 5) & 1
#define REP5 for (int rep_ = 0; rep_ < 2; ++rep_)
#else
#define REP5
#endif
#if (REP_MASK >> 6) & 1
#define REP6 for (int rep_ = 0; rep_ < 2; ++rep_)
#else
#define REP6
#endif
#if (REP_MASK >> 7) & 1
#define REP7 for (int rep_ = 0; rep_ < 2; ++rep_)
#else
#define REP7
#endif
#if (REP_MASK >> 8) & 1
#define REP8 for (int rep_ = 0; rep_ < 2; ++rep_)
#else
#define REP8
#endif
#if (REP_MASK >> 9) & 1
#define REP9 for (int rep_ = 0; rep_ < 2; ++rep_)
#else
#define REP9
#endif
#if (REP_MASK >> 10) & 1
#define REP10 for (int rep_ = 0; rep_ < 2; ++rep_)
#else
#define REP10
#endif
#if (REP_MASK >> 11) & 1
#define REP11 for (int rep_ = 0; rep_ < 2; ++rep_)
#else
#define REP11
#endif
#if (REP_MASK >> 12) & 1
#define REP12 for (int rep_ = 0; rep_ < 2; ++rep_)
#else
#define REP12
#endif
#if (REP_MASK >> 13) & 1
#define REP13 for (int rep_ = 0; rep_ < 2; ++rep_)
#else
#define REP13
#endif

    { WSPTRS(ws, args.out)
      const int lane = lane0, gw = gw0;
    REP0 { ConvArgs ca; ca.w_in = w_in; ca.w_out = w_out; ca.w_gate = w_gate; ca.w_up = w_up; ca.w_down = w_down; ca.norm_mix_g = norm_mix_g; ca.norm_ffn_g = norm_ffn_g; ca.na_norm_g = na_norm_g; ca.ws = ws;
      LAS float* scr = (LAS float*)(lds + wave * CONV_SCR_BYTES);
      convert_stream(ca, gw, ngw, DEPTH * CI_LAYER, scr, lane); }
    { bf16* W16F = (bf16*)(ws + WS_W16F_OFF);
      for (int it = gw; it < DEPTH * 2 * 64; it += ngw) { const int mi = it >> 6, s = it & 63, l = mi >> 1;
          if (mi & 1) w16f_item(w_router + (size_t)l * D * NE, NE, norm_ffn_g + l * D, W16F + (size_t)mi * 32768, s, lane);
          else w16f_item(w_in + (size_t)l * D * NIN + C_GATES, NIN, norm_mix_g + l * D, W16F + (size_t)mi * 32768, s, lane); } }
    GRID_BAR();
    REP1 { RowArgs a; a.src32 = x; a.srcb = nullptr; a.sel = nullptr; a.Y = nullptr; a.XB = XB; a.XB8 = ws + WS_XB8; a.RSTD = RSTD; a.g = norm_mix_g; a.W16F = (const bf16*)(ws + WS_W16F_OFF); a.bias = b_gates; a.GATES = GATES; a.AFF = AFF; a.out = X; a.mode = 0; a.wrxb = 1;
      for (int grp = gw; grp < MTOK / 8; grp += ngw) rowpass_group<true>(a, grp, lane); } }
    GRID_BAR();

    for (int l = 0; l < DEPTH; ++l) {
        unsigned char* wsl = ws; float* Xl = args.out; LAUNDER(wsl); LAUNDER(Xl);
        WSPTRS(wsl, Xl)
        int lane = lane0, gw = gw0; asm volatile("" : "+v"(lane)); LAUNDER(gw);
        const bf16* WinT = (const bf16*)(wsl + WS_WIN) + (size_t)l * NPROJ * D; const bf16* WoutT = (const bf16*)(wsl + WS_WOUT) + (size_t)l * D * D;
        const bf16* WguT = (const bf16*)(wsl + WS_WGU) + (size_t)l * NE * 2048 * D; const bf16* WdT = (const bf16*)(wsl + WS_WD) + (size_t)l * NE * D * DE;
        REP2 { pg8::Gemm g{XB, WinT, MTOK, NPROJ16, D, 0}; pg8::StaticOrder S; S.init(MTOK, NPROJ16, G, bx); pg8::EpiRowScaleBf16 E{P, RSTD, nullptr, NPROJ, 0, 1.0f, 0};
          pg8::gemm_phase<pg8::EpiRowScaleBf16, pg8::StaticOrder, true, true>(lds, g, S, E); }
        { pg8::Gemm g{(const bf16*)(wsl + WS_XB8), (const bf16*)(wsl + WS_WIN + ((size_t)l * NPROJ + NPROJ16) * D * 2), MTOK, NPROJ - NPROJ16, D / 2, 0}; pg8::StaticOrder S; S.init(MTOK, NPROJ - NPROJ16, G, bx);
          pg8::EpiRowScaleBf16 E{P + NPROJ16, RSTD, nullptr, NPROJ, 0, 1.0f / W8_SCALE, 0};
          pg8::gemm_phase<pg8::EpiRowScaleBf16, pg8::StaticOrder, true, true, true>(lds, g, S, E); }
        GRID_BAR();
        REP4 for (int u = vcu; u < 512; u += G) na_unit(u, P, na_rpb + (size_t)l * 8 * 15 * 31, MIX, (float*)(wsl + WS_SSQ), lds, tid, wave);
        { bf16* UC = (bf16*)(wsl + WS_UC); float* NU = (float*)(wsl + WS_NU); float* SC = (float*)(wsl + WS_SC); const float* cwl = conv_w + (size_t)l * 5 * 1024; const float* cbl = conv_b + l * 1024;
          int tidl = tid; asm volatile("" : "+v"(tidl));
          REP5 for (int u = bx; u < 512; u += G) mlstm_m1_unit(u, cwl, cbl, P, GATES, UC, NU, SC, lds, tidl, wave);
          GRID_BAR();
          mlstm_m2(UC, NU, SC, vcu * 512 + tidl, G * 512);
          { const float* ssq = (const float*)(wsl + WS_SSQ); float* rsna = (float*)(wsl + WS_RSNA);
            for (int t = vcu * 512 + tidl; t < MTOK; t += G * 512) { const f32x4 s0 = *(const f32x4*)(ssq + (size_t)t * 8), s1 = *(const f32x4*)(ssq + (size_t)t * 8 + 4);
                rsna[t] = 1.0f / sqrtf(((s0[0] + s0[1]) + (s0[2] + s0[3]) + (s1[0] + s1[1]) + (s1[2] + s1[3])) * (1.0f / 1024.0f) + EPS); } }
          GRID_BAR();
          REP7 for (int u = bx; u < 512; u += G) mlstm_m3_unit(u, cwl, cbl, P, GATES, UC, NU, SC, ml_norm_g + l * 1024, (const float*)(wsl + WS_RSNA), MIX, lds, tidl, wave); }
        GRID_BAR();
#if (REP_MASK >> 8) & 1
        for (int rep_ = 0; rep_ < (l == 0 ? 2 : 1); ++rep_)
#endif
        { pg8::Gemm g{MIX, WoutT, MTOK, D, D, 0}; pg8::StaticOrder S; S.init(MTOK, D, G, bx); pg8::EpiResidBf16 E{XB, (const float*)(wsl + WS_RSNA), D, 0};
          pg8::gemm_phase<pg8::EpiResidBf16, pg8::StaticOrder, true, true>(lds, g, S, E); }
        GRID_BAR();
        REP9 { RowArgs a; a.src32 = nullptr; a.srcb = XB; a.sel = nullptr; a.Y = nullptr; a.XB = XB; a.XB8 = wsl + WS_XB8; a.RSTD = RSTD; a.g = norm_ffn_g + l * D; a.W16F = (const bf16*)(wsl + WS_W16F_OFF) + (size_t)(2 * l + 1) * 32768; a.bias = b_gates; a.GATES = GATES; a.AFF = AFF; a.out = X; a.mode = 1; a.wrxb = 0;
          for (int grp = gw; grp < MTOK / 8; grp += ngw) rowpass_group<false>(a, grp, lane); }
        GRID_BAR();
        REP10 for (int be = bx; be < BATCH * NE; be += G) topk_unit(be, AFF, TOK, GATEV, SEL, (LAS int*)lds);
        GRID_BAR();
        REP12 { pg8::Gemm g{(const bf16*)(wsl + WS_XB8), (const bf16*)(wsl + WS_WGU + (size_t)l * NE * 2048 * D), MR, 2048, D / 2, 0}; pg8::GroupedGatherOrder S{TOK, G, bx};
          pg8::EpiSwiGLU8 E{(unsigned char*)ACT, RSTD, TOK, DE, 8, 1.0f / W8_SCALE, 0};
          pg8::gemm_phase_gather<pg8::EpiSwiGLU8, pg8::GroupedGatherOrder, true, true, true>(lds, g, S, E); }
        GRID_BAR();
        REP13 { pg8::Gemm g{ACT, (const bf16*)(wsl + WS_WD + (size_t)l * NE * D * DE), MR, 2048, DE / 2, 0}; pg8::GroupedOrder S{nullptr, G, bx}; pg8::EpiRowScaleF8 E{(unsigned char*)Y, GATEV, D, 8, Y8_SCALE / W8_SCALE, 0};
          pg8::gemm_phase<pg8::EpiRowScaleF8, pg8::GroupedOrder, true, true, true>(lds, g, S, E); }
        GRID_BAR();
        { RowArgs a; a.src32 = nullptr; a.srcb = XB; a.sel = SEL; a.Y = (const unsigned char*)Y; a.XB = XB; a.XB8 = wsl + WS_XB8; a.RSTD = RSTD; a.bias = b_gates + (l + 1 < DEPTH ? (l + 1) * 16 : 0); a.GATES = GATES; a.AFF = AFF; a.out = X; a.wrxb = 1;
          a.W16F = (const bf16*)(wsl + WS_W16F_OFF) + (size_t)(2 * (l + 1 < DEPTH ? l + 1 : 0)) * 32768;
          if (l + 1 < DEPTH) { a.g = norm_mix_g + (l + 1) * D; a.mode = 0; }
          else { a.g = final_norm_g; a.mode = 2; }
          for (int grp = gw; grp < MTOK / 8; grp += ngw) rowpass_group<false>(a, grp, lane); }
        if (l + 1 < DEPTH) GRID_BAR();
    }
#undef GRID_BAR
#undef WSPTRS
}

extern "C" void kernel_launch(void* const* d_in, const int* in_sizes, int n_in, void* d_out, int out_size, void* d_ws, size_t ws_size, hipStream_t stream) {
    static int grid = 0;
    if (grid == 0) {
        if (n_in != 16 || ws_size < WS_END) { fprintf(stderr, "kernel_launch: unexpected n_in %d or ws_size %zu\n", n_in, ws_size); grid = -1; return; }
        int dev = 0, cus = 0, per_cu = 0;
        if (hipGetDevice(&dev) != hipSuccess || hipDeviceGetAttribute(&cus, hipDeviceAttributeMultiprocessorCount, dev) != hipSuccess) { grid = -1; return; }
        if (hipFuncSetAttribute((const void*)mk_fwd, hipFuncAttributeMaxDynamicSharedMemorySize, LDS_BYTES) != hipSuccess) { fprintf(stderr, "kernel_launch: hipFuncSetAttribute failed\n"); grid = -1; return; }
        if (hipOccupancyMaxActiveBlocksPerMultiprocessor(&per_cu, (const void*)mk_fwd, NWAVES * 64, LDS_BYTES) != hipSuccess || per_cu < 1) fprintf(stderr, "kernel_launch: occupancy query reports %d blocks per CU\n", per_cu);
        (void)hipGetLastError();
        grid = cus;
    }
    if (grid < 0) return;
    if (hipMemsetAsync((char*)d_ws + WS_CTL, 0, CTL_ZERO_BYTES, stream) != hipSuccess) return;
    MKArgs a; memset(&a, 0, sizeof(a));
    for (int i = 0; i < 16; ++i) a.in[i] = (const float*)d_in[i];
    a.out = (float*)d_out; a.ws = (unsigned char*)d_ws;
    hipLaunchKernelGGL(mk_fwd, dim3(grid), dim3(NWAVES * 64), LDS_BYTES, stream, a);
}
```

```cpp
#include <hip/hip_runtime.h>
#include <stdint.h>
#include <stdio.h>
#include <string.h>

namespace pg8 {
#define PG8_LAS __attribute__((address_space(3)))
typedef unsigned short bf16_t;
typedef short bf16x8 __attribute__((ext_vector_type(8)));
typedef float f32x4 __attribute__((ext_vector_type(4)));
typedef unsigned u32x4 __attribute__((ext_vector_type(4)));
typedef int v4i32 __attribute__((ext_vector_type(4)));
typedef int v8i32 __attribute__((ext_vector_type(8)));
constexpr int BM = 256, BK = 64, HALF = 128, HTB = HALF * BK * 2  , STAGE_BYTES = 8 * HTB, NXCD = 8, WGM = 8;

__host__ __device__ __forceinline__ int lds_byte(int r, int c) { const int st = (r >> 4) * 2 + (c >> 5), rr = r & 15, cc = c & 31, ob = rr * 64 + cc * 2; return st * 1024 + (ob ^ (((ob >> 9) & 1) << 5)); }
__host__ __device__ __forceinline__ void stage_rc(int b, int& R, int& C) { const int st = b / 1024, sb = b % 1024, swz = sb ^ (((sb >> 9) & 1) << 5); R = (st >> 1) * 16 + swz / 64; C = (st & 1) * 32 + (swz % 64) / 2; }
__host__ __device__ __forceinline__ int perm32(int rho) { const int n = rho >> 4, i = rho & 15; return 8 * (i >> 2) + 4 * n + (i & 3); }

struct Unit { int pm, pn; };
struct Gemm { const bf16_t* A; const bf16_t* Bt; int M, N, K, pad; };

struct StaticOrder {
    static constexpr bool GATHER = false;
    int nM, nN, nwg, G, c, pad;
    __host__ __device__ void init(int M, int N, int G_, int c_) { nM = M / BM; nN = N / BM; nwg = nM * nN; G = G_; c = c_; pad = 0; }
    __host__ __device__ bool next(int i, Unit& u) const {
        const long L = (long)i * G + c; if (L >= nwg) return false;
        int wgid = (int)L; { const int q = nwg / NXCD, r = nwg % NXCD, xcd = wgid % NXCD, off = wgid / NXCD; wgid = (xcd < r ? xcd * (q + 1) : r * (q + 1) + (xcd - r) * q) + off; }
        const int nig = WGM * nN, gid = wgid / nig, fm = gid * WGM, gsz = (nM - fm) < WGM ? (nM - fm) : WGM;
        u.pm = fm + ((wgid % nig) % gsz); u.pn = (wgid % nig) / gsz; return true;
    }
    __device__ __forceinline__ void a_ready(const Unit&) const {}
    __device__ __forceinline__ void done(const Unit&) const {}
};


__device__ __forceinline__ unsigned cvt_pk_bf16(float lo, float hi) { unsigned r; asm volatile("v_cvt_pk_bf16_f32 %0, %1, %2" : "=v"(r) : "v"(lo), "v"(hi)); return r; }
typedef unsigned u32x2 __attribute__((ext_vector_type(2)));

struct EpiRowScaleBf16 {
    static constexpr bool PERM = true, AFTER_DRAIN = false;
    bf16_t* O; const float* rowscale; const int* rowmap; int ldc; int pn_mod; float mul; int pad;
    __device__ __forceinline__ void pre(const Unit& u, int wr, int fr, float (&rs)[8]) const {
#pragma unroll
        for (int i = 0; i < 8; ++i) { const int row = u.pm * BM + wr * 64 + fr + (i >> 2) * HALF + (i & 3) * 16; rs[i] = rowscale ? rowscale[rowmap ? rowmap[row] : row] : 1.0f; } }
    __device__ __forceinline__ void operator()(const f32x4 (&acc)[2][2][4][2], const Unit& u, int wr, int wc, int fr, int fq, const float (&rs)[8]) const {
        const int row0 = u.pm * BM + wr * 64 + fr; const int pnl = pn_mod ? (u.pn % pn_mod) : u.pn;
        const int col0 = pnl * BM + wc * 32 + 8 * fq;
#pragma unroll
        for (int ai = 0; ai < 2; ++ai)
#pragma unroll
            for (int m = 0; m < 4; ++m) { const int row = row0 + ai * HALF + m * 16; const float sc = rs[4 * ai + m] * mul;
                bf16_t* rowp = O + (size_t)row * ldc + col0;
#pragma unroll
                for (int bj = 0; bj < 2; ++bj) { const f32x4 v0 = acc[ai][bj][m][0] * sc, v1 = acc[ai][bj][m][1] * sc;
                    u32x4 w; w.x = cvt_pk_bf16(v0[0], v0[1]); w.y = cvt_pk_bf16(v0[2], v0[3]); w.z = cvt_pk_bf16(v1[0], v1[1]); w.w = cvt_pk_bf16(v1[2], v1[3]);
                    *(u32x4*)(rowp + bj * HALF) = w; } }
    }
};
__device__ __forceinline__ unsigned pk4_fp8(float a, float b, float c, float d) { int p = __builtin_amdgcn_cvt_pk_fp8_f32(a, b, 0, false); p = __builtin_amdgcn_cvt_pk_fp8_f32(c, d, p, true); return (unsigned)p; }
struct EpiSwiGLU8 {
    static constexpr bool PERM = false, AFTER_DRAIN = false;
    unsigned char* O; const float* rowscale; const int* rowmap; int ldc; int pn_mod; float mul; int pad;
    __device__ __forceinline__ void pre(const Unit& u, int wr, int fr, float (&rs)[8]) const {
#pragma unroll
        for (int i = 0; i < 8; ++i) { const int row = u.pm * BM + wr * 64 + fr + (i >> 2) * HALF + (i & 3) * 16; rs[i] = rowscale[rowmap[row]]; } }
    __device__ __forceinline__ void operator()(const f32x4 (&acc)[2][2][4][2], const Unit& u, int wr, int wc, int fr, int fq, const float (&rs)[8]) const {
        const int row0 = u.pm * BM + wr * 64 + fr; const int pnl = u.pn % pn_mod;
        const int col0 = pnl * 128 + wc * 16 + 4 * fq;
#pragma unroll
        for (int ai = 0; ai < 2; ++ai)
#pragma unroll
            for (int m = 0; m < 4; ++m) { const int row = row0 + ai * HALF + m * 16; const float sc = rs[4 * ai + m] * mul;
                unsigned char* rowp = O + (size_t)row * ldc + col0;
#pragma unroll
                for (int bj = 0; bj < 2; ++bj) { const f32x4 a = acc[ai][bj][m][0] * sc, up = acc[ai][bj][m][1] * sc; f32x4 r;
#pragma unroll
                    for (int j = 0; j < 4; ++j) r[j] = a[j] * up[j] * __builtin_amdgcn_rcpf(1.0f + __builtin_amdgcn_exp2f(-1.4426950408889634f * a[j]));
                    *(unsigned*)(rowp + bj * 64) = pk4_fp8(r[0], r[1], r[2], r[3]); } }
    }
};

struct EpiRowScaleF8 {
    static constexpr bool PERM = true, AFTER_DRAIN = false;
    unsigned char* O; const float* rowscale; int ldc; int pn_mod; float mul; int pad;
    __device__ __forceinline__ void pre(const Unit& u, int wr, int fr, float (&rs)[8]) const {
#pragma unroll
        for (int i = 0; i < 8; ++i) rs[i] = rowscale[u.pm * BM + wr * 64 + fr + (i >> 2) * HALF + (i & 3) * 16]; }
    __device__ __forceinline__ void operator()(const f32x4 (&acc)[2][2][4][2], const Unit& u, int wr, int wc, int fr, int fq, const float (&rs)[8]) const {
        const int row0 = u.pm * BM + wr * 64 + fr; const int pnl = pn_mod ? (u.pn % pn_mod) : u.pn;
        const int col0 = pnl * BM + wc * 32 + 8 * fq;
#pragma unroll
        for (int ai = 0; ai < 2; ++ai)
#pragma unroll
            for (int m = 0; m < 4; ++m) { const int row = row0 + ai * HALF + m * 16; const float sc = rs[4 * ai + m] * mul;
                unsigned char* rowp = O + (size_t)row * ldc + col0;
#pragma unroll
                for (int bj = 0; bj < 2; ++bj) { const f32x4 v0 = acc[ai][bj][m][0] * sc, v1 = acc[ai][bj][m][1] * sc;
                    u32x2 w; w.x = pk4_fp8(v0[0], v0[1], v0[2], v0[3]); w.y = pk4_fp8(v1[0], v1[1], v1[2], v1[3]);
                    *(u32x2*)(rowp + bj * HALF) = w; } }
    }
};

struct EpiResidBf16 {
    static constexpr bool PERM = true, AFTER_DRAIN = false;
    bf16_t* XB; const float* rowscale; int ldc; int pad;
    __device__ __forceinline__ void pre(const Unit& u, int wr, int fr, float (&rs)[8]) const {
#pragma unroll
        for (int i = 0; i < 8; ++i) rs[i] = rowscale[u.pm * BM + wr * 64 + fr + (i >> 2) * HALF + (i & 3) * 16]; }
    __device__ __forceinline__ void operator()(const f32x4 (&acc)[2][2][4][2], const Unit& u, int wr, int wc, int fr, int fq, const float (&rs)[8]) const {
        const int row0 = u.pm * BM + wr * 64 + fr, col0 = u.pn * BM + wc * 32 + 8 * fq;
#pragma unroll
        for (int ai = 0; ai < 2; ++ai)
#pragma unroll
            for (int m = 0; m < 4; ++m) { const int row = row0 + ai * HALF + m * 16; const float sc = rs[4 * ai + m]; bf16_t* rowp = XB + (size_t)row * ldc + col0;
#pragma unroll
                for (int bj = 0; bj < 2; ++bj) { const u32x4 x = *(const u32x4*)(rowp + bj * HALF); const f32x4 v0 = acc[ai][bj][m][0] * sc, v1 = acc[ai][bj][m][1] * sc;
                    u32x4 w; w.x = cvt_pk_bf16(__uint_as_float(x.x << 16) + v0[0], __uint_as_float(x.x & 0xffff0000u) + v0[1]); w.y = cvt_pk_bf16(__uint_as_float(x.y << 16) + v0[2], __uint_as_float(x.y & 0xffff0000u) + v0[3]);
                    w.z = cvt_pk_bf16(__uint_as_float(x.z << 16) + v1[0], __uint_as_float(x.z & 0xffff0000u) + v1[1]); w.w = cvt_pk_bf16(__uint_as_float(x.w << 16) + v1[2], __uint_as_float(x.w & 0xffff0000u) + v1[3]);
                    *(u32x4*)(rowp + bj * HALF) = w; } }
    }
};
template <bool GATHER_> struct GroupedOrderT {
    static constexpr bool GATHER = GATHER_;
    const int* rowmap; int G, c;
    __device__ __forceinline__ bool next(int i, Unit& u) const {
        const int L = i * G + c; if (L >= 1024) return false;
        const int e = L >> 6, w = L & 63; u.pm = e * 8 + (w & 7); u.pn = e * 8 + (w >> 3); return true;
    }
    __device__ __forceinline__ void a_ready(const Unit&) const {}
    __device__ __forceinline__ void done(const Unit&) const {}
};
typedef GroupedOrderT<false> GroupedOrder; typedef GroupedOrderT<true> GroupedGatherOrder;
template <class Epi, class Sched, bool ALIGN_EPI = false, bool SP2 = false, bool F8 = false>
__device__ __forceinline__ void gemm_phase(PG8_LAS unsigned char* lds, const Gemm g, const Sched& S, const Epi& E) {
    int tid_ = threadIdx.x; asm volatile("" : "+v"(tid_));
    const int tid = tid_, wid = __builtin_amdgcn_readfirstlane(tid >> 6), lane = tid & 63, wr = wid >> 2, wc = wid & 3, fr = lane & 15, fq = lane >> 4;
    const int K = g.K, nt = K / BK;
    unsigned voffA[2], voffB[2];
#pragma unroll
    for (int i = 0; i < 2; ++i) { int R, C; stage_rc(tid * 16 + i * 8192, R, C); const int Rb = Epi::PERM ? ((R & ~31) + perm32(R & 31)) : R;
        voffA[i] = (unsigned)(R * K + C) * 2u; voffB[i] = (unsigned)(Rb * K + C) * 2u; }
    const size_t kstep = (size_t)(BK * 2);
    const size_t hstep = (size_t)HALF * K * 2;
    const size_t tstep = 2 * hstep;
    const unsigned ldsw = (unsigned)wid * 1024u;
    const int aoff = lds_byte(wr * 64 + fr, fq * 8), boff = lds_byte(wc * 32 + fr, fq * 8);
#define PG8_SA(b, h) (((b) * 2 + (h)) * HTB)
#define PG8_SB(b, h) ((4 + (b) * 2 + (h)) * HTB)
#define PG8_STAGE(bufoff, gbase, voff) do { _Pragma("unroll") for (int _i = 0; _i < 2; ++_i) \
        __builtin_amdgcn_global_load_lds((const unsigned*)((const char*)(gbase) + (voff)[_i]), (PG8_LAS unsigned*)(lds + (bufoff) + ldsw + _i * 8192), 16, 0, 0); } while (0)
#define PG8_LDA(dst, b, h) do { if constexpr (F8) { _Pragma("unroll") for (int m = 0; m < 4; ++m) dst##8[m] = __builtin_shufflevector(*(const PG8_LAS v4i32*)(lds + PG8_SA(b, h) + aoff + m * 2048), *(const PG8_LAS v4i32*)(lds + PG8_SA(b, h) + aoff + m * 2048 + 1024), 0, 1, 2, 3, 4, 5, 6, 7); } \
    else { _Pragma("unroll") for (int m = 0; m < 4; ++m) _Pragma("unroll") for (int k = 0; k < 2; ++k) dst[m][k] = *(const PG8_LAS bf16x8*)(lds + PG8_SA(b, h) + aoff + m * 2048 + k * 1024); } } while (0)
#define PG8_LDB(dst, b, h) do { if constexpr (F8) { _Pragma("unroll") for (int n = 0; n < 2; ++n) dst##8[n] = __builtin_shufflevector(*(const PG8_LAS v4i32*)(lds + PG8_SB(b, h) + boff + n * 2048), *(const PG8_LAS v4i32*)(lds + PG8_SB(b, h) + boff + n * 2048 + 1024), 0, 1, 2, 3, 4, 5, 6, 7); } \
    else { _Pragma("unroll") for (int n = 0; n < 2; ++n) _Pragma("unroll") for (int k = 0; k < 2; ++k) dst[n][k] = *(const PG8_LAS bf16x8*)(lds + PG8_SB(b, h) + boff + n * 2048 + k * 1024); } } while (0)
#define PG8_MMA(ai, bj, At, Bt) do { __builtin_amdgcn_s_setprio(1); _Pragma("unroll") for (int m = 0; m < 4; ++m) _Pragma("unroll") for (int n = 0; n < 2; ++n) { \
        if constexpr (F8) asm volatile("v_mfma_scale_f32_16x16x128_f8f6f4 %0, %1, %2, %0, %3, %3 op_sel_hi:[0,0,0]" : "+v"(acc[ai][bj][m][n]) : "v"(Bt##8[n]), "v"(At##8[m]), "v"(f8scale));   \
        else { _Pragma("unroll") for (int k = 0; k < 2; ++k) acc[ai][bj][m][n] = __builtin_amdgcn_mfma_f32_16x16x32_bf16(Bt[n][k], At[m][k], acc[ai][bj][m][n], 0, 0, 0); } } \
        __builtin_amdgcn_s_setprio(0); } while (0)
#define PG8_WAIT_V(n) asm volatile("s_waitcnt vmcnt(" #n ")" ::: "memory")
#define PG8_WAIT_L(n) asm volatile("s_waitcnt lgkmcnt(" #n ")" ::: "memory")
#define PG8_BAR __builtin_amdgcn_s_barrier()
#define PG8_SCHED __builtin_amdgcn_sched_barrier(0)
    Unit cur, nxt; int ui = 0;
    if (!S.next(0, cur)) return;
    f32x4 acc[2][2][4][2];
#pragma unroll
    for (int a = 0; a < 2; ++a)
#pragma unroll
        for (int b = 0; b < 2; ++b)
#pragma unroll
            for (int m = 0; m < 4; ++m)
#pragma unroll
                for (int n = 0; n < 2; ++n) acc[a][b][m][n] = (f32x4){0.f, 0.f, 0.f, 0.f};
    bf16x8 At[4][2], B0[2][2], B1[2][2]; v8i32 At8[4], B08[2], B18[2];
    const int f8scale = 0x7F7F7F7F; (void)f8scale;
    const char* cA = (const char*)g.A + (size_t)cur.pm * tstep; const char* cB = (const char*)g.Bt + (size_t)cur.pn * tstep;
    float rs[8];
    E.pre(cur, wr, fr, rs);
    S.a_ready(cur);
    if constexpr (SP2) {
        PG8_STAGE(PG8_SB(0, 0), cB, voffB); PG8_STAGE(PG8_SB(0, 1), cB + hstep, voffB); PG8_STAGE(PG8_SA(0, 0), cA, voffA); PG8_STAGE(PG8_SA(0, 1), cA + hstep, voffA);
        if (wr == 1) PG8_BAR;
        PG8_WAIT_V(2); PG8_BAR;
        PG8_STAGE(PG8_SB(1, 0), cB + kstep, voffB); PG8_STAGE(PG8_SA(1, 0), cA + kstep, voffA); PG8_STAGE(PG8_SB(1, 1), cB + hstep + kstep, voffB);
        PG8_WAIT_V(6); PG8_BAR;
    } else {
        PG8_STAGE(PG8_SB(0, 0), cB, voffB); PG8_STAGE(PG8_SA(0, 0), cA, voffA); PG8_STAGE(PG8_SB(0, 1), cB + hstep, voffB); PG8_STAGE(PG8_SA(0, 1), cA + hstep, voffA);
        if (wr == 1) PG8_BAR;
        PG8_WAIT_V(4); PG8_BAR;
        PG8_STAGE(PG8_SB(1, 0), cB + kstep, voffB); PG8_STAGE(PG8_SA(1, 0), cA + kstep, voffA); PG8_STAGE(PG8_SB(1, 1), cB + hstep + kstep, voffB);
        PG8_WAIT_V(6); PG8_BAR;
    }
    for (;;) {
        const bool has_next = S.next(ui + 1, nxt);
        const char* nA = has_next ? (const char*)g.A + (size_t)nxt.pm * tstep : cA; const char* nB = has_next ? (const char*)g.Bt + (size_t)nxt.pn * tstep : cB;
        for (int t = 0; t < nt; t += 2) {
            const bool last = (t == nt - 2);
            const char* a1 = cA + (size_t)(t + 1) * kstep;
            const char* a2 = last ? nA : cA + (size_t)(t + 2) * kstep; const char* b2 = last ? nB : cB + (size_t)(t + 2) * kstep;
            const char* a3 = a2 + kstep; const char* b3 = b2 + kstep;
            if (last && has_next) S.a_ready(nxt);
            if constexpr (SP2) {
            PG8_LDB(B0, 0, 0); PG8_LDB(B1, 0, 1); PG8_SCHED; PG8_LDA(At, 0, 0); PG8_STAGE(PG8_SA(1, 1), a1 + hstep, voffA);
            PG8_WAIT_V(8); PG8_WAIT_L(0); PG8_BAR; PG8_MMA(0, 0, At, B0); PG8_MMA(0, 1, At, B1); PG8_BAR; PG8_SCHED;
            PG8_LDA(At, 0, 1); PG8_STAGE(PG8_SB(0, 0), b2, voffB); PG8_STAGE(PG8_SB(0, 1), b2 + hstep, voffB); PG8_STAGE(PG8_SA(0, 0), a2, voffA);
            PG8_WAIT_V(8); PG8_WAIT_L(0); PG8_BAR; PG8_MMA(1, 0, At, B0); PG8_MMA(1, 1, At, B1); PG8_BAR; PG8_SCHED;
            PG8_LDB(B0, 1, 0); PG8_LDB(B1, 1, 1); PG8_SCHED; PG8_LDA(At, 1, 0); PG8_STAGE(PG8_SA(0, 1), a2 + hstep, voffA);
            PG8_WAIT_V(8); PG8_WAIT_L(0); PG8_BAR; PG8_MMA(0, 0, At, B0); PG8_MMA(0, 1, At, B1); PG8_BAR; PG8_SCHED;
            PG8_LDA(At, 1, 1); PG8_STAGE(PG8_SB(1, 0), b3, voffB); PG8_STAGE(PG8_SB(1, 1), b3 + hstep, voffB); PG8_STAGE(PG8_SA(1, 0), a3, voffA);
            PG8_WAIT_V(8); PG8_WAIT_L(0); PG8_BAR; PG8_MMA(1, 0, At, B0); PG8_MMA(1, 1, At, B1); PG8_BAR; PG8_SCHED;
            } else {
            PG8_LDB(B0, 0, 0); PG8_SCHED; PG8_LDA(At, 0, 0); PG8_STAGE(PG8_SA(1, 1), a1 + hstep, voffA);
            PG8_WAIT_L(8); PG8_BAR; PG8_WAIT_L(0); PG8_MMA(0, 0, At, B0); PG8_BAR; PG8_SCHED;
            PG8_LDB(B1, 0, 1); PG8_STAGE(PG8_SB(0, 0), b2, voffB);
            PG8_BAR; PG8_WAIT_L(0); PG8_MMA(0, 1, At, B1); PG8_BAR;
            PG8_LDA(At, 0, 1); PG8_STAGE(PG8_SA(0, 0), a2, voffA);
            PG8_BAR; PG8_WAIT_L(0); PG8_MMA(1, 0, At, B0); PG8_BAR; PG8_SCHED;
            PG8_STAGE(PG8_SB(0, 1), b2 + hstep, voffB);
            PG8_WAIT_V(6); PG8_BAR; PG8_MMA(1, 1, At, B1); PG8_BAR;
            PG8_LDB(B0, 1, 0); PG8_SCHED; PG8_LDA(At, 1, 0); PG8_STAGE(PG8_SA(0, 1), a2 + hstep, voffA);
            PG8_WAIT_L(8); PG8_BAR; PG8_WAIT_L(0); PG8_MMA(0, 0, At, B0); PG8_BAR; PG8_SCHED;
            PG8_LDB(B1, 1, 1); PG8_STAGE(PG8_SB(1, 0), b3, voffB);
            PG8_BAR; PG8_WAIT_L(0); PG8_MMA(0, 1, At, B1); PG8_BAR;
            PG8_LDA(At, 1, 1); PG8_STAGE(PG8_SA(1, 0), a3, voffA);
            PG8_BAR; PG8_WAIT_L(0); PG8_MMA(1, 0, At, B0); PG8_BAR; PG8_SCHED;
            PG8_STAGE(PG8_SB(1, 1), b3 + hstep, voffB);
            PG8_WAIT_V(6); PG8_BAR; PG8_MMA(1, 1, At, B1); PG8_BAR;
            }
        }
        if constexpr (F8) asm volatile("s_nop 15\n\ts_nop 15" ::: "memory");
        if constexpr (ALIGN_EPI) { if (wr == 0) PG8_BAR; }
        if constexpr (!Epi::AFTER_DRAIN) { E(acc, cur, wr, wc, fr, fq, rs); S.done(cur); }
        if (!has_next) break;
#pragma unroll
        for (int a = 0; a < 2; ++a)
#pragma unroll
            for (int b = 0; b < 2; ++b)
#pragma unroll
                for (int m = 0; m < 4; ++m)
#pragma unroll
                    for (int n = 0; n < 2; ++n) acc[a][b][m][n] = (f32x4){0.f, 0.f, 0.f, 0.f};
        cur = nxt; cA = nA; cB = nB; ++ui;
        E.pre(cur, wr, fr, rs);
        if constexpr (ALIGN_EPI) { if (wr == 1) PG8_BAR; }
    }
    PG8_WAIT_V(0);
    if constexpr (!ALIGN_EPI) { if (wr == 0) PG8_BAR; }
    PG8_BAR;
    if constexpr (Epi::AFTER_DRAIN) { E.fused(acc, cur, wr, wc, fr, fq, lds, wid, lane); S.done(cur); }
#undef PG8_SA
#undef PG8_SB
#undef PG8_STAGE
#undef PG8_LDA
#undef PG8_LDB
#undef PG8_MMA
#undef PG8_WAIT_V
#undef PG8_WAIT_L
#undef PG8_BAR
#undef PG8_SCHED
}

template <class Epi, class Sched, bool ALIGN_EPI = false, bool SP2 = false, bool F8 = false>
__device__ __forceinline__ void gemm_phase_gather(PG8_LAS unsigned char* lds, const Gemm g, const Sched& S, const Epi& E) {
    int tid_ = threadIdx.x; asm volatile("" : "+v"(tid_));
    const int tid = tid_, wid = __builtin_amdgcn_readfirstlane(tid >> 6), lane = tid & 63, wr = wid >> 2, wc = wid & 3, fr = lane & 15, fq = lane >> 4;
    static_assert(SP2 || !Sched::GATHER, "gathered A rows: SP2 loop only");
    const int K = g.K, nt = K / BK;
    unsigned voffA[2], voffB[2];
#pragma unroll
    for (int i = 0; i < 2; ++i) { int R, C; stage_rc(tid * 16 + i * 8192, R, C); const int Rb = Epi::PERM ? ((R & ~31) + perm32(R & 31)) : R;
        voffA[i] = (unsigned)(R * K + C) * 2u; voffB[i] = (unsigned)(Rb * K + C) * 2u; }
    constexpr bool GATHER = Sched::GATHER;
    int RA[2], CA[2];
#pragma unroll
    for (int i = 0; i < 2; ++i) stage_rc(tid * 16 + i * 8192, RA[i], CA[i]);
    const size_t kstep = (size_t)(BK * 2);
    const size_t hstep = (size_t)HALF * K * 2;
    const size_t tstep = 2 * hstep;
    const unsigned ldsw = (unsigned)wid * 1024u;
    const int aoff = lds_byte(wr * 64 + fr, fq * 8), boff = lds_byte(wc * 32 + fr, fq * 8);
#define PG8_SA(b, h) (((b) * 2 + (h)) * HTB)
#define PG8_SB(b, h) ((4 + (b) * 2 + (h)) * HTB)
#define PG8_STAGE(bufoff, gbase, voff) do { _Pragma("unroll") for (int _i = 0; _i < 2; ++_i) \
        __builtin_amdgcn_global_load_lds((const unsigned*)((const char*)(gbase) + (voff)[_i]), (PG8_LAS unsigned*)(lds + (bufoff) + ldsw + _i * 8192), 16, 0, 0); } while (0)
#define PG8_LDA(dst, b, h) do { if constexpr (F8) { _Pragma("unroll") for (int m = 0; m < 4; ++m) dst##8[m] = __builtin_shufflevector(*(const PG8_LAS v4i32*)(lds + PG8_SA(b, h) + aoff + m * 2048), *(const PG8_LAS v4i32*)(lds + PG8_SA(b, h) + aoff + m * 2048 + 1024), 0, 1, 2, 3, 4, 5, 6, 7); } \
    else { _Pragma("unroll") for (int m = 0; m < 4; ++m) _Pragma("unroll") for (int k = 0; k < 2; ++k) dst[m][k] = *(const PG8_LAS bf16x8*)(lds + PG8_SA(b, h) + aoff + m * 2048 + k * 1024); } } while (0)
#define PG8_LDB(dst, b, h) do { if constexpr (F8) { _Pragma("unroll") for (int n = 0; n < 2; ++n) dst##8[n] = __builtin_shufflevector(*(const PG8_LAS v4i32*)(lds + PG8_SB(b, h) + boff + n * 2048), *(const PG8_LAS v4i32*)(lds + PG8_SB(b, h) + boff + n * 2048 + 1024), 0, 1, 2, 3, 4, 5, 6, 7); } \
    else { _Pragma("unroll") for (int n = 0; n < 2; ++n) _Pragma("unroll") for (int k = 0; k < 2; ++k) dst[n][k] = *(const PG8_LAS bf16x8*)(lds + PG8_SB(b, h) + boff + n * 2048 + k * 1024); } } while (0)
#define PG8_MMA(ai, bj, At, Bt) do { __builtin_amdgcn_s_setprio(1); _Pragma("unroll") for (int m = 0; m < 4; ++m) _Pragma("unroll") for (int n = 0; n < 2; ++n) { \
        if constexpr (F8) asm volatile("v_mfma_scale_f32_16x16x128_f8f6f4 %0, %1, %2, %0, %3, %3 op_sel_hi:[0,0,0]" : "+v"(acc[ai][bj][m][n]) : "v"(Bt##8[n]), "v"(At##8[m]), "v"(f8scale));   \
        else { _Pragma("unroll") for (int k = 0; k < 2; ++k) acc[ai][bj][m][n] = __builtin_amdgcn_mfma_f32_16x16x32_bf16(Bt[n][k], At[m][k], acc[ai][bj][m][n], 0, 0, 0); } } \
        __builtin_amdgcn_s_setprio(0); } while (0)
#define PG8_WAIT_V(n) asm volatile("s_waitcnt vmcnt(" #n ")" ::: "memory")
#define PG8_WAIT_L(n) asm volatile("s_waitcnt lgkmcnt(" #n ")" ::: "memory")
#define PG8_BAR __builtin_amdgcn_s_barrier()
#define PG8_SCHED __builtin_amdgcn_sched_barrier(0)
    Unit cur, nxt; int ui = 0;
    if (!S.next(0, cur)) return;
    f32x4 acc[2][2][4][2];
#pragma unroll
    for (int a = 0; a < 2; ++a)
#pragma unroll
        for (int b = 0; b < 2; ++b)
#pragma unroll
            for (int m = 0; m < 4; ++m)
#pragma unroll
                for (int n = 0; n < 2; ++n) acc[a][b][m][n] = (f32x4){0.f, 0.f, 0.f, 0.f};
    bf16x8 At[4][2], B0[2][2], B1[2][2]; v8i32 At8[4], B08[2], B18[2];
    const int f8scale = 0x7F7F7F7F; (void)f8scale;
    const char* cA = GATHER ? (const char*)g.A : (const char*)g.A + (size_t)cur.pm * tstep; const char* cB = (const char*)g.Bt + (size_t)cur.pn * tstep;
    unsigned offC[2][2], offN[2][2];
#define PG8_SETOFF(o, u) do { _Pragma("unroll") for (int _h = 0; _h < 2; ++_h) _Pragma("unroll") for (int _i = 0; _i < 2; ++_i) { \
        if constexpr (GATHER) o[_h][_i] = (unsigned)S.rowmap[(u).pm * BM + _h * HALF + RA[_i]] * (unsigned)(K * 2) + (unsigned)(CA[_i] * 2); \
        else o[_h][_i] = voffA[_i] + (unsigned)(_h * (int)hstep); } } while (0)
    PG8_SETOFF(offC, cur);
#pragma unroll
    for (int _h = 0; _h < 2; ++_h) { offN[_h][0] = offC[_h][0]; offN[_h][1] = offC[_h][1]; }
    float rs[8];
    E.pre(cur, wr, fr, rs);
    S.a_ready(cur);
    if constexpr (SP2) {
        PG8_STAGE(PG8_SB(0, 0), cB, voffB); PG8_STAGE(PG8_SB(0, 1), cB + hstep, voffB); PG8_STAGE(PG8_SA(0, 0), cA, offC[0]); PG8_STAGE(PG8_SA(0, 1), cA, offC[1]);
        if (wr == 1) PG8_BAR;
        PG8_WAIT_V(2); PG8_BAR;
        PG8_STAGE(PG8_SB(1, 0), cB + kstep, voffB); PG8_STAGE(PG8_SA(1, 0), cA + kstep, offC[0]); PG8_STAGE(PG8_SB(1, 1), cB + hstep + kstep, voffB);
        PG8_WAIT_V(6); PG8_BAR;
    } else {
        PG8_STAGE(PG8_SB(0, 0), cB, voffB); PG8_STAGE(PG8_SA(0, 0), cA, voffA); PG8_STAGE(PG8_SB(0, 1), cB + hstep, voffB); PG8_STAGE(PG8_SA(0, 1), cA + hstep, voffA);
        if (wr == 1) PG8_BAR;
        PG8_WAIT_V(4); PG8_BAR;
        PG8_STAGE(PG8_SB(1, 0), cB + kstep, voffB); PG8_STAGE(PG8_SA(1, 0), cA + kstep, voffA); PG8_STAGE(PG8_SB(1, 1), cB + hstep + kstep, voffB);
        PG8_WAIT_V(6); PG8_BAR;
    }
    for (;;) {
        const bool has_next = S.next(ui + 1, nxt);
        const char* nA = GATHER ? cA : (has_next ? (const char*)g.A + (size_t)nxt.pm * tstep : cA); const char* nB = has_next ? (const char*)g.Bt + (size_t)nxt.pn * tstep : cB;
        if constexpr (GATHER) { if (has_next) PG8_SETOFF(offN, nxt); }
        for (int t = 0; t < nt; t += 2) {
            const bool last = (t == nt - 2);
            const char* a1 = cA + (size_t)(t + 1) * kstep;
            const char* a2 = last ? nA : cA + (size_t)(t + 2) * kstep; const char* b2 = last ? nB : cB + (size_t)(t + 2) * kstep;
            const char* a3 = a2 + kstep; const char* b3 = b2 + kstep;
            if (last && has_next) S.a_ready(nxt);
            unsigned o2[2][2];
#pragma unroll
            for (int _h = 0; _h < 2; ++_h)
#pragma unroll
                for (int _i = 0; _i < 2; ++_i) o2[_h][_i] = (GATHER && last) ? offN[_h][_i] : offC[_h][_i];
            if constexpr (SP2) {
            PG8_LDB(B0, 0, 0); PG8_LDB(B1, 0, 1); PG8_SCHED; PG8_LDA(At, 0, 0); PG8_STAGE(PG8_SA(1, 1), a1, offC[1]);
            PG8_WAIT_V(8); PG8_WAIT_L(0); PG8_BAR; PG8_MMA(0, 0, At, B0); PG8_MMA(0, 1, At, B1); PG8_BAR; PG8_SCHED;
            PG8_LDA(At, 0, 1); PG8_STAGE(PG8_SB(0, 0), b2, voffB); PG8_STAGE(PG8_SB(0, 1), b2 + hstep, voffB); PG8_STAGE(PG8_SA(0, 0), a2, o2[0]);
            PG8_WAIT_V(8); PG8_WAIT_L(0); PG8_BAR; PG8_MMA(1, 0, At, B0); PG8_MMA(1, 1, At, B1); PG8_BAR; PG8_SCHED;
            PG8_LDB(B0, 1, 0); PG8_LDB(B1, 1, 1); PG8_SCHED; PG8_LDA(At, 1, 0); PG8_STAGE(PG8_SA(0, 1), a2, o2[1]);
            PG8_WAIT_V(8); PG8_WAIT_L(0); PG8_BAR; PG8_MMA(0, 0, At, B0); PG8_MMA(0, 1, At, B1); PG8_BAR; PG8_SCHED;
            PG8_LDA(At, 1, 1); PG8_STAGE(PG8_SB(1, 0), b3, voffB); PG8_STAGE(PG8_SB(1, 1), b3 + hstep, voffB); PG8_STAGE(PG8_SA(1, 0), a3, o2[0]);
            PG8_WAIT_V(8); PG8_WAIT_L(0); PG8_BAR; PG8_MMA(1, 0, At, B0); PG8_MMA(1, 1, At, B1); PG8_BAR; PG8_SCHED;
            } else {
            PG8_LDB(B0, 0, 0); PG8_SCHED; PG8_LDA(At, 0, 0); PG8_STAGE(PG8_SA(1, 1), a1 + hstep, voffA);
            PG8_WAIT_L(8); PG8_BAR; PG8_WAIT_L(0); PG8_MMA(0, 0, At, B0); PG8_BAR; PG8_SCHED;
            PG8_LDB(B1, 0, 1); PG8_STAGE(PG8_SB(0, 0), b2, voffB);
            PG8_BAR; PG8_WAIT_L(0); PG8_MMA(0, 1, At, B1); PG8_BAR;
            PG8_LDA(At, 0, 1); PG8_STAGE(PG8_SA(0, 0), a2, voffA);
            PG8_BAR; PG8_WAIT_L(0); PG8_MMA(1, 0, At, B0); PG8_BAR; PG8_SCHED;
            PG8_STAGE(PG8_SB(0, 1), b2 + hstep, voffB);
            PG8_WAIT_V(6); PG8_BAR; PG8_MMA(1, 1, At, B1); PG8_BAR;
            PG8_LDB(B0, 1, 0); PG8_SCHED; PG8_LDA(At, 1, 0); PG8_STAGE(PG8_SA(0, 1), a2 + hstep, voffA);
            PG8_WAIT_L(8); PG8_BAR; PG8_WAIT_L(0); PG8_MMA(0, 0, At, B0); PG8_BAR; PG8_SCHED;
            PG8_LDB(B1, 1, 1); PG8_STAGE(PG8_SB(1, 0), b3, voffB);
            PG8_BAR; PG8_WAIT_L(0); PG8_MMA(0, 1, At, B1); PG8_BAR;
            PG8_LDA(At, 1, 1); PG8_STAGE(PG8_SA(1, 0), a3, voffA);
            PG8_BAR; PG8_WAIT_L(0); PG8_MMA(1, 0, At, B0); PG8_BAR; PG8_SCHED;
            PG8_STAGE(PG8_SB(1, 1), b3 + hstep, voffB);
            PG8_WAIT_V(6); PG8_BAR; PG8_MMA(1, 1, At, B1); PG8_BAR;
            }
        }
        if constexpr (F8) asm volatile("s_nop 15\n\ts_nop 15" ::: "memory");
        if constexpr (ALIGN_EPI) { if (wr == 0) PG8_BAR; }
        if constexpr (!Epi::AFTER_DRAIN) { E(acc, cur, wr, wc, fr, fq, rs); S.done(cur); }
        if (!has_next) break;
#pragma unroll
        for (int a = 0; a < 2; ++a)
#pragma unroll
            for (int b = 0; b < 2; ++b)
#pragma unroll
                for (int m = 0; m < 4; ++m)
#pragma unroll
                    for (int n = 0; n < 2; ++n) acc[a][b][m][n] = (f32x4){0.f, 0.f, 0.f, 0.f};
        cur = nxt; cA = nA; cB = nB; ++ui;
        E.pre(cur, wr, fr, rs);
#pragma unroll
        for (int _h = 0; _h < 2; ++_h) { offC[_h][0] = offN[_h][0]; offC[_h][1] = offN[_h][1]; }
        if constexpr (ALIGN_EPI) { if (wr == 1) PG8_BAR; }
    }
    PG8_WAIT_V(0);
    if constexpr (!ALIGN_EPI) { if (wr == 0) PG8_BAR; }
    PG8_BAR;
    if constexpr (Epi::AFTER_DRAIN) { E.fused(acc, cur, wr, wc, fr, fq, lds, wid, lane); S.done(cur); }
#undef PG8_SETOFF
#undef PG8_SA
#undef PG8_SB
#undef PG8_STAGE
#undef PG8_LDA
#undef PG8_LDB
#undef PG8_MMA
#undef PG8_WAIT_V
#undef PG8_WAIT_L
#undef PG8_BAR
#undef PG8_SCHED
}
}

constexpr int D = 2048, BATCH = 4, SEQ = 4096, MTOK = BATCH * SEQ, DEPTH = 2;
constexpr int NIN = 6160, NPROJ = 6144;
constexpr int C_NAQ = 0, C_NAK = 1024, C_NAV = 2048, C_MLQ = 3072, C_MLK = 3584, C_MLV = 4096, C_MLO = 5120, C_GATES = 6144;
constexpr int NE = 16, CAP = 512, DE = 1024, MR = NE * BATCH * CAP;
constexpr float EPS = 1e-6f;

typedef unsigned short bf16;
typedef float f32x4 __attribute__((ext_vector_type(4)));
typedef unsigned v4u __attribute__((ext_vector_type(4)));
typedef unsigned v2u __attribute__((ext_vector_type(2)));
#define LAS __attribute__((address_space(3)))
typedef short bf16x8v __attribute__((ext_vector_type(8)));
typedef short s16x4 __attribute__((ext_vector_type(4)));
constexpr size_t WS_XB8 = 968 * (size_t)(1u << 20);
constexpr size_t WS_SSQ = 6 * (size_t)(1u << 20) + 512 * 1024;
constexpr size_t WS_RSNA = 7 * (size_t)(1u << 20) + 64 * 1024;
constexpr size_t WS_W16F_OFF = 7 * (1u << 20) + 256 * 1024;

constexpr size_t MiB = 1u << 20;
constexpr size_t WS_CTL = 0;
constexpr size_t WS_RSTD = 1 * MiB;
constexpr size_t WS_GATES = 2 * MiB;
constexpr size_t WS_AFF = 3 * MiB;
constexpr size_t WS_TOK = 4 * MiB;
constexpr size_t WS_GATEV = 4 * MiB + 512 * 1024;
constexpr size_t WS_SEL = 5 * MiB;
constexpr size_t WS_WIN = 8 * MiB;
constexpr size_t WS_WOUT = 56 * MiB;
constexpr size_t WS_WGU = 72 * MiB;
constexpr size_t WS_WD = 328 * MiB;
constexpr size_t WS_XB = 456 * MiB;
constexpr size_t WS_MIX = 520 * MiB;
constexpr size_t WS_P = 584 * MiB;
constexpr size_t WS_NAO = 776 * MiB;
constexpr size_t WS_HF = 840 * MiB;
constexpr size_t WS_ACT = 712 * MiB;
constexpr size_t WS_Y = 776 * MiB;
constexpr size_t WS_END = 1000 * MiB;

__device__ __forceinline__ unsigned f2bf(float f) { unsigned u = __builtin_bit_cast(unsigned, f); return (u + 0x7fffu + ((u >> 16) & 1u)) >> 16; }
__device__ __forceinline__ unsigned pk2(float lo, float hi) { return f2bf(lo) | (f2bf(hi) << 16); }
__device__ __forceinline__ float bf2f(unsigned short b) { return __builtin_bit_cast(float, ((unsigned)b) << 16); }
__device__ __forceinline__ float bflo(unsigned w) { return __builtin_bit_cast(float, w << 16); }
__device__ __forceinline__ float bfhi(unsigned w) { return __builtin_bit_cast(float, w & 0xffff0000u); }
__device__ __forceinline__ float wave_sum(float v) {
#pragma unroll
    for (int o = 1; o < 64; o <<= 1) v += __shfl_xor(v, o);
    return v;
}
__device__ __forceinline__ float wave_max(float v) {
#pragma unroll
    for (int o = 1; o < 64; o <<= 1) v = fmaxf(v, __shfl_xor(v, o));
    return v;
}

struct ConvItem { const float* W; const float* gk; bf16* WT; int ldw, K, k0, n0, dmode, f8; float wmul; };
__device__ __forceinline__ void ti_load(const ConvItem& d, int lane, f32x4 (&wv)[16]) {
    const int r4 = lane >> 4, c4 = (lane & 15) * 4;
#pragma unroll
    for (int i = 0; i < 16; ++i) wv[i] = *(const f32x4*)(d.W + (size_t)(d.k0 + 4 * i + r4) * d.ldw + d.n0 + c4);
}
__device__ __forceinline__ void ti_finish(const ConvItem& d, int lane, const f32x4 (&wv)[16], LAS float* scr) {
    const int r4 = lane >> 4, c4 = (lane & 15) * 4;
#pragma unroll
    for (int i = 0; i < 16; ++i) { const int kk = 4 * i + r4; const float gg = d.gk ? d.gk[d.k0 + kk] : 1.0f; LAS float* p = scr + kk * 65 + c4; p[0] = wv[i][0] * gg; p[1] = wv[i][1] * gg; p[2] = wv[i][2] * gg; p[3] = wv[i][3] * gg; }
    asm volatile("s_waitcnt lgkmcnt(0)" ::: "memory");
    const int c = lane & 7; const float wmul = d.wmul;
#pragma unroll
    for (int j = 0; j < 8; ++j) { const int n = (lane >> 3) + 8 * j; const LAS float* s = scr + (8 * c) * 65 + n;
        const int ng = d.n0 + n; const int drow = d.dmode == 0 ? ng : ((ng >> 4) * 32 + (ng & 15) + (d.dmode == 2 ? 16 : 0));
        if (d.f8) { v2u o8; int p = __builtin_amdgcn_cvt_pk_fp8_f32(s[0 * 65] * wmul, s[1 * 65] * wmul, 0, false); p = __builtin_amdgcn_cvt_pk_fp8_f32(s[2 * 65] * wmul, s[3 * 65] * wmul, p, true); o8.x = (unsigned)p;
            p = __builtin_amdgcn_cvt_pk_fp8_f32(s[4 * 65] * wmul, s[5 * 65] * wmul, 0, false); p = __builtin_amdgcn_cvt_pk_fp8_f32(s[6 * 65] * wmul, s[7 * 65] * wmul, p, true); o8.y = (unsigned)p;
            *(v2u*)((unsigned char*)d.WT + (size_t)drow * d.K + d.k0 + 8 * c) = o8; }
        else { v4u o; o.x = pk2(s[0 * 65], s[1 * 65]); o.y = pk2(s[2 * 65], s[3 * 65]); o.z = pk2(s[4 * 65], s[5 * 65]); o.w = pk2(s[6 * 65], s[7 * 65]);
            *(v4u*)(d.WT + (size_t)drow * d.K + d.k0 + 8 * c) = o; } }
    asm volatile("s_waitcnt lgkmcnt(0)" ::: "memory");
}
constexpr int CONV_SCR_BYTES = 64 * 65 * 4;
constexpr float Y8_SCALE = 16.0f;
typedef float f32x2 __attribute__((ext_vector_type(2)));
constexpr int NPROJ16 = 5120;
constexpr float W8_SCALE = 64.0f;
struct ConvArgs { const float *w_in, *w_out, *w_gate, *w_up, *w_down, *norm_mix_g, *norm_ffn_g, *na_norm_g; unsigned char* ws; };
constexpr int CI_IN = 32 * 96, CI_OUT = 32 * 32, CI_G = 16 * 32 * 16, CI_D = 16 * 16 * 32, CI_LAYER = CI_IN + CI_OUT + 2 * CI_G + CI_D;
__device__ __forceinline__ ConvItem convert_decode(const ConvArgs& a, int it) {
    ConvItem d; d.f8 = 0; d.wmul = 1.0f; d.gk = nullptr; d.dmode = 0; d.K = D;
    const int l = it / CI_LAYER; int r = it % CI_LAYER;
    if (r < CI_IN) { const int kb = r / 96, nb = r % 96; d.ldw = NIN; d.gk = a.norm_mix_g + l * D; d.k0 = 64 * kb;
        if (64 * nb < NPROJ16) { d.W = a.w_in + (size_t)l * D * NIN; d.WT = (bf16*)(a.ws + WS_WIN) + (size_t)l * NPROJ * D; d.n0 = 64 * nb; }
        else { d.W = a.w_in + (size_t)l * D * NIN + NPROJ16; d.WT = (bf16*)(a.ws + WS_WIN + ((size_t)l * NPROJ + NPROJ16) * D * 2); d.n0 = 64 * nb - NPROJ16; d.f8 = 1; d.wmul = W8_SCALE; }
        return d; }
    r -= CI_IN;
    if (r < CI_OUT) { const int kb = r / 32, nb = r % 32; d.W = a.w_out + (size_t)l * D * D; d.ldw = D; if (64 * kb < 1024) d.gk = a.na_norm_g + l * 1024;
        d.WT = (bf16*)(a.ws + WS_WOUT) + (size_t)l * D * D; d.k0 = 64 * kb; d.n0 = 64 * nb; return d; }
    r -= CI_OUT;
    if (r < 2 * CI_G) { const int up = r >= CI_G; if (up) r -= CI_G; const int e = r / 512, q = r % 512, kb = q / 16, nb = q % 16;
        d.W = (up ? a.w_up : a.w_gate) + ((size_t)l * NE + e) * D * DE; d.ldw = DE; d.gk = a.norm_ffn_g + l * D; d.WT = (bf16*)(a.ws + WS_WGU + ((size_t)l * NE + e) * 2048 * D); d.k0 = 64 * kb; d.n0 = 64 * nb; d.dmode = up ? 2 : 1; d.f8 = 1; d.wmul = W8_SCALE; return d; }
    r -= 2 * CI_G;
    { const int e = r / 512, q = r % 512, kb = q / 32, nb = q % 32; d.W = a.w_down + ((size_t)l * NE + e) * DE * D; d.ldw = D; d.WT = (bf16*)(a.ws + WS_WD + ((size_t)l * NE + e) * D * DE); d.K = DE; d.k0 = 64 * kb; d.n0 = 64 * nb; d.f8 = 1; d.wmul = W8_SCALE; return d; }
}
__device__ __forceinline__ void convert_stream(const ConvArgs& a, int first, int stride, int end, LAS float* scr, int lane) {
    if (first >= end) return;
    f32x4 w0[16], w1[16]; ConvItem d0 = convert_decode(a, first), d1 = d0; ti_load(d0, lane, w0);
#pragma unroll 1
    for (int it = first; it < end; it += stride) { const bool hn = it + stride < end;
        if (hn) { d1 = convert_decode(a, it + stride); ti_load(d1, lane, w1); }
        ti_finish(d0, lane, w0, scr);
        d0 = d1;
#pragma unroll
        for (int i = 0; i < 16; ++i) w0[i] = w1[i]; }
}

#define XB_TMO      128
#define XB_XCNT(j)  (256  + 64 * (j))
#define XB_XSUB(j)  (1280 + 64 * (j))
#define XB_XGEN(j)  (2304 + 64 * (j))
#define XB_TOP      3328
#define XB_TOPGEN   3392
#define XCD_BAR_WORDS 3456
#define XB_SPIN_CAP (1u << 18)

__device__ __forceinline__ unsigned xb_ld(unsigned* p)              { return __hip_atomic_load(p, __ATOMIC_RELAXED, __HIP_MEMORY_SCOPE_AGENT); }
__device__ __forceinline__ unsigned xb_add(unsigned* p, unsigned v) { return __hip_atomic_fetch_add(p, v, __ATOMIC_RELAXED, __HIP_MEMORY_SCOPE_AGENT); }
__device__ __forceinline__ unsigned xb_xcc_id() { return (unsigned)__builtin_amdgcn_s_getreg((3 << 11) | 20) & 0xFu; }
#define XB_SPIN(cond, bar) do { unsigned _sp = 0; while (cond) { __builtin_amdgcn_s_sleep(1); \
    if ((++_sp & 255u) == 0u) { if (xb_ld(&(bar)[XB_TMO])) break; if (_sp > XB_SPIN_CAP) { atomicAdd(&(bar)[XB_TMO], 1u); break; } } } } while (0)

struct XcdBarrier {
    unsigned* bar; unsigned x;
    volatile LAS unsigned* st;
};

__device__ __forceinline__ XcdBarrier xcd_barrier_post(unsigned* bar, volatile LAS unsigned* st) {
    XcdBarrier b; b.bar = bar; b.x = xb_xcc_id(); b.st = st;
    if (threadIdx.x == 0) (void)xb_add(&bar[XB_XCNT(b.x)], 1u);
    return b;
}
__device__ __forceinline__ void xcd_barrier_complete(unsigned* bar, unsigned x, unsigned& nloc, unsigned& nx) {
    const unsigned G = gridDim.x * gridDim.y * gridDim.z;
    unsigned sum, cnt, mine, sp = 0u;
    for (;;) {
        sum = 0u; cnt = 0u; mine = 0u;
#pragma unroll
        for (unsigned j = 0; j < 16; ++j) { const unsigned c = xb_ld(&bar[XB_XCNT(j)]); sum += c; cnt += (c > 0u) ? 1u : 0u; mine = (j == x) ? c : mine; }
        if (sum == G) break;
        __builtin_amdgcn_s_sleep(1);
        if ((++sp & 255u) == 0u) { if (xb_ld(&bar[XB_TMO])) break; if (sp > XB_SPIN_CAP) { atomicAdd(&bar[XB_TMO], 1u); break; } }
    }
    nloc = mine > 0u ? mine : 1u; nx = cnt > 0u ? cnt : 1u;
}

__device__ __forceinline__ void xcd_barrier(const XcdBarrier& b) {
    asm volatile("s_waitcnt vmcnt(0)" ::: "memory");
    __syncthreads();
    if (threadIdx.x == 0) {
        unsigned* bar = b.bar;
        __builtin_amdgcn_s_waitcnt(0);
        unsigned nloc = b.st[0], nx = b.st[1];
        if (nloc == 0u) { xcd_barrier_complete(bar, b.x, nloc, nx); b.st[0] = nloc; b.st[1] = nx; }
        const unsigned old = xb_add(&bar[XB_XSUB(b.x)], 1u);
        const unsigned gen = old / nloc;
        if (old + 1u == (gen + 1u) * nloc) {
            __builtin_amdgcn_fence(__ATOMIC_RELEASE, "agent");
            asm volatile("s_waitcnt vmcnt(0)" ::: "memory");
            const unsigned og = xb_add(&bar[XB_TOP], 1u);
            const unsigned tg = og / nx;
            if (og + 1u == (tg + 1u) * nx) xb_add(&bar[XB_TOPGEN], 1u);
            else XB_SPIN(xb_ld(&bar[XB_TOPGEN]) == tg, bar);
            __builtin_amdgcn_fence(__ATOMIC_ACQUIRE, "agent");
            xb_add(&bar[XB_XGEN(b.x)], 1u);
            asm volatile("s_waitcnt vmcnt(0)" ::: "memory");
        } else {
            XB_SPIN(xb_ld(&bar[XB_XGEN(b.x)]) == gen, bar);
            __builtin_amdgcn_fence(__ATOMIC_ACQUIRE, "agent");
            asm volatile("s_waitcnt vmcnt(0)" ::: "memory");
        }
    }
    __syncthreads();
}

struct RowArgs { const float* src32; const bf16* srcb; const int* sel; const unsigned char* Y; bf16* XB; unsigned char* XB8; float* RSTD; const float* g; const bf16* W16F; const float* bias; float* GATES; float* AFF; float* out; int mode; int wrxb; };
__device__ __forceinline__ void rowpass_finish(const RowArgs& a, int row, int rr, int s0, int s1, f32x4 (&v)[8], int lane) {
    const int b = row / SEQ;
    if (a.sel) {
        const int sw = rr < 4 ? s0 : s1;
        for (int e = 0; e < NE; ++e) { const int c = __builtin_amdgcn_readlane(sw, ((rr & 3) << 4) + e);
            if (c >= 0) { const unsigned char* y = a.Y + (size_t)(e * 2048 + b * 512 + c) * D + 4 * lane;
#pragma unroll
                for (int j = 0; j < 8; ++j) { const int w = *(const int*)(y + 256 * j); const f32x2 lo = __builtin_amdgcn_cvt_pk_f32_fp8(w, false), hi = __builtin_amdgcn_cvt_pk_f32_fp8(w, true);
                    v[j][0] += lo[0] * (1.0f / Y8_SCALE); v[j][1] += lo[1] * (1.0f / Y8_SCALE); v[j][2] += hi[0] * (1.0f / Y8_SCALE); v[j][3] += hi[1] * (1.0f / Y8_SCALE); } } }
    }
    float ss = 0.f;
#pragma unroll
    for (int j = 0; j < 8; ++j) ss += (v[j][0] * v[j][0] + v[j][1] * v[j][1]) + (v[j][2] * v[j][2] + v[j][3] * v[j][3]);
    ss = wave_sum(ss);
    const float rstd = 1.0f / sqrtf(ss * (1.0f / D) + EPS);
    if (a.mode == 2) {
#pragma unroll
        for (int j = 0; j < 8; ++j) { const f32x4 g = *(const f32x4*)(a.g + 4 * lane + 256 * j); *(f32x4*)(a.out + (size_t)row * D + 4 * lane + 256 * j) = v[j] * rstd * g; }
        return;
    }
    if (a.wrxb) {
#pragma unroll
        for (int j = 0; j < 8; ++j) { v2u w; w.x = pk2(v[j][0], v[j][1]); w.y = pk2(v[j][2], v[j][3]); *(v2u*)(a.XB + (size_t)row * D + 4 * lane + 256 * j) = w; } }
    if (a.XB8) {
#pragma unroll
        for (int j = 0; j < 8; ++j) *(unsigned*)(a.XB8 + (size_t)row * D + 4 * lane + 256 * j) = pg8::pk4_fp8(v[j][0], v[j][1], v[j][2], v[j][3]); }
    if (lane == 0) a.RSTD[row] = rstd;
}
template <bool SRC32> __device__ __forceinline__ void rowpass_group(const RowArgs& a, int grp, int lane_) {
    int lane = lane_; asm volatile("" : "+v"(lane));
    int s0 = -1, s1 = -1; if (a.sel) { s0 = a.sel[grp * 128 + lane]; s1 = a.sel[grp * 128 + 64 + lane]; }
    f32x4 v[8];
    if constexpr (SRC32) {
        f32x4 vn[8];
#pragma unroll
        for (int j = 0; j < 8; ++j) v[j] = *(const f32x4*)(a.src32 + (size_t)(8 * grp) * D + 4 * lane + 256 * j);
#pragma unroll 1
        for (int rr = 0; rr < 8; ++rr) { const int row = 8 * grp + rr;
            if (rr < 7) {
#pragma unroll
                for (int j = 0; j < 8; ++j) vn[j] = *(const f32x4*)(a.src32 + (size_t)(row + 1) * D + 4 * lane + 256 * j); }
            rowpass_finish(a, row, rr, s0, s1, v, lane);
#pragma unroll
            for (int j = 0; j < 8; ++j) v[j] = vn[j]; }
    } else {
        v2u w[8], wn[8];
#pragma unroll
        for (int j = 0; j < 8; ++j) w[j] = *(const v2u*)(a.srcb + (size_t)(8 * grp) * D + 4 * lane + 256 * j);
#pragma unroll 1
        for (int rr = 0; rr < 8; ++rr) { const int row = 8 * grp + rr;
            if (rr < 7) {
#pragma unroll
                for (int j = 0; j < 8; ++j) wn[j] = *(const v2u*)(a.srcb + (size_t)(row + 1) * D + 4 * lane + 256 * j); }
#pragma unroll
            for (int j = 0; j < 8; ++j) v[j] = (f32x4){bflo(w[j].x), bfhi(w[j].x), bflo(w[j].y), bfhi(w[j].y)};
            rowpass_finish(a, row, rr, s0, s1, v, lane);
#pragma unroll
            for (int j = 0; j < 8; ++j) w[j] = wn[j]; }
    }
    if (a.mode == 2) return;
    asm volatile("s_waitcnt vmcnt(0)" ::: "memory");
    const int g = lane >> 4, lc = lane & 15;
    f32x4 acc = (f32x4){0.f, 0.f, 0.f, 0.f};
    const bf16* xr = a.XB + (size_t)(8 * grp + (lc & 7)) * D + 8 * g; const bf16* wf = a.W16F + lane * 8;
#pragma unroll 8
    for (int s = 0; s < 64; ++s) { bf16x8v af = *(const bf16x8v*)(xr + 32 * s); if (lc >= 8) af = (bf16x8v){0, 0, 0, 0, 0, 0, 0, 0};
        const bf16x8v bf = *(const bf16x8v*)(wf + s * 512); acc = __builtin_amdgcn_mfma_f32_16x16x32_bf16(af, bf, acc, 0, 0, 0); }
    float rs[4];
#pragma unroll
    for (int r = 0; r < 4; ++r) rs[r] = a.RSTD[8 * grp + 4 * (g & 1) + r];
    if (a.mode == 0) { const float bs = a.bias[lc];
#pragma unroll
        for (int r = 0; r < 4; ++r) { const float rstd = rs[r]; if (g < 2) a.GATES[(size_t)(8 * grp + 4 * g + r) * 16 + lc] = acc[r] * rstd + bs; } }
    else {
#pragma unroll
        for (int r = 0; r < 4; ++r) { const float rstd = rs[r]; const float lg = acc[r] * rstd; float mx = lg;
#pragma unroll
            for (int o = 1; o < 16; o <<= 1) mx = fmaxf(mx, __shfl_xor(mx, o));
            const float p = __expf(lg - mx); float sum = p;
#pragma unroll
            for (int o = 1; o < 16; o <<= 1) sum += __shfl_xor(sum, o);
            const int row = 8 * grp + 4 * g + r; if (g < 2) a.AFF[((size_t)(row / SEQ) * NE + lc) * SEQ + (row % SEQ)] = p / sum; } }
}
__device__ __forceinline__ void w16f_item(const float* W, int ldw, const float* gk, bf16* WF, int s, int lane) {
    const int g = lane >> 4, lc = lane & 15; float v[8];
#pragma unroll
    for (int i = 0; i < 8; ++i) { const int k = 32 * s + 8 * g + i; v[i] = W[(size_t)k * ldw + lc] * gk[k]; }
    v4u o; o.x = pk2(v[0], v[1]); o.y = pk2(v[2], v[3]); o.z = pk2(v[4], v[5]); o.w = pk2(v[6], v[7]);
    *(v4u*)(WF + (size_t)(s * 64 + lane) * 8) = o;
}

__device__ __forceinline__ void na_norm_item(const bf16* NAO, const float* g, bf16* MIX, int t, int lane) {
    f32x4 v[4]; float ss = 0.f;
#pragma unroll
    for (int j = 0; j < 4; ++j) { const v2u w = *(const v2u*)(NAO + (size_t)t * 1024 + 4 * lane + 256 * j); v[j] = (f32x4){bflo(w.x), bfhi(w.x), bflo(w.y), bfhi(w.y)}; ss += (v[j][0] * v[j][0] + v[j][1] * v[j][1]) + (v[j][2] * v[j][2] + v[j][3] * v[j][3]); }
    const float rstd = 1.0f / sqrtf(wave_sum(ss) * (1.0f / 1024.0f) + EPS);
#pragma unroll
    for (int j = 0; j < 4; ++j) { const f32x4 gg = *(const f32x4*)(g + 4 * lane + 256 * j); const f32x4 o = v[j] * rstd * gg; v2u w; w.x = pk2(o[0], o[1]); w.y = pk2(o[2], o[3]);
        *(v2u*)(MIX + (size_t)t * D + 4 * lane + 256 * j) = w; }
}

__device__ __forceinline__ int block_sum_512(int v, LAS int* red, int wave, int lane) {
#pragma unroll
    for (int o = 1; o < 64; o <<= 1) v += __shfl_xor(v, o);
    __syncthreads();
    if (lane == 0) red[wave] = v;
    __syncthreads();
    int s = 0;
#pragma unroll
    for (int w = 0; w < 8; ++w) s += red[w];
    return s;
}
__device__ __forceinline__ int block_excl_scan_512(int v, LAS int* red, int wave, int lane) {
    int inc = v;
#pragma unroll
    for (int o = 1; o < 64; o <<= 1) { const int t = __shfl_up(inc, o); if (lane >= o) inc += t; }
    __syncthreads();
    if (lane == 63) red[wave] = inc;
    __syncthreads();
    int base = 0;
#pragma unroll
    for (int w = 0; w < 8; ++w) base += (w < wave) ? red[w] : 0;
    return base + inc - v;
}
__device__ __forceinline__ void topk_unit(int be, const float* AFF, int* TOK, float* GATEV, int* SEL, LAS int* red) {
    int tid_ = threadIdx.x; asm volatile("" : "+v"(tid_)); const int tid = tid_, lane = tid & 63, wave = tid >> 6;
    const int b = be >> 4, e = be & 15;
    const float* a = AFF + (size_t)be * SEQ + tid * 8;
    const f32x4 a0 = *(const f32x4*)a, a1 = *(const f32x4*)(a + 4);
    unsigned key[8] = {__float_as_uint(a0.x), __float_as_uint(a0.y), __float_as_uint(a0.z), __float_as_uint(a0.w),
                       __float_as_uint(a1.x), __float_as_uint(a1.y), __float_as_uint(a1.z), __float_as_uint(a1.w)};
    LAS int* hist = red + 16;
    unsigned T = 0u; int need = CAP;
#pragma unroll 1
    for (int pass = 0; pass < 4; ++pass) { const int shift = 24 - 8 * pass; const unsigned mhi = pass == 0 ? 0u : (0xFFFFFFFFu << (shift + 8));
        __syncthreads();
        if (tid < 256) hist[tid] = 0;
        __syncthreads();
#pragma unroll
        for (int i = 0; i < 8; ++i) if ((key[i] & mhi) == T) (void)__hip_atomic_fetch_add(&hist[(key[i] >> shift) & 255u], 1, __ATOMIC_RELAXED, __HIP_MEMORY_SCOPE_WORKGROUP);
        __syncthreads();
        if (wave == 0) { const int c0 = hist[4 * lane], c1 = hist[4 * lane + 1], c2 = hist[4 * lane + 2], c3 = hist[4 * lane + 3]; const int t = c0 + c1 + c2 + c3; int inc = t;
#pragma unroll
            for (int o = 1; o < 64; o <<= 1) { const int v = __shfl_down(inc, o); if (lane + o < 64) inc += v; }
            const int ab3 = inc - t, ab2 = ab3 + c3, ab1 = ab2 + c2, ab0 = ab1 + c1;
            if (ab3 < need && need <= ab3 + c3) { red[8] = 4 * lane + 3; red[9] = ab3; }
            if (ab2 < need && need <= ab2 + c2) { red[8] = 4 * lane + 2; red[9] = ab2; }
            if (ab1 < need && need <= ab1 + c1) { red[8] = 4 * lane + 1; red[9] = ab1; }
            if (ab0 < need && need <= ab0 + c0) { red[8] = 4 * lane + 0; red[9] = ab0; } }
        __syncthreads();
        T |= (unsigned)red[8] << shift; need -= red[9]; }
    int ceq = 0;
#pragma unroll
    for (int i = 0; i < 8; ++i) ceq += key[i] == T ? 1 : 0;
    const int need_eq = need;
    int eqrank = block_excl_scan_512(ceq, red, wave, lane);
    int selm = 0, csel = 0;
#pragma unroll
    for (int i = 0; i < 8; ++i) { bool sel = key[i] > T; if (key[i] == T) { sel = eqrank < need_eq; ++eqrank; } if (sel) { selm |= 1 << i; ++csel; } }
    int slot = block_excl_scan_512(csel, red, wave, lane);
#pragma unroll
    for (int i = 0; i < 8; ++i) { const int sidx = tid * 8 + i; const int tok = b * SEQ + sidx;
        if (selm & (1 << i)) { const int R = e * 2048 + b * 512 + slot; TOK[R] = tok; GATEV[R] = __uint_as_float(key[i]); SEL[tok * 16 + e] = slot; ++slot; }
        else SEL[tok * 16 + e] = -1; }
    __syncthreads();
}

typedef short bf16x8v __attribute__((ext_vector_type(8)));
typedef short s16x4 __attribute__((ext_vector_type(4)));
constexpr int ML_L = 128, ML_NC = SEQ / ML_L;
constexpr int KP = 272, VP = 528;
constexpr int ML_T0 = 0, ML_T1 = 128 * KP, ML_V = 2 * 128 * KP;
constexpr int ML_AR = ML_V + 128 * VP;
constexpr int ML_END = ML_AR + 24 * 512;
static_assert(ML_AR % 16 == 0, "LDS map");
constexpr size_t WS_UC = WS_HF;
constexpr size_t WS_NU = 6 * MiB;
constexpr size_t WS_SC = 7 * MiB;

__device__ __forceinline__ s16x4 lds_tr(LAS unsigned char* p) { return __builtin_amdgcn_ds_read_tr16_b64_v4i16((LAS s16x4*)p); }
__device__ __forceinline__ bf16x8v frag_tr(LAS unsigned char* tile, int pitch, int k0, int n0, int lane) {
    const int g = lane >> 4, q = (lane & 15) >> 2, p = lane & 3;
    LAS unsigned char* a = tile + (k0 + 8 * g + q) * pitch + (n0 + 4 * p) * 2;
    const s16x4 lo = lds_tr(a), hi = lds_tr(a + 4 * pitch);
    return (bf16x8v){lo[0], lo[1], lo[2], lo[3], hi[0], hi[1], hi[2], hi[3]};
}
__device__ __forceinline__ bf16x8v frag_row(LAS unsigned char* tile, int pitch, int m0, int k0, int lane) {
    return *(LAS bf16x8v*)(tile + (m0 + (lane & 15)) * pitch + (k0 + 8 * (lane >> 4)) * 2);
}
__device__ __forceinline__ float log_sigmoid_f(float f) { return fminf(f, 0.f) - log1pf(__expf(-fabsf(f))); }
__device__ __forceinline__ float shfl_up_f(float v, int o, int lane, float ident) { const float t = __shfl_up(v, o); return lane >= o ? t : ident; }

__device__ __forceinline__ void chunk_gates(const float* GATES, int t0, int h, int dir, int lane, int& s0, int& s1, float& i0, float& i1, float& b0, float& b1, float& btot) {
    const int p0 = 2 * lane, p1 = p0 + 1; s0 = dir ? 127 - p0 : p0; s1 = dir ? 127 - p1 : p1;
    const int icol = dir * 8 + h, fcol = icol + 4;
    const float* gp = GATES + (size_t)t0 * 16;
    const float f0 = log_sigmoid_f(gp[s0 * 16 + fcol]), f1 = log_sigmoid_f(gp[s1 * 16 + fcol]);
    i0 = gp[s0 * 16 + icol]; i1 = gp[s1 * 16 + icol];
    const float s = f0 + f1; float inc = s;
#pragma unroll
    for (int o = 1; o < 64; o <<= 1) inc += shfl_up_f(inc, o, lane, 0.f);
    const float excl = inc - s; b0 = excl + f0; b1 = excl + s; btot = __shfl(inc, 63);
}


__device__ __forceinline__ void conv_chunk4(const bf16* P, const float* cw, const float* cb, int b, int sq0, int chan0, float (&o)[4][8]) {
    const bf16* pc = P + ((size_t)b * SEQ + sq0) * NPROJ + C_MLQ + chan0;
    v4u w[8];
#pragma unroll
    for (int j = 0; j < 8; ++j) { const int ss = sq0 + j - 2; w[j] = (ss >= 0 && ss < SEQ) ? *(const v4u*)(pc + (ptrdiff_t)(j - 2) * NPROJ) : (v4u){0u, 0u, 0u, 0u}; }
    const f32x4 b0 = *(const f32x4*)(cb + chan0), b1 = *(const f32x4*)(cb + chan0 + 4);
#pragma unroll
    for (int t = 0; t < 4; ++t) { o[t][0] = b0[0]; o[t][1] = b0[1]; o[t][2] = b0[2]; o[t][3] = b0[3]; o[t][4] = b1[0]; o[t][5] = b1[1]; o[t][6] = b1[2]; o[t][7] = b1[3]; }
#pragma unroll
    for (int j = 0; j < 5; ++j) { const f32x4 c0 = *(const f32x4*)(cw + j * 1024 + chan0), c1 = *(const f32x4*)(cw + j * 1024 + chan0 + 4);
#pragma unroll
        for (int t = 0; t < 4; ++t) { const v4u x = w[t + j];
            o[t][0] += c0[0] * bflo(x.x); o[t][1] += c0[1] * bfhi(x.x); o[t][2] += c0[2] * bflo(x.y); o[t][3] += c0[3] * bfhi(x.y);
            o[t][4] += c1[0] * bflo(x.z); o[t][5] += c1[1] * bfhi(x.z); o[t][6] += c1[2] * bflo(x.w); o[t][7] += c1[3] * bfhi(x.w); } }
#pragma unroll
    for (int t = 0; t < 4; ++t)
#pragma unroll
        for (int i = 0; i < 8; ++i) o[t][i] = o[t][i] / (1.0f + __expf(-o[t][i]));
}

__device__ __forceinline__ void mlstm_m1_unit(int u, const float* cw, const float* cb, const bf16* P, const float* GATES, bf16* UC, float* NU, float* SC, LAS unsigned char* lds, int tid_, int wave) {
    int tid = tid_; asm volatile("" : "+v"(tid)); const int lane = tid & 63;
    const int c = u & 31, h = (u >> 5) & 3, b = u >> 7; const int t0 = b * SEQ + c * ML_L;
    LAS float* WK = (LAS float*)(lds + ML_AR);
    LAS float* NRED = WK + 256;
    __syncthreads();
    if (wave < 2) { const int dir = wave; int s0, s1; float i0, i1, b0, b1, btot;
        chunk_gates(GATES, t0, h, dir, lane, s0, s1, i0, i1, b0, b1, btot);
        const float g0 = btot - b0 + i0, g1 = btot - b1 + i1; const float mloc = wave_max(fmaxf(g0, g1));
        WK[dir * 128 + s0] = __expf(g0 - mloc); WK[dir * 128 + s1] = __expf(g1 - mloc);
        if (lane == 0) { float* sc = SC + (size_t)((((b * 4 + h) * 2 + dir) * 32) + c) * 4; sc[0] = btot; sc[1] = mloc; } }
#pragma unroll
    for (int i = 0; i < 8; ++i) { const int id = tid + 512 * i, s = id >> 5, ch = id & 31;
        *(LAS v4u*)(lds + ML_V + s * VP + ch * 16) = *(const v4u*)(P + (size_t)(t0 + s) * NPROJ + C_MLV + h * 256 + ch * 8); }
    float k4[4][8]; conv_chunk4(P, cw, cb, b, c * ML_L + 4 * (tid >> 4), 512 + h * 128 + (tid & 15) * 8, k4);
    __syncthreads();
    { float nf[8], nb[8];
#pragma unroll
      for (int j = 0; j < 8; ++j) { nf[j] = 0.f; nb[j] = 0.f; }
#pragma unroll
      for (int i = 0; i < 4; ++i) { const int s = 4 * (tid >> 4) + i, ch = tid & 15; const float (&k)[8] = k4[i];
        const float wf = WK[s], wb = WK[128 + s];
        v4u of, ob; of.x = pk2(k[0] * wf, k[1] * wf); of.y = pk2(k[2] * wf, k[3] * wf); of.z = pk2(k[4] * wf, k[5] * wf); of.w = pk2(k[6] * wf, k[7] * wf);
        ob.x = pk2(k[0] * wb, k[1] * wb); ob.y = pk2(k[2] * wb, k[3] * wb); ob.z = pk2(k[4] * wb, k[5] * wb); ob.w = pk2(k[6] * wb, k[7] * wb);
        *(LAS v4u*)(lds + ML_T0 + s * KP + ch * 16) = of; *(LAS v4u*)(lds + ML_T1 + s * KP + ch * 16) = ob;
#pragma unroll
        for (int j = 0; j < 8; ++j) { nf[j] += k[j] * wf; nb[j] += k[j] * wb; } }
#pragma unroll
      for (int j = 0; j < 8; ++j) { nf[j] += __shfl_xor(nf[j], 16); nf[j] += __shfl_xor(nf[j], 32); nb[j] += __shfl_xor(nb[j], 16); nb[j] += __shfl_xor(nb[j], 32); }
      if ((lane >> 4) == 0) {
#pragma unroll
          for (int j = 0; j < 8; ++j) { NRED[wave * 256 + (lane & 15) * 8 + j] = nf[j]; NRED[wave * 256 + 128 + (lane & 15) * 8 + j] = nb[j]; } } }
    __syncthreads();
    if (tid < 256) { const int dir = tid >> 7, d = tid & 127; float sum = 0.f;
#pragma unroll
        for (int w = 0; w < 8; ++w) sum += NRED[w * 256 + tid];
        NU[(size_t)((((b * 4 + h) * 2 + dir) * 32) + c) * 128 + d] = sum; }
    const int g = lane >> 4;
#pragma unroll 1
    for (int dir = 0; dir < 2; ++dir) {
        LAS unsigned char* Kt = lds + (dir ? ML_T1 : ML_T0);
        f32x4 acc[8][2];
#pragma unroll
        for (int mb = 0; mb < 8; ++mb) { acc[mb][0] = (f32x4){0.f, 0.f, 0.f, 0.f}; acc[mb][1] = (f32x4){0.f, 0.f, 0.f, 0.f}; }
#pragma unroll
        for (int ks = 0; ks < 4; ++ks) {
            const bf16x8v b0 = frag_tr(lds + ML_V, VP, 32 * ks, 32 * wave, lane), b1 = frag_tr(lds + ML_V, VP, 32 * ks, 32 * wave + 16, lane);
#pragma unroll
            for (int mb = 0; mb < 8; ++mb) { const bf16x8v a = frag_tr(Kt, KP, 32 * ks, 16 * mb, lane);
                acc[mb][0] = __builtin_amdgcn_mfma_f32_16x16x32_bf16(a, b0, acc[mb][0], 0, 0, 0); acc[mb][1] = __builtin_amdgcn_mfma_f32_16x16x32_bf16(a, b1, acc[mb][1], 0, 0, 0); } }
        bf16* uc = UC + (size_t)((((b * 4 + h) * 2 + dir) * 32) + c) * 32768;
#pragma unroll
        for (int mb = 0; mb < 8; ++mb)
#pragma unroll
            for (int nb = 0; nb < 2; ++nb) { const int e = 32 * wave + 16 * nb + (lane & 15), d0 = 16 * mb + 4 * g; v2u w; w.x = pk2(acc[mb][nb][0], acc[mb][nb][1]); w.y = pk2(acc[mb][nb][2], acc[mb][nb][3]);
                *(v2u*)(uc + e * 128 + d0) = w; }
    }
}

__device__ __forceinline__ void mlstm_m2(bf16* UC, float* NU, float* SC, int gtid, int nthreads) {
    for (int vid = gtid; vid < 32 * 4096; vid += nthreads) { const int chain = vid >> 12, within = vid & 4095, dir = chain & 1;
        float st[8]; float m = 0.f;
#pragma unroll
        for (int i = 0; i < 8; ++i) st[i] = 0.f;
#pragma unroll 4
        for (int step = 0; step < ML_NC; ++step) { const int c = dir ? ML_NC - 1 - step : step;
            float* sc = SC + (size_t)(chain * 32 + c) * 4; const float btot = sc[0], mloc = sc[1];
            v4u* p = (v4u*)(UC + ((size_t)(chain * 32 + c) * 4096 + within) * 8);
            const v4u uw = *p;
            v4u cw; cw.x = pk2(st[0], st[1]); cw.y = pk2(st[2], st[3]); cw.z = pk2(st[4], st[5]); cw.w = pk2(st[6], st[7]);
            *p = cw;
            if (within == 0) sc[2] = m;
            const float mn = fmaxf(btot + m, mloc), dC = __expf(btot + m - mn), dU = __expf(mloc - mn);
            const float uu[8] = {bflo(uw.x), bfhi(uw.x), bflo(uw.y), bfhi(uw.y), bflo(uw.z), bfhi(uw.z), bflo(uw.w), bfhi(uw.w)};
#pragma unroll
            for (int i = 0; i < 8; ++i) st[i] = dC * st[i] + dU * uu[i];
            m = mn; } }
    for (int nid = gtid; nid < 32 * 128; nid += nthreads) { const int chain = nid >> 7, d = nid & 127, dir = chain & 1; float st = 0.f, m = 0.f;
        for (int step = 0; step < ML_NC; ++step) { const int c = dir ? ML_NC - 1 - step : step;
            const float* sc = SC + (size_t)(chain * 32 + c) * 4; const float btot = sc[0], mloc = sc[1];
            float* p = NU + (size_t)(chain * 32 + c) * 128 + d; const float uu = *p; *p = st;
            const float mn = fmaxf(btot + m, mloc); st = __expf(btot + m - mn) * st + __expf(mloc - mn) * uu; m = mn; } }
}

__device__ __forceinline__ void mlstm_m3_unit(int u, const float* cw, const float* cb, const bf16* P, const float* GATES, const bf16* UC, const float* NU, const float* SC, const float* mlg, const float* RSNA, bf16* MIX, LAS unsigned char* lds, int tid_, int wave) {
    int tid = tid_; asm volatile("" : "+v"(tid)); const int lane = tid & 63;
    const int c = u & 31, h = (u >> 5) & 3, b = u >> 7; const int t0 = b * SEQ + c * ML_L;
    LAS float* AR = (LAS float*)(lds + ML_AR);
    LAS float* CS = AR; LAS float* RR = AR + 256; LAS float* INTER = AR + 512; LAS float* EM = AR + 768; LAS float* ALPHA = AR + 1024; LAS float* SS = AR + 1280;
    const int g = lane >> 4, lc = lane & 15;
    const int chain0 = (b * 4 + h) * 2;
    __syncthreads();
    if (wave < 2) { const int dir = wave; int s0, s1; float i0, i1, b0, b1, btot;
        chunk_gates(GATES, t0, h, dir, lane, s0, s1, i0, i1, b0, b1, btot);
        const float cs0 = i0 - b0, cs1 = i1 - b1;
        float pmx = fmaxf(cs0, cs1);
#pragma unroll
        for (int o = 1; o < 64; o <<= 1) pmx = fmaxf(pmx, shfl_up_f(pmx, o, lane, -3.0e38f));
        const float ex = shfl_up_f(pmx, 1, lane, -3.0e38f);
        const float pm0 = fmaxf(ex, cs0), pm1 = fmaxf(pm0, cs1);
        const float m_in = SC[(size_t)((chain0 + dir) * 32 + c) * 4 + 2];
        const float M0 = b0 + fmaxf(m_in, pm0), M1 = b1 + fmaxf(m_in, pm1);
        CS[dir * 128 + s0] = cs0; CS[dir * 128 + s1] = cs1; RR[dir * 128 + s0] = b0 - M0; RR[dir * 128 + s1] = b1 - M1;
        INTER[dir * 128 + s0] = __expf(b0 + m_in - M0); INTER[dir * 128 + s1] = __expf(b1 + m_in - M1); EM[dir * 128 + s0] = __expf(-M0); EM[dir * 128 + s1] = __expf(-M1); }
    { const int s0 = 4 * (tid >> 4), ch = tid & 15; float x4[4][8];
      conv_chunk4(P, cw, cb, b, c * ML_L + s0, h * 128 + ch * 8, x4);
      const float qs = 0.08838834764831845f;
#pragma unroll
      for (int i = 0; i < 4; ++i) { v4u oq; oq.x = pk2(x4[i][0] * qs, x4[i][1] * qs); oq.y = pk2(x4[i][2] * qs, x4[i][3] * qs); oq.z = pk2(x4[i][4] * qs, x4[i][5] * qs); oq.w = pk2(x4[i][6] * qs, x4[i][7] * qs);
          *(LAS v4u*)(lds + ML_T0 + (s0 + i) * KP + ch * 16) = oq; }
      conv_chunk4(P, cw, cb, b, c * ML_L + s0, 512 + h * 128 + ch * 8, x4);
#pragma unroll
      for (int i = 0; i < 4; ++i) { v4u ok; ok.x = pk2(x4[i][0], x4[i][1]); ok.y = pk2(x4[i][2], x4[i][3]); ok.z = pk2(x4[i][4], x4[i][5]); ok.w = pk2(x4[i][6], x4[i][7]);
          *(LAS v4u*)(lds + ML_T1 + (s0 + i) * KP + ch * 16) = ok; } }
#pragma unroll
    for (int i = 0; i < 8; ++i) { const int id = tid + 512 * i, s = id >> 5, ch = id & 31;
        *(LAS v4u*)(lds + ML_V + s * VP + ch * 16) = *(const v4u*)(P + (size_t)(t0 + s) * NPROJ + C_MLV + h * 256 + ch * 8); }
    __syncthreads();
    f32x4 S[8], qn = (f32x4){0.f, 0.f, 0.f, 0.f};
#pragma unroll
    for (int nb = 0; nb < 8; ++nb) S[nb] = (f32x4){0.f, 0.f, 0.f, 0.f};
#pragma unroll
    for (int ks = 0; ks < 4; ++ks) { const bf16x8v a = frag_row(lds + ML_T0, KP, 16 * wave, 32 * ks, lane);
        bf16x8v nf = (bf16x8v){0, 0, 0, 0, 0, 0, 0, 0};
        if (lc < 2) { const float* np = NU + (size_t)((chain0 + lc) * 32 + c) * 128 + 32 * ks + 8 * g; const f32x4 n0 = *(const f32x4*)np, n1 = *(const f32x4*)(np + 4);
            const unsigned w0 = pk2(n0[0], n0[1]), w1 = pk2(n0[2], n0[3]), w2 = pk2(n1[0], n1[1]), w3 = pk2(n1[2], n1[3]);
            nf = (bf16x8v){(short)(w0 & 0xffff), (short)(w0 >> 16), (short)(w1 & 0xffff), (short)(w1 >> 16), (short)(w2 & 0xffff), (short)(w2 >> 16), (short)(w3 & 0xffff), (short)(w3 >> 16)}; }
        qn = __builtin_amdgcn_mfma_f32_16x16x32_bf16(a, nf, qn, 0, 0, 0);
#pragma unroll
        for (int nb = 0; nb < 8; ++nb) { const bf16x8v kb = frag_row(lds + ML_T1, KP, 16 * nb, 32 * ks, lane); S[nb] = __builtin_amdgcn_mfma_f32_16x16x32_bf16(a, kb, S[nb], 0, 0, 0); } }
    float csf[8], csb[8];
#pragma unroll
    for (int nb = 0; nb < 8; ++nb) { csf[nb] = CS[16 * nb + lc]; csb[nb] = CS[128 + 16 * nb + lc]; }
    float pc[8][4];
#pragma unroll
    for (int r = 0; r < 4; ++r) { const int j = 16 * wave + 4 * g + r; const float Rf = RR[j], Rb = RR[128 + j];
        const float qnf = __shfl(qn[r], 16 * g), qnb = __shfl(qn[r], 16 * g + 1);
        float sf[8], sb[8], rsf = 0.f, rsb = 0.f;
#pragma unroll
        for (int nb = 0; nb < 8; ++nb) { const int s = 16 * nb + lc; const float wf = s <= j ? __expf(Rf + csf[nb]) : 0.f, wb = s >= j ? __expf(Rb + csb[nb]) : 0.f;
            sf[nb] = S[nb][r] * wf; sb[nb] = S[nb][r] * wb; rsf += sf[nb]; rsb += sb[nb]; }
#pragma unroll
        for (int o = 1; o < 16; o <<= 1) { rsf += __shfl_xor(rsf, o); rsb += __shfl_xor(rsb, o); }
        const float inf_ = INTER[j], inb_ = INTER[128 + j];
        const float ivf = 1.0f / fmaxf(fabsf(inf_ * qnf + rsf), EM[j]), ivb = 1.0f / fmaxf(fabsf(inb_ * qnb + rsb), EM[128 + j]);
#pragma unroll
        for (int nb = 0; nb < 8; ++nb) pc[nb][r] = sf[nb] * ivf + sb[nb] * ivb;
        if (lc == 0) { ALPHA[j] = inf_ * ivf; ALPHA[128 + j] = inb_ * ivb; } }
    __syncthreads();
#pragma unroll
    for (int r = 0; r < 4; ++r) { const int j = 16 * wave + 4 * g + r;
#pragma unroll
        for (int nb = 0; nb < 8; ++nb) *(LAS unsigned short*)(lds + ML_T1 + j * KP + (16 * nb + lc) * 2) = (unsigned short)f2bf(pc[nb][r]); }
    __syncthreads();
    f32x4 acc[2][8], acc2[2][8];
#pragma unroll
    for (int mb = 0; mb < 2; ++mb)
#pragma unroll
        for (int nb = 0; nb < 8; ++nb) { acc[mb][nb] = (f32x4){0.f, 0.f, 0.f, 0.f}; acc2[mb][nb] = (f32x4){0.f, 0.f, 0.f, 0.f}; }
    const bf16* ucf = UC + (size_t)((chain0 + 0) * 32 + c) * 32768 + (size_t)(32 * wave + lc) * 128 + 8 * g;
    const bf16* ucb = UC + (size_t)((chain0 + 1) * 32 + c) * 32768 + (size_t)(32 * wave + lc) * 128 + 8 * g;
#pragma unroll
    for (int ks = 0; ks < 4; ++ks) {
        const bf16x8v af0 = *(const bf16x8v*)(ucf + 32 * ks), af1 = *(const bf16x8v*)(ucf + 16 * 128 + 32 * ks), ab0 = *(const bf16x8v*)(ucb + 32 * ks), ab1 = *(const bf16x8v*)(ucb + 16 * 128 + 32 * ks);
#pragma unroll
        for (int nb = 0; nb < 8; ++nb) { const bf16x8v qb = frag_row(lds + ML_T0, KP, 16 * nb, 32 * ks, lane);
            acc[0][nb] = __builtin_amdgcn_mfma_f32_16x16x32_bf16(af0, qb, acc[0][nb], 0, 0, 0); acc[1][nb] = __builtin_amdgcn_mfma_f32_16x16x32_bf16(af1, qb, acc[1][nb], 0, 0, 0);
            acc2[0][nb] = __builtin_amdgcn_mfma_f32_16x16x32_bf16(ab0, qb, acc2[0][nb], 0, 0, 0); acc2[1][nb] = __builtin_amdgcn_mfma_f32_16x16x32_bf16(ab1, qb, acc2[1][nb], 0, 0, 0); } }
#pragma unroll
    for (int nb = 0; nb < 8; ++nb) { const float af = ALPHA[16 * nb + lc], ab = ALPHA[128 + 16 * nb + lc];
        acc[0][nb] = acc[0][nb] * af + acc2[0][nb] * ab; acc[1][nb] = acc[1][nb] * af + acc2[1][nb] * ab; }
#pragma unroll
    for (int ks = 0; ks < 4; ++ks) {
        const bf16x8v v0 = frag_tr(lds + ML_V, VP, 32 * ks, 32 * wave, lane), v1 = frag_tr(lds + ML_V, VP, 32 * ks, 32 * wave + 16, lane);
#pragma unroll
        for (int nb = 0; nb < 8; ++nb) { const bf16x8v pb = frag_row(lds + ML_T1, KP, 16 * nb, 32 * ks, lane);
            acc[0][nb] = __builtin_amdgcn_mfma_f32_16x16x32_bf16(v0, pb, acc[0][nb], 0, 0, 0); acc[1][nb] = __builtin_amdgcn_mfma_f32_16x16x32_bf16(v1, pb, acc[1][nb], 0, 0, 0); } }
#pragma unroll
    for (int nb = 0; nb < 8; ++nb) { float ss = 0.f;
#pragma unroll
        for (int mb = 0; mb < 2; ++mb) ss += (acc[mb][nb][0] * acc[mb][nb][0] + acc[mb][nb][1] * acc[mb][nb][1]) + (acc[mb][nb][2] * acc[mb][nb][2] + acc[mb][nb][3] * acc[mb][nb][3]);
        ss += __shfl_xor(ss, 16); ss += __shfl_xor(ss, 32);
        if (g == 0) SS[wave * 128 + 16 * nb + lc] = ss; }
    __syncthreads();
#pragma unroll
    for (int nb = 0; nb < 8; ++nb) { const int j = 16 * nb + lc; float tot = 0.f;
#pragma unroll
        for (int w = 0; w < 8; ++w) tot += SS[w * 128 + j];
        const float rstd = 1.0f / (sqrtf(tot * (1.0f / 256.0f) + EPS) * RSNA[t0 + j]);
#pragma unroll
        for (int mb = 0; mb < 2; ++mb) { const int e0 = 32 * wave + 16 * mb + 4 * g; const size_t t = (size_t)(t0 + j);
            const v2u ow = *(const v2u*)(P + t * NPROJ + C_MLO + h * 256 + e0); const f32x4 gg = *(const f32x4*)(mlg + h * 256 + e0);
            const float o[4] = {bflo(ow.x), bfhi(ow.x), bflo(ow.y), bfhi(ow.y)}; float rr[4];
#pragma unroll
            for (int r = 0; r < 4; ++r) rr[r] = acc[mb][nb][r] * rstd * gg[r] / (1.0f + __expf(-o[r]));
            v2u w; w.x = pk2(rr[0], rr[1]); w.y = pk2(rr[2], rr[3]);
            *(v2u*)(MIX + t * D + 1024 + h * 256 + e0) = w; } }
}


#ifndef NA_PROBE
#define NA_PROBE 0
#endif
constexpr int NA_TILE = 64 * KP, NA_BUF = 2 * NA_TILE, NA_RPB = 2 * NA_BUF;
static_assert(NA_RPB + 15 * 128 * 4 <= ML_END, "LDS map");
__device__ __forceinline__ bf16x8v frag_tr2(LAS unsigned char* tile, int pitch, int row0, int row1, int n0, int lane) {
    const int q = (lane & 15) >> 2, p = lane & 3;
    const s16x4 lo = lds_tr(tile + (row0 + q) * pitch + (n0 + 4 * p) * 2), hi = lds_tr(tile + (row1 + q) * pitch + (n0 + 4 * p) * 2);
    return (bf16x8v){lo[0], lo[1], lo[2], lo[3], hi[0], hi[1], hi[2], hi[3]};
}
__device__ __forceinline__ void na_unit(int u, const bf16* P, const float* rpb, bf16* MIX, float* SSQ, LAS unsigned char* lds, int tid_, int wave) {
    int tid = tid_; asm volatile("" : "+v"(tid)); const int lane = tid & 63, g = lane >> 4, lc = lane & 15;
    const int r4 = u & 15, h = (u >> 4) & 7, b = u >> 7;
    const int r0 = 4 * r4, r = r0 + (wave >> 1), qh = wave & 1;
    const int rs = min(max(r - 4, 0), 56), rs0 = min(max(r0 - 4, 0), 56), nk = min(max(r0 + 3 - 4, 0), 56) + 8 - rs0;
    LAS float* RPB = (LAS float*)(lds + NA_RPB);
    const int sA = tid >> 4, chA = tid & 15, sB = sA + 32;
    const bf16* gsrc = P + ((size_t)b * SEQ + rs0 * 64) * NPROJ + h * 128 + chA * 8;
    v4u pk0, pk1, pv0, pv1;
#define NA_LOAD(j) do { const bf16* s_ = gsrc + (size_t)(j) * 64 * NPROJ; pk0 = *(const v4u*)(s_ + (size_t)sA * NPROJ + C_NAK); pk1 = *(const v4u*)(s_ + (size_t)sB * NPROJ + C_NAK); \
        pv0 = *(const v4u*)(s_ + (size_t)sA * NPROJ + C_NAV); pv1 = *(const v4u*)(s_ + (size_t)sB * NPROJ + C_NAV); } while (0)
#define NA_STORE(buf) do { LAS unsigned char* t_ = lds + (buf) * NA_BUF; *(LAS v4u*)(t_ + sA * KP + chA * 16) = pk0; *(LAS v4u*)(t_ + sB * KP + chA * 16) = pk1; \
        *(LAS v4u*)(t_ + NA_TILE + sA * KP + chA * 16) = pv0; *(LAS v4u*)(t_ + NA_TILE + sB * KP + chA * 16) = pv1; } while (0)
    NA_LOAD(0);
    __syncthreads();
    for (int i = tid; i < 15 * 128; i += 512) { const int dr = i >> 7, x = (i & 127) - 48; RPB[i] = (x >= 0 && x < 31) ? rpb[h * 465 + dr * 31 + x] * 1.4426950408889634f : 0.f; }
    NA_STORE(0);
    bf16x8v qf[2][4]; int cq[2], cs[2], boff[2]; float m[2], l[2]; f32x4 O[2][8]; f32x4 madd[2][4];
#pragma unroll
    for (int qi = 0; qi < 2; ++qi) { cq[qi] = 32 * qh + 16 * qi + lc; cs[qi] = min(max(cq[qi] - 8, 0), 48); m[qi] = -1.0e30f; l[qi] = 0.f; boff[qi] = 63 - cq[qi] + 4 * g;
#pragma unroll
        for (int kb = 0; kb < 4; ++kb)
#pragma unroll
            for (int rr = 0; rr < 4; ++rr) { const int kc = 16 * kb + 4 * g + rr; madd[qi][kb][rr] = (kc >= cs[qi] && kc < cs[qi] + 16) ? 0.f : -1.0e30f; }
        const bf16* qp = P + ((size_t)b * SEQ + r * 64 + cq[qi]) * NPROJ + C_NAQ + h * 128 + 8 * g;
#pragma unroll
        for (int ks = 0; ks < 4; ++ks) qf[qi][ks] = *(const bf16x8v*)(qp + 32 * ks);
#pragma unroll
        for (int db = 0; db < 8; ++db) O[qi][db] = (f32x4){0.f, 0.f, 0.f, 0.f}; }
    __syncthreads();
#pragma unroll 1
    for (int j = 0; j < nk; ++j) {
        const int kr = rs0 + j;
        if (j + 1 < nk) NA_LOAD(j + 1);
        if (kr >= rs && kr < rs + 8) {
            LAS unsigned char* Kt = lds + (j & 1) * NA_BUF; LAS unsigned char* Vt = Kt + NA_TILE;
            const LAS float* brow = RPB + (kr - r + 7) * 128;
            const int kb0a = qh ? 1 : 0, kb1a = qh ? 3 : 1, kb0b = qh ? 2 : 0, kb1b = qh ? 3 : 2;
            f32x4 s[2][4];
#if NA_PROBE == 1
            for (int prb = 0; prb < 2; ++prb) { asm volatile("" ::: "memory");
#else
            {
#endif
#pragma unroll
            for (int kb = 0; kb < 4; ++kb) { s[0][kb] = (f32x4){0.f, 0.f, 0.f, 0.f}; s[1][kb] = (f32x4){0.f, 0.f, 0.f, 0.f}; }
#pragma unroll
            for (int kb = 0; kb < 4; ++kb) { const bool ua = kb >= kb0a && kb <= kb1a, ub = kb >= kb0b && kb <= kb1b;
                if (ua || ub) {
#pragma unroll
                    for (int ks = 0; ks < 4; ++ks) { const bf16x8v ka = frag_row(Kt, KP, 16 * kb, 32 * ks, lane);
                        if (ua) s[0][kb] = __builtin_amdgcn_mfma_f32_16x16x32_bf16(ka, qf[0][ks], s[0][kb], 0, 0, 0);
                        if (ub) s[1][kb] = __builtin_amdgcn_mfma_f32_16x16x32_bf16(ka, qf[1][ks], s[1][kb], 0, 0, 0); } } }
            }
            bf16x8v pb[2][2];
#pragma unroll
            for (int qi = 0; qi < 2; ++qi) {
                const int k0 = qi ? kb0b : kb0a, k1 = qi ? kb1b : kb1a; const LAS float* bq = brow + boff[qi];
                float mx = -1.0e30f;
#pragma unroll
                for (int kb = 0; kb < 4; ++kb) if (kb >= k0 && kb <= k1) {
#pragma unroll
                    for (int rr = 0; rr < 4; ++rr) { const float v = s[qi][kb][rr] * 0.12753785f + bq[16 * kb + rr] + madd[qi][kb][rr]; s[qi][kb][rr] = v; mx = fmaxf(mx, v); } }
                mx = fmaxf(mx, __shfl_xor(mx, 16)); mx = fmaxf(mx, __shfl_xor(mx, 32));
                const float mn = fmaxf(m[qi], mx); float ls = 0.f;
#pragma unroll
                for (int kb = 0; kb < 4; ++kb) { if (kb >= k0 && kb <= k1) {
#pragma unroll
                    for (int rr = 0; rr < 4; ++rr) { const float p = __builtin_amdgcn_exp2f(s[qi][kb][rr] - mn); s[qi][kb][rr] = p; ls += p; } } else s[qi][kb] = (f32x4){0.f, 0.f, 0.f, 0.f}; }
                ls += __shfl_xor(ls, 16); ls += __shfl_xor(ls, 32);
                if (!__all(mn == m[qi])) { const float corr = __builtin_amdgcn_exp2f(m[qi] - mn); l[qi] *= corr;
#pragma unroll
                    for (int db = 0; db < 8; ++db) O[qi][db] = O[qi][db] * corr; }
                l[qi] += ls; m[qi] = mn;
#pragma unroll
                for (int t = 0; t < 2; ++t) { v4u pw; pw.x = pk2(s[qi][2 * t][0], s[qi][2 * t][1]); pw.y = pk2(s[qi][2 * t][2], s[qi][2 * t][3]); pw.z = pk2(s[qi][2 * t + 1][0], s[qi][2 * t + 1][1]); pw.w = pk2(s[qi][2 * t + 1][2], s[qi][2 * t + 1][3]);
                    pb[qi][t] = __builtin_bit_cast(bf16x8v, pw); }
            }
#if NA_PROBE == 2
            for (int prb = 0; prb < 2; ++prb) { asm volatile("" ::: "memory"); if (prb) { pb[0][0] = pb[0][1] = pb[1][0] = pb[1][1] = (bf16x8v){0, 0, 0, 0, 0, 0, 0, 0}; }
#else
            {
#endif
#pragma unroll
            for (int t = 0; t < 2; ++t) { const bool ua = 2 * t + 1 >= kb0a && 2 * t <= kb1a, ub = 2 * t + 1 >= kb0b && 2 * t <= kb1b;
                if (ua || ub) {
#pragma unroll
                    for (int db = 0; db < 8; ++db) { const bf16x8v va = frag_tr2(Vt, KP, 32 * t + 4 * g, 32 * t + 16 + 4 * g, 16 * db, lane);
                        if (ua) O[0][db] = __builtin_amdgcn_mfma_f32_16x16x32_bf16(va, pb[0][t], O[0][db], 0, 0, 0);
                        if (ub) O[1][db] = __builtin_amdgcn_mfma_f32_16x16x32_bf16(va, pb[1][t], O[1][db], 0, 0, 0); } } }
            }
        }
#if NA_PROBE == 4
        if (j + 1 < nk) { NA_STORE((j + 1) & 1); asm volatile("" ::: "memory"); }
#endif
#if NA_PROBE == 5
        __syncthreads();
#endif
        if (j + 1 < nk) NA_STORE((j + 1) & 1);
        __syncthreads();
    }
#pragma unroll
    for (int qi = 0; qi < 2; ++qi) { const float inv = 1.0f / l[qi]; const size_t t = (size_t)b * SEQ + r * 64 + cq[qi]; bf16* op = MIX + t * D + h * 128 + 4 * g; float ss = 0.f;
#pragma unroll
        for (int db = 0; db < 8; ++db) { const f32x4 o = O[qi][db] * inv; ss += (o[0] * o[0] + o[1] * o[1]) + (o[2] * o[2] + o[3] * o[3]); v2u w; w.x = pk2(o[0], o[1]); w.y = pk2(o[2], o[3]); *(v2u*)(op + 16 * db) = w; }
        ss += __shfl_xor(ss, 16); ss += __shfl_xor(ss, 32);
        if (g == 0) SSQ[t * 8 + h] = ss; }
#undef NA_LOAD
#undef NA_STORE
}


constexpr int NWAVES = 8;
constexpr int RING_BYTES = 131072;
constexpr int LDSCTL_OFF = ML_END, MISC_OFF = LDSCTL_OFF + 320;
constexpr int LDS_BYTES = LDSCTL_OFF + 1024;
static_assert(ML_END >= RING_BYTES && LDS_BYTES <= 163840, "LDS map");
constexpr int CW_BAR = 4096;
constexpr size_t CTL_ZERO_BYTES = 65536;
static_assert((CW_BAR + XCD_BAR_WORDS) * 4 <= (int)CTL_ZERO_BYTES, "barrier words inside the memset region");

struct MKArgs { const float* in[16]; float* out; unsigned char* ws; };
__global__ void __launch_bounds__(NWAVES * 64, 2) mk_fwd(MKArgs args) {
    extern __shared__ __attribute__((aligned(16))) unsigned char lds_raw[];
    LAS unsigned char* lds = (LAS unsigned char*)lds_raw;
    volatile LAS unsigned* MISC = (volatile LAS unsigned*)(lds + MISC_OFF);
    const int tid = threadIdx.x, lane0 = tid & 63, wave = __builtin_amdgcn_readfirstlane(tid >> 6);
    const int G = gridDim.x; const int bx = blockIdx.x; const int vcu = (G % 8 == 0) ? (bx % 8) * (G / 8) + bx / 8 : bx;
    const int gw0 = vcu * NWAVES + wave, ngw = G * NWAVES;
    unsigned char* ws = args.ws;
    for (int u = tid; u < (LDS_BYTES - LDSCTL_OFF) / 4; u += NWAVES * 64) ((LAS unsigned*)(lds + LDSCTL_OFF))[u] = 0u;
    __syncthreads();
    XcdBarrier bar = xcd_barrier_post((unsigned*)(ws + WS_CTL) + CW_BAR, MISC + 8);
#define GRID_BAR() do { XcdBarrier b_ = bar; asm volatile("" : "+s"(b_.bar), "+s"(b_.x)); xcd_barrier(b_); } while (0)
    const float* x = args.in[0]; const float* norm_mix_g = args.in[1]; const float* w_in = args.in[2]; const float* b_gates = args.in[3];
    const float* conv_w = args.in[4]; const float* conv_b = args.in[5]; const float* na_rpb = args.in[6]; const float* na_norm_g = args.in[7];
    const float* ml_norm_g = args.in[8]; const float* w_out = args.in[9]; const float* norm_ffn_g = args.in[10]; const float* w_router = args.in[11];
    const float* w_gate = args.in[12]; const float* w_up = args.in[13]; const float* w_down = args.in[14]; const float* final_norm_g = args.in[15];
#define WSPTRS(wsl, Xl) float* X = (Xl); float* RSTD = (float*)((wsl) + WS_RSTD); float* GATES = (float*)((wsl) + WS_GATES); float* AFF = (float*)((wsl) + WS_AFF); int* TOK = (int*)((wsl) + WS_TOK); float* GATEV = (float*)((wsl) + WS_GATEV); int* SEL = (int*)((wsl) + WS_SEL); \
    bf16* XB = (bf16*)((wsl) + WS_XB); bf16* MIX = (bf16*)((wsl) + WS_MIX); bf16* P = (bf16*)((wsl) + WS_P); bf16* NAO = (bf16*)((wsl) + WS_NAO); bf16* ACT = (bf16*)((wsl) + WS_ACT); bf16* Y = (bf16*)((wsl) + WS_Y); \
    (void)X; (void)RSTD; (void)GATES; (void)AFF; (void)TOK; (void)GATEV; (void)SEL; (void)XB; (void)MIX; (void)P; (void)NAO; (void)ACT; (void)Y;
#define LAUNDER(p) asm volatile("" : "+s"(p))
#ifndef REP_MASK
#define REP_MASK 0
#endif
#if (REP_MASK >> 0) & 1
#define REP0 for (int rep_ = 0; rep_ < 2; ++rep_)
#else
#define REP0
#endif
#if (REP_MASK >> 1) & 1
#define REP1 for (int rep_ = 0; rep_ < 2; ++rep_)
#else
#define REP1
#endif
#if (REP_MASK >> 2) & 1
#define REP2 for (int rep_ = 0; rep_ < 2; ++rep_)
#else
#define REP2
#endif
#if (REP_MASK >> 3) & 1
#define REP3 for (int rep_ = 0; rep_ < 2; ++rep_)
#else
#define REP3
#endif
#if (REP_MASK >> 4) & 1
#define REP4 for (int rep_ = 0; rep_ < 2; ++rep_)
#else
#define REP4
#endif
#if (REP_MASK >> 5) & 1
#define REP5 for (int rep_ = 0; rep_ < 2; ++rep_)
#else
#define REP5
#endif
#if (REP_MASK >> 6) & 1
#define REP6 for (int rep_ = 0; rep_ < 2; ++rep_)
#else
#define REP6
#endif
#if (REP_MASK >> 7) & 1
#define REP7 for (int rep_ = 0; rep_ < 2; ++rep_)
#else
#define REP7
#endif
#if (REP_MASK >> 8) & 1
#define REP8 for (int rep_ = 0; rep_ < 2; ++rep_)
#else
#define REP8
#endif
#if (REP_MASK >> 9) & 1
#define REP9 for (int rep_ = 0; rep_ < 2; ++rep_)
#else
#define REP9
#endif
#if (REP_MASK >> 10) & 1
#define REP10 for (int rep_ = 0; rep_ < 2; ++rep_)
#else
#define REP10
#endif
#if (REP_MASK >> 11) & 1
#define REP11 for (int rep_ = 0; rep_ < 2; ++rep_)
#else
#define REP11
#endif
#if (REP_MASK >> 12) & 1
#define REP12 for (int rep_ = 0; rep_ < 2; ++rep_)
#else
#define REP12
#endif
#if (REP_MASK >> 13) & 1
#define REP13 for (int rep_ = 0; rep_ < 2; ++rep_)
#else
#define REP13
#endif

    { WSPTRS(ws, args.out)
      const int lane = lane0, gw = gw0;
    REP0 { ConvArgs ca; ca.w_in = w_in; ca.w_out = w_out; ca.w_gate = w_gate; ca.w_up = w_up; ca.w_down = w_down; ca.norm_mix_g = norm_mix_g; ca.norm_ffn_g = norm_ffn_g; ca.na_norm_g = na_norm_g; ca.ws = ws;
      LAS float* scr = (LAS float*)(lds + wave * CONV_SCR_BYTES);
      convert_stream(ca, gw, ngw, DEPTH * CI_LAYER, scr, lane); }
    { bf16* W16F = (bf16*)(ws + WS_W16F_OFF);
      for (int it = gw; it < DEPTH * 2 * 64; it += ngw) { const int mi = it >> 6, s = it & 63, l = mi >> 1;
          if (mi & 1) w16f_item(w_router + (size_t)l * D * NE, NE, norm_ffn_g + l * D, W16F + (size_t)mi * 32768, s, lane);
          else w16f_item(w_in + (size_t)l * D * NIN + C_GATES, NIN, norm_mix_g + l * D, W16F + (size_t)mi * 32768, s, lane); } }
    GRID_BAR();
    REP1 { RowArgs a; a.src32 = x; a.srcb = nullptr; a.sel = nullptr; a.Y = nullptr; a.XB = XB; a.XB8 = ws + WS_XB8; a.RSTD = RSTD; a.g = norm_mix_g; a.W16F = (const bf16*)(ws + WS_W16F_OFF); a.bias = b_gates; a.GATES = GATES; a.AFF = AFF; a.out = X; a.mode = 0; a.wrxb = 1;
      for (int grp = gw; grp < MTOK / 8; grp += ngw) rowpass_group<true>(a, grp, lane); } }
    GRID_BAR();

    for (int l = 0; l < DEPTH; ++l) {
        unsigned char* wsl = ws; float* Xl = args.out; LAUNDER(wsl); LAUNDER(Xl);
        WSPTRS(wsl, Xl)
        int lane = lane0, gw = gw0; asm volatile("" : "+v"(lane)); LAUNDER(gw);
        const bf16* WinT = (const bf16*)(wsl + WS_WIN) + (size_t)l * NPROJ * D; const bf16* WoutT = (const bf16*)(wsl + WS_WOUT) + (size_t)l * D * D;
        const bf16* WguT = (const bf16*)(wsl + WS_WGU) + (size_t)l * NE * 2048 * D; const bf16* WdT = (const bf16*)(wsl + WS_WD) + (size_t)l * NE * D * DE;
        REP2 { pg8::Gemm g{XB, WinT, MTOK, NPROJ16, D, 0}; pg8::StaticOrder S; S.init(MTOK, NPROJ16, G, bx); pg8::EpiRowScaleBf16 E{P, RSTD, nullptr, NPROJ, 0, 1.0f, 0};
          pg8::gemm_phase<pg8::EpiRowScaleBf16, pg8::StaticOrder, true, true>(lds, g, S, E); }
        { pg8::Gemm g{(const bf16*)(wsl + WS_XB8), (const bf16*)(wsl + WS_WIN + ((size_t)l * NPROJ + NPROJ16) * D * 2), MTOK, NPROJ - NPROJ16, D / 2, 0}; pg8::StaticOrder S; S.init(MTOK, NPROJ - NPROJ16, G, bx);
          pg8::EpiRowScaleBf16 E{P + NPROJ16, RSTD, nullptr, NPROJ, 0, 1.0f / W8_SCALE, 0};
          pg8::gemm_phase<pg8::EpiRowScaleBf16, pg8::StaticOrder, true, true, true>(lds, g, S, E); }
        GRID_BAR();
        REP4 for (int u = vcu; u < 512; u += G) na_unit(u, P, na_rpb + (size_t)l * 8 * 15 * 31, MIX, (float*)(wsl + WS_SSQ), lds, tid, wave);
        { bf16* UC = (bf16*)(wsl + WS_UC); float* NU = (float*)(wsl + WS_NU); float* SC = (float*)(wsl + WS_SC); const float* cwl = conv_w + (size_t)l * 5 * 1024; const float* cbl = conv_b + l * 1024;
          int tidl = tid; asm volatile("" : "+v"(tidl));
          REP5 for (int u = bx; u < 512; u += G) mlstm_m1_unit(u, cwl, cbl, P, GATES, UC, NU, SC, lds, tidl, wave);
          GRID_BAR();
          mlstm_m2(UC, NU, SC, vcu * 512 + tidl, G * 512);
          { const float* ssq = (const float*)(wsl + WS_SSQ); float* rsna = (float*)(wsl + WS_RSNA);
            for (int t = vcu * 512 + tidl; t < MTOK; t += G * 512) { const f32x4 s0 = *(const f32x4*)(ssq + (size_t)t * 8), s1 = *(const f32x4*)(ssq + (size_t)t * 8 + 4);
                rsna[t] = 1.0f / sqrtf(((s0[0] + s0[1]) + (s0[2] + s0[3]) + (s1[0] + s1[1]) + (s1[2] + s1[3])) * (1.0f / 1024.0f) + EPS); } }
          GRID_BAR();
          REP7 for (int u = bx; u < 512; u += G) mlstm_m3_unit(u, cwl, cbl, P, GATES, UC, NU, SC, ml_norm_g + l * 1024, (const float*)(wsl + WS_RSNA), MIX, lds, tidl, wave); }
        GRID_BAR();
#if (REP_MASK >> 8) & 1
        for (int rep_ = 0; rep_ < 2; ++rep_)
#endif
        { pg8::Gemm g{MIX, WoutT, MTOK, D, D, 0}; pg8::StaticOrder S; S.init(MTOK, D, G, bx); pg8::EpiResidBf16 E{XB, (const float*)(wsl + WS_RSNA), D, 0};
#if (REP_MASK >> 8) & 1
          if (rep_ == 0) E.XB = P;
#endif
          pg8::gemm_phase<pg8::EpiResidBf16, pg8::StaticOrder, true, true>(lds, g, S, E); }
        GRID_BAR();
        REP9 { RowArgs a; a.src32 = nullptr; a.srcb = XB; a.sel = nullptr; a.Y = nullptr; a.XB = XB; a.XB8 = wsl + WS_XB8; a.RSTD = RSTD; a.g = norm_ffn_g + l * D; a.W16F = (const bf16*)(wsl + WS_W16F_OFF) + (size_t)(2 * l + 1) * 32768; a.bias = b_gates; a.GATES = GATES; a.AFF = AFF; a.out = X; a.mode = 1; a.wrxb = 0;
          for (int grp = gw; grp < MTOK / 8; grp += ngw) rowpass_group<false>(a, grp, lane); }
        GRID_BAR();
        REP10 for (int be = bx; be < BATCH * NE; be += G) topk_unit(be, AFF, TOK, GATEV, SEL, (LAS int*)lds);
        GRID_BAR();
        REP12 { pg8::Gemm g{(const bf16*)(wsl + WS_XB8), (const bf16*)(wsl + WS_WGU + (size_t)l * NE * 2048 * D), MR, 2048, D / 2, 0}; pg8::GroupedGatherOrder S{TOK, G, bx};
          pg8::EpiSwiGLU8 E{(unsigned char*)ACT, RSTD, TOK, DE, 8, 1.0f / W8_SCALE, 0};
          pg8::gemm_phase_gather<pg8::EpiSwiGLU8, pg8::GroupedGatherOrder, true, true, true>(lds, g, S, E); }
        GRID_BAR();
        REP13 { pg8::Gemm g{ACT, (const bf16*)(wsl + WS_WD + (size_t)l * NE * D * DE), MR, 2048, DE / 2, 0}; pg8::GroupedOrder S{nullptr, G, bx}; pg8::EpiRowScaleF8 E{(unsigned char*)Y, GATEV, D, 8, Y8_SCALE / W8_SCALE, 0};
          pg8::gemm_phase<pg8::EpiRowScaleF8, pg8::GroupedOrder, true, true, true>(lds, g, S, E); }
        GRID_BAR();
        { RowArgs a; a.src32 = nullptr; a.srcb = XB; a.sel = SEL; a.Y = (const unsigned char*)Y; a.XB = XB; a.XB8 = wsl + WS_XB8; a.RSTD = RSTD; a.bias = b_gates + (l + 1 < DEPTH ? (l + 1) * 16 : 0); a.GATES = GATES; a.AFF = AFF; a.out = X; a.wrxb = 1;
          a.W16F = (const bf16*)(wsl + WS_W16F_OFF) + (size_t)(2 * (l + 1 < DEPTH ? l + 1 : 0)) * 32768;
          if (l + 1 < DEPTH) { a.g = norm_mix_g + (l + 1) * D; a.mode = 0; }
          else { a.g = final_norm_g; a.mode = 2; }
          for (int grp = gw; grp < MTOK / 8; grp += ngw) rowpass_group<false>(a, grp, lane); }
        if (l + 1 < DEPTH) GRID_BAR();
    }
#undef GRID_BAR
#undef WSPTRS
}

extern "C" void kernel_launch(void* const* d_in, const int* in_sizes, int n_in, void* d_out, int out_size, void* d_ws, size_t ws_size, hipStream_t stream) {
    static int grid = 0;
    if (grid == 0) {
        if (n_in != 16 || ws_size < WS_END) { fprintf(stderr, "kernel_launch: unexpected n_in %d or ws_size %zu\n", n_in, ws_size); grid = -1; return; }
        int dev = 0, cus = 0, per_cu = 0;
        if (hipGetDevice(&dev) != hipSuccess || hipDeviceGetAttribute(&cus, hipDeviceAttributeMultiprocessorCount, dev) != hipSuccess) { grid = -1; return; }
        if (hipFuncSetAttribute((const void*)mk_fwd, hipFuncAttributeMaxDynamicSharedMemorySize, LDS_BYTES) != hipSuccess) { fprintf(stderr, "kernel_launch: hipFuncSetAttribute failed\n"); grid = -1; return; }
        if (hipOccupancyMaxActiveBlocksPerMultiprocessor(&per_cu, (const void*)mk_fwd, NWAVES * 64, LDS_BYTES) != hipSuccess || per_cu < 1) fprintf(stderr, "kernel_launch: occupancy query reports %d blocks per CU\n", per_cu);
        (void)hipGetLastError();
        grid = cus;
    }
    if (grid < 0) return;
    if (hipMemsetAsync((char*)d_ws + WS_CTL, 0, CTL_ZERO_BYTES, stream) != hipSuccess) return;
    MKArgs a; memset(&a, 0, sizeof(a));
    for (int i = 0; i < 16; ++i) a.in[i] = (const float*)d_in[i];
    a.out = (float*)d_out; a.ws = (unsigned char*)d_ws;
    hipLaunchKernelGGL(mk_fwd, dim3(grid), dim3(NWAVES * 64), LDS_BYTES, stream, a);
}
```

```cpp
#include <hip/hip_runtime.h>
#include <stdint.h>
#include <stdio.h>
#include <string.h>

namespace pg8 {
#define PG8_LAS __attribute__((address_space(3)))
typedef unsigned short bf16_t;
typedef short bf16x8 __attribute__((ext_vector_type(8)));
typedef float f32x4 __attribute__((ext_vector_type(4)));
typedef unsigned u32x4 __attribute__((ext_vector_type(4)));
typedef int v4i32 __attribute__((ext_vector_type(4)));
typedef int v8i32 __attribute__((ext_vector_type(8)));
constexpr int BM = 256, BK = 64, HALF = 128, HTB = HALF * BK * 2  , STAGE_BYTES = 8 * HTB, NXCD = 8, WGM = 8;

__host__ __device__ __forceinline__ int lds_byte(int r, int c) { const int st = (r >> 4) * 2 + (c >> 5), rr = r & 15, cc = c & 31, ob = rr * 64 + cc * 2; return st * 1024 + (ob ^ (((ob >> 9) & 1) << 5)); }
__host__ __device__ __forceinline__ void stage_rc(int b, int& R, int& C) { const int st = b / 1024, sb = b % 1024, swz = sb ^ (((sb >> 9) & 1) << 5); R = (st >> 1) * 16 + swz / 64; C = (st & 1) * 32 + (swz % 64) / 2; }
__host__ __device__ __forceinline__ int perm32(int rho) { const int n = rho >> 4, i = rho & 15; return 8 * (i >> 2) + 4 * n + (i & 3); }

struct Unit { int pm, pn; };
struct Gemm { const bf16_t* A; const bf16_t* Bt; int M, N, K, pad; };

struct StaticOrder {
    static constexpr bool GATHER = false;
    int nM, nN, nwg, G, c, pad;
    __host__ __device__ void init(int M, int N, int G_, int c_) { nM = M / BM; nN = N / BM; nwg = nM * nN; G = G_; c = c_; pad = 0; }
    __host__ __device__ bool next(int i, Unit& u) const {
        const long L = (long)i * G + c; if (L >= nwg) return false;
        int wgid = (int)L; { const int q = nwg / NXCD, r = nwg % NXCD, xcd = wgid % NXCD, off = wgid / NXCD; wgid = (xcd < r ? xcd * (q + 1) : r * (q + 1) + (xcd - r) * q) + off; }
        const int nig = WGM * nN, gid = wgid / nig, fm = gid * WGM, gsz = (nM - fm) < WGM ? (nM - fm) : WGM;
        u.pm = fm + ((wgid % nig) % gsz); u.pn = (wgid % nig) / gsz; return true;
    }
    __device__ __forceinline__ void a_ready(const Unit&) const {}
    __device__ __forceinline__ void done(const Unit&) const {}
};


__device__ __forceinline__ unsigned cvt_pk_bf16(float lo, float hi) { unsigned r; asm volatile("v_cvt_pk_bf16_f32 %0, %1, %2" : "=v"(r) : "v"(lo), "v"(hi)); return r; }
typedef unsigned u32x2 __attribute__((ext_vector_type(2)));

struct EpiRowScaleBf16 {
    static constexpr bool PERM = true, AFTER_DRAIN = false;
    bf16_t* O; const float* rowscale; const int* rowmap; int ldc; int pn_mod; float mul; int pad;
    __device__ __forceinline__ void pre(const Unit& u, int wr, int fr, float (&rs)[8]) const {
#pragma unroll
        for (int i = 0; i < 8; ++i) { const int row = u.pm * BM + wr * 64 + fr + (i >> 2) * HALF + (i & 3) * 16; rs[i] = rowscale ? rowscale[rowmap ? rowmap[row] : row] : 1.0f; } }
    __device__ __forceinline__ void operator()(const f32x4 (&acc)[2][2][4][2], const Unit& u, int wr, int wc, int fr, int fq, const float (&rs)[8]) const {
        const int row0 = u.pm * BM + wr * 64 + fr; const int pnl = pn_mod ? (u.pn % pn_mod) : u.pn;
        const int col0 = pnl * BM + wc * 32 + 8 * fq;
#pragma unroll
        for (int ai = 0; ai < 2; ++ai)
#pragma unroll
            for (int m = 0; m < 4; ++m) { const int row = row0 + ai * HALF + m * 16; const float sc = rs[4 * ai + m] * mul;
                bf16_t* rowp = O + (size_t)row * ldc + col0;
#pragma unroll
                for (int bj = 0; bj < 2; ++bj) { const f32x4 v0 = acc[ai][bj][m][0] * sc, v1 = acc[ai][bj][m][1] * sc;
                    u32x4 w; w.x = cvt_pk_bf16(v0[0], v0[1]); w.y = cvt_pk_bf16(v0[2], v0[3]); w.z = cvt_pk_bf16(v1[0], v1[1]); w.w = cvt_pk_bf16(v1[2], v1[3]);
                    *(u32x4*)(rowp + bj * HALF) = w; } }
    }
};
__device__ __forceinline__ unsigned pk4_fp8(float a, float b, float c, float d) { int p = __builtin_amdgcn_cvt_pk_fp8_f32(a, b, 0, false); p = __builtin_amdgcn_cvt_pk_fp8_f32(c, d, p, true); return (unsigned)p; }
struct EpiSwiGLU8 {
    static constexpr bool PERM = false, AFTER_DRAIN = false;
    unsigned char* O; const float* rowscale; const int* rowmap; int ldc; int pn_mod; float mul; int pad;
    __device__ __forceinline__ void pre(const Unit& u, int wr, int fr, float (&rs)[8]) const {
#pragma unroll
        for (int i = 0; i < 8; ++i) { const int row = u.pm * BM + wr * 64 + fr + (i >> 2) * HALF + (i & 3) * 16; rs[i] = rowscale[rowmap[row]]; } }
    __device__ __forceinline__ void operator()(const f32x4 (&acc)[2][2][4][2], const Unit& u, int wr, int wc, int fr, int fq, const float (&rs)[8]) const {
        const int row0 = u.pm * BM + wr * 64 + fr; const int pnl = u.pn % pn_mod;
        const int col0 = pnl * 128 + wc * 16 + 4 * fq;
#pragma unroll
        for (int ai = 0; ai < 2; ++ai)
#pragma unroll
            for (int m = 0; m < 4; ++m) { const int row = row0 + ai * HALF + m * 16; const float sc = rs[4 * ai + m] * mul;
                unsigned char* rowp = O + (size_t)row * ldc + col0;
#pragma unroll
                for (int bj = 0; bj < 2; ++bj) { const f32x4 a = acc[ai][bj][m][0] * sc, up = acc[ai][bj][m][1] * sc; f32x4 r;
#pragma unroll
                    for (int j = 0; j < 4; ++j) r[j] = a[j] * up[j] * __builtin_amdgcn_rcpf(1.0f + __builtin_amdgcn_exp2f(-1.4426950408889634f * a[j]));
                    *(unsigned*)(rowp + bj * 64) = pk4_fp8(r[0], r[1], r[2], r[3]); } }
    }
};

struct EpiRowScaleF8 {
    static constexpr bool PERM = true, AFTER_DRAIN = false;
    unsigned char* O; const float* rowscale; int ldc; int pn_mod; float mul; int pad;
    __device__ __forceinline__ void pre(const Unit& u, int wr, int fr, float (&rs)[8]) const {
#pragma unroll
        for (int i = 0; i < 8; ++i) rs[i] = rowscale[u.pm * BM + wr * 64 + fr + (i >> 2) * HALF + (i & 3) * 16]; }
    __device__ __forceinline__ void operator()(const f32x4 (&acc)[2][2][4][2], const Unit& u, int wr, int wc, int fr, int fq, const float (&rs)[8]) const {
        const int row0 = u.pm * BM + wr * 64 + fr; const int pnl = pn_mod ? (u.pn % pn_mod) : u.pn;
        const int col0 = pnl * BM + wc * 32 + 8 * fq;
#pragma unroll
        for (int ai = 0; ai < 2; ++ai)
#pragma unroll
            for (int m = 0; m < 4; ++m) { const int row = row0 + ai * HALF + m * 16; const float sc = rs[4 * ai + m] * mul;
                unsigned char* rowp = O + (size_t)row * ldc + col0;
#pragma unroll
                for (int bj = 0; bj < 2; ++bj) { const f32x4 v0 = acc[ai][bj][m][0] * sc, v1 = acc[ai][bj][m][1] * sc;
                    u32x2 w; w.x = pk4_fp8(v0[0], v0[1], v0[2], v0[3]); w.y = pk4_fp8(v1[0], v1[1], v1[2], v1[3]);
                    *(u32x2*)(rowp + bj * HALF) = w; } }
    }
};

struct EpiResidBf16 {
    static constexpr bool PERM = true, AFTER_DRAIN = false;
    bf16_t* XB; const float* rowscale; int ldc; int pad;
    __device__ __forceinline__ void pre(const Unit& u, int wr, int fr, float (&rs)[8]) const {
#pragma unroll
        for (int i = 0; i < 8; ++i) rs[i] = rowscale[u.pm * BM + wr * 64 + fr + (i >> 2) * HALF + (i & 3) * 16]; }
    __device__ __forceinline__ void operator()(const f32x4 (&acc)[2][2][4][2], const Unit& u, int wr, int wc, int fr, int fq, const float (&rs)[8]) const {
        const int row0 = u.pm * BM + wr * 64 + fr, col0 = u.pn * BM + wc * 32 + 8 * fq;
#pragma unroll
        for (int ai = 0; ai < 2; ++ai)
#pragma unroll
            for (int m = 0; m < 4; ++m) { const int row = row0 + ai * HALF + m * 16; const float sc = rs[4 * ai + m]; bf16_t* rowp = XB + (size_t)row * ldc + col0;
#pragma unroll
                for (int bj = 0; bj < 2; ++bj) { const u32x4 x = *(const u32x4*)(rowp + bj * HALF); const f32x4 v0 = acc[ai][bj][m][0] * sc, v1 = acc[ai][bj][m][1] * sc;
                    u32x4 w; w.x = cvt_pk_bf16(__uint_as_float(x.x << 16) + v0[0], __uint_as_float(x.x & 0xffff0000u) + v0[1]); w.y = cvt_pk_bf16(__uint_as_float(x.y << 16) + v0[2], __uint_as_float(x.y & 0xffff0000u) + v0[3]);
                    w.z = cvt_pk_bf16(__uint_as_float(x.z << 16) + v1[0], __uint_as_float(x.z & 0xffff0000u) + v1[1]); w.w = cvt_pk_bf16(__uint_as_float(x.w << 16) + v1[2], __uint_as_float(x.w & 0xffff0000u) + v1[3]);
                    *(u32x4*)(rowp + bj * HALF) = w; } }
    }
};
template <bool GATHER_> struct GroupedOrderT {
    static constexpr bool GATHER = GATHER_;
    const int* rowmap; int G, c;
    __device__ __forceinline__ bool next(int i, Unit& u) const {
        const int L = i * G + c; if (L >= 1024) return false;
        const int e = L >> 6, w = L & 63; u.pm = e * 8 + (w & 7); u.pn = e * 8 + (w >> 3); return true;
    }
    __device__ __forceinline__ void a_ready(const Unit&) const {}
    __device__ __forceinline__ void done(const Unit&) const {}
};
typedef GroupedOrderT<false> GroupedOrder; typedef GroupedOrderT<true> GroupedGatherOrder;
template <class Epi, class Sched, bool ALIGN_EPI = false, bool SP2 = false, bool F8 = false>
__device__ __forceinline__ void gemm_phase(PG8_LAS unsigned char* lds, const Gemm g, const Sched& S, const Epi& E) {
    int tid_ = threadIdx.x; asm volatile("" : "+v"(tid_));
    const int tid = tid_, wid = __builtin_amdgcn_readfirstlane(tid >> 6), lane = tid & 63, wr = wid >> 2, wc = wid & 3, fr = lane & 15, fq = lane >> 4;
    const int K = g.K, nt = K / BK;
    unsigned voffA[2], voffB[2];
#pragma unroll
    for (int i = 0; i < 2; ++i) { int R, C; stage_rc(tid * 16 + i * 8192, R, C); const int Rb = Epi::PERM ? ((R & ~31) + perm32(R & 31)) : R;
        voffA[i] = (unsigned)(R * K + C) * 2u; voffB[i] = (unsigned)(Rb * K + C) * 2u; }
    const size_t kstep = (size_t)(BK * 2);
    const size_t hstep = (size_t)HALF * K * 2;
    const size_t tstep = 2 * hstep;
    const unsigned ldsw = (unsigned)wid * 1024u;
    const int aoff = lds_byte(wr * 64 + fr, fq * 8), boff = lds_byte(wc * 32 + fr, fq * 8);
#define PG8_SA(b, h) (((b) * 2 + (h)) * HTB)
#define PG8_SB(b, h) ((4 + (b) * 2 + (h)) * HTB)
#define PG8_STAGE(bufoff, gbase, voff) do { _Pragma("unroll") for (int _i = 0; _i < 2; ++_i) \
        __builtin_amdgcn_global_load_lds((const unsigned*)((const char*)(gbase) + (voff)[_i]), (PG8_LAS unsigned*)(lds + (bufoff) + ldsw + _i * 8192), 16, 0, 0); } while (0)
#define PG8_LDA(dst, b, h) do { if constexpr (F8) { _Pragma("unroll") for (int m = 0; m < 4; ++m) dst##8[m] = __builtin_shufflevector(*(const PG8_LAS v4i32*)(lds + PG8_SA(b, h) + aoff + m * 2048), *(const PG8_LAS v4i32*)(lds + PG8_SA(b, h) + aoff + m * 2048 + 1024), 0, 1, 2, 3, 4, 5, 6, 7); } \
    else { _Pragma("unroll") for (int m = 0; m < 4; ++m) _Pragma("unroll") for (int k = 0; k < 2; ++k) dst[m][k] = *(const PG8_LAS bf16x8*)(lds + PG8_SA(b, h) + aoff + m * 2048 + k * 1024); } } while (0)
#define PG8_LDB(dst, b, h) do { if constexpr (F8) { _Pragma("unroll") for (int n = 0; n < 2; ++n) dst##8[n] = __builtin_shufflevector(*(const PG8_LAS v4i32*)(lds + PG8_SB(b, h) + boff + n * 2048), *(const PG8_LAS v4i32*)(lds + PG8_SB(b, h) + boff + n * 2048 + 1024), 0, 1, 2, 3, 4, 5, 6, 7); } \
    else { _Pragma("unroll") for (int n = 0; n < 2; ++n) _Pragma("unroll") for (int k = 0; k < 2; ++k) dst[n][k] = *(const PG8_LAS bf16x8*)(lds + PG8_SB(b, h) + boff + n * 2048 + k * 1024); } } while (0)
#define PG8_MMA(ai, bj, At, Bt) do { __builtin_amdgcn_s_setprio(1); _Pragma("unroll") for (int m = 0; m < 4; ++m) _Pragma("unroll") for (int n = 0; n < 2; ++n) { \
        if constexpr (F8) asm volatile("v_mfma_scale_f32_16x16x128_f8f6f4 %0, %1, %2, %0, %3, %3 op_sel_hi:[0,0,0]" : "+v"(acc[ai][bj][m][n]) : "v"(Bt##8[n]), "v"(At##8[m]), "v"(f8scale));   \
        else { _Pragma("unroll") for (int k = 0; k < 2; ++k) acc[ai][bj][m][n] = __builtin_amdgcn_mfma_f32_16x16x32_bf16(Bt[n][k], At[m][k], acc[ai][bj][m][n], 0, 0, 0); } } \
        __builtin_amdgcn_s_setprio(0); } while (0)
#define PG8_WAIT_V(n) asm volatile("s_waitcnt vmcnt(" #n ")" ::: "memory")
#define PG8_WAIT_L(n) asm volatile("s_waitcnt lgkmcnt(" #n ")" ::: "memory")
#define PG8_BAR __builtin_amdgcn_s_barrier()
#define PG8_SCHED __builtin_amdgcn_sched_barrier(0)
    Unit cur, nxt; int ui = 0;
    if (!S.next(0, cur)) return;
    f32x4 acc[2][2][4][2];
#pragma unroll
    for (int a = 0; a < 2; ++a)
#pragma unroll
        for (int b = 0; b < 2; ++b)
#pragma unroll
            for (int m = 0; m < 4; ++m)
#pragma unroll
                for (int n = 0; n < 2; ++n) acc[a][b][m][n] = (f32x4){0.f, 0.f, 0.f, 0.f};
    bf16x8 At[4][2], B0[2][2], B1[2][2]; v8i32 At8[4], B08[2], B18[2];
    const int f8scale = 0x7F7F7F7F; (void)f8scale;
    const char* cA = (const char*)g.A + (size_t)cur.pm * tstep; const char* cB = (const char*)g.Bt + (size_t)cur.pn * tstep;
    float rs[8];
    E.pre(cur, wr, fr, rs);
    S.a_ready(cur);
    if constexpr (SP2) {
        PG8_STAGE(PG8_SB(0, 0), cB, voffB); PG8_STAGE(PG8_SB(0, 1), cB + hstep, voffB); PG8_STAGE(PG8_SA(0, 0), cA, voffA); PG8_STAGE(PG8_SA(0, 1), cA + hstep, voffA);
        if (wr == 1) PG8_BAR;
        PG8_WAIT_V(2); PG8_BAR;
        PG8_STAGE(PG8_SB(1, 0), cB + kstep, voffB); PG8_STAGE(PG8_SA(1, 0), cA + kstep, voffA); PG8_STAGE(PG8_SB(1, 1), cB + hstep + kstep, voffB);
        PG8_WAIT_V(6); PG8_BAR;
    } else {
        PG8_STAGE(PG8_SB(0, 0), cB, voffB); PG8_STAGE(PG8_SA(0, 0), cA, voffA); PG8_STAGE(PG8_SB(0, 1), cB + hstep, voffB); PG8_STAGE(PG8_SA(0, 1), cA + hstep, voffA);
        if (wr == 1) PG8_BAR;
        PG8_WAIT_V(4); PG8_BAR;
        PG8_STAGE(PG8_SB(1, 0), cB + kstep, voffB); PG8_STAGE(PG8_SA(1, 0), cA + kstep, voffA); PG8_STAGE(PG8_SB(1, 1), cB + hstep + kstep, voffB);
        PG8_WAIT_V(6); PG8_BAR;
    }
    for (;;) {
        const bool has_next = S.next(ui + 1, nxt);
        const char* nA = has_next ? (const char*)g.A + (size_t)nxt.pm * tstep : cA; const char* nB = has_next ? (const char*)g.Bt + (size_t)nxt.pn * tstep : cB;
        for (int t = 0; t < nt; t += 2) {
            const bool last = (t == nt - 2);
            const char* a1 = cA + (size_t)(t + 1) * kstep;
            const char* a2 = last ? nA : cA + (size_t)(t + 2) * kstep; const char* b2 = last ? nB : cB + (size_t)(t + 2) * kstep;
            const char* a3 = a2 + kstep; const char* b3 = b2 + kstep;
            if (last && has_next) S.a_ready(nxt);
            if constexpr (SP2) {
            PG8_LDB(B0, 0, 0); PG8_LDB(B1, 0, 1); PG8_SCHED; PG8_LDA(At, 0, 0); PG8_STAGE(PG8_SA(1, 1), a1 + hstep, voffA);
            PG8_WAIT_V(8); PG8_WAIT_L(0); PG8_BAR; PG8_MMA(0, 0, At, B0); PG8_MMA(0, 1, At, B1); PG8_BAR; PG8_SCHED;
            PG8_LDA(At, 0, 1); PG8_STAGE(PG8_SB(0, 0), b2, voffB); PG8_STAGE(PG8_SB(0, 1), b2 + hstep, voffB); PG8_STAGE(PG8_SA(0, 0), a2, voffA);
            PG8_WAIT_V(8); PG8_WAIT_L(0); PG8_BAR; PG8_MMA(1, 0, At, B0); PG8_MMA(1, 1, At, B1); PG8_BAR; PG8_SCHED;
            PG8_LDB(B0, 1, 0); PG8_LDB(B1, 1, 1); PG8_SCHED; PG8_LDA(At, 1, 0); PG8_STAGE(PG8_SA(0, 1), a2 + hstep, voffA);
            PG8_WAIT_V(8); PG8_WAIT_L(0); PG8_BAR; PG8_MMA(0, 0, At, B0); PG8_MMA(0, 1, At, B1); PG8_BAR; PG8_SCHED;
            PG8_LDA(At, 1, 1); PG8_STAGE(PG8_SB(1, 0), b3, voffB); PG8_STAGE(PG8_SB(1, 1), b3 + hstep, voffB); PG8_STAGE(PG8_SA(1, 0), a3, voffA);
            PG8_WAIT_V(8); PG8_WAIT_L(0); PG8_BAR; PG8_MMA(1, 0, At, B0); PG8_MMA(1, 1, At, B1); PG8_BAR; PG8_SCHED;
            } else {
            PG8_LDB(B0, 0, 0); PG8_SCHED; PG8_LDA(At, 0, 0); PG8_STAGE(PG8_SA(1, 1), a1 + hstep, voffA);
            PG8_WAIT_L(8); PG8_BAR; PG8_WAIT_L(0); PG8_MMA(0, 0, At, B0); PG8_BAR; PG8_SCHED;
            PG8_LDB(B1, 0, 1); PG8_STAGE(PG8_SB(0, 0), b2, voffB);
            PG8_BAR; PG8_WAIT_L(0); PG8_MMA(0, 1, At, B1); PG8_BAR;
            PG8_LDA(At, 0, 1); PG8_STAGE(PG8_SA(0, 0), a2, voffA);
            PG8_BAR; PG8_WAIT_L(0); PG8_MMA(1, 0, At, B0); PG8_BAR; PG8_SCHED;
            PG8_STAGE(PG8_SB(0, 1), b2 + hstep, voffB);
            PG8_WAIT_V(6); PG8_BAR; PG8_MMA(1, 1, At, B1); PG8_BAR;
            PG8_LDB(B0, 1, 0); PG8_SCHED; PG8_LDA(At, 1, 0); PG8_STAGE(PG8_SA(0, 1), a2 + hstep, voffA);
            PG8_WAIT_L(8); PG8_BAR; PG8_WAIT_L(0); PG8_MMA(0, 0, At, B0); PG8_BAR; PG8_SCHED;
            PG8_LDB(B1, 1, 1); PG8_STAGE(PG8_SB(1, 0), b3, voffB);
            PG8_BAR; PG8_WAIT_L(0); PG8_MMA(0, 1, At, B1); PG8_BAR;
            PG8_LDA(At, 1, 1); PG8_STAGE(PG8_SA(1, 0), a3, voffA);
            PG8_BAR; PG8_WAIT_L(0); PG8_MMA(1, 0, At, B0); PG8_BAR; PG8_SCHED;
            PG8_STAGE(PG8_SB(1, 1), b3 + hstep, voffB);
            PG8_WAIT_V(6); PG8_BAR; PG8_MMA(1, 1, At, B1); PG8_BAR;
            }
        }
        if constexpr (F8) asm volatile("s_nop 15\n\ts_nop 15" ::: "memory");
        if constexpr (ALIGN_EPI) { if (wr == 0) PG8_BAR; }
        if constexpr (!Epi::AFTER_DRAIN) { E(acc, cur, wr, wc, fr, fq, rs); S.done(cur); }
        if (!has_next) break;
#pragma unroll
        for (int a = 0; a < 2; ++a)
#pragma unroll
            for (int b = 0; b < 2; ++b)
#pragma unroll
                for (int m = 0; m < 4; ++m)
#pragma unroll
                    for (int n = 0; n < 2; ++n) acc[a][b][m][n] = (f32x4){0.f, 0.f, 0.f, 0.f};
        cur = nxt; cA = nA; cB = nB; ++ui;
        E.pre(cur, wr, fr, rs);
        if constexpr (ALIGN_EPI) { if (wr == 1) PG8_BAR; }
    }
    PG8_WAIT_V(0);
    if constexpr (!ALIGN_EPI) { if (wr == 0) PG8_BAR; }
    PG8_BAR;
    if constexpr (Epi::AFTER_DRAIN) { E.fused(acc, cur, wr, wc, fr, fq, lds, wid, lane); S.done(cur); }
#undef PG8_SA
#undef PG8_SB
#undef PG8_STAGE
#undef PG8_LDA
#undef PG8_LDB
#undef PG8_MMA
#undef PG8_WAIT_V
#undef PG8_WAIT_L
#undef PG8_BAR
#undef PG8_SCHED
}

template <class Epi, class Sched, bool ALIGN_EPI = false, bool SP2 = false, bool F8 = false>
__device__ __forceinline__ void gemm_phase_gather(PG8_LAS unsigned char* lds, const Gemm g, const Sched& S, const Epi& E) {
    int tid_ = threadIdx.x; asm volatile("" : "+v"(tid_));
    const int tid = tid_, wid = __builtin_amdgcn_readfirstlane(tid >> 6), lane = tid & 63, wr = wid >> 2, wc = wid & 3, fr = lane & 15, fq = lane >> 4;
    static_assert(SP2 || !Sched::GATHER, "gathered A rows: SP2 loop only");
    const int K = g.K, nt = K / BK;
    unsigned voffA[2], voffB[2];
#pragma unroll
    for (int i = 0; i < 2; ++i) { int R, C; stage_rc(tid * 16 + i * 8192, R, C); const int Rb = Epi::PERM ? ((R & ~31) + perm32(R & 31)) : R;
        voffA[i] = (unsigned)(R * K + C) * 2u; voffB[i] = (unsigned)(Rb * K + C) * 2u; }
    constexpr bool GATHER = Sched::GATHER;
    int RA[2], CA[2];
#pragma unroll
    for (int i = 0; i < 2; ++i) stage_rc(tid * 16 + i * 8192, RA[i], CA[i]);
    const size_t kstep = (size_t)(BK * 2);
    const size_t hstep = (size_t)HALF * K * 2;
    const size_t tstep = 2 * hstep;
    const unsigned ldsw = (unsigned)wid * 1024u;
    const int aoff = lds_byte(wr * 64 + fr, fq * 8), boff = lds_byte(wc * 32 + fr, fq * 8);
#define PG8_SA(b, h) (((b) * 2 + (h)) * HTB)
#define PG8_SB(b, h) ((4 + (b) * 2 + (h)) * HTB)
#define PG8_STAGE(bufoff, gbase, voff) do { _Pragma("unroll") for (int _i = 0; _i < 2; ++_i) \
        __builtin_amdgcn_global_load_lds((const unsigned*)((const char*)(gbase) + (voff)[_i]), (PG8_LAS unsigned*)(lds + (bufoff) + ldsw + _i * 8192), 16, 0, 0); } while (0)
#define PG8_LDA(dst, b, h) do { if constexpr (F8) { _Pragma("unroll") for (int m = 0; m < 4; ++m) dst##8[m] = __builtin_shufflevector(*(const PG8_LAS v4i32*)(lds + PG8_SA(b, h) + aoff + m * 2048), *(const PG8_LAS v4i32*)(lds + PG8_SA(b, h) + aoff + m * 2048 + 1024), 0, 1, 2, 3, 4, 5, 6, 7); } \
    else { _Pragma("unroll") for (int m = 0; m < 4; ++m) _Pragma("unroll") for (int k = 0; k < 2; ++k) dst[m][k] = *(const PG8_LAS bf16x8*)(lds + PG8_SA(b, h) + aoff + m * 2048 + k * 1024); } } while (0)
#define PG8_LDB(dst, b, h) do { if constexpr (F8) { _Pragma("unroll") for (int n = 0; n < 2; ++n) dst##8[n] = __builtin_shufflevector(*(const PG8_LAS v4i32*)(lds + PG8_SB(b, h) + boff + n * 2048), *(const PG8_LAS v4i32*)(lds + PG8_SB(b, h) + boff + n * 2048 + 1024), 0, 1, 2, 3, 4, 5, 6, 7); } \
    else { _Pragma("unroll") for (int n = 0; n < 2; ++n) _Pragma("unroll") for (int k = 0; k < 2; ++k) dst[n][k] = *(const PG8_LAS bf16x8*)(lds + PG8_SB(b, h) + boff + n * 2048 + k * 1024); } } while (0)
#define PG8_MMA(ai, bj, At, Bt) do { __builtin_amdgcn_s_setprio(1); _Pragma("unroll") for (int m = 0; m < 4; ++m) _Pragma("unroll") for (int n = 0; n < 2; ++n) { \
        if constexpr (F8) asm volatile("v_mfma_scale_f32_16x16x128_f8f6f4 %0, %1, %2, %0, %3, %3 op_sel_hi:[0,0,0]" : "+v"(acc[ai][bj][m][n]) : "v"(Bt##8[n]), "v"(At##8[m]), "v"(f8scale));   \
        else { _Pragma("unroll") for (int k = 0; k < 2; ++k) acc[ai][bj][m][n] = __builtin_amdgcn_mfma_f32_16x16x32_bf16(Bt[n][k], At[m][k], acc[ai][bj][m][n], 0, 0, 0); } } \
        __builtin_amdgcn_s_setprio(0); } while (0)
#define PG8_WAIT_V(n) asm volatile("s_waitcnt vmcnt(" #n ")" ::: "memory")
#define PG8_WAIT_L(n) asm volatile("s_waitcnt lgkmcnt(" #n ")" ::: "memory")
#define PG8_BAR __builtin_amdgcn_s_barrier()
#define PG8_SCHED __builtin_amdgcn_sched_barrier(0)
    Unit cur, nxt; int ui = 0;
    if (!S.next(0, cur)) return;
    f32x4 acc[2][2][4][2];
#pragma unroll
    for (int a = 0; a < 2; ++a)
#pragma unroll
        for (int b = 0; b < 2; ++b)
#pragma unroll
            for (int m = 0; m < 4; ++m)
#pragma unroll
                for (int n = 0; n < 2; ++n) acc[a][b][m][n] = (f32x4){0.f, 0.f, 0.f, 0.f};
    bf16x8 At[4][2], B0[2][2], B1[2][2]; v8i32 At8[4], B08[2], B18[2];
    const int f8scale = 0x7F7F7F7F; (void)f8scale;
    const char* cA = GATHER ? (const char*)g.A : (const char*)g.A + (size_t)cur.pm * tstep; const char* cB = (const char*)g.Bt + (size_t)cur.pn * tstep;
    unsigned offC[2][2], offN[2][2];
#define PG8_SETOFF(o, u) do { _Pragma("unroll") for (int _h = 0; _h < 2; ++_h) _Pragma("unroll") for (int _i = 0; _i < 2; ++_i) { \
        if constexpr (GATHER) o[_h][_i] = (unsigned)S.rowmap[(u).pm * BM + _h * HALF + RA[_i]] * (unsigned)(K * 2) + (unsigned)(CA[_i] * 2); \
        else o[_h][_i] = voffA[_i] + (unsigned)(_h * (int)hstep); } } while (0)
    PG8_SETOFF(offC, cur);
#pragma unroll
    for (int _h = 0; _h < 2; ++_h) { offN[_h][0] = offC[_h][0]; offN[_h][1] = offC[_h][1]; }
    float rs[8];
    E.pre(cur, wr, fr, rs);
    S.a_ready(cur);
    if constexpr (SP2) {
        PG8_STAGE(PG8_SB(0, 0), cB, voffB); PG8_STAGE(PG8_SB(0, 1), cB + hstep, voffB); PG8_STAGE(PG8_SA(0, 0), cA, offC[0]); PG8_STAGE(PG8_SA(0, 1), cA, offC[1]);
        if (wr == 1) PG8_BAR;
        PG8_WAIT_V(2); PG8_BAR;
        PG8_STAGE(PG8_SB(1, 0), cB + kstep, voffB); PG8_STAGE(PG8_SA(1, 0), cA + kstep, offC[0]); PG8_STAGE(PG8_SB(1, 1), cB + hstep + kstep, voffB);
        PG8_WAIT_V(6); PG8_BAR;
    } else {
        PG8_STAGE(PG8_SB(0, 0), cB, voffB); PG8_STAGE(PG8_SA(0, 0), cA, voffA); PG8_STAGE(PG8_SB(0, 1), cB + hstep, voffB); PG8_STAGE(PG8_SA(0, 1), cA + hstep, voffA);
        if (wr == 1) PG8_BAR;
        PG8_WAIT_V(4); PG8_BAR;
        PG8_STAGE(PG8_SB(1, 0), cB + kstep, voffB); PG8_STAGE(PG8_SA(1, 0), cA + kstep, voffA); PG8_STAGE(PG8_SB(1, 1), cB + hstep + kstep, voffB);
        PG8_WAIT_V(6); PG8_BAR;
    }
    for (;;) {
        const bool has_next = S.next(ui + 1, nxt);
        const char* nA = GATHER ? cA : (has_next ? (const char*)g.A + (size_t)nxt.pm * tstep : cA); const char* nB = has_next ? (const char*)g.Bt + (size_t)nxt.pn * tstep : cB;
        if constexpr (GATHER) { if (has_next) PG8_SETOFF(offN, nxt); }
        for (int t = 0; t < nt; t += 2) {
            const bool last = (t == nt - 2);
            const char* a1 = cA + (size_t)(t + 1) * kstep;
            const char* a2 = last ? nA : cA + (size_t)(t + 2) * kstep; const char* b2 = last ? nB : cB + (size_t)(t + 2) * kstep;
            const char* a3 = a2 + kstep; const char* b3 = b2 + kstep;
            if (last && has_next) S.a_ready(nxt);
            unsigned o2[2][2];
#pragma unroll
            for (int _h = 0; _h < 2; ++_h)
#pragma unroll
                for (int _i = 0; _i < 2; ++_i) o2[_h][_i] = (GATHER && last) ? offN[_h][_i] : offC[_h][_i];
            if constexpr (SP2) {
            PG8_LDB(B0, 0, 0); PG8_LDB(B1, 0, 1); PG8_SCHED; PG8_LDA(At, 0, 0); PG8_STAGE(PG8_SA(1, 1), a1, offC[1]);
            PG8_WAIT_V(8); PG8_WAIT_L(0); PG8_BAR; PG8_MMA(0, 0, At, B0); PG8_MMA(0, 1, At, B1); PG8_BAR; PG8_SCHED;
            PG8_LDA(At, 0, 1); PG8_STAGE(PG8_SB(0, 0), b2, voffB); PG8_STAGE(PG8_SB(0, 1), b2 + hstep, voffB); PG8_STAGE(PG8_SA(0, 0), a2, o2[0]);
            PG8_WAIT_V(8); PG8_WAIT_L(0); PG8_BAR; PG8_MMA(1, 0, At, B0); PG8_MMA(1, 1, At, B1); PG8_BAR; PG8_SCHED;
            PG8_LDB(B0, 1, 0); PG8_LDB(B1, 1, 1); PG8_SCHED; PG8_LDA(At, 1, 0); PG8_STAGE(PG8_SA(0, 1), a2, o2[1]);
            PG8_WAIT_V(8); PG8_WAIT_L(0); PG8_BAR; PG8_MMA(0, 0, At, B0); PG8_MMA(0, 1, At, B1); PG8_BAR; PG8_SCHED;
            PG8_LDA(At, 1, 1); PG8_STAGE(PG8_SB(1, 0), b3, voffB); PG8_STAGE(PG8_SB(1, 1), b3 + hstep, voffB); PG8_STAGE(PG8_SA(1, 0), a3, o2[0]);
            PG8_WAIT_V(8); PG8_WAIT_L(0); PG8_BAR; PG8_MMA(1, 0, At, B0); PG8_MMA(1, 1, At, B1); PG8_BAR; PG8_SCHED;
            } else {
            PG8_LDB(B0, 0, 0); PG8_SCHED; PG8_LDA(At, 0, 0); PG8_STAGE(PG8_SA(1, 1), a1 + hstep, voffA);
            PG8_WAIT_L(8); PG8_BAR; PG8_WAIT_L(0); PG8_MMA(0, 0, At, B0); PG8_BAR; PG8_SCHED;
            PG8_LDB(B1, 0, 1); PG8_STAGE(PG8_SB(0, 0), b2, voffB);
            PG8_BAR; PG8_WAIT_L(0); PG8_MMA(0, 1, At, B1); PG8_BAR;
            PG8_LDA(At, 0, 1); PG8_STAGE(PG8_SA(0, 0), a2, voffA);
            PG8_BAR; PG8_WAIT_L(0); PG8_MMA(1, 0, At, B0); PG8_BAR; PG8_SCHED;
            PG8_STAGE(PG8_SB(0, 1), b2 + hstep, voffB);
            PG8_WAIT_V(6); PG8_BAR; PG8_MMA(1, 1, At, B1); PG8_BAR;
            PG8_LDB(B0, 1, 0); PG8_SCHED; PG8_LDA(At, 1, 0); PG8_STAGE(PG8_SA(0, 1), a2 + hstep, voffA);
            PG8_WAIT_L(8); PG8_BAR; PG8_WAIT_L(0); PG8_MMA(0, 0, At, B0); PG8_BAR; PG8_SCHED;
            PG8_LDB(B1, 1, 1); PG8_STAGE(PG8_SB(1, 0), b3, voffB);
            PG8_BAR; PG8_WAIT_L(0); PG8_MMA(0, 1, At, B1); PG8_BAR;
            PG8_LDA(At, 1, 1); PG8_STAGE(PG8_SA(1, 0), a3, voffA);
            PG8_BAR; PG8_WAIT_L(0); PG8_MMA(1, 0, At, B0); PG8_BAR; PG8_SCHED;
            PG8_STAGE(PG8_SB(1, 1), b3 + hstep, voffB);
            PG8_WAIT_V(6); PG8_BAR; PG8_MMA(1, 1, At, B1); PG8_BAR;
            }
        }
        if constexpr (F8) asm volatile("s_nop 15\n\ts_nop 15" ::: "memory");
        if constexpr (ALIGN_EPI) { if (wr == 0) PG8_BAR; }
        if constexpr (!Epi::AFTER_DRAIN) { E(acc, cur, wr, wc, fr, fq, rs); S.done(cur); }
        if (!has_next) break;
#pragma unroll
        for (int a = 0; a < 2; ++a)
#pragma unroll
            for (int b = 0; b < 2; ++b)
#pragma unroll
                for (int m = 0; m < 4; ++m)
#pragma unroll
                    for (int n = 0; n < 2; ++n) acc[a][b][m][n] = (f32x4){0.f, 0.f, 0.f, 0.f};
        cur = nxt; cA = nA; cB = nB; ++ui;
        E.pre(cur, wr, fr, rs);
#pragma unroll
        for (int _h = 0; _h < 2; ++_h) { offC[_h][0] = offN[_h][0]; offC[_h][1] = offN[_h][1]; }
        if constexpr (ALIGN_EPI) { if (wr == 1) PG8_BAR; }
    }
    PG8_WAIT_V(0);
    if constexpr (!ALIGN_EPI) { if (wr == 0) PG8_BAR; }
    PG8_BAR;
    if constexpr (Epi::AFTER_DRAIN) { E.fused(acc, cur, wr, wc, fr, fq, lds, wid, lane); S.done(cur); }
#undef PG8_SETOFF
#undef PG8_SA
#undef PG8_SB
#undef PG8_STAGE
#undef PG8_LDA
#undef PG8_LDB
#undef PG8_MMA
#undef PG8_WAIT_V
#undef PG8_WAIT_L
#undef PG8_BAR
#undef PG8_SCHED
}
}

constexpr int D = 2048, BATCH = 4, SEQ = 4096, MTOK = BATCH * SEQ, DEPTH = 2;
constexpr int NIN = 6160, NPROJ = 6144;
constexpr int C_NAQ = 0, C_NAK = 1024, C_NAV = 2048, C_MLQ = 3072, C_MLK = 3584, C_MLV = 4096, C_MLO = 5120, C_GATES = 6144;
constexpr int NE = 16, CAP = 512, DE = 1024, MR = NE * BATCH * CAP;
constexpr float EPS = 1e-6f;

typedef unsigned short bf16;
typedef float f32x4 __attribute__((ext_vector_type(4)));
typedef unsigned v4u __attribute__((ext_vector_type(4)));
typedef unsigned v2u __attribute__((ext_vector_type(2)));
#define LAS __attribute__((address_space(3)))
typedef short bf16x8v __attribute__((ext_vector_type(8)));
typedef short s16x4 __attribute__((ext_vector_type(4)));
constexpr size_t WS_XB8 = 968 * (size_t)(1u << 20);
constexpr size_t WS_SSQ = 6 * (size_t)(1u << 20) + 512 * 1024;
constexpr size_t WS_RSNA = 7 * (size_t)(1u << 20) + 64 * 1024;
constexpr size_t WS_W16F_OFF = 7 * (1u << 20) + 256 * 1024;

constexpr size_t MiB = 1u << 20;
constexpr size_t WS_CTL = 0;
constexpr size_t WS_RSTD = 1 * MiB;
constexpr size_t WS_GATES = 2 * MiB;
constexpr size_t WS_AFF = 3 * MiB;
constexpr size_t WS_TOK = 4 * MiB;
constexpr size_t WS_GATEV = 4 * MiB + 512 * 1024;
constexpr size_t WS_SEL = 5 * MiB;
constexpr size_t WS_WIN = 8 * MiB;
constexpr size_t WS_WOUT = 56 * MiB;
constexpr size_t WS_WGU = 72 * MiB;
constexpr size_t WS_WD = 328 * MiB;
constexpr size_t WS_XB = 456 * MiB;
constexpr size_t WS_MIX = 520 * MiB;
constexpr size_t WS_P = 584 * MiB;
constexpr size_t WS_NAO = 776 * MiB;
constexpr size_t WS_HF = 840 * MiB;
constexpr size_t WS_ACT = 712 * MiB;
constexpr size_t WS_Y = 776 * MiB;
constexpr size_t WS_END = 1000 * MiB;

__device__ __forceinline__ unsigned f2bf(float f) { unsigned u = __builtin_bit_cast(unsigned, f); return (u + 0x7fffu + ((u >> 16) & 1u)) >> 16; }
__device__ __forceinline__ unsigned pk2(float lo, float hi) { return f2bf(lo) | (f2bf(hi) << 16); }
__device__ __forceinline__ float bf2f(unsigned short b) { return __builtin_bit_cast(float, ((unsigned)b) << 16); }
__device__ __forceinline__ float bflo(unsigned w) { return __builtin_bit_cast(float, w << 16); }
__device__ __forceinline__ float bfhi(unsigned w) { return __builtin_bit_cast(float, w & 0xffff0000u); }
__device__ __forceinline__ float wave_sum(float v) {
#pragma unroll
    for (int o = 1; o < 64; o <<= 1) v += __shfl_xor(v, o);
    return v;
}
__device__ __forceinline__ float wave_max(float v) {
#pragma unroll
    for (int o = 1; o < 64; o <<= 1) v = fmaxf(v, __shfl_xor(v, o));
    return v;
}

struct ConvItem { const float* W; const float* gk; bf16* WT; int ldw, K, k0, n0, dmode, f8; float wmul; };
__device__ __forceinline__ void ti_load(const ConvItem& d, int lane, f32x4 (&wv)[16]) {
    const int r4 = lane >> 4, c4 = (lane & 15) * 4;
#pragma unroll
    for (int i = 0; i < 16; ++i) wv[i] = *(const f32x4*)(d.W + (size_t)(d.k0 + 4 * i + r4) * d.ldw + d.n0 + c4);
}
__device__ __forceinline__ void ti_finish(const ConvItem& d, int lane, const f32x4 (&wv)[16], LAS float* scr) {
    const int r4 = lane >> 4, c4 = (lane & 15) * 4;
#pragma unroll
    for (int i = 0; i < 16; ++i) { const int kk = 4 * i + r4; const float gg = d.gk ? d.gk[d.k0 + kk] : 1.0f; LAS float* p = scr + kk * 65 + c4; p[0] = wv[i][0] * gg; p[1] = wv[i][1] * gg; p[2] = wv[i][2] * gg; p[3] = wv[i][3] * gg; }
    asm volatile("s_waitcnt lgkmcnt(0)" ::: "memory");
    const int c = lane & 7; const float wmul = d.wmul;
#pragma unroll
    for (int j = 0; j < 8; ++j) { const int n = (lane >> 3) + 8 * j; const LAS float* s = scr + (8 * c) * 65 + n;
        const int ng = d.n0 + n; const int drow = d.dmode == 0 ? ng : ((ng >> 4) * 32 + (ng & 15) + (d.dmode == 2 ? 16 : 0));
        if (d.f8) { v2u o8; int p = __builtin_amdgcn_cvt_pk_fp8_f32(s[0 * 65] * wmul, s[1 * 65] * wmul, 0, false); p = __builtin_amdgcn_cvt_pk_fp8_f32(s[2 * 65] * wmul, s[3 * 65] * wmul, p, true); o8.x = (unsigned)p;
            p = __builtin_amdgcn_cvt_pk_fp8_f32(s[4 * 65] * wmul, s[5 * 65] * wmul, 0, false); p = __builtin_amdgcn_cvt_pk_fp8_f32(s[6 * 65] * wmul, s[7 * 65] * wmul, p, true); o8.y = (unsigned)p;
            *(v2u*)((unsigned char*)d.WT + (size_t)drow * d.K + d.k0 + 8 * c) = o8; }
        else { v4u o; o.x = pk2(s[0 * 65], s[1 * 65]); o.y = pk2(s[2 * 65], s[3 * 65]); o.z = pk2(s[4 * 65], s[5 * 65]); o.w = pk2(s[6 * 65], s[7 * 65]);
            *(v4u*)(d.WT + (size_t)drow * d.K + d.k0 + 8 * c) = o; } }
    asm volatile("s_waitcnt lgkmcnt(0)" ::: "memory");
}
constexpr int CONV_SCR_BYTES = 64 * 65 * 4;
constexpr float Y8_SCALE = 16.0f;
typedef float f32x2 __attribute__((ext_vector_type(2)));
constexpr int NPROJ16 = 5120;
constexpr float W8_SCALE = 64.0f;
struct ConvArgs { const float *w_in, *w_out, *w_gate, *w_up, *w_down, *norm_mix_g, *norm_ffn_g, *na_norm_g; unsigned char* ws; };
constexpr int CI_IN = 32 * 96, CI_OUT = 32 * 32, CI_G = 16 * 32 * 16, CI_D = 16 * 16 * 32, CI_LAYER = CI_IN + CI_OUT + 2 * CI_G + CI_D;
__device__ __forceinline__ ConvItem convert_decode(const ConvArgs& a, int it) {
    ConvItem d; d.f8 = 0; d.wmul = 1.0f; d.gk = nullptr; d.dmode = 0; d.K = D;
    const int l = it / CI_LAYER; int r = it % CI_LAYER;
    if (r < CI_IN) { const int kb = r / 96, nb = r % 96; d.ldw = NIN; d.gk = a.norm_mix_g + l * D; d.k0 = 64 * kb;
        if (64 * nb < NPROJ16) { d.W = a.w_in + (size_t)l * D * NIN; d.WT = (bf16*)(a.ws + WS_WIN) + (size_t)l * NPROJ * D; d.n0 = 64 * nb; }
        else { d.W = a.w_in + (size_t)l * D * NIN + NPROJ16; d.WT = (bf16*)(a.ws + WS_WIN + ((size_t)l * NPROJ + NPROJ16) * D * 2); d.n0 = 64 * nb - NPROJ16; d.f8 = 1; d.wmul = W8_SCALE; }
        return d; }
    r -= CI_IN;
    if (r < CI_OUT) { const int kb = r / 32, nb = r % 32; d.W = a.w_out + (size_t)l * D * D; d.ldw = D; if (64 * kb < 1024) d.gk = a.na_norm_g + l * 1024;
        d.WT = (bf16*)(a.ws + WS_WOUT) + (size_t)l * D * D; d.k0 = 64 * kb; d.n0 = 64 * nb; return d; }
    r -= CI_OUT;
    if (r < 2 * CI_G) { const int up = r >= CI_G; if (up) r -= CI_G; const int e = r / 512, q = r % 512, kb = q / 16, nb = q % 16;
        d.W = (up ? a.w_up : a.w_gate) + ((size_t)l * NE + e) * D * DE; d.ldw = DE; d.gk = a.norm_ffn_g + l * D; d.WT = (bf16*)(a.ws + WS_WGU + ((size_t)l * NE + e) * 2048 * D); d.k0 = 64 * kb; d.n0 = 64 * nb; d.dmode = up ? 2 : 1; d.f8 = 1; d.wmul = W8_SCALE; return d; }
    r -= 2 * CI_G;
    { const int e = r / 512, q = r % 512, kb = q / 32, nb = q % 32; d.W = a.w_down + ((size_t)l * NE + e) * DE * D; d.ldw = D; d.WT = (bf16*)(a.ws + WS_WD + ((size_t)l * NE + e) * D * DE); d.K = DE; d.k0 = 64 * kb; d.n0 = 64 * nb; d.f8 = 1; d.wmul = W8_SCALE; return d; }
}
__device__ __forceinline__ void convert_stream(const ConvArgs& a, int first, int stride, int end, LAS float* scr, int lane) {
    if (first >= end) return;
    f32x4 w0[16], w1[16]; ConvItem d0 = convert_decode(a, first), d1 = d0; ti_load(d0, lane, w0);
    if (first + stride < end) { d1 = convert_decode(a, first + stride); ti_load(d1, lane, w1); }
#pragma unroll 1
    for (int it = first; it < end; it += 2 * stride) {
        ti_finish(d0, lane, w0, scr);
        if (it + 2 * stride < end) { d0 = convert_decode(a, it + 2 * stride); ti_load(d0, lane, w0); }
        if (it + stride < end) { ti_finish(d1, lane, w1, scr);
            if (it + 3 * stride < end) { d1 = convert_decode(a, it + 3 * stride); ti_load(d1, lane, w1); } }
    }
}

#define XB_TMO      128
#define XB_XCNT(j)  (256  + 64 * (j))
#define XB_XSUB(j)  (1280 + 64 * (j))
#define XB_XGEN(j)  (2304 + 64 * (j))
#define XB_TOP      3328
#define XB_TOPGEN   3392
#define XCD_BAR_WORDS 3456
#define XB_SPIN_CAP (1u << 18)

__device__ __forceinline__ unsigned xb_ld(unsigned* p)              { return __hip_atomic_load(p, __ATOMIC_RELAXED, __HIP_MEMORY_SCOPE_AGENT); }
__device__ __forceinline__ unsigned xb_add(unsigned* p, unsigned v) { return __hip_atomic_fetch_add(p, v, __ATOMIC_RELAXED, __HIP_MEMORY_SCOPE_AGENT); }
__device__ __forceinline__ unsigned xb_xcc_id() { return (unsigned)__builtin_amdgcn_s_getreg((3 << 11) | 20) & 0xFu; }
#define XB_SPIN(cond, bar) do { unsigned _sp = 0; while (cond) { __builtin_amdgcn_s_sleep(1); \
    if ((++_sp & 255u) == 0u) { if (xb_ld(&(bar)[XB_TMO])) break; if (_sp > XB_SPIN_CAP) { atomicAdd(&(bar)[XB_TMO], 1u); break; } } } } while (0)

struct XcdBarrier {
    unsigned* bar; unsigned x;
    volatile LAS unsigned* st;
};

__device__ __forceinline__ XcdBarrier xcd_barrier_post(unsigned* bar, volatile LAS unsigned* st) {
    XcdBarrier b; b.bar = bar; b.x = xb_xcc_id(); b.st = st;
    if (threadIdx.x == 0) (void)xb_add(&bar[XB_XCNT(b.x)], 1u);
    return b;
}
__device__ __forceinline__ void xcd_barrier_complete(unsigned* bar, unsigned x, unsigned& nloc, unsigned& nx) {
    const unsigned G = gridDim.x * gridDim.y * gridDim.z;
    unsigned sum, cnt, mine, sp = 0u;
    for (;;) {
        sum = 0u; cnt = 0u; mine = 0u;
#pragma unroll
        for (unsigned j = 0; j < 16; ++j) { const unsigned c = xb_ld(&bar[XB_XCNT(j)]); sum += c; cnt += (c > 0u) ? 1u : 0u; mine = (j == x) ? c : mine; }
        if (sum == G) break;
        __builtin_amdgcn_s_sleep(1);
        if ((++sp & 255u) == 0u) { if (xb_ld(&bar[XB_TMO])) break; if (sp > XB_SPIN_CAP) { atomicAdd(&bar[XB_TMO], 1u); break; } }
    }
    nloc = mine > 0u ? mine : 1u; nx = cnt > 0u ? cnt : 1u;
}

__device__ __forceinline__ void xcd_barrier(const XcdBarrier& b) {
    asm volatile("s_waitcnt vmcnt(0)" ::: "memory");
    __syncthreads();
    if (threadIdx.x == 0) {
        unsigned* bar = b.bar;
        __builtin_amdgcn_s_waitcnt(0);
        unsigned nloc = b.st[0], nx = b.st[1];
        if (nloc == 0u) { xcd_barrier_complete(bar, b.x, nloc, nx); b.st[0] = nloc; b.st[1] = nx; }
        const unsigned old = xb_add(&bar[XB_XSUB(b.x)], 1u);
        const unsigned gen = old / nloc;
        if (old + 1u == (gen + 1u) * nloc) {
            __builtin_amdgcn_fence(__ATOMIC_RELEASE, "agent");
            asm volatile("s_waitcnt vmcnt(0)" ::: "memory");
            const unsigned og = xb_add(&bar[XB_TOP], 1u);
            const unsigned tg = og / nx;
            if (og + 1u == (tg + 1u) * nx) xb_add(&bar[XB_TOPGEN], 1u);
            else XB_SPIN(xb_ld(&bar[XB_TOPGEN]) == tg, bar);
            __builtin_amdgcn_fence(__ATOMIC_ACQUIRE, "agent");
            xb_add(&bar[XB_XGEN(b.x)], 1u);
            asm volatile("s_waitcnt vmcnt(0)" ::: "memory");
        } else {
            XB_SPIN(xb_ld(&bar[XB_XGEN(b.x)]) == gen, bar);
            __builtin_amdgcn_fence(__ATOMIC_ACQUIRE, "agent");
            asm volatile("s_waitcnt vmcnt(0)" ::: "memory");
        }
    }
    __syncthreads();
}

struct RowArgs { const float* src32; const bf16* srcb; const int* sel; const unsigned char* Y; bf16* XB; unsigned char* XB8; float* RSTD; const float* g; const bf16* W16F; const float* bias; float* GATES; float* AFF; float* out; int mode; int wrxb; };
__device__ __forceinline__ void rowpass_finish(const RowArgs& a, int row, int rr, int s0, int s1, f32x4 (&v)[8], int lane) {
    const int b = row / SEQ;
    if (a.sel) {
        const int sw = rr < 4 ? s0 : s1;
        for (int e = 0; e < NE; ++e) { const int c = __builtin_amdgcn_readlane(sw, ((rr & 3) << 4) + e);
            if (c >= 0) { const unsigned char* y = a.Y + (size_t)(e * 2048 + b * 512 + c) * D + 4 * lane;
#pragma unroll
                for (int j = 0; j < 8; ++j) { const int w = *(const int*)(y + 256 * j); const f32x2 lo = __builtin_amdgcn_cvt_pk_f32_fp8(w, false), hi = __builtin_amdgcn_cvt_pk_f32_fp8(w, true);
                    v[j][0] += lo[0] * (1.0f / Y8_SCALE); v[j][1] += lo[1] * (1.0f / Y8_SCALE); v[j][2] += hi[0] * (1.0f / Y8_SCALE); v[j][3] += hi[1] * (1.0f / Y8_SCALE); } } }
    }
    float ss = 0.f;
#pragma unroll
    for (int j = 0; j < 8; ++j) ss += (v[j][0] * v[j][0] + v[j][1] * v[j][1]) + (v[j][2] * v[j][2] + v[j][3] * v[j][3]);
    ss = wave_sum(ss);
    const float rstd = 1.0f / sqrtf(ss * (1.0f / D) + EPS);
    if (a.mode == 2) {
#pragma unroll
        for (int j = 0; j < 8; ++j) { const f32x4 g = *(const f32x4*)(a.g + 4 * lane + 256 * j); *(f32x4*)(a.out + (size_t)row * D + 4 * lane + 256 * j) = v[j] * rstd * g; }
        return;
    }
    if (a.wrxb) {
#pragma unroll
        for (int j = 0; j < 8; ++j) { v2u w; w.x = pk2(v[j][0], v[j][1]); w.y = pk2(v[j][2], v[j][3]); *(v2u*)(a.XB + (size_t)row * D + 4 * lane + 256 * j) = w; } }
    if (a.XB8) {
#pragma unroll
        for (int j = 0; j < 8; ++j) *(unsigned*)(a.XB8 + (size_t)row * D + 4 * lane + 256 * j) = pg8::pk4_fp8(v[j][0], v[j][1], v[j][2], v[j][3]); }
    if (lane == 0) a.RSTD[row] = rstd;
}
template <bool SRC32> __device__ __forceinline__ void rowpass_group(const RowArgs& a, int grp, int lane_) {
    int lane = lane_; asm volatile("" : "+v"(lane));
    int s0 = -1, s1 = -1; if (a.sel) { s0 = a.sel[grp * 128 + lane]; s1 = a.sel[grp * 128 + 64 + lane]; }
    f32x4 v[8];
    if constexpr (SRC32) {
        f32x4 vn[8];
#pragma unroll
        for (int j = 0; j < 8; ++j) v[j] = *(const f32x4*)(a.src32 + (size_t)(8 * grp) * D + 4 * lane + 256 * j);
#pragma unroll 1
        for (int rr = 0; rr < 8; ++rr) { const int row = 8 * grp + rr;
            if (rr < 7) {
#pragma unroll
                for (int j = 0; j < 8; ++j) vn[j] = *(const f32x4*)(a.src32 + (size_t)(row + 1) * D + 4 * lane + 256 * j); }
            rowpass_finish(a, row, rr, s0, s1, v, lane);
#pragma unroll
            for (int j = 0; j < 8; ++j) v[j] = vn[j]; }
    } else {
        v2u w[8], wn[8];
#pragma unroll
        for (int j = 0; j < 8; ++j) w[j] = *(const v2u*)(a.srcb + (size_t)(8 * grp) * D + 4 * lane + 256 * j);
#pragma unroll 1
        for (int rr = 0; rr < 8; ++rr) { const int row = 8 * grp + rr;
            if (rr < 7) {
#pragma unroll
                for (int j = 0; j < 8; ++j) wn[j] = *(const v2u*)(a.srcb + (size_t)(row + 1) * D + 4 * lane + 256 * j); }
#pragma unroll
            for (int j = 0; j < 8; ++j) v[j] = (f32x4){bflo(w[j].x), bfhi(w[j].x), bflo(w[j].y), bfhi(w[j].y)};
            rowpass_finish(a, row, rr, s0, s1, v, lane);
#pragma unroll
            for (int j = 0; j < 8; ++j) w[j] = wn[j]; }
    }
    if (a.mode == 2) return;
    asm volatile("s_waitcnt vmcnt(0)" ::: "memory");
    const int g = lane >> 4, lc = lane & 15;
    f32x4 acc = (f32x4){0.f, 0.f, 0.f, 0.f};
    const bf16* xr = a.XB + (size_t)(8 * grp + (lc & 7)) * D + 8 * g; const bf16* wf = a.W16F + lane * 8;
#pragma unroll 8
    for (int s = 0; s < 64; ++s) { bf16x8v af = *(const bf16x8v*)(xr + 32 * s); if (lc >= 8) af = (bf16x8v){0, 0, 0, 0, 0, 0, 0, 0};
        const bf16x8v bf = *(const bf16x8v*)(wf + s * 512); acc = __builtin_amdgcn_mfma_f32_16x16x32_bf16(af, bf, acc, 0, 0, 0); }
    float rs[4];
#pragma unroll
    for (int r = 0; r < 4; ++r) rs[r] = a.RSTD[8 * grp + 4 * (g & 1) + r];
    if (a.mode == 0) { const float bs = a.bias[lc];
#pragma unroll
        for (int r = 0; r < 4; ++r) { const float rstd = rs[r]; if (g < 2) a.GATES[(size_t)(8 * grp + 4 * g + r) * 16 + lc] = acc[r] * rstd + bs; } }
    else {
#pragma unroll
        for (int r = 0; r < 4; ++r) { const float rstd = rs[r]; const float lg = acc[r] * rstd; float mx = lg;
#pragma unroll
            for (int o = 1; o < 16; o <<= 1) mx = fmaxf(mx, __shfl_xor(mx, o));
            const float p = __expf(lg - mx); float sum = p;
#pragma unroll
            for (int o = 1; o < 16; o <<= 1) sum += __shfl_xor(sum, o);
            const int row = 8 * grp + 4 * g + r; if (g < 2) a.AFF[((size_t)(row / SEQ) * NE + lc) * SEQ + (row % SEQ)] = p / sum; } }
}
__device__ __forceinline__ void w16f_item(const float* W, int ldw, const float* gk, bf16* WF, int s, int lane) {
    const int g = lane >> 4, lc = lane & 15; float v[8];
#pragma unroll
    for (int i = 0; i < 8; ++i) { const int k = 32 * s + 8 * g + i; v[i] = W[(size_t)k * ldw + lc] * gk[k]; }
    v4u o; o.x = pk2(v[0], v[1]); o.y = pk2(v[2], v[3]); o.z = pk2(v[4], v[5]); o.w = pk2(v[6], v[7]);
    *(v4u*)(WF + (size_t)(s * 64 + lane) * 8) = o;
}

__device__ __forceinline__ void na_norm_item(const bf16* NAO, const float* g, bf16* MIX, int t, int lane) {
    f32x4 v[4]; float ss = 0.f;
#pragma unroll
    for (int j = 0; j < 4; ++j) { const v2u w = *(const v2u*)(NAO + (size_t)t * 1024 + 4 * lane + 256 * j); v[j] = (f32x4){bflo(w.x), bfhi(w.x), bflo(w.y), bfhi(w.y)}; ss += (v[j][0] * v[j][0] + v[j][1] * v[j][1]) + (v[j][2] * v[j][2] + v[j][3] * v[j][3]); }
    const float rstd = 1.0f / sqrtf(wave_sum(ss) * (1.0f / 1024.0f) + EPS);
#pragma unroll
    for (int j = 0; j < 4; ++j) { const f32x4 gg = *(const f32x4*)(g + 4 * lane + 256 * j); const f32x4 o = v[j] * rstd * gg; v2u w; w.x = pk2(o[0], o[1]); w.y = pk2(o[2], o[3]);
        *(v2u*)(MIX + (size_t)t * D + 4 * lane + 256 * j) = w; }
}

__device__ __forceinline__ int block_sum_512(int v, LAS int* red, int wave, int lane) {
#pragma unroll
    for (int o = 1; o < 64; o <<= 1) v += __shfl_xor(v, o);
    __syncthreads();
    if (lane == 0) red[wave] = v;
    __syncthreads();
    int s = 0;
#pragma unroll
    for (int w = 0; w < 8; ++w) s += red[w];
    return s;
}
__device__ __forceinline__ int block_excl_scan_512(int v, LAS int* red, int wave, int lane) {
    int inc = v;
#pragma unroll
    for (int o = 1; o < 64; o <<= 1) { const int t = __shfl_up(inc, o); if (lane >= o) inc += t; }
    __syncthreads();
    if (lane == 63) red[wave] = inc;
    __syncthreads();
    int base = 0;
#pragma unroll
    for (int w = 0; w < 8; ++w) base += (w < wave) ? red[w] : 0;
    return base + inc - v;
}
__device__ __forceinline__ void topk_unit(int be, const float* AFF, int* TOK, float* GATEV, int* SEL, LAS int* red) {
    int tid_ = threadIdx.x; asm volatile("" : "+v"(tid_)); const int tid = tid_, lane = tid & 63, wave = tid >> 6;
    const int b = be >> 4, e = be & 15;
    const float* a = AFF + (size_t)be * SEQ + tid * 8;
    const f32x4 a0 = *(const f32x4*)a, a1 = *(const f32x4*)(a + 4);
    unsigned key[8] = {__float_as_uint(a0.x), __float_as_uint(a0.y), __float_as_uint(a0.z), __float_as_uint(a0.w),
                       __float_as_uint(a1.x), __float_as_uint(a1.y), __float_as_uint(a1.z), __float_as_uint(a1.w)};
    LAS int* hist = red + 16;
    unsigned T = 0u; int need = CAP;
#pragma unroll 1
    for (int pass = 0; pass < 4; ++pass) { const int shift = 24 - 8 * pass; const unsigned mhi = pass == 0 ? 0u : (0xFFFFFFFFu << (shift + 8));
        __syncthreads();
        if (tid < 256) hist[tid] = 0;
        __syncthreads();
#pragma unroll
        for (int i = 0; i < 8; ++i) if ((key[i] & mhi) == T) (void)__hip_atomic_fetch_add(&hist[(key[i] >> shift) & 255u], 1, __ATOMIC_RELAXED, __HIP_MEMORY_SCOPE_WORKGROUP);
        __syncthreads();
        if (wave == 0) { const int c0 = hist[4 * lane], c1 = hist[4 * lane + 1], c2 = hist[4 * lane + 2], c3 = hist[4 * lane + 3]; const int t = c0 + c1 + c2 + c3; int inc = t;
#pragma unroll
            for (int o = 1; o < 64; o <<= 1) { const int v = __shfl_down(inc, o); if (lane + o < 64) inc += v; }
            const int ab3 = inc - t, ab2 = ab3 + c3, ab1 = ab2 + c2, ab0 = ab1 + c1;
            if (ab3 < need && need <= ab3 + c3) { red[8] = 4 * lane + 3; red[9] = ab3; }
            if (ab2 < need && need <= ab2 + c2) { red[8] = 4 * lane + 2; red[9] = ab2; }
            if (ab1 < need && need <= ab1 + c1) { red[8] = 4 * lane + 1; red[9] = ab1; }
            if (ab0 < need && need <= ab0 + c0) { red[8] = 4 * lane + 0; red[9] = ab0; } }
        __syncthreads();
        T |= (unsigned)red[8] << shift; need -= red[9]; }
    int ceq = 0;
#pragma unroll
    for (int i = 0; i < 8; ++i) ceq += key[i] == T ? 1 : 0;
    const int need_eq = need;
    int eqrank = block_excl_scan_512(ceq, red, wave, lane);
    int selm = 0, csel = 0;
#pragma unroll
    for (int i = 0; i < 8; ++i) { bool sel = key[i] > T; if (key[i] == T) { sel = eqrank < need_eq; ++eqrank; } if (sel) { selm |= 1 << i; ++csel; } }
    int slot = block_excl_scan_512(csel, red, wave, lane);
#pragma unroll
    for (int i = 0; i < 8; ++i) { const int sidx = tid * 8 + i; const int tok = b * SEQ + sidx;
        if (selm & (1 << i)) { const int R = e * 2048 + b * 512 + slot; TOK[R] = tok; GATEV[R] = __uint_as_float(key[i]); SEL[tok * 16 + e] = slot; ++slot; }
        else SEL[tok * 16 + e] = -1; }
    __syncthreads();
}

typedef short bf16x8v __attribute__((ext_vector_type(8)));
typedef short s16x4 __attribute__((ext_vector_type(4)));
constexpr int ML_L = 128, ML_NC = SEQ / ML_L;
constexpr int KP = 272, VP = 528;
constexpr int ML_T0 = 0, ML_T1 = 128 * KP, ML_V = 2 * 128 * KP;
constexpr int ML_AR = ML_V + 128 * VP;
constexpr int ML_END = ML_AR + 24 * 512;
static_assert(ML_AR % 16 == 0, "LDS map");
constexpr size_t WS_UC = WS_HF;
constexpr size_t WS_NU = 6 * MiB;
constexpr size_t WS_SC = 7 * MiB;

__device__ __forceinline__ s16x4 lds_tr(LAS unsigned char* p) { return __builtin_amdgcn_ds_read_tr16_b64_v4i16((LAS s16x4*)p); }
__device__ __forceinline__ bf16x8v frag_tr(LAS unsigned char* tile, int pitch, int k0, int n0, int lane) {
    const int g = lane >> 4, q = (lane & 15) >> 2, p = lane & 3;
    LAS unsigned char* a = tile + (k0 + 8 * g + q) * pitch + (n0 + 4 * p) * 2;
    const s16x4 lo = lds_tr(a), hi = lds_tr(a + 4 * pitch);
    return (bf16x8v){lo[0], lo[1], lo[2], lo[3], hi[0], hi[1], hi[2], hi[3]};
}
__device__ __forceinline__ bf16x8v frag_row(LAS unsigned char* tile, int pitch, int m0, int k0, int lane) {
    return *(LAS bf16x8v*)(tile + (m0 + (lane & 15)) * pitch + (k0 + 8 * (lane >> 4)) * 2);
}
__device__ __forceinline__ float log_sigmoid_f(float f) { return fminf(f, 0.f) - log1pf(__expf(-fabsf(f))); }
__device__ __forceinline__ float shfl_up_f(float v, int o, int lane, float ident) { const float t = __shfl_up(v, o); return lane >= o ? t : ident; }

__device__ __forceinline__ void chunk_gates(const float* GATES, int t0, int h, int dir, int lane, int& s0, int& s1, float& i0, float& i1, float& b0, float& b1, float& btot) {
    const int p0 = 2 * lane, p1 = p0 + 1; s0 = dir ? 127 - p0 : p0; s1 = dir ? 127 - p1 : p1;
    const int icol = dir * 8 + h, fcol = icol + 4;
    const float* gp = GATES + (size_t)t0 * 16;
    const float f0 = log_sigmoid_f(gp[s0 * 16 + fcol]), f1 = log_sigmoid_f(gp[s1 * 16 + fcol]);
    i0 = gp[s0 * 16 + icol]; i1 = gp[s1 * 16 + icol];
    const float s = f0 + f1; float inc = s;
#pragma unroll
    for (int o = 1; o < 64; o <<= 1) inc += shfl_up_f(inc, o, lane, 0.f);
    const float excl = inc - s; b0 = excl + f0; b1 = excl + s; btot = __shfl(inc, 63);
}


__device__ __forceinline__ void conv_chunk4(const bf16* P, const float* cw, const float* cb, int b, int sq0, int chan0, float (&o)[4][8]) {
    const bf16* pc = P + ((size_t)b * SEQ + sq0) * NPROJ + C_MLQ + chan0;
    v4u w[8];
#pragma unroll
    for (int j = 0; j < 8; ++j) { const int ss = sq0 + j - 2; w[j] = (ss >= 0 && ss < SEQ) ? *(const v4u*)(pc + (ptrdiff_t)(j - 2) * NPROJ) : (v4u){0u, 0u, 0u, 0u}; }
    const f32x4 b0 = *(const f32x4*)(cb + chan0), b1 = *(const f32x4*)(cb + chan0 + 4);
#pragma unroll
    for (int t = 0; t < 4; ++t) { o[t][0] = b0[0]; o[t][1] = b0[1]; o[t][2] = b0[2]; o[t][3] = b0[3]; o[t][4] = b1[0]; o[t][5] = b1[1]; o[t][6] = b1[2]; o[t][7] = b1[3]; }
#pragma unroll
    for (int j = 0; j < 5; ++j) { const f32x4 c0 = *(const f32x4*)(cw + j * 1024 + chan0), c1 = *(const f32x4*)(cw + j * 1024 + chan0 + 4);
#pragma unroll
        for (int t = 0; t < 4; ++t) { const v4u x = w[t + j];
            o[t][0] += c0[0] * bflo(x.x); o[t][1] += c0[1] * bfhi(x.x); o[t][2] += c0[2] * bflo(x.y); o[t][3] += c0[3] * bfhi(x.y);
            o[t][4] += c1[0] * bflo(x.z); o[t][5] += c1[1] * bfhi(x.z); o[t][6] += c1[2] * bflo(x.w); o[t][7] += c1[3] * bfhi(x.w); } }
#pragma unroll
    for (int t = 0; t < 4; ++t)
#pragma unroll
        for (int i = 0; i < 8; ++i) o[t][i] = o[t][i] / (1.0f + __expf(-o[t][i]));
}

__device__ __forceinline__ void mlstm_m1_unit(int u, const float* cw, const float* cb, const bf16* P, const float* GATES, bf16* UC, float* NU, float* SC, LAS unsigned char* lds, int tid_, int wave) {
    int tid = tid_; asm volatile("" : "+v"(tid)); const int lane = tid & 63;
    const int c = u & 31, h = (u >> 5) & 3, b = u >> 7; const int t0 = b * SEQ + c * ML_L;
    LAS float* WK = (LAS float*)(lds + ML_AR);
    LAS float* NRED = WK + 256;
    __syncthreads();
    if (wave < 2) { const int dir = wave; int s0, s1; float i0, i1, b0, b1, btot;
        chunk_gates(GATES, t0, h, dir, lane, s0, s1, i0, i1, b0, b1, btot);
        const float g0 = btot - b0 + i0, g1 = btot - b1 + i1; const float mloc = wave_max(fmaxf(g0, g1));
        WK[dir * 128 + s0] = __expf(g0 - mloc); WK[dir * 128 + s1] = __expf(g1 - mloc);
        if (lane == 0) { float* sc = SC + (size_t)((((b * 4 + h) * 2 + dir) * 32) + c) * 4; sc[0] = btot; sc[1] = mloc; } }
#pragma unroll
    for (int i = 0; i < 8; ++i) { const int id = tid + 512 * i, s = id >> 5, ch = id & 31;
        *(LAS v4u*)(lds + ML_V + s * VP + ch * 16) = *(const v4u*)(P + (size_t)(t0 + s) * NPROJ + C_MLV + h * 256 + ch * 8); }
    float k4[4][8]; conv_chunk4(P, cw, cb, b, c * ML_L + 4 * (tid >> 4), 512 + h * 128 + (tid & 15) * 8, k4);
    __syncthreads();
    { float nf[8], nb[8];
#pragma unroll
      for (int j = 0; j < 8; ++j) { nf[j] = 0.f; nb[j] = 0.f; }
#pragma unroll
      for (int i = 0; i < 4; ++i) { const int s = 4 * (tid >> 4) + i, ch = tid & 15; const float (&k)[8] = k4[i];
        const float wf = WK[s], wb = WK[128 + s];
        v4u of, ob; of.x = pk2(k[0] * wf, k[1] * wf); of.y = pk2(k[2] * wf, k[3] * wf); of.z = pk2(k[4] * wf, k[5] * wf); of.w = pk2(k[6] * wf, k[7] * wf);
        ob.x = pk2(k[0] * wb, k[1] * wb); ob.y = pk2(k[2] * wb, k[3] * wb); ob.z = pk2(k[4] * wb, k[5] * wb); ob.w = pk2(k[6] * wb, k[7] * wb);
        *(LAS v4u*)(lds + ML_T0 + s * KP + ch * 16) = of; *(LAS v4u*)(lds + ML_T1 + s * KP + ch * 16) = ob;
#pragma unroll
        for (int j = 0; j < 8; ++j) { nf[j] += k[j] * wf; nb[j] += k[j] * wb; } }
#pragma unroll
      for (int j = 0; j < 8; ++j) { nf[j] += __shfl_xor(nf[j], 16); nf[j] += __shfl_xor(nf[j], 32); nb[j] += __shfl_xor(nb[j], 16); nb[j] += __shfl_xor(nb[j], 32); }
      if ((lane >> 4) == 0) {
#pragma unroll
          for (int j = 0; j < 8; ++j) { NRED[wave * 256 + (lane & 15) * 8 + j] = nf[j]; NRED[wave * 256 + 128 + (lane & 15) * 8 + j] = nb[j]; } } }
    __syncthreads();
    if (tid < 256) { const int dir = tid >> 7, d = tid & 127; float sum = 0.f;
#pragma unroll
        for (int w = 0; w < 8; ++w) sum += NRED[w * 256 + tid];
        NU[(size_t)((((b * 4 + h) * 2 + dir) * 32) + c) * 128 + d] = sum; }
    const int g = lane >> 4;
#pragma unroll 1
    for (int dir = 0; dir < 2; ++dir) {
        LAS unsigned char* Kt = lds + (dir ? ML_T1 : ML_T0);
        f32x4 acc[8][2];
#pragma unroll
        for (int mb = 0; mb < 8; ++mb) { acc[mb][0] = (f32x4){0.f, 0.f, 0.f, 0.f}; acc[mb][1] = (f32x4){0.f, 0.f, 0.f, 0.f}; }
#pragma unroll
        for (int ks = 0; ks < 4; ++ks) {
            const bf16x8v b0 = frag_tr(lds + ML_V, VP, 32 * ks, 32 * wave, lane), b1 = frag_tr(lds + ML_V, VP, 32 * ks, 32 * wave + 16, lane);
#pragma unroll
            for (int mb = 0; mb < 8; ++mb) { const bf16x8v a = frag_tr(Kt, KP, 32 * ks, 16 * mb, lane);
                acc[mb][0] = __builtin_amdgcn_mfma_f32_16x16x32_bf16(a, b0, acc[mb][0], 0, 0, 0); acc[mb][1] = __builtin_amdgcn_mfma_f32_16x16x32_bf16(a, b1, acc[mb][1], 0, 0, 0); } }
        bf16* uc = UC + (size_t)((((b * 4 + h) * 2 + dir) * 32) + c) * 32768;
#pragma unroll
        for (int mb = 0; mb < 8; ++mb)
#pragma unroll
            for (int nb = 0; nb < 2; ++nb) { const int e = 32 * wave + 16 * nb + (lane & 15), d0 = 16 * mb + 4 * g; v2u w; w.x = pk2(acc[mb][nb][0], acc[mb][nb][1]); w.y = pk2(acc[mb][nb][2], acc[mb][nb][3]);
                *(v2u*)(uc + e * 128 + d0) = w; }
    }
}

__device__ __forceinline__ void mlstm_m2(bf16* UC, float* NU, float* SC, int gtid, int nthreads) {
    for (int vid = gtid; vid < 32 * 4096; vid += nthreads) { const int chain = vid >> 12, within = vid & 4095, dir = chain & 1;
        float st[8]; float m = 0.f;
#pragma unroll
        for (int i = 0; i < 8; ++i) st[i] = 0.f;
#pragma unroll 4
        for (int step = 0; step < ML_NC; ++step) { const int c = dir ? ML_NC - 1 - step : step;
            float* sc = SC + (size_t)(chain * 32 + c) * 4; const float btot = sc[0], mloc = sc[1];
            v4u* p = (v4u*)(UC + ((size_t)(chain * 32 + c) * 4096 + within) * 8);
            const v4u uw = *p;
            v4u cw; cw.x = pk2(st[0], st[1]); cw.y = pk2(st[2], st[3]); cw.z = pk2(st[4], st[5]); cw.w = pk2(st[6], st[7]);
            *p = cw;
            if (within == 0) sc[2] = m;
            const float mn = fmaxf(btot + m, mloc), dC = __expf(btot + m - mn), dU = __expf(mloc - mn);
            const float uu[8] = {bflo(uw.x), bfhi(uw.x), bflo(uw.y), bfhi(uw.y), bflo(uw.z), bfhi(uw.z), bflo(uw.w), bfhi(uw.w)};
#pragma unroll
            for (int i = 0; i < 8; ++i) st[i] = dC * st[i] + dU * uu[i];
            m = mn; } }
    for (int nid = gtid; nid < 32 * 128; nid += nthreads) { const int chain = nid >> 7, d = nid & 127, dir = chain & 1; float st = 0.f, m = 0.f;
        for (int step = 0; step < ML_NC; ++step) { const int c = dir ? ML_NC - 1 - step : step;
            const float* sc = SC + (size_t)(chain * 32 + c) * 4; const float btot = sc[0], mloc = sc[1];
            float* p = NU + (size_t)(chain * 32 + c) * 128 + d; const float uu = *p; *p = st;
            const float mn = fmaxf(btot + m, mloc); st = __expf(btot + m - mn) * st + __expf(mloc - mn) * uu; m = mn; } }
}

__device__ __forceinline__ void mlstm_m3_unit(int u, const float* cw, const float* cb, const bf16* P, const float* GATES, const bf16* UC, const float* NU, const float* SC, const float* mlg, const float* RSNA, bf16* MIX, LAS unsigned char* lds, int tid_, int wave) {
    int tid = tid_; asm volatile("" : "+v"(tid)); const int lane = tid & 63;
    const int c = u & 31, h = (u >> 5) & 3, b = u >> 7; const int t0 = b * SEQ + c * ML_L;
    LAS float* AR = (LAS float*)(lds + ML_AR);
    LAS float* CS = AR; LAS float* RR = AR + 256; LAS float* INTER = AR + 512; LAS float* EM = AR + 768; LAS float* ALPHA = AR + 1024; LAS float* SS = AR + 1280;
    const int g = lane >> 4, lc = lane & 15;
    const int chain0 = (b * 4 + h) * 2;
    __syncthreads();
    if (wave < 2) { const int dir = wave; int s0, s1; float i0, i1, b0, b1, btot;
        chunk_gates(GATES, t0, h, dir, lane, s0, s1, i0, i1, b0, b1, btot);
        const float cs0 = i0 - b0, cs1 = i1 - b1;
        float pmx = fmaxf(cs0, cs1);
#pragma unroll
        for (int o = 1; o < 64; o <<= 1) pmx = fmaxf(pmx, shfl_up_f(pmx, o, lane, -3.0e38f));
        const float ex = shfl_up_f(pmx, 1, lane, -3.0e38f);
        const float pm0 = fmaxf(ex, cs0), pm1 = fmaxf(pm0, cs1);
        const float m_in = SC[(size_t)((chain0 + dir) * 32 + c) * 4 + 2];
        const float M0 = b0 + fmaxf(m_in, pm0), M1 = b1 + fmaxf(m_in, pm1);
        CS[dir * 128 + s0] = cs0; CS[dir * 128 + s1] = cs1; RR[dir * 128 + s0] = b0 - M0; RR[dir * 128 + s1] = b1 - M1;
        INTER[dir * 128 + s0] = __expf(b0 + m_in - M0); INTER[dir * 128 + s1] = __expf(b1 + m_in - M1); EM[dir * 128 + s0] = __expf(-M0); EM[dir * 128 + s1] = __expf(-M1); }
    { const int s0 = 4 * (tid >> 4), ch = tid & 15; float x4[4][8];
      conv_chunk4(P, cw, cb, b, c * ML_L + s0, h * 128 + ch * 8, x4);
      const float qs = 0.08838834764831845f;
#pragma unroll
      for (int i = 0; i < 4; ++i) { v4u oq; oq.x = pk2(x4[i][0] * qs, x4[i][1] * qs); oq.y = pk2(x4[i][2] * qs, x4[i][3] * qs); oq.z = pk2(x4[i][4] * qs, x4[i][5] * qs); oq.w = pk2(x4[i][6] * qs, x4[i][7] * qs);
          *(LAS v4u*)(lds + ML_T0 + (s0 + i) * KP + ch * 16) = oq; }
      conv_chunk4(P, cw, cb, b, c * ML_L + s0, 512 + h * 128 + ch * 8, x4);
#pragma unroll
      for (int i = 0; i < 4; ++i) { v4u ok; ok.x = pk2(x4[i][0], x4[i][1]); ok.y = pk2(x4[i][2], x4[i][3]); ok.z = pk2(x4[i][4], x4[i][5]); ok.w = pk2(x4[i][6], x4[i][7]);
          *(LAS v4u*)(lds + ML_T1 + (s0 + i) * KP + ch * 16) = ok; } }
#pragma unroll
    for (int i = 0; i < 8; ++i) { const int id = tid + 512 * i, s = id >> 5, ch = id & 31;
        *(LAS v4u*)(lds + ML_V + s * VP + ch * 16) = *(const v4u*)(P + (size_t)(t0 + s) * NPROJ + C_MLV + h * 256 + ch * 8); }
    __syncthreads();
    f32x4 S[8], qn = (f32x4){0.f, 0.f, 0.f, 0.f};
#pragma unroll
    for (int nb = 0; nb < 8; ++nb) S[nb] = (f32x4){0.f, 0.f, 0.f, 0.f};
#pragma unroll
    for (int ks = 0; ks < 4; ++ks) { const bf16x8v a = frag_row(lds + ML_T0, KP, 16 * wave, 32 * ks, lane);
        bf16x8v nf = (bf16x8v){0, 0, 0, 0, 0, 0, 0, 0};
        if (lc < 2) { const float* np = NU + (size_t)((chain0 + lc) * 32 + c) * 128 + 32 * ks + 8 * g; const f32x4 n0 = *(const f32x4*)np, n1 = *(const f32x4*)(np + 4);
            const unsigned w0 = pk2(n0[0], n0[1]), w1 = pk2(n0[2], n0[3]), w2 = pk2(n1[0], n1[1]), w3 = pk2(n1[2], n1[3]);
            nf = (bf16x8v){(short)(w0 & 0xffff), (short)(w0 >> 16), (short)(w1 & 0xffff), (short)(w1 >> 16), (short)(w2 & 0xffff), (short)(w2 >> 16), (short)(w3 & 0xffff), (short)(w3 >> 16)}; }
        qn = __builtin_amdgcn_mfma_f32_16x16x32_bf16(a, nf, qn, 0, 0, 0);
#pragma unroll
        for (int nb = 0; nb < 8; ++nb) { const bf16x8v kb = frag_row(lds + ML_T1, KP, 16 * nb, 32 * ks, lane); S[nb] = __builtin_amdgcn_mfma_f32_16x16x32_bf16(a, kb, S[nb], 0, 0, 0); } }
    float csf[8], csb[8];
#pragma unroll
    for (int nb = 0; nb < 8; ++nb) { csf[nb] = CS[16 * nb + lc]; csb[nb] = CS[128 + 16 * nb + lc]; }
    float pc[8][4];
#pragma unroll
    for (int r = 0; r < 4; ++r) { const int j = 16 * wave + 4 * g + r; const float Rf = RR[j], Rb = RR[128 + j];
        const float qnf = __shfl(qn[r], 16 * g), qnb = __shfl(qn[r], 16 * g + 1);
        float sf[8], sb[8], rsf = 0.f, rsb = 0.f;
#pragma unroll
        for (int nb = 0; nb < 8; ++nb) { const int s = 16 * nb + lc; const float wf = s <= j ? __expf(Rf + csf[nb]) : 0.f, wb = s >= j ? __expf(Rb + csb[nb]) : 0.f;
            sf[nb] = S[nb][r] * wf; sb[nb] = S[nb][r] * wb; rsf += sf[nb]; rsb += sb[nb]; }
#pragma unroll
        for (int o = 1; o < 16; o <<= 1) { rsf += __shfl_xor(rsf, o); rsb += __shfl_xor(rsb, o); }
        const float inf_ = INTER[j], inb_ = INTER[128 + j];
        const float ivf = 1.0f / fmaxf(fabsf(inf_ * qnf + rsf), EM[j]), ivb = 1.0f / fmaxf(fabsf(inb_ * qnb + rsb), EM[128 + j]);
#pragma unroll
        for (int nb = 0; nb < 8; ++nb) pc[nb][r] = sf[nb] * ivf + sb[nb] * ivb;
        if (lc == 0) { ALPHA[j] = inf_ * ivf; ALPHA[128 + j] = inb_ * ivb; } }
    __syncthreads();
#pragma unroll
    for (int r = 0; r < 4; ++r) { const int j = 16 * wave + 4 * g + r;
#pragma unroll
        for (int nb = 0; nb < 8; ++nb) *(LAS unsigned short*)(lds + ML_T1 + j * KP + (16 * nb + lc) * 2) = (unsigned short)f2bf(pc[nb][r]); }
    __syncthreads();
    f32x4 acc[2][8], acc2[2][8];
#pragma unroll
    for (int mb = 0; mb < 2; ++mb)
#pragma unroll
        for (int nb = 0; nb < 8; ++nb) { acc[mb][nb] = (f32x4){0.f, 0.f, 0.f, 0.f}; acc2[mb][nb] = (f32x4){0.f, 0.f, 0.f, 0.f}; }
    const bf16* ucf = UC + (size_t)((chain0 + 0) * 32 + c) * 32768 + (size_t)(32 * wave + lc) * 128 + 8 * g;
    const bf16* ucb = UC + (size_t)((chain0 + 1) * 32 + c) * 32768 + (size_t)(32 * wave + lc) * 128 + 8 * g;
#pragma unroll
    for (int ks = 0; ks < 4; ++ks) {
        const bf16x8v af0 = *(const bf16x8v*)(ucf + 32 * ks), af1 = *(const bf16x8v*)(ucf + 16 * 128 + 32 * ks), ab0 = *(const bf16x8v*)(ucb + 32 * ks), ab1 = *(const bf16x8v*)(ucb + 16 * 128 + 32 * ks);
#pragma unroll
        for (int nb = 0; nb < 8; ++nb) { const bf16x8v qb = frag_row(lds + ML_T0, KP, 16 * nb, 32 * ks, lane);
            acc[0][nb] = __builtin_amdgcn_mfma_f32_16x16x32_bf16(af0, qb, acc[0][nb], 0, 0, 0); acc[1][nb] = __builtin_amdgcn_mfma_f32_16x16x32_bf16(af1, qb, acc[1][nb], 0, 0, 0);
            acc2[0][nb] = __builtin_amdgcn_mfma_f32_16x16x32_bf16(ab0, qb, acc2[0][nb], 0, 0, 0); acc2[1][nb] = __builtin_amdgcn_mfma_f32_16x16x32_bf16(ab1, qb, acc2[1][nb], 0, 0, 0); } }
#pragma unroll
    for (int nb = 0; nb < 8; ++nb) { const float af = ALPHA[16 * nb + lc], ab = ALPHA[128 + 16 * nb + lc];
        acc[0][nb] = acc[0][nb] * af + acc2[0][nb] * ab; acc[1][nb] = acc[1][nb] * af + acc2[1][nb] * ab; }
#pragma unroll
    for (int ks = 0; ks < 4; ++ks) {
        const bf16x8v v0 = frag_tr(lds + ML_V, VP, 32 * ks, 32 * wave, lane), v1 = frag_tr(lds + ML_V, VP, 32 * ks, 32 * wave + 16, lane);
#pragma unroll
        for (int nb = 0; nb < 8; ++nb) { const bf16x8v pb = frag_row(lds + ML_T1, KP, 16 * nb, 32 * ks, lane);
            acc[0][nb] = __builtin_amdgcn_mfma_f32_16x16x32_bf16(v0, pb, acc[0][nb], 0, 0, 0); acc[1][nb] = __builtin_amdgcn_mfma_f32_16x16x32_bf16(v1, pb, acc[1][nb], 0, 0, 0); } }
#pragma unroll
    for (int nb = 0; nb < 8; ++nb) { float ss = 0.f;
#pragma unroll
        for (int mb = 0; mb < 2; ++mb) ss += (acc[mb][nb][0] * acc[mb][nb][0] + acc[mb][nb][1] * acc[mb][nb][1]) + (acc[mb][nb][2] * acc[mb][nb][2] + acc[mb][nb][3] * acc[mb][nb][3]);
        ss += __shfl_xor(ss, 16); ss += __shfl_xor(ss, 32);
        if (g == 0) SS[wave * 128 + 16 * nb + lc] = ss; }
    __syncthreads();
#pragma unroll
    for (int nb = 0; nb < 8; ++nb) { const int j = 16 * nb + lc; float tot = 0.f;
#pragma unroll
        for (int w = 0; w < 8; ++w) tot += SS[w * 128 + j];
        const float rstd = 1.0f / (sqrtf(tot * (1.0f / 256.0f) + EPS) * RSNA[t0 + j]);
#pragma unroll
        for (int mb = 0; mb < 2; ++mb) { const int e0 = 32 * wave + 16 * mb + 4 * g; const size_t t = (size_t)(t0 + j);
            const v2u ow = *(const v2u*)(P + t * NPROJ + C_MLO + h * 256 + e0); const f32x4 gg = *(const f32x4*)(mlg + h * 256 + e0);
            const float o[4] = {bflo(ow.x), bfhi(ow.x), bflo(ow.y), bfhi(ow.y)}; float rr[4];
#pragma unroll
            for (int r = 0; r < 4; ++r) rr[r] = acc[mb][nb][r] * rstd * gg[r] / (1.0f + __expf(-o[r]));
            v2u w; w.x = pk2(rr[0], rr[1]); w.y = pk2(rr[2], rr[3]);
            *(v2u*)(MIX + t * D + 1024 + h * 256 + e0) = w; } }
}


#ifndef NA_PROBE
#define NA_PROBE 0
#endif
constexpr int NA_TILE = 64 * KP, NA_BUF = 2 * NA_TILE, NA_RPB = 2 * NA_BUF;
static_assert(NA_RPB + 15 * 128 * 4 <= ML_END, "LDS map");
__device__ __forceinline__ bf16x8v frag_tr2(LAS unsigned char* tile, int pitch, int row0, int row1, int n0, int lane) {
    const int q = (lane & 15) >> 2, p = lane & 3;
    const s16x4 lo = lds_tr(tile + (row0 + q) * pitch + (n0 + 4 * p) * 2), hi = lds_tr(tile + (row1 + q) * pitch + (n0 + 4 * p) * 2);
    return (bf16x8v){lo[0], lo[1], lo[2], lo[3], hi[0], hi[1], hi[2], hi[3]};
}
__device__ __forceinline__ void na_unit(int u, const bf16* P, const float* rpb, bf16* MIX, float* SSQ, LAS unsigned char* lds, int tid_, int wave) {
    int tid = tid_; asm volatile("" : "+v"(tid)); const int lane = tid & 63, g = lane >> 4, lc = lane & 15;
    const int r4 = u & 15, h = (u >> 4) & 7, b = u >> 7;
    const int r0 = 4 * r4, r = r0 + (wave >> 1), qh = wave & 1;
    const int rs = min(max(r - 4, 0), 56), rs0 = min(max(r0 - 4, 0), 56), nk = min(max(r0 + 3 - 4, 0), 56) + 8 - rs0;
    LAS float* RPB = (LAS float*)(lds + NA_RPB);
    const int sA = tid >> 4, chA = tid & 15, sB = sA + 32;
    const bf16* gsrc = P + ((size_t)b * SEQ + rs0 * 64) * NPROJ + h * 128 + chA * 8;
    v4u pk0, pk1, pv0, pv1;
#define NA_LOAD(j) do { const bf16* s_ = gsrc + (size_t)(j) * 64 * NPROJ; pk0 = *(const v4u*)(s_ + (size_t)sA * NPROJ + C_NAK); pk1 = *(const v4u*)(s_ + (size_t)sB * NPROJ + C_NAK); \
        pv0 = *(const v4u*)(s_ + (size_t)sA * NPROJ + C_NAV); pv1 = *(const v4u*)(s_ + (size_t)sB * NPROJ + C_NAV); } while (0)
#define NA_STORE(buf) do { LAS unsigned char* t_ = lds + (buf) * NA_BUF; *(LAS v4u*)(t_ + sA * KP + chA * 16) = pk0; *(LAS v4u*)(t_ + sB * KP + chA * 16) = pk1; \
        *(LAS v4u*)(t_ + NA_TILE + sA * KP + chA * 16) = pv0; *(LAS v4u*)(t_ + NA_TILE + sB * KP + chA * 16) = pv1; } while (0)
    NA_LOAD(0);
    __syncthreads();
    for (int i = tid; i < 15 * 128; i += 512) { const int dr = i >> 7, x = (i & 127) - 48; RPB[i] = (x >= 0 && x < 31) ? rpb[h * 465 + dr * 31 + x] * 1.4426950408889634f : 0.f; }
    NA_STORE(0);
    bf16x8v qf[2][4]; int cq[2], cs[2], boff[2]; float m[2], l[2]; f32x4 O[2][8]; f32x4 madd[2][4];
#pragma unroll
    for (int qi = 0; qi < 2; ++qi) { cq[qi] = 32 * qh + 16 * qi + lc; cs[qi] = min(max(cq[qi] - 8, 0), 48); m[qi] = -1.0e30f; l[qi] = 0.f; boff[qi] = 63 - cq[qi] + 4 * g;
#pragma unroll
        for (int kb = 0; kb < 4; ++kb)
#pragma unroll
            for (int rr = 0; rr < 4; ++rr) { const int kc = 16 * kb + 4 * g + rr; madd[qi][kb][rr] = (kc >= cs[qi] && kc < cs[qi] + 16) ? 0.f : -1.0e30f; }
        const bf16* qp = P + ((size_t)b * SEQ + r * 64 + cq[qi]) * NPROJ + C_NAQ + h * 128 + 8 * g;
#pragma unroll
        for (int ks = 0; ks < 4; ++ks) qf[qi][ks] = *(const bf16x8v*)(qp + 32 * ks);
#pragma unroll
        for (int db = 0; db < 8; ++db) O[qi][db] = (f32x4){0.f, 0.f, 0.f, 0.f}; }
    __syncthreads();
#pragma unroll 1
    for (int j = 0; j < nk; ++j) {
        const int kr = rs0 + j;
        if (j + 1 < nk) NA_LOAD(j + 1);
        if (kr >= rs && kr < rs + 8) {
            LAS unsigned char* Kt = lds + (j & 1) * NA_BUF; LAS unsigned char* Vt = Kt + NA_TILE;
            const LAS float* brow = RPB + (kr - r + 7) * 128;
            const int kb0a = qh ? 1 : 0, kb1a = qh ? 3 : 1, kb0b = qh ? 2 : 0, kb1b = qh ? 3 : 2;
            f32x4 s[2][4];
#if NA_PROBE == 1
            for (int prb = 0; prb < 2; ++prb) { asm volatile("" ::: "memory");
#else
            {
#endif
#pragma unroll
            for (int kb = 0; kb < 4; ++kb) { s[0][kb] = (f32x4){0.f, 0.f, 0.f, 0.f}; s[1][kb] = (f32x4){0.f, 0.f, 0.f, 0.f}; }
#pragma unroll
            for (int kb = 0; kb < 4; ++kb) { const bool ua = kb >= kb0a && kb <= kb1a, ub = kb >= kb0b && kb <= kb1b;
                if (ua || ub) {
#pragma unroll
                    for (int ks = 0; ks < 4; ++ks) { const bf16x8v ka = frag_row(Kt, KP, 16 * kb, 32 * ks, lane);
                        if (ua) s[0][kb] = __builtin_amdgcn_mfma_f32_16x16x32_bf16(ka, qf[0][ks], s[0][kb], 0, 0, 0);
                        if (ub) s[1][kb] = __builtin_amdgcn_mfma_f32_16x16x32_bf16(ka, qf[1][ks], s[1][kb], 0, 0, 0); } } }
            }
            bf16x8v pb[2][2];
#pragma unroll
            for (int qi = 0; qi < 2; ++qi) {
                const int k0 = qi ? kb0b : kb0a, k1 = qi ? kb1b : kb1a; const LAS float* bq = brow + boff[qi];
                float mx = -1.0e30f;
#pragma unroll
                for (int kb = 0; kb < 4; ++kb) if (kb >= k0 && kb <= k1) {
#pragma unroll
                    for (int rr = 0; rr < 4; ++rr) { const float v = s[qi][kb][rr] * 0.12753785f + bq[16 * kb + rr] + madd[qi][kb][rr]; s[qi][kb][rr] = v; mx = fmaxf(mx, v); } }
                mx = fmaxf(mx, __shfl_xor(mx, 16)); mx = fmaxf(mx, __shfl_xor(mx, 32));
                const float mn = fmaxf(m[qi], mx); float ls = 0.f;
#pragma unroll
                for (int kb = 0; kb < 4; ++kb) { if (kb >= k0 && kb <= k1) {
#pragma unroll
                    for (int rr = 0; rr < 4; ++rr) { const float p = __builtin_amdgcn_exp2f(s[qi][kb][rr] - mn); s[qi][kb][rr] = p; ls += p; } } else s[qi][kb] = (f32x4){0.f, 0.f, 0.f, 0.f}; }
                ls += __shfl_xor(ls, 16); ls += __shfl_xor(ls, 32);
                if (!__all(mn == m[qi])) { const float corr = __builtin_amdgcn_exp2f(m[qi] - mn); l[qi] *= corr;
#pragma unroll
                    for (int db = 0; db < 8; ++db) O[qi][db] = O[qi][db] * corr; }
                l[qi] += ls; m[qi] = mn;
#pragma unroll
                for (int t = 0; t < 2; ++t) { v4u pw; pw.x = pk2(s[qi][2 * t][0], s[qi][2 * t][1]); pw.y = pk2(s[qi][2 * t][2], s[qi][2 * t][3]); pw.z = pk2(s[qi][2 * t + 1][0], s[qi][2 * t + 1][1]); pw.w = pk2(s[qi][2 * t + 1][2], s[qi][2 * t + 1][3]);
                    pb[qi][t] = __builtin_bit_cast(bf16x8v, pw); }
            }
#if NA_PROBE == 2
            for (int prb = 0; prb < 2; ++prb) { asm volatile("" ::: "memory"); if (prb) { pb[0][0] = pb[0][1] = pb[1][0] = pb[1][1] = (bf16x8v){0, 0, 0, 0, 0, 0, 0, 0}; }
#else
            {
#endif
#pragma unroll
            for (int t = 0; t < 2; ++t) { const bool ua = 2 * t + 1 >= kb0a && 2 * t <= kb1a, ub = 2 * t + 1 >= kb0b && 2 * t <= kb1b;
                if (ua || ub) {
#pragma unroll
                    for (int db = 0; db < 8; ++db) { const bf16x8v va = frag_tr2(Vt, KP, 32 * t + 4 * g, 32 * t + 16 + 4 * g, 16 * db, lane);
                        if (ua) O[0][db] = __builtin_amdgcn_mfma_f32_16x16x32_bf16(va, pb[0][t], O[0][db], 0, 0, 0);
                        if (ub) O[1][db] = __builtin_amdgcn_mfma_f32_16x16x32_bf16(va, pb[1][t], O[1][db], 0, 0, 0); } } }
            }
        }
#if NA_PROBE == 4
        if (j + 1 < nk) { NA_STORE((j + 1) & 1); asm volatile("" ::: "memory"); }
#endif
#if NA_PROBE == 5
        __syncthreads();
#endif
        if (j + 1 < nk) NA_STORE((j + 1) & 1);
        __syncthreads();
    }
#pragma unroll
    for (int qi = 0; qi < 2; ++qi) { const float inv = 1.0f / l[qi]; const size_t t = (size_t)b * SEQ + r * 64 + cq[qi]; bf16* op = MIX + t * D + h * 128 + 4 * g; float ss = 0.f;
#pragma unroll
        for (int db = 0; db < 8; ++db) { const f32x4 o = O[qi][db] * inv; ss += (o[0] * o[0] + o[1] * o[1]) + (o[2] * o[2] + o[3] * o[3]); v2u w; w.x = pk2(o[0], o[1]); w.y = pk2(o[2], o[3]); *(v2u*)(op + 16 * db) = w; }
        ss += __shfl_xor(ss, 16); ss += __shfl_xor(ss, 32);
        if (g == 0) SSQ[t * 8 + h] = ss; }
#undef NA_LOAD
#undef NA_STORE
}


constexpr int NWAVES = 8;
#ifndef NCONV
#define NCONV 112
#endif
constexpr int RING_BYTES = 131072;
constexpr int LDSCTL_OFF = ML_END, MISC_OFF = LDSCTL_OFF + 320;
constexpr int LDS_BYTES = LDSCTL_OFF + 1024;
static_assert(ML_END >= RING_BYTES && LDS_BYTES <= 163840, "LDS map");
constexpr int CW_BAR = 4096;
constexpr size_t CTL_ZERO_BYTES = 65536;
static_assert((CW_BAR + XCD_BAR_WORDS) * 4 <= (int)CTL_ZERO_BYTES, "barrier words inside the memset region");

struct MKArgs { const float* in[16]; float* out; unsigned char* ws; };
__global__ void __launch_bounds__(NWAVES * 64, 2) mk_fwd(MKArgs args) {
    extern __shared__ __attribute__((aligned(16))) unsigned char lds_raw[];
    LAS unsigned char* lds = (LAS unsigned char*)lds_raw;
    volatile LAS unsigned* MISC = (volatile LAS unsigned*)(lds + MISC_OFF);
    const int tid = threadIdx.x, lane0 = tid & 63, wave = __builtin_amdgcn_readfirstlane(tid >> 6);
    const int G = gridDim.x; const int bx = blockIdx.x; const int vcu = (G % 8 == 0) ? (bx % 8) * (G / 8) + bx / 8 : bx;
    const int gw0 = vcu * NWAVES + wave, ngw = G * NWAVES;
    unsigned char* ws = args.ws;
    for (int u = tid; u < (LDS_BYTES - LDSCTL_OFF) / 4; u += NWAVES * 64) ((LAS unsigned*)(lds + LDSCTL_OFF))[u] = 0u;
    __syncthreads();
    XcdBarrier bar = xcd_barrier_post((unsigned*)(ws + WS_CTL) + CW_BAR, MISC + 8);
#define GRID_BAR() do { XcdBarrier b_ = bar; asm volatile("" : "+s"(b_.bar), "+s"(b_.x)); xcd_barrier(b_); } while (0)
    const float* x = args.in[0]; const float* norm_mix_g = args.in[1]; const float* w_in = args.in[2]; const float* b_gates = args.in[3];
    const float* conv_w = args.in[4]; const float* conv_b = args.in[5]; const float* na_rpb = args.in[6]; const float* na_norm_g = args.in[7];
    const float* ml_norm_g = args.in[8]; const float* w_out = args.in[9]; const float* norm_ffn_g = args.in[10]; const float* w_router = args.in[11];
    const float* w_gate = args.in[12]; const float* w_up = args.in[13]; const float* w_down = args.in[14]; const float* final_norm_g = args.in[15];
#define WSPTRS(wsl, Xl) float* X = (Xl); float* RSTD = (float*)((wsl) + WS_RSTD); float* GATES = (float*)((wsl) + WS_GATES); float* AFF = (float*)((wsl) + WS_AFF); int* TOK = (int*)((wsl) + WS_TOK); float* GATEV = (float*)((wsl) + WS_GATEV); int* SEL = (int*)((wsl) + WS_SEL); \
    bf16* XB = (bf16*)((wsl) + WS_XB); bf16* MIX = (bf16*)((wsl) + WS_MIX); bf16* P = (bf16*)((wsl) + WS_P); bf16* NAO = (bf16*)((wsl) + WS_NAO); bf16* ACT = (bf16*)((wsl) + WS_ACT); bf16* Y = (bf16*)((wsl) + WS_Y); \
    (void)X; (void)RSTD; (void)GATES; (void)AFF; (void)TOK; (void)GATEV; (void)SEL; (void)XB; (void)MIX; (void)P; (void)NAO; (void)ACT; (void)Y;
#define LAUNDER(p) asm volatile("" : "+s"(p))
#ifndef REP_MASK
#define REP_MASK 0
#endif
#if (REP_MASK >> 0) & 1
#define REP0 for (int rep_ = 0; rep_ < 2; ++rep_)
#else
#define REP0
#endif
#if (REP_MASK >> 1) & 1
#define REP1 for (int rep_ = 0; rep_ < 2; ++rep_)
#else
#define REP1
#endif
#if (REP_MASK >> 2) & 1
#define REP2 for (int rep_ = 0; rep_ < 2; ++rep_)
#else
#define REP2
#endif
#if (REP_MASK >> 3) & 1
#define REP3 for (int rep_ = 0; rep_ < 2; ++rep_)
#else
#define REP3
#endif
#if (REP_MASK >> 4) & 1
#define REP4 for (int rep_ = 0; rep_ < 2; ++rep_)
#else
#define REP4
#endif
#if (REP_MASK >> 5) & 1
#define REP5 for (int rep_ = 0; rep_ < 2; ++rep_)
#else
#define REP5
#endif
#if (REP_MASK >> 6) & 1
#define REP6 for (int rep_ = 0; rep_ < 2; ++rep_)
#else
#define REP6
#endif
#if (REP_MASK >> 7) & 1
#define REP7 for (int rep_ = 0; rep_ < 2; ++rep_)
#else
#define REP7
#endif
#if (REP_MASK >> 8) & 1
#define REP8 for (int rep_ = 0; rep_ < 2; ++rep_)
#else
#define REP8
#endif
#if (REP_MASK >> 9) & 1
#define REP9 for (int rep_ = 0; rep_ < 2; ++rep_)
#else
#define REP9
#endif
#if (REP_MASK >> 10) & 1
#define REP10 for (int rep_ = 0; rep_ < 2; ++rep_)
#else
#define REP10
#endif
#if (REP_MASK >> 11) & 1
#define REP11 for (int rep_ = 0; rep_ < 2; ++rep_)
#else
#define REP11
#endif
#if (REP_MASK >> 12) & 1
#define REP12 for (int rep_ = 0; rep_ < 2; ++rep_)
#else
#define REP12
#endif
#if (REP_MASK >> 13) & 1
#define REP13 for (int rep_ = 0; rep_ < 2; ++rep_)
#else
#define REP13
#endif

    { WSPTRS(ws, args.out)
      const int lane = lane0, gw = gw0;
    REP0 { ConvArgs ca; ca.w_in = w_in; ca.w_out = w_out; ca.w_gate = w_gate; ca.w_up = w_up; ca.w_down = w_down; ca.norm_mix_g = norm_mix_g; ca.norm_ffn_g = norm_ffn_g; ca.na_norm_g = na_norm_g; ca.ws = ws;
      LAS float* scr = (LAS float*)(lds + wave * CONV_SCR_BYTES);
      if (G == 256) convert_stream(ca, gw, ngw, CI_IN, scr, lane);
      else convert_stream(ca, gw, ngw, DEPTH * CI_LAYER, scr, lane); }
    { bf16* W16F = (bf16*)(ws + WS_W16F_OFF);
      for (int it = gw; it < DEPTH * 2 * 64; it += ngw) { const int mi = it >> 6, s = it & 63, l = mi >> 1;
          if (mi & 1) w16f_item(w_router + (size_t)l * D * NE, NE, norm_ffn_g + l * D, W16F + (size_t)mi * 32768, s, lane);
          else w16f_item(w_in + (size_t)l * D * NIN + C_GATES, NIN, norm_mix_g + l * D, W16F + (size_t)mi * 32768, s, lane); } }
    GRID_BAR();
    REP1 { RowArgs a; a.src32 = x; a.srcb = nullptr; a.sel = nullptr; a.Y = nullptr; a.XB = XB; a.XB8 = ws + WS_XB8; a.RSTD = RSTD; a.g = norm_mix_g; a.W16F = (const bf16*)(ws + WS_W16F_OFF); a.bias = b_gates; a.GATES = GATES; a.AFF = AFF; a.out = X; a.mode = 0; a.wrxb = 1;
      for (int grp = gw; grp < MTOK / 8; grp += ngw) rowpass_group<true>(a, grp, lane); } }
    GRID_BAR();

    for (int l = 0; l < DEPTH; ++l) {
        unsigned char* wsl = ws; float* Xl = args.out; LAUNDER(wsl); LAUNDER(Xl);
        WSPTRS(wsl, Xl)
        int lane = lane0, gw = gw0; asm volatile("" : "+v"(lane)); LAUNDER(gw);
        const bf16* WinT = (const bf16*)(wsl + WS_WIN) + (size_t)l * NPROJ * D; const bf16* WoutT = (const bf16*)(wsl + WS_WOUT) + (size_t)l * D * D;
        const bf16* WguT = (const bf16*)(wsl + WS_WGU) + (size_t)l * NE * 2048 * D; const bf16* WdT = (const bf16*)(wsl + WS_WD) + (size_t)l * NE * D * DE;
        const int Gg = (l == 0 && G == 256) ? G - NCONV : G;
        if (bx >= Gg) { ConvArgs ca; ca.w_in = w_in; ca.w_out = w_out; ca.w_gate = w_gate; ca.w_up = w_up; ca.w_down = w_down; ca.norm_mix_g = norm_mix_g; ca.norm_ffn_g = norm_ffn_g; ca.na_norm_g = na_norm_g; ca.ws = wsl;
          convert_stream(ca, CI_IN + (bx - Gg) * NWAVES + wave, NCONV * NWAVES, DEPTH * CI_LAYER, (LAS float*)(lds + wave * CONV_SCR_BYTES), lane); }
        else {
        REP2 { pg8::Gemm g{XB, WinT, MTOK, NPROJ16, D, 0}; pg8::StaticOrder S; S.init(MTOK, NPROJ16, Gg, bx); pg8::EpiRowScaleBf16 E{P, RSTD, nullptr, NPROJ, 0, 1.0f, 0};
          pg8::gemm_phase<pg8::EpiRowScaleBf16, pg8::StaticOrder, true, true>(lds, g, S, E); }
        { pg8::Gemm g{(const bf16*)(wsl + WS_XB8), (const bf16*)(wsl + WS_WIN + ((size_t)l * NPROJ + NPROJ16) * D * 2), MTOK, NPROJ - NPROJ16, D / 2, 0}; pg8::StaticOrder S; S.init(MTOK, NPROJ - NPROJ16, Gg, bx);
          pg8::EpiRowScaleBf16 E{P + NPROJ16, RSTD, nullptr, NPROJ, 0, 1.0f / W8_SCALE, 0};
          pg8::gemm_phase<pg8::EpiRowScaleBf16, pg8::StaticOrder, true, true, true>(lds, g, S, E); }
        }
        GRID_BAR();
        REP4 for (int u = vcu; u < 512; u += G) na_unit(u, P, na_rpb + (size_t)l * 8 * 15 * 31, MIX, (float*)(wsl + WS_SSQ), lds, tid, wave);
        { bf16* UC = (bf16*)(wsl + WS_UC); float* NU = (float*)(wsl + WS_NU); float* SC = (float*)(wsl + WS_SC); const float* cwl = conv_w + (size_t)l * 5 * 1024; const float* cbl = conv_b + l * 1024;
          int tidl = tid; asm volatile("" : "+v"(tidl));
          REP5 for (int u = bx; u < 512; u += G) mlstm_m1_unit(u, cwl, cbl, P, GATES, UC, NU, SC, lds, tidl, wave);
          GRID_BAR();
          mlstm_m2(UC, NU, SC, vcu * 512 + tidl, G * 512);
          { const float* ssq = (const float*)(wsl + WS_SSQ); float* rsna = (float*)(wsl + WS_RSNA);
            for (int t = vcu * 512 + tidl; t < MTOK; t += G * 512) { const f32x4 s0 = *(const f32x4*)(ssq + (size_t)t * 8), s1 = *(const f32x4*)(ssq + (size_t)t * 8 + 4);
                rsna[t] = 1.0f / sqrtf(((s0[0] + s0[1]) + (s0[2] + s0[3]) + (s1[0] + s1[1]) + (s1[2] + s1[3])) * (1.0f / 1024.0f) + EPS); } }
          GRID_BAR();
          REP7 for (int u = bx; u < 512; u += G) mlstm_m3_unit(u, cwl, cbl, P, GATES, UC, NU, SC, ml_norm_g + l * 1024, (const float*)(wsl + WS_RSNA), MIX, lds, tidl, wave); }
        GRID_BAR();
#if (REP_MASK >> 8) & 1
        for (int rep_ = 0; rep_ < 2; ++rep_)
#endif
        { pg8::Gemm g{MIX, WoutT, MTOK, D, D, 0}; pg8::StaticOrder S; S.init(MTOK, D, G, bx); pg8::EpiResidBf16 E{XB, (const float*)(wsl + WS_RSNA), D, 0};
#if (REP_MASK >> 8) & 1
          if (rep_ == 0) E.XB = P;
#endif
          pg8::gemm_phase<pg8::EpiResidBf16, pg8::StaticOrder, true, true>(lds, g, S, E); }
        GRID_BAR();
        REP9 { RowArgs a; a.src32 = nullptr; a.srcb = XB; a.sel = nullptr; a.Y = nullptr; a.XB = XB; a.XB8 = wsl + WS_XB8; a.RSTD = RSTD; a.g = norm_ffn_g + l * D; a.W16F = (const bf16*)(wsl + WS_W16F_OFF) + (size_t)(2 * l + 1) * 32768; a.bias = b_gates; a.GATES = GATES; a.AFF = AFF; a.out = X; a.mode = 1; a.wrxb = 0;
          for (int grp = gw; grp < MTOK / 8; grp += ngw) rowpass_group<false>(a, grp, lane); }
        GRID_BAR();
        REP10 for (int be = bx; be < BATCH * NE; be += G) topk_unit(be, AFF, TOK, GATEV, SEL, (LAS int*)lds);
        GRID_BAR();
        REP12 { pg8::Gemm g{(const bf16*)(wsl + WS_XB8), (const bf16*)(wsl + WS_WGU + (size_t)l * NE * 2048 * D), MR, 2048, D / 2, 0}; pg8::GroupedGatherOrder S{TOK, G, bx};
          pg8::EpiSwiGLU8 E{(unsigned char*)ACT, RSTD, TOK, DE, 8, 1.0f / W8_SCALE, 0};
          pg8::gemm_phase_gather<pg8::EpiSwiGLU8, pg8::GroupedGatherOrder, true, true, true>(lds, g, S, E); }
        GRID_BAR();
        REP13 { pg8::Gemm g{ACT, (const bf16*)(wsl + WS_WD + (size_t)l * NE * D * DE), MR, 2048, DE / 2, 0}; pg8::GroupedOrder S{nullptr, G, bx}; pg8::EpiRowScaleF8 E{(unsigned char*)Y, GATEV, D, 8, Y8_SCALE / W8_SCALE, 0};
          pg8::gemm_phase<pg8::EpiRowScaleF8, pg8::GroupedOrder, true, true, true>(lds, g, S, E); }
        GRID_BAR();
        { RowArgs a; a.src32 = nullptr; a.srcb = XB; a.sel = SEL; a.Y = (const unsigned char*)Y; a.XB = XB; a.XB8 = wsl + WS_XB8; a.RSTD = RSTD; a.bias = b_gates + (l + 1 < DEPTH ? (l + 1) * 16 : 0); a.GATES = GATES; a.AFF = AFF; a.out = X; a.wrxb = 1;
          a.W16F = (const bf16*)(wsl + WS_W16F_OFF) + (size_t)(2 * (l + 1 < DEPTH ? l + 1 : 0)) * 32768;
          if (l + 1 < DEPTH) { a.g = norm_mix_g + (l + 1) * D; a.mode = 0; }
          else { a.g = final_norm_g; a.mode = 2; }
          for (int grp = gw; grp < MTOK / 8; grp += ngw) rowpass_group<false>(a, grp, lane); }
        if (l + 1 < DEPTH) GRID_BAR();
    }
#undef GRID_BAR
#undef WSPTRS
}

extern "C" void kernel_launch(void* const* d_in, const int* in_sizes, int n_in, void* d_out, int out_size, void* d_ws, size_t ws_size, hipStream_t stream) {
    static int grid = 0;
    if (grid == 0) {
        if (n_in != 16 || ws_size < WS_END) { fprintf(stderr, "kernel_launch: unexpected n_in %d or ws_size %zu\n", n_in, ws_size); grid = -1; return; }
        int dev = 0, cus = 0, per_cu = 0;
        if (hipGetDevice(&dev) != hipSuccess || hipDeviceGetAttribute(&cus, hipDeviceAttributeMultiprocessorCount, dev) != hipSuccess) { grid = -1; return; }
        if (hipFuncSetAttribute((const void*)mk_fwd, hipFuncAttributeMaxDynamicSharedMemorySize, LDS_BYTES) != hipSuccess) { fprintf(stderr, "kernel_launch: hipFuncSetAttribute failed\n"); grid = -1; return; }
        if (hipOccupancyMaxActiveBlocksPerMultiprocessor(&per_cu, (const void*)mk_fwd, NWAVES * 64, LDS_BYTES) != hipSuccess || per_cu < 1) fprintf(stderr, "kernel_launch: occupancy query reports %d blocks per CU\n", per_cu);
        (void)hipGetLastError();
        grid = cus;
    }
    if (grid < 0) return;
    if (hipMemsetAsync((char*)d_ws + WS_CTL, 0, CTL_ZERO_BYTES, stream) != hipSuccess) return;
    MKArgs a; memset(&a, 0, sizeof(a));
    for (int i = 0; i < 16; ++i) a.in[i] = (const float*)d_in[i];
    a.out = (float*)d_out; a.ws = (unsigned char*)d_ws;
    hipLaunchKernelGGL(mk_fwd, dim3(grid), dim3(NWAVES * 64), LDS_BYTES, stream, a);
}
```

```cpp
#include <hip/hip_runtime.h>
#include <stdint.h>
#include <stdio.h>
#include <string.h>

namespace pg8 {
#define PG8_LAS __attribute__((address_space(3)))
typedef unsigned short bf16_t;
typedef short bf16x8 __attribute__((ext_vector_type(8)));
typedef float f32x4 __attribute__((ext_vector_type(4)));
typedef unsigned u32x4 __attribute__((ext_vector_type(4)));
typedef int v4i32 __attribute__((ext_vector_type(4)));
typedef int v8i32 __attribute__((ext_vector_type(8)));
constexpr int BM = 256, BK = 64, HALF = 128, HTB = HALF * BK * 2  , STAGE_BYTES = 8 * HTB, NXCD = 8, WGM = 8;

__host__ __device__ __forceinline__ int lds_byte(int r, int c) { const int st = (r >> 4) * 2 + (c >> 5), rr = r & 15, cc = c & 31, ob = rr * 64 + cc * 2; return st * 1024 + (ob ^ (((ob >> 9) & 1) << 5)); }
__host__ __device__ __forceinline__ void stage_rc(int b, int& R, int& C) { const int st = b / 1024, sb = b % 1024, swz = sb ^ (((sb >> 9) & 1) << 5); R = (st >> 1) * 16 + swz / 64; C = (st & 1) * 32 + (swz % 64) / 2; }
__host__ __device__ __forceinline__ int perm32(int rho) { const int n = rho >> 4, i = rho & 15; return 8 * (i >> 2) + 4 * n + (i & 3); }

struct Unit { int pm, pn; };
struct Gemm { const bf16_t* A; const bf16_t* Bt; int M, N, K, pad; };

struct StaticOrder {
    static constexpr bool GATHER = false;
    int nM, nN, nwg, G, c, pad;
    __host__ __device__ void init(int M, int N, int G_, int c_) { nM = M / BM; nN = N / BM; nwg = nM * nN; G = G_; c = c_; pad = 0; }
    __host__ __device__ bool next(int i, Unit& u) const {
        const long L = (long)i * G + c; if (L >= nwg) return false;
        int wgid = (int)L; { const int q = nwg / NXCD, r = nwg % NXCD, xcd = wgid % NXCD, off = wgid / NXCD; wgid = (xcd < r ? xcd * (q + 1) : r * (q + 1) + (xcd - r) * q) + off; }
        const int nig = WGM * nN, gid = wgid / nig, fm = gid * WGM, gsz = (nM - fm) < WGM ? (nM - fm) : WGM;
        u.pm = fm + ((wgid % nig) % gsz); u.pn = (wgid % nig) / gsz; return true;
    }
    __device__ __forceinline__ void a_ready(const Unit&) const {}
    __device__ __forceinline__ void done(const Unit&) const {}
};


__device__ __forceinline__ unsigned cvt_pk_bf16(float lo, float hi) { unsigned r; asm volatile("v_cvt_pk_bf16_f32 %0, %1, %2" : "=v"(r) : "v"(lo), "v"(hi)); return r; }
typedef unsigned u32x2 __attribute__((ext_vector_type(2)));

struct EpiRowScaleBf16 {
    static constexpr bool PERM = true, AFTER_DRAIN = false;
    bf16_t* O; const float* rowscale; const int* rowmap; int ldc; int pn_mod; float mul; int pad;
    __device__ __forceinline__ void pre(const Unit& u, int wr, int fr, float (&rs)[8]) const {
#pragma unroll
        for (int i = 0; i < 8; ++i) { const int row = u.pm * BM + wr * 64 + fr + (i >> 2) * HALF + (i & 3) * 16; rs[i] = rowscale ? rowscale[rowmap ? rowmap[row] : row] : 1.0f; } }
    __device__ __forceinline__ void operator()(const f32x4 (&acc)[2][2][4][2], const Unit& u, int wr, int wc, int fr, int fq, const float (&rs)[8]) const {
        const int row0 = u.pm * BM + wr * 64 + fr; const int pnl = pn_mod ? (u.pn % pn_mod) : u.pn;
        const int col0 = pnl * BM + wc * 32 + 8 * fq;
#pragma unroll
        for (int ai = 0; ai < 2; ++ai)
#pragma unroll
            for (int m = 0; m < 4; ++m) { const int row = row0 + ai * HALF + m * 16; const float sc = rs[4 * ai + m] * mul;
                bf16_t* rowp = O + (size_t)row * ldc + col0;
#pragma unroll
                for (int bj = 0; bj < 2; ++bj) { const f32x4 v0 = acc[ai][bj][m][0] * sc, v1 = acc[ai][bj][m][1] * sc;
                    u32x4 w; w.x = cvt_pk_bf16(v0[0], v0[1]); w.y = cvt_pk_bf16(v0[2], v0[3]); w.z = cvt_pk_bf16(v1[0], v1[1]); w.w = cvt_pk_bf16(v1[2], v1[3]);
                    *(u32x4*)(rowp + bj * HALF) = w; } }
    }
};
__device__ __forceinline__ unsigned pk4_fp8(float a, float b, float c, float d) { int p = __builtin_amdgcn_cvt_pk_fp8_f32(a, b, 0, false); p = __builtin_amdgcn_cvt_pk_fp8_f32(c, d, p, true); return (unsigned)p; }
struct EpiSwiGLU8 {
    static constexpr bool PERM = false, AFTER_DRAIN = false;
    unsigned char* O; const float* rowscale; const int* rowmap; int ldc; int pn_mod; float mul; int pad;
    __device__ __forceinline__ void pre(const Unit& u, int wr, int fr, float (&rs)[8]) const {
#pragma unroll
        for (int i = 0; i < 8; ++i) { const int row = u.pm * BM + wr * 64 + fr + (i >> 2) * HALF + (i & 3) * 16; rs[i] = rowscale[rowmap[row]]; } }
    __device__ __forceinline__ void operator()(const f32x4 (&acc)[2][2][4][2], const Unit& u, int wr, int wc, int fr, int fq, const float (&rs)[8]) const {
        const int row0 = u.pm * BM + wr * 64 + fr; const int pnl = u.pn % pn_mod;
        const int col0 = pnl * 128 + wc * 16 + 4 * fq;
#pragma unroll
        for (int ai = 0; ai < 2; ++ai)
#pragma unroll
            for (int m = 0; m < 4; ++m) { const int row = row0 + ai * HALF + m * 16; const float sc = rs[4 * ai + m] * mul;
                unsigned char* rowp = O + (size_t)row * ldc + col0;
#pragma unroll
                for (int bj = 0; bj < 2; ++bj) { const f32x4 a = acc[ai][bj][m][0] * sc, up = acc[ai][bj][m][1] * sc; f32x4 r;
#pragma unroll
                    for (int j = 0; j < 4; ++j) r[j] = a[j] * up[j] * __builtin_amdgcn_rcpf(1.0f + __builtin_amdgcn_exp2f(-1.4426950408889634f * a[j]));
                    *(unsigned*)(rowp + bj * 64) = pk4_fp8(r[0], r[1], r[2], r[3]); } }
    }
};

struct EpiRowScaleF8 {
    static constexpr bool PERM = true, AFTER_DRAIN = false;
    unsigned char* O; const float* rowscale; int ldc; int pn_mod; float mul; int pad;
    __device__ __forceinline__ void pre(const Unit& u, int wr, int fr, float (&rs)[8]) const {
#pragma unroll
        for (int i = 0; i < 8; ++i) rs[i] = rowscale[u.pm * BM + wr * 64 + fr + (i >> 2) * HALF + (i & 3) * 16]; }
    __device__ __forceinline__ void operator()(const f32x4 (&acc)[2][2][4][2], const Unit& u, int wr, int wc, int fr, int fq, const float (&rs)[8]) const {
        const int row0 = u.pm * BM + wr * 64 + fr; const int pnl = pn_mod ? (u.pn % pn_mod) : u.pn;
        const int col0 = pnl * BM + wc * 32 + 8 * fq;
#pragma unroll
        for (int ai = 0; ai < 2; ++ai)
#pragma unroll
            for (int m = 0; m < 4; ++m) { const int row = row0 + ai * HALF + m * 16; const float sc = rs[4 * ai + m] * mul;
                unsigned char* rowp = O + (size_t)row * ldc + col0;
#pragma unroll
                for (int bj = 0; bj < 2; ++bj) { const f32x4 v0 = acc[ai][bj][m][0] * sc, v1 = acc[ai][bj][m][1] * sc;
                    u32x2 w; w.x = pk4_fp8(v0[0], v0[1], v0[2], v0[3]); w.y = pk4_fp8(v1[0], v1[1], v1[2], v1[3]);
                    *(u32x2*)(rowp + bj * HALF) = w; } }
    }
};

struct EpiResidBf16 {
    static constexpr bool PERM = true, AFTER_DRAIN = false;
    bf16_t* XB; const float* rowscale; int ldc; int pad;
    __device__ __forceinline__ void pre(const Unit& u, int wr, int fr, float (&rs)[8]) const {
#pragma unroll
        for (int i = 0; i < 8; ++i) rs[i] = rowscale[u.pm * BM + wr * 64 + fr + (i >> 2) * HALF + (i & 3) * 16]; }
    __device__ __forceinline__ void operator()(const f32x4 (&acc)[2][2][4][2], const Unit& u, int wr, int wc, int fr, int fq, const float (&rs)[8]) const {
        const int row0 = u.pm * BM + wr * 64 + fr, col0 = u.pn * BM + wc * 32 + 8 * fq;
#pragma unroll
        for (int ai = 0; ai < 2; ++ai)
#pragma unroll
            for (int m = 0; m < 4; ++m) { const int row = row0 + ai * HALF + m * 16; const float sc = rs[4 * ai + m]; bf16_t* rowp = XB + (size_t)row * ldc + col0;
#pragma unroll
                for (int bj = 0; bj < 2; ++bj) { const u32x4 x = *(const u32x4*)(rowp + bj * HALF); const f32x4 v0 = acc[ai][bj][m][0] * sc, v1 = acc[ai][bj][m][1] * sc;
                    u32x4 w; w.x = cvt_pk_bf16(__uint_as_float(x.x << 16) + v0[0], __uint_as_float(x.x & 0xffff0000u) + v0[1]); w.y = cvt_pk_bf16(__uint_as_float(x.y << 16) + v0[2], __uint_as_float(x.y & 0xffff0000u) + v0[3]);
                    w.z = cvt_pk_bf16(__uint_as_float(x.z << 16) + v1[0], __uint_as_float(x.z & 0xffff0000u) + v1[1]); w.w = cvt_pk_bf16(__uint_as_float(x.w << 16) + v1[2], __uint_as_float(x.w & 0xffff0000u) + v1[3]);
                    *(u32x4*)(rowp + bj * HALF) = w; } }
    }
};
template <bool GATHER_> struct GroupedOrderT {
    static constexpr bool GATHER = GATHER_;
    const int* rowmap; int G, c;
    __device__ __forceinline__ bool next(int i, Unit& u) const {
        const int L = i * G + c; if (L >= 1024) return false;
        const int e = L >> 6, w = L & 63; u.pm = e * 8 + (w & 7); u.pn = e * 8 + (w >> 3); return true;
    }
    __device__ __forceinline__ void a_ready(const Unit&) const {}
    __device__ __forceinline__ void done(const Unit&) const {}
};
typedef GroupedOrderT<false> GroupedOrder; typedef GroupedOrderT<true> GroupedGatherOrder;
template <class Epi, class Sched, bool ALIGN_EPI = false, bool SP2 = false, bool F8 = false>
__device__ __forceinline__ void gemm_phase(PG8_LAS unsigned char* lds, const Gemm g, const Sched& S, const Epi& E) {
    int tid_ = threadIdx.x; asm volatile("" : "+v"(tid_));
    const int tid = tid_, wid = __builtin_amdgcn_readfirstlane(tid >> 6), lane = tid & 63, wr = wid >> 2, wc = wid & 3, fr = lane & 15, fq = lane >> 4;
    const int K = g.K, nt = K / BK;
    unsigned voffA[2], voffB[2];
#pragma unroll
    for (int i = 0; i < 2; ++i) { int R, C; stage_rc(tid * 16 + i * 8192, R, C); const int Rb = Epi::PERM ? ((R & ~31) + perm32(R & 31)) : R;
        voffA[i] = (unsigned)(R * K + C) * 2u; voffB[i] = (unsigned)(Rb * K + C) * 2u; }
    const size_t kstep = (size_t)(BK * 2);
    const size_t hstep = (size_t)HALF * K * 2;
    const size_t tstep = 2 * hstep;
    const unsigned ldsw = (unsigned)wid * 1024u;
    const int aoff = lds_byte(wr * 64 + fr, fq * 8), boff = lds_byte(wc * 32 + fr, fq * 8);
#define PG8_SA(b, h) (((b) * 2 + (h)) * HTB)
#define PG8_SB(b, h) ((4 + (b) * 2 + (h)) * HTB)
#define PG8_STAGE(bufoff, gbase, voff) do { _Pragma("unroll") for (int _i = 0; _i < 2; ++_i) \
        __builtin_amdgcn_global_load_lds((const unsigned*)((const char*)(gbase) + (voff)[_i]), (PG8_LAS unsigned*)(lds + (bufoff) + ldsw + _i * 8192), 16, 0, 0); } while (0)
#define PG8_LDA(dst, b, h) do { if constexpr (F8) { _Pragma("unroll") for (int m = 0; m < 4; ++m) dst##8[m] = __builtin_shufflevector(*(const PG8_LAS v4i32*)(lds + PG8_SA(b, h) + aoff + m * 2048), *(const PG8_LAS v4i32*)(lds + PG8_SA(b, h) + aoff + m * 2048 + 1024), 0, 1, 2, 3, 4, 5, 6, 7); } \
    else { _Pragma("unroll") for (int m = 0; m < 4; ++m) _Pragma("unroll") for (int k = 0; k < 2; ++k) dst[m][k] = *(const PG8_LAS bf16x8*)(lds + PG8_SA(b, h) + aoff + m * 2048 + k * 1024); } } while (0)
#define PG8_LDB(dst, b, h) do { if constexpr (F8) { _Pragma("unroll") for (int n = 0; n < 2; ++n) dst##8[n] = __builtin_shufflevector(*(const PG8_LAS v4i32*)(lds + PG8_SB(b, h) + boff + n * 2048), *(const PG8_LAS v4i32*)(lds + PG8_SB(b, h) + boff + n * 2048 + 1024), 0, 1, 2, 3, 4, 5, 6, 7); } \
    else { _Pragma("unroll") for (int n = 0; n < 2; ++n) _Pragma("unroll") for (int k = 0; k < 2; ++k) dst[n][k] = *(const PG8_LAS bf16x8*)(lds + PG8_SB(b, h) + boff + n * 2048 + k * 1024); } } while (0)
#define PG8_MMA(ai, bj, At, Bt) do { __builtin_amdgcn_s_setprio(1); _Pragma("unroll") for (int m = 0; m < 4; ++m) _Pragma("unroll") for (int n = 0; n < 2; ++n) { \
        if constexpr (F8) asm volatile("v_mfma_scale_f32_16x16x128_f8f6f4 %0, %1, %2, %0, %3, %3 op_sel_hi:[0,0,0]" : "+v"(acc[ai][bj][m][n]) : "v"(Bt##8[n]), "v"(At##8[m]), "v"(f8scale));   \
        else { _Pragma("unroll") for (int k = 0; k < 2; ++k) acc[ai][bj][m][n] = __builtin_amdgcn_mfma_f32_16x16x32_bf16(Bt[n][k], At[m][k], acc[ai][bj][m][n], 0, 0, 0); } } \
        __builtin_amdgcn_s_setprio(0); } while (0)
#define PG8_WAIT_V(n) asm volatile("s_waitcnt vmcnt(" #n ")" ::: "memory")
#define PG8_WAIT_L(n) asm volatile("s_waitcnt lgkmcnt(" #n ")" ::: "memory")
#define PG8_BAR __builtin_amdgcn_s_barrier()
#define PG8_SCHED __builtin_amdgcn_sched_barrier(0)
    Unit cur, nxt; int ui = 0;
    if (!S.next(0, cur)) return;
    f32x4 acc[2][2][4][2];
#pragma unroll
    for (int a = 0; a < 2; ++a)
#pragma unroll
        for (int b = 0; b < 2; ++b)
#pragma unroll
            for (int m = 0; m < 4; ++m)
#pragma unroll
                for (int n = 0; n < 2; ++n) acc[a][b][m][n] = (f32x4){0.f, 0.f, 0.f, 0.f};
    bf16x8 At[4][2], B0[2][2], B1[2][2]; v8i32 At8[4], B08[2], B18[2];
    const int f8scale = 0x7F7F7F7F; (void)f8scale;
    const char* cA = (const char*)g.A + (size_t)cur.pm * tstep; const char* cB = (const char*)g.Bt + (size_t)cur.pn * tstep;
    float rs[8];
    E.pre(cur, wr, fr, rs);
    S.a_ready(cur);
    if constexpr (SP2) {
        PG8_STAGE(PG8_SB(0, 0), cB, voffB); PG8_STAGE(PG8_SB(0, 1), cB + hstep, voffB); PG8_STAGE(PG8_SA(0, 0), cA, voffA); PG8_STAGE(PG8_SA(0, 1), cA + hstep, voffA);
        if (wr == 1) PG8_BAR;
        PG8_WAIT_V(2); PG8_BAR;
        PG8_STAGE(PG8_SB(1, 0), cB + kstep, voffB); PG8_STAGE(PG8_SA(1, 0), cA + kstep, voffA); PG8_STAGE(PG8_SB(1, 1), cB + hstep + kstep, voffB);
        PG8_WAIT_V(6); PG8_BAR;
    } else {
        PG8_STAGE(PG8_SB(0, 0), cB, voffB); PG8_STAGE(PG8_SA(0, 0), cA, voffA); PG8_STAGE(PG8_SB(0, 1), cB + hstep, voffB); PG8_STAGE(PG8_SA(0, 1), cA + hstep, voffA);
        if (wr == 1) PG8_BAR;
        PG8_WAIT_V(4); PG8_BAR;
        PG8_STAGE(PG8_SB(1, 0), cB + kstep, voffB); PG8_STAGE(PG8_SA(1, 0), cA + kstep, voffA); PG8_STAGE(PG8_SB(1, 1), cB + hstep + kstep, voffB);
        PG8_WAIT_V(6); PG8_BAR;
    }
    for (;;) {
        const bool has_next = S.next(ui + 1, nxt);
        const char* nA = has_next ? (const char*)g.A + (size_t)nxt.pm * tstep : cA; const char* nB = has_next ? (const char*)g.Bt + (size_t)nxt.pn * tstep : cB;
        for (int t = 0; t < nt; t += 2) {
            const bool last = (t == nt - 2);
            const char* a1 = cA + (size_t)(t + 1) * kstep;
            const char* a2 = last ? nA : cA + (size_t)(t + 2) * kstep; const char* b2 = last ? nB : cB + (size_t)(t + 2) * kstep;
            const char* a3 = a2 + kstep; const char* b3 = b2 + kstep;
            if (last && has_next) S.a_ready(nxt);
            if constexpr (SP2) {
            PG8_LDB(B0, 0, 0); PG8_LDB(B1, 0, 1); PG8_SCHED; PG8_LDA(At, 0, 0); PG8_STAGE(PG8_SA(1, 1), a1 + hstep, voffA);
            PG8_WAIT_V(8); PG8_WAIT_L(0); PG8_BAR; PG8_MMA(0, 0, At, B0); PG8_MMA(0, 1, At, B1); PG8_BAR; PG8_SCHED;
            PG8_LDA(At, 0, 1); PG8_STAGE(PG8_SB(0, 0), b2, voffB); PG8_STAGE(PG8_SB(0, 1), b2 + hstep, voffB); PG8_STAGE(PG8_SA(0, 0), a2, voffA);
            PG8_WAIT_V(8); PG8_WAIT_L(0); PG8_BAR; PG8_MMA(1, 0, At, B0); PG8_MMA(1, 1, At, B1); PG8_BAR; PG8_SCHED;
            PG8_LDB(B0, 1, 0); PG8_LDB(B1, 1, 1); PG8_SCHED; PG8_LDA(At, 1, 0); PG8_STAGE(PG8_SA(0, 1), a2 + hstep, voffA);
            PG8_WAIT_V(8); PG8_WAIT_L(0); PG8_BAR; PG8_MMA(0, 0, At, B0); PG8_MMA(0, 1, At, B1); PG8_BAR; PG8_SCHED;
            PG8_LDA(At, 1, 1); PG8_STAGE(PG8_SB(1, 0), b3, voffB); PG8_STAGE(PG8_SB(1, 1), b3 + hstep, voffB); PG8_STAGE(PG8_SA(1, 0), a3, voffA);
            PG8_WAIT_V(8); PG8_WAIT_L(0); PG8_BAR; PG8_MMA(1, 0, At, B0); PG8_MMA(1, 1, At, B1); PG8_BAR; PG8_SCHED;
            } else {
            PG8_LDB(B0, 0, 0); PG8_SCHED; PG8_LDA(At, 0, 0); PG8_STAGE(PG8_SA(1, 1), a1 + hstep, voffA);
            PG8_WAIT_L(8); PG8_BAR; PG8_WAIT_L(0); PG8_MMA(0, 0, At, B0); PG8_BAR; PG8_SCHED;
            PG8_LDB(B1, 0, 1); PG8_STAGE(PG8_SB(0, 0), b2, voffB);
            PG8_BAR; PG8_WAIT_L(0); PG8_MMA(0, 1, At, B1); PG8_BAR;
            PG8_LDA(At, 0, 1); PG8_STAGE(PG8_SA(0, 0), a2, voffA);
            PG8_BAR; PG8_WAIT_L(0); PG8_MMA(1, 0, At, B0); PG8_BAR; PG8_SCHED;
            PG8_STAGE(PG8_SB(0, 1), b2 + hstep, voffB);
            PG8_WAIT_V(6); PG8_BAR; PG8_MMA(1, 1, At, B1); PG8_BAR;
            PG8_LDB(B0, 1, 0); PG8_SCHED; PG8_LDA(At, 1, 0); PG8_STAGE(PG8_SA(0, 1), a2 + hstep, voffA);
            PG8_WAIT_L(8); PG8_BAR; PG8_WAIT_L(0); PG8_MMA(0, 0, At, B0); PG8_BAR; PG8_SCHED;
            PG8_LDB(B1, 1, 1); PG8_STAGE(PG8_SB(1, 0), b3, voffB);
            PG8_BAR; PG8_WAIT_L(0); PG8_MMA(0, 1, At, B1); PG8_BAR;
            PG8_LDA(At, 1, 1); PG8_STAGE(PG8_SA(1, 0), a3, voffA);
            PG8_BAR; PG8_WAIT_L(0); PG8_MMA(1, 0, At, B0); PG8_BAR; PG8_SCHED;
            PG8_STAGE(PG8_SB(1, 1), b3 + hstep, voffB);
            PG8_WAIT_V(6); PG8_BAR; PG8_MMA(1, 1, At, B1); PG8_BAR;
            }
        }
        if constexpr (F8) asm volatile("s_nop 15\n\ts_nop 15" ::: "memory");
        if constexpr (ALIGN_EPI) { if (wr == 0) PG8_BAR; }
        if constexpr (!Epi::AFTER_DRAIN) { E(acc, cur, wr, wc, fr, fq, rs); S.done(cur); }
        if (!has_next) break;
#pragma unroll
        for (int a = 0; a < 2; ++a)
#pragma unroll
            for (int b = 0; b < 2; ++b)
#pragma unroll
                for (int m = 0; m < 4; ++m)
#pragma unroll
                    for (int n = 0; n < 2; ++n) acc[a][b][m][n] = (f32x4){0.f, 0.f, 0.f, 0.f};
        cur = nxt; cA = nA; cB = nB; ++ui;
        E.pre(cur, wr, fr, rs);
        if constexpr (ALIGN_EPI) { if (wr == 1) PG8_BAR; }
    }
    PG8_WAIT_V(0);
    if constexpr (!ALIGN_EPI) { if (wr == 0) PG8_BAR; }
    PG8_BAR;
    if constexpr (Epi::AFTER_DRAIN) { E.fused(acc, cur, wr, wc, fr, fq, lds, wid, lane); S.done(cur); }
#undef PG8_SA
#undef PG8_SB
#undef PG8_STAGE
#undef PG8_LDA
#undef PG8_LDB
#undef PG8_MMA
#undef PG8_WAIT_V
#undef PG8_WAIT_L
#undef PG8_BAR
#undef PG8_SCHED
}

template <class Epi, class Sched, bool ALIGN_EPI = false, bool SP2 = false, bool F8 = false>
__device__ __forceinline__ void gemm_phase_gather(PG8_LAS unsigned char* lds, const Gemm g, const Sched& S, const Epi& E) {
    int tid_ = threadIdx.x; asm volatile("" : "+v"(tid_));
    const int tid = tid_, wid = __builtin_amdgcn_readfirstlane(tid >> 6), lane = tid & 63, wr = wid >> 2, wc = wid & 3, fr = lane & 15, fq = lane >> 4;
    static_assert(SP2 || !Sched::GATHER, "gathered A rows: SP2 loop only");
    const int K = g.K, nt = K / BK;
    unsigned voffA[2], voffB[2];
#pragma unroll
    for (int i = 0; i < 2; ++i) { int R, C; stage_rc(tid * 16 + i * 8192, R, C); const int Rb = Epi::PERM ? ((R & ~31) + perm32(R & 31)) : R;
        voffA[i] = (unsigned)(R * K + C) * 2u; voffB[i] = (unsigned)(Rb * K + C) * 2u; }
    constexpr bool GATHER = Sched::GATHER;
    int RA[2], CA[2];
#pragma unroll
    for (int i = 0; i < 2; ++i) stage_rc(tid * 16 + i * 8192, RA[i], CA[i]);
    const size_t kstep = (size_t)(BK * 2);
    const size_t hstep = (size_t)HALF * K * 2;
    const size_t tstep = 2 * hstep;
    const unsigned ldsw = (unsigned)wid * 1024u;
    const int aoff = lds_byte(wr * 64 + fr, fq * 8), boff = lds_byte(wc * 32 + fr, fq * 8);
#define PG8_SA(b, h) (((b) * 2 + (h)) * HTB)
#define PG8_SB(b, h) ((4 + (b) * 2 + (h)) * HTB)
#define PG8_STAGE(bufoff, gbase, voff) do { _Pragma("unroll") for (int _i = 0; _i < 2; ++_i) \
        __builtin_amdgcn_global_load_lds((const unsigned*)((const char*)(gbase) + (voff)[_i]), (PG8_LAS unsigned*)(lds + (bufoff) + ldsw + _i * 8192), 16, 0, 0); } while (0)
#define PG8_LDA(dst, b, h) do { if constexpr (F8) { _Pragma("unroll") for (int m = 0; m < 4; ++m) dst##8[m] = __builtin_shufflevector(*(const PG8_LAS v4i32*)(lds + PG8_SA(b, h) + aoff + m * 2048), *(const PG8_LAS v4i32*)(lds + PG8_SA(b, h) + aoff + m * 2048 + 1024), 0, 1, 2, 3, 4, 5, 6, 7); } \
    else { _Pragma("unroll") for (int m = 0; m < 4; ++m) _Pragma("unroll") for (int k = 0; k < 2; ++k) dst[m][k] = *(const PG8_LAS bf16x8*)(lds + PG8_SA(b, h) + aoff + m * 2048 + k * 1024); } } while (0)
#define PG8_LDB(dst, b, h) do { if constexpr (F8) { _Pragma("unroll") for (int n = 0; n < 2; ++n) dst##8[n] = __builtin_shufflevector(*(const PG8_LAS v4i32*)(lds + PG8_SB(b, h) + boff + n * 2048), *(const PG8_LAS v4i32*)(lds + PG8_SB(b, h) + boff + n * 2048 + 1024), 0, 1, 2, 3, 4, 5, 6, 7); } \
    else { _Pragma("unroll") for (int n = 0; n < 2; ++n) _Pragma("unroll") for (int k = 0; k < 2; ++k) dst[n][k] = *(const PG8_LAS bf16x8*)(lds + PG8_SB(b, h) + boff + n * 2048 + k * 1024); } } while (0)
#define PG8_MMA(ai, bj, At, Bt) do { __builtin_amdgcn_s_setprio(1); _Pragma("unroll") for (int m = 0; m < 4; ++m) _Pragma("unroll") for (int n = 0; n < 2; ++n) { \
        if constexpr (F8) asm volatile("v_mfma_scale_f32_16x16x128_f8f6f4 %0, %1, %2, %0, %3, %3 op_sel_hi:[0,0,0]" : "+v"(acc[ai][bj][m][n]) : "v"(Bt##8[n]), "v"(At##8[m]), "v"(f8scale));   \
        else { _Pragma("unroll") for (int k = 0; k < 2; ++k) acc[ai][bj][m][n] = __builtin_amdgcn_mfma_f32_16x16x32_bf16(Bt[n][k], At[m][k], acc[ai][bj][m][n], 0, 0, 0); } } \
        __builtin_amdgcn_s_setprio(0); } while (0)
#define PG8_WAIT_V(n) asm volatile("s_waitcnt vmcnt(" #n ")" ::: "memory")
#define PG8_WAIT_L(n) asm volatile("s_waitcnt lgkmcnt(" #n ")" ::: "memory")
#define PG8_BAR __builtin_amdgcn_s_barrier()
#define PG8_SCHED __builtin_amdgcn_sched_barrier(0)
    Unit cur, nxt; int ui = 0;
    if (!S.next(0, cur)) return;
    f32x4 acc[2][2][4][2];
#pragma unroll
    for (int a = 0; a < 2; ++a)
#pragma unroll
        for (int b = 0; b < 2; ++b)
#pragma unroll
            for (int m = 0; m < 4; ++m)
#pragma unroll
                for (int n = 0; n < 2; ++n) acc[a][b][m][n] = (f32x4){0.f, 0.f, 0.f, 0.f};
    bf16x8 At[4][2], B0[2][2], B1[2][2]; v8i32 At8[4], B08[2], B18[2];
    const int f8scale = 0x7F7F7F7F; (void)f8scale;
    const char* cA = GATHER ? (const char*)g.A : (const char*)g.A + (size_t)cur.pm * tstep; const char* cB = (const char*)g.Bt + (size_t)cur.pn * tstep;
    unsigned offC[2][2], offN[2][2];
#define PG8_SETOFF(o, u) do { _Pragma("unroll") for (int _h = 0; _h < 2; ++_h) _Pragma("unroll") for (int _i = 0; _i < 2; ++_i) { \
        if constexpr (GATHER) o[_h][_i] = (unsigned)S.rowmap[(u).pm * BM + _h * HALF + RA[_i]] * (unsigned)(K * 2) + (unsigned)(CA[_i] * 2); \
        else o[_h][_i] = voffA[_i] + (unsigned)(_h * (int)hstep); } } while (0)
    PG8_SETOFF(offC, cur);
#pragma unroll
    for (int _h = 0; _h < 2; ++_h) { offN[_h][0] = offC[_h][0]; offN[_h][1] = offC[_h][1]; }
    float rs[8];
    E.pre(cur, wr, fr, rs);
    S.a_ready(cur);
    if constexpr (SP2) {
        PG8_STAGE(PG8_SB(0, 0), cB, voffB); PG8_STAGE(PG8_SB(0, 1), cB + hstep, voffB); PG8_STAGE(PG8_SA(0, 0), cA, offC[0]); PG8_STAGE(PG8_SA(0, 1), cA, offC[1]);
        if (wr == 1) PG8_BAR;
        PG8_WAIT_V(2); PG8_BAR;
        PG8_STAGE(PG8_SB(1, 0), cB + kstep, voffB); PG8_STAGE(PG8_SA(1, 0), cA + kstep, offC[0]); PG8_STAGE(PG8_SB(1, 1), cB + hstep + kstep, voffB);
        PG8_WAIT_V(6); PG8_BAR;
    } else {
        PG8_STAGE(PG8_SB(0, 0), cB, voffB); PG8_STAGE(PG8_SA(0, 0), cA, voffA); PG8_STAGE(PG8_SB(0, 1), cB + hstep, voffB); PG8_STAGE(PG8_SA(0, 1), cA + hstep, voffA);
        if (wr == 1) PG8_BAR;
        PG8_WAIT_V(4); PG8_BAR;
        PG8_STAGE(PG8_SB(1, 0), cB + kstep, voffB); PG8_STAGE(PG8_SA(1, 0), cA + kstep, voffA); PG8_STAGE(PG8_SB(1, 1), cB + hstep + kstep, voffB);
        PG8_WAIT_V(6); PG8_BAR;
    }
    for (;;) {
        const bool has_next = S.next(ui + 1, nxt);
        const char* nA = GATHER ? cA : (has_next ? (const char*)g.A + (size_t)nxt.pm * tstep : cA); const char* nB = has_next ? (const char*)g.Bt + (size_t)nxt.pn * tstep : cB;
        if constexpr (GATHER) { if (has_next) PG8_SETOFF(offN, nxt); }
        for (int t = 0; t < nt; t += 2) {
            const bool last = (t == nt - 2);
            const char* a1 = cA + (size_t)(t + 1) * kstep;
            const char* a2 = last ? nA : cA + (size_t)(t + 2) * kstep; const char* b2 = last ? nB : cB + (size_t)(t + 2) * kstep;
            const char* a3 = a2 + kstep; const char* b3 = b2 + kstep;
            if (last && has_next) S.a_ready(nxt);
            unsigned o2[2][2];
#pragma unroll
            for (int _h = 0; _h < 2; ++_h)
#pragma unroll
                for (int _i = 0; _i < 2; ++_i) o2[_h][_i] = (GATHER && last) ? offN[_h][_i] : offC[_h][_i];
            if constexpr (SP2) {
            PG8_LDB(B0, 0, 0); PG8_LDB(B1, 0, 1); PG8_SCHED; PG8_LDA(At, 0, 0); PG8_STAGE(PG8_SA(1, 1), a1, offC[1]);
            PG8_WAIT_V(8); PG8_WAIT_L(0); PG8_BAR; PG8_MMA(0, 0, At, B0); PG8_MMA(0, 1, At, B1); PG8_BAR; PG8_SCHED;
            PG8_LDA(At, 0, 1); PG8_STAGE(PG8_SB(0, 0), b2, voffB); PG8_STAGE(PG8_SB(0, 1), b2 + hstep, voffB); PG8_STAGE(PG8_SA(0, 0), a2, o2[0]);
            PG8_WAIT_V(8); PG8_WAIT_L(0); PG8_BAR; PG8_MMA(1, 0, At, B0); PG8_MMA(1, 1, At, B1); PG8_BAR; PG8_SCHED;
            PG8_LDB(B0, 1, 0); PG8_LDB(B1, 1, 1); PG8_SCHED; PG8_LDA(At, 1, 0); PG8_STAGE(PG8_SA(0, 1), a2, o2[1]);
            PG8_WAIT_V(8); PG8_WAIT_L(0); PG8_BAR; PG8_MMA(0, 0, At, B0); PG8_MMA(0, 1, At, B1); PG8_BAR; PG8_SCHED;
            PG8_LDA(At, 1, 1); PG8_STAGE(PG8_SB(1, 0), b3, voffB); PG8_STAGE(PG8_SB(1, 1), b3 + hstep, voffB); PG8_STAGE(PG8_SA(1, 0), a3, o2[0]);
            PG8_WAIT_V(8); PG8_WAIT_L(0); PG8_BAR; PG8_MMA(1, 0, At, B0); PG8_MMA(1, 1, At, B1); PG8_BAR; PG8_SCHED;
            } else {
            PG8_LDB(B0, 0, 0); PG8_SCHED; PG8_LDA(At, 0, 0); PG8_STAGE(PG8_SA(1, 1), a1 + hstep, voffA);
            PG8_WAIT_L(8); PG8_BAR; PG8_WAIT_L(0); PG8_MMA(0, 0, At, B0); PG8_BAR; PG8_SCHED;
            PG8_LDB(B1, 0, 1); PG8_STAGE(PG8_SB(0, 0), b2, voffB);
            PG8_BAR; PG8_WAIT_L(0); PG8_MMA(0, 1, At, B1); PG8_BAR;
            PG8_LDA(At, 0, 1); PG8_STAGE(PG8_SA(0, 0), a2, voffA);
            PG8_BAR; PG8_WAIT_L(0); PG8_MMA(1, 0, At, B0); PG8_BAR; PG8_SCHED;
            PG8_STAGE(PG8_SB(0, 1), b2 + hstep, voffB);
            PG8_WAIT_V(6); PG8_BAR; PG8_MMA(1, 1, At, B1); PG8_BAR;
            PG8_LDB(B0, 1, 0); PG8_SCHED; PG8_LDA(At, 1, 0); PG8_STAGE(PG8_SA(0, 1), a2 + hstep, voffA);
            PG8_WAIT_L(8); PG8_BAR; PG8_WAIT_L(0); PG8_MMA(0, 0, At, B0); PG8_BAR; PG8_SCHED;
            PG8_LDB(B1, 1, 1); PG8_STAGE(PG8_SB(1, 0), b3, voffB);
            PG8_BAR; PG8_WAIT_L(0); PG8_MMA(0, 1, At, B1); PG8_BAR;
            PG8_LDA(At, 1, 1); PG8_STAGE(PG8_SA(1, 0), a3, voffA);
            PG8_BAR; PG8_WAIT_L(0); PG8_MMA(1, 0, At, B0); PG8_BAR; PG8_SCHED;
            PG8_STAGE(PG8_SB(1, 1), b3 + hstep, voffB);
            PG8_WAIT_V(6); PG8_BAR; PG8_MMA(1, 1, At, B1); PG8_BAR;
            }
        }
        if constexpr (F8) asm volatile("s_nop 15\n\ts_nop 15" ::: "memory");
        if constexpr (ALIGN_EPI) { if (wr == 0) PG8_BAR; }
        if constexpr (!Epi::AFTER_DRAIN) { E(acc, cur, wr, wc, fr, fq, rs); S.done(cur); }
        if (!has_next) break;
#pragma unroll
        for (int a = 0; a < 2; ++a)
#pragma unroll
            for (int b = 0; b < 2; ++b)
#pragma unroll
                for (int m = 0; m < 4; ++m)
#pragma unroll
                    for (int n = 0; n < 2; ++n) acc[a][b][m][n] = (f32x4){0.f, 0.f, 0.f, 0.f};
        cur = nxt; cA = nA; cB = nB; ++ui;
        E.pre(cur, wr, fr, rs);
#pragma unroll
        for (int _h = 0; _h < 2; ++_h) { offC[_h][0] = offN[_h][0]; offC[_h][1] = offN[_h][1]; }
        if constexpr (ALIGN_EPI) { if (wr == 1) PG8_BAR; }
    }
    PG8_WAIT_V(0);
    if constexpr (!ALIGN_EPI) { if (wr == 0) PG8_BAR; }
    PG8_BAR;
    if constexpr (Epi::AFTER_DRAIN) { E.fused(acc, cur, wr, wc, fr, fq, lds, wid, lane); S.done(cur); }
#undef PG8_SETOFF
#undef PG8_SA
#undef PG8_SB
#undef PG8_STAGE
#undef PG8_LDA
#undef PG8_LDB
#undef PG8_MMA
#undef PG8_WAIT_V
#undef PG8_WAIT_L
#undef PG8_BAR
#undef PG8_SCHED
}
}

constexpr int D = 2048, BATCH = 4, SEQ = 4096, MTOK = BATCH * SEQ, DEPTH = 2;
constexpr int NIN = 6160, NPROJ = 6144;
constexpr int C_NAQ = 0, C_NAK = 1024, C_NAV = 2048, C_MLQ = 3072, C_MLK = 3584, C_MLV = 4096, C_MLO = 5120, C_GATES = 6144;
constexpr int NE = 16, CAP = 512, DE = 1024, MR = NE * BATCH * CAP;
constexpr float EPS = 1e-6f;

typedef unsigned short bf16;
typedef float f32x4 __attribute__((ext_vector_type(4)));
typedef unsigned v4u __attribute__((ext_vector_type(4)));
typedef unsigned v2u __attribute__((ext_vector_type(2)));
#define LAS __attribute__((address_space(3)))
typedef short bf16x8v __attribute__((ext_vector_type(8)));
typedef short s16x4 __attribute__((ext_vector_type(4)));
constexpr size_t WS_XB8 = 968 * (size_t)(1u << 20);
constexpr size_t WS_SSQ = 6 * (size_t)(1u << 20) + 512 * 1024;
constexpr size_t WS_RSNA = 7 * (size_t)(1u << 20) + 64 * 1024;
constexpr size_t WS_W16F_OFF = 7 * (1u << 20) + 256 * 1024;

constexpr size_t MiB = 1u << 20;
constexpr size_t WS_CTL = 0;
constexpr size_t WS_RSTD = 1 * MiB;
constexpr size_t WS_GATES = 2 * MiB;
constexpr size_t WS_AFF = 3 * MiB;
constexpr size_t WS_TOK = 4 * MiB;
constexpr size_t WS_GATEV = 4 * MiB + 512 * 1024;
constexpr size_t WS_SEL = 5 * MiB;
constexpr size_t WS_WIN = 8 * MiB;
constexpr size_t WS_WOUT = 56 * MiB;
constexpr size_t WS_WGU = 72 * MiB;
constexpr size_t WS_WD = 328 * MiB;
constexpr size_t WS_XB = 456 * MiB;
constexpr size_t WS_MIX = 520 * MiB;
constexpr size_t WS_P = 584 * MiB;
constexpr size_t WS_NAO = 776 * MiB;
constexpr size_t WS_HF = 840 * MiB;
constexpr size_t WS_ACT = 712 * MiB;
constexpr size_t WS_Y = 776 * MiB;
constexpr size_t WS_END = 1000 * MiB;

__device__ __forceinline__ unsigned f2bf(float f) { unsigned u = __builtin_bit_cast(unsigned, f); return (u + 0x7fffu + ((u >> 16) & 1u)) >> 16; }
__device__ __forceinline__ unsigned pk2(float lo, float hi) { return f2bf(lo) | (f2bf(hi) << 16); }
__device__ __forceinline__ float bf2f(unsigned short b) { return __builtin_bit_cast(float, ((unsigned)b) << 16); }
__device__ __forceinline__ float bflo(unsigned w) { return __builtin_bit_cast(float, w << 16); }
__device__ __forceinline__ float bfhi(unsigned w) { return __builtin_bit_cast(float, w & 0xffff0000u); }
__device__ __forceinline__ float row_ror(float v, int n) { return n == 8 ? __uint_as_float(__builtin_amdgcn_update_dpp(0, __float_as_uint(v), 0x128, 0xf, 0xf, false)) : n == 4 ? __uint_as_float(__builtin_amdgcn_update_dpp(0, __float_as_uint(v), 0x124, 0xf, 0xf, false))
        : n == 2 ? __uint_as_float(__builtin_amdgcn_update_dpp(0, __float_as_uint(v), 0x122, 0xf, 0xf, false)) : __uint_as_float(__builtin_amdgcn_update_dpp(0, __float_as_uint(v), 0x121, 0xf, 0xf, false)); }
__device__ __forceinline__ float row16_sum(float v) { v += row_ror(v, 8); v += row_ror(v, 4); v += row_ror(v, 2); v += row_ror(v, 1); return v; }
__device__ __forceinline__ float row16_max(float v) { v = fmaxf(v, row_ror(v, 8)); v = fmaxf(v, row_ror(v, 4)); v = fmaxf(v, row_ror(v, 2)); v = fmaxf(v, row_ror(v, 1)); return v; }
__device__ __forceinline__ float rows4_sum(float v) {
    auto a = __builtin_amdgcn_permlane16_swap(__float_as_uint(v), __float_as_uint(v), false, false); v = __uint_as_float(a[0]) + __uint_as_float(a[1]);
    auto b = __builtin_amdgcn_permlane32_swap(__float_as_uint(v), __float_as_uint(v), false, false); return __uint_as_float(b[0]) + __uint_as_float(b[1]); }
__device__ __forceinline__ float rows4_max(float v) {
    auto a = __builtin_amdgcn_permlane16_swap(__float_as_uint(v), __float_as_uint(v), false, false); v = fmaxf(__uint_as_float(a[0]), __uint_as_float(a[1]));
    auto b = __builtin_amdgcn_permlane32_swap(__float_as_uint(v), __float_as_uint(v), false, false); return fmaxf(__uint_as_float(b[0]), __uint_as_float(b[1])); }
__device__ __forceinline__ float wave_sum(float v) { return rows4_sum(row16_sum(v)); }
__device__ __forceinline__ float wave_max(float v) { return rows4_max(row16_max(v)); }

struct ConvItem { const float* W; const float* gk; bf16* WT; int ldw, K, k0, n0, dmode, f8; float wmul; };
__device__ __forceinline__ void ti_load(const ConvItem& d, int lane, f32x4 (&wv)[16]) {
    const int r4 = lane >> 4, c4 = (lane & 15) * 4;
#pragma unroll
    for (int i = 0; i < 16; ++i) wv[i] = *(const f32x4*)(d.W + (size_t)(d.k0 + 4 * i + r4) * d.ldw + d.n0 + c4);
}
__device__ __forceinline__ void ti_finish(const ConvItem& d, int lane, const f32x4 (&wv)[16], LAS float* scr) {
    const int r4 = lane >> 4, c4 = (lane & 15) * 4;
#pragma unroll
    for (int i = 0; i < 16; ++i) { const int kk = 4 * i + r4; const float gg = d.gk ? d.gk[d.k0 + kk] : 1.0f; LAS float* p = scr + kk * 65 + c4; p[0] = wv[i][0] * gg; p[1] = wv[i][1] * gg; p[2] = wv[i][2] * gg; p[3] = wv[i][3] * gg; }
    asm volatile("s_waitcnt lgkmcnt(0)" ::: "memory");
    const int c = lane & 7; const float wmul = d.wmul;
#pragma unroll
    for (int j = 0; j < 8; ++j) { const int n = (lane >> 3) + 8 * j; const LAS float* s = scr + (8 * c) * 65 + n;
        const int ng = d.n0 + n; const int drow = d.dmode == 0 ? ng : ((ng >> 4) * 32 + (ng & 15) + (d.dmode == 2 ? 16 : 0));
        if (d.f8) { v2u o8; int p = __builtin_amdgcn_cvt_pk_fp8_f32(s[0 * 65] * wmul, s[1 * 65] * wmul, 0, false); p = __builtin_amdgcn_cvt_pk_fp8_f32(s[2 * 65] * wmul, s[3 * 65] * wmul, p, true); o8.x = (unsigned)p;
            p = __builtin_amdgcn_cvt_pk_fp8_f32(s[4 * 65] * wmul, s[5 * 65] * wmul, 0, false); p = __builtin_amdgcn_cvt_pk_fp8_f32(s[6 * 65] * wmul, s[7 * 65] * wmul, p, true); o8.y = (unsigned)p;
            *(v2u*)((unsigned char*)d.WT + (size_t)drow * d.K + d.k0 + 8 * c) = o8; }
        else { v4u o; o.x = pk2(s[0 * 65], s[1 * 65]); o.y = pk2(s[2 * 65], s[3 * 65]); o.z = pk2(s[4 * 65], s[5 * 65]); o.w = pk2(s[6 * 65], s[7 * 65]);
            *(v4u*)(d.WT + (size_t)drow * d.K + d.k0 + 8 * c) = o; } }
    asm volatile("s_waitcnt lgkmcnt(0)" ::: "memory");
}
constexpr int CONV_SCR_BYTES = 64 * 65 * 4;
constexpr float Y8_SCALE = 16.0f;
typedef float f32x2 __attribute__((ext_vector_type(2)));
constexpr int NPROJ16 = 5120;
constexpr float W8_SCALE = 64.0f;
struct ConvArgs { const float *w_in, *w_out, *w_gate, *w_up, *w_down, *norm_mix_g, *norm_ffn_g, *na_norm_g; unsigned char* ws; };
constexpr int CI_IN = 32 * 96, CI_OUT = 32 * 32, CI_G = 16 * 32 * 16, CI_D = 16 * 16 * 32, CI_LAYER = CI_IN + CI_OUT + 2 * CI_G + CI_D;
__device__ __forceinline__ ConvItem convert_decode(const ConvArgs& a, int it) {
    ConvItem d; d.f8 = 0; d.wmul = 1.0f; d.gk = nullptr; d.dmode = 0; d.K = D;
    const int l = it / CI_LAYER; int r = it % CI_LAYER;
    if (r < CI_IN) { const int kb = r / 96, nb = r % 96; d.ldw = NIN; d.gk = a.norm_mix_g + l * D; d.k0 = 64 * kb;
        if (64 * nb < NPROJ16) { d.W = a.w_in + (size_t)l * D * NIN; d.WT = (bf16*)(a.ws + WS_WIN) + (size_t)l * NPROJ * D; d.n0 = 64 * nb; }
        else { d.W = a.w_in + (size_t)l * D * NIN + NPROJ16; d.WT = (bf16*)(a.ws + WS_WIN + ((size_t)l * NPROJ + NPROJ16) * D * 2); d.n0 = 64 * nb - NPROJ16; d.f8 = 1; d.wmul = W8_SCALE; }
        return d; }
    r -= CI_IN;
    if (r < CI_OUT) { const int kb = r / 32, nb = r % 32; d.W = a.w_out + (size_t)l * D * D; d.ldw = D; if (64 * kb < 1024) d.gk = a.na_norm_g + l * 1024;
        d.WT = (bf16*)(a.ws + WS_WOUT) + (size_t)l * D * D; d.k0 = 64 * kb; d.n0 = 64 * nb; return d; }
    r -= CI_OUT;
    if (r < 2 * CI_G) { const int up = r >= CI_G; if (up) r -= CI_G; const int e = r / 512, q = r % 512, kb = q / 16, nb = q % 16;
        d.W = (up ? a.w_up : a.w_gate) + ((size_t)l * NE + e) * D * DE; d.ldw = DE; d.gk = a.norm_ffn_g + l * D; d.WT = (bf16*)(a.ws + WS_WGU + ((size_t)l * NE + e) * 2048 * D); d.k0 = 64 * kb; d.n0 = 64 * nb; d.dmode = up ? 2 : 1; d.f8 = 1; d.wmul = W8_SCALE; return d; }
    r -= 2 * CI_G;
    { const int e = r / 512, q = r % 512, kb = q / 32, nb = q % 32; d.W = a.w_down + ((size_t)l * NE + e) * DE * D; d.ldw = D; d.WT = (bf16*)(a.ws + WS_WD + ((size_t)l * NE + e) * D * DE); d.K = DE; d.k0 = 64 * kb; d.n0 = 64 * nb; d.f8 = 1; d.wmul = W8_SCALE; return d; }
}
__device__ __forceinline__ void convert_stream(const ConvArgs& a, int first, int stride, int end, LAS float* scr, int lane) {
    if (first >= end) return;
    f32x4 w0[16], w1[16]; ConvItem d0 = convert_decode(a, first), d1 = d0; ti_load(d0, lane, w0);
    if (first + stride < end) { d1 = convert_decode(a, first + stride); ti_load(d1, lane, w1); }
#pragma unroll 1
    for (int it = first; it < end; it += 2 * stride) {
        ti_finish(d0, lane, w0, scr);
        if (it + 2 * stride < end) { d0 = convert_decode(a, it + 2 * stride); ti_load(d0, lane, w0); }
        if (it + stride < end) { ti_finish(d1, lane, w1, scr);
            if (it + 3 * stride < end) { d1 = convert_decode(a, it + 3 * stride); ti_load(d1, lane, w1); } }
    }
}

#define XB_TMO      128
#define XB_XCNT(j)  (256  + 64 * (j))
#define XB_XSUB(j)  (1280 + 64 * (j))
#define XB_XGEN(j)  (2304 + 64 * (j))
#define XB_TOP      3328
#define XB_TOPGEN   3392
#define XCD_BAR_WORDS 3456
#define XB_SPIN_CAP (1u << 18)

__device__ __forceinline__ unsigned xb_ld(unsigned* p)              { return __hip_atomic_load(p, __ATOMIC_RELAXED, __HIP_MEMORY_SCOPE_AGENT); }
__device__ __forceinline__ unsigned xb_add(unsigned* p, unsigned v) { return __hip_atomic_fetch_add(p, v, __ATOMIC_RELAXED, __HIP_MEMORY_SCOPE_AGENT); }
__device__ __forceinline__ unsigned xb_xcc_id() { return (unsigned)__builtin_amdgcn_s_getreg((3 << 11) | 20) & 0xFu; }
#define XB_SPIN(cond, bar) do { unsigned _sp = 0; while (cond) { __builtin_amdgcn_s_sleep(1); \
    if ((++_sp & 255u) == 0u) { if (xb_ld(&(bar)[XB_TMO])) break; if (_sp > XB_SPIN_CAP) { atomicAdd(&(bar)[XB_TMO], 1u); break; } } } } while (0)

struct XcdBarrier {
    unsigned* bar; unsigned x;
    volatile LAS unsigned* st;
};

__device__ __forceinline__ XcdBarrier xcd_barrier_post(unsigned* bar, volatile LAS unsigned* st) {
    XcdBarrier b; b.bar = bar; b.x = xb_xcc_id(); b.st = st;
    if (threadIdx.x == 0) (void)xb_add(&bar[XB_XCNT(b.x)], 1u);
    return b;
}
__device__ __forceinline__ void xcd_barrier_complete(unsigned* bar, unsigned x, unsigned& nloc, unsigned& nx) {
    const unsigned G = gridDim.x * gridDim.y * gridDim.z;
    unsigned sum, cnt, mine, sp = 0u;
    for (;;) {
        sum = 0u; cnt = 0u; mine = 0u;
#pragma unroll
        for (unsigned j = 0; j < 16; ++j) { const unsigned c = xb_ld(&bar[XB_XCNT(j)]); sum += c; cnt += (c > 0u) ? 1u : 0u; mine = (j == x) ? c : mine; }
        if (sum == G) break;
        __builtin_amdgcn_s_sleep(1);
        if ((++sp & 255u) == 0u) { if (xb_ld(&bar[XB_TMO])) break; if (sp > XB_SPIN_CAP) { atomicAdd(&bar[XB_TMO], 1u); break; } }
    }
    nloc = mine > 0u ? mine : 1u; nx = cnt > 0u ? cnt : 1u;
}

__device__ __forceinline__ void xcd_barrier(const XcdBarrier& b) {
    asm volatile("s_waitcnt vmcnt(0)" ::: "memory");
    __syncthreads();
    if (threadIdx.x == 0) {
        unsigned* bar = b.bar;
        __builtin_amdgcn_s_waitcnt(0);
        unsigned nloc = b.st[0], nx = b.st[1];
        if (nloc == 0u) { xcd_barrier_complete(bar, b.x, nloc, nx); b.st[0] = nloc; b.st[1] = nx; }
        const unsigned old = xb_add(&bar[XB_XSUB(b.x)], 1u);
        const unsigned gen = old / nloc;
        if (old + 1u == (gen + 1u) * nloc) {
            __builtin_amdgcn_fence(__ATOMIC_RELEASE, "agent");
            asm volatile("s_waitcnt vmcnt(0)" ::: "memory");
            const unsigned og = xb_add(&bar[XB_TOP], 1u);
            const unsigned tg = og / nx;
            if (og + 1u == (tg + 1u) * nx) xb_add(&bar[XB_TOPGEN], 1u);
            else XB_SPIN(xb_ld(&bar[XB_TOPGEN]) == tg, bar);
            __builtin_amdgcn_fence(__ATOMIC_ACQUIRE, "agent");
            xb_add(&bar[XB_XGEN(b.x)], 1u);
            asm volatile("s_waitcnt vmcnt(0)" ::: "memory");
        } else {
            XB_SPIN(xb_ld(&bar[XB_XGEN(b.x)]) == gen, bar);
            __builtin_amdgcn_fence(__ATOMIC_ACQUIRE, "agent");
            asm volatile("s_waitcnt vmcnt(0)" ::: "memory");
        }
    }
    __syncthreads();
}

struct RowArgs { const float* src32; const bf16* srcb; const int* sel; const unsigned char* Y; bf16* XB; unsigned char* XB8; float* RSTD; const float* g; const bf16* W16F; const float* bias; float* GATES; float* AFF; float* out; int mode; int wrxb; };
__device__ __forceinline__ void rowpass_finish(const RowArgs& a, int row, int rr, int s0, int s1, f32x4 (&v)[8], int lane) {
    const int b = row / SEQ;
    if (a.sel) {
        const int sw = rr < 4 ? s0 : s1;
        for (int e = 0; e < NE; ++e) { const int c = __builtin_amdgcn_readlane(sw, ((rr & 3) << 4) + e);
            if (c >= 0) { const unsigned char* y = a.Y + (size_t)(e * 2048 + b * 512 + c) * D + 4 * lane;
#pragma unroll
                for (int j = 0; j < 8; ++j) { const int w = *(const int*)(y + 256 * j); const f32x2 lo = __builtin_amdgcn_cvt_pk_f32_fp8(w, false), hi = __builtin_amdgcn_cvt_pk_f32_fp8(w, true);
                    v[j][0] += lo[0] * (1.0f / Y8_SCALE); v[j][1] += lo[1] * (1.0f / Y8_SCALE); v[j][2] += hi[0] * (1.0f / Y8_SCALE); v[j][3] += hi[1] * (1.0f / Y8_SCALE); } } }
    }
    float ss = 0.f;
#pragma unroll
    for (int j = 0; j < 8; ++j) ss += (v[j][0] * v[j][0] + v[j][1] * v[j][1]) + (v[j][2] * v[j][2] + v[j][3] * v[j][3]);
    ss = wave_sum(ss);
    const float rstd = 1.0f / sqrtf(ss * (1.0f / D) + EPS);
    if (a.mode == 2) {
#pragma unroll
        for (int j = 0; j < 8; ++j) { const f32x4 g = *(const f32x4*)(a.g + 4 * lane + 256 * j); *(f32x4*)(a.out + (size_t)row * D + 4 * lane + 256 * j) = v[j] * rstd * g; }
        return;
    }
    if (a.wrxb) {
#pragma unroll
        for (int j = 0; j < 8; ++j) { v2u w; w.x = pk2(v[j][0], v[j][1]); w.y = pk2(v[j][2], v[j][3]); *(v2u*)(a.XB + (size_t)row * D + 4 * lane + 256 * j) = w; } }
    if (a.XB8) {
#pragma unroll
        for (int j = 0; j < 8; ++j) *(unsigned*)(a.XB8 + (size_t)row * D + 4 * lane + 256 * j) = pg8::pk4_fp8(v[j][0], v[j][1], v[j][2], v[j][3]); }
    if (lane == 0) a.RSTD[row] = rstd;
}
template <bool SRC32> __device__ __forceinline__ void rowpass_group(const RowArgs& a, int grp, int lane_) {
    int lane = lane_; asm volatile("" : "+v"(lane));
    int s0 = -1, s1 = -1; if (a.sel) { s0 = a.sel[grp * 128 + lane]; s1 = a.sel[grp * 128 + 64 + lane]; }
    f32x4 v[8];
    if constexpr (SRC32) {
        f32x4 vn[8];
#pragma unroll
        for (int j = 0; j < 8; ++j) v[j] = *(const f32x4*)(a.src32 + (size_t)(8 * grp) * D + 4 * lane + 256 * j);
#pragma unroll 1
        for (int rr = 0; rr < 8; ++rr) { const int row = 8 * grp + rr;
            if (rr < 7) {
#pragma unroll
                for (int j = 0; j < 8; ++j) vn[j] = *(const f32x4*)(a.src32 + (size_t)(row + 1) * D + 4 * lane + 256 * j); }
            rowpass_finish(a, row, rr, s0, s1, v, lane);
#pragma unroll
            for (int j = 0; j < 8; ++j) v[j] = vn[j]; }
    } else {
        v2u w[8], wn[8];
#pragma unroll
        for (int j = 0; j < 8; ++j) w[j] = *(const v2u*)(a.srcb + (size_t)(8 * grp) * D + 4 * lane + 256 * j);
#pragma unroll 1
        for (int rr = 0; rr < 8; ++rr) { const int row = 8 * grp + rr;
            if (rr < 7) {
#pragma unroll
                for (int j = 0; j < 8; ++j) wn[j] = *(const v2u*)(a.srcb + (size_t)(row + 1) * D + 4 * lane + 256 * j); }
#pragma unroll
            for (int j = 0; j < 8; ++j) v[j] = (f32x4){bflo(w[j].x), bfhi(w[j].x), bflo(w[j].y), bfhi(w[j].y)};
            rowpass_finish(a, row, rr, s0, s1, v, lane);
#pragma unroll
            for (int j = 0; j < 8; ++j) w[j] = wn[j]; }
    }
    if (a.mode == 2) return;
    asm volatile("s_waitcnt vmcnt(0)" ::: "memory");
    const int g = lane >> 4, lc = lane & 15;
    f32x4 acc = (f32x4){0.f, 0.f, 0.f, 0.f};
    const bf16* xr = a.XB + (size_t)(8 * grp + (lc & 7)) * D + 8 * g; const bf16* wf = a.W16F + lane * 8;
#pragma unroll 8
    for (int s = 0; s < 64; ++s) { bf16x8v af = *(const bf16x8v*)(xr + 32 * s); if (lc >= 8) af = (bf16x8v){0, 0, 0, 0, 0, 0, 0, 0};
        const bf16x8v bf = *(const bf16x8v*)(wf + s * 512); acc = __builtin_amdgcn_mfma_f32_16x16x32_bf16(af, bf, acc, 0, 0, 0); }
    float rs[4];
#pragma unroll
    for (int r = 0; r < 4; ++r) rs[r] = a.RSTD[8 * grp + 4 * (g & 1) + r];
    if (a.mode == 0) { const float bs = a.bias[lc];
#pragma unroll
        for (int r = 0; r < 4; ++r) { const float rstd = rs[r]; if (g < 2) a.GATES[(size_t)(8 * grp + 4 * g + r) * 16 + lc] = acc[r] * rstd + bs; } }
    else {
#pragma unroll
        for (int r = 0; r < 4; ++r) { const float rstd = rs[r]; const float lg = acc[r] * rstd; float mx = lg;
#pragma unroll
            for (int o = 1; o < 16; o <<= 1) mx = fmaxf(mx, __shfl_xor(mx, o));
            const float p = __expf(lg - mx); float sum = p;
#pragma unroll
            for (int o = 1; o < 16; o <<= 1) sum += __shfl_xor(sum, o);
            const int row = 8 * grp + 4 * g + r; if (g < 2) a.AFF[((size_t)(row / SEQ) * NE + lc) * SEQ + (row % SEQ)] = p / sum; } }
}
__device__ __forceinline__ void w16f_item(const float* W, int ldw, const float* gk, bf16* WF, int s, int lane) {
    const int g = lane >> 4, lc = lane & 15; float v[8];
#pragma unroll
    for (int i = 0; i < 8; ++i) { const int k = 32 * s + 8 * g + i; v[i] = W[(size_t)k * ldw + lc] * gk[k]; }
    v4u o; o.x = pk2(v[0], v[1]); o.y = pk2(v[2], v[3]); o.z = pk2(v[4], v[5]); o.w = pk2(v[6], v[7]);
    *(v4u*)(WF + (size_t)(s * 64 + lane) * 8) = o;
}

__device__ __forceinline__ void na_norm_item(const bf16* NAO, const float* g, bf16* MIX, int t, int lane) {
    f32x4 v[4]; float ss = 0.f;
#pragma unroll
    for (int j = 0; j < 4; ++j) { const v2u w = *(const v2u*)(NAO + (size_t)t * 1024 + 4 * lane + 256 * j); v[j] = (f32x4){bflo(w.x), bfhi(w.x), bflo(w.y), bfhi(w.y)}; ss += (v[j][0] * v[j][0] + v[j][1] * v[j][1]) + (v[j][2] * v[j][2] + v[j][3] * v[j][3]); }
    const float rstd = 1.0f / sqrtf(wave_sum(ss) * (1.0f / 1024.0f) + EPS);
#pragma unroll
    for (int j = 0; j < 4; ++j) { const f32x4 gg = *(const f32x4*)(g + 4 * lane + 256 * j); const f32x4 o = v[j] * rstd * gg; v2u w; w.x = pk2(o[0], o[1]); w.y = pk2(o[2], o[3]);
        *(v2u*)(MIX + (size_t)t * D + 4 * lane + 256 * j) = w; }
}

__device__ __forceinline__ int block_sum_512(int v, LAS int* red, int wave, int lane) {
#pragma unroll
    for (int o = 1; o < 64; o <<= 1) v += __shfl_xor(v, o);
    __syncthreads();
    if (lane == 0) red[wave] = v;
    __syncthreads();
    int s = 0;
#pragma unroll
    for (int w = 0; w < 8; ++w) s += red[w];
    return s;
}
__device__ __forceinline__ int block_excl_scan_512(int v, LAS int* red, int wave, int lane) {
    int inc = v;
#pragma unroll
    for (int o = 1; o < 64; o <<= 1) { const int t = __shfl_up(inc, o); if (lane >= o) inc += t; }
    __syncthreads();
    if (lane == 63) red[wave] = inc;
    __syncthreads();
    int base = 0;
#pragma unroll
    for (int w = 0; w < 8; ++w) base += (w < wave) ? red[w] : 0;
    return base + inc - v;
}
__device__ __forceinline__ void topk_unit(int be, const float* AFF, int* TOK, float* GATEV, int* SEL, LAS int* red) {
    int tid_ = threadIdx.x; asm volatile("" : "+v"(tid_)); const int tid = tid_, lane = tid & 63, wave = tid >> 6;
    const int b = be >> 4, e = be & 15;
    const float* a = AFF + (size_t)be * SEQ + tid * 8;
    const f32x4 a0 = *(const f32x4*)a, a1 = *(const f32x4*)(a + 4);
    unsigned key[8] = {__float_as_uint(a0.x), __float_as_uint(a0.y), __float_as_uint(a0.z), __float_as_uint(a0.w),
                       __float_as_uint(a1.x), __float_as_uint(a1.y), __float_as_uint(a1.z), __float_as_uint(a1.w)};
    LAS int* hist = red + 16;
    unsigned T = 0u; int need = CAP;
#pragma unroll 1
    for (int pass = 0; pass < 4; ++pass) { const int shift = 24 - 8 * pass; const unsigned mhi = pass == 0 ? 0u : (0xFFFFFFFFu << (shift + 8));
        __syncthreads();
        if (tid < 256) hist[tid] = 0;
        __syncthreads();
#pragma unroll
        for (int i = 0; i < 8; ++i) if ((key[i] & mhi) == T) (void)__hip_atomic_fetch_add(&hist[(key[i] >> shift) & 255u], 1, __ATOMIC_RELAXED, __HIP_MEMORY_SCOPE_WORKGROUP);
        __syncthreads();
        if (wave == 0) { const int c0 = hist[4 * lane], c1 = hist[4 * lane + 1], c2 = hist[4 * lane + 2], c3 = hist[4 * lane + 3]; const int t = c0 + c1 + c2 + c3; int inc = t;
#pragma unroll
            for (int o = 1; o < 64; o <<= 1) { const int v = __shfl_down(inc, o); if (lane + o < 64) inc += v; }
            const int ab3 = inc - t, ab2 = ab3 + c3, ab1 = ab2 + c2, ab0 = ab1 + c1;
            if (ab3 < need && need <= ab3 + c3) { red[8] = 4 * lane + 3; red[9] = ab3; }
            if (ab2 < need && need <= ab2 + c2) { red[8] = 4 * lane + 2; red[9] = ab2; }
            if (ab1 < need && need <= ab1 + c1) { red[8] = 4 * lane + 1; red[9] = ab1; }
            if (ab0 < need && need <= ab0 + c0) { red[8] = 4 * lane + 0; red[9] = ab0; } }
        __syncthreads();
        T |= (unsigned)red[8] << shift; need -= red[9]; }
    int ceq = 0;
#pragma unroll
    for (int i = 0; i < 8; ++i) ceq += key[i] == T ? 1 : 0;
    const int need_eq = need;
    int eqrank = block_excl_scan_512(ceq, red, wave, lane);
    int selm = 0, csel = 0;
#pragma unroll
    for (int i = 0; i < 8; ++i) { bool sel = key[i] > T; if (key[i] == T) { sel = eqrank < need_eq; ++eqrank; } if (sel) { selm |= 1 << i; ++csel; } }
    int slot = block_excl_scan_512(csel, red, wave, lane);
#pragma unroll
    for (int i = 0; i < 8; ++i) { const int sidx = tid * 8 + i; const int tok = b * SEQ + sidx;
        if (selm & (1 << i)) { const int R = e * 2048 + b * 512 + slot; TOK[R] = tok; GATEV[R] = __uint_as_float(key[i]); SEL[tok * 16 + e] = slot; ++slot; }
        else SEL[tok * 16 + e] = -1; }
    __syncthreads();
}

typedef short bf16x8v __attribute__((ext_vector_type(8)));
typedef short s16x4 __attribute__((ext_vector_type(4)));
constexpr int ML_L = 128, ML_NC = SEQ / ML_L;
constexpr int KP = 272, VP = 528;
constexpr int ML_T0 = 0, ML_T1 = 128 * KP, ML_V = 2 * 128 * KP;
constexpr int ML_AR = ML_V + 128 * VP;
constexpr int ML_END = ML_AR + 24 * 512;
static_assert(ML_AR % 16 == 0, "LDS map");
constexpr size_t WS_UC = WS_HF;
constexpr size_t WS_NU = 6 * MiB;
constexpr size_t WS_SC = 7 * MiB;

__device__ __forceinline__ s16x4 lds_tr(LAS unsigned char* p) { return __builtin_amdgcn_ds_read_tr16_b64_v4i16((LAS s16x4*)p); }
__device__ __forceinline__ bf16x8v frag_tr(LAS unsigned char* tile, int pitch, int k0, int n0, int lane) {
    const int g = lane >> 4, q = (lane & 15) >> 2, p = lane & 3;
    LAS unsigned char* a = tile + (k0 + 8 * g + q) * pitch + (n0 + 4 * p) * 2;
    const s16x4 lo = lds_tr(a), hi = lds_tr(a + 4 * pitch);
    return (bf16x8v){lo[0], lo[1], lo[2], lo[3], hi[0], hi[1], hi[2], hi[3]};
}
__device__ __forceinline__ bf16x8v frag_row(LAS unsigned char* tile, int pitch, int m0, int k0, int lane) {
    return *(LAS bf16x8v*)(tile + (m0 + (lane & 15)) * pitch + (k0 + 8 * (lane >> 4)) * 2);
}
__device__ __forceinline__ float log_sigmoid_f(float f) { return fminf(f, 0.f) - log1pf(__expf(-fabsf(f))); }
__device__ __forceinline__ float shfl_up_f(float v, int o, int lane, float ident) { const float t = __shfl_up(v, o); return lane >= o ? t : ident; }

__device__ __forceinline__ void chunk_gates(const float* GATES, int t0, int h, int dir, int lane, int& s0, int& s1, float& i0, float& i1, float& b0, float& b1, float& btot) {
    const int p0 = 2 * lane, p1 = p0 + 1; s0 = dir ? 127 - p0 : p0; s1 = dir ? 127 - p1 : p1;
    const int icol = dir * 8 + h, fcol = icol + 4;
    const float* gp = GATES + (size_t)t0 * 16;
    const float f0 = log_sigmoid_f(gp[s0 * 16 + fcol]), f1 = log_sigmoid_f(gp[s1 * 16 + fcol]);
    i0 = gp[s0 * 16 + icol]; i1 = gp[s1 * 16 + icol];
    const float s = f0 + f1; float inc = s;
#pragma unroll
    for (int o = 1; o < 64; o <<= 1) inc += shfl_up_f(inc, o, lane, 0.f);
    const float excl = inc - s; b0 = excl + f0; b1 = excl + s; btot = __shfl(inc, 63);
}


__device__ __forceinline__ void conv_chunk4(const bf16* P, const float* cw, const float* cb, int b, int sq0, int chan0, float (&o)[4][8]) {
    const bf16* pc = P + ((size_t)b * SEQ + sq0) * NPROJ + C_MLQ + chan0;
    v4u w[8];
#pragma unroll
    for (int j = 0; j < 8; ++j) { const int ss = sq0 + j - 2; w[j] = (ss >= 0 && ss < SEQ) ? *(const v4u*)(pc + (ptrdiff_t)(j - 2) * NPROJ) : (v4u){0u, 0u, 0u, 0u}; }
    const f32x4 b0 = *(const f32x4*)(cb + chan0), b1 = *(const f32x4*)(cb + chan0 + 4);
#pragma unroll
    for (int t = 0; t < 4; ++t) { o[t][0] = b0[0]; o[t][1] = b0[1]; o[t][2] = b0[2]; o[t][3] = b0[3]; o[t][4] = b1[0]; o[t][5] = b1[1]; o[t][6] = b1[2]; o[t][7] = b1[3]; }
#pragma unroll
    for (int j = 0; j < 5; ++j) { const f32x4 c0 = *(const f32x4*)(cw + j * 1024 + chan0), c1 = *(const f32x4*)(cw + j * 1024 + chan0 + 4);
#pragma unroll
        for (int t = 0; t < 4; ++t) { const v4u x = w[t + j];
            o[t][0] += c0[0] * bflo(x.x); o[t][1] += c0[1] * bfhi(x.x); o[t][2] += c0[2] * bflo(x.y); o[t][3] += c0[3] * bfhi(x.y);
            o[t][4] += c1[0] * bflo(x.z); o[t][5] += c1[1] * bfhi(x.z); o[t][6] += c1[2] * bflo(x.w); o[t][7] += c1[3] * bfhi(x.w); } }
#pragma unroll
    for (int t = 0; t < 4; ++t)
#pragma unroll
        for (int i = 0; i < 8; ++i) o[t][i] = o[t][i] / (1.0f + __expf(-o[t][i]));
}

__device__ __forceinline__ void mlstm_m1_unit(int u, const float* cw, const float* cb, const bf16* P, const float* GATES, bf16* UC, float* NU, float* SC, LAS unsigned char* lds, int tid_, int wave) {
    int tid = tid_; asm volatile("" : "+v"(tid)); const int lane = tid & 63;
    const int c = u & 31, h = (u >> 5) & 3, b = u >> 7; const int t0 = b * SEQ + c * ML_L;
    LAS float* WK = (LAS float*)(lds + ML_AR);
    LAS float* NRED = WK + 256;
    __syncthreads();
    if (wave < 2) { const int dir = wave; int s0, s1; float i0, i1, b0, b1, btot;
        chunk_gates(GATES, t0, h, dir, lane, s0, s1, i0, i1, b0, b1, btot);
        const float g0 = btot - b0 + i0, g1 = btot - b1 + i1; const float mloc = wave_max(fmaxf(g0, g1));
        WK[dir * 128 + s0] = __expf(g0 - mloc); WK[dir * 128 + s1] = __expf(g1 - mloc);
        if (lane == 0) { float* sc = SC + (size_t)((((b * 4 + h) * 2 + dir) * 32) + c) * 4; sc[0] = btot; sc[1] = mloc; } }
#pragma unroll
    for (int i = 0; i < 8; ++i) { const int id = tid + 512 * i, s = id >> 5, ch = id & 31;
        *(LAS v4u*)(lds + ML_V + s * VP + ch * 16) = *(const v4u*)(P + (size_t)(t0 + s) * NPROJ + C_MLV + h * 256 + ch * 8); }
    float k4[4][8]; conv_chunk4(P, cw, cb, b, c * ML_L + 4 * (tid >> 4), 512 + h * 128 + (tid & 15) * 8, k4);
    __syncthreads();
    { float nf[8], nb[8];
#pragma unroll
      for (int j = 0; j < 8; ++j) { nf[j] = 0.f; nb[j] = 0.f; }
#pragma unroll
      for (int i = 0; i < 4; ++i) { const int s = 4 * (tid >> 4) + i, ch = tid & 15; const float (&k)[8] = k4[i];
        const float wf = WK[s], wb = WK[128 + s];
        v4u of, ob; of.x = pk2(k[0] * wf, k[1] * wf); of.y = pk2(k[2] * wf, k[3] * wf); of.z = pk2(k[4] * wf, k[5] * wf); of.w = pk2(k[6] * wf, k[7] * wf);
        ob.x = pk2(k[0] * wb, k[1] * wb); ob.y = pk2(k[2] * wb, k[3] * wb); ob.z = pk2(k[4] * wb, k[5] * wb); ob.w = pk2(k[6] * wb, k[7] * wb);
        *(LAS v4u*)(lds + ML_T0 + s * KP + ch * 16) = of; *(LAS v4u*)(lds + ML_T1 + s * KP + ch * 16) = ob;
#pragma unroll
        for (int j = 0; j < 8; ++j) { nf[j] += k[j] * wf; nb[j] += k[j] * wb; } }
#pragma unroll
      for (int j = 0; j < 8; ++j) { nf[j] += __shfl_xor(nf[j], 16); nf[j] += __shfl_xor(nf[j], 32); nb[j] += __shfl_xor(nb[j], 16); nb[j] += __shfl_xor(nb[j], 32); }
      if ((lane >> 4) == 0) {
#pragma unroll
          for (int j = 0; j < 8; ++j) { NRED[wave * 256 + (lane & 15) * 8 + j] = nf[j]; NRED[wave * 256 + 128 + (lane & 15) * 8 + j] = nb[j]; } } }
    __syncthreads();
    if (tid < 256) { const int dir = tid >> 7, d = tid & 127; float sum = 0.f;
#pragma unroll
        for (int w = 0; w < 8; ++w) sum += NRED[w * 256 + tid];
        NU[(size_t)((((b * 4 + h) * 2 + dir) * 32) + c) * 128 + d] = sum; }
    const int g = lane >> 4;
#pragma unroll 1
    for (int dir = 0; dir < 2; ++dir) {
        LAS unsigned char* Kt = lds + (dir ? ML_T1 : ML_T0);
        f32x4 acc[8][2];
#pragma unroll
        for (int mb = 0; mb < 8; ++mb) { acc[mb][0] = (f32x4){0.f, 0.f, 0.f, 0.f}; acc[mb][1] = (f32x4){0.f, 0.f, 0.f, 0.f}; }
#pragma unroll
        for (int ks = 0; ks < 4; ++ks) {
            const bf16x8v b0 = frag_tr(lds + ML_V, VP, 32 * ks, 32 * wave, lane), b1 = frag_tr(lds + ML_V, VP, 32 * ks, 32 * wave + 16, lane);
#pragma unroll
            for (int mb = 0; mb < 8; ++mb) { const bf16x8v a = frag_tr(Kt, KP, 32 * ks, 16 * mb, lane);
                acc[mb][0] = __builtin_amdgcn_mfma_f32_16x16x32_bf16(a, b0, acc[mb][0], 0, 0, 0); acc[mb][1] = __builtin_amdgcn_mfma_f32_16x16x32_bf16(a, b1, acc[mb][1], 0, 0, 0); } }
        bf16* uc = UC + (size_t)((((b * 4 + h) * 2 + dir) * 32) + c) * 32768;
#pragma unroll
        for (int mb = 0; mb < 8; ++mb)
#pragma unroll
            for (int nb = 0; nb < 2; ++nb) { const int e = 32 * wave + 16 * nb + (lane & 15), d0 = 16 * mb + 4 * g; v2u w; w.x = pk2(acc[mb][nb][0], acc[mb][nb][1]); w.y = pk2(acc[mb][nb][2], acc[mb][nb][3]);
                *(v2u*)(uc + e * 128 + d0) = w; }
    }
}

__device__ __forceinline__ void mlstm_m2(bf16* UC, float* NU, float* SC, int gtid, int nthreads) {
    for (int vid = gtid; vid < 32 * 4096; vid += nthreads) { const int chain = vid >> 12, within = vid & 4095, dir = chain & 1;
        float st[8]; float m = 0.f;
#pragma unroll
        for (int i = 0; i < 8; ++i) st[i] = 0.f;
#pragma unroll 4
        for (int step = 0; step < ML_NC; ++step) { const int c = dir ? ML_NC - 1 - step : step;
            float* sc = SC + (size_t)(chain * 32 + c) * 4; const float btot = sc[0], mloc = sc[1];
            v4u* p = (v4u*)(UC + ((size_t)(chain * 32 + c) * 4096 + within) * 8);
            const v4u uw = *p;
            v4u cw; cw.x = pk2(st[0], st[1]); cw.y = pk2(st[2], st[3]); cw.z = pk2(st[4], st[5]); cw.w = pk2(st[6], st[7]);
            *p = cw;
            if (within == 0) sc[2] = m;
            const float mn = fmaxf(btot + m, mloc), dC = __expf(btot + m - mn), dU = __expf(mloc - mn);
            const float uu[8] = {bflo(uw.x), bfhi(uw.x), bflo(uw.y), bfhi(uw.y), bflo(uw.z), bfhi(uw.z), bflo(uw.w), bfhi(uw.w)};
#pragma unroll
            for (int i = 0; i < 8; ++i) st[i] = dC * st[i] + dU * uu[i];
            m = mn; } }
    for (int nid = gtid; nid < 32 * 128; nid += nthreads) { const int chain = nid >> 7, d = nid & 127, dir = chain & 1; float st = 0.f, m = 0.f;
        for (int step = 0; step < ML_NC; ++step) { const int c = dir ? ML_NC - 1 - step : step;
            const float* sc = SC + (size_t)(chain * 32 + c) * 4; const float btot = sc[0], mloc = sc[1];
            float* p = NU + (size_t)(chain * 32 + c) * 128 + d; const float uu = *p; *p = st;
            const float mn = fmaxf(btot + m, mloc); st = __expf(btot + m - mn) * st + __expf(mloc - mn) * uu; m = mn; } }
}

__device__ __forceinline__ void mlstm_m3_unit(int u, const float* cw, const float* cb, const bf16* P, const float* GATES, const bf16* UC, const float* NU, const float* SC, const float* mlg, const float* RSNA, bf16* MIX, LAS unsigned char* lds, int tid_, int wave) {
    int tid = tid_; asm volatile("" : "+v"(tid)); const int lane = tid & 63;
    const int c = u & 31, h = (u >> 5) & 3, b = u >> 7; const int t0 = b * SEQ + c * ML_L;
    LAS float* AR = (LAS float*)(lds + ML_AR);
    LAS float* CS = AR; LAS float* RR = AR + 256; LAS float* INTER = AR + 512; LAS float* EM = AR + 768; LAS float* ALPHA = AR + 1024; LAS float* SS = AR + 1280;
    const int g = lane >> 4, lc = lane & 15;
    const int chain0 = (b * 4 + h) * 2;
    __syncthreads();
    if (wave < 2) { const int dir = wave; int s0, s1; float i0, i1, b0, b1, btot;
        chunk_gates(GATES, t0, h, dir, lane, s0, s1, i0, i1, b0, b1, btot);
        const float cs0 = i0 - b0, cs1 = i1 - b1;
        float pmx = fmaxf(cs0, cs1);
#pragma unroll
        for (int o = 1; o < 64; o <<= 1) pmx = fmaxf(pmx, shfl_up_f(pmx, o, lane, -3.0e38f));
        const float ex = shfl_up_f(pmx, 1, lane, -3.0e38f);
        const float pm0 = fmaxf(ex, cs0), pm1 = fmaxf(pm0, cs1);
        const float m_in = SC[(size_t)((chain0 + dir) * 32 + c) * 4 + 2];
        const float M0 = b0 + fmaxf(m_in, pm0), M1 = b1 + fmaxf(m_in, pm1);
        CS[dir * 128 + s0] = cs0; CS[dir * 128 + s1] = cs1; RR[dir * 128 + s0] = b0 - M0; RR[dir * 128 + s1] = b1 - M1;
        INTER[dir * 128 + s0] = __expf(b0 + m_in - M0); INTER[dir * 128 + s1] = __expf(b1 + m_in - M1); EM[dir * 128 + s0] = __expf(-M0); EM[dir * 128 + s1] = __expf(-M1); }
    { const int s0 = 4 * (tid >> 4), ch = tid & 15; float x4[4][8];
      conv_chunk4(P, cw, cb, b, c * ML_L + s0, h * 128 + ch * 8, x4);
      const float qs = 0.08838834764831845f;
#pragma unroll
      for (int i = 0; i < 4; ++i) { v4u oq; oq.x = pk2(x4[i][0] * qs, x4[i][1] * qs); oq.y = pk2(x4[i][2] * qs, x4[i][3] * qs); oq.z = pk2(x4[i][4] * qs, x4[i][5] * qs); oq.w = pk2(x4[i][6] * qs, x4[i][7] * qs);
          *(LAS v4u*)(lds + ML_T0 + (s0 + i) * KP + ch * 16) = oq; }
      conv_chunk4(P, cw, cb, b, c * ML_L + s0, 512 + h * 128 + ch * 8, x4);
#pragma unroll
      for (int i = 0; i < 4; ++i) { v4u ok; ok.x = pk2(x4[i][0], x4[i][1]); ok.y = pk2(x4[i][2], x4[i][3]); ok.z = pk2(x4[i][4], x4[i][5]); ok.w = pk2(x4[i][6], x4[i][7]);
          *(LAS v4u*)(lds + ML_T1 + (s0 + i) * KP + ch * 16) = ok; } }
#pragma unroll
    for (int i = 0; i < 8; ++i) { const int id = tid + 512 * i, s = id >> 5, ch = id & 31;
        *(LAS v4u*)(lds + ML_V + s * VP + ch * 16) = *(const v4u*)(P + (size_t)(t0 + s) * NPROJ + C_MLV + h * 256 + ch * 8); }
    __syncthreads();
    f32x4 S[8], qn = (f32x4){0.f, 0.f, 0.f, 0.f};
#pragma unroll
    for (int nb = 0; nb < 8; ++nb) S[nb] = (f32x4){0.f, 0.f, 0.f, 0.f};
#pragma unroll
    for (int ks = 0; ks < 4; ++ks) { const bf16x8v a = frag_row(lds + ML_T0, KP, 16 * wave, 32 * ks, lane);
        bf16x8v nf = (bf16x8v){0, 0, 0, 0, 0, 0, 0, 0};
        if (lc < 2) { const float* np = NU + (size_t)((chain0 + lc) * 32 + c) * 128 + 32 * ks + 8 * g; const f32x4 n0 = *(const f32x4*)np, n1 = *(const f32x4*)(np + 4);
            const unsigned w0 = pk2(n0[0], n0[1]), w1 = pk2(n0[2], n0[3]), w2 = pk2(n1[0], n1[1]), w3 = pk2(n1[2], n1[3]);
            nf = (bf16x8v){(short)(w0 & 0xffff), (short)(w0 >> 16), (short)(w1 & 0xffff), (short)(w1 >> 16), (short)(w2 & 0xffff), (short)(w2 >> 16), (short)(w3 & 0xffff), (short)(w3 >> 16)}; }
        qn = __builtin_amdgcn_mfma_f32_16x16x32_bf16(a, nf, qn, 0, 0, 0);
#pragma unroll
        for (int nb = 0; nb < 8; ++nb) { const bf16x8v kb = frag_row(lds + ML_T1, KP, 16 * nb, 32 * ks, lane); S[nb] = __builtin_amdgcn_mfma_f32_16x16x32_bf16(a, kb, S[nb], 0, 0, 0); } }
    float csf[8], csb[8];
#pragma unroll
    for (int nb = 0; nb < 8; ++nb) { csf[nb] = CS[16 * nb + lc]; csb[nb] = CS[128 + 16 * nb + lc]; }
    float pc[8][4];
#pragma unroll
    for (int r = 0; r < 4; ++r) { const int j = 16 * wave + 4 * g + r; const float Rf = RR[j], Rb = RR[128 + j];
        const float qnf = __shfl(qn[r], 16 * g), qnb = __shfl(qn[r], 16 * g + 1);
        float sf[8], sb[8], rsf = 0.f, rsb = 0.f;
#pragma unroll
        for (int nb = 0; nb < 8; ++nb) { const int s = 16 * nb + lc; const float wf = s <= j ? __expf(Rf + csf[nb]) : 0.f, wb = s >= j ? __expf(Rb + csb[nb]) : 0.f;
            sf[nb] = S[nb][r] * wf; sb[nb] = S[nb][r] * wb; rsf += sf[nb]; rsb += sb[nb]; }
        rsf = row16_sum(rsf); rsb = row16_sum(rsb);
        const float inf_ = INTER[j], inb_ = INTER[128 + j];
        const float ivf = 1.0f / fmaxf(fabsf(inf_ * qnf + rsf), EM[j]), ivb = 1.0f / fmaxf(fabsf(inb_ * qnb + rsb), EM[128 + j]);
#pragma unroll
        for (int nb = 0; nb < 8; ++nb) pc[nb][r] = sf[nb] * ivf + sb[nb] * ivb;
        if (lc == 0) { ALPHA[j] = inf_ * ivf; ALPHA[128 + j] = inb_ * ivb; } }
    __syncthreads();
#pragma unroll
    for (int r = 0; r < 4; ++r) { const int j = 16 * wave + 4 * g + r;
#pragma unroll
        for (int nb = 0; nb < 8; ++nb) *(LAS unsigned short*)(lds + ML_T1 + j * KP + (16 * nb + lc) * 2) = (unsigned short)f2bf(pc[nb][r]); }
    __syncthreads();
    f32x4 acc[2][8], acc2[2][8];
#pragma unroll
    for (int mb = 0; mb < 2; ++mb)
#pragma unroll
        for (int nb = 0; nb < 8; ++nb) { acc[mb][nb] = (f32x4){0.f, 0.f, 0.f, 0.f}; acc2[mb][nb] = (f32x4){0.f, 0.f, 0.f, 0.f}; }
    const bf16* ucf = UC + (size_t)((chain0 + 0) * 32 + c) * 32768 + (size_t)(32 * wave + lc) * 128 + 8 * g;
    const bf16* ucb = UC + (size_t)((chain0 + 1) * 32 + c) * 32768 + (size_t)(32 * wave + lc) * 128 + 8 * g;
#pragma unroll
    for (int ks = 0; ks < 4; ++ks) {
        const bf16x8v af0 = *(const bf16x8v*)(ucf + 32 * ks), af1 = *(const bf16x8v*)(ucf + 16 * 128 + 32 * ks), ab0 = *(const bf16x8v*)(ucb + 32 * ks), ab1 = *(const bf16x8v*)(ucb + 16 * 128 + 32 * ks);
#pragma unroll
        for (int nb = 0; nb < 8; ++nb) { const bf16x8v qb = frag_row(lds + ML_T0, KP, 16 * nb, 32 * ks, lane);
            acc[0][nb] = __builtin_amdgcn_mfma_f32_16x16x32_bf16(af0, qb, acc[0][nb], 0, 0, 0); acc[1][nb] = __builtin_amdgcn_mfma_f32_16x16x32_bf16(af1, qb, acc[1][nb], 0, 0, 0);
            acc2[0][nb] = __builtin_amdgcn_mfma_f32_16x16x32_bf16(ab0, qb, acc2[0][nb], 0, 0, 0); acc2[1][nb] = __builtin_amdgcn_mfma_f32_16x16x32_bf16(ab1, qb, acc2[1][nb], 0, 0, 0); } }
#pragma unroll
    for (int nb = 0; nb < 8; ++nb) { const float af = ALPHA[16 * nb + lc], ab = ALPHA[128 + 16 * nb + lc];
        acc[0][nb] = acc[0][nb] * af + acc2[0][nb] * ab; acc[1][nb] = acc[1][nb] * af + acc2[1][nb] * ab; }
#pragma unroll
    for (int ks = 0; ks < 4; ++ks) {
        const bf16x8v v0 = frag_tr(lds + ML_V, VP, 32 * ks, 32 * wave, lane), v1 = frag_tr(lds + ML_V, VP, 32 * ks, 32 * wave + 16, lane);
#pragma unroll
        for (int nb = 0; nb < 8; ++nb) { const bf16x8v pb = frag_row(lds + ML_T1, KP, 16 * nb, 32 * ks, lane);
            acc[0][nb] = __builtin_amdgcn_mfma_f32_16x16x32_bf16(v0, pb, acc[0][nb], 0, 0, 0); acc[1][nb] = __builtin_amdgcn_mfma_f32_16x16x32_bf16(v1, pb, acc[1][nb], 0, 0, 0); } }
#pragma unroll
    for (int nb = 0; nb < 8; ++nb) { float ss = 0.f;
#pragma unroll
        for (int mb = 0; mb < 2; ++mb) ss += (acc[mb][nb][0] * acc[mb][nb][0] + acc[mb][nb][1] * acc[mb][nb][1]) + (acc[mb][nb][2] * acc[mb][nb][2] + acc[mb][nb][3] * acc[mb][nb][3]);
        ss = rows4_sum(ss);
        if (g == 0) SS[wave * 128 + 16 * nb + lc] = ss; }
    __syncthreads();
#pragma unroll
    for (int nb = 0; nb < 8; ++nb) { const int j = 16 * nb + lc; float tot = 0.f;
#pragma unroll
        for (int w = 0; w < 8; ++w) tot += SS[w * 128 + j];
        const float rstd = 1.0f / (sqrtf(tot * (1.0f / 256.0f) + EPS) * RSNA[t0 + j]);
#pragma unroll
        for (int mb = 0; mb < 2; ++mb) { const int e0 = 32 * wave + 16 * mb + 4 * g; const size_t t = (size_t)(t0 + j);
            const v2u ow = *(const v2u*)(P + t * NPROJ + C_MLO + h * 256 + e0); const f32x4 gg = *(const f32x4*)(mlg + h * 256 + e0);
            const float o[4] = {bflo(ow.x), bfhi(ow.x), bflo(ow.y), bfhi(ow.y)}; float rr[4];
#pragma unroll
            for (int r = 0; r < 4; ++r) rr[r] = acc[mb][nb][r] * rstd * gg[r] / (1.0f + __expf(-o[r]));
            v2u w; w.x = pk2(rr[0], rr[1]); w.y = pk2(rr[2], rr[3]);
            *(v2u*)(MIX + t * D + 1024 + h * 256 + e0) = w; } }
}


#ifndef NA_PROBE
#define NA_PROBE 0
#endif
constexpr int NA_TILE = 64 * KP, NA_BUF = 2 * NA_TILE, NA_RPB = 2 * NA_BUF;
static_assert(NA_RPB + 15 * 128 * 4 <= ML_END, "LDS map");
__device__ __forceinline__ bf16x8v frag_tr2(LAS unsigned char* tile, int pitch, int row0, int row1, int n0, int lane) {
    const int q = (lane & 15) >> 2, p = lane & 3;
    const s16x4 lo = lds_tr(tile + (row0 + q) * pitch + (n0 + 4 * p) * 2), hi = lds_tr(tile + (row1 + q) * pitch + (n0 + 4 * p) * 2);
    return (bf16x8v){lo[0], lo[1], lo[2], lo[3], hi[0], hi[1], hi[2], hi[3]};
}
__device__ __forceinline__ void na_unit(int u, const bf16* P, const float* rpb, bf16* MIX, float* SSQ, LAS unsigned char* lds, int tid_, int wave) {
    int tid = tid_; asm volatile("" : "+v"(tid)); const int lane = tid & 63, g = lane >> 4, lc = lane & 15;
    const int r4 = u & 15, h = (u >> 4) & 7, b = u >> 7;
    const int r0 = 4 * r4, r = r0 + (wave >> 1), qh = wave & 1;
    const int rs = min(max(r - 4, 0), 56), rs0 = min(max(r0 - 4, 0), 56), nk = min(max(r0 + 3 - 4, 0), 56) + 8 - rs0;
    LAS float* RPB = (LAS float*)(lds + NA_RPB);
    const int sA = tid >> 4, chA = tid & 15, sB = sA + 32;
    const bf16* gsrc = P + ((size_t)b * SEQ + rs0 * 64) * NPROJ + h * 128 + chA * 8;
    v4u pk0, pk1, pv0, pv1;
#define NA_LOAD(j) do { const bf16* s_ = gsrc + (size_t)(j) * 64 * NPROJ; pk0 = *(const v4u*)(s_ + (size_t)sA * NPROJ + C_NAK); pk1 = *(const v4u*)(s_ + (size_t)sB * NPROJ + C_NAK); \
        pv0 = *(const v4u*)(s_ + (size_t)sA * NPROJ + C_NAV); pv1 = *(const v4u*)(s_ + (size_t)sB * NPROJ + C_NAV); } while (0)
#define NA_STORE(buf) do { LAS unsigned char* t_ = lds + (buf) * NA_BUF; *(LAS v4u*)(t_ + sA * KP + chA * 16) = pk0; *(LAS v4u*)(t_ + sB * KP + chA * 16) = pk1; \
        *(LAS v4u*)(t_ + NA_TILE + sA * KP + chA * 16) = pv0; *(LAS v4u*)(t_ + NA_TILE + sB * KP + chA * 16) = pv1; } while (0)
    NA_LOAD(0);
    __syncthreads();
    for (int i = tid; i < 15 * 128; i += 512) { const int dr = i >> 7, x = (i & 127) - 48; RPB[i] = (x >= 0 && x < 31) ? rpb[h * 465 + dr * 31 + x] * 1.4426950408889634f : 0.f; }
    NA_STORE(0);
    bf16x8v qf[2][4]; int cq[2], cs[2], boff[2]; float m[2], l[2]; f32x4 O[2][8]; f32x4 madd[2][4];
#pragma unroll
    for (int qi = 0; qi < 2; ++qi) { cq[qi] = 32 * qh + 16 * qi + lc; cs[qi] = min(max(cq[qi] - 8, 0), 48); m[qi] = -1.0e30f; l[qi] = 0.f; boff[qi] = 63 - cq[qi] + 4 * g;
#pragma unroll
        for (int kb = 0; kb < 4; ++kb)
#pragma unroll
            for (int rr = 0; rr < 4; ++rr) { const int kc = 16 * kb + 4 * g + rr; madd[qi][kb][rr] = (kc >= cs[qi] && kc < cs[qi] + 16) ? 0.f : -1.0e30f; }
        const bf16* qp = P + ((size_t)b * SEQ + r * 64 + cq[qi]) * NPROJ + C_NAQ + h * 128 + 8 * g;
#pragma unroll
        for (int ks = 0; ks < 4; ++ks) qf[qi][ks] = *(const bf16x8v*)(qp + 32 * ks);
#pragma unroll
        for (int db = 0; db < 8; ++db) O[qi][db] = (f32x4){0.f, 0.f, 0.f, 0.f}; }
    __syncthreads();
#pragma unroll 1
    for (int j = 0; j < nk; ++j) {
        const int kr = rs0 + j;
        if (j + 1 < nk) NA_LOAD(j + 1);
        if (kr >= rs && kr < rs + 8) {
            LAS unsigned char* Kt = lds + (j & 1) * NA_BUF; LAS unsigned char* Vt = Kt + NA_TILE;
            const LAS float* brow = RPB + (kr - r + 7) * 128;
            const int kb0a = qh ? 1 : 0, kb1a = qh ? 3 : 1, kb0b = qh ? 2 : 0, kb1b = qh ? 3 : 2;
            f32x4 s[2][4];
#if NA_PROBE == 1
            for (int prb = 0; prb < 2; ++prb) { asm volatile("" ::: "memory");
#else
            {
#endif
#pragma unroll
            for (int kb = 0; kb < 4; ++kb) { s[0][kb] = (f32x4){0.f, 0.f, 0.f, 0.f}; s[1][kb] = (f32x4){0.f, 0.f, 0.f, 0.f}; }
#pragma unroll
            for (int kb = 0; kb < 4; ++kb) { const bool ua = kb >= kb0a && kb <= kb1a, ub = kb >= kb0b && kb <= kb1b;
                if (ua || ub) {
#pragma unroll
                    for (int ks = 0; ks < 4; ++ks) { const bf16x8v ka = frag_row(Kt, KP, 16 * kb, 32 * ks, lane);
                        if (ua) s[0][kb] = __builtin_amdgcn_mfma_f32_16x16x32_bf16(ka, qf[0][ks], s[0][kb], 0, 0, 0);
                        if (ub) s[1][kb] = __builtin_amdgcn_mfma_f32_16x16x32_bf16(ka, qf[1][ks], s[1][kb], 0, 0, 0); } } }
            }
            bf16x8v pb[2][2];
#pragma unroll
            for (int qi = 0; qi < 2; ++qi) {
                const int k0 = qi ? kb0b : kb0a, k1 = qi ? kb1b : kb1a; const LAS float* bq = brow + boff[qi];
                float mx = -1.0e30f;
#pragma unroll
                for (int kb = 0; kb < 4; ++kb) if (kb >= k0 && kb <= k1) {
#pragma unroll
                    for (int rr = 0; rr < 4; ++rr) { const float v = s[qi][kb][rr] * 0.12753785f + bq[16 * kb + rr] + madd[qi][kb][rr]; s[qi][kb][rr] = v; mx = fmaxf(mx, v); } }
                mx = rows4_max(mx);
                const float mn = fmaxf(m[qi], mx); float ls = 0.f;
#pragma unroll
                for (int kb = 0; kb < 4; ++kb) { if (kb >= k0 && kb <= k1) {
#pragma unroll
                    for (int rr = 0; rr < 4; ++rr) { const float p = __builtin_amdgcn_exp2f(s[qi][kb][rr] - mn); s[qi][kb][rr] = p; ls += p; } } else s[qi][kb] = (f32x4){0.f, 0.f, 0.f, 0.f}; }
                ls = rows4_sum(ls);
                if (!__all(mn == m[qi])) { const float corr = __builtin_amdgcn_exp2f(m[qi] - mn); l[qi] *= corr;
#pragma unroll
                    for (int db = 0; db < 8; ++db) O[qi][db] = O[qi][db] * corr; }
                l[qi] += ls; m[qi] = mn;
#pragma unroll
                for (int t = 0; t < 2; ++t) { v4u pw; pw.x = pk2(s[qi][2 * t][0], s[qi][2 * t][1]); pw.y = pk2(s[qi][2 * t][2], s[qi][2 * t][3]); pw.z = pk2(s[qi][2 * t + 1][0], s[qi][2 * t + 1][1]); pw.w = pk2(s[qi][2 * t + 1][2], s[qi][2 * t + 1][3]);
                    pb[qi][t] = __builtin_bit_cast(bf16x8v, pw); }
            }
#if NA_PROBE == 2
            for (int prb = 0; prb < 2; ++prb) { asm volatile("" ::: "memory"); if (prb) { pb[0][0] = pb[0][1] = pb[1][0] = pb[1][1] = (bf16x8v){0, 0, 0, 0, 0, 0, 0, 0}; }
#else
            {
#endif
#pragma unroll
            for (int t = 0; t < 2; ++t) { const bool ua = 2 * t + 1 >= kb0a && 2 * t <= kb1a, ub = 2 * t + 1 >= kb0b && 2 * t <= kb1b;
                if (ua || ub) {
#pragma unroll
                    for (int db = 0; db < 8; ++db) { const bf16x8v va = frag_tr2(Vt, KP, 32 * t + 4 * g, 32 * t + 16 + 4 * g, 16 * db, lane);
                        if (ua) O[0][db] = __builtin_amdgcn_mfma_f32_16x16x32_bf16(va, pb[0][t], O[0][db], 0, 0, 0);
                        if (ub) O[1][db] = __builtin_amdgcn_mfma_f32_16x16x32_bf16(va, pb[1][t], O[1][db], 0, 0, 0); } } }
            }
        }
#if NA_PROBE == 4
        if (j + 1 < nk) { NA_STORE((j + 1) & 1); asm volatile("" ::: "memory"); }
#endif
#if NA_PROBE == 5
        __syncthreads();
#endif
        if (j + 1 < nk) NA_STORE((j + 1) & 1);
        __syncthreads();
    }
#pragma unroll
    for (int qi = 0; qi < 2; ++qi) { const float inv = 1.0f / l[qi]; const size_t t = (size_t)b * SEQ + r * 64 + cq[qi]; bf16* op = MIX + t * D + h * 128 + 4 * g; float ss = 0.f;
#pragma unroll
        for (int db = 0; db < 8; ++db) { const f32x4 o = O[qi][db] * inv; ss += (o[0] * o[0] + o[1] * o[1]) + (o[2] * o[2] + o[3] * o[3]); v2u w; w.x = pk2(o[0], o[1]); w.y = pk2(o[2], o[3]); *(v2u*)(op + 16 * db) = w; }
        ss = rows4_sum(ss);
        if (g == 0) SSQ[t * 8 + h] = ss; }
#undef NA_LOAD
#undef NA_STORE
}


constexpr int NWAVES = 8;
#ifndef NCONV
#define NCONV 112
#endif
constexpr int RING_BYTES = 131072;
constexpr int LDSCTL_OFF = ML_END, MISC_OFF = LDSCTL_OFF + 320;
constexpr int LDS_BYTES = LDSCTL_OFF + 1024;
static_assert(ML_END >= RING_BYTES && LDS_BYTES <= 163840, "LDS map");
constexpr int CW_BAR = 4096;
constexpr size_t CTL_ZERO_BYTES = 65536;
static_assert((CW_BAR + XCD_BAR_WORDS) * 4 <= (int)CTL_ZERO_BYTES, "barrier words inside the memset region");

struct MKArgs { const float* in[16]; float* out; unsigned char* ws; };
__global__ void __launch_bounds__(NWAVES * 64, 2) mk_fwd(MKArgs args) {
    extern __shared__ __attribute__((aligned(16))) unsigned char lds_raw[];
    LAS unsigned char* lds = (LAS unsigned char*)lds_raw;
    volatile LAS unsigned* MISC = (volatile LAS unsigned*)(lds + MISC_OFF);
    const int tid = threadIdx.x, lane0 = tid & 63, wave = __builtin_amdgcn_readfirstlane(tid >> 6);
    const int G = gridDim.x; const int bx = blockIdx.x; const int vcu = (G % 8 == 0) ? (bx % 8) * (G / 8) + bx / 8 : bx;
    const int gw0 = vcu * NWAVES + wave, ngw = G * NWAVES;
    unsigned char* ws = args.ws;
    for (int u = tid; u < (LDS_BYTES - LDSCTL_OFF) / 4; u += NWAVES * 64) ((LAS unsigned*)(lds + LDSCTL_OFF))[u] = 0u;
    __syncthreads();
    XcdBarrier bar = xcd_barrier_post((unsigned*)(ws + WS_CTL) + CW_BAR, MISC + 8);
#define GRID_BAR() do { XcdBarrier b_ = bar; asm volatile("" : "+s"(b_.bar), "+s"(b_.x)); xcd_barrier(b_); } while (0)
    const float* x = args.in[0]; const float* norm_mix_g = args.in[1]; const float* w_in = args.in[2]; const float* b_gates = args.in[3];
    const float* conv_w = args.in[4]; const float* conv_b = args.in[5]; const float* na_rpb = args.in[6]; const float* na_norm_g = args.in[7];
    const float* ml_norm_g = args.in[8]; const float* w_out = args.in[9]; const float* norm_ffn_g = args.in[10]; const float* w_router = args.in[11];
    const float* w_gate = args.in[12]; const float* w_up = args.in[13]; const float* w_down = args.in[14]; const float* final_norm_g = args.in[15];
#define WSPTRS(wsl, Xl) float* X = (Xl); float* RSTD = (float*)((wsl) + WS_RSTD); float* GATES = (float*)((wsl) + WS_GATES); float* AFF = (float*)((wsl) + WS_AFF); int* TOK = (int*)((wsl) + WS_TOK); float* GATEV = (float*)((wsl) + WS_GATEV); int* SEL = (int*)((wsl) + WS_SEL); \
    bf16* XB = (bf16*)((wsl) + WS_XB); bf16* MIX = (bf16*)((wsl) + WS_MIX); bf16* P = (bf16*)((wsl) + WS_P); bf16* NAO = (bf16*)((wsl) + WS_NAO); bf16* ACT = (bf16*)((wsl) + WS_ACT); bf16* Y = (bf16*)((wsl) + WS_Y); \
    (void)X; (void)RSTD; (void)GATES; (void)AFF; (void)TOK; (void)GATEV; (void)SEL; (void)XB; (void)MIX; (void)P; (void)NAO; (void)ACT; (void)Y;
#define LAUNDER(p) asm volatile("" : "+s"(p))
#ifndef REP_MASK
#define REP_MASK 0
#endif
#if (REP_MASK >> 0) & 1
#define REP0 for (int rep_ = 0; rep_ < 2; ++rep_)
#else
#define REP0
#endif
#if (REP_MASK >> 1) & 1
#define REP1 for (int rep_ = 0; rep_ < 2; ++rep_)
#else
#define REP1
#endif
#if (REP_MASK >> 2) & 1
#define REP2 for (int rep_ = 0; rep_ < 2; ++rep_)
#else
#define REP2
#endif
#if (REP_MASK >> 3) & 1
#define REP3 for (int rep_ = 0; rep_ < 2; ++rep_)
#else
#define REP3
#endif
#if (REP_MASK >> 4) & 1
#define REP4 for (int rep_ = 0; rep_ < 2; ++rep_)
#else
#define REP4
#endif
#if (REP_MASK >> 5) & 1
#define REP5 for (int rep_ = 0; rep_ < 2; ++rep_)
#else
#define REP5
#endif
#if (REP_MASK >> 6) & 1
#define REP6 for (int rep_ = 0; rep_ < 2; ++rep_)
#else
#define REP6
#endif
#if (REP_MASK >> 7) & 1
#define REP7 for (int rep_ = 0; rep_ < 2; ++rep_)
#else
#define REP7
#endif
#if (REP_MASK >> 8) & 1
#define REP8 for (int rep_ = 0; rep_ < 2; ++rep_)
#else
#define REP8
#endif
#if (REP_MASK >> 9) & 1
#define REP9 for (int rep_ = 0; rep_ < 2; ++rep_)
#else
#define REP9
#endif
#if (REP_MASK >> 10) & 1
#define REP10 for (int rep_ = 0; rep_ < 2; ++rep_)
#else
#define REP10
#endif
#if (REP_MASK >> 11) & 1
#define REP11 for (int rep_ = 0; rep_ < 2; ++rep_)
#else
#define REP11
#endif
#if (REP_MASK >> 12) & 1
#define REP12 for (int rep_ = 0; rep_ < 2; ++rep_)
#else
#define REP12
#endif
#if (REP_MASK >> 13) & 1
#define REP13 for (int rep_ = 0; rep_ < 2; ++rep_)
#else
#define REP13
#endif

    { WSPTRS(ws, args.out)
      const int lane = lane0, gw = gw0;
    REP0 { ConvArgs ca; ca.w_in = w_in; ca.w_out = w_out; ca.w_gate = w_gate; ca.w_up = w_up; ca.w_down = w_down; ca.norm_mix_g = norm_mix_g; ca.norm_ffn_g = norm_ffn_g; ca.na_norm_g = na_norm_g; ca.ws = ws;
      LAS float* scr = (LAS float*)(lds + wave * CONV_SCR_BYTES);
      if (G == 256) convert_stream(ca, gw, ngw, CI_IN, scr, lane);
      else convert_stream(ca, gw, ngw, DEPTH * CI_LAYER, scr, lane); }
    { bf16* W16F = (bf16*)(ws + WS_W16F_OFF);
      for (int it = gw; it < DEPTH * 2 * 64; it += ngw) { const int mi = it >> 6, s = it & 63, l = mi >> 1;
          if (mi & 1) w16f_item(w_router + (size_t)l * D * NE, NE, norm_ffn_g + l * D, W16F + (size_t)mi * 32768, s, lane);
          else w16f_item(w_in + (size_t)l * D * NIN + C_GATES, NIN, norm_mix_g + l * D, W16F + (size_t)mi * 32768, s, lane); } }
    GRID_BAR();
    REP1 { RowArgs a; a.src32 = x; a.srcb = nullptr; a.sel = nullptr; a.Y = nullptr; a.XB = XB; a.XB8 = ws + WS_XB8; a.RSTD = RSTD; a.g = norm_mix_g; a.W16F = (const bf16*)(ws + WS_W16F_OFF); a.bias = b_gates; a.GATES = GATES; a.AFF = AFF; a.out = X; a.mode = 0; a.wrxb = 1;
      for (int grp = gw; grp < MTOK / 8; grp += ngw) rowpass_group<true>(a, grp, lane); } }
    GRID_BAR();

    for (int l = 0; l < DEPTH; ++l) {
        unsigned char* wsl = ws; float* Xl = args.out; LAUNDER(wsl); LAUNDER(Xl);
        WSPTRS(wsl, Xl)
        int lane = lane0, gw = gw0; asm volatile("" : "+v"(lane)); LAUNDER(gw);
        const bf16* WinT = (const bf16*)(wsl + WS_WIN) + (size_t)l * NPROJ * D; const bf16* WoutT = (const bf16*)(wsl + WS_WOUT) + (size_t)l * D * D;
        const bf16* WguT = (const bf16*)(wsl + WS_WGU) + (size_t)l * NE * 2048 * D; const bf16* WdT = (const bf16*)(wsl + WS_WD) + (size_t)l * NE * D * DE;
        const int Gg = (l == 0 && G == 256) ? G - NCONV : G;
        if (bx >= Gg) { ConvArgs ca; ca.w_in = w_in; ca.w_out = w_out; ca.w_gate = w_gate; ca.w_up = w_up; ca.w_down = w_down; ca.norm_mix_g = norm_mix_g; ca.norm_ffn_g = norm_ffn_g; ca.na_norm_g = na_norm_g; ca.ws = wsl;
          convert_stream(ca, CI_IN + (bx - Gg) * NWAVES + wave, NCONV * NWAVES, DEPTH * CI_LAYER, (LAS float*)(lds + wave * CONV_SCR_BYTES), lane); }
        else {
        REP2 { pg8::Gemm g{XB, WinT, MTOK, NPROJ16, D, 0}; pg8::StaticOrder S; S.init(MTOK, NPROJ16, Gg, bx); pg8::EpiRowScaleBf16 E{P, RSTD, nullptr, NPROJ, 0, 1.0f, 0};
          pg8::gemm_phase<pg8::EpiRowScaleBf16, pg8::StaticOrder, true, true>(lds, g, S, E); }
        { pg8::Gemm g{(const bf16*)(wsl + WS_XB8), (const bf16*)(wsl + WS_WIN + ((size_t)l * NPROJ + NPROJ16) * D * 2), MTOK, NPROJ - NPROJ16, D / 2, 0}; pg8::StaticOrder S; S.init(MTOK, NPROJ - NPROJ16, Gg, bx);
          pg8::EpiRowScaleBf16 E{P + NPROJ16, RSTD, nullptr, NPROJ, 0, 1.0f / W8_SCALE, 0};
          pg8::gemm_phase<pg8::EpiRowScaleBf16, pg8::StaticOrder, true, true, true>(lds, g, S, E); }
        }
        GRID_BAR();
        REP4 for (int u = vcu; u < 512; u += G) na_unit(u, P, na_rpb + (size_t)l * 8 * 15 * 31, MIX, (float*)(wsl + WS_SSQ), lds, tid, wave);
        { bf16* UC = (bf16*)(wsl + WS_UC); float* NU = (float*)(wsl + WS_NU); float* SC = (float*)(wsl + WS_SC); const float* cwl = conv_w + (size_t)l * 5 * 1024; const float* cbl = conv_b + l * 1024;
          int tidl = tid; asm volatile("" : "+v"(tidl));
          REP5 for (int u = bx; u < 512; u += G) mlstm_m1_unit(u, cwl, cbl, P, GATES, UC, NU, SC, lds, tidl, wave);
          GRID_BAR();
          mlstm_m2(UC, NU, SC, vcu * 512 + tidl, G * 512);
          { const float* ssq = (const float*)(wsl + WS_SSQ); float* rsna = (float*)(wsl + WS_RSNA);
            for (int t = vcu * 512 + tidl; t < MTOK; t += G * 512) { const f32x4 s0 = *(const f32x4*)(ssq + (size_t)t * 8), s1 = *(const f32x4*)(ssq + (size_t)t * 8 + 4);
                rsna[t] = 1.0f / sqrtf(((s0[0] + s0[1]) + (s0[2] + s0[3]) + (s1[0] + s1[1]) + (s1[2] + s1[3])) * (1.0f / 1024.0f) + EPS); } }
          GRID_BAR();
          REP7 for (int u = bx; u < 512; u += G) mlstm_m3_unit(u, cwl, cbl, P, GATES, UC, NU, SC, ml_norm_g + l * 1024, (const float*)(wsl + WS_RSNA), MIX, lds, tidl, wave); }
        GRID_BAR();
#if (REP_MASK >> 8) & 1
        for (int rep_ = 0; rep_ < 2; ++rep_)
#endif
        { pg8::Gemm g{MIX, WoutT, MTOK, D, D, 0}; pg8::StaticOrder S; S.init(MTOK, D, G, bx); pg8::EpiResidBf16 E{XB, (const float*)(wsl + WS_RSNA), D, 0};
#if (REP_MASK >> 8) & 1
          if (rep_ == 0) E.XB = P;
#endif
          pg8::gemm_phase<pg8::EpiResidBf16, pg8::StaticOrder, true, true>(lds, g, S, E); }
        GRID_BAR();
        REP9 { RowArgs a; a.src32 = nullptr; a.srcb = XB; a.sel = nullptr; a.Y = nullptr; a.XB = XB; a.XB8 = wsl + WS_XB8; a.RSTD = RSTD; a.g = norm_ffn_g + l * D; a.W16F = (const bf16*)(wsl + WS_W16F_OFF) + (size_t)(2 * l + 1) * 32768; a.bias = b_gates; a.GATES = GATES; a.AFF = AFF; a.out = X; a.mode = 1; a.wrxb = 0;
          for (int grp = gw; grp < MTOK / 8; grp += ngw) rowpass_group<false>(a, grp, lane); }
        GRID_BAR();
        REP10 for (int be = bx; be < BATCH * NE; be += G) topk_unit(be, AFF, TOK, GATEV, SEL, (LAS int*)lds);
        GRID_BAR();
        REP12 { pg8::Gemm g{(const bf16*)(wsl + WS_XB8), (const bf16*)(wsl + WS_WGU + (size_t)l * NE * 2048 * D), MR, 2048, D / 2, 0}; pg8::GroupedGatherOrder S{TOK, G, bx};
          pg8::EpiSwiGLU8 E{(unsigned char*)ACT, RSTD, TOK, DE, 8, 1.0f / W8_SCALE, 0};
          pg8::gemm_phase_gather<pg8::EpiSwiGLU8, pg8::GroupedGatherOrder, true, true, true>(lds, g, S, E); }
        GRID_BAR();
        REP13 { pg8::Gemm g{ACT, (const bf16*)(wsl + WS_WD + (size_t)l * NE * D * DE), MR, 2048, DE / 2, 0}; pg8::GroupedOrder S{nullptr, G, bx}; pg8::EpiRowScaleF8 E{(unsigned char*)Y, GATEV, D, 8, Y8_SCALE / W8_SCALE, 0};
          pg8::gemm_phase<pg8::EpiRowScaleF8, pg8::GroupedOrder, true, true, true>(lds, g, S, E); }
        GRID_BAR();
        { RowArgs a; a.src32 = nullptr; a.srcb = XB; a.sel = SEL; a.Y = (const unsigned char*)Y; a.XB = XB; a.XB8 = wsl + WS_XB8; a.RSTD = RSTD; a.bias = b_gates + (l + 1 < DEPTH ? (l + 1) * 16 : 0); a.GATES = GATES; a.AFF = AFF; a.out = X; a.wrxb = 1;
          a.W16F = (const bf16*)(wsl + WS_W16F_OFF) + (size_t)(2 * (l + 1 < DEPTH ? l + 1 : 0)) * 32768;
          if (l + 1 < DEPTH) { a.g = norm_mix_g + (l + 1) * D; a.mode = 0; }
          else { a.g = final_norm_g; a.mode = 2; }
          for (int grp = gw; grp < MTOK / 8; grp += ngw) rowpass_group<false>(a, grp, lane); }
        if (l + 1 < DEPTH) GRID_BAR();
    }
#undef GRID_BAR
#undef WSPTRS
}

extern "C" void kernel_launch(void* const* d_in, const int* in_sizes, int n_in, void* d_out, int out_size, void* d_ws, size_t ws_size, hipStream_t stream) {
    static int grid = 0;
    if (grid == 0) {
        if (n_in != 16 || ws_size < WS_END) { fprintf(stderr, "kernel_launch: unexpected n_in %d or ws_size %zu\n", n_in, ws_size); grid = -1; return; }
        int dev = 0, cus = 0, per_cu = 0;
        if (hipGetDevice(&dev) != hipSuccess || hipDeviceGetAttribute(&cus, hipDeviceAttributeMultiprocessorCount, dev) != hipSuccess) { grid = -1; return; }
        if (hipFuncSetAttribute((const void*)mk_fwd, hipFuncAttributeMaxDynamicSharedMemorySize, LDS_BYTES) != hipSuccess) { fprintf(stderr, "kernel_launch: hipFuncSetAttribute failed\n"); grid = -1; return; }
        if (hipOccupancyMaxActiveBlocksPerMultiprocessor(&per_cu, (const void*)mk_fwd, NWAVES * 64, LDS_BYTES) != hipSuccess || per_cu < 1) fprintf(stderr, "kernel_launch: occupancy query reports %d blocks per CU\n", per_cu);
        (void)hipGetLastError();
        grid = cus;
    }
    if (grid < 0) return;
    if (hipMemsetAsync((char*)d_ws + WS_CTL, 0, CTL_ZERO_BYTES, stream) != hipSuccess) return;
    MKArgs a; memset(&a, 0, sizeof(a));
    for (int i = 0; i < 16; ++i) a.in[i] = (const float*)d_in[i];
    a.out = (float*)d_out; a.ws = (unsigned char*)d_ws;
    hipLaunchKernelGGL(mk_fwd, dim3(grid), dim3(NWAVES * 64), LDS_BYTES, stream, a);
}
```

```cpp
#include <hip/hip_runtime.h>
#include <stdint.h>
#include <stdio.h>
#include <string.h>

namespace pg8 {
#define PG8_LAS __attribute__((address_space(3)))
typedef unsigned short bf16_t;
typedef short bf16x8 __attribute__((ext_vector_type(8)));
typedef float f32x4 __attribute__((ext_vector_type(4)));
typedef unsigned u32x4 __attribute__((ext_vector_type(4)));
typedef int v4i32 __attribute__((ext_vector_type(4)));
typedef int v8i32 __attribute__((ext_vector_type(8)));
constexpr int BM = 256, BK = 64, HALF = 128, HTB = HALF * BK * 2  , STAGE_BYTES = 8 * HTB, NXCD = 8, WGM = 8;

__host__ __device__ __forceinline__ int lds_byte(int r, int c) { const int st = (r >> 4) * 2 + (c >> 5), rr = r & 15, cc = c & 31, ob = rr * 64 + cc * 2; return st * 1024 + (ob ^ (((ob >> 9) & 1) << 5)); }
__host__ __device__ __forceinline__ void stage_rc(int b, int& R, int& C) { const int st = b / 1024, sb = b % 1024, swz = sb ^ (((sb >> 9) & 1) << 5); R = (st >> 1) * 16 + swz / 64; C = (st & 1) * 32 + (swz % 64) / 2; }
__host__ __device__ __forceinline__ int perm32(int rho) { const int n = rho >> 4, i = rho & 15; return 8 * (i >> 2) + 4 * n + (i & 3); }

struct Unit { int pm, pn; };
struct Gemm { const bf16_t* A; const bf16_t* Bt; int M, N, K, pad; };

struct StaticOrder {
    static constexpr bool GATHER = false;
    int nM, nN, nwg, G, c, pad;
    __host__ __device__ void init(int M, int N, int G_, int c_) { nM = M / BM; nN = N / BM; nwg = nM * nN; G = G_; c = c_; pad = 0; }
    __host__ __device__ bool next(int i, Unit& u) const {
        const long L = (long)i * G + c; if (L >= nwg) return false;
        int wgid = (int)L; { const int q = nwg / NXCD, r = nwg % NXCD, xcd = wgid % NXCD, off = wgid / NXCD; wgid = (xcd < r ? xcd * (q + 1) : r * (q + 1) + (xcd - r) * q) + off; }
        const int nig = WGM * nN, gid = wgid / nig, fm = gid * WGM, gsz = (nM - fm) < WGM ? (nM - fm) : WGM;
        u.pm = fm + ((wgid % nig) % gsz); u.pn = (wgid % nig) / gsz; return true;
    }
    __device__ __forceinline__ void a_ready(const Unit&) const {}
    __device__ __forceinline__ void done(const Unit&) const {}
};


__device__ __forceinline__ unsigned cvt_pk_bf16(float lo, float hi) { unsigned r; asm volatile("v_cvt_pk_bf16_f32 %0, %1, %2" : "=v"(r) : "v"(lo), "v"(hi)); return r; }
typedef unsigned u32x2 __attribute__((ext_vector_type(2)));

struct EpiRowScaleBf16 {
    static constexpr bool PERM = true, AFTER_DRAIN = false;
    bf16_t* O; const float* rowscale; const int* rowmap; int ldc; int pn_mod; float mul; int pad;
    __device__ __forceinline__ void pre(const Unit& u, int wr, int fr, float (&rs)[8]) const {
#pragma unroll
        for (int i = 0; i < 8; ++i) { const int row = u.pm * BM + wr * 64 + fr + (i >> 2) * HALF + (i & 3) * 16; rs[i] = rowscale ? rowscale[rowmap ? rowmap[row] : row] : 1.0f; } }
    __device__ __forceinline__ void operator()(const f32x4 (&acc)[2][2][4][2], const Unit& u, int wr, int wc, int fr, int fq, const float (&rs)[8]) const {
        const int row0 = u.pm * BM + wr * 64 + fr; const int pnl = pn_mod ? (u.pn % pn_mod) : u.pn;
        const int col0 = pnl * BM + wc * 32 + 8 * fq;
#pragma unroll
        for (int ai = 0; ai < 2; ++ai)
#pragma unroll
            for (int m = 0; m < 4; ++m) { const int row = row0 + ai * HALF + m * 16; const float sc = rs[4 * ai + m] * mul;
                bf16_t* rowp = O + (size_t)row * ldc + col0;
#pragma unroll
                for (int bj = 0; bj < 2; ++bj) { const f32x4 v0 = acc[ai][bj][m][0] * sc, v1 = acc[ai][bj][m][1] * sc;
                    u32x4 w; w.x = cvt_pk_bf16(v0[0], v0[1]); w.y = cvt_pk_bf16(v0[2], v0[3]); w.z = cvt_pk_bf16(v1[0], v1[1]); w.w = cvt_pk_bf16(v1[2], v1[3]);
                    *(u32x4*)(rowp + bj * HALF) = w; } }
    }
};
__device__ __forceinline__ unsigned pk4_fp8(float a, float b, float c, float d) { int p = __builtin_amdgcn_cvt_pk_fp8_f32(a, b, 0, false); p = __builtin_amdgcn_cvt_pk_fp8_f32(c, d, p, true); return (unsigned)p; }
struct EpiSwiGLU8 {
    static constexpr bool PERM = false, AFTER_DRAIN = false;
    unsigned char* O; const float* rowscale; const int* rowmap; int ldc; int pn_mod; float mul; int pad;
    __device__ __forceinline__ void pre(const Unit& u, int wr, int fr, float (&rs)[8]) const {
#pragma unroll
        for (int i = 0; i < 8; ++i) { const int row = u.pm * BM + wr * 64 + fr + (i >> 2) * HALF + (i & 3) * 16; rs[i] = rowscale[rowmap[row]]; } }
    __device__ __forceinline__ void operator()(const f32x4 (&acc)[2][2][4][2], const Unit& u, int wr, int wc, int fr, int fq, const float (&rs)[8]) const {
        const int row0 = u.pm * BM + wr * 64 + fr; const int pnl = u.pn % pn_mod;
        const int col0 = pnl * 128 + wc * 16 + 4 * fq;
#pragma unroll
        for (int ai = 0; ai < 2; ++ai)
#pragma unroll
            for (int m = 0; m < 4; ++m) { const int row = row0 + ai * HALF + m * 16; const float sc = rs[4 * ai + m] * mul;
                unsigned char* rowp = O + (size_t)row * ldc + col0;
#pragma unroll
                for (int bj = 0; bj < 2; ++bj) { const f32x4 a = acc[ai][bj][m][0] * sc, up = acc[ai][bj][m][1] * sc; f32x4 r;
#pragma unroll
                    for (int j = 0; j < 4; ++j) r[j] = a[j] * up[j] * __builtin_amdgcn_rcpf(1.0f + __builtin_amdgcn_exp2f(-1.4426950408889634f * a[j]));
                    *(unsigned*)(rowp + bj * 64) = pk4_fp8(r[0], r[1], r[2], r[3]); } }
    }
};

struct EpiRowScaleF8 {
    static constexpr bool PERM = true, AFTER_DRAIN = false;
    unsigned char* O; const float* rowscale; int ldc; int pn_mod; float mul; int pad;
    __device__ __forceinline__ void pre(const Unit& u, int wr, int fr, float (&rs)[8]) const {
#pragma unroll
        for (int i = 0; i < 8; ++i) rs[i] = rowscale[u.pm * BM + wr * 64 + fr + (i >> 2) * HALF + (i & 3) * 16]; }
    __device__ __forceinline__ void operator()(const f32x4 (&acc)[2][2][4][2], const Unit& u, int wr, int wc, int fr, int fq, const float (&rs)[8]) const {
        const int row0 = u.pm * BM + wr * 64 + fr; const int pnl = pn_mod ? (u.pn % pn_mod) : u.pn;
        const int col0 = pnl * BM + wc * 32 + 8 * fq;
#pragma unroll
        for (int ai = 0; ai < 2; ++ai)
#pragma unroll
            for (int m = 0; m < 4; ++m) { const int row = row0 + ai * HALF + m * 16; const float sc = rs[4 * ai + m] * mul;
                unsigned char* rowp = O + (size_t)row * ldc + col0;
#pragma unroll
                for (int bj = 0; bj < 2; ++bj) { const f32x4 v0 = acc[ai][bj][m][0] * sc, v1 = acc[ai][bj][m][1] * sc;
                    u32x2 w; w.x = pk4_fp8(v0[0], v0[1], v0[2], v0[3]); w.y = pk4_fp8(v1[0], v1[1], v1[2], v1[3]);
                    *(u32x2*)(rowp + bj * HALF) = w; } }
    }
};

struct EpiResidBf16 {
    static constexpr bool PERM = true, AFTER_DRAIN = false;
    bf16_t* XB; const float* rowscale; int ldc; int pad;
    __device__ __forceinline__ void pre(const Unit& u, int wr, int fr, float (&rs)[8]) const {
#pragma unroll
        for (int i = 0; i < 8; ++i) rs[i] = rowscale[u.pm * BM + wr * 64 + fr + (i >> 2) * HALF + (i & 3) * 16]; }
    __device__ __forceinline__ void operator()(const f32x4 (&acc)[2][2][4][2], const Unit& u, int wr, int wc, int fr, int fq, const float (&rs)[8]) const {
        const int row0 = u.pm * BM + wr * 64 + fr, col0 = u.pn * BM + wc * 32 + 8 * fq;
#pragma unroll
        for (int ai = 0; ai < 2; ++ai) {
            u32x4 xin[4][2];
#pragma unroll
            for (int m = 0; m < 4; ++m)
#pragma unroll
                for (int bj = 0; bj < 2; ++bj) xin[m][bj] = *(const u32x4*)(XB + (size_t)(row0 + ai * HALF + m * 16) * ldc + col0 + bj * HALF);
#pragma unroll
            for (int m = 0; m < 4; ++m) { const int row = row0 + ai * HALF + m * 16; const float sc = rs[4 * ai + m]; bf16_t* rowp = XB + (size_t)row * ldc + col0;
#pragma unroll
                for (int bj = 0; bj < 2; ++bj) { const u32x4 x = xin[m][bj]; const f32x4 v0 = acc[ai][bj][m][0] * sc, v1 = acc[ai][bj][m][1] * sc;
                    u32x4 w; w.x = cvt_pk_bf16(__uint_as_float(x.x << 16) + v0[0], __uint_as_float(x.x & 0xffff0000u) + v0[1]); w.y = cvt_pk_bf16(__uint_as_float(x.y << 16) + v0[2], __uint_as_float(x.y & 0xffff0000u) + v0[3]);
                    w.z = cvt_pk_bf16(__uint_as_float(x.z << 16) + v1[0], __uint_as_float(x.z & 0xffff0000u) + v1[1]); w.w = cvt_pk_bf16(__uint_as_float(x.w << 16) + v1[2], __uint_as_float(x.w & 0xffff0000u) + v1[3]);
                    *(u32x4*)(rowp + bj * HALF) = w; } } }
    }
};
template <bool GATHER_> struct GroupedOrderT {
    static constexpr bool GATHER = GATHER_;
    const int* rowmap; int G, c;
    __device__ __forceinline__ bool next(int i, Unit& u) const {
        const int L = i * G + c; if (L >= 1024) return false;
        const int e = L >> 6, w = L & 63; u.pm = e * 8 + (w & 7); u.pn = e * 8 + (w >> 3); return true;
    }
    __device__ __forceinline__ void a_ready(const Unit&) const {}
    __device__ __forceinline__ void done(const Unit&) const {}
};
typedef GroupedOrderT<false> GroupedOrder; typedef GroupedOrderT<true> GroupedGatherOrder;
template <class Epi, class Sched, bool ALIGN_EPI = false, bool SP2 = false, bool F8 = false>
__device__ __forceinline__ void gemm_phase(PG8_LAS unsigned char* lds, const Gemm g, const Sched& S, const Epi& E) {
    int tid_ = threadIdx.x; asm volatile("" : "+v"(tid_));
    const int tid = tid_, wid = __builtin_amdgcn_readfirstlane(tid >> 6), lane = tid & 63, wr = wid >> 2, wc = wid & 3, fr = lane & 15, fq = lane >> 4;
    const int K = g.K, nt = K / BK;
    unsigned voffA[2], voffB[2];
#pragma unroll
    for (int i = 0; i < 2; ++i) { int R, C; stage_rc(tid * 16 + i * 8192, R, C); const int Rb = Epi::PERM ? ((R & ~31) + perm32(R & 31)) : R;
        voffA[i] = (unsigned)(R * K + C) * 2u; voffB[i] = (unsigned)(Rb * K + C) * 2u; }
    const size_t kstep = (size_t)(BK * 2);
    const size_t hstep = (size_t)HALF * K * 2;
    const size_t tstep = 2 * hstep;
    const unsigned ldsw = (unsigned)wid * 1024u;
    const int aoff = lds_byte(wr * 64 + fr, fq * 8), boff = lds_byte(wc * 32 + fr, fq * 8);
#define PG8_SA(b, h) (((b) * 2 + (h)) * HTB)
#define PG8_SB(b, h) ((4 + (b) * 2 + (h)) * HTB)
#define PG8_STAGE(bufoff, gbase, voff) do { _Pragma("unroll") for (int _i = 0; _i < 2; ++_i) \
        __builtin_amdgcn_global_load_lds((const unsigned*)((const char*)(gbase) + (voff)[_i]), (PG8_LAS unsigned*)(lds + (bufoff) + ldsw + _i * 8192), 16, 0, 0); } while (0)
#define PG8_LDA(dst, b, h) do { if constexpr (F8) { _Pragma("unroll") for (int m = 0; m < 4; ++m) dst##8[m] = __builtin_shufflevector(*(const PG8_LAS v4i32*)(lds + PG8_SA(b, h) + aoff + m * 2048), *(const PG8_LAS v4i32*)(lds + PG8_SA(b, h) + aoff + m * 2048 + 1024), 0, 1, 2, 3, 4, 5, 6, 7); } \
    else { _Pragma("unroll") for (int m = 0; m < 4; ++m) _Pragma("unroll") for (int k = 0; k < 2; ++k) dst[m][k] = *(const PG8_LAS bf16x8*)(lds + PG8_SA(b, h) + aoff + m * 2048 + k * 1024); } } while (0)
#define PG8_LDB(dst, b, h) do { if constexpr (F8) { _Pragma("unroll") for (int n = 0; n < 2; ++n) dst##8[n] = __builtin_shufflevector(*(const PG8_LAS v4i32*)(lds + PG8_SB(b, h) + boff + n * 2048), *(const PG8_LAS v4i32*)(lds + PG8_SB(b, h) + boff + n * 2048 + 1024), 0, 1, 2, 3, 4, 5, 6, 7); } \
    else { _Pragma("unroll") for (int n = 0; n < 2; ++n) _Pragma("unroll") for (int k = 0; k < 2; ++k) dst[n][k] = *(const PG8_LAS bf16x8*)(lds + PG8_SB(b, h) + boff + n * 2048 + k * 1024); } } while (0)
#define PG8_MMA(ai, bj, At, Bt) do { __builtin_amdgcn_s_setprio(1); _Pragma("unroll") for (int m = 0; m < 4; ++m) _Pragma("unroll") for (int n = 0; n < 2; ++n) { \
        if constexpr (F8) asm volatile("v_mfma_scale_f32_16x16x128_f8f6f4 %0, %1, %2, %0, %3, %3 op_sel_hi:[0,0,0]" : "+v"(acc[ai][bj][m][n]) : "v"(Bt##8[n]), "v"(At##8[m]), "v"(f8scale));   \
        else { _Pragma("unroll") for (int k = 0; k < 2; ++k) acc[ai][bj][m][n] = __builtin_amdgcn_mfma_f32_16x16x32_bf16(Bt[n][k], At[m][k], acc[ai][bj][m][n], 0, 0, 0); } } \
        __builtin_amdgcn_s_setprio(0); } while (0)
#define PG8_WAIT_V(n) asm volatile("s_waitcnt vmcnt(" #n ")" ::: "memory")
#define PG8_WAIT_L(n) asm volatile("s_waitcnt lgkmcnt(" #n ")" ::: "memory")
#define PG8_BAR __builtin_amdgcn_s_barrier()
#define PG8_SCHED __builtin_amdgcn_sched_barrier(0)
    Unit cur, nxt; int ui = 0;
    if (!S.next(0, cur)) return;
    f32x4 acc[2][2][4][2];
#pragma unroll
    for (int a = 0; a < 2; ++a)
#pragma unroll
        for (int b = 0; b < 2; ++b)
#pragma unroll
            for (int m = 0; m < 4; ++m)
#pragma unroll
                for (int n = 0; n < 2; ++n) acc[a][b][m][n] = (f32x4){0.f, 0.f, 0.f, 0.f};
    bf16x8 At[4][2], B0[2][2], B1[2][2]; v8i32 At8[4], B08[2], B18[2];
    const int f8scale = 0x7F7F7F7F; (void)f8scale;
    const char* cA = (const char*)g.A + (size_t)cur.pm * tstep; const char* cB = (const char*)g.Bt + (size_t)cur.pn * tstep;
    float rs[8];
    E.pre(cur, wr, fr, rs);
    S.a_ready(cur);
    if constexpr (SP2) {
        PG8_STAGE(PG8_SB(0, 0), cB, voffB); PG8_STAGE(PG8_SB(0, 1), cB + hstep, voffB); PG8_STAGE(PG8_SA(0, 0), cA, voffA); PG8_STAGE(PG8_SA(0, 1), cA + hstep, voffA);
        if (wr == 1) PG8_BAR;
        PG8_WAIT_V(2); PG8_BAR;
        PG8_STAGE(PG8_SB(1, 0), cB + kstep, voffB); PG8_STAGE(PG8_SA(1, 0), cA + kstep, voffA); PG8_STAGE(PG8_SB(1, 1), cB + hstep + kstep, voffB);
        PG8_WAIT_V(6); PG8_BAR;
    } else {
        PG8_STAGE(PG8_SB(0, 0), cB, voffB); PG8_STAGE(PG8_SA(0, 0), cA, voffA); PG8_STAGE(PG8_SB(0, 1), cB + hstep, voffB); PG8_STAGE(PG8_SA(0, 1), cA + hstep, voffA);
        if (wr == 1) PG8_BAR;
        PG8_WAIT_V(4); PG8_BAR;
        PG8_STAGE(PG8_SB(1, 0), cB + kstep, voffB); PG8_STAGE(PG8_SA(1, 0), cA + kstep, voffA); PG8_STAGE(PG8_SB(1, 1), cB + hstep + kstep, voffB);
        PG8_WAIT_V(6); PG8_BAR;
    }
    for (;;) {
        const bool has_next = S.next(ui + 1, nxt);
        const char* nA = has_next ? (const char*)g.A + (size_t)nxt.pm * tstep : cA; const char* nB = has_next ? (const char*)g.Bt + (size_t)nxt.pn * tstep : cB;
        for (int t = 0; t < nt; t += 2) {
            const bool last = (t == nt - 2);
            const char* a1 = cA + (size_t)(t + 1) * kstep;
            const char* a2 = last ? nA : cA + (size_t)(t + 2) * kstep; const char* b2 = last ? nB : cB + (size_t)(t + 2) * kstep;
            const char* a3 = a2 + kstep; const char* b3 = b2 + kstep;
            if (last && has_next) S.a_ready(nxt);
            if constexpr (SP2) {
            PG8_LDB(B0, 0, 0); PG8_LDB(B1, 0, 1); PG8_SCHED; PG8_LDA(At, 0, 0); PG8_STAGE(PG8_SA(1, 1), a1 + hstep, voffA);
            PG8_WAIT_V(8); PG8_WAIT_L(0); PG8_BAR; PG8_MMA(0, 0, At, B0); PG8_MMA(0, 1, At, B1); PG8_BAR; PG8_SCHED;
            PG8_LDA(At, 0, 1); PG8_STAGE(PG8_SB(0, 0), b2, voffB); PG8_STAGE(PG8_SB(0, 1), b2 + hstep, voffB); PG8_STAGE(PG8_SA(0, 0), a2, voffA);
            PG8_WAIT_V(8); PG8_WAIT_L(0); PG8_BAR; PG8_MMA(1, 0, At, B0); PG8_MMA(1, 1, At, B1); PG8_BAR; PG8_SCHED;
            PG8_LDB(B0, 1, 0); PG8_LDB(B1, 1, 1); PG8_SCHED; PG8_LDA(At, 1, 0); PG8_STAGE(PG8_SA(0, 1), a2 + hstep, voffA);
            PG8_WAIT_V(8); PG8_WAIT_L(0); PG8_BAR; PG8_MMA(0, 0, At, B0); PG8_MMA(0, 1, At, B1); PG8_BAR; PG8_SCHED;
            PG8_LDA(At, 1, 1); PG8_STAGE(PG8_SB(1, 0), b3, voffB); PG8_STAGE(PG8_SB(1, 1), b3 + hstep, voffB); PG8_STAGE(PG8_SA(1, 0), a3, voffA);
            PG8_WAIT_V(8); PG8_WAIT_L(0); PG8_BAR; PG8_MMA(1, 0, At, B0); PG8_MMA(1, 1, At, B1); PG8_BAR; PG8_SCHED;
            } else {
            PG8_LDB(B0, 0, 0); PG8_SCHED; PG8_LDA(At, 0, 0); PG8_STAGE(PG8_SA(1, 1), a1 + hstep, voffA);
            PG8_WAIT_L(8); PG8_BAR; PG8_WAIT_L(0); PG8_MMA(0, 0, At, B0); PG8_BAR; PG8_SCHED;
            PG8_LDB(B1, 0, 1); PG8_STAGE(PG8_SB(0, 0), b2, voffB);
            PG8_BAR; PG8_WAIT_L(0); PG8_MMA(0, 1, At, B1); PG8_BAR;
            PG8_LDA(At, 0, 1); PG8_STAGE(PG8_SA(0, 0), a2, voffA);
            PG8_BAR; PG8_WAIT_L(0); PG8_MMA(1, 0, At, B0); PG8_BAR; PG8_SCHED;
            PG8_STAGE(PG8_SB(0, 1), b2 + hstep, voffB);
            PG8_WAIT_V(6); PG8_BAR; PG8_MMA(1, 1, At, B1); PG8_BAR;
            PG8_LDB(B0, 1, 0); PG8_SCHED; PG8_LDA(At, 1, 0); PG8_STAGE(PG8_SA(0, 1), a2 + hstep, voffA);
            PG8_WAIT_L(8); PG8_BAR; PG8_WAIT_L(0); PG8_MMA(0, 0, At, B0); PG8_BAR; PG8_SCHED;
            PG8_LDB(B1, 1, 1); PG8_STAGE(PG8_SB(1, 0), b3, voffB);
            PG8_BAR; PG8_WAIT_L(0); PG8_MMA(0, 1, At, B1); PG8_BAR;
            PG8_LDA(At, 1, 1); PG8_STAGE(PG8_SA(1, 0), a3, voffA);
            PG8_BAR; PG8_WAIT_L(0); PG8_MMA(1, 0, At, B0); PG8_BAR; PG8_SCHED;
            PG8_STAGE(PG8_SB(1, 1), b3 + hstep, voffB);
            PG8_WAIT_V(6); PG8_BAR; PG8_MMA(1, 1, At, B1); PG8_BAR;
            }
        }
        if constexpr (F8) asm volatile("s_nop 15\n\ts_nop 15" ::: "memory");
        if constexpr (ALIGN_EPI) { if (wr == 0) PG8_BAR; }
        if constexpr (!Epi::AFTER_DRAIN) { E(acc, cur, wr, wc, fr, fq, rs); S.done(cur); }
        if (!has_next) break;
#pragma unroll
        for (int a = 0; a < 2; ++a)
#pragma unroll
            for (int b = 0; b < 2; ++b)
#pragma unroll
                for (int m = 0; m < 4; ++m)
#pragma unroll
                    for (int n = 0; n < 2; ++n) acc[a][b][m][n] = (f32x4){0.f, 0.f, 0.f, 0.f};
        cur = nxt; cA = nA; cB = nB; ++ui;
        E.pre(cur, wr, fr, rs);
        if constexpr (ALIGN_EPI) { if (wr == 1) PG8_BAR; }
    }
    PG8_WAIT_V(0);
    if constexpr (!ALIGN_EPI) { if (wr == 0) PG8_BAR; }
    PG8_BAR;
    if constexpr (Epi::AFTER_DRAIN) { E.fused(acc, cur, wr, wc, fr, fq, lds, wid, lane); S.done(cur); }
#undef PG8_SA
#undef PG8_SB
#undef PG8_STAGE
#undef PG8_LDA
#undef PG8_LDB
#undef PG8_MMA
#undef PG8_WAIT_V
#undef PG8_WAIT_L
#undef PG8_BAR
#undef PG8_SCHED
}

template <class Epi, class Sched, bool ALIGN_EPI = false, bool SP2 = false, bool F8 = false>
__device__ __forceinline__ void gemm_phase_gather(PG8_LAS unsigned char* lds, const Gemm g, const Sched& S, const Epi& E) {
    int tid_ = threadIdx.x; asm volatile("" : "+v"(tid_));
    const int tid = tid_, wid = __builtin_amdgcn_readfirstlane(tid >> 6), lane = tid & 63, wr = wid >> 2, wc = wid & 3, fr = lane & 15, fq = lane >> 4;
    static_assert(SP2 || !Sched::GATHER, "gathered A rows: SP2 loop only");
    const int K = g.K, nt = K / BK;
    unsigned voffA[2], voffB[2];
#pragma unroll
    for (int i = 0; i < 2; ++i) { int R, C; stage_rc(tid * 16 + i * 8192, R, C); const int Rb = Epi::PERM ? ((R & ~31) + perm32(R & 31)) : R;
        voffA[i] = (unsigned)(R * K + C) * 2u; voffB[i] = (unsigned)(Rb * K + C) * 2u; }
    constexpr bool GATHER = Sched::GATHER;
    int RA[2], CA[2];
#pragma unroll
    for (int i = 0; i < 2; ++i) stage_rc(tid * 16 + i * 8192, RA[i], CA[i]);
    const size_t kstep = (size_t)(BK * 2);
    const size_t hstep = (size_t)HALF * K * 2;
    const size_t tstep = 2 * hstep;
    const unsigned ldsw = (unsigned)wid * 1024u;
    const int aoff = lds_byte(wr * 64 + fr, fq * 8), boff = lds_byte(wc * 32 + fr, fq * 8);
#define PG8_SA(b, h) (((b) * 2 + (h)) * HTB)
#define PG8_SB(b, h) ((4 + (b) * 2 + (h)) * HTB)
#define PG8_STAGE(bufoff, gbase, voff) do { _Pragma("unroll") for (int _i = 0; _i < 2; ++_i) \
        __builtin_amdgcn_global_load_lds((const unsigned*)((const char*)(gbase) + (voff)[_i]), (PG8_LAS unsigned*)(lds + (bufoff) + ldsw + _i * 8192), 16, 0, 0); } while (0)
#define PG8_LDA(dst, b, h) do { if constexpr (F8) { _Pragma("unroll") for (int m = 0; m < 4; ++m) dst##8[m] = __builtin_shufflevector(*(const PG8_LAS v4i32*)(lds + PG8_SA(b, h) + aoff + m * 2048), *(const PG8_LAS v4i32*)(lds + PG8_SA(b, h) + aoff + m * 2048 + 1024), 0, 1, 2, 3, 4, 5, 6, 7); } \
    else { _Pragma("unroll") for (int m = 0; m < 4; ++m) _Pragma("unroll") for (int k = 0; k < 2; ++k) dst[m][k] = *(const PG8_LAS bf16x8*)(lds + PG8_SA(b, h) + aoff + m * 2048 + k * 1024); } } while (0)
#define PG8_LDB(dst, b, h) do { if constexpr (F8) { _Pragma("unroll") for (int n = 0; n < 2; ++n) dst##8[n] = __builtin_shufflevector(*(const PG8_LAS v4i32*)(lds + PG8_SB(b, h) + boff + n * 2048), *(const PG8_LAS v4i32*)(lds + PG8_SB(b, h) + boff + n * 2048 + 1024), 0, 1, 2, 3, 4, 5, 6, 7); } \
    else { _Pragma("unroll") for (int n = 0; n < 2; ++n) _Pragma("unroll") for (int k = 0; k < 2; ++k) dst[n][k] = *(const PG8_LAS bf16x8*)(lds + PG8_SB(b, h) + boff + n * 2048 + k * 1024); } } while (0)
#define PG8_MMA(ai, bj, At, Bt) do { __builtin_amdgcn_s_setprio(1); _Pragma("unroll") for (int m = 0; m < 4; ++m) _Pragma("unroll") for (int n = 0; n < 2; ++n) { \
        if constexpr (F8) asm volatile("v_mfma_scale_f32_16x16x128_f8f6f4 %0, %1, %2, %0, %3, %3 op_sel_hi:[0,0,0]" : "+v"(acc[ai][bj][m][n]) : "v"(Bt##8[n]), "v"(At##8[m]), "v"(f8scale));   \
        else { _Pragma("unroll") for (int k = 0; k < 2; ++k) acc[ai][bj][m][n] = __builtin_amdgcn_mfma_f32_16x16x32_bf16(Bt[n][k], At[m][k], acc[ai][bj][m][n], 0, 0, 0); } } \
        __builtin_amdgcn_s_setprio(0); } while (0)
#define PG8_WAIT_V(n) asm volatile("s_waitcnt vmcnt(" #n ")" ::: "memory")
#define PG8_WAIT_L(n) asm volatile("s_waitcnt lgkmcnt(" #n ")" ::: "memory")
#define PG8_BAR __builtin_amdgcn_s_barrier()
#define PG8_SCHED __builtin_amdgcn_sched_barrier(0)
    Unit cur, nxt; int ui = 0;
    if (!S.next(0, cur)) return;
    f32x4 acc[2][2][4][2];
#pragma unroll
    for (int a = 0; a < 2; ++a)
#pragma unroll
        for (int b = 0; b < 2; ++b)
#pragma unroll
            for (int m = 0; m < 4; ++m)
#pragma unroll
                for (int n = 0; n < 2; ++n) acc[a][b][m][n] = (f32x4){0.f, 0.f, 0.f, 0.f};
    bf16x8 At[4][2], B0[2][2], B1[2][2]; v8i32 At8[4], B08[2], B18[2];
    const int f8scale = 0x7F7F7F7F; (void)f8scale;
    const char* cA = GATHER ? (const char*)g.A : (const char*)g.A + (size_t)cur.pm * tstep; const char* cB = (const char*)g.Bt + (size_t)cur.pn * tstep;
    unsigned offC[2][2], offN[2][2];
#define PG8_SETOFF(o, u) do { _Pragma("unroll") for (int _h = 0; _h < 2; ++_h) _Pragma("unroll") for (int _i = 0; _i < 2; ++_i) { \
        if constexpr (GATHER) o[_h][_i] = (unsigned)S.rowmap[(u).pm * BM + _h * HALF + RA[_i]] * (unsigned)(K * 2) + (unsigned)(CA[_i] * 2); \
        else o[_h][_i] = voffA[_i] + (unsigned)(_h * (int)hstep); } } while (0)
    PG8_SETOFF(offC, cur);
#pragma unroll
    for (int _h = 0; _h < 2; ++_h) { offN[_h][0] = offC[_h][0]; offN[_h][1] = offC[_h][1]; }
    float rs[8];
    E.pre(cur, wr, fr, rs);
    S.a_ready(cur);
    if constexpr (SP2) {
        PG8_STAGE(PG8_SB(0, 0), cB, voffB); PG8_STAGE(PG8_SB(0, 1), cB + hstep, voffB); PG8_STAGE(PG8_SA(0, 0), cA, offC[0]); PG8_STAGE(PG8_SA(0, 1), cA, offC[1]);
        if (wr == 1) PG8_BAR;
        PG8_WAIT_V(2); PG8_BAR;
        PG8_STAGE(PG8_SB(1, 0), cB + kstep, voffB); PG8_STAGE(PG8_SA(1, 0), cA + kstep, offC[0]); PG8_STAGE(PG8_SB(1, 1), cB + hstep + kstep, voffB);
        PG8_WAIT_V(6); PG8_BAR;
    } else {
        PG8_STAGE(PG8_SB(0, 0), cB, voffB); PG8_STAGE(PG8_SA(0, 0), cA, voffA); PG8_STAGE(PG8_SB(0, 1), cB + hstep, voffB); PG8_STAGE(PG8_SA(0, 1), cA + hstep, voffA);
        if (wr == 1) PG8_BAR;
        PG8_WAIT_V(4); PG8_BAR;
        PG8_STAGE(PG8_SB(1, 0), cB + kstep, voffB); PG8_STAGE(PG8_SA(1, 0), cA + kstep, voffA); PG8_STAGE(PG8_SB(1, 1), cB + hstep + kstep, voffB);
        PG8_WAIT_V(6); PG8_BAR;
    }
    for (;;) {
        const bool has_next = S.next(ui + 1, nxt);
        const char* nA = GATHER ? cA : (has_next ? (const char*)g.A + (size_t)nxt.pm * tstep : cA); const char* nB = has_next ? (const char*)g.Bt + (size_t)nxt.pn * tstep : cB;
        if constexpr (GATHER) { if (has_next) PG8_SETOFF(offN, nxt); }
        for (int t = 0; t < nt; t += 2) {
            const bool last = (t == nt - 2);
            const char* a1 = cA + (size_t)(t + 1) * kstep;
            const char* a2 = last ? nA : cA + (size_t)(t + 2) * kstep; const char* b2 = last ? nB : cB + (size_t)(t + 2) * kstep;
            const char* a3 = a2 + kstep; const char* b3 = b2 + kstep;
            if (last && has_next) S.a_ready(nxt);
            unsigned o2[2][2];
#pragma unroll
            for (int _h = 0; _h < 2; ++_h)
#pragma unroll
                for (int _i = 0; _i < 2; ++_i) o2[_h][_i] = (GATHER && last) ? offN[_h][_i] : offC[_h][_i];
            if constexpr (SP2) {
            PG8_LDB(B0, 0, 0); PG8_LDB(B1, 0, 1); PG8_SCHED; PG8_LDA(At, 0, 0); PG8_STAGE(PG8_SA(1, 1), a1, offC[1]);
            PG8_WAIT_V(8); PG8_WAIT_L(0); PG8_BAR; PG8_MMA(0, 0, At, B0); PG8_MMA(0, 1, At, B1); PG8_BAR; PG8_SCHED;
            PG8_LDA(At, 0, 1); PG8_STAGE(PG8_SB(0, 0), b2, voffB); PG8_STAGE(PG8_SB(0, 1), b2 + hstep, voffB); PG8_STAGE(PG8_SA(0, 0), a2, o2[0]);
            PG8_WAIT_V(8); PG8_WAIT_L(0); PG8_BAR; PG8_MMA(1, 0, At, B0); PG8_MMA(1, 1, At, B1); PG8_BAR; PG8_SCHED;
            PG8_LDB(B0, 1, 0); PG8_LDB(B1, 1, 1); PG8_SCHED; PG8_LDA(At, 1, 0); PG8_STAGE(PG8_SA(0, 1), a2, o2[1]);
            PG8_WAIT_V(8); PG8_WAIT_L(0); PG8_BAR; PG8_MMA(0, 0, At, B0); PG8_MMA(0, 1, At, B1); PG8_BAR; PG8_SCHED;
            PG8_LDA(At, 1, 1); PG8_STAGE(PG8_SB(1, 0), b3, voffB); PG8_STAGE(PG8_SB(1, 1), b3 + hstep, voffB); PG8_STAGE(PG8_SA(1, 0), a3, o2[0]);
            PG8_WAIT_V(8); PG8_WAIT_L(0); PG8_BAR; PG8_MMA(1, 0, At, B0); PG8_MMA(1, 1, At, B1); PG8_BAR; PG8_SCHED;
            } else {
            PG8_LDB(B0, 0, 0); PG8_SCHED; PG8_LDA(At, 0, 0); PG8_STAGE(PG8_SA(1, 1), a1 + hstep, voffA);
            PG8_WAIT_L(8); PG8_BAR; PG8_WAIT_L(0); PG8_MMA(0, 0, At, B0); PG8_BAR; PG8_SCHED;
            PG8_LDB(B1, 0, 1); PG8_STAGE(PG8_SB(0, 0), b2, voffB);
            PG8_BAR; PG8_WAIT_L(0); PG8_MMA(0, 1, At, B1); PG8_BAR;
            PG8_LDA(At, 0, 1); PG8_STAGE(PG8_SA(0, 0), a2, voffA);
            PG8_BAR; PG8_WAIT_L(0); PG8_MMA(1, 0, At, B0); PG8_BAR; PG8_SCHED;
            PG8_STAGE(PG8_SB(0, 1), b2 + hstep, voffB);
            PG8_WAIT_V(6); PG8_BAR; PG8_MMA(1, 1, At, B1); PG8_BAR;
            PG8_LDB(B0, 1, 0); PG8_SCHED; PG8_LDA(At, 1, 0); PG8_STAGE(PG8_SA(0, 1), a2 + hstep, voffA);
            PG8_WAIT_L(8); PG8_BAR; PG8_WAIT_L(0); PG8_MMA(0, 0, At, B0); PG8_BAR; PG8_SCHED;
            PG8_LDB(B1, 1, 1); PG8_STAGE(PG8_SB(1, 0), b3, voffB);
            PG8_BAR; PG8_WAIT_L(0); PG8_MMA(0, 1, At, B1); PG8_BAR;
            PG8_LDA(At, 1, 1); PG8_STAGE(PG8_SA(1, 0), a3, voffA);
            PG8_BAR; PG8_WAIT_L(0); PG8_MMA(1, 0, At, B0); PG8_BAR; PG8_SCHED;
            PG8_STAGE(PG8_SB(1, 1), b3 + hstep, voffB);
            PG8_WAIT_V(6); PG8_BAR; PG8_MMA(1, 1, At, B1); PG8_BAR;
            }
        }
        if constexpr (F8) asm volatile("s_nop 15\n\ts_nop 15" ::: "memory");
        if constexpr (ALIGN_EPI) { if (wr == 0) PG8_BAR; }
        if constexpr (!Epi::AFTER_DRAIN) { E(acc, cur, wr, wc, fr, fq, rs); S.done(cur); }
        if (!has_next) break;
#pragma unroll
        for (int a = 0; a < 2; ++a)
#pragma unroll
            for (int b = 0; b < 2; ++b)
#pragma unroll
                for (int m = 0; m < 4; ++m)
#pragma unroll
                    for (int n = 0; n < 2; ++n) acc[a][b][m][n] = (f32x4){0.f, 0.f, 0.f, 0.f};
        cur = nxt; cA = nA; cB = nB; ++ui;
        E.pre(cur, wr, fr, rs);
#pragma unroll
        for (int _h = 0; _h < 2; ++_h) { offC[_h][0] = offN[_h][0]; offC[_h][1] = offN[_h][1]; }
        if constexpr (ALIGN_EPI) { if (wr == 1) PG8_BAR; }
    }
    PG8_WAIT_V(0);
    if constexpr (!ALIGN_EPI) { if (wr == 0) PG8_BAR; }
    PG8_BAR;
    if constexpr (Epi::AFTER_DRAIN) { E.fused(acc, cur, wr, wc, fr, fq, lds, wid, lane); S.done(cur); }
#undef PG8_SETOFF
#undef PG8_SA
#undef PG8_SB
#undef PG8_STAGE
#undef PG8_LDA
#undef PG8_LDB
#undef PG8_MMA
#undef PG8_WAIT_V
#undef PG8_WAIT_L
#undef PG8_BAR
#undef PG8_SCHED
}
}

constexpr int D = 2048, BATCH = 4, SEQ = 4096, MTOK = BATCH * SEQ, DEPTH = 2;
constexpr int NIN = 6160, NPROJ = 6144;
constexpr int C_NAQ = 0, C_NAK = 1024, C_NAV = 2048, C_MLQ = 3072, C_MLK = 3584, C_MLV = 4096, C_MLO = 5120, C_GATES = 6144;
constexpr int NE = 16, CAP = 512, DE = 1024, MR = NE * BATCH * CAP;
constexpr float EPS = 1e-6f;

typedef unsigned short bf16;
typedef float f32x4 __attribute__((ext_vector_type(4)));
typedef unsigned v4u __attribute__((ext_vector_type(4)));
typedef unsigned v2u __attribute__((ext_vector_type(2)));
#define LAS __attribute__((address_space(3)))
typedef short bf16x8v __attribute__((ext_vector_type(8)));
typedef short s16x4 __attribute__((ext_vector_type(4)));
constexpr size_t WS_XB8 = 968 * (size_t)(1u << 20);
constexpr size_t WS_SSQ = 6 * (size_t)(1u << 20) + 512 * 1024;
constexpr size_t WS_RSNA = 7 * (size_t)(1u << 20) + 64 * 1024;
constexpr size_t WS_W16F_OFF = 7 * (1u << 20) + 256 * 1024;

constexpr size_t MiB = 1u << 20;
constexpr size_t WS_CTL = 0;
constexpr size_t WS_RSTD = 1 * MiB;
constexpr size_t WS_GATES = 2 * MiB;
constexpr size_t WS_AFF = 3 * MiB;
constexpr size_t WS_TOK = 4 * MiB;
constexpr size_t WS_GATEV = 4 * MiB + 512 * 1024;
constexpr size_t WS_SEL = 5 * MiB;
constexpr size_t WS_WIN = 8 * MiB;
constexpr size_t WS_WOUT = 56 * MiB;
constexpr size_t WS_WGU = 72 * MiB;
constexpr size_t WS_WD = 328 * MiB;
constexpr size_t WS_XB = 456 * MiB;
constexpr size_t WS_MIX = 520 * MiB;
constexpr size_t WS_P = 584 * MiB;
constexpr size_t WS_NAO = 776 * MiB;
constexpr size_t WS_HF = 840 * MiB;
constexpr size_t WS_ACT = 712 * MiB;
constexpr size_t WS_Y = 776 * MiB;
constexpr size_t WS_END = 1000 * MiB;

__device__ __forceinline__ unsigned f2bf(float f) { unsigned u = __builtin_bit_cast(unsigned, f); return (u + 0x7fffu + ((u >> 16) & 1u)) >> 16; }
__device__ __forceinline__ unsigned pk2(float lo, float hi) { return f2bf(lo) | (f2bf(hi) << 16); }
__device__ __forceinline__ float bf2f(unsigned short b) { return __builtin_bit_cast(float, ((unsigned)b) << 16); }
__device__ __forceinline__ float bflo(unsigned w) { return __builtin_bit_cast(float, w << 16); }
__device__ __forceinline__ float bfhi(unsigned w) { return __builtin_bit_cast(float, w & 0xffff0000u); }
__device__ __forceinline__ float row_ror(float v, int n) { return n == 8 ? __uint_as_float(__builtin_amdgcn_update_dpp(0, __float_as_uint(v), 0x128, 0xf, 0xf, false)) : n == 4 ? __uint_as_float(__builtin_amdgcn_update_dpp(0, __float_as_uint(v), 0x124, 0xf, 0xf, false))
        : n == 2 ? __uint_as_float(__builtin_amdgcn_update_dpp(0, __float_as_uint(v), 0x122, 0xf, 0xf, false)) : __uint_as_float(__builtin_amdgcn_update_dpp(0, __float_as_uint(v), 0x121, 0xf, 0xf, false)); }
__device__ __forceinline__ float row16_sum(float v) { v += row_ror(v, 8); v += row_ror(v, 4); v += row_ror(v, 2); v += row_ror(v, 1); return v; }
__device__ __forceinline__ float row16_max(float v) { v = fmaxf(v, row_ror(v, 8)); v = fmaxf(v, row_ror(v, 4)); v = fmaxf(v, row_ror(v, 2)); v = fmaxf(v, row_ror(v, 1)); return v; }
__device__ __forceinline__ float rows4_sum(float v) {
    auto a = __builtin_amdgcn_permlane16_swap(__float_as_uint(v), __float_as_uint(v), false, false); v = __uint_as_float(a[0]) + __uint_as_float(a[1]);
    auto b = __builtin_amdgcn_permlane32_swap(__float_as_uint(v), __float_as_uint(v), false, false); return __uint_as_float(b[0]) + __uint_as_float(b[1]); }
__device__ __forceinline__ float rows4_max(float v) {
    auto a = __builtin_amdgcn_permlane16_swap(__float_as_uint(v), __float_as_uint(v), false, false); v = fmaxf(__uint_as_float(a[0]), __uint_as_float(a[1]));
    auto b = __builtin_amdgcn_permlane32_swap(__float_as_uint(v), __float_as_uint(v), false, false); return fmaxf(__uint_as_float(b[0]), __uint_as_float(b[1])); }
__device__ __forceinline__ float wave_sum(float v) { return rows4_sum(row16_sum(v)); }
__device__ __forceinline__ float wave_max(float v) { return rows4_max(row16_max(v)); }

struct ConvItem { const float* W; const float* gk; bf16* WT; int ldw, K, k0, n0, dmode, f8; float wmul; };
__device__ __forceinline__ void ti_load(const ConvItem& d, int lane, f32x4 (&wv)[16]) {
    const int r4 = lane >> 4, c4 = (lane & 15) * 4;
#pragma unroll
    for (int i = 0; i < 16; ++i) wv[i] = *(const f32x4*)(d.W + (size_t)(d.k0 + 4 * i + r4) * d.ldw + d.n0 + c4);
}
__device__ __forceinline__ void ti_finish(const ConvItem& d, int lane, const f32x4 (&wv)[16], LAS float* scr) {
    const int r4 = lane >> 4, c4 = (lane & 15) * 4;
#pragma unroll
    for (int i = 0; i < 16; ++i) { const int kk = 4 * i + r4; const float gg = d.gk ? d.gk[d.k0 + kk] : 1.0f; LAS float* p = scr + kk * 65 + c4; p[0] = wv[i][0] * gg; p[1] = wv[i][1] * gg; p[2] = wv[i][2] * gg; p[3] = wv[i][3] * gg; }
    asm volatile("s_waitcnt lgkmcnt(0)" ::: "memory");
    const int c = lane & 7; const float wmul = d.wmul;
#pragma unroll
    for (int j = 0; j < 8; ++j) { const int n = (lane >> 3) + 8 * j; const LAS float* s = scr + (8 * c) * 65 + n;
        const int ng = d.n0 + n; const int drow = d.dmode == 0 ? ng : ((ng >> 4) * 32 + (ng & 15) + (d.dmode == 2 ? 16 : 0));
        if (d.f8) { v2u o8; int p = __builtin_amdgcn_cvt_pk_fp8_f32(s[0 * 65] * wmul, s[1 * 65] * wmul, 0, false); p = __builtin_amdgcn_cvt_pk_fp8_f32(s[2 * 65] * wmul, s[3 * 65] * wmul, p, true); o8.x = (unsigned)p;
            p = __builtin_amdgcn_cvt_pk_fp8_f32(s[4 * 65] * wmul, s[5 * 65] * wmul, 0, false); p = __builtin_amdgcn_cvt_pk_fp8_f32(s[6 * 65] * wmul, s[7 * 65] * wmul, p, true); o8.y = (unsigned)p;
            *(v2u*)((unsigned char*)d.WT + (size_t)drow * d.K + d.k0 + 8 * c) = o8; }
        else { v4u o; o.x = pk2(s[0 * 65], s[1 * 65]); o.y = pk2(s[2 * 65], s[3 * 65]); o.z = pk2(s[4 * 65], s[5 * 65]); o.w = pk2(s[6 * 65], s[7 * 65]);
            *(v4u*)(d.WT + (size_t)drow * d.K + d.k0 + 8 * c) = o; } }
    asm volatile("s_waitcnt lgkmcnt(0)" ::: "memory");
}
constexpr int CONV_SCR_BYTES = 64 * 65 * 4;
constexpr float Y8_SCALE = 16.0f;
typedef float f32x2 __attribute__((ext_vector_type(2)));
constexpr int NPROJ16 = 5120;
constexpr float W8_SCALE = 64.0f;
struct ConvArgs { const float *w_in, *w_out, *w_gate, *w_up, *w_down, *norm_mix_g, *norm_ffn_g, *na_norm_g; unsigned char* ws; };
constexpr int CI_IN = 32 * 96, CI_OUT = 32 * 32, CI_G = 16 * 32 * 16, CI_D = 16 * 16 * 32, CI_LAYER = CI_IN + CI_OUT + 2 * CI_G + CI_D;
__device__ __forceinline__ ConvItem convert_decode(const ConvArgs& a, int it) {
    ConvItem d; d.f8 = 0; d.wmul = 1.0f; d.gk = nullptr; d.dmode = 0; d.K = D;
    const int l = it / CI_LAYER; int r = it % CI_LAYER;
    if (r < CI_IN) { const int kb = r / 96, nb = r % 96; d.ldw = NIN; d.gk = a.norm_mix_g + l * D; d.k0 = 64 * kb;
        if (64 * nb < NPROJ16) { d.W = a.w_in + (size_t)l * D * NIN; d.WT = (bf16*)(a.ws + WS_WIN) + (size_t)l * NPROJ * D; d.n0 = 64 * nb; }
        else { d.W = a.w_in + (size_t)l * D * NIN + NPROJ16; d.WT = (bf16*)(a.ws + WS_WIN + ((size_t)l * NPROJ + NPROJ16) * D * 2); d.n0 = 64 * nb - NPROJ16; d.f8 = 1; d.wmul = W8_SCALE; }
        return d; }
    r -= CI_IN;
    if (r < CI_OUT) { const int kb = r / 32, nb = r % 32; d.W = a.w_out + (size_t)l * D * D; d.ldw = D; if (64 * kb < 1024) d.gk = a.na_norm_g + l * 1024;
        d.WT = (bf16*)(a.ws + WS_WOUT) + (size_t)l * D * D; d.k0 = 64 * kb; d.n0 = 64 * nb; return d; }
    r -= CI_OUT;
    if (r < 2 * CI_G) { const int up = r >= CI_G; if (up) r -= CI_G; const int e = r / 512, q = r % 512, kb = q / 16, nb = q % 16;
        d.W = (up ? a.w_up : a.w_gate) + ((size_t)l * NE + e) * D * DE; d.ldw = DE; d.gk = a.norm_ffn_g + l * D; d.WT = (bf16*)(a.ws + WS_WGU + ((size_t)l * NE + e) * 2048 * D); d.k0 = 64 * kb; d.n0 = 64 * nb; d.dmode = up ? 2 : 1; d.f8 = 1; d.wmul = W8_SCALE; return d; }
    r -= 2 * CI_G;
    { const int e = r / 512, q = r % 512, kb = q / 32, nb = q % 32; d.W = a.w_down + ((size_t)l * NE + e) * DE * D; d.ldw = D; d.WT = (bf16*)(a.ws + WS_WD + ((size_t)l * NE + e) * D * DE); d.K = DE; d.k0 = 64 * kb; d.n0 = 64 * nb; d.f8 = 1; d.wmul = W8_SCALE; return d; }
}
__device__ __forceinline__ void convert_stream(const ConvArgs& a, int first, int stride, int end, LAS float* scr, int lane) {
    if (first >= end) return;
    f32x4 w0[16], w1[16]; ConvItem d0 = convert_decode(a, first), d1 = d0; ti_load(d0, lane, w0);
    if (first + stride < end) { d1 = convert_decode(a, first + stride); ti_load(d1, lane, w1); }
#pragma unroll 1
    for (int it = first; it < end; it += 2 * stride) {
        ti_finish(d0, lane, w0, scr);
        if (it + 2 * stride < end) { d0 = convert_decode(a, it + 2 * stride); ti_load(d0, lane, w0); }
        if (it + stride < end) { ti_finish(d1, lane, w1, scr);
            if (it + 3 * stride < end) { d1 = convert_decode(a, it + 3 * stride); ti_load(d1, lane, w1); } }
    }
}

#define XB_TMO      128
#define XB_XCNT(j)  (256  + 64 * (j))
#define XB_XSUB(j)  (1280 + 64 * (j))
#define XB_XGEN(j)  (2304 + 64 * (j))
#define XB_TOP      3328
#define XB_TOPGEN   3392
#define XCD_BAR_WORDS 3456
#define XB_SPIN_CAP (1u << 18)

__device__ __forceinline__ unsigned xb_ld(unsigned* p)              { return __hip_atomic_load(p, __ATOMIC_RELAXED, __HIP_MEMORY_SCOPE_AGENT); }
__device__ __forceinline__ unsigned xb_add(unsigned* p, unsigned v) { return __hip_atomic_fetch_add(p, v, __ATOMIC_RELAXED, __HIP_MEMORY_SCOPE_AGENT); }
__device__ __forceinline__ unsigned xb_xcc_id() { return (unsigned)__builtin_amdgcn_s_getreg((3 << 11) | 20) & 0xFu; }
#define XB_SPIN(cond, bar) do { unsigned _sp = 0; while (cond) { __builtin_amdgcn_s_sleep(1); \
    if ((++_sp & 255u) == 0u) { if (xb_ld(&(bar)[XB_TMO])) break; if (_sp > XB_SPIN_CAP) { atomicAdd(&(bar)[XB_TMO], 1u); break; } } } } while (0)

struct XcdBarrier {
    unsigned* bar; unsigned x;
    volatile LAS unsigned* st;
};

__device__ __forceinline__ XcdBarrier xcd_barrier_post(unsigned* bar, volatile LAS unsigned* st) {
    XcdBarrier b; b.bar = bar; b.x = xb_xcc_id(); b.st = st;
    if (threadIdx.x == 0) (void)xb_add(&bar[XB_XCNT(b.x)], 1u);
    return b;
}
__device__ __forceinline__ void xcd_barrier_complete(unsigned* bar, unsigned x, unsigned& nloc, unsigned& nx) {
    const unsigned G = gridDim.x * gridDim.y * gridDim.z;
    unsigned sum, cnt, mine, sp = 0u;
    for (;;) {
        sum = 0u; cnt = 0u; mine = 0u;
#pragma unroll
        for (unsigned j = 0; j < 16; ++j) { const unsigned c = xb_ld(&bar[XB_XCNT(j)]); sum += c; cnt += (c > 0u) ? 1u : 0u; mine = (j == x) ? c : mine; }
        if (sum == G) break;
        __builtin_amdgcn_s_sleep(1);
        if ((++sp & 255u) == 0u) { if (xb_ld(&bar[XB_TMO])) break; if (sp > XB_SPIN_CAP) { atomicAdd(&bar[XB_TMO], 1u); break; } }
    }
    nloc = mine > 0u ? mine : 1u; nx = cnt > 0u ? cnt : 1u;
}

__device__ __forceinline__ void xcd_barrier(const XcdBarrier& b) {
    asm volatile("s_waitcnt vmcnt(0)" ::: "memory");
    __syncthreads();
    if (threadIdx.x == 0) {
        unsigned* bar = b.bar;
        __builtin_amdgcn_s_waitcnt(0);
        unsigned nloc = b.st[0], nx = b.st[1];
        if (nloc == 0u) { xcd_barrier_complete(bar, b.x, nloc, nx); b.st[0] = nloc; b.st[1] = nx; }
        const unsigned old = xb_add(&bar[XB_XSUB(b.x)], 1u);
        const unsigned gen = old / nloc;
        if (old + 1u == (gen + 1u) * nloc) {
            __builtin_amdgcn_fence(__ATOMIC_RELEASE, "agent");
            asm volatile("s_waitcnt vmcnt(0)" ::: "memory");
            const unsigned og = xb_add(&bar[XB_TOP], 1u);
            const unsigned tg = og / nx;
            if (og + 1u == (tg + 1u) * nx) xb_add(&bar[XB_TOPGEN], 1u);
            else XB_SPIN(xb_ld(&bar[XB_TOPGEN]) == tg, bar);
            __builtin_amdgcn_fence(__ATOMIC_ACQUIRE, "agent");
            xb_add(&bar[XB_XGEN(b.x)], 1u);
            asm volatile("s_waitcnt vmcnt(0)" ::: "memory");
        } else {
            XB_SPIN(xb_ld(&bar[XB_XGEN(b.x)]) == gen, bar);
            __builtin_amdgcn_fence(__ATOMIC_ACQUIRE, "agent");
            asm volatile("s_waitcnt vmcnt(0)" ::: "memory");
        }
    }
    __syncthreads();
}

struct RowArgs { const float* src32; const bf16* srcb; const int* sel; const unsigned char* Y; bf16* XB; unsigned char* XB8; float* RSTD; const float* g; const bf16* W16F; const float* bias; float* GATES; float* AFF; float* out; int mode; int wrxb; };
__device__ __forceinline__ void rowpass_finish(const RowArgs& a, int row, int rr, int s0, int s1, f32x4 (&v)[8], int lane) {
    const int b = row / SEQ;
    if (a.sel) {
        const int sw = rr < 4 ? s0 : s1;
#pragma unroll
        for (int eh = 0; eh < 2; ++eh) { int yw[8][8]; int cc[8];
#pragma unroll
            for (int k = 0; k < 8; ++k) { const int e = 8 * eh + k; cc[k] = __builtin_amdgcn_readlane(sw, ((rr & 3) << 4) + e);
                if (cc[k] >= 0) { const unsigned char* y = a.Y + (size_t)(e * 2048 + b * 512 + cc[k]) * D + 4 * lane;
#pragma unroll
                    for (int j = 0; j < 8; ++j) yw[k][j] = *(const int*)(y + 256 * j); } }
#pragma unroll
            for (int k = 0; k < 8; ++k) if (cc[k] >= 0) {
#pragma unroll
                for (int j = 0; j < 8; ++j) { const f32x2 lo = __builtin_amdgcn_cvt_pk_f32_fp8(yw[k][j], false), hi = __builtin_amdgcn_cvt_pk_f32_fp8(yw[k][j], true);
                    v[j][0] += lo[0] * (1.0f / Y8_SCALE); v[j][1] += lo[1] * (1.0f / Y8_SCALE); v[j][2] += hi[0] * (1.0f / Y8_SCALE); v[j][3] += hi[1] * (1.0f / Y8_SCALE); } } }
    }
    float ss = 0.f;
#pragma unroll
    for (int j = 0; j < 8; ++j) ss += (v[j][0] * v[j][0] + v[j][1] * v[j][1]) + (v[j][2] * v[j][2] + v[j][3] * v[j][3]);
    ss = wave_sum(ss);
    const float rstd = 1.0f / sqrtf(ss * (1.0f / D) + EPS);
    if (a.mode == 2) {
#pragma unroll
        for (int j = 0; j < 8; ++j) { const f32x4 g = *(const f32x4*)(a.g + 4 * lane + 256 * j); *(f32x4*)(a.out + (size_t)row * D + 4 * lane + 256 * j) = v[j] * rstd * g; }
        return;
    }
    if (a.wrxb) {
#pragma unroll
        for (int j = 0; j < 8; ++j) { v2u w; w.x = pk2(v[j][0], v[j][1]); w.y = pk2(v[j][2], v[j][3]); *(v2u*)(a.XB + (size_t)row * D + 4 * lane + 256 * j) = w; } }
    if (a.XB8) {
#pragma unroll
        for (int j = 0; j < 8; ++j) *(unsigned*)(a.XB8 + (size_t)row * D + 4 * lane + 256 * j) = pg8::pk4_fp8(v[j][0], v[j][1], v[j][2], v[j][3]); }
    if (lane == 0) a.RSTD[row] = rstd;
}
template <bool SRC32> __device__ __forceinline__ void rowpass_group(const RowArgs& a, int grp, int lane_) {
    int lane = lane_; asm volatile("" : "+v"(lane));
    int s0 = -1, s1 = -1; if (a.sel) { s0 = a.sel[grp * 128 + lane]; s1 = a.sel[grp * 128 + 64 + lane]; }
    f32x4 v[8];
    if constexpr (SRC32) {
        f32x4 vn[8];
#pragma unroll
        for (int j = 0; j < 8; ++j) v[j] = *(const f32x4*)(a.src32 + (size_t)(8 * grp) * D + 4 * lane + 256 * j);
#pragma unroll 1
        for (int rr = 0; rr < 8; ++rr) { const int row = 8 * grp + rr;
            if (rr < 7) {
#pragma unroll
                for (int j = 0; j < 8; ++j) vn[j] = *(const f32x4*)(a.src32 + (size_t)(row + 1) * D + 4 * lane + 256 * j); }
            rowpass_finish(a, row, rr, s0, s1, v, lane);
#pragma unroll
            for (int j = 0; j < 8; ++j) v[j] = vn[j]; }
    } else {
        v2u w[8], wn[8];
#pragma unroll
        for (int j = 0; j < 8; ++j) w[j] = *(const v2u*)(a.srcb + (size_t)(8 * grp) * D + 4 * lane + 256 * j);
#pragma unroll 1
        for (int rr = 0; rr < 8; ++rr) { const int row = 8 * grp + rr;
            if (rr < 7) {
#pragma unroll
                for (int j = 0; j < 8; ++j) wn[j] = *(const v2u*)(a.srcb + (size_t)(row + 1) * D + 4 * lane + 256 * j); }
#pragma unroll
            for (int j = 0; j < 8; ++j) v[j] = (f32x4){bflo(w[j].x), bfhi(w[j].x), bflo(w[j].y), bfhi(w[j].y)};
            rowpass_finish(a, row, rr, s0, s1, v, lane);
#pragma unroll
            for (int j = 0; j < 8; ++j) w[j] = wn[j]; }
    }
    if (a.mode == 2) return;
    asm volatile("s_waitcnt vmcnt(0)" ::: "memory");
    const int g = lane >> 4, lc = lane & 15;
    f32x4 acc = (f32x4){0.f, 0.f, 0.f, 0.f};
    const bf16* xr = a.XB + (size_t)(8 * grp + (lc & 7)) * D + 8 * g; const bf16* wf = a.W16F + lane * 8;
#pragma unroll 8
    for (int s = 0; s < 64; ++s) { bf16x8v af = *(const bf16x8v*)(xr + 32 * s); if (lc >= 8) af = (bf16x8v){0, 0, 0, 0, 0, 0, 0, 0};
        const bf16x8v bf = *(const bf16x8v*)(wf + s * 512); acc = __builtin_amdgcn_mfma_f32_16x16x32_bf16(af, bf, acc, 0, 0, 0); }
    float rs[4];
#pragma unroll
    for (int r = 0; r < 4; ++r) rs[r] = a.RSTD[8 * grp + 4 * (g & 1) + r];
    if (a.mode == 0) { const float bs = a.bias[lc];
#pragma unroll
        for (int r = 0; r < 4; ++r) { const float rstd = rs[r]; if (g < 2) a.GATES[(size_t)(8 * grp + 4 * g + r) * 16 + lc] = acc[r] * rstd + bs; } }
    else {
#pragma unroll
        for (int r = 0; r < 4; ++r) { const float rstd = rs[r]; const float lg = acc[r] * rstd; float mx = lg;
#pragma unroll
            for (int o = 1; o < 16; o <<= 1) mx = fmaxf(mx, __shfl_xor(mx, o));
            const float p = __expf(lg - mx); float sum = p;
#pragma unroll
            for (int o = 1; o < 16; o <<= 1) sum += __shfl_xor(sum, o);
            const int row = 8 * grp + 4 * g + r; if (g < 2) a.AFF[((size_t)(row / SEQ) * NE + lc) * SEQ + (row % SEQ)] = p / sum; } }
}
__device__ __forceinline__ void w16f_item(const float* W, int ldw, const float* gk, bf16* WF, int s, int lane) {
    const int g = lane >> 4, lc = lane & 15; float v[8];
#pragma unroll
    for (int i = 0; i < 8; ++i) { const int k = 32 * s + 8 * g + i; v[i] = W[(size_t)k * ldw + lc] * gk[k]; }
    v4u o; o.x = pk2(v[0], v[1]); o.y = pk2(v[2], v[3]); o.z = pk2(v[4], v[5]); o.w = pk2(v[6], v[7]);
    *(v4u*)(WF + (size_t)(s * 64 + lane) * 8) = o;
}

__device__ __forceinline__ void na_norm_item(const bf16* NAO, const float* g, bf16* MIX, int t, int lane) {
    f32x4 v[4]; float ss = 0.f;
#pragma unroll
    for (int j = 0; j < 4; ++j) { const v2u w = *(const v2u*)(NAO + (size_t)t * 1024 + 4 * lane + 256 * j); v[j] = (f32x4){bflo(w.x), bfhi(w.x), bflo(w.y), bfhi(w.y)}; ss += (v[j][0] * v[j][0] + v[j][1] * v[j][1]) + (v[j][2] * v[j][2] + v[j][3] * v[j][3]); }
    const float rstd = 1.0f / sqrtf(wave_sum(ss) * (1.0f / 1024.0f) + EPS);
#pragma unroll
    for (int j = 0; j < 4; ++j) { const f32x4 gg = *(const f32x4*)(g + 4 * lane + 256 * j); const f32x4 o = v[j] * rstd * gg; v2u w; w.x = pk2(o[0], o[1]); w.y = pk2(o[2], o[3]);
        *(v2u*)(MIX + (size_t)t * D + 4 * lane + 256 * j) = w; }
}

__device__ __forceinline__ int block_sum_512(int v, LAS int* red, int wave, int lane) {
#pragma unroll
    for (int o = 1; o < 64; o <<= 1) v += __shfl_xor(v, o);
    __syncthreads();
    if (lane == 0) red[wave] = v;
    __syncthreads();
    int s = 0;
#pragma unroll
    for (int w = 0; w < 8; ++w) s += red[w];
    return s;
}
__device__ __forceinline__ int block_excl_scan_512(int v, LAS int* red, int wave, int lane) {
    int inc = v;
#pragma unroll
    for (int o = 1; o < 64; o <<= 1) { const int t = __shfl_up(inc, o); if (lane >= o) inc += t; }
    __syncthreads();
    if (lane == 63) red[wave] = inc;
    __syncthreads();
    int base = 0;
#pragma unroll
    for (int w = 0; w < 8; ++w) base += (w < wave) ? red[w] : 0;
    return base + inc - v;
}
__device__ __forceinline__ void topk_unit(int be, const float* AFF, int* TOK, float* GATEV, int* SEL, LAS int* red) {
    int tid_ = threadIdx.x; asm volatile("" : "+v"(tid_)); const int tid = tid_, lane = tid & 63, wave = tid >> 6;
    const int b = be >> 4, e = be & 15;
    const float* a = AFF + (size_t)be * SEQ + tid * 8;
    const f32x4 a0 = *(const f32x4*)a, a1 = *(const f32x4*)(a + 4);
    unsigned key[8] = {__float_as_uint(a0.x), __float_as_uint(a0.y), __float_as_uint(a0.z), __float_as_uint(a0.w),
                       __float_as_uint(a1.x), __float_as_uint(a1.y), __float_as_uint(a1.z), __float_as_uint(a1.w)};
    LAS int* hist = red + 16;
    unsigned T = 0u; int need = CAP;
#pragma unroll 1
    for (int pass = 0; pass < 4; ++pass) { const int shift = 24 - 8 * pass; const unsigned mhi = pass == 0 ? 0u : (0xFFFFFFFFu << (shift + 8));
        __syncthreads();
        if (tid < 256) hist[tid] = 0;
        __syncthreads();
#pragma unroll
        for (int i = 0; i < 8; ++i) if ((key[i] & mhi) == T) (void)__hip_atomic_fetch_add(&hist[(key[i] >> shift) & 255u], 1, __ATOMIC_RELAXED, __HIP_MEMORY_SCOPE_WORKGROUP);
        __syncthreads();
        if (wave == 0) { const int c0 = hist[4 * lane], c1 = hist[4 * lane + 1], c2 = hist[4 * lane + 2], c3 = hist[4 * lane + 3]; const int t = c0 + c1 + c2 + c3; int inc = t;
#pragma unroll
            for (int o = 1; o < 64; o <<= 1) { const int v = __shfl_down(inc, o); if (lane + o < 64) inc += v; }
            const int ab3 = inc - t, ab2 = ab3 + c3, ab1 = ab2 + c2, ab0 = ab1 + c1;
            if (ab3 < need && need <= ab3 + c3) { red[8] = 4 * lane + 3; red[9] = ab3; }
            if (ab2 < need && need <= ab2 + c2) { red[8] = 4 * lane + 2; red[9] = ab2; }
            if (ab1 < need && need <= ab1 + c1) { red[8] = 4 * lane + 1; red[9] = ab1; }
            if (ab0 < need && need <= ab0 + c0) { red[8] = 4 * lane + 0; red[9] = ab0; } }
        __syncthreads();
        T |= (unsigned)red[8] << shift; need -= red[9]; }
    int ceq = 0;
#pragma unroll
    for (int i = 0; i < 8; ++i) ceq += key[i] == T ? 1 : 0;
    const int need_eq = need;
    int eqrank = block_excl_scan_512(ceq, red, wave, lane);
    int selm = 0, csel = 0;
#pragma unroll
    for (int i = 0; i < 8; ++i) { bool sel = key[i] > T; if (key[i] == T) { sel = eqrank < need_eq; ++eqrank; } if (sel) { selm |= 1 << i; ++csel; } }
    int slot = block_excl_scan_512(csel, red, wave, lane);
#pragma unroll
    for (int i = 0; i < 8; ++i) { const int sidx = tid * 8 + i; const int tok = b * SEQ + sidx;
        if (selm & (1 << i)) { const int R = e * 2048 + b * 512 + slot; TOK[R] = tok; GATEV[R] = __uint_as_float(key[i]); SEL[tok * 16 + e] = slot; ++slot; }
        else SEL[tok * 16 + e] = -1; }
    __syncthreads();
}

typedef short bf16x8v __attribute__((ext_vector_type(8)));
typedef short s16x4 __attribute__((ext_vector_type(4)));
constexpr int ML_L = 128, ML_NC = SEQ / ML_L;
constexpr int KP = 272, VP = 528;
constexpr int ML_T0 = 0, ML_T1 = 128 * KP, ML_V = 2 * 128 * KP;
constexpr int ML_AR = ML_V + 128 * VP;
constexpr int ML_END = ML_AR + 24 * 512;
static_assert(ML_AR % 16 == 0, "LDS map");
constexpr size_t WS_UC = WS_HF;
constexpr size_t WS_NU = 6 * MiB;
constexpr size_t WS_SC = 7 * MiB;

__device__ __forceinline__ s16x4 lds_tr(LAS unsigned char* p) { return __builtin_amdgcn_ds_read_tr16_b64_v4i16((LAS s16x4*)p); }
__device__ __forceinline__ bf16x8v frag_tr(LAS unsigned char* tile, int pitch, int k0, int n0, int lane) {
    const int g = lane >> 4, q = (lane & 15) >> 2, p = lane & 3;
    LAS unsigned char* a = tile + (k0 + 8 * g + q) * pitch + (n0 + 4 * p) * 2;
    const s16x4 lo = lds_tr(a), hi = lds_tr(a + 4 * pitch);
    return (bf16x8v){lo[0], lo[1], lo[2], lo[3], hi[0], hi[1], hi[2], hi[3]};
}
__device__ __forceinline__ bf16x8v frag_row(LAS unsigned char* tile, int pitch, int m0, int k0, int lane) {
    return *(LAS bf16x8v*)(tile + (m0 + (lane & 15)) * pitch + (k0 + 8 * (lane >> 4)) * 2);
}
__device__ __forceinline__ float log_sigmoid_f(float f) { return fminf(f, 0.f) - log1pf(__expf(-fabsf(f))); }
__device__ __forceinline__ float shfl_up_f(float v, int o, int lane, float ident) { const float t = __shfl_up(v, o); return lane >= o ? t : ident; }

__device__ __forceinline__ void chunk_gates(const float* GATES, int t0, int h, int dir, int lane, int& s0, int& s1, float& i0, float& i1, float& b0, float& b1, float& btot) {
    const int p0 = 2 * lane, p1 = p0 + 1; s0 = dir ? 127 - p0 : p0; s1 = dir ? 127 - p1 : p1;
    const int icol = dir * 8 + h, fcol = icol + 4;
    const float* gp = GATES + (size_t)t0 * 16;
    const float f0 = log_sigmoid_f(gp[s0 * 16 + fcol]), f1 = log_sigmoid_f(gp[s1 * 16 + fcol]);
    i0 = gp[s0 * 16 + icol]; i1 = gp[s1 * 16 + icol];
    const float s = f0 + f1; float inc = s;
#pragma unroll
    for (int o = 1; o < 64; o <<= 1) inc += shfl_up_f(inc, o, lane, 0.f);
    const float excl = inc - s; b0 = excl + f0; b1 = excl + s; btot = __shfl(inc, 63);
}


__device__ __forceinline__ void conv_chunk4(const bf16* P, const float* cw, const float* cb, int b, int sq0, int chan0, float (&o)[4][8]) {
    const bf16* pc = P + ((size_t)b * SEQ + sq0) * NPROJ + C_MLQ + chan0;
    v4u w[8];
#pragma unroll
    for (int j = 0; j < 8; ++j) { const int ss = sq0 + j - 2; w[j] = (ss >= 0 && ss < SEQ) ? *(const v4u*)(pc + (ptrdiff_t)(j - 2) * NPROJ) : (v4u){0u, 0u, 0u, 0u}; }
    const f32x4 b0 = *(const f32x4*)(cb + chan0), b1 = *(const f32x4*)(cb + chan0 + 4);
#pragma unroll
    for (int t = 0; t < 4; ++t) { o[t][0] = b0[0]; o[t][1] = b0[1]; o[t][2] = b0[2]; o[t][3] = b0[3]; o[t][4] = b1[0]; o[t][5] = b1[1]; o[t][6] = b1[2]; o[t][7] = b1[3]; }
#pragma unroll
    for (int j = 0; j < 5; ++j) { const f32x4 c0 = *(const f32x4*)(cw + j * 1024 + chan0), c1 = *(const f32x4*)(cw + j * 1024 + chan0 + 4);
#pragma unroll
        for (int t = 0; t < 4; ++t) { const v4u x = w[t + j];
            o[t][0] += c0[0] * bflo(x.x); o[t][1] += c0[1] * bfhi(x.x); o[t][2] += c0[2] * bflo(x.y); o[t][3] += c0[3] * bfhi(x.y);
            o[t][4] += c1[0] * bflo(x.z); o[t][5] += c1[1] * bfhi(x.z); o[t][6] += c1[2] * bflo(x.w); o[t][7] += c1[3] * bfhi(x.w); } }
#pragma unroll
    for (int t = 0; t < 4; ++t)
#pragma unroll
        for (int i = 0; i < 8; ++i) o[t][i] = o[t][i] / (1.0f + __expf(-o[t][i]));
}

__device__ __forceinline__ void mlstm_m1_unit(int u, const float* cw, const float* cb, const bf16* P, const float* GATES, bf16* UC, float* NU, float* SC, LAS unsigned char* lds, int tid_, int wave) {
    int tid = tid_; asm volatile("" : "+v"(tid)); const int lane = tid & 63;
    const int c = u & 31, h = (u >> 5) & 3, b = u >> 7; const int t0 = b * SEQ + c * ML_L;
    LAS float* WK = (LAS float*)(lds + ML_AR);
    LAS float* NRED = WK + 256;
    __syncthreads();
    if (wave < 2) { const int dir = wave; int s0, s1; float i0, i1, b0, b1, btot;
        chunk_gates(GATES, t0, h, dir, lane, s0, s1, i0, i1, b0, b1, btot);
        const float g0 = btot - b0 + i0, g1 = btot - b1 + i1; const float mloc = wave_max(fmaxf(g0, g1));
        WK[dir * 128 + s0] = __expf(g0 - mloc); WK[dir * 128 + s1] = __expf(g1 - mloc);
        if (lane == 0) { float* sc = SC + (size_t)((((b * 4 + h) * 2 + dir) * 32) + c) * 4; sc[0] = btot; sc[1] = mloc; } }
#pragma unroll
    for (int i = 0; i < 8; ++i) { const int id = tid + 512 * i, s = id >> 5, ch = id & 31;
        *(LAS v4u*)(lds + ML_V + s * VP + ch * 16) = *(const v4u*)(P + (size_t)(t0 + s) * NPROJ + C_MLV + h * 256 + ch * 8); }
    float k4[4][8]; conv_chunk4(P, cw, cb, b, c * ML_L + 4 * (tid >> 4), 512 + h * 128 + (tid & 15) * 8, k4);
    __syncthreads();
    { float nf[8], nb[8];
#pragma unroll
      for (int j = 0; j < 8; ++j) { nf[j] = 0.f; nb[j] = 0.f; }
#pragma unroll
      for (int i = 0; i < 4; ++i) { const int s = 4 * (tid >> 4) + i, ch = tid & 15; const float (&k)[8] = k4[i];
        const float wf = WK[s], wb = WK[128 + s];
        v4u of, ob; of.x = pk2(k[0] * wf, k[1] * wf); of.y = pk2(k[2] * wf, k[3] * wf); of.z = pk2(k[4] * wf, k[5] * wf); of.w = pk2(k[6] * wf, k[7] * wf);
        ob.x = pk2(k[0] * wb, k[1] * wb); ob.y = pk2(k[2] * wb, k[3] * wb); ob.z = pk2(k[4] * wb, k[5] * wb); ob.w = pk2(k[6] * wb, k[7] * wb);
        *(LAS v4u*)(lds + ML_T0 + s * KP + ch * 16) = of; *(LAS v4u*)(lds + ML_T1 + s * KP + ch * 16) = ob;
#pragma unroll
        for (int j = 0; j < 8; ++j) { nf[j] += k[j] * wf; nb[j] += k[j] * wb; } }
#pragma unroll
      for (int j = 0; j < 8; ++j) { nf[j] += __shfl_xor(nf[j], 16); nf[j] += __shfl_xor(nf[j], 32); nb[j] += __shfl_xor(nb[j], 16); nb[j] += __shfl_xor(nb[j], 32); }
      if ((lane >> 4) == 0) {
#pragma unroll
          for (int j = 0; j < 8; ++j) { NRED[wave * 256 + (lane & 15) * 8 + j] = nf[j]; NRED[wave * 256 + 128 + (lane & 15) * 8 + j] = nb[j]; } } }
    __syncthreads();
    if (tid < 256) { const int dir = tid >> 7, d = tid & 127; float sum = 0.f;
#pragma unroll
        for (int w = 0; w < 8; ++w) sum += NRED[w * 256 + tid];
        NU[(size_t)((((b * 4 + h) * 2 + dir) * 32) + c) * 128 + d] = sum; }
    const int g = lane >> 4;
#pragma unroll 1
    for (int dir = 0; dir < 2; ++dir) {
        LAS unsigned char* Kt = lds + (dir ? ML_T1 : ML_T0);
        f32x4 acc[8][2];
#pragma unroll
        for (int mb = 0; mb < 8; ++mb) { acc[mb][0] = (f32x4){0.f, 0.f, 0.f, 0.f}; acc[mb][1] = (f32x4){0.f, 0.f, 0.f, 0.f}; }
#pragma unroll
        for (int ks = 0; ks < 4; ++ks) {
            const bf16x8v b0 = frag_tr(lds + ML_V, VP, 32 * ks, 32 * wave, lane), b1 = frag_tr(lds + ML_V, VP, 32 * ks, 32 * wave + 16, lane);
#pragma unroll
            for (int mb = 0; mb < 8; ++mb) { const bf16x8v a = frag_tr(Kt, KP, 32 * ks, 16 * mb, lane);
                acc[mb][0] = __builtin_amdgcn_mfma_f32_16x16x32_bf16(a, b0, acc[mb][0], 0, 0, 0); acc[mb][1] = __builtin_amdgcn_mfma_f32_16x16x32_bf16(a, b1, acc[mb][1], 0, 0, 0); } }
        bf16* uc = UC + (size_t)((((b * 4 + h) * 2 + dir) * 32) + c) * 32768;
#pragma unroll
        for (int mb = 0; mb < 8; ++mb)
#pragma unroll
            for (int nb = 0; nb < 2; ++nb) { const int e = 32 * wave + 16 * nb + (lane & 15), d0 = 16 * mb + 4 * g; v2u w; w.x = pk2(acc[mb][nb][0], acc[mb][nb][1]); w.y = pk2(acc[mb][nb][2], acc[mb][nb][3]);
                *(v2u*)(uc + e * 128 + d0) = w; }
    }
}

__device__ __forceinline__ void mlstm_m2(bf16* UC, float* NU, float* SC, int gtid, int nthreads) {
    for (int vid = gtid; vid < 32 * 4096; vid += nthreads) { const int chain = vid >> 12, within = vid & 4095, dir = chain & 1;
        float st[8]; float m = 0.f;
#pragma unroll
        for (int i = 0; i < 8; ++i) st[i] = 0.f;
#pragma unroll 1
        for (int s0 = 0; s0 < ML_NC; s0 += 8) {
            v4u uw[8]; float bt[8], ml[8];
#pragma unroll
            for (int k = 0; k < 8; ++k) { const int c = dir ? ML_NC - 1 - (s0 + k) : s0 + k; const float* sc = SC + (size_t)(chain * 32 + c) * 4; bt[k] = sc[0]; ml[k] = sc[1];
                uw[k] = *(const v4u*)(UC + ((size_t)(chain * 32 + c) * 4096 + within) * 8); }
#pragma unroll
            for (int k = 0; k < 8; ++k) { const int c = dir ? ML_NC - 1 - (s0 + k) : s0 + k;
                v4u cw; cw.x = pk2(st[0], st[1]); cw.y = pk2(st[2], st[3]); cw.z = pk2(st[4], st[5]); cw.w = pk2(st[6], st[7]);
                *(v4u*)(UC + ((size_t)(chain * 32 + c) * 4096 + within) * 8) = cw;
                if (within == 0) SC[(size_t)(chain * 32 + c) * 4 + 2] = m;
                const float mn = fmaxf(bt[k] + m, ml[k]), dC = __expf(bt[k] + m - mn), dU = __expf(ml[k] - mn);
                const float uu[8] = {bflo(uw[k].x), bfhi(uw[k].x), bflo(uw[k].y), bfhi(uw[k].y), bflo(uw[k].z), bfhi(uw[k].z), bflo(uw[k].w), bfhi(uw[k].w)};
#pragma unroll
                for (int i = 0; i < 8; ++i) st[i] = dC * st[i] + dU * uu[i];
                m = mn; } } }
    for (int nid = gtid; nid < 32 * 128; nid += nthreads) { const int chain = nid >> 7, d = nid & 127, dir = chain & 1; float st = 0.f, m = 0.f;
#pragma unroll 1
        for (int s0 = 0; s0 < ML_NC; s0 += 8) { float uu[8], bt[8], ml[8];
#pragma unroll
            for (int k = 0; k < 8; ++k) { const int c = dir ? ML_NC - 1 - (s0 + k) : s0 + k; const float* sc = SC + (size_t)(chain * 32 + c) * 4; bt[k] = sc[0]; ml[k] = sc[1]; uu[k] = NU[(size_t)(chain * 32 + c) * 128 + d]; }
#pragma unroll
            for (int k = 0; k < 8; ++k) { const int c = dir ? ML_NC - 1 - (s0 + k) : s0 + k; NU[(size_t)(chain * 32 + c) * 128 + d] = st;
                const float mn = fmaxf(bt[k] + m, ml[k]); st = __expf(bt[k] + m - mn) * st + __expf(ml[k] - mn) * uu[k]; m = mn; } } }
}

__device__ __forceinline__ void mlstm_m3_unit(int u, const float* cw, const float* cb, const bf16* P, const float* GATES, const bf16* UC, const float* NU, const float* SC, const float* mlg, const float* RSNA, bf16* MIX, LAS unsigned char* lds, int tid_, int wave) {
    int tid = tid_; asm volatile("" : "+v"(tid)); const int lane = tid & 63;
    const int c = u & 31, h = (u >> 5) & 3, b = u >> 7; const int t0 = b * SEQ + c * ML_L;
    LAS float* AR = (LAS float*)(lds + ML_AR);
    LAS float* CS = AR; LAS float* RR = AR + 256; LAS float* INTER = AR + 512; LAS float* EM = AR + 768; LAS float* ALPHA = AR + 1024; LAS float* SS = AR + 1280;
    const int g = lane >> 4, lc = lane & 15;
    const int chain0 = (b * 4 + h) * 2;
    __syncthreads();
    if (wave < 2) { const int dir = wave; int s0, s1; float i0, i1, b0, b1, btot;
        chunk_gates(GATES, t0, h, dir, lane, s0, s1, i0, i1, b0, b1, btot);
        const float cs0 = i0 - b0, cs1 = i1 - b1;
        float pmx = fmaxf(cs0, cs1);
#pragma unroll
        for (int o = 1; o < 64; o <<= 1) pmx = fmaxf(pmx, shfl_up_f(pmx, o, lane, -3.0e38f));
        const float ex = shfl_up_f(pmx, 1, lane, -3.0e38f);
        const float pm0 = fmaxf(ex, cs0), pm1 = fmaxf(pm0, cs1);
        const float m_in = SC[(size_t)((chain0 + dir) * 32 + c) * 4 + 2];
        const float M0 = b0 + fmaxf(m_in, pm0), M1 = b1 + fmaxf(m_in, pm1);
        CS[dir * 128 + s0] = cs0; CS[dir * 128 + s1] = cs1; RR[dir * 128 + s0] = b0 - M0; RR[dir * 128 + s1] = b1 - M1;
        INTER[dir * 128 + s0] = __expf(b0 + m_in - M0); INTER[dir * 128 + s1] = __expf(b1 + m_in - M1); EM[dir * 128 + s0] = __expf(-M0); EM[dir * 128 + s1] = __expf(-M1); }
    { const int s0 = 4 * (tid >> 4), ch = tid & 15; float x4[4][8];
      conv_chunk4(P, cw, cb, b, c * ML_L + s0, h * 128 + ch * 8, x4);
      const float qs = 0.08838834764831845f;
#pragma unroll
      for (int i = 0; i < 4; ++i) { v4u oq; oq.x = pk2(x4[i][0] * qs, x4[i][1] * qs); oq.y = pk2(x4[i][2] * qs, x4[i][3] * qs); oq.z = pk2(x4[i][4] * qs, x4[i][5] * qs); oq.w = pk2(x4[i][6] * qs, x4[i][7] * qs);
          *(LAS v4u*)(lds + ML_T0 + (s0 + i) * KP + ch * 16) = oq; }
      conv_chunk4(P, cw, cb, b, c * ML_L + s0, 512 + h * 128 + ch * 8, x4);
#pragma unroll
      for (int i = 0; i < 4; ++i) { v4u ok; ok.x = pk2(x4[i][0], x4[i][1]); ok.y = pk2(x4[i][2], x4[i][3]); ok.z = pk2(x4[i][4], x4[i][5]); ok.w = pk2(x4[i][6], x4[i][7]);
          *(LAS v4u*)(lds + ML_T1 + (s0 + i) * KP + ch * 16) = ok; } }
#pragma unroll
    for (int i = 0; i < 8; ++i) { const int id = tid + 512 * i, s = id >> 5, ch = id & 31;
        *(LAS v4u*)(lds + ML_V + s * VP + ch * 16) = *(const v4u*)(P + (size_t)(t0 + s) * NPROJ + C_MLV + h * 256 + ch * 8); }
    __syncthreads();
    f32x4 S[8], qn = (f32x4){0.f, 0.f, 0.f, 0.f};
#pragma unroll
    for (int nb = 0; nb < 8; ++nb) S[nb] = (f32x4){0.f, 0.f, 0.f, 0.f};
#pragma unroll
    for (int ks = 0; ks < 4; ++ks) { const bf16x8v a = frag_row(lds + ML_T0, KP, 16 * wave, 32 * ks, lane);
        bf16x8v nf = (bf16x8v){0, 0, 0, 0, 0, 0, 0, 0};
        if (lc < 2) { const float* np = NU + (size_t)((chain0 + lc) * 32 + c) * 128 + 32 * ks + 8 * g; const f32x4 n0 = *(const f32x4*)np, n1 = *(const f32x4*)(np + 4);
            const unsigned w0 = pk2(n0[0], n0[1]), w1 = pk2(n0[2], n0[3]), w2 = pk2(n1[0], n1[1]), w3 = pk2(n1[2], n1[3]);
            nf = (bf16x8v){(short)(w0 & 0xffff), (short)(w0 >> 16), (short)(w1 & 0xffff), (short)(w1 >> 16), (short)(w2 & 0xffff), (short)(w2 >> 16), (short)(w3 & 0xffff), (short)(w3 >> 16)}; }
        qn = __builtin_amdgcn_mfma_f32_16x16x32_bf16(a, nf, qn, 0, 0, 0);
#pragma unroll
        for (int nb = 0; nb < 8; ++nb) { const bf16x8v kb = frag_row(lds + ML_T1, KP, 16 * nb, 32 * ks, lane); S[nb] = __builtin_amdgcn_mfma_f32_16x16x32_bf16(a, kb, S[nb], 0, 0, 0); } }
    float csf[8], csb[8];
#pragma unroll
    for (int nb = 0; nb < 8; ++nb) { csf[nb] = CS[16 * nb + lc]; csb[nb] = CS[128 + 16 * nb + lc]; }
    float pc[8][4];
#pragma unroll
    for (int r = 0; r < 4; ++r) { const int j = 16 * wave + 4 * g + r; const float Rf = RR[j], Rb = RR[128 + j];
        const float qnf = __shfl(qn[r], 16 * g), qnb = __shfl(qn[r], 16 * g + 1);
        float sf[8], sb[8], rsf = 0.f, rsb = 0.f;
#pragma unroll
        for (int nb = 0; nb < 8; ++nb) { const int s = 16 * nb + lc; const float wf = s <= j ? __expf(Rf + csf[nb]) : 0.f, wb = s >= j ? __expf(Rb + csb[nb]) : 0.f;
            sf[nb] = S[nb][r] * wf; sb[nb] = S[nb][r] * wb; rsf += sf[nb]; rsb += sb[nb]; }
        rsf = row16_sum(rsf); rsb = row16_sum(rsb);
        const float inf_ = INTER[j], inb_ = INTER[128 + j];
        const float ivf = 1.0f / fmaxf(fabsf(inf_ * qnf + rsf), EM[j]), ivb = 1.0f / fmaxf(fabsf(inb_ * qnb + rsb), EM[128 + j]);
#pragma unroll
        for (int nb = 0; nb < 8; ++nb) pc[nb][r] = sf[nb] * ivf + sb[nb] * ivb;
        if (lc == 0) { ALPHA[j] = inf_ * ivf; ALPHA[128 + j] = inb_ * ivb; } }
    __syncthreads();
#pragma unroll
    for (int r = 0; r < 4; ++r) { const int j = 16 * wave + 4 * g + r;
#pragma unroll
        for (int nb = 0; nb < 8; ++nb) *(LAS unsigned short*)(lds + ML_T1 + j * KP + (16 * nb + lc) * 2) = (unsigned short)f2bf(pc[nb][r]); }
    __syncthreads();
    f32x4 acc[2][8], acc2[2][8];
#pragma unroll
    for (int mb = 0; mb < 2; ++mb)
#pragma unroll
        for (int nb = 0; nb < 8; ++nb) { acc[mb][nb] = (f32x4){0.f, 0.f, 0.f, 0.f}; acc2[mb][nb] = (f32x4){0.f, 0.f, 0.f, 0.f}; }
    const bf16* ucf = UC + (size_t)((chain0 + 0) * 32 + c) * 32768 + (size_t)(32 * wave + lc) * 128 + 8 * g;
    const bf16* ucb = UC + (size_t)((chain0 + 1) * 32 + c) * 32768 + (size_t)(32 * wave + lc) * 128 + 8 * g;
#pragma unroll
    for (int ks = 0; ks < 4; ++ks) {
        const bf16x8v af0 = *(const bf16x8v*)(ucf + 32 * ks), af1 = *(const bf16x8v*)(ucf + 16 * 128 + 32 * ks), ab0 = *(const bf16x8v*)(ucb + 32 * ks), ab1 = *(const bf16x8v*)(ucb + 16 * 128 + 32 * ks);
#pragma unroll
        for (int nb = 0; nb < 8; ++nb) { const bf16x8v qb = frag_row(lds + ML_T0, KP, 16 * nb, 32 * ks, lane);
            acc[0][nb] = __builtin_amdgcn_mfma_f32_16x16x32_bf16(af0, qb, acc[0][nb], 0, 0, 0); acc[1][nb] = __builtin_amdgcn_mfma_f32_16x16x32_bf16(af1, qb, acc[1][nb], 0, 0, 0);
            acc2[0][nb] = __builtin_amdgcn_mfma_f32_16x16x32_bf16(ab0, qb, acc2[0][nb], 0, 0, 0); acc2[1][nb] = __builtin_amdgcn_mfma_f32_16x16x32_bf16(ab1, qb, acc2[1][nb], 0, 0, 0); } }
#pragma unroll
    for (int nb = 0; nb < 8; ++nb) { const float af = ALPHA[16 * nb + lc], ab = ALPHA[128 + 16 * nb + lc];
        acc[0][nb] = acc[0][nb] * af + acc2[0][nb] * ab; acc[1][nb] = acc[1][nb] * af + acc2[1][nb] * ab; }
#pragma unroll
    for (int ks = 0; ks < 4; ++ks) {
        const bf16x8v v0 = frag_tr(lds + ML_V, VP, 32 * ks, 32 * wave, lane), v1 = frag_tr(lds + ML_V, VP, 32 * ks, 32 * wave + 16, lane);
#pragma unroll
        for (int nb = 0; nb < 8; ++nb) { const bf16x8v pb = frag_row(lds + ML_T1, KP, 16 * nb, 32 * ks, lane);
            acc[0][nb] = __builtin_amdgcn_mfma_f32_16x16x32_bf16(v0, pb, acc[0][nb], 0, 0, 0); acc[1][nb] = __builtin_amdgcn_mfma_f32_16x16x32_bf16(v1, pb, acc[1][nb], 0, 0, 0); } }
    v2u ogate[2][8]; f32x4 gg2[2];
#pragma unroll
    for (int mb = 0; mb < 2; ++mb) { gg2[mb] = *(const f32x4*)(mlg + h * 256 + 32 * wave + 16 * mb + 4 * g);
#pragma unroll
        for (int nb = 0; nb < 8; ++nb) ogate[mb][nb] = *(const v2u*)(P + (size_t)(t0 + 16 * nb + lc) * NPROJ + C_MLO + h * 256 + 32 * wave + 16 * mb + 4 * g); }
    float rsna[8];
#pragma unroll
    for (int nb = 0; nb < 8; ++nb) rsna[nb] = RSNA[t0 + 16 * nb + lc];
#pragma unroll
    for (int nb = 0; nb < 8; ++nb) { float ss = 0.f;
#pragma unroll
        for (int mb = 0; mb < 2; ++mb) ss += (acc[mb][nb][0] * acc[mb][nb][0] + acc[mb][nb][1] * acc[mb][nb][1]) + (acc[mb][nb][2] * acc[mb][nb][2] + acc[mb][nb][3] * acc[mb][nb][3]);
        ss = rows4_sum(ss);
        if (g == 0) SS[wave * 128 + 16 * nb + lc] = ss; }
    __syncthreads();
#pragma unroll
    for (int nb = 0; nb < 8; ++nb) { const int j = 16 * nb + lc; float tot = 0.f;
#pragma unroll
        for (int w = 0; w < 8; ++w) tot += SS[w * 128 + j];
        const float rstd = 1.0f / (sqrtf(tot * (1.0f / 256.0f) + EPS) * rsna[nb]);
#pragma unroll
        for (int mb = 0; mb < 2; ++mb) { const int e0 = 32 * wave + 16 * mb + 4 * g; const size_t t = (size_t)(t0 + j);
            const v2u ow = ogate[mb][nb]; const f32x4 gg = gg2[mb];
            const float o[4] = {bflo(ow.x), bfhi(ow.x), bflo(ow.y), bfhi(ow.y)}; float rr[4];
#pragma unroll
            for (int r = 0; r < 4; ++r) rr[r] = acc[mb][nb][r] * rstd * gg[r] / (1.0f + __expf(-o[r]));
            v2u w; w.x = pk2(rr[0], rr[1]); w.y = pk2(rr[2], rr[3]);
            *(v2u*)(MIX + t * D + 1024 + h * 256 + e0) = w; } }
}


#ifndef NA_PROBE
#define NA_PROBE 0
#endif
constexpr int NA_TILE = 64 * KP, NA_BUF = 2 * NA_TILE, NA_RPB = 2 * NA_BUF;
static_assert(NA_RPB + 15 * 128 * 4 <= ML_END, "LDS map");
__device__ __forceinline__ bf16x8v frag_tr2(LAS unsigned char* tile, int pitch, int row0, int row1, int n0, int lane) {
    const int q = (lane & 15) >> 2, p = lane & 3;
    const s16x4 lo = lds_tr(tile + (row0 + q) * pitch + (n0 + 4 * p) * 2), hi = lds_tr(tile + (row1 + q) * pitch + (n0 + 4 * p) * 2);
    return (bf16x8v){lo[0], lo[1], lo[2], lo[3], hi[0], hi[1], hi[2], hi[3]};
}
__device__ __forceinline__ void na_unit(int u, const bf16* P, const float* rpb, bf16* MIX, float* SSQ, LAS unsigned char* lds, int tid_, int wave) {
    int tid = tid_; asm volatile("" : "+v"(tid)); const int lane = tid & 63, g = lane >> 4, lc = lane & 15;
    const int r4 = u & 15, h = (u >> 4) & 7, b = u >> 7;
    const int r0 = 4 * r4, r = r0 + (wave >> 1), qh = wave & 1;
    const int rs = min(max(r - 4, 0), 56), rs0 = min(max(r0 - 4, 0), 56), nk = min(max(r0 + 3 - 4, 0), 56) + 8 - rs0;
    LAS float* RPB = (LAS float*)(lds + NA_RPB);
    const int sA = tid >> 4, chA = tid & 15, sB = sA + 32;
    const bf16* gsrc = P + ((size_t)b * SEQ + rs0 * 64) * NPROJ + h * 128 + chA * 8;
    v4u pk0, pk1, pv0, pv1;
#define NA_LOAD(j) do { const bf16* s_ = gsrc + (size_t)(j) * 64 * NPROJ; pk0 = *(const v4u*)(s_ + (size_t)sA * NPROJ + C_NAK); pk1 = *(const v4u*)(s_ + (size_t)sB * NPROJ + C_NAK); \
        pv0 = *(const v4u*)(s_ + (size_t)sA * NPROJ + C_NAV); pv1 = *(const v4u*)(s_ + (size_t)sB * NPROJ + C_NAV); } while (0)
#define NA_STORE(buf) do { LAS unsigned char* t_ = lds + (buf) * NA_BUF; *(LAS v4u*)(t_ + sA * KP + chA * 16) = pk0; *(LAS v4u*)(t_ + sB * KP + chA * 16) = pk1; \
        *(LAS v4u*)(t_ + NA_TILE + sA * KP + chA * 16) = pv0; *(LAS v4u*)(t_ + NA_TILE + sB * KP + chA * 16) = pv1; } while (0)
    NA_LOAD(0);
    __syncthreads();
    for (int i = tid; i < 15 * 128; i += 512) { const int dr = i >> 7, x = (i & 127) - 48; RPB[i] = (x >= 0 && x < 31) ? rpb[h * 465 + dr * 31 + x] * 1.4426950408889634f : 0.f; }
    NA_STORE(0);
    bf16x8v qf[2][4]; int cq[2], cs[2], boff[2]; float m[2], l[2]; f32x4 O[2][8]; f32x4 madd[2][4];
#pragma unroll
    for (int qi = 0; qi < 2; ++qi) { cq[qi] = 32 * qh + 16 * qi + lc; cs[qi] = min(max(cq[qi] - 8, 0), 48); m[qi] = -1.0e30f; l[qi] = 0.f; boff[qi] = 63 - cq[qi] + 4 * g;
#pragma unroll
        for (int kb = 0; kb < 4; ++kb)
#pragma unroll
            for (int rr = 0; rr < 4; ++rr) { const int kc = 16 * kb + 4 * g + rr; madd[qi][kb][rr] = (kc >= cs[qi] && kc < cs[qi] + 16) ? 0.f : -1.0e30f; }
        const bf16* qp = P + ((size_t)b * SEQ + r * 64 + cq[qi]) * NPROJ + C_NAQ + h * 128 + 8 * g;
#pragma unroll
        for (int ks = 0; ks < 4; ++ks) qf[qi][ks] = *(const bf16x8v*)(qp + 32 * ks);
#pragma unroll
        for (int db = 0; db < 8; ++db) O[qi][db] = (f32x4){0.f, 0.f, 0.f, 0.f}; }
    __syncthreads();
#pragma unroll 1
    for (int j = 0; j < nk; ++j) {
        const int kr = rs0 + j;
        if (j + 1 < nk) NA_LOAD(j + 1);
        if (kr >= rs && kr < rs + 8) {
            LAS unsigned char* Kt = lds + (j & 1) * NA_BUF; LAS unsigned char* Vt = Kt + NA_TILE;
            const LAS float* brow = RPB + (kr - r + 7) * 128;
            const int kb0a = qh ? 1 : 0, kb1a = qh ? 3 : 1, kb0b = qh ? 2 : 0, kb1b = qh ? 3 : 2;
            f32x4 s[2][4];
#if NA_PROBE == 1
            for (int prb = 0; prb < 2; ++prb) { asm volatile("" ::: "memory");
#else
            {
#endif
#pragma unroll
            for (int kb = 0; kb < 4; ++kb) { s[0][kb] = (f32x4){0.f, 0.f, 0.f, 0.f}; s[1][kb] = (f32x4){0.f, 0.f, 0.f, 0.f}; }
#pragma unroll
            for (int kb = 0; kb < 4; ++kb) { const bool ua = kb >= kb0a && kb <= kb1a, ub = kb >= kb0b && kb <= kb1b;
                if (ua || ub) {
#pragma unroll
                    for (int ks = 0; ks < 4; ++ks) { const bf16x8v ka = frag_row(Kt, KP, 16 * kb, 32 * ks, lane);
                        if (ua) s[0][kb] = __builtin_amdgcn_mfma_f32_16x16x32_bf16(ka, qf[0][ks], s[0][kb], 0, 0, 0);
                        if (ub) s[1][kb] = __builtin_amdgcn_mfma_f32_16x16x32_bf16(ka, qf[1][ks], s[1][kb], 0, 0, 0); } } }
            }
            bf16x8v pb[2][2];
#pragma unroll
            for (int qi = 0; qi < 2; ++qi) {
                const int k0 = qi ? kb0b : kb0a, k1 = qi ? kb1b : kb1a; const LAS float* bq = brow + boff[qi];
                float mx = -1.0e30f;
#pragma unroll
                for (int kb = 0; kb < 4; ++kb) if (kb >= k0 && kb <= k1) {
#pragma unroll
                    for (int rr = 0; rr < 4; ++rr) { const float v = s[qi][kb][rr] * 0.12753785f + bq[16 * kb + rr] + madd[qi][kb][rr]; s[qi][kb][rr] = v; mx = fmaxf(mx, v); } }
                mx = rows4_max(mx);
                const float mn = fmaxf(m[qi], mx); float ls = 0.f;
#pragma unroll
                for (int kb = 0; kb < 4; ++kb) { if (kb >= k0 && kb <= k1) {
#pragma unroll
                    for (int rr = 0; rr < 4; ++rr) { const float p = __builtin_amdgcn_exp2f(s[qi][kb][rr] - mn); s[qi][kb][rr] = p; ls += p; } } else s[qi][kb] = (f32x4){0.f, 0.f, 0.f, 0.f}; }
                ls = rows4_sum(ls);
                if (!__all(mn == m[qi])) { const float corr = __builtin_amdgcn_exp2f(m[qi] - mn); l[qi] *= corr;
#pragma unroll
                    for (int db = 0; db < 8; ++db) O[qi][db] = O[qi][db] * corr; }
                l[qi] += ls; m[qi] = mn;
#pragma unroll
                for (int t = 0; t < 2; ++t) { v4u pw; pw.x = pk2(s[qi][2 * t][0], s[qi][2 * t][1]); pw.y = pk2(s[qi][2 * t][2], s[qi][2 * t][3]); pw.z = pk2(s[qi][2 * t + 1][0], s[qi][2 * t + 1][1]); pw.w = pk2(s[qi][2 * t + 1][2], s[qi][2 * t + 1][3]);
                    pb[qi][t] = __builtin_bit_cast(bf16x8v, pw); }
            }
#if NA_PROBE == 2
            for (int prb = 0; prb < 2; ++prb) { asm volatile("" ::: "memory"); if (prb) { pb[0][0] = pb[0][1] = pb[1][0] = pb[1][1] = (bf16x8v){0, 0, 0, 0, 0, 0, 0, 0}; }
#else
            {
#endif
#pragma unroll
            for (int t = 0; t < 2; ++t) { const bool ua = 2 * t + 1 >= kb0a && 2 * t <= kb1a, ub = 2 * t + 1 >= kb0b && 2 * t <= kb1b;
                if (ua || ub) {
#pragma unroll
                    for (int db = 0; db < 8; ++db) { const bf16x8v va = frag_tr2(Vt, KP, 32 * t + 4 * g, 32 * t + 16 + 4 * g, 16 * db, lane);
                        if (ua) O[0][db] = __builtin_amdgcn_mfma_f32_16x16x32_bf16(va, pb[0][t], O[0][db], 0, 0, 0);
                        if (ub) O[1][db] = __builtin_amdgcn_mfma_f32_16x16x32_bf16(va, pb[1][t], O[1][db], 0, 0, 0); } } }
            }
        }
#if NA_PROBE == 4
        if (j + 1 < nk) { NA_STORE((j + 1) & 1); asm volatile("" ::: "memory"); }
#endif
#if NA_PROBE == 5
        __syncthreads();
#endif
        if (j + 1 < nk) NA_STORE((j + 1) & 1);
        __syncthreads();
    }
#pragma unroll
    for (int qi = 0; qi < 2; ++qi) { const float inv = 1.0f / l[qi]; const size_t t = (size_t)b * SEQ + r * 64 + cq[qi]; bf16* op = MIX + t * D + h * 128 + 4 * g; float ss = 0.f;
#pragma unroll
        for (int db = 0; db < 8; ++db) { const f32x4 o = O[qi][db] * inv; ss += (o[0] * o[0] + o[1] * o[1]) + (o[2] * o[2] + o[3] * o[3]); v2u w; w.x = pk2(o[0], o[1]); w.y = pk2(o[2], o[3]); *(v2u*)(op + 16 * db) = w; }
        ss = rows4_sum(ss);
        if (g == 0) SSQ[t * 8 + h] = ss; }
#undef NA_LOAD
#undef NA_STORE
}


constexpr int NWAVES = 8;
#ifndef NCONV
#define NCONV 112
#endif
constexpr int RING_BYTES = 131072;
constexpr int LDSCTL_OFF = ML_END, MISC_OFF = LDSCTL_OFF + 320;
constexpr int LDS_BYTES = LDSCTL_OFF + 1024;
static_assert(ML_END >= RING_BYTES && LDS_BYTES <= 163840, "LDS map");
constexpr int CW_BAR = 4096;
constexpr size_t CTL_ZERO_BYTES = 65536;
static_assert((CW_BAR + XCD_BAR_WORDS) * 4 <= (int)CTL_ZERO_BYTES, "barrier words inside the memset region");

struct MKArgs { const float* in[16]; float* out; unsigned char* ws; };
__global__ void __launch_bounds__(NWAVES * 64, 2) mk_fwd(MKArgs args) {
    extern __shared__ __attribute__((aligned(16))) unsigned char lds_raw[];
    LAS unsigned char* lds = (LAS unsigned char*)lds_raw;
    volatile LAS unsigned* MISC = (volatile LAS unsigned*)(lds + MISC_OFF);
    const int tid = threadIdx.x, lane0 = tid & 63, wave = __builtin_amdgcn_readfirstlane(tid >> 6);
    const int G = gridDim.x; const int bx = blockIdx.x; const int vcu = (G % 8 == 0) ? (bx % 8) * (G / 8) + bx / 8 : bx;
    const int gw0 = vcu * NWAVES + wave, ngw = G * NWAVES;
    unsigned char* ws = args.ws;
    for (int u = tid; u < (LDS_BYTES - LDSCTL_OFF) / 4; u += NWAVES * 64) ((LAS unsigned*)(lds + LDSCTL_OFF))[u] = 0u;
    __syncthreads();
    XcdBarrier bar = xcd_barrier_post((unsigned*)(ws + WS_CTL) + CW_BAR, MISC + 8);
#define GRID_BAR() do { XcdBarrier b_ = bar; asm volatile("" : "+s"(b_.bar), "+s"(b_.x)); xcd_barrier(b_); } while (0)
    const float* x = args.in[0]; const float* norm_mix_g = args.in[1]; const float* w_in = args.in[2]; const float* b_gates = args.in[3];
    const float* conv_w = args.in[4]; const float* conv_b = args.in[5]; const float* na_rpb = args.in[6]; const float* na_norm_g = args.in[7];
    const float* ml_norm_g = args.in[8]; const float* w_out = args.in[9]; const float* norm_ffn_g = args.in[10]; const float* w_router = args.in[11];
    const float* w_gate = args.in[12]; const float* w_up = args.in[13]; const float* w_down = args.in[14]; const float* final_norm_g = args.in[15];
#define WSPTRS(wsl, Xl) float* X = (Xl); float* RSTD = (float*)((wsl) + WS_RSTD); float* GATES = (float*)((wsl) + WS_GATES); float* AFF = (float*)((wsl) + WS_AFF); int* TOK = (int*)((wsl) + WS_TOK); float* GATEV = (float*)((wsl) + WS_GATEV); int* SEL = (int*)((wsl) + WS_SEL); \
    bf16* XB = (bf16*)((wsl) + WS_XB); bf16* MIX = (bf16*)((wsl) + WS_MIX); bf16* P = (bf16*)((wsl) + WS_P); bf16* NAO = (bf16*)((wsl) + WS_NAO); bf16* ACT = (bf16*)((wsl) + WS_ACT); bf16* Y = (bf16*)((wsl) + WS_Y); \
    (void)X; (void)RSTD; (void)GATES; (void)AFF; (void)TOK; (void)GATEV; (void)SEL; (void)XB; (void)MIX; (void)P; (void)NAO; (void)ACT; (void)Y;
#define LAUNDER(p) asm volatile("" : "+s"(p))
#ifndef REP_MASK
#define REP_MASK 0
#endif
#if (REP_MASK >> 0) & 1
#define REP0 for (int rep_ = 0; rep_ < 2; ++rep_)
#else
#define REP0
#endif
#if (REP_MASK >> 1) & 1
#define REP1 for (int rep_ = 0; rep_ < 2; ++rep_)
#else
#define REP1
#endif
#if (REP_MASK >> 2) & 1
#define REP2 for (int rep_ = 0; rep_ < 2; ++rep_)
#else
#define REP2
#endif
#if (REP_MASK >> 3) & 1
#define REP3 for (int rep_ = 0; rep_ < 2; ++rep_)
#else
#define REP3
#endif
#if (REP_MASK >> 4) & 1
#define REP4 for (int rep_ = 0; rep_ < 2; ++rep_)
#else
#define REP4
#endif
#if (REP_MASK >> 5) & 1
#define REP5 for (int rep_ = 0; rep_ < 2; ++rep_)
#else
#define REP5
#endif
#if (REP_MASK >> 6) & 1
#define REP6 for (int rep_ = 0; rep_ < 2; ++rep_)
#else
#define REP6
#endif
#if (REP_MASK >> 7) & 1
#define REP7 for (int rep_ = 0; rep_ < 2; ++rep_)
#else
#define REP7
#endif
#if (REP_MASK >> 8) & 1
#define REP8 for (int rep_ = 0; rep_ < 2; ++rep_)
#else
#define REP8
#endif
#if (REP_MASK >> 9) & 1
#define REP9 for (int rep_ = 0; rep_ < 2; ++rep_)
#else
#define REP9
#endif
#if (REP_MASK >> 10) & 1
#define REP10 for (int rep_ = 0; rep_ < 2; ++rep_)
#else
#define REP10
#endif
#if (REP_MASK >> 11) & 1
#define REP11 for (int rep_ = 0; rep_ < 2; ++rep_)
#else
#define REP11
#endif
#if (REP_MASK >> 12) & 1
#define REP12 for (int rep_ = 0; rep_ < 2; ++rep_)
#else
#define REP12
#endif
#if (REP_MASK >> 13) & 1
#define REP13 for (int rep_ = 0; rep_ < 2; ++rep_)
#else
#define REP13
#endif

    { WSPTRS(ws, args.out)
      const int lane = lane0, gw = gw0;
    REP0 { ConvArgs ca; ca.w_in = w_in; ca.w_out = w_out; ca.w_gate = w_gate; ca.w_up = w_up; ca.w_down = w_down; ca.norm_mix_g = norm_mix_g; ca.norm_ffn_g = norm_ffn_g; ca.na_norm_g = na_norm_g; ca.ws = ws;
      LAS float* scr = (LAS float*)(lds + wave * CONV_SCR_BYTES);
      if (G == 256) convert_stream(ca, gw, ngw, CI_IN, scr, lane);
      else convert_stream(ca, gw, ngw, DEPTH * CI_LAYER, scr, lane); }
    { bf16* W16F = (bf16*)(ws + WS_W16F_OFF);
      for (int it = gw; it < DEPTH * 2 * 64; it += ngw) { const int mi = it >> 6, s = it & 63, l = mi >> 1;
          if (mi & 1) w16f_item(w_router + (size_t)l * D * NE, NE, norm_ffn_g + l * D, W16F + (size_t)mi * 32768, s, lane);
          else w16f_item(w_in + (size_t)l * D * NIN + C_GATES, NIN, norm_mix_g + l * D, W16F + (size_t)mi * 32768, s, lane); } }
    GRID_BAR();
    REP1 { RowArgs a; a.src32 = x; a.srcb = nullptr; a.sel = nullptr; a.Y = nullptr; a.XB = XB; a.XB8 = ws + WS_XB8; a.RSTD = RSTD; a.g = norm_mix_g; a.W16F = (const bf16*)(ws + WS_W16F_OFF); a.bias = b_gates; a.GATES = GATES; a.AFF = AFF; a.out = X; a.mode = 0; a.wrxb = 1;
      for (int grp = gw; grp < MTOK / 8; grp += ngw) rowpass_group<true>(a, grp, lane); } }
    GRID_BAR();

    for (int l = 0; l < DEPTH; ++l) {
        unsigned char* wsl = ws; float* Xl = args.out; LAUNDER(wsl); LAUNDER(Xl);
        WSPTRS(wsl, Xl)
        int lane = lane0, gw = gw0; asm volatile("" : "+v"(lane)); LAUNDER(gw);
        const bf16* WinT = (const bf16*)(wsl + WS_WIN) + (size_t)l * NPROJ * D; const bf16* WoutT = (const bf16*)(wsl + WS_WOUT) + (size_t)l * D * D;
        const bf16* WguT = (const bf16*)(wsl + WS_WGU) + (size_t)l * NE * 2048 * D; const bf16* WdT = (const bf16*)(wsl + WS_WD) + (size_t)l * NE * D * DE;
        const int Gg = (l == 0 && G == 256) ? G - NCONV : G;
        if (bx >= Gg) { ConvArgs ca; ca.w_in = w_in; ca.w_out = w_out; ca.w_gate = w_gate; ca.w_up = w_up; ca.w_down = w_down; ca.norm_mix_g = norm_mix_g; ca.norm_ffn_g = norm_ffn_g; ca.na_norm_g = na_norm_g; ca.ws = wsl;
          convert_stream(ca, CI_IN + (bx - Gg) * NWAVES + wave, NCONV * NWAVES, DEPTH * CI_LAYER, (LAS float*)(lds + wave * CONV_SCR_BYTES), lane); }
        else {
        REP2 { pg8::Gemm g{XB, WinT, MTOK, NPROJ16, D, 0}; pg8::StaticOrder S; S.init(MTOK, NPROJ16, Gg, bx); pg8::EpiRowScaleBf16 E{P, RSTD, nullptr, NPROJ, 0, 1.0f, 0};
          pg8::gemm_phase<pg8::EpiRowScaleBf16, pg8::StaticOrder, true, true>(lds, g, S, E); }
        { pg8::Gemm g{(const bf16*)(wsl + WS_XB8), (const bf16*)(wsl + WS_WIN + ((size_t)l * NPROJ + NPROJ16) * D * 2), MTOK, NPROJ - NPROJ16, D / 2, 0}; pg8::StaticOrder S; S.init(MTOK, NPROJ - NPROJ16, Gg, bx);
          pg8::EpiRowScaleBf16 E{P + NPROJ16, RSTD, nullptr, NPROJ, 0, 1.0f / W8_SCALE, 0};
          pg8::gemm_phase<pg8::EpiRowScaleBf16, pg8::StaticOrder, true, true, true>(lds, g, S, E); }
        }
        GRID_BAR();
        REP4 for (int u = vcu; u < 512; u += G) na_unit(u, P, na_rpb + (size_t)l * 8 * 15 * 31, MIX, (float*)(wsl + WS_SSQ), lds, tid, wave);
        { bf16* UC = (bf16*)(wsl + WS_UC); float* NU = (float*)(wsl + WS_NU); float* SC = (float*)(wsl + WS_SC); const float* cwl = conv_w + (size_t)l * 5 * 1024; const float* cbl = conv_b + l * 1024;
          int tidl = tid; asm volatile("" : "+v"(tidl));
          REP5 for (int u = bx; u < 512; u += G) mlstm_m1_unit(u, cwl, cbl, P, GATES, UC, NU, SC, lds, tidl, wave);
          GRID_BAR();
          mlstm_m2(UC, NU, SC, vcu * 512 + tidl, G * 512);
          { const float* ssq = (const float*)(wsl + WS_SSQ); float* rsna = (float*)(wsl + WS_RSNA);
            for (int t = vcu * 512 + tidl; t < MTOK; t += G * 512) { const f32x4 s0 = *(const f32x4*)(ssq + (size_t)t * 8), s1 = *(const f32x4*)(ssq + (size_t)t * 8 + 4);
                rsna[t] = 1.0f / sqrtf(((s0[0] + s0[1]) + (s0[2] + s0[3]) + (s1[0] + s1[1]) + (s1[2] + s1[3])) * (1.0f / 1024.0f) + EPS); } }
          GRID_BAR();
          REP7 for (int u = bx; u < 512; u += G) mlstm_m3_unit(u, cwl, cbl, P, GATES, UC, NU, SC, ml_norm_g + l * 1024, (const float*)(wsl + WS_RSNA), MIX, lds, tidl, wave); }
        GRID_BAR();
#if (REP_MASK >> 8) & 1
        for (int rep_ = 0; rep_ < 2; ++rep_)
#endif
        { pg8::Gemm g{MIX, WoutT, MTOK, D, D, 0}; pg8::StaticOrder S; S.init(MTOK, D, G, bx); pg8::EpiResidBf16 E{XB, (const float*)(wsl + WS_RSNA), D, 0};
#if (REP_MASK >> 8) & 1
          if (rep_ == 0) E.XB = P;
#endif
          pg8::gemm_phase<pg8::EpiResidBf16, pg8::StaticOrder, true, true>(lds, g, S, E); }
        GRID_BAR();
        REP9 { RowArgs a; a.src32 = nullptr; a.srcb = XB; a.sel = nullptr; a.Y = nullptr; a.XB = XB; a.XB8 = wsl + WS_XB8; a.RSTD = RSTD; a.g = norm_ffn_g + l * D; a.W16F = (const bf16*)(wsl + WS_W16F_OFF) + (size_t)(2 * l + 1) * 32768; a.bias = b_gates; a.GATES = GATES; a.AFF = AFF; a.out = X; a.mode = 1; a.wrxb = 0;
          for (int grp = gw; grp < MTOK / 8; grp += ngw) rowpass_group<false>(a, grp, lane); }
        GRID_BAR();
        REP10 for (int be = bx; be < BATCH * NE; be += G) topk_unit(be, AFF, TOK, GATEV, SEL, (LAS int*)lds);
        GRID_BAR();
        REP12 { pg8::Gemm g{(const bf16*)(wsl + WS_XB8), (const bf16*)(wsl + WS_WGU + (size_t)l * NE * 2048 * D), MR, 2048, D / 2, 0}; pg8::GroupedGatherOrder S{TOK, G, bx};
          pg8::EpiSwiGLU8 E{(unsigned char*)ACT, RSTD, TOK, DE, 8, 1.0f / W8_SCALE, 0};
          pg8::gemm_phase_gather<pg8::EpiSwiGLU8, pg8::GroupedGatherOrder, true, true, true>(lds, g, S, E); }
        GRID_BAR();
        REP13 { pg8::Gemm g{ACT, (const bf16*)(wsl + WS_WD + (size_t)l * NE * D * DE), MR, 2048, DE / 2, 0}; pg8::GroupedOrder S{nullptr, G, bx}; pg8::EpiRowScaleF8 E{(unsigned char*)Y, GATEV, D, 8, Y8_SCALE / W8_SCALE, 0};
          pg8::gemm_phase<pg8::EpiRowScaleF8, pg8::GroupedOrder, true, true, true>(lds, g, S, E); }
        GRID_BAR();
        { RowArgs a; a.src32 = nullptr; a.srcb = XB; a.sel = SEL; a.Y = (const unsigned char*)Y; a.XB = XB; a.XB8 = wsl + WS_XB8; a.RSTD = RSTD; a.bias = b_gates + (l + 1 < DEPTH ? (l + 1) * 16 : 0); a.GATES = GATES; a.AFF = AFF; a.out = X; a.wrxb = 1;
          a.W16F = (const bf16*)(wsl + WS_W16F_OFF) + (size_t)(2 * (l + 1 < DEPTH ? l + 1 : 0)) * 32768;
          if (l + 1 < DEPTH) { a.g = norm_mix_g + (l + 1) * D; a.mode = 0; }
          else { a.g = final_norm_g; a.mode = 2; }
          for (int grp = gw; grp < MTOK / 8; grp += ngw) rowpass_group<false>(a, grp, lane); }
        if (l + 1 < DEPTH) GRID_BAR();
    }
#undef GRID_BAR
#undef WSPTRS
}

extern "C" void kernel_launch(void* const* d_in, const int* in_sizes, int n_in, void* d_out, int out_size, void* d_ws, size_t ws_size, hipStream_t stream) {
    static int grid = 0;
    if (grid == 0) {
        if (n_in != 16 || ws_size < WS_END) { fprintf(stderr, "kernel_launch: unexpected n_in %d or ws_size %zu\n", n_in, ws_size); grid = -1; return; }
        int dev = 0, cus = 0, per_cu = 0;
        if (hipGetDevice(&dev) != hipSuccess || hipDeviceGetAttribute(&cus, hipDeviceAttributeMultiprocessorCount, dev) != hipSuccess) { grid = -1; return; }
        if (hipFuncSetAttribute((const void*)mk_fwd, hipFuncAttributeMaxDynamicSharedMemorySize, LDS_BYTES) != hipSuccess) { fprintf(stderr, "kernel_launch: hipFuncSetAttribute failed\n"); grid = -1; return; }
        if (hipOccupancyMaxActiveBlocksPerMultiprocessor(&per_cu, (const void*)mk_fwd, NWAVES * 64, LDS_BYTES) != hipSuccess || per_cu < 1) fprintf(stderr, "kernel_launch: occupancy query reports %d blocks per CU\n", per_cu);
        (void)hipGetLastError();
        grid = cus;
    }
    if (grid < 0) return;
    if (hipMemsetAsync((char*)d_ws + WS_CTL, 0, CTL_ZERO_BYTES, stream) != hipSuccess) return;
    MKArgs a; memset(&a, 0, sizeof(a));
    for (int i = 0; i < 16; ++i) a.in[i] = (const float*)d_in[i];
    a.out = (float*)d_out; a.ws = (unsigned char*)d_ws;
    hipLaunchKernelGGL(mk_fwd, dim3(grid), dim3(NWAVES * 64), LDS_BYTES, stream, a);
}
```

```cpp
#include <hip/hip_runtime.h>
#include <stdint.h>
#include <stdio.h>
#include <string.h>

namespace pg8 {
#define PG8_LAS __attribute__((address_space(3)))
typedef unsigned short bf16_t;
typedef short bf16x8 __attribute__((ext_vector_type(8)));
typedef float f32x4 __attribute__((ext_vector_type(4)));
typedef unsigned u32x4 __attribute__((ext_vector_type(4)));
typedef int v4i32 __attribute__((ext_vector_type(4)));
typedef int v8i32 __attribute__((ext_vector_type(8)));
constexpr int BM = 256, BK = 64, HALF = 128, HTB = HALF * BK * 2  , STAGE_BYTES = 8 * HTB, NXCD = 8, WGM = 8;

__host__ __device__ __forceinline__ int lds_byte(int r, int c) { const int st = (r >> 4) * 2 + (c >> 5), rr = r & 15, cc = c & 31, ob = rr * 64 + cc * 2; return st * 1024 + (ob ^ (((ob >> 9) & 1) << 5)); }
__host__ __device__ __forceinline__ void stage_rc(int b, int& R, int& C) { const int st = b / 1024, sb = b % 1024, swz = sb ^ (((sb >> 9) & 1) << 5); R = (st >> 1) * 16 + swz / 64; C = (st & 1) * 32 + (swz % 64) / 2; }
__host__ __device__ __forceinline__ int perm32(int rho) { const int n = rho >> 4, i = rho & 15; return 8 * (i >> 2) + 4 * n + (i & 3); }

struct Unit { int pm, pn; };
struct Gemm { const bf16_t* A; const bf16_t* Bt; int M, N, K, pad; };

struct StaticOrder {
    static constexpr bool GATHER = false;
    int nM, nN, nwg, G, c, pad;
    __host__ __device__ void init(int M, int N, int G_, int c_) { nM = M / BM; nN = N / BM; nwg = nM * nN; G = G_; c = c_; pad = 0; }
    __host__ __device__ bool next(int i, Unit& u) const {
        const long L = (long)i * G + c; if (L >= nwg) return false;
        int wgid = (int)L; { const int q = nwg / NXCD, r = nwg % NXCD, xcd = wgid % NXCD, off = wgid / NXCD; wgid = (xcd < r ? xcd * (q + 1) : r * (q + 1) + (xcd - r) * q) + off; }
        const int nig = WGM * nN, gid = wgid / nig, fm = gid * WGM, gsz = (nM - fm) < WGM ? (nM - fm) : WGM;
        u.pm = fm + ((wgid % nig) % gsz); u.pn = (wgid % nig) / gsz; return true;
    }
    __device__ __forceinline__ void a_ready(const Unit&) const {}
    __device__ __forceinline__ void done(const Unit&) const {}
};


__device__ __forceinline__ unsigned cvt_pk_bf16(float lo, float hi) { unsigned r; asm volatile("v_cvt_pk_bf16_f32 %0, %1, %2" : "=v"(r) : "v"(lo), "v"(hi)); return r; }
typedef unsigned u32x2 __attribute__((ext_vector_type(2)));

struct EpiRowScaleBf16 {
    static constexpr bool PERM = true, AFTER_DRAIN = false;
    bf16_t* O; const float* rowscale; const int* rowmap; int ldc; int pn_mod; float mul; int pad;
    __device__ __forceinline__ void pre(const Unit& u, int wr, int fr, float (&rs)[8]) const {
#pragma unroll
        for (int i = 0; i < 8; ++i) { const int row = u.pm * BM + wr * 64 + fr + (i >> 2) * HALF + (i & 3) * 16; rs[i] = rowscale ? rowscale[rowmap ? rowmap[row] : row] : 1.0f; } }
    __device__ __forceinline__ void operator()(const f32x4 (&acc)[2][2][4][2], const Unit& u, int wr, int wc, int fr, int fq, const float (&rs)[8]) const {
        const int row0 = u.pm * BM + wr * 64 + fr; const int pnl = pn_mod ? (u.pn % pn_mod) : u.pn;
        const int col0 = pnl * BM + wc * 32 + 8 * fq;
#pragma unroll
        for (int ai = 0; ai < 2; ++ai)
#pragma unroll
            for (int m = 0; m < 4; ++m) { const int row = row0 + ai * HALF + m * 16; const float sc = rs[4 * ai + m] * mul;
                bf16_t* rowp = O + (size_t)row * ldc + col0;
#pragma unroll
                for (int bj = 0; bj < 2; ++bj) { const f32x4 v0 = acc[ai][bj][m][0] * sc, v1 = acc[ai][bj][m][1] * sc;
                    u32x4 w; w.x = cvt_pk_bf16(v0[0], v0[1]); w.y = cvt_pk_bf16(v0[2], v0[3]); w.z = cvt_pk_bf16(v1[0], v1[1]); w.w = cvt_pk_bf16(v1[2], v1[3]);
                    *(u32x4*)(rowp + bj * HALF) = w; } }
    }
};
__device__ __forceinline__ unsigned pk4_fp8(float a, float b, float c, float d) { int p = __builtin_amdgcn_cvt_pk_fp8_f32(a, b, 0, false); p = __builtin_amdgcn_cvt_pk_fp8_f32(c, d, p, true); return (unsigned)p; }
struct EpiSwiGLU8 {
    static constexpr bool PERM = false, AFTER_DRAIN = false;
    unsigned char* O; const float* rowscale; const int* rowmap; int ldc; int pn_mod; float mul; int pad;
    __device__ __forceinline__ void pre(const Unit& u, int wr, int fr, float (&rs)[8]) const {
#pragma unroll
        for (int i = 0; i < 8; ++i) { const int row = u.pm * BM + wr * 64 + fr + (i >> 2) * HALF + (i & 3) * 16; rs[i] = rowscale[rowmap[row]]; } }
    __device__ __forceinline__ void operator()(const f32x4 (&acc)[2][2][4][2], const Unit& u, int wr, int wc, int fr, int fq, const float (&rs)[8]) const {
        const int row0 = u.pm * BM + wr * 64 + fr; const int pnl = u.pn % pn_mod;
        const int col0 = pnl * 128 + wc * 16 + 4 * fq;
#pragma unroll
        for (int ai = 0; ai < 2; ++ai)
#pragma unroll
            for (int m = 0; m < 4; ++m) { const int row = row0 + ai * HALF + m * 16; const float sc = rs[4 * ai + m] * mul;
                unsigned char* rowp = O + (size_t)row * ldc + col0;
#pragma unroll
                for (int bj = 0; bj < 2; ++bj) { const f32x4 a = acc[ai][bj][m][0] * sc, up = acc[ai][bj][m][1] * sc; f32x4 r;
#pragma unroll
                    for (int j = 0; j < 4; ++j) r[j] = a[j] * up[j] * __builtin_amdgcn_rcpf(1.0f + __builtin_amdgcn_exp2f(-1.4426950408889634f * a[j]));
                    *(unsigned*)(rowp + bj * 64) = pk4_fp8(r[0], r[1], r[2], r[3]); } }
    }
};

struct EpiRowScaleF8 {
    static constexpr bool PERM = true, AFTER_DRAIN = false;
    unsigned char* O; const float* rowscale; int ldc; int pn_mod; float mul; int pad;
    __device__ __forceinline__ void pre(const Unit& u, int wr, int fr, float (&rs)[8]) const {
#pragma unroll
        for (int i = 0; i < 8; ++i) rs[i] = rowscale[u.pm * BM + wr * 64 + fr + (i >> 2) * HALF + (i & 3) * 16]; }
    __device__ __forceinline__ void operator()(const f32x4 (&acc)[2][2][4][2], const Unit& u, int wr, int wc, int fr, int fq, const float (&rs)[8]) const {
        const int row0 = u.pm * BM + wr * 64 + fr; const int pnl = pn_mod ? (u.pn % pn_mod) : u.pn;
        const int col0 = pnl * BM + wc * 32 + 8 * fq;
#pragma unroll
        for (int ai = 0; ai < 2; ++ai)
#pragma unroll
            for (int m = 0; m < 4; ++m) { const int row = row0 + ai * HALF + m * 16; const float sc = rs[4 * ai + m] * mul;
                unsigned char* rowp = O + (size_t)row * ldc + col0;
#pragma unroll
                for (int bj = 0; bj < 2; ++bj) { const f32x4 v0 = acc[ai][bj][m][0] * sc, v1 = acc[ai][bj][m][1] * sc;
                    u32x2 w; w.x = pk4_fp8(v0[0], v0[1], v0[2], v0[3]); w.y = pk4_fp8(v1[0], v1[1], v1[2], v1[3]);
                    *(u32x2*)(rowp + bj * HALF) = w; } }
    }
};

struct EpiResidBf16 {
    static constexpr bool PERM = true, AFTER_DRAIN = false;
    bf16_t* XB; const float* rowscale; int ldc; int pad;
    __device__ __forceinline__ void pre(const Unit& u, int wr, int fr, float (&rs)[8]) const {
#pragma unroll
        for (int i = 0; i < 8; ++i) rs[i] = rowscale[u.pm * BM + wr * 64 + fr + (i >> 2) * HALF + (i & 3) * 16]; }
    __device__ __forceinline__ void operator()(const f32x4 (&acc)[2][2][4][2], const Unit& u, int wr, int wc, int fr, int fq, const float (&rs)[8]) const {
        const int row0 = u.pm * BM + wr * 64 + fr, col0 = u.pn * BM + wc * 32 + 8 * fq;
#pragma unroll
        for (int ai = 0; ai < 2; ++ai) {
            u32x4 xin[4][2];
#pragma unroll
            for (int m = 0; m < 4; ++m)
#pragma unroll
                for (int bj = 0; bj < 2; ++bj) xin[m][bj] = *(const u32x4*)(XB + (size_t)(row0 + ai * HALF + m * 16) * ldc + col0 + bj * HALF);
#pragma unroll
            for (int m = 0; m < 4; ++m) { const int row = row0 + ai * HALF + m * 16; const float sc = rs[4 * ai + m]; bf16_t* rowp = XB + (size_t)row * ldc + col0;
#pragma unroll
                for (int bj = 0; bj < 2; ++bj) { const u32x4 x = xin[m][bj]; const f32x4 v0 = acc[ai][bj][m][0] * sc, v1 = acc[ai][bj][m][1] * sc;
                    u32x4 w; w.x = cvt_pk_bf16(__uint_as_float(x.x << 16) + v0[0], __uint_as_float(x.x & 0xffff0000u) + v0[1]); w.y = cvt_pk_bf16(__uint_as_float(x.y << 16) + v0[2], __uint_as_float(x.y & 0xffff0000u) + v0[3]);
                    w.z = cvt_pk_bf16(__uint_as_float(x.z << 16) + v1[0], __uint_as_float(x.z & 0xffff0000u) + v1[1]); w.w = cvt_pk_bf16(__uint_as_float(x.w << 16) + v1[2], __uint_as_float(x.w & 0xffff0000u) + v1[3]);
                    *(u32x4*)(rowp + bj * HALF) = w; } } }
    }
};
template <bool GATHER_> struct GroupedOrderT {
    static constexpr bool GATHER = GATHER_;
    const int* rowmap; int G, c;
    __device__ __forceinline__ bool next(int i, Unit& u) const {
        const int L = i * G + c; if (L >= 1024) return false;
        const int e = L >> 6, w = L & 63; u.pm = e * 8 + (w & 7); u.pn = e * 8 + (w >> 3); return true;
    }
    __device__ __forceinline__ void a_ready(const Unit&) const {}
    __device__ __forceinline__ void done(const Unit&) const {}
};
typedef GroupedOrderT<false> GroupedOrder; typedef GroupedOrderT<true> GroupedGatherOrder;
template <class Epi, class Sched, bool ALIGN_EPI = false, bool SP2 = false, bool F8 = false>
__device__ __forceinline__ void gemm_phase(PG8_LAS unsigned char* lds, const Gemm g, const Sched& S, const Epi& E) {
    int tid_ = threadIdx.x; asm volatile("" : "+v"(tid_));
    const int tid = tid_, wid = __builtin_amdgcn_readfirstlane(tid >> 6), lane = tid & 63, wr = wid >> 2, wc = wid & 3, fr = lane & 15, fq = lane >> 4;
    const int K = g.K, nt = K / BK;
    unsigned voffA[2], voffB[2];
#pragma unroll
    for (int i = 0; i < 2; ++i) { int R, C; stage_rc(tid * 16 + i * 8192, R, C); const int Rb = Epi::PERM ? ((R & ~31) + perm32(R & 31)) : R;
        voffA[i] = (unsigned)(R * K + C) * 2u; voffB[i] = (unsigned)(Rb * K + C) * 2u; }
    const size_t kstep = (size_t)(BK * 2);
    const size_t hstep = (size_t)HALF * K * 2;
    const size_t tstep = 2 * hstep;
    const unsigned ldsw = (unsigned)wid * 1024u;
    const int aoff = lds_byte(wr * 64 + fr, fq * 8), boff = lds_byte(wc * 32 + fr, fq * 8);
#define PG8_SA(b, h) (((b) * 2 + (h)) * HTB)
#define PG8_SB(b, h) ((4 + (b) * 2 + (h)) * HTB)
#define PG8_STAGE(bufoff, gbase, voff) do { _Pragma("unroll") for (int _i = 0; _i < 2; ++_i) \
        __builtin_amdgcn_global_load_lds((const unsigned*)((const char*)(gbase) + (voff)[_i]), (PG8_LAS unsigned*)(lds + (bufoff) + ldsw + _i * 8192), 16, 0, 0); } while (0)
#define PG8_LDA(dst, b, h) do { if constexpr (F8) { _Pragma("unroll") for (int m = 0; m < 4; ++m) dst##8[m] = __builtin_shufflevector(*(const PG8_LAS v4i32*)(lds + PG8_SA(b, h) + aoff + m * 2048), *(const PG8_LAS v4i32*)(lds + PG8_SA(b, h) + aoff + m * 2048 + 1024), 0, 1, 2, 3, 4, 5, 6, 7); } \
    else { _Pragma("unroll") for (int m = 0; m < 4; ++m) _Pragma("unroll") for (int k = 0; k < 2; ++k) dst[m][k] = *(const PG8_LAS bf16x8*)(lds + PG8_SA(b, h) + aoff + m * 2048 + k * 1024); } } while (0)
#define PG8_LDB(dst, b, h) do { if constexpr (F8) { _Pragma("unroll") for (int n = 0; n < 2; ++n) dst##8[n] = __builtin_shufflevector(*(const PG8_LAS v4i32*)(lds + PG8_SB(b, h) + boff + n * 2048), *(const PG8_LAS v4i32*)(lds + PG8_SB(b, h) + boff + n * 2048 + 1024), 0, 1, 2, 3, 4, 5, 6, 7); } \
    else { _Pragma("unroll") for (int n = 0; n < 2; ++n) _Pragma("unroll") for (int k = 0; k < 2; ++k) dst[n][k] = *(const PG8_LAS bf16x8*)(lds + PG8_SB(b, h) + boff + n * 2048 + k * 1024); } } while (0)
#define PG8_MMA(ai, bj, At, Bt) do { __builtin_amdgcn_s_setprio(1); _Pragma("unroll") for (int m = 0; m < 4; ++m) _Pragma("unroll") for (int n = 0; n < 2; ++n) { \
        if constexpr (F8) asm volatile("v_mfma_scale_f32_16x16x128_f8f6f4 %0, %1, %2, %0, %3, %3 op_sel_hi:[0,0,0]" : "+v"(acc[ai][bj][m][n]) : "v"(Bt##8[n]), "v"(At##8[m]), "v"(f8scale));   \
        else { _Pragma("unroll") for (int k = 0; k < 2; ++k) acc[ai][bj][m][n] = __builtin_amdgcn_mfma_f32_16x16x32_bf16(Bt[n][k], At[m][k], acc[ai][bj][m][n], 0, 0, 0); } } \
        __builtin_amdgcn_s_setprio(0); } while (0)
#define PG8_WAIT_V(n) asm volatile("s_waitcnt vmcnt(" #n ")" ::: "memory")
#define PG8_WAIT_L(n) asm volatile("s_waitcnt lgkmcnt(" #n ")" ::: "memory")
#define PG8_BAR __builtin_amdgcn_s_barrier()
#define PG8_SCHED __builtin_amdgcn_sched_barrier(0)
    Unit cur, nxt; int ui = 0;
    if (!S.next(0, cur)) return;
    f32x4 acc[2][2][4][2];
#pragma unroll
    for (int a = 0; a < 2; ++a)
#pragma unroll
        for (int b = 0; b < 2; ++b)
#pragma unroll
            for (int m = 0; m < 4; ++m)
#pragma unroll
                for (int n = 0; n < 2; ++n) acc[a][b][m][n] = (f32x4){0.f, 0.f, 0.f, 0.f};
    bf16x8 At[4][2], B0[2][2], B1[2][2]; v8i32 At8[4], B08[2], B18[2];
    const int f8scale = 0x7F7F7F7F; (void)f8scale;
    const char* cA = (const char*)g.A + (size_t)cur.pm * tstep; const char* cB = (const char*)g.Bt + (size_t)cur.pn * tstep;
    float rs[8];
    E.pre(cur, wr, fr, rs);
    S.a_ready(cur);
    if constexpr (SP2) {
        PG8_STAGE(PG8_SB(0, 0), cB, voffB); PG8_STAGE(PG8_SB(0, 1), cB + hstep, voffB); PG8_STAGE(PG8_SA(0, 0), cA, voffA); PG8_STAGE(PG8_SA(0, 1), cA + hstep, voffA);
        if (wr == 1) PG8_BAR;
        PG8_WAIT_V(2); PG8_BAR;
        PG8_STAGE(PG8_SB(1, 0), cB + kstep, voffB); PG8_STAGE(PG8_SA(1, 0), cA + kstep, voffA); PG8_STAGE(PG8_SB(1, 1), cB + hstep + kstep, voffB);
        PG8_WAIT_V(6); PG8_BAR;
    } else {
        PG8_STAGE(PG8_SB(0, 0), cB, voffB); PG8_STAGE(PG8_SA(0, 0), cA, voffA); PG8_STAGE(PG8_SB(0, 1), cB + hstep, voffB); PG8_STAGE(PG8_SA(0, 1), cA + hstep, voffA);
        if (wr == 1) PG8_BAR;
        PG8_WAIT_V(4); PG8_BAR;
        PG8_STAGE(PG8_SB(1, 0), cB + kstep, voffB); PG8_STAGE(PG8_SA(1, 0), cA + kstep, voffA); PG8_STAGE(PG8_SB(1, 1), cB + hstep + kstep, voffB);
        PG8_WAIT_V(6); PG8_BAR;
    }
    for (;;) {
        const bool has_next = S.next(ui + 1, nxt);
        const char* nA = has_next ? (const char*)g.A + (size_t)nxt.pm * tstep : cA; const char* nB = has_next ? (const char*)g.Bt + (size_t)nxt.pn * tstep : cB;
        for (int t = 0; t < nt; t += 2) {
            const bool last = (t == nt - 2);
            const char* a1 = cA + (size_t)(t + 1) * kstep;
            const char* a2 = last ? nA : cA + (size_t)(t + 2) * kstep; const char* b2 = last ? nB : cB + (size_t)(t + 2) * kstep;
            const char* a3 = a2 + kstep; const char* b3 = b2 + kstep;
            if (last && has_next) S.a_ready(nxt);
            if constexpr (SP2) {
            PG8_LDB(B0, 0, 0); PG8_LDB(B1, 0, 1); PG8_SCHED; PG8_LDA(At, 0, 0); PG8_STAGE(PG8_SA(1, 1), a1 + hstep, voffA);
            PG8_WAIT_V(8); PG8_WAIT_L(0); PG8_BAR; PG8_MMA(0, 0, At, B0); PG8_MMA(0, 1, At, B1); PG8_BAR; PG8_SCHED;
            PG8_LDA(At, 0, 1); PG8_STAGE(PG8_SB(0, 0), b2, voffB); PG8_STAGE(PG8_SB(0, 1), b2 + hstep, voffB); PG8_STAGE(PG8_SA(0, 0), a2, voffA);
            PG8_WAIT_V(8); PG8_WAIT_L(0); PG8_BAR; PG8_MMA(1, 0, At, B0); PG8_MMA(1, 1, At, B1); PG8_BAR; PG8_SCHED;
            PG8_LDB(B0, 1, 0); PG8_LDB(B1, 1, 1); PG8_SCHED; PG8_LDA(At, 1, 0); PG8_STAGE(PG8_SA(0, 1), a2 + hstep, voffA);
            PG8_WAIT_V(8); PG8_WAIT_L(0); PG8_BAR; PG8_MMA(0, 0, At, B0); PG8_MMA(0, 1, At, B1); PG8_BAR; PG8_SCHED;
            PG8_LDA(At, 1, 1); PG8_STAGE(PG8_SB(1, 0), b3, voffB); PG8_STAGE(PG8_SB(1, 1), b3 + hstep, voffB); PG8_STAGE(PG8_SA(1, 0), a3, voffA);
            PG8_WAIT_V(8); PG8_WAIT_L(0); PG8_BAR; PG8_MMA(1, 0, At, B0); PG8_MMA(1, 1, At, B1); PG8_BAR; PG8_SCHED;
            } else {
            PG8_LDB(B0, 0, 0); PG8_SCHED; PG8_LDA(At, 0, 0); PG8_STAGE(PG8_SA(1, 1), a1 + hstep, voffA);
            PG8_WAIT_L(8); PG8_BAR; PG8_WAIT_L(0); PG8_MMA(0, 0, At, B0); PG8_BAR; PG8_SCHED;
            PG8_LDB(B1, 0, 1); PG8_STAGE(PG8_SB(0, 0), b2, voffB);
            PG8_BAR; PG8_WAIT_L(0); PG8_MMA(0, 1, At, B1); PG8_BAR;
            PG8_LDA(At, 0, 1); PG8_STAGE(PG8_SA(0, 0), a2, voffA);
            PG8_BAR; PG8_WAIT_L(0); PG8_MMA(1, 0, At, B0); PG8_BAR; PG8_SCHED;
            PG8_STAGE(PG8_SB(0, 1), b2 + hstep, voffB);
            PG8_WAIT_V(6); PG8_BAR; PG8_MMA(1, 1, At, B1); PG8_BAR;
            PG8_LDB(B0, 1, 0); PG8_SCHED; PG8_LDA(At, 1, 0); PG8_STAGE(PG8_SA(0, 1), a2 + hstep, voffA);
            PG8_WAIT_L(8); PG8_BAR; PG8_WAIT_L(0); PG8_MMA(0, 0, At, B0); PG8_BAR; PG8_SCHED;
            PG8_LDB(B1, 1, 1); PG8_STAGE(PG8_SB(1, 0), b3, voffB);
            PG8_BAR; PG8_WAIT_L(0); PG8_MMA(0, 1, At, B1); PG8_BAR;
            PG8_LDA(At, 1, 1); PG8_STAGE(PG8_SA(1, 0), a3, voffA);
            PG8_BAR; PG8_WAIT_L(0); PG8_MMA(1, 0, At, B0); PG8_BAR; PG8_SCHED;
            PG8_STAGE(PG8_SB(1, 1), b3 + hstep, voffB);
            PG8_WAIT_V(6); PG8_BAR; PG8_MMA(1, 1, At, B1); PG8_BAR;
            }
        }
        if constexpr (F8) asm volatile("s_nop 15\n\ts_nop 15" ::: "memory");
        if constexpr (ALIGN_EPI) { if (wr == 0) PG8_BAR; }
        if constexpr (!Epi::AFTER_DRAIN) { E(acc, cur, wr, wc, fr, fq, rs); S.done(cur); }
        if (!has_next) break;
#pragma unroll
        for (int a = 0; a < 2; ++a)
#pragma unroll
            for (int b = 0; b < 2; ++b)
#pragma unroll
                for (int m = 0; m < 4; ++m)
#pragma unroll
                    for (int n = 0; n < 2; ++n) acc[a][b][m][n] = (f32x4){0.f, 0.f, 0.f, 0.f};
        cur = nxt; cA = nA; cB = nB; ++ui;
        E.pre(cur, wr, fr, rs);
        if constexpr (ALIGN_EPI) { if (wr == 1) PG8_BAR; }
    }
    PG8_WAIT_V(0);
    if constexpr (!ALIGN_EPI) { if (wr == 0) PG8_BAR; }
    PG8_BAR;
    if constexpr (Epi::AFTER_DRAIN) { E.fused(acc, cur, wr, wc, fr, fq, lds, wid, lane); S.done(cur); }
#undef PG8_SA
#undef PG8_SB
#undef PG8_STAGE
#undef PG8_LDA
#undef PG8_LDB
#undef PG8_MMA
#undef PG8_WAIT_V
#undef PG8_WAIT_L
#undef PG8_BAR
#undef PG8_SCHED
}

template <class Epi, class Sched, bool ALIGN_EPI = false, bool SP2 = false, bool F8 = false>
__device__ __forceinline__ void gemm_phase_gather(PG8_LAS unsigned char* lds, const Gemm g, const Sched& S, const Epi& E) {
    int tid_ = threadIdx.x; asm volatile("" : "+v"(tid_));
    const int tid = tid_, wid = __builtin_amdgcn_readfirstlane(tid >> 6), lane = tid & 63, wr = wid >> 2, wc = wid & 3, fr = lane & 15, fq = lane >> 4;
    static_assert(SP2 || !Sched::GATHER, "gathered A rows: SP2 loop only");
    const int K = g.K, nt = K / BK;
    unsigned voffA[2], voffB[2];
#pragma unroll
    for (int i = 0; i < 2; ++i) { int R, C; stage_rc(tid * 16 + i * 8192, R, C); const int Rb = Epi::PERM ? ((R & ~31) + perm32(R & 31)) : R;
        voffA[i] = (unsigned)(R * K + C) * 2u; voffB[i] = (unsigned)(Rb * K + C) * 2u; }
    constexpr bool GATHER = Sched::GATHER;
    int RA[2], CA[2];
#pragma unroll
    for (int i = 0; i < 2; ++i) stage_rc(tid * 16 + i * 8192, RA[i], CA[i]);
    const size_t kstep = (size_t)(BK * 2);
    const size_t hstep = (size_t)HALF * K * 2;
    const size_t tstep = 2 * hstep;
    const unsigned ldsw = (unsigned)wid * 1024u;
    const int aoff = lds_byte(wr * 64 + fr, fq * 8), boff = lds_byte(wc * 32 + fr, fq * 8);
#define PG8_SA(b, h) (((b) * 2 + (h)) * HTB)
#define PG8_SB(b, h) ((4 + (b) * 2 + (h)) * HTB)
#define PG8_STAGE(bufoff, gbase, voff) do { _Pragma("unroll") for (int _i = 0; _i < 2; ++_i) \
        __builtin_amdgcn_global_load_lds((const unsigned*)((const char*)(gbase) + (voff)[_i]), (PG8_LAS unsigned*)(lds + (bufoff) + ldsw + _i * 8192), 16, 0, 0); } while (0)
#define PG8_LDA(dst, b, h) do { if constexpr (F8) { _Pragma("unroll") for (int m = 0; m < 4; ++m) dst##8[m] = __builtin_shufflevector(*(const PG8_LAS v4i32*)(lds + PG8_SA(b, h) + aoff + m * 2048), *(const PG8_LAS v4i32*)(lds + PG8_SA(b, h) + aoff + m * 2048 + 1024), 0, 1, 2, 3, 4, 5, 6, 7); } \
    else { _Pragma("unroll") for (int m = 0; m < 4; ++m) _Pragma("unroll") for (int k = 0; k < 2; ++k) dst[m][k] = *(const PG8_LAS bf16x8*)(lds + PG8_SA(b, h) + aoff + m * 2048 + k * 1024); } } while (0)
#define PG8_LDB(dst, b, h) do { if constexpr (F8) { _Pragma("unroll") for (int n = 0; n < 2; ++n) dst##8[n] = __builtin_shufflevector(*(const PG8_LAS v4i32*)(lds + PG8_SB(b, h) + boff + n * 2048), *(const PG8_LAS v4i32*)(lds + PG8_SB(b, h) + boff + n * 2048 + 1024), 0, 1, 2, 3, 4, 5, 6, 7); } \
    else { _Pragma("unroll") for (int n = 0; n < 2; ++n) _Pragma("unroll") for (int k = 0; k < 2; ++k) dst[n][k] = *(const PG8_LAS bf16x8*)(lds + PG8_SB(b, h) + boff + n * 2048 + k * 1024); } } while (0)
#define PG8_MMA(ai, bj, At, Bt) do { __builtin_amdgcn_s_setprio(1); _Pragma("unroll") for (int m = 0; m < 4; ++m) _Pragma("unroll") for (int n = 0; n < 2; ++n) { \
        if constexpr (F8) asm volatile("v_mfma_scale_f32_16x16x128_f8f6f4 %0, %1, %2, %0, %3, %3 op_sel_hi:[0,0,0]" : "+v"(acc[ai][bj][m][n]) : "v"(Bt##8[n]), "v"(At##8[m]), "v"(f8scale));   \
        else { _Pragma("unroll") for (int k = 0; k < 2; ++k) acc[ai][bj][m][n] = __builtin_amdgcn_mfma_f32_16x16x32_bf16(Bt[n][k], At[m][k], acc[ai][bj][m][n], 0, 0, 0); } } \
        __builtin_amdgcn_s_setprio(0); } while (0)
#define PG8_WAIT_V(n) asm volatile("s_waitcnt vmcnt(" #n ")" ::: "memory")
#define PG8_WAIT_L(n) asm volatile("s_waitcnt lgkmcnt(" #n ")" ::: "memory")
#define PG8_BAR __builtin_amdgcn_s_barrier()
#define PG8_SCHED __builtin_amdgcn_sched_barrier(0)
    Unit cur, nxt; int ui = 0;
    if (!S.next(0, cur)) return;
    f32x4 acc[2][2][4][2];
#pragma unroll
    for (int a = 0; a < 2; ++a)
#pragma unroll
        for (int b = 0; b < 2; ++b)
#pragma unroll
            for (int m = 0; m < 4; ++m)
#pragma unroll
                for (int n = 0; n < 2; ++n) acc[a][b][m][n] = (f32x4){0.f, 0.f, 0.f, 0.f};
    bf16x8 At[4][2], B0[2][2], B1[2][2]; v8i32 At8[4], B08[2], B18[2];
    const int f8scale = 0x7F7F7F7F; (void)f8scale;
    const char* cA = GATHER ? (const char*)g.A : (const char*)g.A + (size_t)cur.pm * tstep; const char* cB = (const char*)g.Bt + (size_t)cur.pn * tstep;
    unsigned offC[2][2], offN[2][2];
#define PG8_SETOFF(o, u) do { _Pragma("unroll") for (int _h = 0; _h < 2; ++_h) _Pragma("unroll") for (int _i = 0; _i < 2; ++_i) { \
        if constexpr (GATHER) o[_h][_i] = (unsigned)S.rowmap[(u).pm * BM + _h * HALF + RA[_i]] * (unsigned)(K * 2) + (unsigned)(CA[_i] * 2); \
        else o[_h][_i] = voffA[_i] + (unsigned)(_h * (int)hstep); } } while (0)
    PG8_SETOFF(offC, cur);
#pragma unroll
    for (int _h = 0; _h < 2; ++_h) { offN[_h][0] = offC[_h][0]; offN[_h][1] = offC[_h][1]; }
    float rs[8];
    E.pre(cur, wr, fr, rs);
    S.a_ready(cur);
    if constexpr (SP2) {
        PG8_STAGE(PG8_SB(0, 0), cB, voffB); PG8_STAGE(PG8_SB(0, 1), cB + hstep, voffB); PG8_STAGE(PG8_SA(0, 0), cA, offC[0]); PG8_STAGE(PG8_SA(0, 1), cA, offC[1]);
        if (wr == 1) PG8_BAR;
        PG8_WAIT_V(2); PG8_BAR;
        PG8_STAGE(PG8_SB(1, 0), cB + kstep, voffB); PG8_STAGE(PG8_SA(1, 0), cA + kstep, offC[0]); PG8_STAGE(PG8_SB(1, 1), cB + hstep + kstep, voffB);
        PG8_WAIT_V(6); PG8_BAR;
    } else {
        PG8_STAGE(PG8_SB(0, 0), cB, voffB); PG8_STAGE(PG8_SA(0, 0), cA, voffA); PG8_STAGE(PG8_SB(0, 1), cB + hstep, voffB); PG8_STAGE(PG8_SA(0, 1), cA + hstep, voffA);
        if (wr == 1) PG8_BAR;
        PG8_WAIT_V(4); PG8_BAR;
        PG8_STAGE(PG8_SB(1, 0), cB + kstep, voffB); PG8_STAGE(PG8_SA(1, 0), cA + kstep, voffA); PG8_STAGE(PG8_SB(1, 1), cB + hstep + kstep, voffB);
        PG8_WAIT_V(6); PG8_BAR;
    }
    for (;;) {
        const bool has_next = S.next(ui + 1, nxt);
        const char* nA = GATHER ? cA : (has_next ? (const char*)g.A + (size_t)nxt.pm * tstep : cA); const char* nB = has_next ? (const char*)g.Bt + (size_t)nxt.pn * tstep : cB;
        if constexpr (GATHER) { if (has_next) PG8_SETOFF(offN, nxt); }
        for (int t = 0; t < nt; t += 2) {
            const bool last = (t == nt - 2);
            const char* a1 = cA + (size_t)(t + 1) * kstep;
            const char* a2 = last ? nA : cA + (size_t)(t + 2) * kstep; const char* b2 = last ? nB : cB + (size_t)(t + 2) * kstep;
            const char* a3 = a2 + kstep; const char* b3 = b2 + kstep;
            if (last && has_next) S.a_ready(nxt);
            unsigned o2[2][2];
#pragma unroll
            for (int _h = 0; _h < 2; ++_h)
#pragma unroll
                for (int _i = 0; _i < 2; ++_i) o2[_h][_i] = (GATHER && last) ? offN[_h][_i] : offC[_h][_i];
            if constexpr (SP2) {
            PG8_LDB(B0, 0, 0); PG8_LDB(B1, 0, 1); PG8_SCHED; PG8_LDA(At, 0, 0); PG8_STAGE(PG8_SA(1, 1), a1, offC[1]);
            PG8_WAIT_V(8); PG8_WAIT_L(0); PG8_BAR; PG8_MMA(0, 0, At, B0); PG8_MMA(0, 1, At, B1); PG8_BAR; PG8_SCHED;
            PG8_LDA(At, 0, 1); PG8_STAGE(PG8_SB(0, 0), b2, voffB); PG8_STAGE(PG8_SB(0, 1), b2 + hstep, voffB); PG8_STAGE(PG8_SA(0, 0), a2, o2[0]);
            PG8_WAIT_V(8); PG8_WAIT_L(0); PG8_BAR; PG8_MMA(1, 0, At, B0); PG8_MMA(1, 1, At, B1); PG8_BAR; PG8_SCHED;
            PG8_LDB(B0, 1, 0); PG8_LDB(B1, 1, 1); PG8_SCHED; PG8_LDA(At, 1, 0); PG8_STAGE(PG8_SA(0, 1), a2, o2[1]);
            PG8_WAIT_V(8); PG8_WAIT_L(0); PG8_BAR; PG8_MMA(0, 0, At, B0); PG8_MMA(0, 1, At, B1); PG8_BAR; PG8_SCHED;
            PG8_LDA(At, 1, 1); PG8_STAGE(PG8_SB(1, 0), b3, voffB); PG8_STAGE(PG8_SB(1, 1), b3 + hstep, voffB); PG8_STAGE(PG8_SA(1, 0), a3, o2[0]);
            PG8_WAIT_V(8); PG8_WAIT_L(0); PG8_BAR; PG8_MMA(1, 0, At, B0); PG8_MMA(1, 1, At, B1); PG8_BAR; PG8_SCHED;
            } else {
            PG8_LDB(B0, 0, 0); PG8_SCHED; PG8_LDA(At, 0, 0); PG8_STAGE(PG8_SA(1, 1), a1 + hstep, voffA);
            PG8_WAIT_L(8); PG8_BAR; PG8_WAIT_L(0); PG8_MMA(0, 0, At, B0); PG8_BAR; PG8_SCHED;
            PG8_LDB(B1, 0, 1); PG8_STAGE(PG8_SB(0, 0), b2, voffB);
            PG8_BAR; PG8_WAIT_L(0); PG8_MMA(0, 1, At, B1); PG8_BAR;
            PG8_LDA(At, 0, 1); PG8_STAGE(PG8_SA(0, 0), a2, voffA);
            PG8_BAR; PG8_WAIT_L(0); PG8_MMA(1, 0, At, B0); PG8_BAR; PG8_SCHED;
            PG8_STAGE(PG8_SB(0, 1), b2 + hstep, voffB);
            PG8_WAIT_V(6); PG8_BAR; PG8_MMA(1, 1, At, B1); PG8_BAR;
            PG8_LDB(B0, 1, 0); PG8_SCHED; PG8_LDA(At, 1, 0); PG8_STAGE(PG8_SA(0, 1), a2 + hstep, voffA);
            PG8_WAIT_L(8); PG8_BAR; PG8_WAIT_L(0); PG8_MMA(0, 0, At, B0); PG8_BAR; PG8_SCHED;
            PG8_LDB(B1, 1, 1); PG8_STAGE(PG8_SB(1, 0), b3, voffB);
            PG8_BAR; PG8_WAIT_L(0); PG8_MMA(0, 1, At, B1); PG8_BAR;
            PG8_LDA(At, 1, 1); PG8_STAGE(PG8_SA(1, 0), a3, voffA);
            PG8_BAR; PG8_WAIT_L(0); PG8_MMA(1, 0, At, B0); PG8_BAR; PG8_SCHED;
            PG8_STAGE(PG8_SB(1, 1), b3 + hstep, voffB);
            PG8_WAIT_V(6); PG8_BAR; PG8_MMA(1, 1, At, B1); PG8_BAR;
            }
        }
        if constexpr (F8) asm volatile("s_nop 15\n\ts_nop 15" ::: "memory");
        if constexpr (ALIGN_EPI) { if (wr == 0) PG8_BAR; }
        if constexpr (!Epi::AFTER_DRAIN) { E(acc, cur, wr, wc, fr, fq, rs); S.done(cur); }
        if (!has_next) break;
#pragma unroll
        for (int a = 0; a < 2; ++a)
#pragma unroll
            for (int b = 0; b < 2; ++b)
#pragma unroll
                for (int m = 0; m < 4; ++m)
#pragma unroll
                    for (int n = 0; n < 2; ++n) acc[a][b][m][n] = (f32x4){0.f, 0.f, 0.f, 0.f};
        cur = nxt; cA = nA; cB = nB; ++ui;
        E.pre(cur, wr, fr, rs);
#pragma unroll
        for (int _h = 0; _h < 2; ++_h) { offC[_h][0] = offN[_h][0]; offC[_h][1] = offN[_h][1]; }
        if constexpr (ALIGN_EPI) { if (wr == 1) PG8_BAR; }
    }
    PG8_WAIT_V(0);
    if constexpr (!ALIGN_EPI) { if (wr == 0) PG8_BAR; }
    PG8_BAR;
    if constexpr (Epi::AFTER_DRAIN) { E.fused(acc, cur, wr, wc, fr, fq, lds, wid, lane); S.done(cur); }
#undef PG8_SETOFF
#undef PG8_SA
#undef PG8_SB
#undef PG8_STAGE
#undef PG8_LDA
#undef PG8_LDB
#undef PG8_MMA
#undef PG8_WAIT_V
#undef PG8_WAIT_L
#undef PG8_BAR
#undef PG8_SCHED
}
}

constexpr int D = 2048, BATCH = 4, SEQ = 4096, MTOK = BATCH * SEQ, DEPTH = 2;
constexpr int NIN = 6160, NPROJ = 6144;
constexpr int C_NAQ = 0, C_NAK = 1024, C_NAV = 2048, C_MLQ = 3072, C_MLK = 3584, C_MLV = 4096, C_MLO = 5120, C_GATES = 6144;
constexpr int NE = 16, CAP = 512, DE = 1024, MR = NE * BATCH * CAP;
constexpr float EPS = 1e-6f;

typedef unsigned short bf16;
typedef float f32x4 __attribute__((ext_vector_type(4)));
typedef unsigned v4u __attribute__((ext_vector_type(4)));
typedef unsigned v2u __attribute__((ext_vector_type(2)));
#define LAS __attribute__((address_space(3)))
typedef short bf16x8v __attribute__((ext_vector_type(8)));
typedef short s16x4 __attribute__((ext_vector_type(4)));
constexpr size_t WS_XB8 = 968 * (size_t)(1u << 20);
constexpr size_t WS_SSQ = 6 * (size_t)(1u << 20) + 512 * 1024;
constexpr size_t WS_RSNA = 7 * (size_t)(1u << 20) + 64 * 1024;
constexpr size_t WS_W16F_OFF = 7 * (1u << 20) + 256 * 1024;

constexpr size_t MiB = 1u << 20;
constexpr size_t WS_CTL = 0;
constexpr size_t WS_RSTD = 1 * MiB;
constexpr size_t WS_GATES = 2 * MiB;
constexpr size_t WS_AFF = 3 * MiB;
constexpr size_t WS_TOK = 4 * MiB;
constexpr size_t WS_GATEV = 4 * MiB + 512 * 1024;
constexpr size_t WS_SEL = 5 * MiB;
constexpr size_t WS_WIN = 8 * MiB;
constexpr size_t WS_WOUT = 56 * MiB;
constexpr size_t WS_WGU = 72 * MiB;
constexpr size_t WS_WD = 328 * MiB;
constexpr size_t WS_XB = 456 * MiB;
constexpr size_t WS_MIX = 520 * MiB;
constexpr size_t WS_P = 584 * MiB;
constexpr size_t WS_NAO = 776 * MiB;
constexpr size_t WS_HF = 840 * MiB;
constexpr size_t WS_ACT = 712 * MiB;
constexpr size_t WS_Y = 776 * MiB;
constexpr size_t WS_END = 1000 * MiB;

__device__ __forceinline__ unsigned f2bf(float f) { unsigned u = __builtin_bit_cast(unsigned, f); return (u + 0x7fffu + ((u >> 16) & 1u)) >> 16; }
__device__ __forceinline__ unsigned pk2(float lo, float hi) { return f2bf(lo) | (f2bf(hi) << 16); }
__device__ __forceinline__ float bf2f(unsigned short b) { return __builtin_bit_cast(float, ((unsigned)b) << 16); }
__device__ __forceinline__ float bflo(unsigned w) { return __builtin_bit_cast(float, w << 16); }
__device__ __forceinline__ float bfhi(unsigned w) { return __builtin_bit_cast(float, w & 0xffff0000u); }
__device__ __forceinline__ float row_ror(float v, int n) { return n == 8 ? __uint_as_float(__builtin_amdgcn_update_dpp(0, __float_as_uint(v), 0x128, 0xf, 0xf, false)) : n == 4 ? __uint_as_float(__builtin_amdgcn_update_dpp(0, __float_as_uint(v), 0x124, 0xf, 0xf, false))
        : n == 2 ? __uint_as_float(__builtin_amdgcn_update_dpp(0, __float_as_uint(v), 0x122, 0xf, 0xf, false)) : __uint_as_float(__builtin_amdgcn_update_dpp(0, __float_as_uint(v), 0x121, 0xf, 0xf, false)); }
__device__ __forceinline__ float row16_sum(float v) { v += row_ror(v, 8); v += row_ror(v, 4); v += row_ror(v, 2); v += row_ror(v, 1); return v; }
__device__ __forceinline__ float row16_max(float v) { v = fmaxf(v, row_ror(v, 8)); v = fmaxf(v, row_ror(v, 4)); v = fmaxf(v, row_ror(v, 2)); v = fmaxf(v, row_ror(v, 1)); return v; }
__device__ __forceinline__ float rows4_sum(float v) {
    auto a = __builtin_amdgcn_permlane16_swap(__float_as_uint(v), __float_as_uint(v), false, false); v = __uint_as_float(a[0]) + __uint_as_float(a[1]);
    auto b = __builtin_amdgcn_permlane32_swap(__float_as_uint(v), __float_as_uint(v), false, false); return __uint_as_float(b[0]) + __uint_as_float(b[1]); }
__device__ __forceinline__ float rows4_max(float v) {
    auto a = __builtin_amdgcn_permlane16_swap(__float_as_uint(v), __float_as_uint(v), false, false); v = fmaxf(__uint_as_float(a[0]), __uint_as_float(a[1]));
    auto b = __builtin_amdgcn_permlane32_swap(__float_as_uint(v), __float_as_uint(v), false, false); return fmaxf(__uint_as_float(b[0]), __uint_as_float(b[1])); }
__device__ __forceinline__ float wave_sum(float v) { return rows4_sum(row16_sum(v)); }
__device__ __forceinline__ float wave_max(float v) { return rows4_max(row16_max(v)); }

struct ConvItem { const float* W; const float* gk; bf16* WT; int ldw, K, k0, n0, dmode, f8; float wmul; };
template <class T> __device__ __forceinline__ T* uni_ptr(T* p) { const unsigned long long v = (unsigned long long)p;
    const unsigned lo = __builtin_amdgcn_readfirstlane((unsigned)v), hi = __builtin_amdgcn_readfirstlane((unsigned)(v >> 32)); return (T*)(((unsigned long long)hi << 32) | lo); }
__device__ __forceinline__ void ti_load(const ConvItem& d, int lane, f32x4 (&wv)[16], f32x4 (&gv)[2]) {
    const int r4 = lane >> 4, c4 = (lane & 15) * 4;
    const float* gp = uni_ptr(d.gk ? d.gk + d.k0 : d.W);
    const unsigned gvo = 32u * (lane & 7);
    asm volatile("global_load_dwordx4 %0, %1, %2" : "=v"(gv[0]) : "v"(gvo), "s"(gp) : "memory");
    asm volatile("global_load_dwordx4 %0, %1, %2 offset:16" : "=v"(gv[1]) : "v"(gvo), "s"(gp) : "memory");
    const unsigned voff = (unsigned)(r4 * d.ldw + c4) * 4u;
#pragma unroll
    for (int i = 0; i < 16; ++i) { const float* p = uni_ptr(d.W + (size_t)(d.k0 + 4 * i) * d.ldw + d.n0); asm volatile("global_load_dwordx4 %0, %1, %2" : "=v"(wv[i]) : "v"(voff), "s"(p) : "memory"); }
}
template <int N> __device__ __forceinline__ void ti_wait(f32x4 (&wv)[16], f32x4 (&gv)[2]) {
    asm volatile("s_waitcnt vmcnt(%18)" : "+v"(wv[0]), "+v"(wv[1]), "+v"(wv[2]), "+v"(wv[3]), "+v"(wv[4]), "+v"(wv[5]), "+v"(wv[6]), "+v"(wv[7]), "+v"(wv[8]), "+v"(wv[9]), "+v"(wv[10]), "+v"(wv[11]),
                 "+v"(wv[12]), "+v"(wv[13]), "+v"(wv[14]), "+v"(wv[15]), "+v"(gv[0]), "+v"(gv[1]) : "n"(N) : "memory");
}
__device__ __forceinline__ unsigned cvt2bf(float lo, float hi) { unsigned r; asm("v_cvt_pk_bf16_f32 %0, %1, %2" : "=v"(r) : "v"(lo), "v"(hi)); return r; }
__device__ __forceinline__ void ti_finish(const ConvItem& d, int lane, const f32x4 (&wv)[16], const f32x4 (&gv)[2], LAS float* scr) {
    const int r4 = lane >> 4, c4 = (lane & 15) * 4;
#pragma unroll
    for (int i = 0; i < 16; ++i) { const int kk = 4 * i + r4; LAS float* p = scr + kk * 65 + c4; p[0] = wv[i][0]; p[1] = wv[i][1]; p[2] = wv[i][2]; p[3] = wv[i][3]; }
    asm volatile("s_waitcnt lgkmcnt(0)" ::: "memory");
    const int c = lane & 7; const float wmul = d.wmul;
    const bool hg = d.gk != nullptr;
    const float m0 = (hg ? gv[0][0] : 1.f) * wmul, m1 = (hg ? gv[0][1] : 1.f) * wmul, m2 = (hg ? gv[0][2] : 1.f) * wmul, m3 = (hg ? gv[0][3] : 1.f) * wmul,
                m4 = (hg ? gv[1][0] : 1.f) * wmul, m5 = (hg ? gv[1][1] : 1.f) * wmul, m6 = (hg ? gv[1][2] : 1.f) * wmul, m7 = (hg ? gv[1][3] : 1.f) * wmul;
    const int es = d.f8 ? 1 : 2;
    const unsigned svo = (unsigned)((lane >> 3) * d.K + 8 * c) * (unsigned)es;
    const int rb0 = d.dmode == 0 ? d.n0 : ((d.n0 >> 4) * 32 + (d.dmode == 2 ? 16 : 0));
    const LAS float* s0 = scr + (8 * c) * 65 + (lane >> 3);
#pragma unroll
    for (int j = 0; j < 8; ++j) { const LAS float* s = s0 + 8 * j;
        const int rb = rb0 + (d.dmode == 0 ? 8 * j : 32 * (j >> 1) + 8 * (j & 1));
        unsigned char* sp = uni_ptr((unsigned char*)d.WT + ((size_t)rb * d.K + d.k0) * es);
        const float y0 = s[0 * 65] * m0, y1 = s[1 * 65] * m1, y2 = s[2 * 65] * m2, y3 = s[3 * 65] * m3, y4 = s[4 * 65] * m4, y5 = s[5 * 65] * m5, y6 = s[6 * 65] * m6, y7 = s[7 * 65] * m7;
        if (d.f8) { v2u o8; int p = __builtin_amdgcn_cvt_pk_fp8_f32(y0, y1, 0, false); p = __builtin_amdgcn_cvt_pk_fp8_f32(y2, y3, p, true); o8.x = (unsigned)p;
            p = __builtin_amdgcn_cvt_pk_fp8_f32(y4, y5, 0, false); p = __builtin_amdgcn_cvt_pk_fp8_f32(y6, y7, p, true); o8.y = (unsigned)p;
            asm volatile("global_store_dwordx2 %0, %1, %2" : : "v"(svo), "v"(o8), "s"(sp) : "memory"); }
        else { v4u o; o.x = cvt2bf(y0, y1); o.y = cvt2bf(y2, y3); o.z = cvt2bf(y4, y5); o.w = cvt2bf(y6, y7);
            asm volatile("global_store_dwordx4 %0, %1, %2" : : "v"(svo), "v"(o), "s"(sp) : "memory"); } }
    asm volatile("s_waitcnt lgkmcnt(0)" ::: "memory");
}
constexpr int CONV_SCR_BYTES = 64 * 65 * 4;
constexpr float Y8_SCALE = 16.0f;
typedef float f32x2 __attribute__((ext_vector_type(2)));
constexpr int NPROJ16 = 5120;
constexpr float W8_SCALE = 64.0f;
struct ConvArgs { const float *w_in, *w_out, *w_gate, *w_up, *w_down, *norm_mix_g, *norm_ffn_g, *na_norm_g; unsigned char* ws; };
constexpr int CI_IN = 32 * 96, CI_OUT = 32 * 32, CI_G = 16 * 32 * 16, CI_D = 16 * 16 * 32, CI_LAYER = CI_IN + CI_OUT + 2 * CI_G + CI_D;
__device__ __forceinline__ ConvItem convert_decode(const ConvArgs& a, int it) {
    ConvItem d; d.f8 = 0; d.wmul = 1.0f; d.gk = nullptr; d.dmode = 0; d.K = D;
    const int l = it / CI_LAYER; int r = it % CI_LAYER;
    if (r < CI_IN) { const int kb = r / 96, nb = r % 96; d.ldw = NIN; d.gk = a.norm_mix_g + l * D; d.k0 = 64 * kb;
        if (64 * nb < NPROJ16) { d.W = a.w_in + (size_t)l * D * NIN; d.WT = (bf16*)(a.ws + WS_WIN) + (size_t)l * NPROJ * D; d.n0 = 64 * nb; }
        else { d.W = a.w_in + (size_t)l * D * NIN + NPROJ16; d.WT = (bf16*)(a.ws + WS_WIN + ((size_t)l * NPROJ + NPROJ16) * D * 2); d.n0 = 64 * nb - NPROJ16; d.f8 = 1; d.wmul = W8_SCALE; }
        return d; }
    r -= CI_IN;
    if (r < CI_OUT) { const int kb = r / 32, nb = r % 32; d.W = a.w_out + (size_t)l * D * D; d.ldw = D; if (64 * kb < 1024) d.gk = a.na_norm_g + l * 1024;
        d.WT = (bf16*)(a.ws + WS_WOUT) + (size_t)l * D * D; d.k0 = 64 * kb; d.n0 = 64 * nb; return d; }
    r -= CI_OUT;
    if (r < 2 * CI_G) { const int up = r >= CI_G; if (up) r -= CI_G; const int e = r / 512, q = r % 512, kb = q / 16, nb = q % 16;
        d.W = (up ? a.w_up : a.w_gate) + ((size_t)l * NE + e) * D * DE; d.ldw = DE; d.gk = a.norm_ffn_g + l * D; d.WT = (bf16*)(a.ws + WS_WGU + ((size_t)l * NE + e) * 2048 * D); d.k0 = 64 * kb; d.n0 = 64 * nb; d.dmode = up ? 2 : 1; d.f8 = 1; d.wmul = W8_SCALE; return d; }
    r -= 2 * CI_G;
    { const int e = r / 512, q = r % 512, kb = q / 32, nb = q % 32; d.W = a.w_down + ((size_t)l * NE + e) * DE * D; d.ldw = D; d.WT = (bf16*)(a.ws + WS_WD + ((size_t)l * NE + e) * D * DE); d.K = DE; d.k0 = 64 * kb; d.n0 = 64 * nb; d.f8 = 1; d.wmul = W8_SCALE; return d; }
}
__device__ __forceinline__ void convert_stream(const ConvArgs& a, int first_, int stride, int end, LAS float* scr, int lane) {
    const int first = __builtin_amdgcn_readfirstlane(first_);
    if (first >= end) return;
    const int n = (end - first + stride - 1) / stride, last = first + (n - 1) * stride;
    f32x4 w0[16], w1[16], g0[2], g1[2]; ConvItem d0 = convert_decode(a, first), d1 = convert_decode(a, min(first + stride, last)); ti_load(d0, lane, w0, g0); ti_load(d1, lane, w1, g1);
    ti_wait<18>(w0, g0); ti_finish(d0, lane, w0, g0, scr);
    d0 = convert_decode(a, min(first + 2 * stride, last)); ti_load(d0, lane, w0, g0);
#pragma unroll 1
    for (int it = first + stride; it <= last; it += 2 * stride) {
        ti_wait<26>(w1, g1); ti_finish(d1, lane, w1, g1, scr);
        d1 = convert_decode(a, min(it + 2 * stride, last)); ti_load(d1, lane, w1, g1);
        ti_wait<26>(w0, g0); ti_finish(d0, lane, w0, g0, scr);
        d0 = convert_decode(a, min(it + 3 * stride, last)); ti_load(d0, lane, w0, g0);
    }
    asm volatile("s_waitcnt vmcnt(0)" ::: "memory");
}
#define XB_TMO      128
#define XB_XCNT(j)  (256  + 64 * (j))
#define XB_XSUB(j)  (1280 + 64 * (j))
#define XB_XGEN(j)  (2304 + 64 * (j))
#define XB_TOP      3328
#define XB_TOPGEN   3392
#define XCD_BAR_WORDS 3456
#define XB_SPIN_CAP (1u << 18)

__device__ __forceinline__ unsigned xb_ld(unsigned* p)              { return __hip_atomic_load(p, __ATOMIC_RELAXED, __HIP_MEMORY_SCOPE_AGENT); }
__device__ __forceinline__ unsigned xb_add(unsigned* p, unsigned v) { return __hip_atomic_fetch_add(p, v, __ATOMIC_RELAXED, __HIP_MEMORY_SCOPE_AGENT); }
__device__ __forceinline__ unsigned xb_xcc_id() { return (unsigned)__builtin_amdgcn_s_getreg((3 << 11) | 20) & 0xFu; }
#define XB_SPIN(cond, bar) do { unsigned _sp = 0; while (cond) { __builtin_amdgcn_s_sleep(1); \
    if ((++_sp & 255u) == 0u) { if (xb_ld(&(bar)[XB_TMO])) break; if (_sp > XB_SPIN_CAP) { atomicAdd(&(bar)[XB_TMO], 1u); break; } } } } while (0)

struct XcdBarrier {
    unsigned* bar; unsigned x;
    volatile LAS unsigned* st;
};

__device__ __forceinline__ XcdBarrier xcd_barrier_post(unsigned* bar, volatile LAS unsigned* st) {
    XcdBarrier b; b.bar = bar; b.x = xb_xcc_id(); b.st = st;
    if (threadIdx.x == 0) (void)xb_add(&bar[XB_XCNT(b.x)], 1u);
    return b;
}
__device__ __forceinline__ void xcd_barrier_complete(unsigned* bar, unsigned x, unsigned& nloc, unsigned& nx) {
    const unsigned G = gridDim.x * gridDim.y * gridDim.z;
    unsigned sum, cnt, mine, sp = 0u;
    for (;;) {
        sum = 0u; cnt = 0u; mine = 0u;
#pragma unroll
        for (unsigned j = 0; j < 16; ++j) { const unsigned c = xb_ld(&bar[XB_XCNT(j)]); sum += c; cnt += (c > 0u) ? 1u : 0u; mine = (j == x) ? c : mine; }
        if (sum == G) break;
        __builtin_amdgcn_s_sleep(1);
        if ((++sp & 255u) == 0u) { if (xb_ld(&bar[XB_TMO])) break; if (sp > XB_SPIN_CAP) { atomicAdd(&bar[XB_TMO], 1u); break; } }
    }
    nloc = mine > 0u ? mine : 1u; nx = cnt > 0u ? cnt : 1u;
}

__device__ __forceinline__ void xcd_barrier(const XcdBarrier& b) {
    asm volatile("s_waitcnt vmcnt(0)" ::: "memory");
    __syncthreads();
    if (threadIdx.x == 0) {
        unsigned* bar = b.bar;
        __builtin_amdgcn_s_waitcnt(0);
        unsigned nloc = b.st[0], nx = b.st[1];
        if (nloc == 0u) { xcd_barrier_complete(bar, b.x, nloc, nx); b.st[0] = nloc; b.st[1] = nx; }
        const unsigned old = xb_add(&bar[XB_XSUB(b.x)], 1u);
        const unsigned gen = old / nloc;
        if (old + 1u == (gen + 1u) * nloc) {
            __builtin_amdgcn_fence(__ATOMIC_RELEASE, "agent");
            asm volatile("s_waitcnt vmcnt(0)" ::: "memory");
            const unsigned og = xb_add(&bar[XB_TOP], 1u);
            const unsigned tg = og / nx;
            if (og + 1u == (tg + 1u) * nx) xb_add(&bar[XB_TOPGEN], 1u);
            else XB_SPIN(xb_ld(&bar[XB_TOPGEN]) == tg, bar);
            __builtin_amdgcn_fence(__ATOMIC_ACQUIRE, "agent");
            xb_add(&bar[XB_XGEN(b.x)], 1u);
            asm volatile("s_waitcnt vmcnt(0)" ::: "memory");
        } else {
            XB_SPIN(xb_ld(&bar[XB_XGEN(b.x)]) == gen, bar);
            __builtin_amdgcn_fence(__ATOMIC_ACQUIRE, "agent");
            asm volatile("s_waitcnt vmcnt(0)" ::: "memory");
        }
    }
    __syncthreads();
}

struct RowArgs { const float* src32; const bf16* srcb; const int* sel; const unsigned char* Y; bf16* XB; unsigned char* XB8; float* RSTD; const float* g; const bf16* W16F; const float* bias; float* GATES; float* AFF; float* out; int mode; int wrxb; };
__device__ __forceinline__ void rowpass_finish(const RowArgs& a, int row, int rr, int s0, int s1, f32x4 (&v)[8], int lane) {
    const int b = row / SEQ;
    if (a.sel) {
        const int sw = rr < 4 ? s0 : s1;
#pragma unroll
        for (int eh = 0; eh < 2; ++eh) { int yw[8][8]; int cc[8];
#pragma unroll
            for (int k = 0; k < 8; ++k) { const int e = 8 * eh + k; cc[k] = __builtin_amdgcn_readlane(sw, ((rr & 3) << 4) + e);
                if (cc[k] >= 0) { const unsigned char* y = a.Y + (size_t)(e * 2048 + b * 512 + cc[k]) * D + 4 * lane;
#pragma unroll
                    for (int j = 0; j < 8; ++j) yw[k][j] = *(const int*)(y + 256 * j); } }
#pragma unroll
            for (int k = 0; k < 8; ++k) if (cc[k] >= 0) {
#pragma unroll
                for (int j = 0; j < 8; ++j) { const f32x2 lo = __builtin_amdgcn_cvt_pk_f32_fp8(yw[k][j], false), hi = __builtin_amdgcn_cvt_pk_f32_fp8(yw[k][j], true);
                    v[j][0] += lo[0] * (1.0f / Y8_SCALE); v[j][1] += lo[1] * (1.0f / Y8_SCALE); v[j][2] += hi[0] * (1.0f / Y8_SCALE); v[j][3] += hi[1] * (1.0f / Y8_SCALE); } } }
    }
    float ss = 0.f;
#pragma unroll
    for (int j = 0; j < 8; ++j) ss += (v[j][0] * v[j][0] + v[j][1] * v[j][1]) + (v[j][2] * v[j][2] + v[j][3] * v[j][3]);
    ss = wave_sum(ss);
    const float rstd = 1.0f / sqrtf(ss * (1.0f / D) + EPS);
    if (a.mode == 2) {
#pragma unroll
        for (int j = 0; j < 8; ++j) { const f32x4 g = *(const f32x4*)(a.g + 4 * lane + 256 * j); *(f32x4*)(a.out + (size_t)row * D + 4 * lane + 256 * j) = v[j] * rstd * g; }
        return;
    }
    if (a.wrxb) {
#pragma unroll
        for (int j = 0; j < 8; ++j) { v2u w; w.x = pk2(v[j][0], v[j][1]); w.y = pk2(v[j][2], v[j][3]); *(v2u*)(a.XB + (size_t)row * D + 4 * lane + 256 * j) = w; } }
    if (a.XB8) {
#pragma unroll
        for (int j = 0; j < 8; ++j) *(unsigned*)(a.XB8 + (size_t)row * D + 4 * lane + 256 * j) = pg8::pk4_fp8(v[j][0], v[j][1], v[j][2], v[j][3]); }
    if (lane == 0) a.RSTD[row] = rstd;
}
template <bool SRC32> __device__ __forceinline__ void rowpass_group(const RowArgs& a, int grp, int lane_) {
    int lane = lane_; asm volatile("" : "+v"(lane));
    int s0 = -1, s1 = -1; if (a.sel) { s0 = a.sel[grp * 128 + lane]; s1 = a.sel[grp * 128 + 64 + lane]; }
    f32x4 v[8];
    if constexpr (SRC32) {
        f32x4 vn[8];
#pragma unroll
        for (int j = 0; j < 8; ++j) v[j] = *(const f32x4*)(a.src32 + (size_t)(8 * grp) * D + 4 * lane + 256 * j);
#pragma unroll 1
        for (int rr = 0; rr < 8; ++rr) { const int row = 8 * grp + rr;
            if (rr < 7) {
#pragma unroll
                for (int j = 0; j < 8; ++j) vn[j] = *(const f32x4*)(a.src32 + (size_t)(row + 1) * D + 4 * lane + 256 * j); }
            rowpass_finish(a, row, rr, s0, s1, v, lane);
#pragma unroll
            for (int j = 0; j < 8; ++j) v[j] = vn[j]; }
    } else {
        v2u w[8], wn[8];
#pragma unroll
        for (int j = 0; j < 8; ++j) w[j] = *(const v2u*)(a.srcb + (size_t)(8 * grp) * D + 4 * lane + 256 * j);
#pragma unroll 1
        for (int rr = 0; rr < 8; ++rr) { const int row = 8 * grp + rr;
            if (rr < 7) {
#pragma unroll
                for (int j = 0; j < 8; ++j) wn[j] = *(const v2u*)(a.srcb + (size_t)(row + 1) * D + 4 * lane + 256 * j); }
#pragma unroll
            for (int j = 0; j < 8; ++j) v[j] = (f32x4){bflo(w[j].x), bfhi(w[j].x), bflo(w[j].y), bfhi(w[j].y)};
            rowpass_finish(a, row, rr, s0, s1, v, lane);
#pragma unroll
            for (int j = 0; j < 8; ++j) w[j] = wn[j]; }
    }
    if (a.mode == 2) return;
    asm volatile("s_waitcnt vmcnt(0)" ::: "memory");
    const int g = lane >> 4, lc = lane & 15;
    f32x4 acc = (f32x4){0.f, 0.f, 0.f, 0.f};
    const bf16* xr = a.XB + (size_t)(8 * grp + (lc & 7)) * D + 8 * g; const bf16* wf = a.W16F + lane * 8;
#pragma unroll 8
    for (int s = 0; s < 64; ++s) { bf16x8v af = *(const bf16x8v*)(xr + 32 * s); if (lc >= 8) af = (bf16x8v){0, 0, 0, 0, 0, 0, 0, 0};
        const bf16x8v bf = *(const bf16x8v*)(wf + s * 512); acc = __builtin_amdgcn_mfma_f32_16x16x32_bf16(af, bf, acc, 0, 0, 0); }
    float rs[4];
#pragma unroll
    for (int r = 0; r < 4; ++r) rs[r] = a.RSTD[8 * grp + 4 * (g & 1) + r];
    if (a.mode == 0) { const float bs = a.bias[lc];
#pragma unroll
        for (int r = 0; r < 4; ++r) { const float rstd = rs[r]; if (g < 2) a.GATES[(size_t)(8 * grp + 4 * g + r) * 16 + lc] = acc[r] * rstd + bs; } }
    else {
#pragma unroll
        for (int r = 0; r < 4; ++r) { const float rstd = rs[r]; const float lg = acc[r] * rstd; float mx = lg;
#pragma unroll
            for (int o = 1; o < 16; o <<= 1) mx = fmaxf(mx, __shfl_xor(mx, o));
            const float p = __expf(lg - mx); float sum = p;
#pragma unroll
            for (int o = 1; o < 16; o <<= 1) sum += __shfl_xor(sum, o);
            const int row = 8 * grp + 4 * g + r; if (g < 2) a.AFF[((size_t)(row / SEQ) * NE + lc) * SEQ + (row % SEQ)] = p / sum; } }
}
__device__ __forceinline__ void w16f_item(const float* W, int ldw, const float* gk, bf16* WF, int s, int lane) {
    const int g = lane >> 4, lc = lane & 15; float v[8];
#pragma unroll
    for (int i = 0; i < 8; ++i) { const int k = 32 * s + 8 * g + i; v[i] = W[(size_t)k * ldw + lc] * gk[k]; }
    v4u o; o.x = pk2(v[0], v[1]); o.y = pk2(v[2], v[3]); o.z = pk2(v[4], v[5]); o.w = pk2(v[6], v[7]);
    *(v4u*)(WF + (size_t)(s * 64 + lane) * 8) = o;
}

__device__ __forceinline__ void na_norm_item(const bf16* NAO, const float* g, bf16* MIX, int t, int lane) {
    f32x4 v[4]; float ss = 0.f;
#pragma unroll
    for (int j = 0; j < 4; ++j) { const v2u w = *(const v2u*)(NAO + (size_t)t * 1024 + 4 * lane + 256 * j); v[j] = (f32x4){bflo(w.x), bfhi(w.x), bflo(w.y), bfhi(w.y)}; ss += (v[j][0] * v[j][0] + v[j][1] * v[j][1]) + (v[j][2] * v[j][2] + v[j][3] * v[j][3]); }
    const float rstd = 1.0f / sqrtf(wave_sum(ss) * (1.0f / 1024.0f) + EPS);
#pragma unroll
    for (int j = 0; j < 4; ++j) { const f32x4 gg = *(const f32x4*)(g + 4 * lane + 256 * j); const f32x4 o = v[j] * rstd * gg; v2u w; w.x = pk2(o[0], o[1]); w.y = pk2(o[2], o[3]);
        *(v2u*)(MIX + (size_t)t * D + 4 * lane + 256 * j) = w; }
}

__device__ __forceinline__ int block_sum_512(int v, LAS int* red, int wave, int lane) {
#pragma unroll
    for (int o = 1; o < 64; o <<= 1) v += __shfl_xor(v, o);
    __syncthreads();
    if (lane == 0) red[wave] = v;
    __syncthreads();
    int s = 0;
#pragma unroll
    for (int w = 0; w < 8; ++w) s += red[w];
    return s;
}
__device__ __forceinline__ int block_excl_scan_512(int v, LAS int* red, int wave, int lane) {
    int inc = v;
#pragma unroll
    for (int o = 1; o < 64; o <<= 1) { const int t = __shfl_up(inc, o); if (lane >= o) inc += t; }
    __syncthreads();
    if (lane == 63) red[wave] = inc;
    __syncthreads();
    int base = 0;
#pragma unroll
    for (int w = 0; w < 8; ++w) base += (w < wave) ? red[w] : 0;
    return base + inc - v;
}
__device__ __forceinline__ void topk_unit(int be, const float* AFF, int* TOK, float* GATEV, int* SEL, LAS int* red) {
    int tid_ = threadIdx.x; asm volatile("" : "+v"(tid_)); const int tid = tid_, lane = tid & 63, wave = tid >> 6;
    const int b = be >> 4, e = be & 15;
    const float* a = AFF + (size_t)be * SEQ + tid * 8;
    const f32x4 a0 = *(const f32x4*)a, a1 = *(const f32x4*)(a + 4);
    unsigned key[8] = {__float_as_uint(a0.x), __float_as_uint(a0.y), __float_as_uint(a0.z), __float_as_uint(a0.w),
                       __float_as_uint(a1.x), __float_as_uint(a1.y), __float_as_uint(a1.z), __float_as_uint(a1.w)};
    LAS int* hist = red + 16;
    unsigned T = 0u; int need = CAP;
#pragma unroll 1
    for (int pass = 0; pass < 4; ++pass) { const int shift = 24 - 8 * pass; const unsigned mhi = pass == 0 ? 0u : (0xFFFFFFFFu << (shift + 8));
        __syncthreads();
        if (tid < 256) hist[tid] = 0;
        __syncthreads();
#pragma unroll
        for (int i = 0; i < 8; ++i) if ((key[i] & mhi) == T) (void)__hip_atomic_fetch_add(&hist[(key[i] >> shift) & 255u], 1, __ATOMIC_RELAXED, __HIP_MEMORY_SCOPE_WORKGROUP);
        __syncthreads();
        if (wave == 0) { const int c0 = hist[4 * lane], c1 = hist[4 * lane + 1], c2 = hist[4 * lane + 2], c3 = hist[4 * lane + 3]; const int t = c0 + c1 + c2 + c3; int inc = t;
#pragma unroll
            for (int o = 1; o < 64; o <<= 1) { const int v = __shfl_down(inc, o); if (lane + o < 64) inc += v; }
            const int ab3 = inc - t, ab2 = ab3 + c3, ab1 = ab2 + c2, ab0 = ab1 + c1;
            if (ab3 < need && need <= ab3 + c3) { red[8] = 4 * lane + 3; red[9] = ab3; }
            if (ab2 < need && need <= ab2 + c2) { red[8] = 4 * lane + 2; red[9] = ab2; }
            if (ab1 < need && need <= ab1 + c1) { red[8] = 4 * lane + 1; red[9] = ab1; }
            if (ab0 < need && need <= ab0 + c0) { red[8] = 4 * lane + 0; red[9] = ab0; } }
        __syncthreads();
        T |= (unsigned)red[8] << shift; need -= red[9]; }
    int ceq = 0;
#pragma unroll
    for (int i = 0; i < 8; ++i) ceq += key[i] == T ? 1 : 0;
    const int need_eq = need;
    int eqrank = block_excl_scan_512(ceq, red, wave, lane);
    int selm = 0, csel = 0;
#pragma unroll
    for (int i = 0; i < 8; ++i) { bool sel = key[i] > T; if (key[i] == T) { sel = eqrank < need_eq; ++eqrank; } if (sel) { selm |= 1 << i; ++csel; } }
    int slot = block_excl_scan_512(csel, red, wave, lane);
#pragma unroll
    for (int i = 0; i < 8; ++i) { const int sidx = tid * 8 + i; const int tok = b * SEQ + sidx;
        if (selm & (1 << i)) { const int R = e * 2048 + b * 512 + slot; TOK[R] = tok; GATEV[R] = __uint_as_float(key[i]); SEL[tok * 16 + e] = slot; ++slot; }
        else SEL[tok * 16 + e] = -1; }
    __syncthreads();
}

typedef short bf16x8v __attribute__((ext_vector_type(8)));
typedef short s16x4 __attribute__((ext_vector_type(4)));
constexpr int ML_L = 128, ML_NC = SEQ / ML_L;
constexpr int KP = 272, VP = 528;
constexpr int ML_T0 = 0, ML_T1 = 128 * KP, ML_V = 2 * 128 * KP;
constexpr int ML_AR = ML_V + 128 * VP;
constexpr int ML_END = ML_AR + 24 * 512;
static_assert(ML_AR % 16 == 0, "LDS map");
constexpr size_t WS_UC = WS_HF;
constexpr size_t WS_NU = 6 * MiB;
constexpr size_t WS_SC = 7 * MiB;

__device__ __forceinline__ s16x4 lds_tr(LAS unsigned char* p) { return __builtin_amdgcn_ds_read_tr16_b64_v4i16((LAS s16x4*)p); }
__device__ __forceinline__ bf16x8v frag_tr(LAS unsigned char* tile, int pitch, int k0, int n0, int lane) {
    const int g = lane >> 4, q = (lane & 15) >> 2, p = lane & 3;
    LAS unsigned char* a = tile + (k0 + 8 * g + q) * pitch + (n0 + 4 * p) * 2;
    const s16x4 lo = lds_tr(a), hi = lds_tr(a + 4 * pitch);
    return (bf16x8v){lo[0], lo[1], lo[2], lo[3], hi[0], hi[1], hi[2], hi[3]};
}
__device__ __forceinline__ bf16x8v frag_row(LAS unsigned char* tile, int pitch, int m0, int k0, int lane) {
    return *(LAS bf16x8v*)(tile + (m0 + (lane & 15)) * pitch + (k0 + 8 * (lane >> 4)) * 2);
}
__device__ __forceinline__ float log_sigmoid_f(float f) { return fminf(f, 0.f) - log1pf(__expf(-fabsf(f))); }
__device__ __forceinline__ float shfl_up_f(float v, int o, int lane, float ident) { const float t = __shfl_up(v, o); return lane >= o ? t : ident; }

__device__ __forceinline__ void chunk_gates(const float* GATES, int t0, int h, int dir, int lane, int& s0, int& s1, float& i0, float& i1, float& b0, float& b1, float& btot) {
    const int p0 = 2 * lane, p1 = p0 + 1; s0 = dir ? 127 - p0 : p0; s1 = dir ? 127 - p1 : p1;
    const int icol = dir * 8 + h, fcol = icol + 4;
    const float* gp = GATES + (size_t)t0 * 16;
    const float f0 = log_sigmoid_f(gp[s0 * 16 + fcol]), f1 = log_sigmoid_f(gp[s1 * 16 + fcol]);
    i0 = gp[s0 * 16 + icol]; i1 = gp[s1 * 16 + icol];
    const float s = f0 + f1; float inc = s;
#pragma unroll
    for (int o = 1; o < 64; o <<= 1) inc += shfl_up_f(inc, o, lane, 0.f);
    const float excl = inc - s; b0 = excl + f0; b1 = excl + s; btot = __shfl(inc, 63);
}


__device__ __forceinline__ void conv_chunk4(const bf16* P, const float* cw, const float* cb, int b, int sq0, int chan0, float (&o)[4][8]) {
    const bf16* pc = P + ((size_t)b * SEQ + sq0) * NPROJ + C_MLQ + chan0;
    v4u w[8];
#pragma unroll
    for (int j = 0; j < 8; ++j) { const int ss = sq0 + j - 2; w[j] = (ss >= 0 && ss < SEQ) ? *(const v4u*)(pc + (ptrdiff_t)(j - 2) * NPROJ) : (v4u){0u, 0u, 0u, 0u}; }
    const f32x4 b0 = *(const f32x4*)(cb + chan0), b1 = *(const f32x4*)(cb + chan0 + 4);
#pragma unroll
    for (int t = 0; t < 4; ++t) { o[t][0] = b0[0]; o[t][1] = b0[1]; o[t][2] = b0[2]; o[t][3] = b0[3]; o[t][4] = b1[0]; o[t][5] = b1[1]; o[t][6] = b1[2]; o[t][7] = b1[3]; }
#pragma unroll
    for (int j = 0; j < 5; ++j) { const f32x4 c0 = *(const f32x4*)(cw + j * 1024 + chan0), c1 = *(const f32x4*)(cw + j * 1024 + chan0 + 4);
#pragma unroll
        for (int t = 0; t < 4; ++t) { const v4u x = w[t + j];
            o[t][0] += c0[0] * bflo(x.x); o[t][1] += c0[1] * bfhi(x.x); o[t][2] += c0[2] * bflo(x.y); o[t][3] += c0[3] * bfhi(x.y);
            o[t][4] += c1[0] * bflo(x.z); o[t][5] += c1[1] * bfhi(x.z); o[t][6] += c1[2] * bflo(x.w); o[t][7] += c1[3] * bfhi(x.w); } }
#pragma unroll
    for (int t = 0; t < 4; ++t)
#pragma unroll
        for (int i = 0; i < 8; ++i) o[t][i] = o[t][i] / (1.0f + __expf(-o[t][i]));
}

__device__ __forceinline__ void mlstm_m1_unit(int u, const float* cw, const float* cb, const bf16* P, const float* GATES, bf16* UC, float* NU, float* SC, LAS unsigned char* lds, int tid_, int wave) {
    int tid = tid_; asm volatile("" : "+v"(tid)); const int lane = tid & 63;
    const int c = u & 31, h = (u >> 5) & 3, b = u >> 7; const int t0 = b * SEQ + c * ML_L;
    LAS float* WK = (LAS float*)(lds + ML_AR);
    LAS float* NRED = WK + 256;
    __syncthreads();
    if (wave < 2) { const int dir = wave; int s0, s1; float i0, i1, b0, b1, btot;
        chunk_gates(GATES, t0, h, dir, lane, s0, s1, i0, i1, b0, b1, btot);
        const float g0 = btot - b0 + i0, g1 = btot - b1 + i1; const float mloc = wave_max(fmaxf(g0, g1));
        WK[dir * 128 + s0] = __expf(g0 - mloc); WK[dir * 128 + s1] = __expf(g1 - mloc);
        if (lane == 0) { float* sc = SC + (size_t)((((b * 4 + h) * 2 + dir) * 32) + c) * 4; sc[0] = btot; sc[1] = mloc; } }
#pragma unroll
    for (int i = 0; i < 8; ++i) { const int id = tid + 512 * i, s = id >> 5, ch = id & 31;
        *(LAS v4u*)(lds + ML_V + s * VP + ch * 16) = *(const v4u*)(P + (size_t)(t0 + s) * NPROJ + C_MLV + h * 256 + ch * 8); }
    float k4[4][8]; conv_chunk4(P, cw, cb, b, c * ML_L + 4 * (tid >> 4), 512 + h * 128 + (tid & 15) * 8, k4);
    __syncthreads();
    { float nf[8], nb[8];
#pragma unroll
      for (int j = 0; j < 8; ++j) { nf[j] = 0.f; nb[j] = 0.f; }
#pragma unroll
      for (int i = 0; i < 4; ++i) { const int s = 4 * (tid >> 4) + i, ch = tid & 15; const float (&k)[8] = k4[i];
        const float wf = WK[s], wb = WK[128 + s];
        v4u of, ob; of.x = pk2(k[0] * wf, k[1] * wf); of.y = pk2(k[2] * wf, k[3] * wf); of.z = pk2(k[4] * wf, k[5] * wf); of.w = pk2(k[6] * wf, k[7] * wf);
        ob.x = pk2(k[0] * wb, k[1] * wb); ob.y = pk2(k[2] * wb, k[3] * wb); ob.z = pk2(k[4] * wb, k[5] * wb); ob.w = pk2(k[6] * wb, k[7] * wb);
        *(LAS v4u*)(lds + ML_T0 + s * KP + ch * 16) = of; *(LAS v4u*)(lds + ML_T1 + s * KP + ch * 16) = ob;
#pragma unroll
        for (int j = 0; j < 8; ++j) { nf[j] += k[j] * wf; nb[j] += k[j] * wb; } }
#pragma unroll
      for (int j = 0; j < 8; ++j) { nf[j] += __shfl_xor(nf[j], 16); nf[j] += __shfl_xor(nf[j], 32); nb[j] += __shfl_xor(nb[j], 16); nb[j] += __shfl_xor(nb[j], 32); }
      if ((lane >> 4) == 0) {
#pragma unroll
          for (int j = 0; j < 8; ++j) { NRED[wave * 256 + (lane & 15) * 8 + j] = nf[j]; NRED[wave * 256 + 128 + (lane & 15) * 8 + j] = nb[j]; } } }
    __syncthreads();
    if (tid < 256) { const int dir = tid >> 7, d = tid & 127; float sum = 0.f;
#pragma unroll
        for (int w = 0; w < 8; ++w) sum += NRED[w * 256 + tid];
        NU[(size_t)((((b * 4 + h) * 2 + dir) * 32) + c) * 128 + d] = sum; }
    const int g = lane >> 4;
#pragma unroll 1
    for (int dir = 0; dir < 2; ++dir) {
        LAS unsigned char* Kt = lds + (dir ? ML_T1 : ML_T0);
        f32x4 acc[8][2];
#pragma unroll
        for (int mb = 0; mb < 8; ++mb) { acc[mb][0] = (f32x4){0.f, 0.f, 0.f, 0.f}; acc[mb][1] = (f32x4){0.f, 0.f, 0.f, 0.f}; }
#pragma unroll
        for (int ks = 0; ks < 4; ++ks) {
            const bf16x8v b0 = frag_tr(lds + ML_V, VP, 32 * ks, 32 * wave, lane), b1 = frag_tr(lds + ML_V, VP, 32 * ks, 32 * wave + 16, lane);
#pragma unroll
            for (int mb = 0; mb < 8; ++mb) { const bf16x8v a = frag_tr(Kt, KP, 32 * ks, 16 * mb, lane);
                acc[mb][0] = __builtin_amdgcn_mfma_f32_16x16x32_bf16(a, b0, acc[mb][0], 0, 0, 0); acc[mb][1] = __builtin_amdgcn_mfma_f32_16x16x32_bf16(a, b1, acc[mb][1], 0, 0, 0); } }
        bf16* uc = UC + (size_t)((((b * 4 + h) * 2 + dir) * 32) + c) * 32768;
#pragma unroll
        for (int mb = 0; mb < 8; ++mb)
#pragma unroll
            for (int nb = 0; nb < 2; ++nb) { const int e = 32 * wave + 16 * nb + (lane & 15), d0 = 16 * mb + 4 * g; v2u w; w.x = pk2(acc[mb][nb][0], acc[mb][nb][1]); w.y = pk2(acc[mb][nb][2], acc[mb][nb][3]);
                *(v2u*)(uc + e * 128 + d0) = w; }
    }
}

__device__ __forceinline__ void mlstm_m2(bf16* UC, float* NU, float* SC, int gtid, int nthreads) {
    for (int vid = gtid; vid < 32 * 4096; vid += nthreads) { const int chain = vid >> 12, within = vid & 4095, dir = chain & 1;
        float st[8]; float m = 0.f;
#pragma unroll
        for (int i = 0; i < 8; ++i) st[i] = 0.f;
#pragma unroll 1
        for (int s0 = 0; s0 < ML_NC; s0 += 8) {
            v4u uw[8]; float bt[8], ml[8];
#pragma unroll
            for (int k = 0; k < 8; ++k) { const int c = dir ? ML_NC - 1 - (s0 + k) : s0 + k; const float* sc = SC + (size_t)(chain * 32 + c) * 4; bt[k] = sc[0]; ml[k] = sc[1];
                uw[k] = *(const v4u*)(UC + ((size_t)(chain * 32 + c) * 4096 + within) * 8); }
#pragma unroll
            for (int k = 0; k < 8; ++k) { const int c = dir ? ML_NC - 1 - (s0 + k) : s0 + k;
                v4u cw; cw.x = pk2(st[0], st[1]); cw.y = pk2(st[2], st[3]); cw.z = pk2(st[4], st[5]); cw.w = pk2(st[6], st[7]);
                *(v4u*)(UC + ((size_t)(chain * 32 + c) * 4096 + within) * 8) = cw;
                if (within == 0) SC[(size_t)(chain * 32 + c) * 4 + 2] = m;
                const float mn = fmaxf(bt[k] + m, ml[k]), dC = __expf(bt[k] + m - mn), dU = __expf(ml[k] - mn);
                const float uu[8] = {bflo(uw[k].x), bfhi(uw[k].x), bflo(uw[k].y), bfhi(uw[k].y), bflo(uw[k].z), bfhi(uw[k].z), bflo(uw[k].w), bfhi(uw[k].w)};
#pragma unroll
                for (int i = 0; i < 8; ++i) st[i] = dC * st[i] + dU * uu[i];
                m = mn; } } }
    for (int nid = gtid; nid < 32 * 128; nid += nthreads) { const int chain = nid >> 7, d = nid & 127, dir = chain & 1; float st = 0.f, m = 0.f;
#pragma unroll 1
        for (int s0 = 0; s0 < ML_NC; s0 += 8) { float uu[8], bt[8], ml[8];
#pragma unroll
            for (int k = 0; k < 8; ++k) { const int c = dir ? ML_NC - 1 - (s0 + k) : s0 + k; const float* sc = SC + (size_t)(chain * 32 + c) * 4; bt[k] = sc[0]; ml[k] = sc[1]; uu[k] = NU[(size_t)(chain * 32 + c) * 128 + d]; }
#pragma unroll
            for (int k = 0; k < 8; ++k) { const int c = dir ? ML_NC - 1 - (s0 + k) : s0 + k; NU[(size_t)(chain * 32 + c) * 128 + d] = st;
                const float mn = fmaxf(bt[k] + m, ml[k]); st = __expf(bt[k] + m - mn) * st + __expf(ml[k] - mn) * uu[k]; m = mn; } } }
}

__device__ __forceinline__ void mlstm_m3_unit(int u, const float* cw, const float* cb, const bf16* P, const float* GATES, const bf16* UC, const float* NU, const float* SC, const float* mlg, const float* RSNA, bf16* MIX, LAS unsigned char* lds, int tid_, int wave) {
    int tid = tid_; asm volatile("" : "+v"(tid)); const int lane = tid & 63;
    const int c = u & 31, h = (u >> 5) & 3, b = u >> 7; const int t0 = b * SEQ + c * ML_L;
    LAS float* AR = (LAS float*)(lds + ML_AR);
    LAS float* CS = AR; LAS float* RR = AR + 256; LAS float* INTER = AR + 512; LAS float* EM = AR + 768; LAS float* ALPHA = AR + 1024; LAS float* SS = AR + 1280;
    const int g = lane >> 4, lc = lane & 15;
    const int chain0 = (b * 4 + h) * 2;
    __syncthreads();
    if (wave < 2) { const int dir = wave; int s0, s1; float i0, i1, b0, b1, btot;
        chunk_gates(GATES, t0, h, dir, lane, s0, s1, i0, i1, b0, b1, btot);
        const float cs0 = i0 - b0, cs1 = i1 - b1;
        float pmx = fmaxf(cs0, cs1);
#pragma unroll
        for (int o = 1; o < 64; o <<= 1) pmx = fmaxf(pmx, shfl_up_f(pmx, o, lane, -3.0e38f));
        const float ex = shfl_up_f(pmx, 1, lane, -3.0e38f);
        const float pm0 = fmaxf(ex, cs0), pm1 = fmaxf(pm0, cs1);
        const float m_in = SC[(size_t)((chain0 + dir) * 32 + c) * 4 + 2];
        const float M0 = b0 + fmaxf(m_in, pm0), M1 = b1 + fmaxf(m_in, pm1);
        CS[dir * 128 + s0] = cs0; CS[dir * 128 + s1] = cs1; RR[dir * 128 + s0] = b0 - M0; RR[dir * 128 + s1] = b1 - M1;
        INTER[dir * 128 + s0] = __expf(b0 + m_in - M0); INTER[dir * 128 + s1] = __expf(b1 + m_in - M1); EM[dir * 128 + s0] = __expf(-M0); EM[dir * 128 + s1] = __expf(-M1); }
    { const int s0 = 4 * (tid >> 4), ch = tid & 15; float x4[4][8];
      conv_chunk4(P, cw, cb, b, c * ML_L + s0, h * 128 + ch * 8, x4);
      const float qs = 0.08838834764831845f;
#pragma unroll
      for (int i = 0; i < 4; ++i) { v4u oq; oq.x = pk2(x4[i][0] * qs, x4[i][1] * qs); oq.y = pk2(x4[i][2] * qs, x4[i][3] * qs); oq.z = pk2(x4[i][4] * qs, x4[i][5] * qs); oq.w = pk2(x4[i][6] * qs, x4[i][7] * qs);
          *(LAS v4u*)(lds + ML_T0 + (s0 + i) * KP + ch * 16) = oq; }
      conv_chunk4(P, cw, cb, b, c * ML_L + s0, 512 + h * 128 + ch * 8, x4);
#pragma unroll
      for (int i = 0; i < 4; ++i) { v4u ok; ok.x = pk2(x4[i][0], x4[i][1]); ok.y = pk2(x4[i][2], x4[i][3]); ok.z = pk2(x4[i][4], x4[i][5]); ok.w = pk2(x4[i][6], x4[i][7]);
          *(LAS v4u*)(lds + ML_T1 + (s0 + i) * KP + ch * 16) = ok; } }
#pragma unroll
    for (int i = 0; i < 8; ++i) { const int id = tid + 512 * i, s = id >> 5, ch = id & 31;
        *(LAS v4u*)(lds + ML_V + s * VP + ch * 16) = *(const v4u*)(P + (size_t)(t0 + s) * NPROJ + C_MLV + h * 256 + ch * 8); }
    __syncthreads();
    f32x4 S[8], qn = (f32x4){0.f, 0.f, 0.f, 0.f};
#pragma unroll
    for (int nb = 0; nb < 8; ++nb) S[nb] = (f32x4){0.f, 0.f, 0.f, 0.f};
#pragma unroll
    for (int ks = 0; ks < 4; ++ks) { const bf16x8v a = frag_row(lds + ML_T0, KP, 16 * wave, 32 * ks, lane);
        bf16x8v nf = (bf16x8v){0, 0, 0, 0, 0, 0, 0, 0};
        if (lc < 2) { const float* np = NU + (size_t)((chain0 + lc) * 32 + c) * 128 + 32 * ks + 8 * g; const f32x4 n0 = *(const f32x4*)np, n1 = *(const f32x4*)(np + 4);
            const unsigned w0 = pk2(n0[0], n0[1]), w1 = pk2(n0[2], n0[3]), w2 = pk2(n1[0], n1[1]), w3 = pk2(n1[2], n1[3]);
            nf = (bf16x8v){(short)(w0 & 0xffff), (short)(w0 >> 16), (short)(w1 & 0xffff), (short)(w1 >> 16), (short)(w2 & 0xffff), (short)(w2 >> 16), (short)(w3 & 0xffff), (short)(w3 >> 16)}; }
        qn = __builtin_amdgcn_mfma_f32_16x16x32_bf16(a, nf, qn, 0, 0, 0);
#pragma unroll
        for (int nb = 0; nb < 8; ++nb) { const bf16x8v kb = frag_row(lds + ML_T1, KP, 16 * nb, 32 * ks, lane); S[nb] = __builtin_amdgcn_mfma_f32_16x16x32_bf16(a, kb, S[nb], 0, 0, 0); } }
    float csf[8], csb[8];
#pragma unroll
    for (int nb = 0; nb < 8; ++nb) { csf[nb] = CS[16 * nb + lc]; csb[nb] = CS[128 + 16 * nb + lc]; }
    float pc[8][4];
#pragma unroll
    for (int r = 0; r < 4; ++r) { const int j = 16 * wave + 4 * g + r; const float Rf = RR[j], Rb = RR[128 + j];
        const float qnf = __shfl(qn[r], 16 * g), qnb = __shfl(qn[r], 16 * g + 1);
        float sf[8], sb[8], rsf = 0.f, rsb = 0.f;
#pragma unroll
        for (int nb = 0; nb < 8; ++nb) { const int s = 16 * nb + lc; const float wf = s <= j ? __expf(Rf + csf[nb]) : 0.f, wb = s >= j ? __expf(Rb + csb[nb]) : 0.f;
            sf[nb] = S[nb][r] * wf; sb[nb] = S[nb][r] * wb; rsf += sf[nb]; rsb += sb[nb]; }
        rsf = row16_sum(rsf); rsb = row16_sum(rsb);
        const float inf_ = INTER[j], inb_ = INTER[128 + j];
        const float ivf = 1.0f / fmaxf(fabsf(inf_ * qnf + rsf), EM[j]), ivb = 1.0f / fmaxf(fabsf(inb_ * qnb + rsb), EM[128 + j]);
#pragma unroll
        for (int nb = 0; nb < 8; ++nb) pc[nb][r] = sf[nb] * ivf + sb[nb] * ivb;
        if (lc == 0) { ALPHA[j] = inf_ * ivf; ALPHA[128 + j] = inb_ * ivb; } }
    __syncthreads();
#pragma unroll
    for (int r = 0; r < 4; ++r) { const int j = 16 * wave + 4 * g + r;
#pragma unroll
        for (int nb = 0; nb < 8; ++nb) *(LAS unsigned short*)(lds + ML_T1 + j * KP + (16 * nb + lc) * 2) = (unsigned short)f2bf(pc[nb][r]); }
    __syncthreads();
    f32x4 acc[2][8], acc2[2][8];
#pragma unroll
    for (int mb = 0; mb < 2; ++mb)
#pragma unroll
        for (int nb = 0; nb < 8; ++nb) { acc[mb][nb] = (f32x4){0.f, 0.f, 0.f, 0.f}; acc2[mb][nb] = (f32x4){0.f, 0.f, 0.f, 0.f}; }
    const bf16* ucf = UC + (size_t)((chain0 + 0) * 32 + c) * 32768 + (size_t)(32 * wave + lc) * 128 + 8 * g;
    const bf16* ucb = UC + (size_t)((chain0 + 1) * 32 + c) * 32768 + (size_t)(32 * wave + lc) * 128 + 8 * g;
#pragma unroll
    for (int ks = 0; ks < 4; ++ks) {
        const bf16x8v af0 = *(const bf16x8v*)(ucf + 32 * ks), af1 = *(const bf16x8v*)(ucf + 16 * 128 + 32 * ks), ab0 = *(const bf16x8v*)(ucb + 32 * ks), ab1 = *(const bf16x8v*)(ucb + 16 * 128 + 32 * ks);
#pragma unroll
        for (int nb = 0; nb < 8; ++nb) { const bf16x8v qb = frag_row(lds + ML_T0, KP, 16 * nb, 32 * ks, lane);
            acc[0][nb] = __builtin_amdgcn_mfma_f32_16x16x32_bf16(af0, qb, acc[0][nb], 0, 0, 0); acc[1][nb] = __builtin_amdgcn_mfma_f32_16x16x32_bf16(af1, qb, acc[1][nb], 0, 0, 0);
            acc2[0][nb] = __builtin_amdgcn_mfma_f32_16x16x32_bf16(ab0, qb, acc2[0][nb], 0, 0, 0); acc2[1][nb] = __builtin_amdgcn_mfma_f32_16x16x32_bf16(ab1, qb, acc2[1][nb], 0, 0, 0); } }
#pragma unroll
    for (int nb = 0; nb < 8; ++nb) { const float af = ALPHA[16 * nb + lc], ab = ALPHA[128 + 16 * nb + lc];
        acc[0][nb] = acc[0][nb] * af + acc2[0][nb] * ab; acc[1][nb] = acc[1][nb] * af + acc2[1][nb] * ab; }
#pragma unroll
    for (int ks = 0; ks < 4; ++ks) {
        const bf16x8v v0 = frag_tr(lds + ML_V, VP, 32 * ks, 32 * wave, lane), v1 = frag_tr(lds + ML_V, VP, 32 * ks, 32 * wave + 16, lane);
#pragma unroll
        for (int nb = 0; nb < 8; ++nb) { const bf16x8v pb = frag_row(lds + ML_T1, KP, 16 * nb, 32 * ks, lane);
            acc[0][nb] = __builtin_amdgcn_mfma_f32_16x16x32_bf16(v0, pb, acc[0][nb], 0, 0, 0); acc[1][nb] = __builtin_amdgcn_mfma_f32_16x16x32_bf16(v1, pb, acc[1][nb], 0, 0, 0); } }
    v2u ogate[2][8]; f32x4 gg2[2];
#pragma unroll
    for (int mb = 0; mb < 2; ++mb) { gg2[mb] = *(const f32x4*)(mlg + h * 256 + 32 * wave + 16 * mb + 4 * g);
#pragma unroll
        for (int nb = 0; nb < 8; ++nb) ogate[mb][nb] = *(const v2u*)(P + (size_t)(t0 + 16 * nb + lc) * NPROJ + C_MLO + h * 256 + 32 * wave + 16 * mb + 4 * g); }
    float rsna[8];
#pragma unroll
    for (int nb = 0; nb < 8; ++nb) rsna[nb] = RSNA[t0 + 16 * nb + lc];
#pragma unroll
    for (int nb = 0; nb < 8; ++nb) { float ss = 0.f;
#pragma unroll
        for (int mb = 0; mb < 2; ++mb) ss += (acc[mb][nb][0] * acc[mb][nb][0] + acc[mb][nb][1] * acc[mb][nb][1]) + (acc[mb][nb][2] * acc[mb][nb][2] + acc[mb][nb][3] * acc[mb][nb][3]);
        ss = rows4_sum(ss);
        if (g == 0) SS[wave * 128 + 16 * nb + lc] = ss; }
    __syncthreads();
#pragma unroll
    for (int nb = 0; nb < 8; ++nb) { const int j = 16 * nb + lc; float tot = 0.f;
#pragma unroll
        for (int w = 0; w < 8; ++w) tot += SS[w * 128 + j];
        const float rstd = 1.0f / (sqrtf(tot * (1.0f / 256.0f) + EPS) * rsna[nb]);
#pragma unroll
        for (int mb = 0; mb < 2; ++mb) { const int e0 = 32 * wave + 16 * mb + 4 * g; const size_t t = (size_t)(t0 + j);
            const v2u ow = ogate[mb][nb]; const f32x4 gg = gg2[mb];
            const float o[4] = {bflo(ow.x), bfhi(ow.x), bflo(ow.y), bfhi(ow.y)}; float rr[4];
#pragma unroll
            for (int r = 0; r < 4; ++r) rr[r] = acc[mb][nb][r] * rstd * gg[r] / (1.0f + __expf(-o[r]));
            v2u w; w.x = pk2(rr[0], rr[1]); w.y = pk2(rr[2], rr[3]);
            *(v2u*)(MIX + t * D + 1024 + h * 256 + e0) = w; } }
}


#ifndef NA_PROBE
#define NA_PROBE 0
#endif
constexpr int NA_TILE = 64 * KP, NA_BUF = 2 * NA_TILE, NA_RPB = 2 * NA_BUF;
static_assert(NA_RPB + 15 * 128 * 4 <= ML_END, "LDS map");
__device__ __forceinline__ bf16x8v frag_tr2(LAS unsigned char* tile, int pitch, int row0, int row1, int n0, int lane) {
    const int q = (lane & 15) >> 2, p = lane & 3;
    const s16x4 lo = lds_tr(tile + (row0 + q) * pitch + (n0 + 4 * p) * 2), hi = lds_tr(tile + (row1 + q) * pitch + (n0 + 4 * p) * 2);
    return (bf16x8v){lo[0], lo[1], lo[2], lo[3], hi[0], hi[1], hi[2], hi[3]};
}
__device__ __forceinline__ void na_unit(int u, const bf16* P, const float* rpb, bf16* MIX, float* SSQ, LAS unsigned char* lds, int tid_, int wave) {
    int tid = tid_; asm volatile("" : "+v"(tid)); const int lane = tid & 63, g = lane >> 4, lc = lane & 15;
    const int r4 = u & 15, h = (u >> 4) & 7, b = u >> 7;
    const int r0 = 4 * r4, r = r0 + (wave >> 1), qh = wave & 1;
    const int rs = min(max(r - 4, 0), 56), rs0 = min(max(r0 - 4, 0), 56), nk = min(max(r0 + 3 - 4, 0), 56) + 8 - rs0;
    LAS float* RPB = (LAS float*)(lds + NA_RPB);
    const int sA = tid >> 4, chA = tid & 15, sB = sA + 32;
    const bf16* gsrc = P + ((size_t)b * SEQ + rs0 * 64) * NPROJ + h * 128 + chA * 8;
    v4u pk0, pk1, pv0, pv1;
#define NA_LOAD(j) do { const bf16* s_ = gsrc + (size_t)(j) * 64 * NPROJ; pk0 = *(const v4u*)(s_ + (size_t)sA * NPROJ + C_NAK); pk1 = *(const v4u*)(s_ + (size_t)sB * NPROJ + C_NAK); \
        pv0 = *(const v4u*)(s_ + (size_t)sA * NPROJ + C_NAV); pv1 = *(const v4u*)(s_ + (size_t)sB * NPROJ + C_NAV); } while (0)
#define NA_STORE(buf) do { LAS unsigned char* t_ = lds + (buf) * NA_BUF; *(LAS v4u*)(t_ + sA * KP + chA * 16) = pk0; *(LAS v4u*)(t_ + sB * KP + chA * 16) = pk1; \
        *(LAS v4u*)(t_ + NA_TILE + sA * KP + chA * 16) = pv0; *(LAS v4u*)(t_ + NA_TILE + sB * KP + chA * 16) = pv1; } while (0)
    NA_LOAD(0);
    __syncthreads();
    for (int i = tid; i < 15 * 128; i += 512) { const int dr = i >> 7, x = (i & 127) - 48; RPB[i] = (x >= 0 && x < 31) ? rpb[h * 465 + dr * 31 + x] * 1.4426950408889634f : 0.f; }
    NA_STORE(0);
    bf16x8v qf[2][4]; int cq[2], cs[2], boff[2]; float m[2], l[2]; f32x4 O[2][8]; f32x4 madd[2][4];
#pragma unroll
    for (int qi = 0; qi < 2; ++qi) { cq[qi] = 32 * qh + 16 * qi + lc; cs[qi] = min(max(cq[qi] - 8, 0), 48); m[qi] = -1.0e30f; l[qi] = 0.f; boff[qi] = 63 - cq[qi] + 4 * g;
#pragma unroll
        for (int kb = 0; kb < 4; ++kb)
#pragma unroll
            for (int rr = 0; rr < 4; ++rr) { const int kc = 16 * kb + 4 * g + rr; madd[qi][kb][rr] = (kc >= cs[qi] && kc < cs[qi] + 16) ? 0.f : -1.0e30f; }
        const bf16* qp = P + ((size_t)b * SEQ + r * 64 + cq[qi]) * NPROJ + C_NAQ + h * 128 + 8 * g;
#pragma unroll
        for (int ks = 0; ks < 4; ++ks) qf[qi][ks] = *(const bf16x8v*)(qp + 32 * ks);
#pragma unroll
        for (int db = 0; db < 8; ++db) O[qi][db] = (f32x4){0.f, 0.f, 0.f, 0.f}; }
    __syncthreads();
#pragma unroll 1
    for (int j = 0; j < nk; ++j) {
        const int kr = rs0 + j;
        if (j + 1 < nk) NA_LOAD(j + 1);
        if (kr >= rs && kr < rs + 8) {
            LAS unsigned char* Kt = lds + (j & 1) * NA_BUF; LAS unsigned char* Vt = Kt + NA_TILE;
            const LAS float* brow = RPB + (kr - r + 7) * 128;
            const int kb0a = qh ? 1 : 0, kb1a = qh ? 3 : 1, kb0b = qh ? 2 : 0, kb1b = qh ? 3 : 2;
            f32x4 s[2][4];
#if NA_PROBE == 1
            for (int prb = 0; prb < 2; ++prb) { asm volatile("" ::: "memory");
#else
            {
#endif
#pragma unroll
            for (int kb = 0; kb < 4; ++kb) { s[0][kb] = (f32x4){0.f, 0.f, 0.f, 0.f}; s[1][kb] = (f32x4){0.f, 0.f, 0.f, 0.f}; }
#pragma unroll
            for (int kb = 0; kb < 4; ++kb) { const bool ua = kb >= kb0a && kb <= kb1a, ub = kb >= kb0b && kb <= kb1b;
                if (ua || ub) {
#pragma unroll
                    for (int ks = 0; ks < 4; ++ks) { const bf16x8v ka = frag_row(Kt, KP, 16 * kb, 32 * ks, lane);
                        if (ua) s[0][kb] = __builtin_amdgcn_mfma_f32_16x16x32_bf16(ka, qf[0][ks], s[0][kb], 0, 0, 0);
                        if (ub) s[1][kb] = __builtin_amdgcn_mfma_f32_16x16x32_bf16(ka, qf[1][ks], s[1][kb], 0, 0, 0); } } }
            }
            bf16x8v pb[2][2];
#pragma unroll
            for (int qi = 0; qi < 2; ++qi) {
                const int k0 = qi ? kb0b : kb0a, k1 = qi ? kb1b : kb1a; const LAS float* bq = brow + boff[qi];
                float mx = -1.0e30f;
#pragma unroll
                for (int kb = 0; kb < 4; ++kb) if (kb >= k0 && kb <= k1) {
#pragma unroll
                    for (int rr = 0; rr < 4; ++rr) { const float v = s[qi][kb][rr] * 0.12753785f + bq[16 * kb + rr] + madd[qi][kb][rr]; s[qi][kb][rr] = v; mx = fmaxf(mx, v); } }
                mx = rows4_max(mx);
                const float mn = fmaxf(m[qi], mx); float ls = 0.f;
#pragma unroll
                for (int kb = 0; kb < 4; ++kb) { if (kb >= k0 && kb <= k1) {
#pragma unroll
                    for (int rr = 0; rr < 4; ++rr) { const float p = __builtin_amdgcn_exp2f(s[qi][kb][rr] - mn); s[qi][kb][rr] = p; ls += p; } } else s[qi][kb] = (f32x4){0.f, 0.f, 0.f, 0.f}; }
                ls = rows4_sum(ls);
                if (!__all(mn == m[qi])) { const float corr = __builtin_amdgcn_exp2f(m[qi] - mn); l[qi] *= corr;
#pragma unroll
                    for (int db = 0; db < 8; ++db) O[qi][db] = O[qi][db] * corr; }
                l[qi] += ls; m[qi] = mn;
#pragma unroll
                for (int t = 0; t < 2; ++t) { v4u pw; pw.x = pk2(s[qi][2 * t][0], s[qi][2 * t][1]); pw.y = pk2(s[qi][2 * t][2], s[qi][2 * t][3]); pw.z = pk2(s[qi][2 * t + 1][0], s[qi][2 * t + 1][1]); pw.w = pk2(s[qi][2 * t + 1][2], s[qi][2 * t + 1][3]);
                    pb[qi][t] = __builtin_bit_cast(bf16x8v, pw); }
            }
#if NA_PROBE == 2
            for (int prb = 0; prb < 2; ++prb) { asm volatile("" ::: "memory"); if (prb) { pb[0][0] = pb[0][1] = pb[1][0] = pb[1][1] = (bf16x8v){0, 0, 0, 0, 0, 0, 0, 0}; }
#else
            {
#endif
#pragma unroll
            for (int t = 0; t < 2; ++t) { const bool ua = 2 * t + 1 >= kb0a && 2 * t <= kb1a, ub = 2 * t + 1 >= kb0b && 2 * t <= kb1b;
                if (ua || ub) {
#pragma unroll
                    for (int db = 0; db < 8; ++db) { const bf16x8v va = frag_tr2(Vt, KP, 32 * t + 4 * g, 32 * t + 16 + 4 * g, 16 * db, lane);
                        if (ua) O[0][db] = __builtin_amdgcn_mfma_f32_16x16x32_bf16(va, pb[0][t], O[0][db], 0, 0, 0);
                        if (ub) O[1][db] = __builtin_amdgcn_mfma_f32_16x16x32_bf16(va, pb[1][t], O[1][db], 0, 0, 0); } } }
            }
        }
#if NA_PROBE == 4
        if (j + 1 < nk) { NA_STORE((j + 1) & 1); asm volatile("" ::: "memory"); }
#endif
#if NA_PROBE == 5
        __syncthreads();
#endif
        if (j + 1 < nk) NA_STORE((j + 1) & 1);
        __syncthreads();
    }
#pragma unroll
    for (int qi = 0; qi < 2; ++qi) { const float inv = 1.0f / l[qi]; const size_t t = (size_t)b * SEQ + r * 64 + cq[qi]; bf16* op = MIX + t * D + h * 128 + 4 * g; float ss = 0.f;
#pragma unroll
        for (int db = 0; db < 8; ++db) { const f32x4 o = O[qi][db] * inv; ss += (o[0] * o[0] + o[1] * o[1]) + (o[2] * o[2] + o[3] * o[3]); v2u w; w.x = pk2(o[0], o[1]); w.y = pk2(o[2], o[3]); *(v2u*)(op + 16 * db) = w; }
        ss = rows4_sum(ss);
        if (g == 0) SSQ[t * 8 + h] = ss; }
#undef NA_LOAD
#undef NA_STORE
}


constexpr int NWAVES = 8;
#ifndef NCONV
#define NCONV 96
#endif
constexpr int RING_BYTES = 131072;
constexpr int LDSCTL_OFF = ML_END, MISC_OFF = LDSCTL_OFF + 320;
constexpr int LDS_BYTES = LDSCTL_OFF + 1024;
static_assert(ML_END >= RING_BYTES && LDS_BYTES <= 163840, "LDS map");
constexpr int CW_BAR = 4096;
constexpr size_t CTL_ZERO_BYTES = 65536;
static_assert((CW_BAR + XCD_BAR_WORDS) * 4 <= (int)CTL_ZERO_BYTES, "barrier words inside the memset region");

struct MKArgs { const float* in[16]; float* out; unsigned char* ws; };
__global__ void __launch_bounds__(NWAVES * 64, 2) mk_fwd(MKArgs args) {
    extern __shared__ __attribute__((aligned(16))) unsigned char lds_raw[];
    LAS unsigned char* lds = (LAS unsigned char*)lds_raw;
    volatile LAS unsigned* MISC = (volatile LAS unsigned*)(lds + MISC_OFF);
    const int tid = threadIdx.x, lane0 = tid & 63, wave = __builtin_amdgcn_readfirstlane(tid >> 6);
    const int G = gridDim.x; const int bx = blockIdx.x; const int vcu = (G % 8 == 0) ? (bx % 8) * (G / 8) + bx / 8 : bx;
    const int gw0 = vcu * NWAVES + wave, ngw = G * NWAVES;
    unsigned char* ws = args.ws;
    for (int u = tid; u < (LDS_BYTES - LDSCTL_OFF) / 4; u += NWAVES * 64) ((LAS unsigned*)(lds + LDSCTL_OFF))[u] = 0u;
    __syncthreads();
    XcdBarrier bar = xcd_barrier_post((unsigned*)(ws + WS_CTL) + CW_BAR, MISC + 8);
#define GRID_BAR() do { XcdBarrier b_ = bar; asm volatile("" : "+s"(b_.bar), "+s"(b_.x)); xcd_barrier(b_); } while (0)
    const float* x = args.in[0]; const float* norm_mix_g = args.in[1]; const float* w_in = args.in[2]; const float* b_gates = args.in[3];
    const float* conv_w = args.in[4]; const float* conv_b = args.in[5]; const float* na_rpb = args.in[6]; const float* na_norm_g = args.in[7];
    const float* ml_norm_g = args.in[8]; const float* w_out = args.in[9]; const float* norm_ffn_g = args.in[10]; const float* w_router = args.in[11];
    const float* w_gate = args.in[12]; const float* w_up = args.in[13]; const float* w_down = args.in[14]; const float* final_norm_g = args.in[15];
#define WSPTRS(wsl, Xl) float* X = (Xl); float* RSTD = (float*)((wsl) + WS_RSTD); float* GATES = (float*)((wsl) + WS_GATES); float* AFF = (float*)((wsl) + WS_AFF); int* TOK = (int*)((wsl) + WS_TOK); float* GATEV = (float*)((wsl) + WS_GATEV); int* SEL = (int*)((wsl) + WS_SEL); \
    bf16* XB = (bf16*)((wsl) + WS_XB); bf16* MIX = (bf16*)((wsl) + WS_MIX); bf16* P = (bf16*)((wsl) + WS_P); bf16* NAO = (bf16*)((wsl) + WS_NAO); bf16* ACT = (bf16*)((wsl) + WS_ACT); bf16* Y = (bf16*)((wsl) + WS_Y); \
    (void)X; (void)RSTD; (void)GATES; (void)AFF; (void)TOK; (void)GATEV; (void)SEL; (void)XB; (void)MIX; (void)P; (void)NAO; (void)ACT; (void)Y;
#define LAUNDER(p) asm volatile("" : "+s"(p))
#ifndef REP_MASK
#define REP_MASK 0
#endif
#if (REP_MASK >> 0) & 1
#define REP0 for (int rep_ = 0; rep_ < 2; ++rep_)
#else
#define REP0
#endif
#if (REP_MASK >> 1) & 1
#define REP1 for (int rep_ = 0; rep_ < 2; ++rep_)
#else
#define REP1
#endif
#if (REP_MASK >> 2) & 1
#define REP2 for (int rep_ = 0; rep_ < 2; ++rep_)
#else
#define REP2
#endif
#if (REP_MASK >> 3) & 1
#define REP3 for (int rep_ = 0; rep_ < 2; ++rep_)
#else
#define REP3
#endif
#if (REP_MASK >> 4) & 1
#define REP4 for (int rep_ = 0; rep_ < 2; ++rep_)
#else
#define REP4
#endif
#if (REP_MASK >> 5) & 1
#define REP5 for (int rep_ = 0; rep_ < 2; ++rep_)
#else
#define REP5
#endif
#if (REP_MASK >> 6) & 1
#define REP6 for (int rep_ = 0; rep_ < 2; ++rep_)
#else
#define REP6
#endif
#if (REP_MASK >> 7) & 1
#define REP7 for (int rep_ = 0; rep_ < 2; ++rep_)
#else
#define REP7
#endif
#if (REP_MASK >> 8) & 1
#define REP8 for (int rep_ = 0; rep_ < 2; ++rep_)
#else
#define REP8
#endif
#if (REP_MASK >> 9) & 1
#define REP9 for (int rep_ = 0; rep_ < 2; ++rep_)
#else
#define REP9
#endif
#if (REP_MASK >> 10) & 1
#define REP10 for (int rep_ = 0; rep_ < 2; ++rep_)
#else
#define REP10
#endif
#if (REP_MASK >> 11) & 1
#define REP11 for (int rep_ = 0; rep_ < 2; ++rep_)
#else
#define REP11
#endif
#if (REP_MASK >> 12) & 1
#define REP12 for (int rep_ = 0; rep_ < 2; ++rep_)
#else
#define REP12
#endif
#if (REP_MASK >> 13) & 1
#define REP13 for (int rep_ = 0; rep_ < 2; ++rep_)
#else
#define REP13
#endif

    { WSPTRS(ws, args.out)
      const int lane = lane0, gw = gw0;
    REP0 { ConvArgs ca; ca.w_in = w_in; ca.w_out = w_out; ca.w_gate = w_gate; ca.w_up = w_up; ca.w_down = w_down; ca.norm_mix_g = norm_mix_g; ca.norm_ffn_g = norm_ffn_g; ca.na_norm_g = na_norm_g; ca.ws = ws;
      LAS float* scr = (LAS float*)(lds + wave * CONV_SCR_BYTES);
      if (G == 256) convert_stream(ca, gw, ngw, CI_IN, scr, lane);
      else convert_stream(ca, gw, ngw, DEPTH * CI_LAYER, scr, lane); }
    { bf16* W16F = (bf16*)(ws + WS_W16F_OFF);
      for (int it = gw; it < DEPTH * 2 * 64; it += ngw) { const int mi = it >> 6, s = it & 63, l = mi >> 1;
          if (mi & 1) w16f_item(w_router + (size_t)l * D * NE, NE, norm_ffn_g + l * D, W16F + (size_t)mi * 32768, s, lane);
          else w16f_item(w_in + (size_t)l * D * NIN + C_GATES, NIN, norm_mix_g + l * D, W16F + (size_t)mi * 32768, s, lane); } }
    GRID_BAR();
    REP1 { RowArgs a; a.src32 = x; a.srcb = nullptr; a.sel = nullptr; a.Y = nullptr; a.XB = XB; a.XB8 = ws + WS_XB8; a.RSTD = RSTD; a.g = norm_mix_g; a.W16F = (const bf16*)(ws + WS_W16F_OFF); a.bias = b_gates; a.GATES = GATES; a.AFF = AFF; a.out = X; a.mode = 0; a.wrxb = 1;
      for (int grp = gw; grp < MTOK / 8; grp += ngw) rowpass_group<true>(a, grp, lane); } }
    GRID_BAR();

    for (int l = 0; l < DEPTH; ++l) {
        unsigned char* wsl = ws; float* Xl = args.out; LAUNDER(wsl); LAUNDER(Xl);
        WSPTRS(wsl, Xl)
        int lane = lane0, gw = gw0; asm volatile("" : "+v"(lane)); LAUNDER(gw);
        const bf16* WinT = (const bf16*)(wsl + WS_WIN) + (size_t)l * NPROJ * D; const bf16* WoutT = (const bf16*)(wsl + WS_WOUT) + (size_t)l * D * D;
        const bf16* WguT = (const bf16*)(wsl + WS_WGU) + (size_t)l * NE * 2048 * D; const bf16* WdT = (const bf16*)(wsl + WS_WD) + (size_t)l * NE * D * DE;
        const int Gg = (l == 0 && G == 256) ? G - NCONV : G;
        if (bx >= Gg) { ConvArgs ca; ca.w_in = w_in; ca.w_out = w_out; ca.w_gate = w_gate; ca.w_up = w_up; ca.w_down = w_down; ca.norm_mix_g = norm_mix_g; ca.norm_ffn_g = norm_ffn_g; ca.na_norm_g = na_norm_g; ca.ws = wsl;
          convert_stream(ca, CI_IN + (bx - Gg) * NWAVES + wave, NCONV * NWAVES, DEPTH * CI_LAYER, (LAS float*)(lds + wave * CONV_SCR_BYTES), lane); }
        else {
        REP2 { pg8::Gemm g{XB, WinT, MTOK, NPROJ16, D, 0}; pg8::StaticOrder S; S.init(MTOK, NPROJ16, Gg, bx); pg8::EpiRowScaleBf16 E{P, RSTD, nullptr, NPROJ, 0, 1.0f, 0};
          pg8::gemm_phase<pg8::EpiRowScaleBf16, pg8::StaticOrder, true, true>(lds, g, S, E); }
        { pg8::Gemm g{(const bf16*)(wsl + WS_XB8), (const bf16*)(wsl + WS_WIN + ((size_t)l * NPROJ + NPROJ16) * D * 2), MTOK, NPROJ - NPROJ16, D / 2, 0}; pg8::StaticOrder S; S.init(MTOK, NPROJ - NPROJ16, Gg, bx);
          pg8::EpiRowScaleBf16 E{P + NPROJ16, RSTD, nullptr, NPROJ, 0, 1.0f / W8_SCALE, 0};
          pg8::gemm_phase<pg8::EpiRowScaleBf16, pg8::StaticOrder, true, true, true>(lds, g, S, E); }
        }
        GRID_BAR();
        REP4 for (int u = vcu; u < 512; u += G) na_unit(u, P, na_rpb + (size_t)l * 8 * 15 * 31, MIX, (float*)(wsl + WS_SSQ), lds, tid, wave);
        { bf16* UC = (bf16*)(wsl + WS_UC); float* NU = (float*)(wsl + WS_NU); float* SC = (float*)(wsl + WS_SC); const float* cwl = conv_w + (size_t)l * 5 * 1024; const float* cbl = conv_b + l * 1024;
          int tidl = tid; asm volatile("" : "+v"(tidl));
          REP5 for (int u = bx; u < 512; u += G) mlstm_m1_unit(u, cwl, cbl, P, GATES, UC, NU, SC, lds, tidl, wave);
          GRID_BAR();
          mlstm_m2(UC, NU, SC, vcu * 512 + tidl, G * 512);
          { const float* ssq = (const float*)(wsl + WS_SSQ); float* rsna = (float*)(wsl + WS_RSNA);
            for (int t = vcu * 512 + tidl; t < MTOK; t += G * 512) { const f32x4 s0 = *(const f32x4*)(ssq + (size_t)t * 8), s1 = *(const f32x4*)(ssq + (size_t)t * 8 + 4);
                rsna[t] = 1.0f / sqrtf(((s0[0] + s0[1]) + (s0[2] + s0[3]) + (s1[0] + s1[1]) + (s1[2] + s1[3])) * (1.0f / 1024.0f) + EPS); } }
          GRID_BAR();
          REP7 for (int u = bx; u < 512; u += G) mlstm_m3_unit(u, cwl, cbl, P, GATES, UC, NU, SC, ml_norm_g + l * 1024, (const float*)(wsl + WS_RSNA), MIX, lds, tidl, wave); }
        GRID_BAR();
#if (REP_MASK >> 8) & 1
        for (int rep_ = 0; rep_ < 2; ++rep_)
#endif
        { pg8::Gemm g{MIX, WoutT, MTOK, D, D, 0}; pg8::StaticOrder S; S.init(MTOK, D, G, bx); pg8::EpiResidBf16 E{XB, (const float*)(wsl + WS_RSNA), D, 0};
#if (REP_MASK >> 8) & 1
          if (rep_ == 0) E.XB = P;
#endif
          pg8::gemm_phase<pg8::EpiResidBf16, pg8::StaticOrder, true, true>(lds, g, S, E); }
        GRID_BAR();
        REP9 { RowArgs a; a.src32 = nullptr; a.srcb = XB; a.sel = nullptr; a.Y = nullptr; a.XB = XB; a.XB8 = wsl + WS_XB8; a.RSTD = RSTD; a.g = norm_ffn_g + l * D; a.W16F = (const bf16*)(wsl + WS_W16F_OFF) + (size_t)(2 * l + 1) * 32768; a.bias = b_gates; a.GATES = GATES; a.AFF = AFF; a.out = X; a.mode = 1; a.wrxb = 0;
          for (int grp = gw; grp < MTOK / 8; grp += ngw) rowpass_group<false>(a, grp, lane); }
        GRID_BAR();
        REP10 for (int be = bx; be < BATCH * NE; be += G) topk_unit(be, AFF, TOK, GATEV, SEL, (LAS int*)lds);
        GRID_BAR();
        REP12 { pg8::Gemm g{(const bf16*)(wsl + WS_XB8), (const bf16*)(wsl + WS_WGU + (size_t)l * NE * 2048 * D), MR, 2048, D / 2, 0}; pg8::GroupedGatherOrder S{TOK, G, bx};
          pg8::EpiSwiGLU8 E{(unsigned char*)ACT, RSTD, TOK, DE, 8, 1.0f / W8_SCALE, 0};
          pg8::gemm_phase_gather<pg8::EpiSwiGLU8, pg8::GroupedGatherOrder, true, true, true>(lds, g, S, E); }
        GRID_BAR();
        REP13 { pg8::Gemm g{ACT, (const bf16*)(wsl + WS_WD + (size_t)l * NE * D * DE), MR, 2048, DE / 2, 0}; pg8::GroupedOrder S{nullptr, G, bx}; pg8::EpiRowScaleF8 E{(unsigned char*)Y, GATEV, D, 8, Y8_SCALE / W8_SCALE, 0};
          pg8::gemm_phase<pg8::EpiRowScaleF8, pg8::GroupedOrder, true, true, true>(lds, g, S, E); }
        GRID_BAR();
        { RowArgs a; a.src32 = nullptr; a.srcb = XB; a.sel = SEL; a.Y = (const unsigned char*)Y; a.XB = XB; a.XB8 = wsl + WS_XB8; a.RSTD = RSTD; a.bias = b_gates + (l + 1 < DEPTH ? (l + 1) * 16 : 0); a.GATES = GATES; a.AFF = AFF; a.out = X; a.wrxb = 1;
          a.W16F = (const bf16*)(wsl + WS_W16F_OFF) + (size_t)(2 * (l + 1 < DEPTH ? l + 1 : 0)) * 32768;
          if (l + 1 < DEPTH) { a.g = norm_mix_g + (l + 1) * D; a.mode = 0; }
          else { a.g = final_norm_g; a.mode = 2; }
          for (int grp = gw; grp < MTOK / 8; grp += ngw) rowpass_group<false>(a, grp, lane); }
        if (l + 1 < DEPTH) GRID_BAR();
    }
#undef GRID_BAR
#undef WSPTRS
}

extern "C" void kernel_launch(void* const* d_in, const int* in_sizes, int n_in, void* d_out, int out_size, void* d_ws, size_t ws_size, hipStream_t stream) {
    static int grid = 0;
    if (grid == 0) {
        if (n_in != 16 || ws_size < WS_END) { fprintf(stderr, "kernel_launch: unexpected n_in %d or ws_size %zu\n", n_in, ws_size); grid = -1; return; }
        int dev = 0, cus = 0, per_cu = 0;
        if (hipGetDevice(&dev) != hipSuccess || hipDeviceGetAttribute(&cus, hipDeviceAttributeMultiprocessorCount, dev) != hipSuccess) { grid = -1; return; }
        if (hipFuncSetAttribute((const void*)mk_fwd, hipFuncAttributeMaxDynamicSharedMemorySize, LDS_BYTES) != hipSuccess) { fprintf(stderr, "kernel_launch: hipFuncSetAttribute failed\n"); grid = -1; return; }
        if (hipOccupancyMaxActiveBlocksPerMultiprocessor(&per_cu, (const void*)mk_fwd, NWAVES * 64, LDS_BYTES) != hipSuccess || per_cu < 1) fprintf(stderr, "kernel_launch: occupancy query reports %d blocks per CU\n", per_cu);
        (void)hipGetLastError();
        grid = cus;
    }
    if (grid < 0) return;
    if (hipMemsetAsync((char*)d_ws + WS_CTL, 0, CTL_ZERO_BYTES, stream) != hipSuccess) return;
    MKArgs a; memset(&a, 0, sizeof(a));
    for (int i = 0; i < 16; ++i) a.in[i] = (const float*)d_in[i];
    a.out = (float*)d_out; a.ws = (unsigned char*)d_ws;
    hipLaunchKernelGGL(mk_fwd, dim3(grid), dim3(NWAVES * 64), LDS_BYTES, stream, a);
}
```

```cpp
#include <hip/hip_runtime.h>
#include <stdint.h>
#include <stdio.h>
#include <string.h>

namespace pg8 {
#define PG8_LAS __attribute__((address_space(3)))
typedef unsigned short bf16_t;
typedef short bf16x8 __attribute__((ext_vector_type(8)));
typedef float f32x4 __attribute__((ext_vector_type(4)));
typedef unsigned u32x4 __attribute__((ext_vector_type(4)));
typedef int v4i32 __attribute__((ext_vector_type(4)));
typedef int v8i32 __attribute__((ext_vector_type(8)));
constexpr int BM = 256, BK = 64, HALF = 128, HTB = HALF * BK * 2  , STAGE_BYTES = 8 * HTB, NXCD = 8, WGM = 8;

__host__ __device__ __forceinline__ int lds_byte(int r, int c) { const int st = (r >> 4) * 2 + (c >> 5), rr = r & 15, cc = c & 31, ob = rr * 64 + cc * 2; return st * 1024 + (ob ^ (((ob >> 9) & 1) << 5)); }
__host__ __device__ __forceinline__ void stage_rc(int b, int& R, int& C) { const int st = b / 1024, sb = b % 1024, swz = sb ^ (((sb >> 9) & 1) << 5); R = (st >> 1) * 16 + swz / 64; C = (st & 1) * 32 + (swz % 64) / 2; }
__host__ __device__ __forceinline__ int perm32(int rho) { const int n = rho >> 4, i = rho & 15; return 8 * (i >> 2) + 4 * n + (i & 3); }

struct Unit { int pm, pn; };
struct Gemm { const bf16_t* A; const bf16_t* Bt; int M, N, K, pad; };

struct StaticOrder {
    static constexpr bool GATHER = false;
    int nM, nN, nwg, G, c, pad;
    __host__ __device__ void init(int M, int N, int G_, int c_) { nM = M / BM; nN = N / BM; nwg = nM * nN; G = G_; c = c_; pad = 0; }
    __host__ __device__ bool next(int i, Unit& u) const {
        const long L = (long)i * G + c; if (L >= nwg) return false;
        int wgid = (int)L; { const int q = nwg / NXCD, r = nwg % NXCD, xcd = wgid % NXCD, off = wgid / NXCD; wgid = (xcd < r ? xcd * (q + 1) : r * (q + 1) + (xcd - r) * q) + off; }
        const int nig = WGM * nN, gid = wgid / nig, fm = gid * WGM, gsz = (nM - fm) < WGM ? (nM - fm) : WGM;
        u.pm = fm + ((wgid % nig) % gsz); u.pn = (wgid % nig) / gsz; return true;
    }
    __device__ __forceinline__ void a_ready(const Unit&) const {}
    __device__ __forceinline__ void done(const Unit&) const {}
};


__device__ __forceinline__ unsigned cvt_pk_bf16(float lo, float hi) { unsigned r; asm volatile("v_cvt_pk_bf16_f32 %0, %1, %2" : "=v"(r) : "v"(lo), "v"(hi)); return r; }
typedef unsigned u32x2 __attribute__((ext_vector_type(2)));

struct EpiRowScaleBf16 {
    static constexpr bool PERM = true, AFTER_DRAIN = false;
    bf16_t* O; const float* rowscale; const int* rowmap; int ldc; int pn_mod; float mul; int pad;
    __device__ __forceinline__ void pre(const Unit& u, int wr, int fr, float (&rs)[8]) const {
#pragma unroll
        for (int i = 0; i < 8; ++i) { const int row = u.pm * BM + wr * 64 + fr + (i >> 2) * HALF + (i & 3) * 16; rs[i] = rowscale ? rowscale[rowmap ? rowmap[row] : row] : 1.0f; } }
    __device__ __forceinline__ void operator()(const f32x4 (&acc)[2][2][4][2], const Unit& u, int wr, int wc, int fr, int fq, const float (&rs)[8]) const {
        const int row0 = u.pm * BM + wr * 64 + fr; const int pnl = pn_mod ? (u.pn % pn_mod) : u.pn;
        const int col0 = pnl * BM + wc * 32 + 8 * fq;
#pragma unroll
        for (int ai = 0; ai < 2; ++ai)
#pragma unroll
            for (int m = 0; m < 4; ++m) { const int row = row0 + ai * HALF + m * 16; const float sc = rs[4 * ai + m] * mul;
                bf16_t* rowp = O + (size_t)row * ldc + col0;
#pragma unroll
                for (int bj = 0; bj < 2; ++bj) { const f32x4 v0 = acc[ai][bj][m][0] * sc, v1 = acc[ai][bj][m][1] * sc;
                    u32x4 w; w.x = cvt_pk_bf16(v0[0], v0[1]); w.y = cvt_pk_bf16(v0[2], v0[3]); w.z = cvt_pk_bf16(v1[0], v1[1]); w.w = cvt_pk_bf16(v1[2], v1[3]);
                    *(u32x4*)(rowp + bj * HALF) = w; } }
    }
};
__device__ __forceinline__ unsigned pk4_fp8(float a, float b, float c, float d) { int p = __builtin_amdgcn_cvt_pk_fp8_f32(a, b, 0, false); p = __builtin_amdgcn_cvt_pk_fp8_f32(c, d, p, true); return (unsigned)p; }
struct EpiSwiGLU8 {
    static constexpr bool PERM = false, AFTER_DRAIN = false;
    unsigned char* O; const float* rowscale; const int* rowmap; int ldc; int pn_mod; float mul; int pad;
    __device__ __forceinline__ void pre(const Unit& u, int wr, int fr, float (&rs)[8]) const {
#pragma unroll
        for (int i = 0; i < 8; ++i) { const int row = u.pm * BM + wr * 64 + fr + (i >> 2) * HALF + (i & 3) * 16; rs[i] = rowscale[rowmap[row]]; } }
    __device__ __forceinline__ void operator()(const f32x4 (&acc)[2][2][4][2], const Unit& u, int wr, int wc, int fr, int fq, const float (&rs)[8]) const {
        const int row0 = u.pm * BM + wr * 64 + fr; const int pnl = u.pn % pn_mod;
        const int col0 = pnl * 128 + wc * 16 + 4 * fq;
#pragma unroll
        for (int ai = 0; ai < 2; ++ai)
#pragma unroll
            for (int m = 0; m < 4; ++m) { const int row = row0 + ai * HALF + m * 16; const float sc = rs[4 * ai + m] * mul;
                unsigned char* rowp = O + (size_t)row * ldc + col0;
#pragma unroll
                for (int bj = 0; bj < 2; ++bj) { const f32x4 a = acc[ai][bj][m][0] * sc, up = acc[ai][bj][m][1] * sc; f32x4 r;
#pragma unroll
                    for (int j = 0; j < 4; ++j) r[j] = a[j] * up[j] * __builtin_amdgcn_rcpf(1.0f + __builtin_amdgcn_exp2f(-1.4426950408889634f * a[j]));
                    *(unsigned*)(rowp + bj * 64) = pk4_fp8(r[0], r[1], r[2], r[3]); } }
    }
};

struct EpiRowScaleF8 {
    static constexpr bool PERM = true, AFTER_DRAIN = false;
    unsigned char* O; const float* rowscale; int ldc; int pn_mod; float mul; int pad;
    __device__ __forceinline__ void pre(const Unit& u, int wr, int fr, float (&rs)[8]) const {
#pragma unroll
        for (int i = 0; i < 8; ++i) rs[i] = rowscale[u.pm * BM + wr * 64 + fr + (i >> 2) * HALF + (i & 3) * 16]; }
    __device__ __forceinline__ void operator()(const f32x4 (&acc)[2][2][4][2], const Unit& u, int wr, int wc, int fr, int fq, const float (&rs)[8]) const {
        const int row0 = u.pm * BM + wr * 64 + fr; const int pnl = pn_mod ? (u.pn % pn_mod) : u.pn;
        const int col0 = pnl * BM + wc * 32 + 8 * fq;
#pragma unroll
        for (int ai = 0; ai < 2; ++ai)
#pragma unroll
            for (int m = 0; m < 4; ++m) { const int row = row0 + ai * HALF + m * 16; const float sc = rs[4 * ai + m] * mul;
                unsigned char* rowp = O + (size_t)row * ldc + col0;
#pragma unroll
                for (int bj = 0; bj < 2; ++bj) { const f32x4 v0 = acc[ai][bj][m][0] * sc, v1 = acc[ai][bj][m][1] * sc;
                    u32x2 w; w.x = pk4_fp8(v0[0], v0[1], v0[2], v0[3]); w.y = pk4_fp8(v1[0], v1[1], v1[2], v1[3]);
                    *(u32x2*)(rowp + bj * HALF) = w; } }
    }
};

struct EpiResidBf16 {
    static constexpr bool PERM = true, AFTER_DRAIN = false;
    bf16_t* XB; const float* rowscale; int ldc; int pad;
    __device__ __forceinline__ void pre(const Unit& u, int wr, int fr, float (&rs)[8]) const {
#pragma unroll
        for (int i = 0; i < 8; ++i) rs[i] = rowscale[u.pm * BM + wr * 64 + fr + (i >> 2) * HALF + (i & 3) * 16]; }
    __device__ __forceinline__ void operator()(const f32x4 (&acc)[2][2][4][2], const Unit& u, int wr, int wc, int fr, int fq, const float (&rs)[8]) const {
        const int row0 = u.pm * BM + wr * 64 + fr, col0 = u.pn * BM + wc * 32 + 8 * fq;
#pragma unroll
        for (int ai = 0; ai < 2; ++ai) {
            u32x4 xin[4][2];
#pragma unroll
            for (int m = 0; m < 4; ++m)
#pragma unroll
                for (int bj = 0; bj < 2; ++bj) xin[m][bj] = *(const u32x4*)(XB + (size_t)(row0 + ai * HALF + m * 16) * ldc + col0 + bj * HALF);
#pragma unroll
            for (int m = 0; m < 4; ++m) { const int row = row0 + ai * HALF + m * 16; const float sc = rs[4 * ai + m]; bf16_t* rowp = XB + (size_t)row * ldc + col0;
#pragma unroll
                for (int bj = 0; bj < 2; ++bj) { const u32x4 x = xin[m][bj]; const f32x4 v0 = acc[ai][bj][m][0] * sc, v1 = acc[ai][bj][m][1] * sc;
                    u32x4 w; w.x = cvt_pk_bf16(__uint_as_float(x.x << 16) + v0[0], __uint_as_float(x.x & 0xffff0000u) + v0[1]); w.y = cvt_pk_bf16(__uint_as_float(x.y << 16) + v0[2], __uint_as_float(x.y & 0xffff0000u) + v0[3]);
                    w.z = cvt_pk_bf16(__uint_as_float(x.z << 16) + v1[0], __uint_as_float(x.z & 0xffff0000u) + v1[1]); w.w = cvt_pk_bf16(__uint_as_float(x.w << 16) + v1[2], __uint_as_float(x.w & 0xffff0000u) + v1[3]);
                    *(u32x4*)(rowp + bj * HALF) = w; } } }
    }
};
template <bool GATHER_> struct GroupedOrderT {
    static constexpr bool GATHER = GATHER_;
    const int* rowmap; int G, c;
    __device__ __forceinline__ bool next(int i, Unit& u) const {
        const int L = i * G + c; if (L >= 1024) return false;
        const int e = L >> 6, w = L & 63; u.pm = e * 8 + (w & 7); u.pn = e * 8 + (w >> 3); return true;
    }
    __device__ __forceinline__ void a_ready(const Unit&) const {}
    __device__ __forceinline__ void done(const Unit&) const {}
};
typedef GroupedOrderT<false> GroupedOrder; typedef GroupedOrderT<true> GroupedGatherOrder;
template <class Epi, class Sched, bool ALIGN_EPI = false, bool SP2 = false, bool F8 = false>
__device__ __forceinline__ void gemm_phase(PG8_LAS unsigned char* lds, const Gemm g, const Sched& S, const Epi& E) {
    int tid_ = threadIdx.x; asm volatile("" : "+v"(tid_));
    const int tid = tid_, wid = __builtin_amdgcn_readfirstlane(tid >> 6), lane = tid & 63, wr = wid >> 2, wc = wid & 3, fr = lane & 15, fq = lane >> 4;
    const int K = g.K, nt = K / BK;
    unsigned voffA[2], voffB[2];
#pragma unroll
    for (int i = 0; i < 2; ++i) { int R, C; stage_rc(tid * 16 + i * 8192, R, C); const int Rb = Epi::PERM ? ((R & ~31) + perm32(R & 31)) : R;
        voffA[i] = (unsigned)(R * K + C) * 2u; voffB[i] = (unsigned)(Rb * K + C) * 2u; }
    const size_t kstep = (size_t)(BK * 2);
    const size_t hstep = (size_t)HALF * K * 2;
    const size_t tstep = 2 * hstep;
    const unsigned ldsw = (unsigned)wid * 1024u;
    const int aoff = lds_byte(wr * 64 + fr, fq * 8), boff = lds_byte(wc * 32 + fr, fq * 8);
#define PG8_SA(b, h) (((b) * 2 + (h)) * HTB)
#define PG8_SB(b, h) ((4 + (b) * 2 + (h)) * HTB)
#define PG8_STAGE(bufoff, gbase, voff) do { _Pragma("unroll") for (int _i = 0; _i < 2; ++_i) \
        __builtin_amdgcn_global_load_lds((const unsigned*)((const char*)(gbase) + (voff)[_i]), (PG8_LAS unsigned*)(lds + (bufoff) + ldsw + _i * 8192), 16, 0, 0); } while (0)
#define PG8_LDA(dst, b, h) do { if constexpr (F8) { _Pragma("unroll") for (int m = 0; m < 4; ++m) dst##8[m] = __builtin_shufflevector(*(const PG8_LAS v4i32*)(lds + PG8_SA(b, h) + aoff + m * 2048), *(const PG8_LAS v4i32*)(lds + PG8_SA(b, h) + aoff + m * 2048 + 1024), 0, 1, 2, 3, 4, 5, 6, 7); } \
    else { _Pragma("unroll") for (int m = 0; m < 4; ++m) _Pragma("unroll") for (int k = 0; k < 2; ++k) dst[m][k] = *(const PG8_LAS bf16x8*)(lds + PG8_SA(b, h) + aoff + m * 2048 + k * 1024); } } while (0)
#define PG8_LDB(dst, b, h) do { if constexpr (F8) { _Pragma("unroll") for (int n = 0; n < 2; ++n) dst##8[n] = __builtin_shufflevector(*(const PG8_LAS v4i32*)(lds + PG8_SB(b, h) + boff + n * 2048), *(const PG8_LAS v4i32*)(lds + PG8_SB(b, h) + boff + n * 2048 + 1024), 0, 1, 2, 3, 4, 5, 6, 7); } \
    else { _Pragma("unroll") for (int n = 0; n < 2; ++n) _Pragma("unroll") for (int k = 0; k < 2; ++k) dst[n][k] = *(const PG8_LAS bf16x8*)(lds + PG8_SB(b, h) + boff + n * 2048 + k * 1024); } } while (0)
#define PG8_MMA(ai, bj, At, Bt) do { __builtin_amdgcn_s_setprio(1); _Pragma("unroll") for (int m = 0; m < 4; ++m) _Pragma("unroll") for (int n = 0; n < 2; ++n) { \
        if constexpr (F8) asm volatile("v_mfma_scale_f32_16x16x128_f8f6f4 %0, %1, %2, %0, %3, %3 op_sel_hi:[0,0,0]" : "+v"(acc[ai][bj][m][n]) : "v"(Bt##8[n]), "v"(At##8[m]), "v"(f8scale));   \
        else { _Pragma("unroll") for (int k = 0; k < 2; ++k) acc[ai][bj][m][n] = __builtin_amdgcn_mfma_f32_16x16x32_bf16(Bt[n][k], At[m][k], acc[ai][bj][m][n], 0, 0, 0); } } \
        __builtin_amdgcn_s_setprio(0); } while (0)
#define PG8_WAIT_V(n) asm volatile("s_waitcnt vmcnt(" #n ")" ::: "memory")
#define PG8_WAIT_L(n) asm volatile("s_waitcnt lgkmcnt(" #n ")" ::: "memory")
#define PG8_BAR __builtin_amdgcn_s_barrier()
#define PG8_SCHED __builtin_amdgcn_sched_barrier(0)
    Unit cur, nxt; int ui = 0;
    if (!S.next(0, cur)) return;
    f32x4 acc[2][2][4][2];
#pragma unroll
    for (int a = 0; a < 2; ++a)
#pragma unroll
        for (int b = 0; b < 2; ++b)
#pragma unroll
            for (int m = 0; m < 4; ++m)
#pragma unroll
                for (int n = 0; n < 2; ++n) acc[a][b][m][n] = (f32x4){0.f, 0.f, 0.f, 0.f};
    bf16x8 At[4][2], B0[2][2], B1[2][2]; v8i32 At8[4], B08[2], B18[2];
    const int f8scale = 0x7F7F7F7F; (void)f8scale;
    const char* cA = (const char*)g.A + (size_t)cur.pm * tstep; const char* cB = (const char*)g.Bt + (size_t)cur.pn * tstep;
    float rs[8];
    E.pre(cur, wr, fr, rs);
    S.a_ready(cur);
    if constexpr (SP2) {
        PG8_STAGE(PG8_SB(0, 0), cB, voffB); PG8_STAGE(PG8_SB(0, 1), cB + hstep, voffB); PG8_STAGE(PG8_SA(0, 0), cA, voffA); PG8_STAGE(PG8_SA(0, 1), cA + hstep, voffA);
        if (wr == 1) PG8_BAR;
        PG8_WAIT_V(2); PG8_BAR;
        PG8_STAGE(PG8_SB(1, 0), cB + kstep, voffB); PG8_STAGE(PG8_SA(1, 0), cA + kstep, voffA); PG8_STAGE(PG8_SB(1, 1), cB + hstep + kstep, voffB);
        PG8_WAIT_V(6); PG8_BAR;
    } else {
        PG8_STAGE(PG8_SB(0, 0), cB, voffB); PG8_STAGE(PG8_SA(0, 0), cA, voffA); PG8_STAGE(PG8_SB(0, 1), cB + hstep, voffB); PG8_STAGE(PG8_SA(0, 1), cA + hstep, voffA);
        if (wr == 1) PG8_BAR;
        PG8_WAIT_V(4); PG8_BAR;
        PG8_STAGE(PG8_SB(1, 0), cB + kstep, voffB); PG8_STAGE(PG8_SA(1, 0), cA + kstep, voffA); PG8_STAGE(PG8_SB(1, 1), cB + hstep + kstep, voffB);
        PG8_WAIT_V(6); PG8_BAR;
    }
    for (;;) {
        const bool has_next = S.next(ui + 1, nxt);
        const char* nA = has_next ? (const char*)g.A + (size_t)nxt.pm * tstep : cA; const char* nB = has_next ? (const char*)g.Bt + (size_t)nxt.pn * tstep : cB;
        for (int t = 0; t < nt; t += 2) {
            const bool last = (t == nt - 2);
            const char* a1 = cA + (size_t)(t + 1) * kstep;
            const char* a2 = last ? nA : cA + (size_t)(t + 2) * kstep; const char* b2 = last ? nB : cB + (size_t)(t + 2) * kstep;
            const char* a3 = a2 + kstep; const char* b3 = b2 + kstep;
            if (last && has_next) S.a_ready(nxt);
            if constexpr (SP2) {
            PG8_LDB(B0, 0, 0); PG8_LDB(B1, 0, 1); PG8_SCHED; PG8_LDA(At, 0, 0); PG8_STAGE(PG8_SA(1, 1), a1 + hstep, voffA);
            PG8_WAIT_V(8); PG8_WAIT_L(0); PG8_BAR; PG8_MMA(0, 0, At, B0); PG8_MMA(0, 1, At, B1); PG8_BAR; PG8_SCHED;
            PG8_LDA(At, 0, 1); PG8_STAGE(PG8_SB(0, 0), b2, voffB); PG8_STAGE(PG8_SB(0, 1), b2 + hstep, voffB); PG8_STAGE(PG8_SA(0, 0), a2, voffA);
            PG8_WAIT_V(8); PG8_WAIT_L(0); PG8_BAR; PG8_MMA(1, 0, At, B0); PG8_MMA(1, 1, At, B1); PG8_BAR; PG8_SCHED;
            PG8_LDB(B0, 1, 0); PG8_LDB(B1, 1, 1); PG8_SCHED; PG8_LDA(At, 1, 0); PG8_STAGE(PG8_SA(0, 1), a2 + hstep, voffA);
            PG8_WAIT_V(8); PG8_WAIT_L(0); PG8_BAR; PG8_MMA(0, 0, At, B0); PG8_MMA(0, 1, At, B1); PG8_BAR; PG8_SCHED;
            PG8_LDA(At, 1, 1); PG8_STAGE(PG8_SB(1, 0), b3, voffB); PG8_STAGE(PG8_SB(1, 1), b3 + hstep, voffB); PG8_STAGE(PG8_SA(1, 0), a3, voffA);
            PG8_WAIT_V(8); PG8_WAIT_L(0); PG8_BAR; PG8_MMA(1, 0, At, B0); PG8_MMA(1, 1, At, B1); PG8_BAR; PG8_SCHED;
            } else {
            PG8_LDB(B0, 0, 0); PG8_SCHED; PG8_LDA(At, 0, 0); PG8_STAGE(PG8_SA(1, 1), a1 + hstep, voffA);
            PG8_WAIT_L(8); PG8_BAR; PG8_WAIT_L(0); PG8_MMA(0, 0, At, B0); PG8_BAR; PG8_SCHED;
            PG8_LDB(B1, 0, 1); PG8_STAGE(PG8_SB(0, 0), b2, voffB);
            PG8_BAR; PG8_WAIT_L(0); PG8_MMA(0, 1, At, B1); PG8_BAR;
            PG8_LDA(At, 0, 1); PG8_STAGE(PG8_SA(0, 0), a2, voffA);
            PG8_BAR; PG8_WAIT_L(0); PG8_MMA(1, 0, At, B0); PG8_BAR; PG8_SCHED;
            PG8_STAGE(PG8_SB(0, 1), b2 + hstep, voffB);
            PG8_WAIT_V(6); PG8_BAR; PG8_MMA(1, 1, At, B1); PG8_BAR;
            PG8_LDB(B0, 1, 0); PG8_SCHED; PG8_LDA(At, 1, 0); PG8_STAGE(PG8_SA(0, 1), a2 + hstep, voffA);
            PG8_WAIT_L(8); PG8_BAR; PG8_WAIT_L(0); PG8_MMA(0, 0, At, B0); PG8_BAR; PG8_SCHED;
            PG8_LDB(B1, 1, 1); PG8_STAGE(PG8_SB(1, 0), b3, voffB);
            PG8_BAR; PG8_WAIT_L(0); PG8_MMA(0, 1, At, B1); PG8_BAR;
            PG8_LDA(At, 1, 1); PG8_STAGE(PG8_SA(1, 0), a3, voffA);
            PG8_BAR; PG8_WAIT_L(0); PG8_MMA(1, 0, At, B0); PG8_BAR; PG8_SCHED;
            PG8_STAGE(PG8_SB(1, 1), b3 + hstep, voffB);
            PG8_WAIT_V(6); PG8_BAR; PG8_MMA(1, 1, At, B1); PG8_BAR;
            }
        }
        if constexpr (F8) asm volatile("s_nop 15\n\ts_nop 15" ::: "memory");
        if constexpr (ALIGN_EPI) { if (wr == 0) PG8_BAR; }
        if constexpr (!Epi::AFTER_DRAIN) { E(acc, cur, wr, wc, fr, fq, rs); S.done(cur); }
        if (!has_next) break;
#pragma unroll
        for (int a = 0; a < 2; ++a)
#pragma unroll
            for (int b = 0; b < 2; ++b)
#pragma unroll
                for (int m = 0; m < 4; ++m)
#pragma unroll
                    for (int n = 0; n < 2; ++n) acc[a][b][m][n] = (f32x4){0.f, 0.f, 0.f, 0.f};
        cur = nxt; cA = nA; cB = nB; ++ui;
        E.pre(cur, wr, fr, rs);
        if constexpr (ALIGN_EPI) { if (wr == 1) PG8_BAR; }
    }
    PG8_WAIT_V(0);
    if constexpr (!ALIGN_EPI) { if (wr == 0) PG8_BAR; }
    PG8_BAR;
    if constexpr (Epi::AFTER_DRAIN) { E.fused(acc, cur, wr, wc, fr, fq, lds, wid, lane); S.done(cur); }
#undef PG8_SA
#undef PG8_SB
#undef PG8_STAGE
#undef PG8_LDA
#undef PG8_LDB
#undef PG8_MMA
#undef PG8_WAIT_V
#undef PG8_WAIT_L
#undef PG8_BAR
#undef PG8_SCHED
}

template <class Epi, class Sched, bool ALIGN_EPI = false, bool SP2 = false, bool F8 = false>
__device__ __forceinline__ void gemm_phase_gather(PG8_LAS unsigned char* lds, const Gemm g, const Sched& S, const Epi& E) {
    int tid_ = threadIdx.x; asm volatile("" : "+v"(tid_));
    const int tid = tid_, wid = __builtin_amdgcn_readfirstlane(tid >> 6), lane = tid & 63, wr = wid >> 2, wc = wid & 3, fr = lane & 15, fq = lane >> 4;
    static_assert(SP2 || !Sched::GATHER, "gathered A rows: SP2 loop only");
    const int K = g.K, nt = K / BK;
    unsigned voffA[2], voffB[2];
#pragma unroll
    for (int i = 0; i < 2; ++i) { int R, C; stage_rc(tid * 16 + i * 8192, R, C); const int Rb = Epi::PERM ? ((R & ~31) + perm32(R & 31)) : R;
        voffA[i] = (unsigned)(R * K + C) * 2u; voffB[i] = (unsigned)(Rb * K + C) * 2u; }
    constexpr bool GATHER = Sched::GATHER;
    int RA[2], CA[2];
#pragma unroll
    for (int i = 0; i < 2; ++i) stage_rc(tid * 16 + i * 8192, RA[i], CA[i]);
    const size_t kstep = (size_t)(BK * 2);
    const size_t hstep = (size_t)HALF * K * 2;
    const size_t tstep = 2 * hstep;
    const unsigned ldsw = (unsigned)wid * 1024u;
    const int aoff = lds_byte(wr * 64 + fr, fq * 8), boff = lds_byte(wc * 32 + fr, fq * 8);
#define PG8_SA(b, h) (((b) * 2 + (h)) * HTB)
#define PG8_SB(b, h) ((4 + (b) * 2 + (h)) * HTB)
#define PG8_STAGE(bufoff, gbase, voff) do { _Pragma("unroll") for (int _i = 0; _i < 2; ++_i) \
        __builtin_amdgcn_global_load_lds((const unsigned*)((const char*)(gbase) + (voff)[_i]), (PG8_LAS unsigned*)(lds + (bufoff) + ldsw + _i * 8192), 16, 0, 0); } while (0)
#define PG8_LDA(dst, b, h) do { if constexpr (F8) { _Pragma("unroll") for (int m = 0; m < 4; ++m) dst##8[m] = __builtin_shufflevector(*(const PG8_LAS v4i32*)(lds + PG8_SA(b, h) + aoff + m * 2048), *(const PG8_LAS v4i32*)(lds + PG8_SA(b, h) + aoff + m * 2048 + 1024), 0, 1, 2, 3, 4, 5, 6, 7); } \
    else { _Pragma("unroll") for (int m = 0; m < 4; ++m) _Pragma("unroll") for (int k = 0; k < 2; ++k) dst[m][k] = *(const PG8_LAS bf16x8*)(lds + PG8_SA(b, h) + aoff + m * 2048 + k * 1024); } } while (0)
#define PG8_LDB(dst, b, h) do { if constexpr (F8) { _Pragma("unroll") for (int n = 0; n < 2; ++n) dst##8[n] = __builtin_shufflevector(*(const PG8_LAS v4i32*)(lds + PG8_SB(b, h) + boff + n * 2048), *(const PG8_LAS v4i32*)(lds + PG8_SB(b, h) + boff + n * 2048 + 1024), 0, 1, 2, 3, 4, 5, 6, 7); } \
    else { _Pragma("unroll") for (int n = 0; n < 2; ++n) _Pragma("unroll") for (int k = 0; k < 2; ++k) dst[n][k] = *(const PG8_LAS bf16x8*)(lds + PG8_SB(b, h) + boff + n * 2048 + k * 1024); } } while (0)
#define PG8_MMA(ai, bj, At, Bt) do { __builtin_amdgcn_s_setprio(1); _Pragma("unroll") for (int m = 0; m < 4; ++m) _Pragma("unroll") for (int n = 0; n < 2; ++n) { \
        if constexpr (F8) asm volatile("v_mfma_scale_f32_16x16x128_f8f6f4 %0, %1, %2, %0, %3, %3 op_sel_hi:[0,0,0]" : "+v"(acc[ai][bj][m][n]) : "v"(Bt##8[n]), "v"(At##8[m]), "v"(f8scale));   \
        else { _Pragma("unroll") for (int k = 0; k < 2; ++k) acc[ai][bj][m][n] = __builtin_amdgcn_mfma_f32_16x16x32_bf16(Bt[n][k], At[m][k], acc[ai][bj][m][n], 0, 0, 0); } } \
        __builtin_amdgcn_s_setprio(0); } while (0)
#define PG8_WAIT_V(n) asm volatile("s_waitcnt vmcnt(" #n ")" ::: "memory")
#define PG8_WAIT_L(n) asm volatile("s_waitcnt lgkmcnt(" #n ")" ::: "memory")
#define PG8_BAR __builtin_amdgcn_s_barrier()
#define PG8_SCHED __builtin_amdgcn_sched_barrier(0)
    Unit cur, nxt; int ui = 0;
    if (!S.next(0, cur)) return;
    f32x4 acc[2][2][4][2];
#pragma unroll
    for (int a = 0; a < 2; ++a)
#pragma unroll
        for (int b = 0; b < 2; ++b)
#pragma unroll
            for (int m = 0; m < 4; ++m)
#pragma unroll
                for (int n = 0; n < 2; ++n) acc[a][b][m][n] = (f32x4){0.f, 0.f, 0.f, 0.f};
    bf16x8 At[4][2], B0[2][2], B1[2][2]; v8i32 At8[4], B08[2], B18[2];
    const int f8scale = 0x7F7F7F7F; (void)f8scale;
    const char* cA = GATHER ? (const char*)g.A : (const char*)g.A + (size_t)cur.pm * tstep; const char* cB = (const char*)g.Bt + (size_t)cur.pn * tstep;
    unsigned offC[2][2], offN[2][2];
#define PG8_SETOFF(o, u) do { _Pragma("unroll") for (int _h = 0; _h < 2; ++_h) _Pragma("unroll") for (int _i = 0; _i < 2; ++_i) { \
        if constexpr (GATHER) o[_h][_i] = (unsigned)S.rowmap[(u).pm * BM + _h * HALF + RA[_i]] * (unsigned)(K * 2) + (unsigned)(CA[_i] * 2); \
        else o[_h][_i] = voffA[_i] + (unsigned)(_h * (int)hstep); } } while (0)
    PG8_SETOFF(offC, cur);
#pragma unroll
    for (int _h = 0; _h < 2; ++_h) { offN[_h][0] = offC[_h][0]; offN[_h][1] = offC[_h][1]; }
    float rs[8];
    E.pre(cur, wr, fr, rs);
    S.a_ready(cur);
    if constexpr (SP2) {
        PG8_STAGE(PG8_SB(0, 0), cB, voffB); PG8_STAGE(PG8_SB(0, 1), cB + hstep, voffB); PG8_STAGE(PG8_SA(0, 0), cA, offC[0]); PG8_STAGE(PG8_SA(0, 1), cA, offC[1]);
        if (wr == 1) PG8_BAR;
        PG8_WAIT_V(2); PG8_BAR;
        PG8_STAGE(PG8_SB(1, 0), cB + kstep, voffB); PG8_STAGE(PG8_SA(1, 0), cA + kstep, offC[0]); PG8_STAGE(PG8_SB(1, 1), cB + hstep + kstep, voffB);
        PG8_WAIT_V(6); PG8_BAR;
    } else {
        PG8_STAGE(PG8_SB(0, 0), cB, voffB); PG8_STAGE(PG8_SA(0, 0), cA, voffA); PG8_STAGE(PG8_SB(0, 1), cB + hstep, voffB); PG8_STAGE(PG8_SA(0, 1), cA + hstep, voffA);
        if (wr == 1) PG8_BAR;
        PG8_WAIT_V(4); PG8_BAR;
        PG8_STAGE(PG8_SB(1, 0), cB + kstep, voffB); PG8_STAGE(PG8_SA(1, 0), cA + kstep, voffA); PG8_STAGE(PG8_SB(1, 1), cB + hstep + kstep, voffB);
        PG8_WAIT_V(6); PG8_BAR;
    }
    for (;;) {
        const bool has_next = S.next(ui + 1, nxt);
        const char* nA = GATHER ? cA : (has_next ? (const char*)g.A + (size_t)nxt.pm * tstep : cA); const char* nB = has_next ? (const char*)g.Bt + (size_t)nxt.pn * tstep : cB;
        if constexpr (GATHER) { if (has_next) PG8_SETOFF(offN, nxt); }
        for (int t = 0; t < nt; t += 2) {
            const bool last = (t == nt - 2);
            const char* a1 = cA + (size_t)(t + 1) * kstep;
            const char* a2 = last ? nA : cA + (size_t)(t + 2) * kstep; const char* b2 = last ? nB : cB + (size_t)(t + 2) * kstep;
            const char* a3 = a2 + kstep; const char* b3 = b2 + kstep;
            if (last && has_next) S.a_ready(nxt);
            unsigned o2[2][2];
#pragma unroll
            for (int _h = 0; _h < 2; ++_h)
#pragma unroll
                for (int _i = 0; _i < 2; ++_i) o2[_h][_i] = (GATHER && last) ? offN[_h][_i] : offC[_h][_i];
            if constexpr (SP2) {
            PG8_LDB(B0, 0, 0); PG8_LDB(B1, 0, 1); PG8_SCHED; PG8_LDA(At, 0, 0); PG8_STAGE(PG8_SA(1, 1), a1, offC[1]);
            PG8_WAIT_V(8); PG8_WAIT_L(0); PG8_BAR; PG8_MMA(0, 0, At, B0); PG8_MMA(0, 1, At, B1); PG8_BAR; PG8_SCHED;
            PG8_LDA(At, 0, 1); PG8_STAGE(PG8_SB(0, 0), b2, voffB); PG8_STAGE(PG8_SB(0, 1), b2 + hstep, voffB); PG8_STAGE(PG8_SA(0, 0), a2, o2[0]);
            PG8_WAIT_V(8); PG8_WAIT_L(0); PG8_BAR; PG8_MMA(1, 0, At, B0); PG8_MMA(1, 1, At, B1); PG8_BAR; PG8_SCHED;
            PG8_LDB(B0, 1, 0); PG8_LDB(B1, 1, 1); PG8_SCHED; PG8_LDA(At, 1, 0); PG8_STAGE(PG8_SA(0, 1), a2, o2[1]);
            PG8_WAIT_V(8); PG8_WAIT_L(0); PG8_BAR; PG8_MMA(0, 0, At, B0); PG8_MMA(0, 1, At, B1); PG8_BAR; PG8_SCHED;
            PG8_LDA(At, 1, 1); PG8_STAGE(PG8_SB(1, 0), b3, voffB); PG8_STAGE(PG8_SB(1, 1), b3 + hstep, voffB); PG8_STAGE(PG8_SA(1, 0), a3, o2[0]);
            PG8_WAIT_V(8); PG8_WAIT_L(0); PG8_BAR; PG8_MMA(1, 0, At, B0); PG8_MMA(1, 1, At, B1); PG8_BAR; PG8_SCHED;
            } else {
            PG8_LDB(B0, 0, 0); PG8_SCHED; PG8_LDA(At, 0, 0); PG8_STAGE(PG8_SA(1, 1), a1 + hstep, voffA);
            PG8_WAIT_L(8); PG8_BAR; PG8_WAIT_L(0); PG8_MMA(0, 0, At, B0); PG8_BAR; PG8_SCHED;
            PG8_LDB(B1, 0, 1); PG8_STAGE(PG8_SB(0, 0), b2, voffB);
            PG8_BAR; PG8_WAIT_L(0); PG8_MMA(0, 1, At, B1); PG8_BAR;
            PG8_LDA(At, 0, 1); PG8_STAGE(PG8_SA(0, 0), a2, voffA);
            PG8_BAR; PG8_WAIT_L(0); PG8_MMA(1, 0, At, B0); PG8_BAR; PG8_SCHED;
            PG8_STAGE(PG8_SB(0, 1), b2 + hstep, voffB);
            PG8_WAIT_V(6); PG8_BAR; PG8_MMA(1, 1, At, B1); PG8_BAR;
            PG8_LDB(B0, 1, 0); PG8_SCHED; PG8_LDA(At, 1, 0); PG8_STAGE(PG8_SA(0, 1), a2 + hstep, voffA);
            PG8_WAIT_L(8); PG8_BAR; PG8_WAIT_L(0); PG8_MMA(0, 0, At, B0); PG8_BAR; PG8_SCHED;
            PG8_LDB(B1, 1, 1); PG8_STAGE(PG8_SB(1, 0), b3, voffB);
            PG8_BAR; PG8_WAIT_L(0); PG8_MMA(0, 1, At, B1); PG8_BAR;
            PG8_LDA(At, 1, 1); PG8_STAGE(PG8_SA(1, 0), a3, voffA);
            PG8_BAR; PG8_WAIT_L(0); PG8_MMA(1, 0, At, B0); PG8_BAR; PG8_SCHED;
            PG8_STAGE(PG8_SB(1, 1), b3 + hstep, voffB);
            PG8_WAIT_V(6); PG8_BAR; PG8_MMA(1, 1, At, B1); PG8_BAR;
            }
        }
        if constexpr (F8) asm volatile("s_nop 15\n\ts_nop 15" ::: "memory");
        if constexpr (ALIGN_EPI) { if (wr == 0) PG8_BAR; }
        if constexpr (!Epi::AFTER_DRAIN) { E(acc, cur, wr, wc, fr, fq, rs); S.done(cur); }
        if (!has_next) break;
#pragma unroll
        for (int a = 0; a < 2; ++a)
#pragma unroll
            for (int b = 0; b < 2; ++b)
#pragma unroll
                for (int m = 0; m < 4; ++m)
#pragma unroll
                    for (int n = 0; n < 2; ++n) acc[a][b][m][n] = (f32x4){0.f, 0.f, 0.f, 0.f};
        cur = nxt; cA = nA; cB = nB; ++ui;
        E.pre(cur, wr, fr, rs);
#pragma unroll
        for (int _h = 0; _h < 2; ++_h) { offC[_h][0] = offN[_h][0]; offC[_h][1] = offN[_h][1]; }
        if constexpr (ALIGN_EPI) { if (wr == 1) PG8_BAR; }
    }
    PG8_WAIT_V(0);
    if constexpr (!ALIGN_EPI) { if (wr == 0) PG8_BAR; }
    PG8_BAR;
    if constexpr (Epi::AFTER_DRAIN) { E.fused(acc, cur, wr, wc, fr, fq, lds, wid, lane); S.done(cur); }
#undef PG8_SETOFF
#undef PG8_SA
#undef PG8_SB
#undef PG8_STAGE
#undef PG8_LDA
#undef PG8_LDB
#undef PG8_MMA
#undef PG8_WAIT_V
#undef PG8_WAIT_L
#undef PG8_BAR
#undef PG8_SCHED
}
}

constexpr int D = 2048, BATCH = 4, SEQ = 4096, MTOK = BATCH * SEQ, DEPTH = 2;
constexpr int NIN = 6160, NPROJ = 6144;
constexpr int C_NAQ = 0, C_NAK = 1024, C_NAV = 2048, C_MLQ = 3072, C_MLK = 3584, C_MLV = 4096, C_MLO = 5120, C_GATES = 6144;
constexpr int NE = 16, CAP = 512, DE = 1024, MR = NE * BATCH * CAP;
constexpr float EPS = 1e-6f;

typedef unsigned short bf16;
typedef float f32x4 __attribute__((ext_vector_type(4)));
typedef unsigned v4u __attribute__((ext_vector_type(4)));
typedef unsigned v2u __attribute__((ext_vector_type(2)));
#define LAS __attribute__((address_space(3)))
typedef short bf16x8v __attribute__((ext_vector_type(8)));
typedef short s16x4 __attribute__((ext_vector_type(4)));
constexpr size_t WS_XB8 = 968 * (size_t)(1u << 20);
constexpr size_t WS_SSQ = 6 * (size_t)(1u << 20) + 512 * 1024;
constexpr size_t WS_RSNA = 7 * (size_t)(1u << 20) + 64 * 1024;
constexpr size_t WS_W16F_OFF = 7 * (1u << 20) + 256 * 1024;

constexpr size_t MiB = 1u << 20;
constexpr size_t WS_CTL = 0;
constexpr size_t WS_RSTD = 1 * MiB;
constexpr size_t WS_GATES = 2 * MiB;
constexpr size_t WS_AFF = 3 * MiB;
constexpr size_t WS_TOK = 4 * MiB;
constexpr size_t WS_GATEV = 4 * MiB + 512 * 1024;
constexpr size_t WS_SEL = 5 * MiB;
constexpr size_t WS_WIN = 8 * MiB;
constexpr size_t WS_WOUT = 56 * MiB;
constexpr size_t WS_WGU = 72 * MiB;
constexpr size_t WS_WD = 328 * MiB;
constexpr size_t WS_XB = 456 * MiB;
constexpr size_t WS_MIX = 520 * MiB;
constexpr size_t WS_P = 584 * MiB;
constexpr size_t WS_NAO = 776 * MiB;
constexpr size_t WS_HF = 840 * MiB;
constexpr size_t WS_ACT = 712 * MiB;
constexpr size_t WS_Y = 776 * MiB;
constexpr size_t WS_END = 1000 * MiB;

__device__ __forceinline__ unsigned f2bf(float f) { unsigned u = __builtin_bit_cast(unsigned, f); return (u + 0x7fffu + ((u >> 16) & 1u)) >> 16; }
__device__ __forceinline__ unsigned pk2(float lo, float hi) { return f2bf(lo) | (f2bf(hi) << 16); }
__device__ __forceinline__ float bf2f(unsigned short b) { return __builtin_bit_cast(float, ((unsigned)b) << 16); }
__device__ __forceinline__ float bflo(unsigned w) { return __builtin_bit_cast(float, w << 16); }
__device__ __forceinline__ float bfhi(unsigned w) { return __builtin_bit_cast(float, w & 0xffff0000u); }
__device__ __forceinline__ float row_ror(float v, int n) { return n == 8 ? __uint_as_float(__builtin_amdgcn_update_dpp(0, __float_as_uint(v), 0x128, 0xf, 0xf, false)) : n == 4 ? __uint_as_float(__builtin_amdgcn_update_dpp(0, __float_as_uint(v), 0x124, 0xf, 0xf, false))
        : n == 2 ? __uint_as_float(__builtin_amdgcn_update_dpp(0, __float_as_uint(v), 0x122, 0xf, 0xf, false)) : __uint_as_float(__builtin_amdgcn_update_dpp(0, __float_as_uint(v), 0x121, 0xf, 0xf, false)); }
__device__ __forceinline__ float row16_sum(float v) { v += row_ror(v, 8); v += row_ror(v, 4); v += row_ror(v, 2); v += row_ror(v, 1); return v; }
__device__ __forceinline__ float row16_max(float v) { v = fmaxf(v, row_ror(v, 8)); v = fmaxf(v, row_ror(v, 4)); v = fmaxf(v, row_ror(v, 2)); v = fmaxf(v, row_ror(v, 1)); return v; }
__device__ __forceinline__ float rows4_sum(float v) {
    auto a = __builtin_amdgcn_permlane16_swap(__float_as_uint(v), __float_as_uint(v), false, false); v = __uint_as_float(a[0]) + __uint_as_float(a[1]);
    auto b = __builtin_amdgcn_permlane32_swap(__float_as_uint(v), __float_as_uint(v), false, false); return __uint_as_float(b[0]) + __uint_as_float(b[1]); }
__device__ __forceinline__ float rows4_max(float v) {
    auto a = __builtin_amdgcn_permlane16_swap(__float_as_uint(v), __float_as_uint(v), false, false); v = fmaxf(__uint_as_float(a[0]), __uint_as_float(a[1]));
    auto b = __builtin_amdgcn_permlane32_swap(__float_as_uint(v), __float_as_uint(v), false, false); return fmaxf(__uint_as_float(b[0]), __uint_as_float(b[1])); }
__device__ __forceinline__ float wave_sum(float v) { return rows4_sum(row16_sum(v)); }
__device__ __forceinline__ float wave_max(float v) { return rows4_max(row16_max(v)); }

struct ConvItem { const float* W; const float* gk; bf16* WT; int ldw, K, k0, n0, dmode, f8; float wmul; };
template <class T> __device__ __forceinline__ T* uni_ptr(T* p) { const unsigned long long v = (unsigned long long)p;
    const unsigned lo = __builtin_amdgcn_readfirstlane((unsigned)v), hi = __builtin_amdgcn_readfirstlane((unsigned)(v >> 32)); return (T*)(((unsigned long long)hi << 32) | lo); }
__device__ __forceinline__ void ti_load(const ConvItem& d, int lane, f32x4 (&wv)[16], f32x4 (&gv)[2]) {
    const int r4 = lane >> 4, c4 = (lane & 15) * 4;
    const float* gp = uni_ptr(d.gk ? d.gk + d.k0 : d.W);
    const unsigned gvo = 32u * (lane & 7);
    asm volatile("global_load_dwordx4 %0, %1, %2" : "=v"(gv[0]) : "v"(gvo), "s"(gp) : "memory");
    asm volatile("global_load_dwordx4 %0, %1, %2 offset:16" : "=v"(gv[1]) : "v"(gvo), "s"(gp) : "memory");
    const unsigned voff = (unsigned)(r4 * d.ldw + c4) * 4u;
#pragma unroll
    for (int i = 0; i < 16; ++i) { const float* p = uni_ptr(d.W + (size_t)(d.k0 + 4 * i) * d.ldw + d.n0); asm volatile("global_load_dwordx4 %0, %1, %2" : "=v"(wv[i]) : "v"(voff), "s"(p) : "memory"); }
}
template <int N> __device__ __forceinline__ void ti_wait(f32x4 (&wv)[16], f32x4 (&gv)[2]) {
    asm volatile("s_waitcnt vmcnt(%18)" : "+v"(wv[0]), "+v"(wv[1]), "+v"(wv[2]), "+v"(wv[3]), "+v"(wv[4]), "+v"(wv[5]), "+v"(wv[6]), "+v"(wv[7]), "+v"(wv[8]), "+v"(wv[9]), "+v"(wv[10]), "+v"(wv[11]),
                 "+v"(wv[12]), "+v"(wv[13]), "+v"(wv[14]), "+v"(wv[15]), "+v"(gv[0]), "+v"(gv[1]) : "n"(N) : "memory");
}
__device__ __forceinline__ unsigned cvt2bf(float lo, float hi) { unsigned r; asm("v_cvt_pk_bf16_f32 %0, %1, %2" : "=v"(r) : "v"(lo), "v"(hi)); return r; }
__device__ __forceinline__ void ti_finish(const ConvItem& d, int lane, const f32x4 (&wv)[16], const f32x4 (&gv)[2], LAS float* scr) {
    const int r4 = lane >> 4, c4 = (lane & 15) * 4;
#pragma unroll
    for (int i = 0; i < 16; ++i) { const int kk = 4 * i + r4; LAS float* p = scr + kk * 65 + c4; p[0] = wv[i][0]; p[1] = wv[i][1]; p[2] = wv[i][2]; p[3] = wv[i][3]; }
    asm volatile("s_waitcnt lgkmcnt(0)" ::: "memory");
    const int c = lane & 7; const float wmul = d.wmul;
    const bool hg = d.gk != nullptr;
    const float m0 = (hg ? gv[0][0] : 1.f) * wmul, m1 = (hg ? gv[0][1] : 1.f) * wmul, m2 = (hg ? gv[0][2] : 1.f) * wmul, m3 = (hg ? gv[0][3] : 1.f) * wmul,
                m4 = (hg ? gv[1][0] : 1.f) * wmul, m5 = (hg ? gv[1][1] : 1.f) * wmul, m6 = (hg ? gv[1][2] : 1.f) * wmul, m7 = (hg ? gv[1][3] : 1.f) * wmul;
    const int es = d.f8 ? 1 : 2;
    const unsigned svo = (unsigned)((lane >> 3) * d.K + 8 * c) * (unsigned)es;
    const int rb0 = d.dmode == 0 ? d.n0 : ((d.n0 >> 4) * 32 + (d.dmode == 2 ? 16 : 0));
    const LAS float* s0 = scr + (8 * c) * 65 + (lane >> 3);
#pragma unroll
    for (int j = 0; j < 8; ++j) { const LAS float* s = s0 + 8 * j;
        const int rb = rb0 + (d.dmode == 0 ? 8 * j : 32 * (j >> 1) + 8 * (j & 1));
        unsigned char* sp = uni_ptr((unsigned char*)d.WT + ((size_t)rb * d.K + d.k0) * es);
        const float y0 = s[0 * 65] * m0, y1 = s[1 * 65] * m1, y2 = s[2 * 65] * m2, y3 = s[3 * 65] * m3, y4 = s[4 * 65] * m4, y5 = s[5 * 65] * m5, y6 = s[6 * 65] * m6, y7 = s[7 * 65] * m7;
        if (d.f8) { v2u o8; int p = __builtin_amdgcn_cvt_pk_fp8_f32(y0, y1, 0, false); p = __builtin_amdgcn_cvt_pk_fp8_f32(y2, y3, p, true); o8.x = (unsigned)p;
            p = __builtin_amdgcn_cvt_pk_fp8_f32(y4, y5, 0, false); p = __builtin_amdgcn_cvt_pk_fp8_f32(y6, y7, p, true); o8.y = (unsigned)p;
            asm volatile("global_store_dwordx2 %0, %1, %2" : : "v"(svo), "v"(o8), "s"(sp) : "memory"); }
        else { v4u o; o.x = cvt2bf(y0, y1); o.y = cvt2bf(y2, y3); o.z = cvt2bf(y4, y5); o.w = cvt2bf(y6, y7);
            asm volatile("global_store_dwordx4 %0, %1, %2" : : "v"(svo), "v"(o), "s"(sp) : "memory"); } }
    asm volatile("s_waitcnt lgkmcnt(0)" ::: "memory");
}
constexpr int CONV_SCR_BYTES = 64 * 65 * 4;
constexpr float Y8_SCALE = 16.0f;
typedef float f32x2 __attribute__((ext_vector_type(2)));
constexpr int NPROJ16 = 5120;
constexpr float W8_SCALE = 64.0f;
struct ConvArgs { const float *w_in, *w_out, *w_gate, *w_up, *w_down, *norm_mix_g, *norm_ffn_g, *na_norm_g; unsigned char* ws; };
constexpr int CI_IN = 32 * 96, CI_OUT = 32 * 32, CI_G = 16 * 32 * 16, CI_D = 16 * 16 * 32, CI_LAYER = CI_IN + CI_OUT + 2 * CI_G + CI_D;
__device__ __forceinline__ ConvItem convert_decode(const ConvArgs& a, int it) {
    ConvItem d; d.f8 = 0; d.wmul = 1.0f; d.gk = nullptr; d.dmode = 0; d.K = D;
    const int l = it / CI_LAYER; int r = it % CI_LAYER;
    if (r < CI_IN) { const int kb = r / 96, nb = r % 96; d.ldw = NIN; d.gk = a.norm_mix_g + l * D; d.k0 = 64 * kb;
        if (64 * nb < NPROJ16) { d.W = a.w_in + (size_t)l * D * NIN; d.WT = (bf16*)(a.ws + WS_WIN) + (size_t)l * NPROJ * D; d.n0 = 64 * nb; }
        else { d.W = a.w_in + (size_t)l * D * NIN + NPROJ16; d.WT = (bf16*)(a.ws + WS_WIN + ((size_t)l * NPROJ + NPROJ16) * D * 2); d.n0 = 64 * nb - NPROJ16; d.f8 = 1; d.wmul = W8_SCALE; }
        return d; }
    r -= CI_IN;
    if (r < CI_OUT) { const int kb = r / 32, nb = r % 32; d.W = a.w_out + (size_t)l * D * D; d.ldw = D; if (64 * kb < 1024) d.gk = a.na_norm_g + l * 1024;
        d.WT = (bf16*)(a.ws + WS_WOUT) + (size_t)l * D * D; d.k0 = 64 * kb; d.n0 = 64 * nb; return d; }
    r -= CI_OUT;
    if (r < 2 * CI_G) { const int up = r >= CI_G; if (up) r -= CI_G; const int e = r / 512, q = r % 512, kb = q / 16, nb = q % 16;
        d.W = (up ? a.w_up : a.w_gate) + ((size_t)l * NE + e) * D * DE; d.ldw = DE; d.gk = a.norm_ffn_g + l * D; d.WT = (bf16*)(a.ws + WS_WGU + ((size_t)l * NE + e) * 2048 * D); d.k0 = 64 * kb; d.n0 = 64 * nb; d.dmode = up ? 2 : 1; d.f8 = 1; d.wmul = W8_SCALE; return d; }
    r -= 2 * CI_G;
    { const int e = r / 512, q = r % 512, kb = q / 32, nb = q % 32; d.W = a.w_down + ((size_t)l * NE + e) * DE * D; d.ldw = D; d.WT = (bf16*)(a.ws + WS_WD + ((size_t)l * NE + e) * D * DE); d.K = DE; d.k0 = 64 * kb; d.n0 = 64 * nb; d.f8 = 1; d.wmul = W8_SCALE; return d; }
}
__device__ __forceinline__ void convert_stream(const ConvArgs& a, int first_, int stride, int end, LAS float* scr, int lane) {
    const int first = __builtin_amdgcn_readfirstlane(first_);
    if (first >= end) return;
    const int n = (end - first + stride - 1) / stride, last = first + (n - 1) * stride;
    f32x4 w0[16], w1[16], g0[2], g1[2]; ConvItem d0 = convert_decode(a, first), d1 = convert_decode(a, min(first + stride, last)); ti_load(d0, lane, w0, g0); ti_load(d1, lane, w1, g1);
    ti_wait<18>(w0, g0); ti_finish(d0, lane, w0, g0, scr);
    d0 = convert_decode(a, min(first + 2 * stride, last)); ti_load(d0, lane, w0, g0);
#pragma unroll 1
    for (int it = first + stride; it <= last; it += 2 * stride) {
        ti_wait<26>(w1, g1); ti_finish(d1, lane, w1, g1, scr);
        d1 = convert_decode(a, min(it + 2 * stride, last)); ti_load(d1, lane, w1, g1);
        ti_wait<26>(w0, g0); ti_finish(d0, lane, w0, g0, scr);
        d0 = convert_decode(a, min(it + 3 * stride, last)); ti_load(d0, lane, w0, g0);
    }
    asm volatile("s_waitcnt vmcnt(0)" ::: "memory");
}
#define XB_TMO      128
#define XB_XCNT(j)  (256  + 64 * (j))
#define XB_XSUB(j)  (1280 + 64 * (j))
#define XB_XGEN(j)  (2304 + 64 * (j))
#define XB_TOP      3328
#define XB_TOPGEN   3392
#define XCD_BAR_WORDS 3456
#define XB_SPIN_CAP (1u << 18)

__device__ __forceinline__ unsigned xb_ld(unsigned* p)              { return __hip_atomic_load(p, __ATOMIC_RELAXED, __HIP_MEMORY_SCOPE_AGENT); }
__device__ __forceinline__ unsigned xb_add(unsigned* p, unsigned v) { return __hip_atomic_fetch_add(p, v, __ATOMIC_RELAXED, __HIP_MEMORY_SCOPE_AGENT); }
__device__ __forceinline__ unsigned xb_xcc_id() { return (unsigned)__builtin_amdgcn_s_getreg((3 << 11) | 20) & 0xFu; }
#define XB_SPIN(cond, bar) do { unsigned _sp = 0; while (cond) { __builtin_amdgcn_s_sleep(1); \
    if ((++_sp & 255u) == 0u) { if (xb_ld(&(bar)[XB_TMO])) break; if (_sp > XB_SPIN_CAP) { atomicAdd(&(bar)[XB_TMO], 1u); break; } } } } while (0)

struct XcdBarrier {
    unsigned* bar; unsigned x;
    volatile LAS unsigned* st;
};

__device__ __forceinline__ XcdBarrier xcd_barrier_post(unsigned* bar, volatile LAS unsigned* st) {
    XcdBarrier b; b.bar = bar; b.x = xb_xcc_id(); b.st = st;
    if (threadIdx.x == 0) (void)xb_add(&bar[XB_XCNT(b.x)], 1u);
    return b;
}
__device__ __forceinline__ void xcd_barrier_complete(unsigned* bar, unsigned x, unsigned& nloc, unsigned& nx) {
    const unsigned G = gridDim.x * gridDim.y * gridDim.z;
    unsigned sum, cnt, mine, sp = 0u;
    for (;;) {
        sum = 0u; cnt = 0u; mine = 0u;
#pragma unroll
        for (unsigned j = 0; j < 16; ++j) { const unsigned c = xb_ld(&bar[XB_XCNT(j)]); sum += c; cnt += (c > 0u) ? 1u : 0u; mine = (j == x) ? c : mine; }
        if (sum == G) break;
        __builtin_amdgcn_s_sleep(1);
        if ((++sp & 255u) == 0u) { if (xb_ld(&bar[XB_TMO])) break; if (sp > XB_SPIN_CAP) { atomicAdd(&bar[XB_TMO], 1u); break; } }
    }
    nloc = mine > 0u ? mine : 1u; nx = cnt > 0u ? cnt : 1u;
}

__device__ __forceinline__ void xcd_barrier(const XcdBarrier& b) {
    asm volatile("s_waitcnt vmcnt(0)" ::: "memory");
    __syncthreads();
    if (threadIdx.x == 0) {
        unsigned* bar = b.bar;
        __builtin_amdgcn_s_waitcnt(0);
        unsigned nloc = b.st[0], nx = b.st[1];
        if (nloc == 0u) { xcd_barrier_complete(bar, b.x, nloc, nx); b.st[0] = nloc; b.st[1] = nx; }
        const unsigned old = xb_add(&bar[XB_XSUB(b.x)], 1u);
        const unsigned gen = old / nloc;
        if (old + 1u == (gen + 1u) * nloc) {
            __builtin_amdgcn_fence(__ATOMIC_RELEASE, "agent");
            asm volatile("s_waitcnt vmcnt(0)" ::: "memory");
            const unsigned og = xb_add(&bar[XB_TOP], 1u);
            const unsigned tg = og / nx;
            if (og + 1u == (tg + 1u) * nx) xb_add(&bar[XB_TOPGEN], 1u);
            else XB_SPIN(xb_ld(&bar[XB_TOPGEN]) == tg, bar);
            __builtin_amdgcn_fence(__ATOMIC_ACQUIRE, "agent");
            xb_add(&bar[XB_XGEN(b.x)], 1u);
            asm volatile("s_waitcnt vmcnt(0)" ::: "memory");
        } else {
            XB_SPIN(xb_ld(&bar[XB_XGEN(b.x)]) == gen, bar);
            __builtin_amdgcn_fence(__ATOMIC_ACQUIRE, "agent");
            asm volatile("s_waitcnt vmcnt(0)" ::: "memory");
        }
    }
    __syncthreads();
}

struct RowArgs { const float* src32; const bf16* srcb; const int* sel; const unsigned char* Y; bf16* XB; unsigned char* XB8; float* RSTD; const float* g; const bf16* W16F; const float* bias; float* GATES; float* AFF; float* out; int mode; int wrxb; };
__device__ __forceinline__ void rowpass_finish(const RowArgs& a, int row, int rr, int s0, int s1, f32x4 (&v)[8], int lane) {
    const int b = row / SEQ;
    if (a.sel) {
        const int sw = rr < 4 ? s0 : s1;
#pragma unroll
        for (int eh = 0; eh < 2; ++eh) { int yw[8][8]; int cc[8];
#pragma unroll
            for (int k = 0; k < 8; ++k) { const int e = 8 * eh + k; cc[k] = __builtin_amdgcn_readlane(sw, ((rr & 3) << 4) + e);
                if (cc[k] >= 0) { const unsigned char* y = a.Y + (size_t)(e * 2048 + b * 512 + cc[k]) * D + 4 * lane;
#pragma unroll
                    for (int j = 0; j < 8; ++j) yw[k][j] = *(const int*)(y + 256 * j); } }
#pragma unroll
            for (int k = 0; k < 8; ++k) if (cc[k] >= 0) {
#pragma unroll
                for (int j = 0; j < 8; ++j) { const f32x2 lo = __builtin_amdgcn_cvt_pk_f32_fp8(yw[k][j], false), hi = __builtin_amdgcn_cvt_pk_f32_fp8(yw[k][j], true);
                    v[j][0] += lo[0] * (1.0f / Y8_SCALE); v[j][1] += lo[1] * (1.0f / Y8_SCALE); v[j][2] += hi[0] * (1.0f / Y8_SCALE); v[j][3] += hi[1] * (1.0f / Y8_SCALE); } } }
    }
    float ss = 0.f;
#pragma unroll
    for (int j = 0; j < 8; ++j) ss += (v[j][0] * v[j][0] + v[j][1] * v[j][1]) + (v[j][2] * v[j][2] + v[j][3] * v[j][3]);
    ss = wave_sum(ss);
    const float rstd = 1.0f / sqrtf(ss * (1.0f / D) + EPS);
    if (a.mode == 2) {
#pragma unroll
        for (int j = 0; j < 8; ++j) { const f32x4 g = *(const f32x4*)(a.g + 4 * lane + 256 * j); *(f32x4*)(a.out + (size_t)row * D + 4 * lane + 256 * j) = v[j] * rstd * g; }
        return;
    }
    if (a.wrxb) {
#pragma unroll
        for (int j = 0; j < 8; ++j) { v2u w; w.x = pk2(v[j][0], v[j][1]); w.y = pk2(v[j][2], v[j][3]); *(v2u*)(a.XB + (size_t)row * D + 4 * lane + 256 * j) = w; } }
    if (a.XB8) {
#pragma unroll
        for (int j = 0; j < 8; ++j) *(unsigned*)(a.XB8 + (size_t)row * D + 4 * lane + 256 * j) = pg8::pk4_fp8(v[j][0], v[j][1], v[j][2], v[j][3]); }
    if (lane == 0) a.RSTD[row] = rstd;
}
template <bool SRC32> __device__ __forceinline__ void rowpass_group(const RowArgs& a, int grp, int lane_) {
    int lane = lane_; asm volatile("" : "+v"(lane));
    int s0 = -1, s1 = -1; if (a.sel) { s0 = a.sel[grp * 128 + lane]; s1 = a.sel[grp * 128 + 64 + lane]; }
    f32x4 v[8];
    if constexpr (SRC32) {
        f32x4 vn[8];
#pragma unroll
        for (int j = 0; j < 8; ++j) v[j] = *(const f32x4*)(a.src32 + (size_t)(8 * grp) * D + 4 * lane + 256 * j);
#pragma unroll 1
        for (int rr = 0; rr < 8; ++rr) { const int row = 8 * grp + rr;
            if (rr < 7) {
#pragma unroll
                for (int j = 0; j < 8; ++j) vn[j] = *(const f32x4*)(a.src32 + (size_t)(row + 1) * D + 4 * lane + 256 * j); }
            rowpass_finish(a, row, rr, s0, s1, v, lane);
#pragma unroll
            for (int j = 0; j < 8; ++j) v[j] = vn[j]; }
    } else if (!a.sel) {
        v2u w[8][8];
#pragma unroll
        for (int rr = 0; rr < 8; ++rr)
#pragma unroll
            for (int j = 0; j < 8; ++j) w[rr][j] = *(const v2u*)(a.srcb + (size_t)(8 * grp + rr) * D + 4 * lane + 256 * j);
#pragma unroll
        for (int rr = 0; rr < 8; ++rr) {
#pragma unroll
            for (int j = 0; j < 8; ++j) v[j] = (f32x4){bflo(w[rr][j].x), bfhi(w[rr][j].x), bflo(w[rr][j].y), bfhi(w[rr][j].y)};
            rowpass_finish(a, 8 * grp + rr, rr, s0, s1, v, lane); }
    } else {
        v2u w[8], wn[8];
#pragma unroll
        for (int j = 0; j < 8; ++j) w[j] = *(const v2u*)(a.srcb + (size_t)(8 * grp) * D + 4 * lane + 256 * j);
#pragma unroll 1
        for (int rr = 0; rr < 8; ++rr) { const int row = 8 * grp + rr;
            if (rr < 7) {
#pragma unroll
                for (int j = 0; j < 8; ++j) wn[j] = *(const v2u*)(a.srcb + (size_t)(row + 1) * D + 4 * lane + 256 * j); }
#pragma unroll
            for (int j = 0; j < 8; ++j) v[j] = (f32x4){bflo(w[j].x), bfhi(w[j].x), bflo(w[j].y), bfhi(w[j].y)};
            rowpass_finish(a, row, rr, s0, s1, v, lane);
#pragma unroll
            for (int j = 0; j < 8; ++j) w[j] = wn[j]; }
    }
    if (a.mode == 2) return;
    asm volatile("s_waitcnt vmcnt(0)" ::: "memory");
    const int g = lane >> 4, lc = lane & 15;
    f32x4 acc = (f32x4){0.f, 0.f, 0.f, 0.f};
    const bf16* xr = a.XB + (size_t)(8 * grp + (lc & 7)) * D + 8 * g; const bf16* wf = a.W16F + lane * 8;
    { bf16x8v fa[2][8], fb[2][8]; const bf16x8v zero8 = (bf16x8v){0, 0, 0, 0, 0, 0, 0, 0};
#pragma unroll
      for (int s = 0; s < 8; ++s) { fa[0][s] = *(const bf16x8v*)(xr + 32 * s); fb[0][s] = *(const bf16x8v*)(wf + s * 512); }
#pragma unroll
      for (int q = 0; q < 8; ++q) {
          if (q < 7) {
#pragma unroll
              for (int s = 0; s < 8; ++s) { fa[(q + 1) & 1][s] = *(const bf16x8v*)(xr + 32 * (8 * (q + 1) + s)); fb[(q + 1) & 1][s] = *(const bf16x8v*)(wf + (8 * (q + 1) + s) * 512); } }
#pragma unroll
          for (int s = 0; s < 8; ++s) acc = __builtin_amdgcn_mfma_f32_16x16x32_bf16(lc >= 8 ? zero8 : fa[q & 1][s], fb[q & 1][s], acc, 0, 0, 0); } }
    float rs[4];
#pragma unroll
    for (int r = 0; r < 4; ++r) rs[r] = a.RSTD[8 * grp + 4 * (g & 1) + r];
    if (a.mode == 0) { const float bs = a.bias[lc];
#pragma unroll
        for (int r = 0; r < 4; ++r) { const float rstd = rs[r]; if (g < 2) a.GATES[(size_t)(8 * grp + 4 * g + r) * 16 + lc] = acc[r] * rstd + bs; } }
    else {
#pragma unroll
        for (int r = 0; r < 4; ++r) { const float rstd = rs[r]; const float lg = acc[r] * rstd; float mx = lg;
#pragma unroll
            for (int o = 1; o < 16; o <<= 1) mx = fmaxf(mx, __shfl_xor(mx, o));
            const float p = __expf(lg - mx); float sum = p;
#pragma unroll
            for (int o = 1; o < 16; o <<= 1) sum += __shfl_xor(sum, o);
            const int row = 8 * grp + 4 * g + r; if (g < 2) a.AFF[((size_t)(row / SEQ) * NE + lc) * SEQ + (row % SEQ)] = p / sum; } }
}
__device__ __forceinline__ void w16f_item(const float* W, int ldw, const float* gk, bf16* WF, int s, int lane) {
    const int g = lane >> 4, lc = lane & 15; float v[8];
#pragma unroll
    for (int i = 0; i < 8; ++i) { const int k = 32 * s + 8 * g + i; v[i] = W[(size_t)k * ldw + lc] * gk[k]; }
    v4u o; o.x = pk2(v[0], v[1]); o.y = pk2(v[2], v[3]); o.z = pk2(v[4], v[5]); o.w = pk2(v[6], v[7]);
    *(v4u*)(WF + (size_t)(s * 64 + lane) * 8) = o;
}

__device__ __forceinline__ void na_norm_item(const bf16* NAO, const float* g, bf16* MIX, int t, int lane) {
    f32x4 v[4]; float ss = 0.f;
#pragma unroll
    for (int j = 0; j < 4; ++j) { const v2u w = *(const v2u*)(NAO + (size_t)t * 1024 + 4 * lane + 256 * j); v[j] = (f32x4){bflo(w.x), bfhi(w.x), bflo(w.y), bfhi(w.y)}; ss += (v[j][0] * v[j][0] + v[j][1] * v[j][1]) + (v[j][2] * v[j][2] + v[j][3] * v[j][3]); }
    const float rstd = 1.0f / sqrtf(wave_sum(ss) * (1.0f / 1024.0f) + EPS);
#pragma unroll
    for (int j = 0; j < 4; ++j) { const f32x4 gg = *(const f32x4*)(g + 4 * lane + 256 * j); const f32x4 o = v[j] * rstd * gg; v2u w; w.x = pk2(o[0], o[1]); w.y = pk2(o[2], o[3]);
        *(v2u*)(MIX + (size_t)t * D + 4 * lane + 256 * j) = w; }
}

__device__ __forceinline__ int block_sum_512(int v, LAS int* red, int wave, int lane) {
#pragma unroll
    for (int o = 1; o < 64; o <<= 1) v += __shfl_xor(v, o);
    __syncthreads();
    if (lane == 0) red[wave] = v;
    __syncthreads();
    int s = 0;
#pragma unroll
    for (int w = 0; w < 8; ++w) s += red[w];
    return s;
}
__device__ __forceinline__ int block_excl_scan_512(int v, LAS int* red, int wave, int lane) {
    int inc = v;
#pragma unroll
    for (int o = 1; o < 64; o <<= 1) { const int t = __shfl_up(inc, o); if (lane >= o) inc += t; }
    __syncthreads();
    if (lane == 63) red[wave] = inc;
    __syncthreads();
    int base = 0;
#pragma unroll
    for (int w = 0; w < 8; ++w) base += (w < wave) ? red[w] : 0;
    return base + inc - v;
}
__device__ __forceinline__ void topk_unit(int be, const float* AFF, int* TOK, float* GATEV, int* SEL, LAS int* red) {
    int tid_ = threadIdx.x; asm volatile("" : "+v"(tid_)); const int tid = tid_, lane = tid & 63, wave = tid >> 6;
    const int b = be >> 4, e = be & 15;
    const float* a = AFF + (size_t)be * SEQ + tid * 8;
    const f32x4 a0 = *(const f32x4*)a, a1 = *(const f32x4*)(a + 4);
    unsigned key[8] = {__float_as_uint(a0.x), __float_as_uint(a0.y), __float_as_uint(a0.z), __float_as_uint(a0.w),
                       __float_as_uint(a1.x), __float_as_uint(a1.y), __float_as_uint(a1.z), __float_as_uint(a1.w)};
    LAS int* hist = red + 16;
    unsigned T = 0u; int need = CAP;
#pragma unroll 1
    for (int pass = 0; pass < 4; ++pass) { const int shift = 24 - 8 * pass; const unsigned mhi = pass == 0 ? 0u : (0xFFFFFFFFu << (shift + 8));
        __syncthreads();
        if (tid < 256) hist[tid] = 0;
        __syncthreads();
#pragma unroll
        for (int i = 0; i < 8; ++i) if ((key[i] & mhi) == T) (void)__hip_atomic_fetch_add(&hist[(key[i] >> shift) & 255u], 1, __ATOMIC_RELAXED, __HIP_MEMORY_SCOPE_WORKGROUP);
        __syncthreads();
        if (wave == 0) { const int c0 = hist[4 * lane], c1 = hist[4 * lane + 1], c2 = hist[4 * lane + 2], c3 = hist[4 * lane + 3]; const int t = c0 + c1 + c2 + c3; int inc = t;
#pragma unroll
            for (int o = 1; o < 64; o <<= 1) { const int v = __shfl_down(inc, o); if (lane + o < 64) inc += v; }
            const int ab3 = inc - t, ab2 = ab3 + c3, ab1 = ab2 + c2, ab0 = ab1 + c1;
            if (ab3 < need && need <= ab3 + c3) { red[8] = 4 * lane + 3; red[9] = ab3; }
            if (ab2 < need && need <= ab2 + c2) { red[8] = 4 * lane + 2; red[9] = ab2; }
            if (ab1 < need && need <= ab1 + c1) { red[8] = 4 * lane + 1; red[9] = ab1; }
            if (ab0 < need && need <= ab0 + c0) { red[8] = 4 * lane + 0; red[9] = ab0; } }
        __syncthreads();
        T |= (unsigned)red[8] << shift; need -= red[9]; }
    int ceq = 0;
#pragma unroll
    for (int i = 0; i < 8; ++i) ceq += key[i] == T ? 1 : 0;
    const int need_eq = need;
    int eqrank = block_excl_scan_512(ceq, red, wave, lane);
    int selm = 0, csel = 0;
#pragma unroll
    for (int i = 0; i < 8; ++i) { bool sel = key[i] > T; if (key[i] == T) { sel = eqrank < need_eq; ++eqrank; } if (sel) { selm |= 1 << i; ++csel; } }
    int slot = block_excl_scan_512(csel, red, wave, lane);
#pragma unroll
    for (int i = 0; i < 8; ++i) { const int sidx = tid * 8 + i; const int tok = b * SEQ + sidx;
        if (selm & (1 << i)) { const int R = e * 2048 + b * 512 + slot; TOK[R] = tok; GATEV[R] = __uint_as_float(key[i]); SEL[tok * 16 + e] = slot; ++slot; }
        else SEL[tok * 16 + e] = -1; }
    __syncthreads();
}

typedef short bf16x8v __attribute__((ext_vector_type(8)));
typedef short s16x4 __attribute__((ext_vector_type(4)));
constexpr int ML_L = 128, ML_NC = SEQ / ML_L;
constexpr int KP = 272, VP = 528;
constexpr int ML_T0 = 0, ML_T1 = 128 * KP, ML_V = 2 * 128 * KP;
constexpr int ML_AR = ML_V + 128 * VP;
constexpr int ML_END = ML_AR + 24 * 512;
static_assert(ML_AR % 16 == 0, "LDS map");
constexpr size_t WS_UC = WS_HF;
constexpr size_t WS_NU = 6 * MiB;
constexpr size_t WS_SC = 7 * MiB;

__device__ __forceinline__ s16x4 lds_tr(LAS unsigned char* p) { return __builtin_amdgcn_ds_read_tr16_b64_v4i16((LAS s16x4*)p); }
__device__ __forceinline__ bf16x8v frag_tr(LAS unsigned char* tile, int pitch, int k0, int n0, int lane) {
    const int g = lane >> 4, q = (lane & 15) >> 2, p = lane & 3;
    LAS unsigned char* a = tile + (k0 + 8 * g + q) * pitch + (n0 + 4 * p) * 2;
    const s16x4 lo = lds_tr(a), hi = lds_tr(a + 4 * pitch);
    return (bf16x8v){lo[0], lo[1], lo[2], lo[3], hi[0], hi[1], hi[2], hi[3]};
}
__device__ __forceinline__ bf16x8v frag_row(LAS unsigned char* tile, int pitch, int m0, int k0, int lane) {
    return *(LAS bf16x8v*)(tile + (m0 + (lane & 15)) * pitch + (k0 + 8 * (lane >> 4)) * 2);
}
__device__ __forceinline__ float log_sigmoid_f(float f) { return fminf(f, 0.f) - log1pf(__expf(-fabsf(f))); }
__device__ __forceinline__ float shfl_up_f(float v, int o, int lane, float ident) { const float t = __shfl_up(v, o); return lane >= o ? t : ident; }

__device__ __forceinline__ void chunk_gates(const float* GATES, int t0, int h, int dir, int lane, int& s0, int& s1, float& i0, float& i1, float& b0, float& b1, float& btot) {
    const int p0 = 2 * lane, p1 = p0 + 1; s0 = dir ? 127 - p0 : p0; s1 = dir ? 127 - p1 : p1;
    const int icol = dir * 8 + h, fcol = icol + 4;
    const float* gp = GATES + (size_t)t0 * 16;
    const float f0 = log_sigmoid_f(gp[s0 * 16 + fcol]), f1 = log_sigmoid_f(gp[s1 * 16 + fcol]);
    i0 = gp[s0 * 16 + icol]; i1 = gp[s1 * 16 + icol];
    const float s = f0 + f1; float inc = s;
#pragma unroll
    for (int o = 1; o < 64; o <<= 1) inc += shfl_up_f(inc, o, lane, 0.f);
    const float excl = inc - s; b0 = excl + f0; b1 = excl + s; btot = __shfl(inc, 63);
}


__device__ __forceinline__ void conv_chunk4(const bf16* P, const float* cw, const float* cb, int b, int sq0, int chan0, float (&o)[4][8]) {
    const bf16* pc = P + ((size_t)b * SEQ + sq0) * NPROJ + C_MLQ + chan0;
    v4u w[8];
#pragma unroll
    for (int j = 0; j < 8; ++j) { const int ss = sq0 + j - 2; w[j] = (ss >= 0 && ss < SEQ) ? *(const v4u*)(pc + (ptrdiff_t)(j - 2) * NPROJ) : (v4u){0u, 0u, 0u, 0u}; }
    const f32x4 b0 = *(const f32x4*)(cb + chan0), b1 = *(const f32x4*)(cb + chan0 + 4);
#pragma unroll
    for (int t = 0; t < 4; ++t) { o[t][0] = b0[0]; o[t][1] = b0[1]; o[t][2] = b0[2]; o[t][3] = b0[3]; o[t][4] = b1[0]; o[t][5] = b1[1]; o[t][6] = b1[2]; o[t][7] = b1[3]; }
#pragma unroll
    for (int j = 0; j < 5; ++j) { const f32x4 c0 = *(const f32x4*)(cw + j * 1024 + chan0), c1 = *(const f32x4*)(cw + j * 1024 + chan0 + 4);
#pragma unroll
        for (int t = 0; t < 4; ++t) { const v4u x = w[t + j];
            o[t][0] += c0[0] * bflo(x.x); o[t][1] += c0[1] * bfhi(x.x); o[t][2] += c0[2] * bflo(x.y); o[t][3] += c0[3] * bfhi(x.y);
            o[t][4] += c1[0] * bflo(x.z); o[t][5] += c1[1] * bfhi(x.z); o[t][6] += c1[2] * bflo(x.w); o[t][7] += c1[3] * bfhi(x.w); } }
#pragma unroll
    for (int t = 0; t < 4; ++t)
#pragma unroll
        for (int i = 0; i < 8; ++i) o[t][i] = o[t][i] / (1.0f + __expf(-o[t][i]));
}

__device__ __forceinline__ void mlstm_m1_unit(int u, const float* cw, const float* cb, const bf16* P, const float* GATES, bf16* UC, float* NU, float* SC, LAS unsigned char* lds, int tid_, int wave) {
    int tid = tid_; asm volatile("" : "+v"(tid)); const int lane = tid & 63;
    const int c = u & 31, h = (u >> 5) & 3, b = u >> 7; const int t0 = b * SEQ + c * ML_L;
    LAS float* WK = (LAS float*)(lds + ML_AR);
    LAS float* NRED = WK + 256;
    __syncthreads();
    if (wave < 2) { const int dir = wave; int s0, s1; float i0, i1, b0, b1, btot;
        chunk_gates(GATES, t0, h, dir, lane, s0, s1, i0, i1, b0, b1, btot);
        const float g0 = btot - b0 + i0, g1 = btot - b1 + i1; const float mloc = wave_max(fmaxf(g0, g1));
        WK[dir * 128 + s0] = __expf(g0 - mloc); WK[dir * 128 + s1] = __expf(g1 - mloc);
        if (lane == 0) { float* sc = SC + (size_t)((((b * 4 + h) * 2 + dir) * 32) + c) * 4; sc[0] = btot; sc[1] = mloc; } }
#pragma unroll
    for (int i = 0; i < 8; ++i) { const int id = tid + 512 * i, s = id >> 5, ch = id & 31;
        *(LAS v4u*)(lds + ML_V + s * VP + ch * 16) = *(const v4u*)(P + (size_t)(t0 + s) * NPROJ + C_MLV + h * 256 + ch * 8); }
    float k4[4][8]; conv_chunk4(P, cw, cb, b, c * ML_L + 4 * (tid >> 4), 512 + h * 128 + (tid & 15) * 8, k4);
    __syncthreads();
    { float nf[8], nb[8];
#pragma unroll
      for (int j = 0; j < 8; ++j) { nf[j] = 0.f; nb[j] = 0.f; }
#pragma unroll
      for (int i = 0; i < 4; ++i) { const int s = 4 * (tid >> 4) + i, ch = tid & 15; const float (&k)[8] = k4[i];
        const float wf = WK[s], wb = WK[128 + s];
        v4u of, ob; of.x = pk2(k[0] * wf, k[1] * wf); of.y = pk2(k[2] * wf, k[3] * wf); of.z = pk2(k[4] * wf, k[5] * wf); of.w = pk2(k[6] * wf, k[7] * wf);
        ob.x = pk2(k[0] * wb, k[1] * wb); ob.y = pk2(k[2] * wb, k[3] * wb); ob.z = pk2(k[4] * wb, k[5] * wb); ob.w = pk2(k[6] * wb, k[7] * wb);
        *(LAS v4u*)(lds + ML_T0 + s * KP + ch * 16) = of; *(LAS v4u*)(lds + ML_T1 + s * KP + ch * 16) = ob;
#pragma unroll
        for (int j = 0; j < 8; ++j) { nf[j] += k[j] * wf; nb[j] += k[j] * wb; } }
#pragma unroll
      for (int j = 0; j < 8; ++j) { nf[j] += __shfl_xor(nf[j], 16); nf[j] += __shfl_xor(nf[j], 32); nb[j] += __shfl_xor(nb[j], 16); nb[j] += __shfl_xor(nb[j], 32); }
      if ((lane >> 4) == 0) {
#pragma unroll
          for (int j = 0; j < 8; ++j) { NRED[wave * 256 + (lane & 15) * 8 + j] = nf[j]; NRED[wave * 256 + 128 + (lane & 15) * 8 + j] = nb[j]; } } }
    __syncthreads();
    if (tid < 256) { const int dir = tid >> 7, d = tid & 127; float sum = 0.f;
#pragma unroll
        for (int w = 0; w < 8; ++w) sum += NRED[w * 256 + tid];
        NU[(size_t)((((b * 4 + h) * 2 + dir) * 32) + c) * 128 + d] = sum; }
    const int g = lane >> 4;
#pragma unroll 1
    for (int dir = 0; dir < 2; ++dir) {
        LAS unsigned char* Kt = lds + (dir ? ML_T1 : ML_T0);
        f32x4 acc[8][2];
#pragma unroll
        for (int mb = 0; mb < 8; ++mb) { acc[mb][0] = (f32x4){0.f, 0.f, 0.f, 0.f}; acc[mb][1] = (f32x4){0.f, 0.f, 0.f, 0.f}; }
#pragma unroll
        for (int ks = 0; ks < 4; ++ks) {
            const bf16x8v b0 = frag_tr(lds + ML_V, VP, 32 * ks, 32 * wave, lane), b1 = frag_tr(lds + ML_V, VP, 32 * ks, 32 * wave + 16, lane);
#pragma unroll
            for (int mb = 0; mb < 8; ++mb) { const bf16x8v a = frag_tr(Kt, KP, 32 * ks, 16 * mb, lane);
                acc[mb][0] = __builtin_amdgcn_mfma_f32_16x16x32_bf16(a, b0, acc[mb][0], 0, 0, 0); acc[mb][1] = __builtin_amdgcn_mfma_f32_16x16x32_bf16(a, b1, acc[mb][1], 0, 0, 0); } }
        bf16* uc = UC + (size_t)((((b * 4 + h) * 2 + dir) * 32) + c) * 32768;
#pragma unroll
        for (int mb = 0; mb < 8; ++mb)
#pragma unroll
            for (int nb = 0; nb < 2; ++nb) { const int e = 32 * wave + 16 * nb + (lane & 15), d0 = 16 * mb + 4 * g; v2u w; w.x = pk2(acc[mb][nb][0], acc[mb][nb][1]); w.y = pk2(acc[mb][nb][2], acc[mb][nb][3]);
                *(v2u*)(uc + e * 128 + d0) = w; }
    }
}

__device__ __forceinline__ void mlstm_m2(bf16* UC, float* NU, float* SC, int gtid, int nthreads) {
    for (int vid = gtid; vid < 32 * 4096; vid += nthreads) { const int chain = vid >> 12, within = vid & 4095, dir = chain & 1;
        float st[8]; float m = 0.f;
#pragma unroll
        for (int i = 0; i < 8; ++i) st[i] = 0.f;
#pragma unroll 1
        for (int s0 = 0; s0 < ML_NC; s0 += 8) {
            v4u uw[8]; float bt[8], ml[8];
#pragma unroll
            for (int k = 0; k < 8; ++k) { const int c = dir ? ML_NC - 1 - (s0 + k) : s0 + k; const float* sc = SC + (size_t)(chain * 32 + c) * 4; bt[k] = sc[0]; ml[k] = sc[1];
                uw[k] = *(const v4u*)(UC + ((size_t)(chain * 32 + c) * 4096 + within) * 8); }
#pragma unroll
            for (int k = 0; k < 8; ++k) { const int c = dir ? ML_NC - 1 - (s0 + k) : s0 + k;
                v4u cw; cw.x = pk2(st[0], st[1]); cw.y = pk2(st[2], st[3]); cw.z = pk2(st[4], st[5]); cw.w = pk2(st[6], st[7]);
                *(v4u*)(UC + ((size_t)(chain * 32 + c) * 4096 + within) * 8) = cw;
                if (within == 0) SC[(size_t)(chain * 32 + c) * 4 + 2] = m;
                const float mn = fmaxf(bt[k] + m, ml[k]), dC = __expf(bt[k] + m - mn), dU = __expf(ml[k] - mn);
                const float uu[8] = {bflo(uw[k].x), bfhi(uw[k].x), bflo(uw[k].y), bfhi(uw[k].y), bflo(uw[k].z), bfhi(uw[k].z), bflo(uw[k].w), bfhi(uw[k].w)};
#pragma unroll
                for (int i = 0; i < 8; ++i) st[i] = dC * st[i] + dU * uu[i];
                m = mn; } } }
    for (int nid = gtid; nid < 32 * 128; nid += nthreads) { const int chain = nid >> 7, d = nid & 127, dir = chain & 1; float st = 0.f, m = 0.f;
#pragma unroll 1
        for (int s0 = 0; s0 < ML_NC; s0 += 8) { float uu[8], bt[8], ml[8];
#pragma unroll
            for (int k = 0; k < 8; ++k) { const int c = dir ? ML_NC - 1 - (s0 + k) : s0 + k; const float* sc = SC + (size_t)(chain * 32 + c) * 4; bt[k] = sc[0]; ml[k] = sc[1]; uu[k] = NU[(size_t)(chain * 32 + c) * 128 + d]; }
#pragma unroll
            for (int k = 0; k < 8; ++k) { const int c = dir ? ML_NC - 1 - (s0 + k) : s0 + k; NU[(size_t)(chain * 32 + c) * 128 + d] = st;
                const float mn = fmaxf(bt[k] + m, ml[k]); st = __expf(bt[k] + m - mn) * st + __expf(ml[k] - mn) * uu[k]; m = mn; } } }
}

__device__ __forceinline__ void mlstm_m3_unit(int u, const float* cw, const float* cb, const bf16* P, const float* GATES, const bf16* UC, const float* NU, const float* SC, const float* mlg, const float* RSNA, bf16* MIX, LAS unsigned char* lds, int tid_, int wave) {
    int tid = tid_; asm volatile("" : "+v"(tid)); const int lane = tid & 63;
    const int c = u & 31, h = (u >> 5) & 3, b = u >> 7; const int t0 = b * SEQ + c * ML_L;
    LAS float* AR = (LAS float*)(lds + ML_AR);
    LAS float* CS = AR; LAS float* RR = AR + 256; LAS float* INTER = AR + 512; LAS float* EM = AR + 768; LAS float* ALPHA = AR + 1024; LAS float* SS = AR + 1280;
    const int g = lane >> 4, lc = lane & 15;
    const int chain0 = (b * 4 + h) * 2;
    __syncthreads();
    if (wave < 2) { const int dir = wave; int s0, s1; float i0, i1, b0, b1, btot;
        chunk_gates(GATES, t0, h, dir, lane, s0, s1, i0, i1, b0, b1, btot);
        const float cs0 = i0 - b0, cs1 = i1 - b1;
        float pmx = fmaxf(cs0, cs1);
#pragma unroll
        for (int o = 1; o < 64; o <<= 1) pmx = fmaxf(pmx, shfl_up_f(pmx, o, lane, -3.0e38f));
        const float ex = shfl_up_f(pmx, 1, lane, -3.0e38f);
        const float pm0 = fmaxf(ex, cs0), pm1 = fmaxf(pm0, cs1);
        const float m_in = SC[(size_t)((chain0 + dir) * 32 + c) * 4 + 2];
        const float M0 = b0 + fmaxf(m_in, pm0), M1 = b1 + fmaxf(m_in, pm1);
        CS[dir * 128 + s0] = cs0; CS[dir * 128 + s1] = cs1; RR[dir * 128 + s0] = b0 - M0; RR[dir * 128 + s1] = b1 - M1;
        INTER[dir * 128 + s0] = __expf(b0 + m_in - M0); INTER[dir * 128 + s1] = __expf(b1 + m_in - M1); EM[dir * 128 + s0] = __expf(-M0); EM[dir * 128 + s1] = __expf(-M1); }
    { const int s0 = 4 * (tid >> 4), ch = tid & 15; float x4[4][8];
      conv_chunk4(P, cw, cb, b, c * ML_L + s0, h * 128 + ch * 8, x4);
      const float qs = 0.08838834764831845f;
#pragma unroll
      for (int i = 0; i < 4; ++i) { v4u oq; oq.x = pk2(x4[i][0] * qs, x4[i][1] * qs); oq.y = pk2(x4[i][2] * qs, x4[i][3] * qs); oq.z = pk2(x4[i][4] * qs, x4[i][5] * qs); oq.w = pk2(x4[i][6] * qs, x4[i][7] * qs);
          *(LAS v4u*)(lds + ML_T0 + (s0 + i) * KP + ch * 16) = oq; }
      conv_chunk4(P, cw, cb, b, c * ML_L + s0, 512 + h * 128 + ch * 8, x4);
#pragma unroll
      for (int i = 0; i < 4; ++i) { v4u ok; ok.x = pk2(x4[i][0], x4[i][1]); ok.y = pk2(x4[i][2], x4[i][3]); ok.z = pk2(x4[i][4], x4[i][5]); ok.w = pk2(x4[i][6], x4[i][7]);
          *(LAS v4u*)(lds + ML_T1 + (s0 + i) * KP + ch * 16) = ok; } }
#pragma unroll
    for (int i = 0; i < 8; ++i) { const int id = tid + 512 * i, s = id >> 5, ch = id & 31;
        *(LAS v4u*)(lds + ML_V + s * VP + ch * 16) = *(const v4u*)(P + (size_t)(t0 + s) * NPROJ + C_MLV + h * 256 + ch * 8); }
    __syncthreads();
    f32x4 S[8], qn = (f32x4){0.f, 0.f, 0.f, 0.f};
#pragma unroll
    for (int nb = 0; nb < 8; ++nb) S[nb] = (f32x4){0.f, 0.f, 0.f, 0.f};
#pragma unroll
    for (int ks = 0; ks < 4; ++ks) { const bf16x8v a = frag_row(lds + ML_T0, KP, 16 * wave, 32 * ks, lane);
        bf16x8v nf = (bf16x8v){0, 0, 0, 0, 0, 0, 0, 0};
        if (lc < 2) { const float* np = NU + (size_t)((chain0 + lc) * 32 + c) * 128 + 32 * ks + 8 * g; const f32x4 n0 = *(const f32x4*)np, n1 = *(const f32x4*)(np + 4);
            const unsigned w0 = pk2(n0[0], n0[1]), w1 = pk2(n0[2], n0[3]), w2 = pk2(n1[0], n1[1]), w3 = pk2(n1[2], n1[3]);
            nf = (bf16x8v){(short)(w0 & 0xffff), (short)(w0 >> 16), (short)(w1 & 0xffff), (short)(w1 >> 16), (short)(w2 & 0xffff), (short)(w2 >> 16), (short)(w3 & 0xffff), (short)(w3 >> 16)}; }
        qn = __builtin_amdgcn_mfma_f32_16x16x32_bf16(a, nf, qn, 0, 0, 0);
#pragma unroll
        for (int nb = 0; nb < 8; ++nb) { const bf16x8v kb = frag_row(lds + ML_T1, KP, 16 * nb, 32 * ks, lane); S[nb] = __builtin_amdgcn_mfma_f32_16x16x32_bf16(a, kb, S[nb], 0, 0, 0); } }
    float csf[8], csb[8];
#pragma unroll
    for (int nb = 0; nb < 8; ++nb) { csf[nb] = CS[16 * nb + lc]; csb[nb] = CS[128 + 16 * nb + lc]; }
    float pc[8][4];
#pragma unroll
    for (int r = 0; r < 4; ++r) { const int j = 16 * wave + 4 * g + r; const float Rf = RR[j], Rb = RR[128 + j];
        const float qnf = __shfl(qn[r], 16 * g), qnb = __shfl(qn[r], 16 * g + 1);
        float sf[8], sb[8], rsf = 0.f, rsb = 0.f;
#pragma unroll
        for (int nb = 0; nb < 8; ++nb) { const int s = 16 * nb + lc; const float wf = s <= j ? __expf(Rf + csf[nb]) : 0.f, wb = s >= j ? __expf(Rb + csb[nb]) : 0.f;
            sf[nb] = S[nb][r] * wf; sb[nb] = S[nb][r] * wb; rsf += sf[nb]; rsb += sb[nb]; }
        rsf = row16_sum(rsf); rsb = row16_sum(rsb);
        const float inf_ = INTER[j], inb_ = INTER[128 + j];
        const float ivf = 1.0f / fmaxf(fabsf(inf_ * qnf + rsf), EM[j]), ivb = 1.0f / fmaxf(fabsf(inb_ * qnb + rsb), EM[128 + j]);
#pragma unroll
        for (int nb = 0; nb < 8; ++nb) pc[nb][r] = sf[nb] * ivf + sb[nb] * ivb;
        if (lc == 0) { ALPHA[j] = inf_ * ivf; ALPHA[128 + j] = inb_ * ivb; } }
    __syncthreads();
#pragma unroll
    for (int r = 0; r < 4; ++r) { const int j = 16 * wave + 4 * g + r;
#pragma unroll
        for (int nb = 0; nb < 8; ++nb) *(LAS unsigned short*)(lds + ML_T1 + j * KP + (16 * nb + lc) * 2) = (unsigned short)f2bf(pc[nb][r]); }
    __syncthreads();
    f32x4 acc[2][8], acc2[2][8];
#pragma unroll
    for (int mb = 0; mb < 2; ++mb)
#pragma unroll
        for (int nb = 0; nb < 8; ++nb) { acc[mb][nb] = (f32x4){0.f, 0.f, 0.f, 0.f}; acc2[mb][nb] = (f32x4){0.f, 0.f, 0.f, 0.f}; }
    const bf16* ucf = UC + (size_t)((chain0 + 0) * 32 + c) * 32768 + (size_t)(32 * wave + lc) * 128 + 8 * g;
    const bf16* ucb = UC + (size_t)((chain0 + 1) * 32 + c) * 32768 + (size_t)(32 * wave + lc) * 128 + 8 * g;
#pragma unroll
    for (int ks = 0; ks < 4; ++ks) {
        const bf16x8v af0 = *(const bf16x8v*)(ucf + 32 * ks), af1 = *(const bf16x8v*)(ucf + 16 * 128 + 32 * ks), ab0 = *(const bf16x8v*)(ucb + 32 * ks), ab1 = *(const bf16x8v*)(ucb + 16 * 128 + 32 * ks);
#pragma unroll
        for (int nb = 0; nb < 8; ++nb) { const bf16x8v qb = frag_row(lds + ML_T0, KP, 16 * nb, 32 * ks, lane);
            acc[0][nb] = __builtin_amdgcn_mfma_f32_16x16x32_bf16(af0, qb, acc[0][nb], 0, 0, 0); acc[1][nb] = __builtin_amdgcn_mfma_f32_16x16x32_bf16(af1, qb, acc[1][nb], 0, 0, 0);
            acc2[0][nb] = __builtin_amdgcn_mfma_f32_16x16x32_bf16(ab0, qb, acc2[0][nb], 0, 0, 0); acc2[1][nb] = __builtin_amdgcn_mfma_f32_16x16x32_bf16(ab1, qb, acc2[1][nb], 0, 0, 0); } }
#pragma unroll
    for (int nb = 0; nb < 8; ++nb) { const float af = ALPHA[16 * nb + lc], ab = ALPHA[128 + 16 * nb + lc];
        acc[0][nb] = acc[0][nb] * af + acc2[0][nb] * ab; acc[1][nb] = acc[1][nb] * af + acc2[1][nb] * ab; }
#pragma unroll
    for (int ks = 0; ks < 4; ++ks) {
        const bf16x8v v0 = frag_tr(lds + ML_V, VP, 32 * ks, 32 * wave, lane), v1 = frag_tr(lds + ML_V, VP, 32 * ks, 32 * wave + 16, lane);
#pragma unroll
        for (int nb = 0; nb < 8; ++nb) { const bf16x8v pb = frag_row(lds + ML_T1, KP, 16 * nb, 32 * ks, lane);
            acc[0][nb] = __builtin_amdgcn_mfma_f32_16x16x32_bf16(v0, pb, acc[0][nb], 0, 0, 0); acc[1][nb] = __builtin_amdgcn_mfma_f32_16x16x32_bf16(v1, pb, acc[1][nb], 0, 0, 0); } }
    v2u ogate[2][8]; f32x4 gg2[2];
#pragma unroll
    for (int mb = 0; mb < 2; ++mb) { gg2[mb] = *(const f32x4*)(mlg + h * 256 + 32 * wave + 16 * mb + 4 * g);
#pragma unroll
        for (int nb = 0; nb < 8; ++nb) ogate[mb][nb] = *(const v2u*)(P + (size_t)(t0 + 16 * nb + lc) * NPROJ + C_MLO + h * 256 + 32 * wave + 16 * mb + 4 * g); }
    float rsna[8];
#pragma unroll
    for (int nb = 0; nb < 8; ++nb) rsna[nb] = RSNA[t0 + 16 * nb + lc];
#pragma unroll
    for (int nb = 0; nb < 8; ++nb) { float ss = 0.f;
#pragma unroll
        for (int mb = 0; mb < 2; ++mb) ss += (acc[mb][nb][0] * acc[mb][nb][0] + acc[mb][nb][1] * acc[mb][nb][1]) + (acc[mb][nb][2] * acc[mb][nb][2] + acc[mb][nb][3] * acc[mb][nb][3]);
        ss = rows4_sum(ss);
        if (g == 0) SS[wave * 128 + 16 * nb + lc] = ss; }
    __syncthreads();
#pragma unroll
    for (int nb = 0; nb < 8; ++nb) { const int j = 16 * nb + lc; float tot = 0.f;
#pragma unroll
        for (int w = 0; w < 8; ++w) tot += SS[w * 128 + j];
        const float rstd = 1.0f / (sqrtf(tot * (1.0f / 256.0f) + EPS) * rsna[nb]);
#pragma unroll
        for (int mb = 0; mb < 2; ++mb) { const int e0 = 32 * wave + 16 * mb + 4 * g; const size_t t = (size_t)(t0 + j);
            const v2u ow = ogate[mb][nb]; const f32x4 gg = gg2[mb];
            const float o[4] = {bflo(ow.x), bfhi(ow.x), bflo(ow.y), bfhi(ow.y)}; float rr[4];
#pragma unroll
            for (int r = 0; r < 4; ++r) rr[r] = acc[mb][nb][r] * rstd * gg[r] / (1.0f + __expf(-o[r]));
            v2u w; w.x = pk2(rr[0], rr[1]); w.y = pk2(rr[2], rr[3]);
            *(v2u*)(MIX + t * D + 1024 + h * 256 + e0) = w; } }
}


#ifndef NA_PROBE
#define NA_PROBE 0
#endif
constexpr int NA_TILE = 64 * KP, NA_BUF = 2 * NA_TILE, NA_RPB = 2 * NA_BUF;
static_assert(NA_RPB + 15 * 128 * 4 <= ML_END, "LDS map");
__device__ __forceinline__ bf16x8v frag_tr2(LAS unsigned char* tile, int pitch, int row0, int row1, int n0, int lane) {
    const int q = (lane & 15) >> 2, p = lane & 3;
    const s16x4 lo = lds_tr(tile + (row0 + q) * pitch + (n0 + 4 * p) * 2), hi = lds_tr(tile + (row1 + q) * pitch + (n0 + 4 * p) * 2);
    return (bf16x8v){lo[0], lo[1], lo[2], lo[3], hi[0], hi[1], hi[2], hi[3]};
}
__device__ __forceinline__ void na_unit(int u, const bf16* P, const float* rpb, bf16* MIX, float* SSQ, LAS unsigned char* lds, int tid_, int wave) {
    int tid = tid_; asm volatile("" : "+v"(tid)); const int lane = tid & 63, g = lane >> 4, lc = lane & 15;
    const int r4 = u & 15, h = (u >> 4) & 7, b = u >> 7;
    const int r0 = 4 * r4, r = r0 + (wave >> 1), qh = wave & 1;
    const int rs = min(max(r - 4, 0), 56), rs0 = min(max(r0 - 4, 0), 56), nk = min(max(r0 + 3 - 4, 0), 56) + 8 - rs0;
    LAS float* RPB = (LAS float*)(lds + NA_RPB);
    const int sA = tid >> 4, chA = tid & 15, sB = sA + 32;
    const bf16* gsrc = P + ((size_t)b * SEQ + rs0 * 64) * NPROJ + h * 128 + chA * 8;
    v4u pk0, pk1, pv0, pv1;
#define NA_LOAD(j) do { const bf16* s_ = gsrc + (size_t)(j) * 64 * NPROJ; pk0 = *(const v4u*)(s_ + (size_t)sA * NPROJ + C_NAK); pk1 = *(const v4u*)(s_ + (size_t)sB * NPROJ + C_NAK); \
        pv0 = *(const v4u*)(s_ + (size_t)sA * NPROJ + C_NAV); pv1 = *(const v4u*)(s_ + (size_t)sB * NPROJ + C_NAV); } while (0)
#define NA_STORE(buf) do { LAS unsigned char* t_ = lds + (buf) * NA_BUF; *(LAS v4u*)(t_ + sA * KP + chA * 16) = pk0; *(LAS v4u*)(t_ + sB * KP + chA * 16) = pk1; \
        *(LAS v4u*)(t_ + NA_TILE + sA * KP + chA * 16) = pv0; *(LAS v4u*)(t_ + NA_TILE + sB * KP + chA * 16) = pv1; } while (0)
    NA_LOAD(0);
    __syncthreads();
    for (int i = tid; i < 15 * 128; i += 512) { const int dr = i >> 7, x = (i & 127) - 48; RPB[i] = (x >= 0 && x < 31) ? rpb[h * 465 + dr * 31 + x] * 1.4426950408889634f : 0.f; }
    NA_STORE(0);
    bf16x8v qf[2][4]; int cq[2], cs[2], boff[2]; float m[2], l[2]; f32x4 O[2][8]; f32x4 madd[2][4];
#pragma unroll
    for (int qi = 0; qi < 2; ++qi) { cq[qi] = 32 * qh + 16 * qi + lc; cs[qi] = min(max(cq[qi] - 8, 0), 48); m[qi] = -1.0e30f; l[qi] = 0.f; boff[qi] = 63 - cq[qi] + 4 * g;
#pragma unroll
        for (int kb = 0; kb < 4; ++kb)
#pragma unroll
            for (int rr = 0; rr < 4; ++rr) { const int kc = 16 * kb + 4 * g + rr; madd[qi][kb][rr] = (kc >= cs[qi] && kc < cs[qi] + 16) ? 0.f : -1.0e30f; }
        const bf16* qp = P + ((size_t)b * SEQ + r * 64 + cq[qi]) * NPROJ + C_NAQ + h * 128 + 8 * g;
#pragma unroll
        for (int ks = 0; ks < 4; ++ks) qf[qi][ks] = *(const bf16x8v*)(qp + 32 * ks);
#pragma unroll
        for (int db = 0; db < 8; ++db) O[qi][db] = (f32x4){0.f, 0.f, 0.f, 0.f}; }
    __syncthreads();
#pragma unroll 1
    for (int j = 0; j < nk; ++j) {
        const int kr = rs0 + j;
        if (j + 1 < nk) NA_LOAD(j + 1);
        if (kr >= rs && kr < rs + 8) {
            LAS unsigned char* Kt = lds + (j & 1) * NA_BUF; LAS unsigned char* Vt = Kt + NA_TILE;
            const LAS float* brow = RPB + (kr - r + 7) * 128;
            const int kb0a = qh ? 1 : 0, kb1a = qh ? 3 : 1, kb0b = qh ? 2 : 0, kb1b = qh ? 3 : 2;
            f32x4 s[2][4];
#if NA_PROBE == 1
            for (int prb = 0; prb < 2; ++prb) { asm volatile("" ::: "memory");
#else
            {
#endif
#pragma unroll
            for (int kb = 0; kb < 4; ++kb) { s[0][kb] = (f32x4){0.f, 0.f, 0.f, 0.f}; s[1][kb] = (f32x4){0.f, 0.f, 0.f, 0.f}; }
#pragma unroll
            for (int kb = 0; kb < 4; ++kb) { const bool ua = kb >= kb0a && kb <= kb1a, ub = kb >= kb0b && kb <= kb1b;
                if (ua || ub) {
#pragma unroll
                    for (int ks = 0; ks < 4; ++ks) { const bf16x8v ka = frag_row(Kt, KP, 16 * kb, 32 * ks, lane);
                        if (ua) s[0][kb] = __builtin_amdgcn_mfma_f32_16x16x32_bf16(ka, qf[0][ks], s[0][kb], 0, 0, 0);
                        if (ub) s[1][kb] = __builtin_amdgcn_mfma_f32_16x16x32_bf16(ka, qf[1][ks], s[1][kb], 0, 0, 0); } } }
            }
            bf16x8v pb[2][2];
#pragma unroll
            for (int qi = 0; qi < 2; ++qi) {
                const int k0 = qi ? kb0b : kb0a, k1 = qi ? kb1b : kb1a; const LAS float* bq = brow + boff[qi];
                float mx = -1.0e30f;
#pragma unroll
                for (int kb = 0; kb < 4; ++kb) if (kb >= k0 && kb <= k1) {
#pragma unroll
                    for (int rr = 0; rr < 4; ++rr) { const float v = s[qi][kb][rr] * 0.12753785f + bq[16 * kb + rr] + madd[qi][kb][rr]; s[qi][kb][rr] = v; mx = fmaxf(mx, v); } }
                mx = rows4_max(mx);
                const float mn = fmaxf(m[qi], mx); float ls = 0.f;
#pragma unroll
                for (int kb = 0; kb < 4; ++kb) { if (kb >= k0 && kb <= k1) {
#pragma unroll
                    for (int rr = 0; rr < 4; ++rr) { const float p = __builtin_amdgcn_exp2f(s[qi][kb][rr] - mn); s[qi][kb][rr] = p; ls += p; } } else s[qi][kb] = (f32x4){0.f, 0.f, 0.f, 0.f}; }
                ls = rows4_sum(ls);
                if (!__all(mn == m[qi])) { const float corr = __builtin_amdgcn_exp2f(m[qi] - mn); l[qi] *= corr;
#pragma unroll
                    for (int db = 0; db < 8; ++db) O[qi][db] = O[qi][db] * corr; }
                l[qi] += ls; m[qi] = mn;
#pragma unroll
                for (int t = 0; t < 2; ++t) { v4u pw; pw.x = pk2(s[qi][2 * t][0], s[qi][2 * t][1]); pw.y = pk2(s[qi][2 * t][2], s[qi][2 * t][3]); pw.z = pk2(s[qi][2 * t + 1][0], s[qi][2 * t + 1][1]); pw.w = pk2(s[qi][2 * t + 1][2], s[qi][2 * t + 1][3]);
                    pb[qi][t] = __builtin_bit_cast(bf16x8v, pw); }
            }
#if NA_PROBE == 2
            for (int prb = 0; prb < 2; ++prb) { asm volatile("" ::: "memory"); if (prb) { pb[0][0] = pb[0][1] = pb[1][0] = pb[1][1] = (bf16x8v){0, 0, 0, 0, 0, 0, 0, 0}; }
#else
            {
#endif
#pragma unroll
            for (int t = 0; t < 2; ++t) { const bool ua = 2 * t + 1 >= kb0a && 2 * t <= kb1a, ub = 2 * t + 1 >= kb0b && 2 * t <= kb1b;
                if (ua || ub) {
#pragma unroll
                    for (int db = 0; db < 8; ++db) { const bf16x8v va = frag_tr2(Vt, KP, 32 * t + 4 * g, 32 * t + 16 + 4 * g, 16 * db, lane);
                        if (ua) O[0][db] = __builtin_amdgcn_mfma_f32_16x16x32_bf16(va, pb[0][t], O[0][db], 0, 0, 0);
                        if (ub) O[1][db] = __builtin_amdgcn_mfma_f32_16x16x32_bf16(va, pb[1][t], O[1][db], 0, 0, 0); } } }
            }
        }
#if NA_PROBE == 4
        if (j + 1 < nk) { NA_STORE((j + 1) & 1); asm volatile("" ::: "memory"); }
#endif
#if NA_PROBE == 5
        __syncthreads();
#endif
        if (j + 1 < nk) NA_STORE((j + 1) & 1);
        __syncthreads();
    }
#pragma unroll
    for (int qi = 0; qi < 2; ++qi) { const float inv = 1.0f / l[qi]; const size_t t = (size_t)b * SEQ + r * 64 + cq[qi]; bf16* op = MIX + t * D + h * 128 + 4 * g; float ss = 0.f;
#pragma unroll
        for (int db = 0; db < 8; ++db) { const f32x4 o = O[qi][db] * inv; ss += (o[0] * o[0] + o[1] * o[1]) + (o[2] * o[2] + o[3] * o[3]); v2u w; w.x = pk2(o[0], o[1]); w.y = pk2(o[2], o[3]); *(v2u*)(op + 16 * db) = w; }
        ss = rows4_sum(ss);
        if (g == 0) SSQ[t * 8 + h] = ss; }
#undef NA_LOAD
#undef NA_STORE
}


constexpr int NWAVES = 8;
#ifndef NCONV
#define NCONV 96
#endif
constexpr int RING_BYTES = 131072;
constexpr int LDSCTL_OFF = ML_END, MISC_OFF = LDSCTL_OFF + 320;
constexpr int LDS_BYTES = LDSCTL_OFF + 1024;
static_assert(ML_END >= RING_BYTES && LDS_BYTES <= 163840, "LDS map");
constexpr int CW_BAR = 4096;
constexpr size_t CTL_ZERO_BYTES = 65536;
static_assert((CW_BAR + XCD_BAR_WORDS) * 4 <= (int)CTL_ZERO_BYTES, "barrier words inside the memset region");

struct MKArgs { const float* in[16]; float* out; unsigned char* ws; };
__global__ void __launch_bounds__(NWAVES * 64, 2) mk_fwd(MKArgs args) {
    extern __shared__ __attribute__((aligned(16))) unsigned char lds_raw[];
    LAS unsigned char* lds = (LAS unsigned char*)lds_raw;
    volatile LAS unsigned* MISC = (volatile LAS unsigned*)(lds + MISC_OFF);
    const int tid = threadIdx.x, lane0 = tid & 63, wave = __builtin_amdgcn_readfirstlane(tid >> 6);
    const int G = gridDim.x; const int bx = blockIdx.x; const int vcu = (G % 8 == 0) ? (bx % 8) * (G / 8) + bx / 8 : bx;
    const int gw0 = vcu * NWAVES + wave, ngw = G * NWAVES;
    unsigned char* ws = args.ws;
    for (int u = tid; u < (LDS_BYTES - LDSCTL_OFF) / 4; u += NWAVES * 64) ((LAS unsigned*)(lds + LDSCTL_OFF))[u] = 0u;
    __syncthreads();
    XcdBarrier bar = xcd_barrier_post((unsigned*)(ws + WS_CTL) + CW_BAR, MISC + 8);
#define GRID_BAR() do { XcdBarrier b_ = bar; asm volatile("" : "+s"(b_.bar), "+s"(b_.x)); xcd_barrier(b_); } while (0)
    const float* x = args.in[0]; const float* norm_mix_g = args.in[1]; const float* w_in = args.in[2]; const float* b_gates = args.in[3];
    const float* conv_w = args.in[4]; const float* conv_b = args.in[5]; const float* na_rpb = args.in[6]; const float* na_norm_g = args.in[7];
    const float* ml_norm_g = args.in[8]; const float* w_out = args.in[9]; const float* norm_ffn_g = args.in[10]; const float* w_router = args.in[11];
    const float* w_gate = args.in[12]; const float* w_up = args.in[13]; const float* w_down = args.in[14]; const float* final_norm_g = args.in[15];
#define WSPTRS(wsl, Xl) float* X = (Xl); float* RSTD = (float*)((wsl) + WS_RSTD); float* GATES = (float*)((wsl) + WS_GATES); float* AFF = (float*)((wsl) + WS_AFF); int* TOK = (int*)((wsl) + WS_TOK); float* GATEV = (float*)((wsl) + WS_GATEV); int* SEL = (int*)((wsl) + WS_SEL); \
    bf16* XB = (bf16*)((wsl) + WS_XB); bf16* MIX = (bf16*)((wsl) + WS_MIX); bf16* P = (bf16*)((wsl) + WS_P); bf16* NAO = (bf16*)((wsl) + WS_NAO); bf16* ACT = (bf16*)((wsl) + WS_ACT); bf16* Y = (bf16*)((wsl) + WS_Y); \
    (void)X; (void)RSTD; (void)GATES; (void)AFF; (void)TOK; (void)GATEV; (void)SEL; (void)XB; (void)MIX; (void)P; (void)NAO; (void)ACT; (void)Y;
#define LAUNDER(p) asm volatile("" : "+s"(p))
#ifndef REP_MASK
#define REP_MASK 0
#endif
#if (REP_MASK >> 0) & 1
#define REP0 for (int rep_ = 0; rep_ < 2; ++rep_)
#else
#define REP0
#endif
#if (REP_MASK >> 1) & 1
#define REP1 for (int rep_ = 0; rep_ < 2; ++rep_)
#else
#define REP1
#endif
#if (REP_MASK >> 2) & 1
#define REP2 for (int rep_ = 0; rep_ < 2; ++rep_)
#else
#define REP2
#endif
#if (REP_MASK >> 3) & 1
#define REP3 for (int rep_ = 0; rep_ < 2; ++rep_)
#else
#define REP3
#endif
#if (REP_MASK >> 4) & 1
#define REP4 for (int rep_ = 0; rep_ < 2; ++rep_)
#else
#define REP4
#endif
#if (REP_MASK >> 5) & 1
#define REP5 for (int rep_ = 0; rep_ < 2; ++rep_)
#else
#define REP5
#endif
#if (REP_MASK >> 6) & 1
#define REP6 for (int rep_ = 0; rep_ < 2; ++rep_)
#else
#define REP6
#endif
#if (REP_MASK >> 7) & 1
#define REP7 for (int rep_ = 0; rep_ < 2; ++rep_)
#else
#define REP7
#endif
#if (REP_MASK >> 8) & 1
#define REP8 for (int rep_ = 0; rep_ < 2; ++rep_)
#else
#define REP8
#endif
#if (REP_MASK >> 9) & 1
#define REP9 for (int rep_ = 0; rep_ < 2; ++rep_)
#else
#define REP9
#endif
#if (REP_MASK >> 10) & 1
#define REP10 for (int rep_ = 0; rep_ < 2; ++rep_)
#else
#define REP10
#endif
#if (REP_MASK >> 11) & 1
#define REP11 for (int rep_ = 0; rep_ < 2; ++rep_)
#else
#define REP11
#endif
#if (REP_MASK >> 12) & 1
#define REP12 for (int rep_ = 0; rep_ < 2; ++rep_)
#else
#define REP12
#endif
#if (REP_MASK >> 13) & 1
#define REP13 for (int rep_ = 0; rep_ < 2; ++rep_)
#else
#define REP13
#endif

    { WSPTRS(ws, args.out)
      const int lane = lane0, gw = gw0;
    REP0 { ConvArgs ca; ca.w_in = w_in; ca.w_out = w_out; ca.w_gate = w_gate; ca.w_up = w_up; ca.w_down = w_down; ca.norm_mix_g = norm_mix_g; ca.norm_ffn_g = norm_ffn_g; ca.na_norm_g = na_norm_g; ca.ws = ws;
      LAS float* scr = (LAS float*)(lds + wave * CONV_SCR_BYTES);
      if (G == 256) convert_stream(ca, gw, ngw, CI_IN, scr, lane);
      else convert_stream(ca, gw, ngw, DEPTH * CI_LAYER, scr, lane); }
    { bf16* W16F = (bf16*)(ws + WS_W16F_OFF);
      for (int it = gw; it < DEPTH * 2 * 64; it += ngw) { const int mi = it >> 6, s = it & 63, l = mi >> 1;
          if (mi & 1) w16f_item(w_router + (size_t)l * D * NE, NE, norm_ffn_g + l * D, W16F + (size_t)mi * 32768, s, lane);
          else w16f_item(w_in + (size_t)l * D * NIN + C_GATES, NIN, norm_mix_g + l * D, W16F + (size_t)mi * 32768, s, lane); } }
    GRID_BAR();
    REP1 { RowArgs a; a.src32 = x; a.srcb = nullptr; a.sel = nullptr; a.Y = nullptr; a.XB = XB; a.XB8 = ws + WS_XB8; a.RSTD = RSTD; a.g = norm_mix_g; a.W16F = (const bf16*)(ws + WS_W16F_OFF); a.bias = b_gates; a.GATES = GATES; a.AFF = AFF; a.out = X; a.mode = 0; a.wrxb = 1;
      for (int grp = gw; grp < MTOK / 8; grp += ngw) rowpass_group<true>(a, grp, lane); } }
    GRID_BAR();

    for (int l = 0; l < DEPTH; ++l) {
        unsigned char* wsl = ws; float* Xl = args.out; LAUNDER(wsl); LAUNDER(Xl);
        WSPTRS(wsl, Xl)
        int lane = lane0, gw = gw0; asm volatile("" : "+v"(lane)); LAUNDER(gw);
        const bf16* WinT = (const bf16*)(wsl + WS_WIN) + (size_t)l * NPROJ * D; const bf16* WoutT = (const bf16*)(wsl + WS_WOUT) + (size_t)l * D * D;
        const bf16* WguT = (const bf16*)(wsl + WS_WGU) + (size_t)l * NE * 2048 * D; const bf16* WdT = (const bf16*)(wsl + WS_WD) + (size_t)l * NE * D * DE;
        const int Gg = (l == 0 && G == 256) ? G - NCONV : G;
        if (bx >= Gg) { ConvArgs ca; ca.w_in = w_in; ca.w_out = w_out; ca.w_gate = w_gate; ca.w_up = w_up; ca.w_down = w_down; ca.norm_mix_g = norm_mix_g; ca.norm_ffn_g = norm_ffn_g; ca.na_norm_g = na_norm_g; ca.ws = wsl;
          convert_stream(ca, CI_IN + (bx - Gg) * NWAVES + wave, NCONV * NWAVES, DEPTH * CI_LAYER, (LAS float*)(lds + wave * CONV_SCR_BYTES), lane); }
        else {
        REP2 { pg8::Gemm g{XB, WinT, MTOK, NPROJ16, D, 0}; pg8::StaticOrder S; S.init(MTOK, NPROJ16, Gg, bx); pg8::EpiRowScaleBf16 E{P, RSTD, nullptr, NPROJ, 0, 1.0f, 0};
          pg8::gemm_phase<pg8::EpiRowScaleBf16, pg8::StaticOrder, true, true>(lds, g, S, E); }
        { pg8::Gemm g{(const bf16*)(wsl + WS_XB8), (const bf16*)(wsl + WS_WIN + ((size_t)l * NPROJ + NPROJ16) * D * 2), MTOK, NPROJ - NPROJ16, D / 2, 0}; pg8::StaticOrder S; S.init(MTOK, NPROJ - NPROJ16, Gg, bx);
          pg8::EpiRowScaleBf16 E{P + NPROJ16, RSTD, nullptr, NPROJ, 0, 1.0f / W8_SCALE, 0};
          pg8::gemm_phase<pg8::EpiRowScaleBf16, pg8::StaticOrder, true, true, true>(lds, g, S, E); }
        }
        GRID_BAR();
        REP4 for (int u = vcu; u < 512; u += G) na_unit(u, P, na_rpb + (size_t)l * 8 * 15 * 31, MIX, (float*)(wsl + WS_SSQ), lds, tid, wave);
        { bf16* UC = (bf16*)(wsl + WS_UC); float* NU = (float*)(wsl + WS_NU); float* SC = (float*)(wsl + WS_SC); const float* cwl = conv_w + (size_t)l * 5 * 1024; const float* cbl = conv_b + l * 1024;
          int tidl = tid; asm volatile("" : "+v"(tidl));
          REP5 for (int u = bx; u < 512; u += G) mlstm_m1_unit(u, cwl, cbl, P, GATES, UC, NU, SC, lds, tidl, wave);
          GRID_BAR();
          mlstm_m2(UC, NU, SC, vcu * 512 + tidl, G * 512);
          { const float* ssq = (const float*)(wsl + WS_SSQ); float* rsna = (float*)(wsl + WS_RSNA);
            for (int t = vcu * 512 + tidl; t < MTOK; t += G * 512) { const f32x4 s0 = *(const f32x4*)(ssq + (size_t)t * 8), s1 = *(const f32x4*)(ssq + (size_t)t * 8 + 4);
                rsna[t] = 1.0f / sqrtf(((s0[0] + s0[1]) + (s0[2] + s0[3]) + (s1[0] + s1[1]) + (s1[2] + s1[3])) * (1.0f / 1024.0f) + EPS); } }
          GRID_BAR();
          REP7 for (int u = bx; u < 512; u += G) mlstm_m3_unit(u, cwl, cbl, P, GATES, UC, NU, SC, ml_norm_g + l * 1024, (const float*)(wsl + WS_RSNA), MIX, lds, tidl, wave); }
        GRID_BAR();
#if (REP_MASK >> 8) & 1
        for (int rep_ = 0; rep_ < 2; ++rep_)
#endif
        { pg8::Gemm g{MIX, WoutT, MTOK, D, D, 0}; pg8::StaticOrder S; S.init(MTOK, D, G, bx); pg8::EpiResidBf16 E{XB, (const float*)(wsl + WS_RSNA), D, 0};
#if (REP_MASK >> 8) & 1
          if (rep_ == 0) E.XB = P;
#endif
          pg8::gemm_phase<pg8::EpiResidBf16, pg8::StaticOrder, true, true>(lds, g, S, E); }
        GRID_BAR();
        REP9 { RowArgs a; a.src32 = nullptr; a.srcb = XB; a.sel = nullptr; a.Y = nullptr; a.XB = XB; a.XB8 = wsl + WS_XB8; a.RSTD = RSTD; a.g = norm_ffn_g + l * D; a.W16F = (const bf16*)(wsl + WS_W16F_OFF) + (size_t)(2 * l + 1) * 32768; a.bias = b_gates; a.GATES = GATES; a.AFF = AFF; a.out = X; a.mode = 1; a.wrxb = 0;
          for (int grp = gw; grp < MTOK / 8; grp += ngw) rowpass_group<false>(a, grp, lane); }
        GRID_BAR();
        REP10 for (int be = bx; be < BATCH * NE; be += G) topk_unit(be, AFF, TOK, GATEV, SEL, (LAS int*)lds);
        GRID_BAR();
        REP12 { pg8::Gemm g{(const bf16*)(wsl + WS_XB8), (const bf16*)(wsl + WS_WGU + (size_t)l * NE * 2048 * D), MR, 2048, D / 2, 0}; pg8::GroupedGatherOrder S{TOK, G, bx};
          pg8::EpiSwiGLU8 E{(unsigned char*)ACT, RSTD, TOK, DE, 8, 1.0f / W8_SCALE, 0};
          pg8::gemm_phase_gather<pg8::EpiSwiGLU8, pg8::GroupedGatherOrder, true, true, true>(lds, g, S, E); }
        GRID_BAR();
        REP13 { pg8::Gemm g{ACT, (const bf16*)(wsl + WS_WD + (size_t)l * NE * D * DE), MR, 2048, DE / 2, 0}; pg8::GroupedOrder S{nullptr, G, bx}; pg8::EpiRowScaleF8 E{(unsigned char*)Y, GATEV, D, 8, Y8_SCALE / W8_SCALE, 0};
          pg8::gemm_phase<pg8::EpiRowScaleF8, pg8::GroupedOrder, true, true, true>(lds, g, S, E); }
        GRID_BAR();
        { RowArgs a; a.src32 = nullptr; a.srcb = XB; a.sel = SEL; a.Y = (const unsigned char*)Y; a.XB = XB; a.XB8 = wsl + WS_XB8; a.RSTD = RSTD; a.bias = b_gates + (l + 1 < DEPTH ? (l + 1) * 16 : 0); a.GATES = GATES; a.AFF = AFF; a.out = X; a.wrxb = 1;
          a.W16F = (const bf16*)(wsl + WS_W16F_OFF) + (size_t)(2 * (l + 1 < DEPTH ? l + 1 : 0)) * 32768;
          if (l + 1 < DEPTH) { a.g = norm_mix_g + (l + 1) * D; a.mode = 0; }
          else { a.g = final_norm_g; a.mode = 2; }
          for (int grp = gw; grp < MTOK / 8; grp += ngw) rowpass_group<false>(a, grp, lane); }
        if (l + 1 < DEPTH) GRID_BAR();
    }
#undef GRID_BAR
#undef WSPTRS
}

extern "C" void kernel_launch(void* const* d_in, const int* in_sizes, int n_in, void* d_out, int out_size, void* d_ws, size_t ws_size, hipStream_t stream) {
    static int grid = 0;
    if (grid == 0) {
        if (n_in != 16 || ws_size < WS_END) { fprintf(stderr, "kernel_launch: unexpected n_in %d or ws_size %zu\n", n_in, ws_size); grid = -1; return; }
        int dev = 0, cus = 0, per_cu = 0;
        if (hipGetDevice(&dev) != hipSuccess || hipDeviceGetAttribute(&cus, hipDeviceAttributeMultiprocessorCount, dev) != hipSuccess) { grid = -1; return; }
        if (hipFuncSetAttribute((const void*)mk_fwd, hipFuncAttributeMaxDynamicSharedMemorySize, LDS_BYTES) != hipSuccess) { fprintf(stderr, "kernel_launch: hipFuncSetAttribute failed\n"); grid = -1; return; }
        if (hipOccupancyMaxActiveBlocksPerMultiprocessor(&per_cu, (const void*)mk_fwd, NWAVES * 64, LDS_BYTES) != hipSuccess || per_cu < 1) fprintf(stderr, "kernel_launch: occupancy query reports %d blocks per CU\n", per_cu);
        (void)hipGetLastError();
        grid = cus;
    }
    if (grid < 0) return;
    if (hipMemsetAsync((char*)d_ws + WS_CTL, 0, CTL_ZERO_BYTES, stream) != hipSuccess) return;
    MKArgs a; memset(&a, 0, sizeof(a));
    for (int i = 0; i < 16; ++i) a.in[i] = (const float*)d_in[i];
    a.out = (float*)d_out; a.ws = (unsigned char*)d_ws;
    hipLaunchKernelGGL(mk_fwd, dim3(grid), dim3(NWAVES * 64), LDS_BYTES, stream, a);
}
```

```cpp
#include <hip/hip_runtime.h>
#include <stdint.h>
#include <stdio.h>
#include <string.h>

namespace pg8 {
#define PG8_LAS __attribute__((address_space(3)))
typedef unsigned short bf16_t;
typedef short bf16x8 __attribute__((ext_vector_type(8)));
typedef float f32x4 __attribute__((ext_vector_type(4)));
typedef unsigned u32x4 __attribute__((ext_vector_type(4)));
typedef int v4i32 __attribute__((ext_vector_type(4)));
typedef int v8i32 __attribute__((ext_vector_type(8)));
constexpr int BM = 256, BK = 64, HALF = 128, HTB = HALF * BK * 2  , STAGE_BYTES = 8 * HTB, NXCD = 8, WGM = 8;

__host__ __device__ __forceinline__ int lds_byte(int r, int c) { const int st = (r >> 4) * 2 + (c >> 5), rr = r & 15, cc = c & 31, ob = rr * 64 + cc * 2; return st * 1024 + (ob ^ (((ob >> 9) & 1) << 5)); }
__host__ __device__ __forceinline__ void stage_rc(int b, int& R, int& C) { const int st = b / 1024, sb = b % 1024, swz = sb ^ (((sb >> 9) & 1) << 5); R = (st >> 1) * 16 + swz / 64; C = (st & 1) * 32 + (swz % 64) / 2; }
__host__ __device__ __forceinline__ int perm32(int rho) { const int n = rho >> 4, i = rho & 15; return 8 * (i >> 2) + 4 * n + (i & 3); }

struct Unit { int pm, pn; };
struct Gemm { const bf16_t* A; const bf16_t* Bt; int M, N, K, pad; };

struct StaticOrder {
    static constexpr bool GATHER = false;
    int nM, nN, nwg, G, c, pad;
    __host__ __device__ void init(int M, int N, int G_, int c_) { nM = M / BM; nN = N / BM; nwg = nM * nN; G = G_; c = c_; pad = 0; }
    __host__ __device__ bool next(int i, Unit& u) const {
        const long L = (long)i * G + c; if (L >= nwg) return false;
        int wgid = (int)L; { const int q = nwg / NXCD, r = nwg % NXCD, xcd = wgid % NXCD, off = wgid / NXCD; wgid = (xcd < r ? xcd * (q + 1) : r * (q + 1) + (xcd - r) * q) + off; }
        const int nig = WGM * nN, gid = wgid / nig, fm = gid * WGM, gsz = (nM - fm) < WGM ? (nM - fm) : WGM;
        u.pm = fm + ((wgid % nig) % gsz); u.pn = (wgid % nig) / gsz; return true;
    }
    __device__ __forceinline__ void a_ready(const Unit&) const {}
    __device__ __forceinline__ void done(const Unit&) const {}
};


__device__ __forceinline__ unsigned cvt_pk_bf16(float lo, float hi) { unsigned r; asm volatile("v_cvt_pk_bf16_f32 %0, %1, %2" : "=v"(r) : "v"(lo), "v"(hi)); return r; }
typedef unsigned u32x2 __attribute__((ext_vector_type(2)));

struct EpiRowScaleBf16 {
    static constexpr bool PERM = true, AFTER_DRAIN = false;
    bf16_t* O; const float* rowscale; const int* rowmap; int ldc; int pn_mod; float mul; int pad;
    __device__ __forceinline__ void pre(const Unit& u, int wr, int fr, float (&rs)[8]) const {
#pragma unroll
        for (int i = 0; i < 8; ++i) { const int row = u.pm * BM + wr * 64 + fr + (i >> 2) * HALF + (i & 3) * 16; rs[i] = rowscale ? rowscale[rowmap ? rowmap[row] : row] : 1.0f; } }
    __device__ __forceinline__ void operator()(const f32x4 (&acc)[2][2][4][2], const Unit& u, int wr, int wc, int fr, int fq, const float (&rs)[8]) const {
        const int row0 = u.pm * BM + wr * 64 + fr; const int pnl = pn_mod ? (u.pn % pn_mod) : u.pn;
        const int col0 = pnl * BM + wc * 32 + 8 * fq;
#pragma unroll
        for (int ai = 0; ai < 2; ++ai)
#pragma unroll
            for (int m = 0; m < 4; ++m) { const int row = row0 + ai * HALF + m * 16; const float sc = rs[4 * ai + m] * mul;
                bf16_t* rowp = O + (size_t)row * ldc + col0;
#pragma unroll
                for (int bj = 0; bj < 2; ++bj) { const f32x4 v0 = acc[ai][bj][m][0] * sc, v1 = acc[ai][bj][m][1] * sc;
                    u32x4 w; w.x = cvt_pk_bf16(v0[0], v0[1]); w.y = cvt_pk_bf16(v0[2], v0[3]); w.z = cvt_pk_bf16(v1[0], v1[1]); w.w = cvt_pk_bf16(v1[2], v1[3]);
                    *(u32x4*)(rowp + bj * HALF) = w; } }
    }
};
__device__ __forceinline__ unsigned pk4_fp8(float a, float b, float c, float d) { int p = __builtin_amdgcn_cvt_pk_fp8_f32(a, b, 0, false); p = __builtin_amdgcn_cvt_pk_fp8_f32(c, d, p, true); return (unsigned)p; }
struct EpiSwiGLU8 {
    static constexpr bool PERM = false, AFTER_DRAIN = false;
    unsigned char* O; const float* rowscale; const int* rowmap; int ldc; int pn_mod; float mul; int pad;
    __device__ __forceinline__ void pre(const Unit& u, int wr, int fr, float (&rs)[8]) const {
#pragma unroll
        for (int i = 0; i < 8; ++i) { const int row = u.pm * BM + wr * 64 + fr + (i >> 2) * HALF + (i & 3) * 16; rs[i] = rowscale[rowmap[row]]; } }
    __device__ __forceinline__ void operator()(const f32x4 (&acc)[2][2][4][2], const Unit& u, int wr, int wc, int fr, int fq, const float (&rs)[8]) const {
        const int row0 = u.pm * BM + wr * 64 + fr; const int pnl = u.pn % pn_mod;
        const int col0 = pnl * 128 + wc * 16 + 4 * fq;
#pragma unroll
        for (int ai = 0; ai < 2; ++ai)
#pragma unroll
            for (int m = 0; m < 4; ++m) { const int row = row0 + ai * HALF + m * 16; const float sc = rs[4 * ai + m] * mul;
                unsigned char* rowp = O + (size_t)row * ldc + col0;
#pragma unroll
                for (int bj = 0; bj < 2; ++bj) { const f32x4 a = acc[ai][bj][m][0] * sc, up = acc[ai][bj][m][1] * sc; f32x4 r;
#pragma unroll
                    for (int j = 0; j < 4; ++j) r[j] = a[j] * up[j] * __builtin_amdgcn_rcpf(1.0f + __builtin_amdgcn_exp2f(-1.4426950408889634f * a[j]));
                    *(unsigned*)(rowp + bj * 64) = pk4_fp8(r[0], r[1], r[2], r[3]); } }
    }
};

struct EpiRowScaleF8 {
    static constexpr bool PERM = true, AFTER_DRAIN = false;
    unsigned char* O; const float* rowscale; int ldc; int pn_mod; float mul; int pad;
    __device__ __forceinline__ void pre(const Unit& u, int wr, int fr, float (&rs)[8]) const {
#pragma unroll
        for (int i = 0; i < 8; ++i) rs[i] = rowscale[u.pm * BM + wr * 64 + fr + (i >> 2) * HALF + (i & 3) * 16]; }
    __device__ __forceinline__ void operator()(const f32x4 (&acc)[2][2][4][2], const Unit& u, int wr, int wc, int fr, int fq, const float (&rs)[8]) const {
        const int row0 = u.pm * BM + wr * 64 + fr; const int pnl = pn_mod ? (u.pn % pn_mod) : u.pn;
        const int col0 = pnl * BM + wc * 32 + 8 * fq;
#pragma unroll
        for (int ai = 0; ai < 2; ++ai)
#pragma unroll
            for (int m = 0; m < 4; ++m) { const int row = row0 + ai * HALF + m * 16; const float sc = rs[4 * ai + m] * mul;
                unsigned char* rowp = O + (size_t)row * ldc + col0;
#pragma unroll
                for (int bj = 0; bj < 2; ++bj) { const f32x4 v0 = acc[ai][bj][m][0] * sc, v1 = acc[ai][bj][m][1] * sc;
                    u32x2 w; w.x = pk4_fp8(v0[0], v0[1], v0[2], v0[3]); w.y = pk4_fp8(v1[0], v1[1], v1[2], v1[3]);
                    *(u32x2*)(rowp + bj * HALF) = w; } }
    }
};

struct EpiResidBf16 {
    static constexpr bool PERM = true, AFTER_DRAIN = false;
    bf16_t* XB; const float* rowscale; int ldc; int pad;
    __device__ __forceinline__ void pre(const Unit& u, int wr, int fr, float (&rs)[8]) const {
#pragma unroll
        for (int i = 0; i < 8; ++i) rs[i] = rowscale[u.pm * BM + wr * 64 + fr + (i >> 2) * HALF + (i & 3) * 16]; }
    __device__ __forceinline__ void operator()(const f32x4 (&acc)[2][2][4][2], const Unit& u, int wr, int wc, int fr, int fq, const float (&rs)[8]) const {
        const int row0 = u.pm * BM + wr * 64 + fr, col0 = u.pn * BM + wc * 32 + 8 * fq;
#pragma unroll
        for (int ai = 0; ai < 2; ++ai) {
            u32x4 xin[4][2];
#pragma unroll
            for (int m = 0; m < 4; ++m)
#pragma unroll
                for (int bj = 0; bj < 2; ++bj) xin[m][bj] = *(const u32x4*)(XB + (size_t)(row0 + ai * HALF + m * 16) * ldc + col0 + bj * HALF);
#pragma unroll
            for (int m = 0; m < 4; ++m) { const int row = row0 + ai * HALF + m * 16; const float sc = rs[4 * ai + m]; bf16_t* rowp = XB + (size_t)row * ldc + col0;
#pragma unroll
                for (int bj = 0; bj < 2; ++bj) { const u32x4 x = xin[m][bj]; const f32x4 v0 = acc[ai][bj][m][0] * sc, v1 = acc[ai][bj][m][1] * sc;
                    u32x4 w; w.x = cvt_pk_bf16(__uint_as_float(x.x << 16) + v0[0], __uint_as_float(x.x & 0xffff0000u) + v0[1]); w.y = cvt_pk_bf16(__uint_as_float(x.y << 16) + v0[2], __uint_as_float(x.y & 0xffff0000u) + v0[3]);
                    w.z = cvt_pk_bf16(__uint_as_float(x.z << 16) + v1[0], __uint_as_float(x.z & 0xffff0000u) + v1[1]); w.w = cvt_pk_bf16(__uint_as_float(x.w << 16) + v1[2], __uint_as_float(x.w & 0xffff0000u) + v1[3]);
                    *(u32x4*)(rowp + bj * HALF) = w; } } }
    }
};
template <bool GATHER_> struct GroupedOrderT {
    static constexpr bool GATHER = GATHER_;
    const int* rowmap; int G, c;
    __device__ __forceinline__ bool next(int i, Unit& u) const {
        const int L = i * G + c; if (L >= 1024) return false;
        const int e = L >> 6, w = L & 63; u.pm = e * 8 + (w & 7); u.pn = e * 8 + (w >> 3); return true;
    }
    __device__ __forceinline__ void a_ready(const Unit&) const {}
    __device__ __forceinline__ void done(const Unit&) const {}
};
typedef GroupedOrderT<false> GroupedOrder; typedef GroupedOrderT<true> GroupedGatherOrder;
template <class Epi, class Sched, bool ALIGN_EPI = false, bool SP2 = false, bool F8 = false>
__device__ __forceinline__ void gemm_phase(PG8_LAS unsigned char* lds, const Gemm g, const Sched& S, const Epi& E) {
    int tid_ = threadIdx.x; asm volatile("" : "+v"(tid_));
    const int tid = tid_, wid = __builtin_amdgcn_readfirstlane(tid >> 6), lane = tid & 63, wr = wid >> 2, wc = wid & 3, fr = lane & 15, fq = lane >> 4;
    const int K = g.K, nt = K / BK;
    unsigned voffA[2], voffB[2];
#pragma unroll
    for (int i = 0; i < 2; ++i) { int R, C; stage_rc(tid * 16 + i * 8192, R, C); const int Rb = Epi::PERM ? ((R & ~31) + perm32(R & 31)) : R;
        voffA[i] = (unsigned)(R * K + C) * 2u; voffB[i] = (unsigned)(Rb * K + C) * 2u; }
    const size_t kstep = (size_t)(BK * 2);
    const size_t hstep = (size_t)HALF * K * 2;
    const size_t tstep = 2 * hstep;
    const unsigned ldsw = (unsigned)wid * 1024u;
    const int aoff = lds_byte(wr * 64 + fr, fq * 8), boff = lds_byte(wc * 32 + fr, fq * 8);
#define PG8_SA(b, h) (((b) * 2 + (h)) * HTB)
#define PG8_SB(b, h) ((4 + (b) * 2 + (h)) * HTB)
#define PG8_STAGE(bufoff, gbase, voff) do { _Pragma("unroll") for (int _i = 0; _i < 2; ++_i) \
        __builtin_amdgcn_global_load_lds((const unsigned*)((const char*)(gbase) + (voff)[_i]), (PG8_LAS unsigned*)(lds + (bufoff) + ldsw + _i * 8192), 16, 0, 0); } while (0)
#define PG8_LDA(dst, b, h) do { if constexpr (F8) { _Pragma("unroll") for (int m = 0; m < 4; ++m) dst##8[m] = __builtin_shufflevector(*(const PG8_LAS v4i32*)(lds + PG8_SA(b, h) + aoff + m * 2048), *(const PG8_LAS v4i32*)(lds + PG8_SA(b, h) + aoff + m * 2048 + 1024), 0, 1, 2, 3, 4, 5, 6, 7); } \
    else { _Pragma("unroll") for (int m = 0; m < 4; ++m) _Pragma("unroll") for (int k = 0; k < 2; ++k) dst[m][k] = *(const PG8_LAS bf16x8*)(lds + PG8_SA(b, h) + aoff + m * 2048 + k * 1024); } } while (0)
#define PG8_LDB(dst, b, h) do { if constexpr (F8) { _Pragma("unroll") for (int n = 0; n < 2; ++n) dst##8[n] = __builtin_shufflevector(*(const PG8_LAS v4i32*)(lds + PG8_SB(b, h) + boff + n * 2048), *(const PG8_LAS v4i32*)(lds + PG8_SB(b, h) + boff + n * 2048 + 1024), 0, 1, 2, 3, 4, 5, 6, 7); } \
    else { _Pragma("unroll") for (int n = 0; n < 2; ++n) _Pragma("unroll") for (int k = 0; k < 2; ++k) dst[n][k] = *(const PG8_LAS bf16x8*)(lds + PG8_SB(b, h) + boff + n * 2048 + k * 1024); } } while (0)
#define PG8_MMA(ai, bj, At, Bt) do { __builtin_amdgcn_s_setprio(1); _Pragma("unroll") for (int m = 0; m < 4; ++m) _Pragma("unroll") for (int n = 0; n < 2; ++n) { \
        if constexpr (F8) asm volatile("v_mfma_f32_16x16x128_f8f6f4 %0, %1, %2, %0" : "+v"(acc[ai][bj][m][n]) : "v"(Bt##8[n]), "v"(At##8[m]));   \
        else { _Pragma("unroll") for (int k = 0; k < 2; ++k) acc[ai][bj][m][n] = __builtin_amdgcn_mfma_f32_16x16x32_bf16(Bt[n][k], At[m][k], acc[ai][bj][m][n], 0, 0, 0); } } \
        __builtin_amdgcn_s_setprio(0); } while (0)
#define PG8_WAIT_V(n) asm volatile("s_waitcnt vmcnt(" #n ")" ::: "memory")
#define PG8_WAIT_L(n) asm volatile("s_waitcnt lgkmcnt(" #n ")" ::: "memory")
#define PG8_BAR __builtin_amdgcn_s_barrier()
#define PG8_SCHED __builtin_amdgcn_sched_barrier(0)
    Unit cur, nxt; int ui = 0;
    if (!S.next(0, cur)) return;
    f32x4 acc[2][2][4][2];
#pragma unroll
    for (int a = 0; a < 2; ++a)
#pragma unroll
        for (int b = 0; b < 2; ++b)
#pragma unroll
            for (int m = 0; m < 4; ++m)
#pragma unroll
                for (int n = 0; n < 2; ++n) acc[a][b][m][n] = (f32x4){0.f, 0.f, 0.f, 0.f};
    bf16x8 At[4][2], B0[2][2], B1[2][2]; v8i32 At8[4], B08[2], B18[2];
    const char* cA = (const char*)g.A + (size_t)cur.pm * tstep; const char* cB = (const char*)g.Bt + (size_t)cur.pn * tstep;
    float rs[8];
    E.pre(cur, wr, fr, rs);
    S.a_ready(cur);
    if constexpr (SP2) {
        PG8_STAGE(PG8_SB(0, 0), cB, voffB); PG8_STAGE(PG8_SB(0, 1), cB + hstep, voffB); PG8_STAGE(PG8_SA(0, 0), cA, voffA); PG8_STAGE(PG8_SA(0, 1), cA + hstep, voffA);
        if (wr == 1) PG8_BAR;
        PG8_WAIT_V(2); PG8_BAR;
        PG8_STAGE(PG8_SB(1, 0), cB + kstep, voffB); PG8_STAGE(PG8_SA(1, 0), cA + kstep, voffA); PG8_STAGE(PG8_SB(1, 1), cB + hstep + kstep, voffB);
        PG8_WAIT_V(6); PG8_BAR;
    } else {
        PG8_STAGE(PG8_SB(0, 0), cB, voffB); PG8_STAGE(PG8_SA(0, 0), cA, voffA); PG8_STAGE(PG8_SB(0, 1), cB + hstep, voffB); PG8_STAGE(PG8_SA(0, 1), cA + hstep, voffA);
        if (wr == 1) PG8_BAR;
        PG8_WAIT_V(4); PG8_BAR;
        PG8_STAGE(PG8_SB(1, 0), cB + kstep, voffB); PG8_STAGE(PG8_SA(1, 0), cA + kstep, voffA); PG8_STAGE(PG8_SB(1, 1), cB + hstep + kstep, voffB);
        PG8_WAIT_V(6); PG8_BAR;
    }
    for (;;) {
        const bool has_next = S.next(ui + 1, nxt);
        const char* nA = has_next ? (const char*)g.A + (size_t)nxt.pm * tstep : cA; const char* nB = has_next ? (const char*)g.Bt + (size_t)nxt.pn * tstep : cB;
        for (int t = 0; t < nt; t += 2) {
            const bool last = (t == nt - 2);
            const char* a1 = cA + (size_t)(t + 1) * kstep;
            const char* a2 = last ? nA : cA + (size_t)(t + 2) * kstep; const char* b2 = last ? nB : cB + (size_t)(t + 2) * kstep;
            const char* a3 = a2 + kstep; const char* b3 = b2 + kstep;
            if (last && has_next) S.a_ready(nxt);
            if constexpr (SP2) {
            PG8_LDB(B0, 0, 0); PG8_LDB(B1, 0, 1); PG8_SCHED; PG8_LDA(At, 0, 0); PG8_STAGE(PG8_SA(1, 1), a1 + hstep, voffA);
            PG8_WAIT_V(8); PG8_WAIT_L(0); PG8_BAR; PG8_MMA(0, 0, At, B0); PG8_MMA(0, 1, At, B1); PG8_BAR; PG8_SCHED;
            PG8_LDA(At, 0, 1); PG8_STAGE(PG8_SB(0, 0), b2, voffB); PG8_STAGE(PG8_SB(0, 1), b2 + hstep, voffB); PG8_STAGE(PG8_SA(0, 0), a2, voffA);
            PG8_WAIT_V(8); PG8_WAIT_L(0); PG8_BAR; PG8_MMA(1, 0, At, B0); PG8_MMA(1, 1, At, B1); PG8_BAR; PG8_SCHED;
            PG8_LDB(B0, 1, 0); PG8_LDB(B1, 1, 1); PG8_SCHED; PG8_LDA(At, 1, 0); PG8_STAGE(PG8_SA(0, 1), a2 + hstep, voffA);
            PG8_WAIT_V(8); PG8_WAIT_L(0); PG8_BAR; PG8_MMA(0, 0, At, B0); PG8_MMA(0, 1, At, B1); PG8_BAR; PG8_SCHED;
            PG8_LDA(At, 1, 1); PG8_STAGE(PG8_SB(1, 0), b3, voffB); PG8_STAGE(PG8_SB(1, 1), b3 + hstep, voffB); PG8_STAGE(PG8_SA(1, 0), a3, voffA);
            PG8_WAIT_V(8); PG8_WAIT_L(0); PG8_BAR; PG8_MMA(1, 0, At, B0); PG8_MMA(1, 1, At, B1); PG8_BAR; PG8_SCHED;
            } else {
            PG8_LDB(B0, 0, 0); PG8_SCHED; PG8_LDA(At, 0, 0); PG8_STAGE(PG8_SA(1, 1), a1 + hstep, voffA);
            PG8_WAIT_L(8); PG8_BAR; PG8_WAIT_L(0); PG8_MMA(0, 0, At, B0); PG8_BAR; PG8_SCHED;
            PG8_LDB(B1, 0, 1); PG8_STAGE(PG8_SB(0, 0), b2, voffB);
            PG8_BAR; PG8_WAIT_L(0); PG8_MMA(0, 1, At, B1); PG8_BAR;
            PG8_LDA(At, 0, 1); PG8_STAGE(PG8_SA(0, 0), a2, voffA);
            PG8_BAR; PG8_WAIT_L(0); PG8_MMA(1, 0, At, B0); PG8_BAR; PG8_SCHED;
            PG8_STAGE(PG8_SB(0, 1), b2 + hstep, voffB);
            PG8_WAIT_V(6); PG8_BAR; PG8_MMA(1, 1, At, B1); PG8_BAR;
            PG8_LDB(B0, 1, 0); PG8_SCHED; PG8_LDA(At, 1, 0); PG8_STAGE(PG8_SA(0, 1), a2 + hstep, voffA);
            PG8_WAIT_L(8); PG8_BAR; PG8_WAIT_L(0); PG8_MMA(0, 0, At, B0); PG8_BAR; PG8_SCHED;
            PG8_LDB(B1, 1, 1); PG8_STAGE(PG8_SB(1, 0), b3, voffB);
            PG8_BAR; PG8_WAIT_L(0); PG8_MMA(0, 1, At, B1); PG8_BAR;
            PG8_LDA(At, 1, 1); PG8_STAGE(PG8_SA(1, 0), a3, voffA);
            PG8_BAR; PG8_WAIT_L(0); PG8_MMA(1, 0, At, B0); PG8_BAR; PG8_SCHED;
            PG8_STAGE(PG8_SB(1, 1), b3 + hstep, voffB);
            PG8_WAIT_V(6); PG8_BAR; PG8_MMA(1, 1, At, B1); PG8_BAR;
            }
        }
        if constexpr (F8) asm volatile("s_nop 15\n\ts_nop 15" ::: "memory");
        if constexpr (ALIGN_EPI) { if (wr == 0) PG8_BAR; }
        if constexpr (!Epi::AFTER_DRAIN) { E(acc, cur, wr, wc, fr, fq, rs); S.done(cur); }
        if (!has_next) break;
#pragma unroll
        for (int a = 0; a < 2; ++a)
#pragma unroll
            for (int b = 0; b < 2; ++b)
#pragma unroll
                for (int m = 0; m < 4; ++m)
#pragma unroll
                    for (int n = 0; n < 2; ++n) acc[a][b][m][n] = (f32x4){0.f, 0.f, 0.f, 0.f};
        cur = nxt; cA = nA; cB = nB; ++ui;
        E.pre(cur, wr, fr, rs);
        if constexpr (ALIGN_EPI) { if (wr == 1) PG8_BAR; }
    }
    PG8_WAIT_V(0);
    if constexpr (!ALIGN_EPI) { if (wr == 0) PG8_BAR; }
    PG8_BAR;
    if constexpr (Epi::AFTER_DRAIN) { E.fused(acc, cur, wr, wc, fr, fq, lds, wid, lane); S.done(cur); }
#undef PG8_SA
#undef PG8_SB
#undef PG8_STAGE
#undef PG8_LDA
#undef PG8_LDB
#undef PG8_MMA
#undef PG8_WAIT_V
#undef PG8_WAIT_L
#undef PG8_BAR
#undef PG8_SCHED
}

template <class Epi, class Sched, bool ALIGN_EPI = false, bool SP2 = false, bool F8 = false>
__device__ __forceinline__ void gemm_phase_gather(PG8_LAS unsigned char* lds, const Gemm g, const Sched& S, const Epi& E) {
    int tid_ = threadIdx.x; asm volatile("" : "+v"(tid_));
    const int tid = tid_, wid = __builtin_amdgcn_readfirstlane(tid >> 6), lane = tid & 63, wr = wid >> 2, wc = wid & 3, fr = lane & 15, fq = lane >> 4;
    static_assert(SP2 || !Sched::GATHER, "gathered A rows: SP2 loop only");
    const int K = g.K, nt = K / BK;
    unsigned voffA[2], voffB[2];
#pragma unroll
    for (int i = 0; i < 2; ++i) { int R, C; stage_rc(tid * 16 + i * 8192, R, C); const int Rb = Epi::PERM ? ((R & ~31) + perm32(R & 31)) : R;
        voffA[i] = (unsigned)(R * K + C) * 2u; voffB[i] = (unsigned)(Rb * K + C) * 2u; }
    constexpr bool GATHER = Sched::GATHER;
    int RA[2], CA[2];
#pragma unroll
    for (int i = 0; i < 2; ++i) stage_rc(tid * 16 + i * 8192, RA[i], CA[i]);
    const size_t kstep = (size_t)(BK * 2);
    const size_t hstep = (size_t)HALF * K * 2;
    const size_t tstep = 2 * hstep;
    const unsigned ldsw = (unsigned)wid * 1024u;
    const int aoff = lds_byte(wr * 64 + fr, fq * 8), boff = lds_byte(wc * 32 + fr, fq * 8);
#define PG8_SA(b, h) (((b) * 2 + (h)) * HTB)
#define PG8_SB(b, h) ((4 + (b) * 2 + (h)) * HTB)
#define PG8_STAGE(bufoff, gbase, voff) do { _Pragma("unroll") for (int _i = 0; _i < 2; ++_i) \
        __builtin_amdgcn_global_load_lds((const unsigned*)((const char*)(gbase) + (voff)[_i]), (PG8_LAS unsigned*)(lds + (bufoff) + ldsw + _i * 8192), 16, 0, 0); } while (0)
#define PG8_LDA(dst, b, h) do { if constexpr (F8) { _Pragma("unroll") for (int m = 0; m < 4; ++m) dst##8[m] = __builtin_shufflevector(*(const PG8_LAS v4i32*)(lds + PG8_SA(b, h) + aoff + m * 2048), *(const PG8_LAS v4i32*)(lds + PG8_SA(b, h) + aoff + m * 2048 + 1024), 0, 1, 2, 3, 4, 5, 6, 7); } \
    else { _Pragma("unroll") for (int m = 0; m < 4; ++m) _Pragma("unroll") for (int k = 0; k < 2; ++k) dst[m][k] = *(const PG8_LAS bf16x8*)(lds + PG8_SA(b, h) + aoff + m * 2048 + k * 1024); } } while (0)
#define PG8_LDB(dst, b, h) do { if constexpr (F8) { _Pragma("unroll") for (int n = 0; n < 2; ++n) dst##8[n] = __builtin_shufflevector(*(const PG8_LAS v4i32*)(lds + PG8_SB(b, h) + boff + n * 2048), *(const PG8_LAS v4i32*)(lds + PG8_SB(b, h) + boff + n * 2048 + 1024), 0, 1, 2, 3, 4, 5, 6, 7); } \
    else { _Pragma("unroll") for (int n = 0; n < 2; ++n) _Pragma("unroll") for (int k = 0; k < 2; ++k) dst[n][k] = *(const PG8_LAS bf16x8*)(lds + PG8_SB(b, h) + boff + n * 2048 + k * 1024); } } while (0)
#define PG8_MMA(ai, bj, At, Bt) do { __builtin_amdgcn_s_setprio(1); _Pragma("unroll") for (int m = 0; m < 4; ++m) _Pragma("unroll") for (int n = 0; n < 2; ++n) { \
        if constexpr (F8) asm volatile("v_mfma_f32_16x16x128_f8f6f4 %0, %1, %2, %0" : "+v"(acc[ai][bj][m][n]) : "v"(Bt##8[n]), "v"(At##8[m]));   \
        else { _Pragma("unroll") for (int k = 0; k < 2; ++k) acc[ai][bj][m][n] = __builtin_amdgcn_mfma_f32_16x16x32_bf16(Bt[n][k], At[m][k], acc[ai][bj][m][n], 0, 0, 0); } } \
        __builtin_amdgcn_s_setprio(0); } while (0)
#define PG8_WAIT_V(n) asm volatile("s_waitcnt vmcnt(" #n ")" ::: "memory")
#define PG8_WAIT_L(n) asm volatile("s_waitcnt lgkmcnt(" #n ")" ::: "memory")
#define PG8_BAR __builtin_amdgcn_s_barrier()
#define PG8_SCHED __builtin_amdgcn_sched_barrier(0)
    Unit cur, nxt; int ui = 0;
    if (!S.next(0, cur)) return;
    f32x4 acc[2][2][4][2];
#pragma unroll
    for (int a = 0; a < 2; ++a)
#pragma unroll
        for (int b = 0; b < 2; ++b)
#pragma unroll
            for (int m = 0; m < 4; ++m)
#pragma unroll
                for (int n = 0; n < 2; ++n) acc[a][b][m][n] = (f32x4){0.f, 0.f, 0.f, 0.f};
    bf16x8 At[4][2], B0[2][2], B1[2][2]; v8i32 At8[4], B08[2], B18[2];
    const char* cA = GATHER ? (const char*)g.A : (const char*)g.A + (size_t)cur.pm * tstep; const char* cB = (const char*)g.Bt + (size_t)cur.pn * tstep;
    unsigned offC[2][2], offN[2][2];
#define PG8_SETOFF(o, u) do { _Pragma("unroll") for (int _h = 0; _h < 2; ++_h) _Pragma("unroll") for (int _i = 0; _i < 2; ++_i) { \
        if constexpr (GATHER) o[_h][_i] = (unsigned)S.rowmap[(u).pm * BM + _h * HALF + RA[_i]] * (unsigned)(K * 2) + (unsigned)(CA[_i] * 2); \
        else o[_h][_i] = voffA[_i] + (unsigned)(_h * (int)hstep); } } while (0)
    PG8_SETOFF(offC, cur);
#pragma unroll
    for (int _h = 0; _h < 2; ++_h) { offN[_h][0] = offC[_h][0]; offN[_h][1] = offC[_h][1]; }
    float rs[8];
    E.pre(cur, wr, fr, rs);
    S.a_ready(cur);
    if constexpr (SP2) {
        PG8_STAGE(PG8_SB(0, 0), cB, voffB); PG8_STAGE(PG8_SB(0, 1), cB + hstep, voffB); PG8_STAGE(PG8_SA(0, 0), cA, offC[0]); PG8_STAGE(PG8_SA(0, 1), cA, offC[1]);
        if (wr == 1) PG8_BAR;
        PG8_WAIT_V(2); PG8_BAR;
        PG8_STAGE(PG8_SB(1, 0), cB + kstep, voffB); PG8_STAGE(PG8_SA(1, 0), cA + kstep, offC[0]); PG8_STAGE(PG8_SB(1, 1), cB + hstep + kstep, voffB);
        PG8_WAIT_V(6); PG8_BAR;
    } else {
        PG8_STAGE(PG8_SB(0, 0), cB, voffB); PG8_STAGE(PG8_SA(0, 0), cA, voffA); PG8_STAGE(PG8_SB(0, 1), cB + hstep, voffB); PG8_STAGE(PG8_SA(0, 1), cA + hstep, voffA);
        if (wr == 1) PG8_BAR;
        PG8_WAIT_V(4); PG8_BAR;
        PG8_STAGE(PG8_SB(1, 0), cB + kstep, voffB); PG8_STAGE(PG8_SA(1, 0), cA + kstep, voffA); PG8_STAGE(PG8_SB(1, 1), cB + hstep + kstep, voffB);
        PG8_WAIT_V(6); PG8_BAR;
    }
    for (;;) {
        const bool has_next = S.next(ui + 1, nxt);
        const char* nA = GATHER ? cA : (has_next ? (const char*)g.A + (size_t)nxt.pm * tstep : cA); const char* nB = has_next ? (const char*)g.Bt + (size_t)nxt.pn * tstep : cB;
        if constexpr (GATHER) { if (has_next) PG8_SETOFF(offN, nxt); }
        for (int t = 0; t < nt; t += 2) {
            const bool last = (t == nt - 2);
            const char* a1 = cA + (size_t)(t + 1) * kstep;
            const char* a2 = last ? nA : cA + (size_t)(t + 2) * kstep; const char* b2 = last ? nB : cB + (size_t)(t + 2) * kstep;
            const char* a3 = a2 + kstep; const char* b3 = b2 + kstep;
            if (last && has_next) S.a_ready(nxt);
            unsigned o2[2][2];
#pragma unroll
            for (int _h = 0; _h < 2; ++_h)
#pragma unroll
                for (int _i = 0; _i < 2; ++_i) o2[_h][_i] = (GATHER && last) ? offN[_h][_i] : offC[_h][_i];
            if constexpr (SP2) {
            PG8_LDB(B0, 0, 0); PG8_LDB(B1, 0, 1); PG8_SCHED; PG8_LDA(At, 0, 0); PG8_STAGE(PG8_SA(1, 1), a1, offC[1]);
            PG8_WAIT_V(8); PG8_WAIT_L(0); PG8_BAR; PG8_MMA(0, 0, At, B0); PG8_MMA(0, 1, At, B1); PG8_BAR; PG8_SCHED;
            PG8_LDA(At, 0, 1); PG8_STAGE(PG8_SB(0, 0), b2, voffB); PG8_STAGE(PG8_SB(0, 1), b2 + hstep, voffB); PG8_STAGE(PG8_SA(0, 0), a2, o2[0]);
            PG8_WAIT_V(8); PG8_WAIT_L(0); PG8_BAR; PG8_MMA(1, 0, At, B0); PG8_MMA(1, 1, At, B1); PG8_BAR; PG8_SCHED;
            PG8_LDB(B0, 1, 0); PG8_LDB(B1, 1, 1); PG8_SCHED; PG8_LDA(At, 1, 0); PG8_STAGE(PG8_SA(0, 1), a2, o2[1]);
            PG8_WAIT_V(8); PG8_WAIT_L(0); PG8_BAR; PG8_MMA(0, 0, At, B0); PG8_MMA(0, 1, At, B1); PG8_BAR; PG8_SCHED;
            PG8_LDA(At, 1, 1); PG8_STAGE(PG8_SB(1, 0), b3, voffB); PG8_STAGE(PG8_SB(1, 1), b3 + hstep, voffB); PG8_STAGE(PG8_SA(1, 0), a3, o2[0]);
            PG8_WAIT_V(8); PG8_WAIT_L(0); PG8_BAR; PG8_MMA(1, 0, At, B0); PG8_MMA(1, 1, At, B1); PG8_BAR; PG8_SCHED;
            } else {
            PG8_LDB(B0, 0, 0); PG8_SCHED; PG8_LDA(At, 0, 0); PG8_STAGE(PG8_SA(1, 1), a1 + hstep, voffA);
            PG8_WAIT_L(8); PG8_BAR; PG8_WAIT_L(0); PG8_MMA(0, 0, At, B0); PG8_BAR; PG8_SCHED;
            PG8_LDB(B1, 0, 1); PG8_STAGE(PG8_SB(0, 0), b2, voffB);
            PG8_BAR; PG8_WAIT_L(0); PG8_MMA(0, 1, At, B1); PG8_BAR;
            PG8_LDA(At, 0, 1); PG8_STAGE(PG8_SA(0, 0), a2, voffA);
            PG8_BAR; PG8_WAIT_L(0); PG8_MMA(1, 0, At, B0); PG8_BAR; PG8_SCHED;
            PG8_STAGE(PG8_SB(0, 1), b2 + hstep, voffB);
            PG8_WAIT_V(6); PG8_BAR; PG8_MMA(1, 1, At, B1); PG8_BAR;
            PG8_LDB(B0, 1, 0); PG8_SCHED; PG8_LDA(At, 1, 0); PG8_STAGE(PG8_SA(0, 1), a2 + hstep, voffA);
            PG8_WAIT_L(8); PG8_BAR; PG8_WAIT_L(0); PG8_MMA(0, 0, At, B0); PG8_BAR; PG8_SCHED;
            PG8_LDB(B1, 1, 1); PG8_STAGE(PG8_SB(1, 0), b3, voffB);
            PG8_BAR; PG8_WAIT_L(0); PG8_MMA(0, 1, At, B1); PG8_BAR;
            PG8_LDA(At, 1, 1); PG8_STAGE(PG8_SA(1, 0), a3, voffA);
            PG8_BAR; PG8_WAIT_L(0); PG8_MMA(1, 0, At, B0); PG8_BAR; PG8_SCHED;
            PG8_STAGE(PG8_SB(1, 1), b3 + hstep, voffB);
            PG8_WAIT_V(6); PG8_BAR; PG8_MMA(1, 1, At, B1); PG8_BAR;
            }
        }
        if constexpr (F8) asm volatile("s_nop 15\n\ts_nop 15" ::: "memory");
        if constexpr (ALIGN_EPI) { if (wr == 0) PG8_BAR; }
        if constexpr (!Epi::AFTER_DRAIN) { E(acc, cur, wr, wc, fr, fq, rs); S.done(cur); }
        if (!has_next) break;
#pragma unroll
        for (int a = 0; a < 2; ++a)
#pragma unroll
            for (int b = 0; b < 2; ++b)
#pragma unroll
                for (int m = 0; m < 4; ++m)
#pragma unroll
                    for (int n = 0; n < 2; ++n) acc[a][b][m][n] = (f32x4){0.f, 0.f, 0.f, 0.f};
        cur = nxt; cA = nA; cB = nB; ++ui;
        E.pre(cur, wr, fr, rs);
#pragma unroll
        for (int _h = 0; _h < 2; ++_h) { offC[_h][0] = offN[_h][0]; offC[_h][1] = offN[_h][1]; }
        if constexpr (ALIGN_EPI) { if (wr == 1) PG8_BAR; }
    }
    PG8_WAIT_V(0);
    if constexpr (!ALIGN_EPI) { if (wr == 0) PG8_BAR; }
    PG8_BAR;
    if constexpr (Epi::AFTER_DRAIN) { E.fused(acc, cur, wr, wc, fr, fq, lds, wid, lane); S.done(cur); }
#undef PG8_SETOFF
#undef PG8_SA
#undef PG8_SB
#undef PG8_STAGE
#undef PG8_LDA
#undef PG8_LDB
#undef PG8_MMA
#undef PG8_WAIT_V
#undef PG8_WAIT_L
#undef PG8_BAR
#undef PG8_SCHED
}
}

constexpr int D = 2048, BATCH = 4, SEQ = 4096, MTOK = BATCH * SEQ, DEPTH = 2;
constexpr int NIN = 6160, NPROJ = 6144;
constexpr int C_NAQ = 0, C_NAK = 1024, C_NAV = 2048, C_MLQ = 3072, C_MLK = 3584, C_MLV = 4096, C_MLO = 5120, C_GATES = 6144;
constexpr int NE = 16, CAP = 512, DE = 1024, MR = NE * BATCH * CAP;
constexpr float EPS = 1e-6f;

typedef unsigned short bf16;
typedef float f32x4 __attribute__((ext_vector_type(4)));
typedef unsigned v4u __attribute__((ext_vector_type(4)));
typedef unsigned v2u __attribute__((ext_vector_type(2)));
#define LAS __attribute__((address_space(3)))
typedef short bf16x8v __attribute__((ext_vector_type(8)));
typedef short s16x4 __attribute__((ext_vector_type(4)));
constexpr size_t WS_XB8 = 968 * (size_t)(1u << 20);
constexpr size_t WS_SSQ = 6 * (size_t)(1u << 20) + 512 * 1024;
constexpr size_t WS_RSNA = 7 * (size_t)(1u << 20) + 64 * 1024;
constexpr size_t WS_W16F_OFF = 7 * (1u << 20) + 256 * 1024;

constexpr size_t MiB = 1u << 20;
constexpr size_t WS_CTL = 0;
constexpr size_t WS_RSTD = 1 * MiB;
constexpr size_t WS_GATES = 2 * MiB;
constexpr size_t WS_AFF = 3 * MiB;
constexpr size_t WS_TOK = 4 * MiB;
constexpr size_t WS_GATEV = 4 * MiB + 512 * 1024;
constexpr size_t WS_SEL = 5 * MiB;
constexpr size_t WS_WIN = 8 * MiB;
constexpr size_t WS_WOUT = 56 * MiB;
constexpr size_t WS_WGU = 72 * MiB;
constexpr size_t WS_WD = 328 * MiB;
constexpr size_t WS_XB = 456 * MiB;
constexpr size_t WS_MIX = 520 * MiB;
constexpr size_t WS_P = 584 * MiB;
constexpr size_t WS_NAO = 776 * MiB;
constexpr size_t WS_HF = 840 * MiB;
constexpr size_t WS_ACT = 712 * MiB;
constexpr size_t WS_Y = 776 * MiB;
constexpr size_t WS_END = 1000 * MiB;

__device__ __forceinline__ unsigned f2bf(float f) { unsigned u = __builtin_bit_cast(unsigned, f); return (u + 0x7fffu + ((u >> 16) & 1u)) >> 16; }
__device__ __forceinline__ unsigned pk2(float lo, float hi) { return f2bf(lo) | (f2bf(hi) << 16); }
__device__ __forceinline__ float bf2f(unsigned short b) { return __builtin_bit_cast(float, ((unsigned)b) << 16); }
__device__ __forceinline__ float bflo(unsigned w) { return __builtin_bit_cast(float, w << 16); }
__device__ __forceinline__ float bfhi(unsigned w) { return __builtin_bit_cast(float, w & 0xffff0000u); }
__device__ __forceinline__ float row_ror(float v, int n) { return n == 8 ? __uint_as_float(__builtin_amdgcn_update_dpp(0, __float_as_uint(v), 0x128, 0xf, 0xf, false)) : n == 4 ? __uint_as_float(__builtin_amdgcn_update_dpp(0, __float_as_uint(v), 0x124, 0xf, 0xf, false))
        : n == 2 ? __uint_as_float(__builtin_amdgcn_update_dpp(0, __float_as_uint(v), 0x122, 0xf, 0xf, false)) : __uint_as_float(__builtin_amdgcn_update_dpp(0, __float_as_uint(v), 0x121, 0xf, 0xf, false)); }
__device__ __forceinline__ float row16_sum(float v) { v += row_ror(v, 8); v += row_ror(v, 4); v += row_ror(v, 2); v += row_ror(v, 1); return v; }
__device__ __forceinline__ float row16_max(float v) { v = fmaxf(v, row_ror(v, 8)); v = fmaxf(v, row_ror(v, 4)); v = fmaxf(v, row_ror(v, 2)); v = fmaxf(v, row_ror(v, 1)); return v; }
__device__ __forceinline__ float rows4_sum(float v) {
    auto a = __builtin_amdgcn_permlane16_swap(__float_as_uint(v), __float_as_uint(v), false, false); v = __uint_as_float(a[0]) + __uint_as_float(a[1]);
    auto b = __builtin_amdgcn_permlane32_swap(__float_as_uint(v), __float_as_uint(v), false, false); return __uint_as_float(b[0]) + __uint_as_float(b[1]); }
__device__ __forceinline__ float rows4_max(float v) {
    auto a = __builtin_amdgcn_permlane16_swap(__float_as_uint(v), __float_as_uint(v), false, false); v = fmaxf(__uint_as_float(a[0]), __uint_as_float(a[1]));
    auto b = __builtin_amdgcn_permlane32_swap(__float_as_uint(v), __float_as_uint(v), false, false); return fmaxf(__uint_as_float(b[0]), __uint_as_float(b[1])); }
__device__ __forceinline__ float wave_sum(float v) { return rows4_sum(row16_sum(v)); }
__device__ __forceinline__ float wave_max(float v) { return rows4_max(row16_max(v)); }

struct ConvItem { const float* W; const float* gk; bf16* WT; int ldw, K, k0, n0, dmode, f8; float wmul; };
template <class T> __device__ __forceinline__ T* uni_ptr(T* p) { const unsigned long long v = (unsigned long long)p;
    const unsigned lo = __builtin_amdgcn_readfirstlane((unsigned)v), hi = __builtin_amdgcn_readfirstlane((unsigned)(v >> 32)); return (T*)(((unsigned long long)hi << 32) | lo); }
__device__ __forceinline__ void ti_load(const ConvItem& d, int lane, f32x4 (&wv)[16], f32x4 (&gv)[2]) {
    const int r4 = lane >> 4, c4 = (lane & 15) * 4;
    const float* gp = uni_ptr(d.gk ? d.gk + d.k0 : d.W);
    const unsigned gvo = 32u * (lane & 7);
    asm volatile("global_load_dwordx4 %0, %1, %2" : "=v"(gv[0]) : "v"(gvo), "s"(gp) : "memory");
    asm volatile("global_load_dwordx4 %0, %1, %2 offset:16" : "=v"(gv[1]) : "v"(gvo), "s"(gp) : "memory");
    const unsigned voff = (unsigned)(r4 * d.ldw + c4) * 4u;
#pragma unroll
    for (int i = 0; i < 16; ++i) { const float* p = uni_ptr(d.W + (size_t)(d.k0 + 4 * i) * d.ldw + d.n0); asm volatile("global_load_dwordx4 %0, %1, %2" : "=v"(wv[i]) : "v"(voff), "s"(p) : "memory"); }
}
template <int N> __device__ __forceinline__ void ti_wait(f32x4 (&wv)[16], f32x4 (&gv)[2]) {
    asm volatile("s_waitcnt vmcnt(%18)" : "+v"(wv[0]), "+v"(wv[1]), "+v"(wv[2]), "+v"(wv[3]), "+v"(wv[4]), "+v"(wv[5]), "+v"(wv[6]), "+v"(wv[7]), "+v"(wv[8]), "+v"(wv[9]), "+v"(wv[10]), "+v"(wv[11]),
                 "+v"(wv[12]), "+v"(wv[13]), "+v"(wv[14]), "+v"(wv[15]), "+v"(gv[0]), "+v"(gv[1]) : "n"(N) : "memory");
}
__device__ __forceinline__ unsigned cvt2bf(float lo, float hi) { unsigned r; asm("v_cvt_pk_bf16_f32 %0, %1, %2" : "=v"(r) : "v"(lo), "v"(hi)); return r; }
__device__ __forceinline__ void ti_finish(const ConvItem& d, int lane, const f32x4 (&wv)[16], const f32x4 (&gv)[2], LAS float* scr) {
    const int r4 = lane >> 4, c4 = (lane & 15) * 4;
#pragma unroll
    for (int i = 0; i < 16; ++i) { const int kk = 4 * i + r4; LAS float* p = scr + kk * 65 + c4; p[0] = wv[i][0]; p[1] = wv[i][1]; p[2] = wv[i][2]; p[3] = wv[i][3]; }
    asm volatile("s_waitcnt lgkmcnt(0)" ::: "memory");
    const int c = lane & 7; const float wmul = d.wmul;
    const bool hg = d.gk != nullptr;
    const float m0 = (hg ? gv[0][0] : 1.f) * wmul, m1 = (hg ? gv[0][1] : 1.f) * wmul, m2 = (hg ? gv[0][2] : 1.f) * wmul, m3 = (hg ? gv[0][3] : 1.f) * wmul,
                m4 = (hg ? gv[1][0] : 1.f) * wmul, m5 = (hg ? gv[1][1] : 1.f) * wmul, m6 = (hg ? gv[1][2] : 1.f) * wmul, m7 = (hg ? gv[1][3] : 1.f) * wmul;
    const int es = d.f8 ? 1 : 2;
    const unsigned svo = (unsigned)((lane >> 3) * d.K + 8 * c) * (unsigned)es;
    const int rb0 = d.dmode == 0 ? d.n0 : ((d.n0 >> 4) * 32 + (d.dmode == 2 ? 16 : 0));
    const LAS float* s0 = scr + (8 * c) * 65 + (lane >> 3);
#pragma unroll
    for (int j = 0; j < 8; ++j) { const LAS float* s = s0 + 8 * j;
        const int rb = rb0 + (d.dmode == 0 ? 8 * j : 32 * (j >> 1) + 8 * (j & 1));
        unsigned char* sp = uni_ptr((unsigned char*)d.WT + ((size_t)rb * d.K + d.k0) * es);
        const float y0 = s[0 * 65] * m0, y1 = s[1 * 65] * m1, y2 = s[2 * 65] * m2, y3 = s[3 * 65] * m3, y4 = s[4 * 65] * m4, y5 = s[5 * 65] * m5, y6 = s[6 * 65] * m6, y7 = s[7 * 65] * m7;
        if (d.f8) { v2u o8; int p = __builtin_amdgcn_cvt_pk_fp8_f32(y0, y1, 0, false); p = __builtin_amdgcn_cvt_pk_fp8_f32(y2, y3, p, true); o8.x = (unsigned)p;
            p = __builtin_amdgcn_cvt_pk_fp8_f32(y4, y5, 0, false); p = __builtin_amdgcn_cvt_pk_fp8_f32(y6, y7, p, true); o8.y = (unsigned)p;
            asm volatile("global_store_dwordx2 %0, %1, %2" : : "v"(svo), "v"(o8), "s"(sp) : "memory"); }
        else { v4u o; o.x = cvt2bf(y0, y1); o.y = cvt2bf(y2, y3); o.z = cvt2bf(y4, y5); o.w = cvt2bf(y6, y7);
            asm volatile("global_store_dwordx4 %0, %1, %2" : : "v"(svo), "v"(o), "s"(sp) : "memory"); } }
    asm volatile("s_waitcnt lgkmcnt(0)" ::: "memory");
}
constexpr int CONV_SCR_BYTES = 64 * 65 * 4;
constexpr float Y8_SCALE = 16.0f;
typedef float f32x2 __attribute__((ext_vector_type(2)));
constexpr int NPROJ16 = 5120;
constexpr float W8_SCALE = 64.0f;
struct ConvArgs { const float *w_in, *w_out, *w_gate, *w_up, *w_down, *norm_mix_g, *norm_ffn_g, *na_norm_g; unsigned char* ws; };
constexpr int CI_IN = 32 * 96, CI_OUT = 32 * 32, CI_G = 16 * 32 * 16, CI_D = 16 * 16 * 32, CI_LAYER = CI_IN + CI_OUT + 2 * CI_G + CI_D;
__device__ __forceinline__ ConvItem convert_decode(const ConvArgs& a, int it) {
    ConvItem d; d.f8 = 0; d.wmul = 1.0f; d.gk = nullptr; d.dmode = 0; d.K = D;
    const int l = it / CI_LAYER; int r = it % CI_LAYER;
    if (r < CI_IN) { const int kb = r / 96, nb = r % 96; d.ldw = NIN; d.gk = a.norm_mix_g + l * D; d.k0 = 64 * kb;
        if (64 * nb < NPROJ16) { d.W = a.w_in + (size_t)l * D * NIN; d.WT = (bf16*)(a.ws + WS_WIN) + (size_t)l * NPROJ * D; d.n0 = 64 * nb; }
        else { d.W = a.w_in + (size_t)l * D * NIN + NPROJ16; d.WT = (bf16*)(a.ws + WS_WIN + ((size_t)l * NPROJ + NPROJ16) * D * 2); d.n0 = 64 * nb - NPROJ16; d.f8 = 1; d.wmul = W8_SCALE; }
        return d; }
    r -= CI_IN;
    if (r < CI_OUT) { const int kb = r / 32, nb = r % 32; d.W = a.w_out + (size_t)l * D * D; d.ldw = D; if (64 * kb < 1024) d.gk = a.na_norm_g + l * 1024;
        d.WT = (bf16*)(a.ws + WS_WOUT) + (size_t)l * D * D; d.k0 = 64 * kb; d.n0 = 64 * nb; return d; }
    r -= CI_OUT;
    if (r < 2 * CI_G) { const int up = r >= CI_G; if (up) r -= CI_G; const int e = r / 512, q = r % 512, kb = q / 16, nb = q % 16;
        d.W = (up ? a.w_up : a.w_gate) + ((size_t)l * NE + e) * D * DE; d.ldw = DE; d.gk = a.norm_ffn_g + l * D; d.WT = (bf16*)(a.ws + WS_WGU + ((size_t)l * NE + e) * 2048 * D); d.k0 = 64 * kb; d.n0 = 64 * nb; d.dmode = up ? 2 : 1; d.f8 = 1; d.wmul = W8_SCALE; return d; }
    r -= 2 * CI_G;
    { const int e = r / 512, q = r % 512, kb = q / 32, nb = q % 32; d.W = a.w_down + ((size_t)l * NE + e) * DE * D; d.ldw = D; d.WT = (bf16*)(a.ws + WS_WD + ((size_t)l * NE + e) * D * DE); d.K = DE; d.k0 = 64 * kb; d.n0 = 64 * nb; d.f8 = 1; d.wmul = W8_SCALE; return d; }
}
__device__ __forceinline__ void convert_stream(const ConvArgs& a, int first_, int stride, int end, LAS float* scr, int lane) {
    const int first = __builtin_amdgcn_readfirstlane(first_);
    if (first >= end) return;
    const int n = (end - first + stride - 1) / stride, last = first + (n - 1) * stride;
    f32x4 w0[16], w1[16], g0[2], g1[2]; ConvItem d0 = convert_decode(a, first), d1 = convert_decode(a, min(first + stride, last)); ti_load(d0, lane, w0, g0); ti_load(d1, lane, w1, g1);
    ti_wait<18>(w0, g0); ti_finish(d0, lane, w0, g0, scr);
    d0 = convert_decode(a, min(first + 2 * stride, last)); ti_load(d0, lane, w0, g0);
#pragma unroll 1
    for (int it = first + stride; it <= last; it += 2 * stride) {
        ti_wait<26>(w1, g1); ti_finish(d1, lane, w1, g1, scr);
        d1 = convert_decode(a, min(it + 2 * stride, last)); ti_load(d1, lane, w1, g1);
        ti_wait<26>(w0, g0); ti_finish(d0, lane, w0, g0, scr);
        d0 = convert_decode(a, min(it + 3 * stride, last)); ti_load(d0, lane, w0, g0);
    }
    asm volatile("s_waitcnt vmcnt(0)" ::: "memory");
}
#define XB_TMO      128
#define XB_XCNT(j)  (256  + 64 * (j))
#define XB_XSUB(j)  (1280 + 64 * (j))
#define XB_XGEN(j)  (2304 + 64 * (j))
#define XB_TOP      3328
#define XB_TOPGEN   3392
#define XCD_BAR_WORDS 3456
#define XB_SPIN_CAP (1u << 18)

__device__ __forceinline__ unsigned xb_ld(unsigned* p)              { return __hip_atomic_load(p, __ATOMIC_RELAXED, __HIP_MEMORY_SCOPE_AGENT); }
__device__ __forceinline__ unsigned xb_add(unsigned* p, unsigned v) { return __hip_atomic_fetch_add(p, v, __ATOMIC_RELAXED, __HIP_MEMORY_SCOPE_AGENT); }
__device__ __forceinline__ unsigned xb_xcc_id() { return (unsigned)__builtin_amdgcn_s_getreg((3 << 11) | 20) & 0xFu; }
#define XB_SPIN(cond, bar) do { unsigned _sp = 0; while (cond) { __builtin_amdgcn_s_sleep(1); \
    if ((++_sp & 255u) == 0u) { if (xb_ld(&(bar)[XB_TMO])) break; if (_sp > XB_SPIN_CAP) { atomicAdd(&(bar)[XB_TMO], 1u); break; } } } } while (0)

struct XcdBarrier {
    unsigned* bar; unsigned x;
    volatile LAS unsigned* st;
};

__device__ __forceinline__ XcdBarrier xcd_barrier_post(unsigned* bar, volatile LAS unsigned* st) {
    XcdBarrier b; b.bar = bar; b.x = xb_xcc_id(); b.st = st;
    if (threadIdx.x == 0) (void)xb_add(&bar[XB_XCNT(b.x)], 1u);
    return b;
}
__device__ __forceinline__ void xcd_barrier_complete(unsigned* bar, unsigned x, unsigned& nloc, unsigned& nx) {
    const unsigned G = gridDim.x * gridDim.y * gridDim.z;
    unsigned sum, cnt, mine, sp = 0u;
    for (;;) {
        sum = 0u; cnt = 0u; mine = 0u;
#pragma unroll
        for (unsigned j = 0; j < 16; ++j) { const unsigned c = xb_ld(&bar[XB_XCNT(j)]); sum += c; cnt += (c > 0u) ? 1u : 0u; mine = (j == x) ? c : mine; }
        if (sum == G) break;
        __builtin_amdgcn_s_sleep(1);
        if ((++sp & 255u) == 0u) { if (xb_ld(&bar[XB_TMO])) break; if (sp > XB_SPIN_CAP) { atomicAdd(&bar[XB_TMO], 1u); break; } }
    }
    nloc = mine > 0u ? mine : 1u; nx = cnt > 0u ? cnt : 1u;
}

__device__ __forceinline__ void xcd_barrier(const XcdBarrier& b) {
    asm volatile("s_waitcnt vmcnt(0)" ::: "memory");
    __syncthreads();
    if (threadIdx.x == 0) {
        unsigned* bar = b.bar;
        __builtin_amdgcn_s_waitcnt(0);
        unsigned nloc = b.st[0], nx = b.st[1];
        if (nloc == 0u) { xcd_barrier_complete(bar, b.x, nloc, nx); b.st[0] = nloc; b.st[1] = nx; }
        const unsigned old = xb_add(&bar[XB_XSUB(b.x)], 1u);
        const unsigned gen = old / nloc;
        if (old + 1u == (gen + 1u) * nloc) {
            __builtin_amdgcn_fence(__ATOMIC_RELEASE, "agent");
            asm volatile("s_waitcnt vmcnt(0)" ::: "memory");
            const unsigned og = xb_add(&bar[XB_TOP], 1u);
            const unsigned tg = og / nx;
            if (og + 1u == (tg + 1u) * nx) xb_add(&bar[XB_TOPGEN], 1u);
            else XB_SPIN(xb_ld(&bar[XB_TOPGEN]) == tg, bar);
            __builtin_amdgcn_fence(__ATOMIC_ACQUIRE, "agent");
            xb_add(&bar[XB_XGEN(b.x)], 1u);
            asm volatile("s_waitcnt vmcnt(0)" ::: "memory");
        } else {
            XB_SPIN(xb_ld(&bar[XB_XGEN(b.x)]) == gen, bar);
            __builtin_amdgcn_fence(__ATOMIC_ACQUIRE, "agent");
            asm volatile("s_waitcnt vmcnt(0)" ::: "memory");
        }
    }
    __syncthreads();
}

struct RowArgs { const float* src32; const bf16* srcb; const int* sel; const unsigned char* Y; bf16* XB; unsigned char* XB8; float* RSTD; const float* g; const bf16* W16F; const float* bias; float* GATES; float* AFF; float* out; int mode; int wrxb; };
__device__ __forceinline__ void rowpass_finish(const RowArgs& a, int row, int rr, int s0, int s1, f32x4 (&v)[8], int lane) {
    const int b = row / SEQ;
    if (a.sel) {
        const int sw = rr < 4 ? s0 : s1;
        { int yw[16][8]; int cc[16];
#pragma unroll
            for (int k = 0; k < 16; ++k) { const int e = k; cc[k] = __builtin_amdgcn_readlane(sw, ((rr & 3) << 4) + e);
                if (cc[k] >= 0) { const unsigned char* y = a.Y + (size_t)(e * 2048 + b * 512 + cc[k]) * D + 4 * lane;
#pragma unroll
                    for (int j = 0; j < 8; ++j) yw[k][j] = *(const int*)(y + 256 * j); } }
#pragma unroll
            for (int k = 0; k < 16; ++k) if (cc[k] >= 0) {
#pragma unroll
                for (int j = 0; j < 8; ++j) { const f32x2 lo = __builtin_amdgcn_cvt_pk_f32_fp8(yw[k][j], false), hi = __builtin_amdgcn_cvt_pk_f32_fp8(yw[k][j], true);
                    v[j][0] += lo[0] * (1.0f / Y8_SCALE); v[j][1] += lo[1] * (1.0f / Y8_SCALE); v[j][2] += hi[0] * (1.0f / Y8_SCALE); v[j][3] += hi[1] * (1.0f / Y8_SCALE); } } }
    }
    float ss = 0.f;
#pragma unroll
    for (int j = 0; j < 8; ++j) ss += (v[j][0] * v[j][0] + v[j][1] * v[j][1]) + (v[j][2] * v[j][2] + v[j][3] * v[j][3]);
    ss = wave_sum(ss);
    const float rstd = 1.0f / sqrtf(ss * (1.0f / D) + EPS);
    if (a.mode == 2) {
#pragma unroll
        for (int j = 0; j < 8; ++j) { const f32x4 g = *(const f32x4*)(a.g + 4 * lane + 256 * j); *(f32x4*)(a.out + (size_t)row * D + 4 * lane + 256 * j) = v[j] * rstd * g; }
        return;
    }
    if (a.wrxb) {
#pragma unroll
        for (int j = 0; j < 8; ++j) { v2u w; w.x = pk2(v[j][0], v[j][1]); w.y = pk2(v[j][2], v[j][3]); *(v2u*)(a.XB + (size_t)row * D + 4 * lane + 256 * j) = w; } }
    if (a.XB8) {
#pragma unroll
        for (int j = 0; j < 8; ++j) *(unsigned*)(a.XB8 + (size_t)row * D + 4 * lane + 256 * j) = pg8::pk4_fp8(v[j][0], v[j][1], v[j][2], v[j][3]); }
    if (lane == 0) a.RSTD[row] = rstd;
}
template <bool SRC32> __device__ __forceinline__ void rowpass_group(const RowArgs& a, int grp, int lane_) {
    int lane = lane_; asm volatile("" : "+v"(lane));
    int s0 = -1, s1 = -1; if (a.sel) { s0 = a.sel[grp * 128 + lane]; s1 = a.sel[grp * 128 + 64 + lane]; }
    f32x4 v[8];
    if constexpr (SRC32) {
        f32x4 vn[8];
#pragma unroll
        for (int j = 0; j < 8; ++j) v[j] = *(const f32x4*)(a.src32 + (size_t)(8 * grp) * D + 4 * lane + 256 * j);
#pragma unroll 1
        for (int rr = 0; rr < 8; ++rr) { const int row = 8 * grp + rr;
            if (rr < 7) {
#pragma unroll
                for (int j = 0; j < 8; ++j) vn[j] = *(const f32x4*)(a.src32 + (size_t)(row + 1) * D + 4 * lane + 256 * j); }
            rowpass_finish(a, row, rr, s0, s1, v, lane);
#pragma unroll
            for (int j = 0; j < 8; ++j) v[j] = vn[j]; }
    } else if (!a.sel) {
        v2u w[8][8];
#pragma unroll
        for (int rr = 0; rr < 8; ++rr)
#pragma unroll
            for (int j = 0; j < 8; ++j) w[rr][j] = *(const v2u*)(a.srcb + (size_t)(8 * grp + rr) * D + 4 * lane + 256 * j);
#pragma unroll
        for (int rr = 0; rr < 8; ++rr) {
#pragma unroll
            for (int j = 0; j < 8; ++j) v[j] = (f32x4){bflo(w[rr][j].x), bfhi(w[rr][j].x), bflo(w[rr][j].y), bfhi(w[rr][j].y)};
            rowpass_finish(a, 8 * grp + rr, rr, s0, s1, v, lane); }
    } else {
        v2u w[8], wn[8];
#pragma unroll
        for (int j = 0; j < 8; ++j) w[j] = *(const v2u*)(a.srcb + (size_t)(8 * grp) * D + 4 * lane + 256 * j);
#pragma unroll 1
        for (int rr = 0; rr < 8; ++rr) { const int row = 8 * grp + rr;
            if (rr < 7) {
#pragma unroll
                for (int j = 0; j < 8; ++j) wn[j] = *(const v2u*)(a.srcb + (size_t)(row + 1) * D + 4 * lane + 256 * j); }
#pragma unroll
            for (int j = 0; j < 8; ++j) v[j] = (f32x4){bflo(w[j].x), bfhi(w[j].x), bflo(w[j].y), bfhi(w[j].y)};
            rowpass_finish(a, row, rr, s0, s1, v, lane);
#pragma unroll
            for (int j = 0; j < 8; ++j) w[j] = wn[j]; }
    }
    if (a.mode == 2) return;
    asm volatile("s_waitcnt vmcnt(0)" ::: "memory");
    const int g = lane >> 4, lc = lane & 15;
    f32x4 acc = (f32x4){0.f, 0.f, 0.f, 0.f};
    const bf16* xr = a.XB + (size_t)(8 * grp + (lc & 7)) * D + 8 * g; const bf16* wf = a.W16F + lane * 8;
    { bf16x8v fa[2][8], fb[2][8]; const bf16x8v zero8 = (bf16x8v){0, 0, 0, 0, 0, 0, 0, 0};
#pragma unroll
      for (int s = 0; s < 8; ++s) { fa[0][s] = *(const bf16x8v*)(xr + 32 * s); fb[0][s] = *(const bf16x8v*)(wf + s * 512); }
#pragma unroll
      for (int q = 0; q < 8; ++q) {
          if (q < 7) {
#pragma unroll
              for (int s = 0; s < 8; ++s) { fa[(q + 1) & 1][s] = *(const bf16x8v*)(xr + 32 * (8 * (q + 1) + s)); fb[(q + 1) & 1][s] = *(const bf16x8v*)(wf + (8 * (q + 1) + s) * 512); } }
#pragma unroll
          for (int s = 0; s < 8; ++s) acc = __builtin_amdgcn_mfma_f32_16x16x32_bf16(lc >= 8 ? zero8 : fa[q & 1][s], fb[q & 1][s], acc, 0, 0, 0); } }
    float rs[4];
#pragma unroll
    for (int r = 0; r < 4; ++r) rs[r] = a.RSTD[8 * grp + 4 * (g & 1) + r];
    if (a.mode == 0) { const float bs = a.bias[lc];
#pragma unroll
        for (int r = 0; r < 4; ++r) { const float rstd = rs[r]; if (g < 2) a.GATES[(size_t)(8 * grp + 4 * g + r) * 16 + lc] = acc[r] * rstd + bs; } }
    else {
#pragma unroll
        for (int r = 0; r < 4; ++r) { const float rstd = rs[r]; const float lg = acc[r] * rstd; float mx = lg;
#pragma unroll
            for (int o = 1; o < 16; o <<= 1) mx = fmaxf(mx, __shfl_xor(mx, o));
            const float p = __expf(lg - mx); float sum = p;
#pragma unroll
            for (int o = 1; o < 16; o <<= 1) sum += __shfl_xor(sum, o);
            const int row = 8 * grp + 4 * g + r; if (g < 2) a.AFF[((size_t)(row / SEQ) * NE + lc) * SEQ + (row % SEQ)] = p / sum; } }
}
__device__ __forceinline__ void w16f_item(const float* W, int ldw, const float* gk, bf16* WF, int s, int lane) {
    const int g = lane >> 4, lc = lane & 15; float v[8];
#pragma unroll
    for (int i = 0; i < 8; ++i) { const int k = 32 * s + 8 * g + i; v[i] = W[(size_t)k * ldw + lc] * gk[k]; }
    v4u o; o.x = pk2(v[0], v[1]); o.y = pk2(v[2], v[3]); o.z = pk2(v[4], v[5]); o.w = pk2(v[6], v[7]);
    *(v4u*)(WF + (size_t)(s * 64 + lane) * 8) = o;
}

__device__ __forceinline__ void na_norm_item(const bf16* NAO, const float* g, bf16* MIX, int t, int lane) {
    f32x4 v[4]; float ss = 0.f;
#pragma unroll
    for (int j = 0; j < 4; ++j) { const v2u w = *(const v2u*)(NAO + (size_t)t * 1024 + 4 * lane + 256 * j); v[j] = (f32x4){bflo(w.x), bfhi(w.x), bflo(w.y), bfhi(w.y)}; ss += (v[j][0] * v[j][0] + v[j][1] * v[j][1]) + (v[j][2] * v[j][2] + v[j][3] * v[j][3]); }
    const float rstd = 1.0f / sqrtf(wave_sum(ss) * (1.0f / 1024.0f) + EPS);
#pragma unroll
    for (int j = 0; j < 4; ++j) { const f32x4 gg = *(const f32x4*)(g + 4 * lane + 256 * j); const f32x4 o = v[j] * rstd * gg; v2u w; w.x = pk2(o[0], o[1]); w.y = pk2(o[2], o[3]);
        *(v2u*)(MIX + (size_t)t * D + 4 * lane + 256 * j) = w; }
}

__device__ __forceinline__ int block_sum_512(int v, LAS int* red, int wave, int lane) {
#pragma unroll
    for (int o = 1; o < 64; o <<= 1) v += __shfl_xor(v, o);
    __syncthreads();
    if (lane == 0) red[wave] = v;
    __syncthreads();
    int s = 0;
#pragma unroll
    for (int w = 0; w < 8; ++w) s += red[w];
    return s;
}
__device__ __forceinline__ int block_excl_scan_512(int v, LAS int* red, int wave, int lane) {
    int inc = v;
#pragma unroll
    for (int o = 1; o < 64; o <<= 1) { const int t = __shfl_up(inc, o); if (lane >= o) inc += t; }
    __syncthreads();
    if (lane == 63) red[wave] = inc;
    __syncthreads();
    int base = 0;
#pragma unroll
    for (int w = 0; w < 8; ++w) base += (w < wave) ? red[w] : 0;
    return base + inc - v;
}
__device__ __forceinline__ void topk_unit(int be, const float* AFF, int* TOK, float* GATEV, int* SEL, LAS int* red) {
    int tid_ = threadIdx.x; asm volatile("" : "+v"(tid_)); const int tid = tid_, lane = tid & 63, wave = tid >> 6;
    const int b = be >> 4, e = be & 15;
    const float* a = AFF + (size_t)be * SEQ + tid * 8;
    const f32x4 a0 = *(const f32x4*)a, a1 = *(const f32x4*)(a + 4);
    unsigned key[8] = {__float_as_uint(a0.x), __float_as_uint(a0.y), __float_as_uint(a0.z), __float_as_uint(a0.w),
                       __float_as_uint(a1.x), __float_as_uint(a1.y), __float_as_uint(a1.z), __float_as_uint(a1.w)};
    LAS int* hist = red + 16;
    unsigned T = 0u; int need = CAP;
#pragma unroll 1
    for (int pass = 0; pass < 4; ++pass) { const int shift = 24 - 8 * pass; const unsigned mhi = pass == 0 ? 0u : (0xFFFFFFFFu << (shift + 8));
        __syncthreads();
        if (tid < 256) hist[tid] = 0;
        __syncthreads();
#pragma unroll
        for (int i = 0; i < 8; ++i) if ((key[i] & mhi) == T) (void)__hip_atomic_fetch_add(&hist[(key[i] >> shift) & 255u], 1, __ATOMIC_RELAXED, __HIP_MEMORY_SCOPE_WORKGROUP);
        __syncthreads();
        if (wave == 0) { const int c0 = hist[4 * lane], c1 = hist[4 * lane + 1], c2 = hist[4 * lane + 2], c3 = hist[4 * lane + 3]; const int t = c0 + c1 + c2 + c3; int inc = t;
#pragma unroll
            for (int o = 1; o < 64; o <<= 1) { const int v = __shfl_down(inc, o); if (lane + o < 64) inc += v; }
            const int ab3 = inc - t, ab2 = ab3 + c3, ab1 = ab2 + c2, ab0 = ab1 + c1;
            if (ab3 < need && need <= ab3 + c3) { red[8] = 4 * lane + 3; red[9] = ab3; }
            if (ab2 < need && need <= ab2 + c2) { red[8] = 4 * lane + 2; red[9] = ab2; }
            if (ab1 < need && need <= ab1 + c1) { red[8] = 4 * lane + 1; red[9] = ab1; }
            if (ab0 < need && need <= ab0 + c0) { red[8] = 4 * lane + 0; red[9] = ab0; } }
        __syncthreads();
        T |= (unsigned)red[8] << shift; need -= red[9]; }
    int ceq = 0;
#pragma unroll
    for (int i = 0; i < 8; ++i) ceq += key[i] == T ? 1 : 0;
    const int need_eq = need;
    int eqrank = block_excl_scan_512(ceq, red, wave, lane);
    int selm = 0, csel = 0;
#pragma unroll
    for (int i = 0; i < 8; ++i) { bool sel = key[i] > T; if (key[i] == T) { sel = eqrank < need_eq; ++eqrank; } if (sel) { selm |= 1 << i; ++csel; } }
    int slot = block_excl_scan_512(csel, red, wave, lane);
#pragma unroll
    for (int i = 0; i < 8; ++i) { const int sidx = tid * 8 + i; const int tok = b * SEQ + sidx;
        if (selm & (1 << i)) { const int R = e * 2048 + b * 512 + slot; TOK[R] = tok; GATEV[R] = __uint_as_float(key[i]); SEL[tok * 16 + e] = slot; ++slot; }
        else SEL[tok * 16 + e] = -1; }
    __syncthreads();
}

typedef short bf16x8v __attribute__((ext_vector_type(8)));
typedef short s16x4 __attribute__((ext_vector_type(4)));
constexpr int ML_L = 128, ML_NC = SEQ / ML_L;
constexpr int KP = 272, VP = 528;
constexpr int ML_T0 = 0, ML_T1 = 128 * KP, ML_V = 2 * 128 * KP;
constexpr int ML_AR = ML_V + 128 * VP;
constexpr int ML_END = ML_AR + 24 * 512;
static_assert(ML_AR % 16 == 0, "LDS map");
constexpr size_t WS_UC = WS_HF;
constexpr size_t WS_NU = 6 * MiB;
constexpr size_t WS_SC = 7 * MiB;

__device__ __forceinline__ s16x4 lds_tr(LAS unsigned char* p) { return __builtin_amdgcn_ds_read_tr16_b64_v4i16((LAS s16x4*)p); }
__device__ __forceinline__ bf16x8v frag_tr(LAS unsigned char* tile, int pitch, int k0, int n0, int lane) {
    const int g = lane >> 4, q = (lane & 15) >> 2, p = lane & 3;
    LAS unsigned char* a = tile + (k0 + 8 * g + q) * pitch + (n0 + 4 * p) * 2;
    const s16x4 lo = lds_tr(a), hi = lds_tr(a + 4 * pitch);
    return (bf16x8v){lo[0], lo[1], lo[2], lo[3], hi[0], hi[1], hi[2], hi[3]};
}
__device__ __forceinline__ bf16x8v frag_row(LAS unsigned char* tile, int pitch, int m0, int k0, int lane) {
    return *(LAS bf16x8v*)(tile + (m0 + (lane & 15)) * pitch + (k0 + 8 * (lane >> 4)) * 2);
}
__device__ __forceinline__ float log_sigmoid_f(float f) { return fminf(f, 0.f) - log1pf(__expf(-fabsf(f))); }
__device__ __forceinline__ float shfl_up_f(float v, int o, int lane, float ident) { const float t = __shfl_up(v, o); return lane >= o ? t : ident; }

__device__ __forceinline__ void chunk_gates(const float* GATES, int t0, int h, int dir, int lane, int& s0, int& s1, float& i0, float& i1, float& b0, float& b1, float& btot) {
    const int p0 = 2 * lane, p1 = p0 + 1; s0 = dir ? 127 - p0 : p0; s1 = dir ? 127 - p1 : p1;
    const int icol = dir * 8 + h, fcol = icol + 4;
    const float* gp = GATES + (size_t)t0 * 16;
    const float f0 = log_sigmoid_f(gp[s0 * 16 + fcol]), f1 = log_sigmoid_f(gp[s1 * 16 + fcol]);
    i0 = gp[s0 * 16 + icol]; i1 = gp[s1 * 16 + icol];
    const float s = f0 + f1; float inc = s;
#pragma unroll
    for (int o = 1; o < 64; o <<= 1) inc += shfl_up_f(inc, o, lane, 0.f);
    const float excl = inc - s; b0 = excl + f0; b1 = excl + s; btot = __shfl(inc, 63);
}


__device__ __forceinline__ void conv_chunk4(const bf16* P, const float* cw, const float* cb, int b, int sq0, int chan0, float (&o)[4][8]) {
    const bf16* pc = P + ((size_t)b * SEQ + sq0) * NPROJ + C_MLQ + chan0;
    v4u w[8];
#pragma unroll
    for (int j = 0; j < 8; ++j) { const int ss = sq0 + j - 2; w[j] = (ss >= 0 && ss < SEQ) ? *(const v4u*)(pc + (ptrdiff_t)(j - 2) * NPROJ) : (v4u){0u, 0u, 0u, 0u}; }
    const f32x4 b0 = *(const f32x4*)(cb + chan0), b1 = *(const f32x4*)(cb + chan0 + 4);
#pragma unroll
    for (int t = 0; t < 4; ++t) { o[t][0] = b0[0]; o[t][1] = b0[1]; o[t][2] = b0[2]; o[t][3] = b0[3]; o[t][4] = b1[0]; o[t][5] = b1[1]; o[t][6] = b1[2]; o[t][7] = b1[3]; }
#pragma unroll
    for (int j = 0; j < 5; ++j) { const f32x4 c0 = *(const f32x4*)(cw + j * 1024 + chan0), c1 = *(const f32x4*)(cw + j * 1024 + chan0 + 4);
#pragma unroll
        for (int t = 0; t < 4; ++t) { const v4u x = w[t + j];
            o[t][0] += c0[0] * bflo(x.x); o[t][1] += c0[1] * bfhi(x.x); o[t][2] += c0[2] * bflo(x.y); o[t][3] += c0[3] * bfhi(x.y);
            o[t][4] += c1[0] * bflo(x.z); o[t][5] += c1[1] * bfhi(x.z); o[t][6] += c1[2] * bflo(x.w); o[t][7] += c1[3] * bfhi(x.w); } }
#pragma unroll
    for (int t = 0; t < 4; ++t)
#pragma unroll
        for (int i = 0; i < 8; ++i) o[t][i] = o[t][i] * __builtin_amdgcn_rcpf(1.0f + __expf(-o[t][i]));
}

__device__ __forceinline__ void mlstm_m1_unit(int u, const float* cw, const float* cb, const bf16* P, const float* GATES, bf16* UC, float* NU, float* SC, LAS unsigned char* lds, int tid_, int wave) {
    int tid = tid_; asm volatile("" : "+v"(tid)); const int lane = tid & 63;
    const int c = u & 31, h = (u >> 5) & 3, b = u >> 7; const int t0 = b * SEQ + c * ML_L;
    LAS float* WK = (LAS float*)(lds + ML_AR);
    LAS float* NRED = WK + 256;
    __syncthreads();
    if (wave < 2) { const int dir = wave; int s0, s1; float i0, i1, b0, b1, btot;
        chunk_gates(GATES, t0, h, dir, lane, s0, s1, i0, i1, b0, b1, btot);
        const float g0 = btot - b0 + i0, g1 = btot - b1 + i1; const float mloc = wave_max(fmaxf(g0, g1));
        WK[dir * 128 + s0] = __expf(g0 - mloc); WK[dir * 128 + s1] = __expf(g1 - mloc);
        if (lane == 0) { float* sc = SC + (size_t)((((b * 4 + h) * 2 + dir) * 32) + c) * 4; sc[0] = btot; sc[1] = mloc; } }
#pragma unroll
    for (int i = 0; i < 8; ++i) { const int id = tid + 512 * i, s = id >> 5, ch = id & 31;
        *(LAS v4u*)(lds + ML_V + s * VP + ch * 16) = *(const v4u*)(P + (size_t)(t0 + s) * NPROJ + C_MLV + h * 256 + ch * 8); }
    float k4[4][8]; conv_chunk4(P, cw, cb, b, c * ML_L + 4 * (tid >> 4), 512 + h * 128 + (tid & 15) * 8, k4);
    __syncthreads();
    { float nf[8], nb[8];
#pragma unroll
      for (int j = 0; j < 8; ++j) { nf[j] = 0.f; nb[j] = 0.f; }
#pragma unroll
      for (int i = 0; i < 4; ++i) { const int s = 4 * (tid >> 4) + i, ch = tid & 15; const float (&k)[8] = k4[i];
        const float wf = WK[s], wb = WK[128 + s];
        v4u of, ob; of.x = pk2(k[0] * wf, k[1] * wf); of.y = pk2(k[2] * wf, k[3] * wf); of.z = pk2(k[4] * wf, k[5] * wf); of.w = pk2(k[6] * wf, k[7] * wf);
        ob.x = pk2(k[0] * wb, k[1] * wb); ob.y = pk2(k[2] * wb, k[3] * wb); ob.z = pk2(k[4] * wb, k[5] * wb); ob.w = pk2(k[6] * wb, k[7] * wb);
        *(LAS v4u*)(lds + ML_T0 + s * KP + ch * 16) = of; *(LAS v4u*)(lds + ML_T1 + s * KP + ch * 16) = ob;
#pragma unroll
        for (int j = 0; j < 8; ++j) { nf[j] += k[j] * wf; nb[j] += k[j] * wb; } }
#pragma unroll
      for (int j = 0; j < 8; ++j) { nf[j] += __shfl_xor(nf[j], 16); nf[j] += __shfl_xor(nf[j], 32); nb[j] += __shfl_xor(nb[j], 16); nb[j] += __shfl_xor(nb[j], 32); }
      if ((lane >> 4) == 0) {
#pragma unroll
          for (int j = 0; j < 8; ++j) { NRED[wave * 256 + (lane & 15) * 8 + j] = nf[j]; NRED[wave * 256 + 128 + (lane & 15) * 8 + j] = nb[j]; } } }
    __syncthreads();
    if (tid < 256) { const int dir = tid >> 7, d = tid & 127; float sum = 0.f;
#pragma unroll
        for (int w = 0; w < 8; ++w) sum += NRED[w * 256 + tid];
        NU[(size_t)((((b * 4 + h) * 2 + dir) * 32) + c) * 128 + d] = sum; }
    const int g = lane >> 4;
#pragma unroll 1
    for (int dir = 0; dir < 2; ++dir) {
        LAS unsigned char* Kt = lds + (dir ? ML_T1 : ML_T0);
        f32x4 acc[8][2];
#pragma unroll
        for (int mb = 0; mb < 8; ++mb) { acc[mb][0] = (f32x4){0.f, 0.f, 0.f, 0.f}; acc[mb][1] = (f32x4){0.f, 0.f, 0.f, 0.f}; }
#pragma unroll
        for (int ks = 0; ks < 4; ++ks) {
            const bf16x8v b0 = frag_tr(lds + ML_V, VP, 32 * ks, 32 * wave, lane), b1 = frag_tr(lds + ML_V, VP, 32 * ks, 32 * wave + 16, lane);
#pragma unroll
            for (int mb = 0; mb < 8; ++mb) { const bf16x8v a = frag_tr(Kt, KP, 32 * ks, 16 * mb, lane);
                acc[mb][0] = __builtin_amdgcn_mfma_f32_16x16x32_bf16(a, b0, acc[mb][0], 0, 0, 0); acc[mb][1] = __builtin_amdgcn_mfma_f32_16x16x32_bf16(a, b1, acc[mb][1], 0, 0, 0); } }
        bf16* uc = UC + (size_t)((((b * 4 + h) * 2 + dir) * 32) + c) * 32768;
#pragma unroll
        for (int mb = 0; mb < 8; ++mb)
#pragma unroll
            for (int nb = 0; nb < 2; ++nb) { const int e = 32 * wave + 16 * nb + (lane & 15), d0 = 16 * mb + 4 * g; v2u w; w.x = pk2(acc[mb][nb][0], acc[mb][nb][1]); w.y = pk2(acc[mb][nb][2], acc[mb][nb][3]);
                *(v2u*)(uc + e * 128 + d0) = w; }
    }
}

__device__ __forceinline__ void mlstm_m2(bf16* UC, float* NU, float* SC, int gtid, int nthreads) {
    for (int vid = gtid; vid < 32 * 4096; vid += nthreads) { const int chain = vid >> 12, within = vid & 4095, dir = chain & 1;
        float st[8]; float m = 0.f;
#pragma unroll
        for (int i = 0; i < 8; ++i) st[i] = 0.f;
#pragma unroll 1
        for (int s0 = 0; s0 < ML_NC; s0 += 8) {
            v4u uw[8]; float bt[8], ml[8];
#pragma unroll
            for (int k = 0; k < 8; ++k) { const int c = dir ? ML_NC - 1 - (s0 + k) : s0 + k; const float* sc = SC + (size_t)(chain * 32 + c) * 4; bt[k] = sc[0]; ml[k] = sc[1];
                uw[k] = *(const v4u*)(UC + ((size_t)(chain * 32 + c) * 4096 + within) * 8); }
#pragma unroll
            for (int k = 0; k < 8; ++k) { const int c = dir ? ML_NC - 1 - (s0 + k) : s0 + k;
                v4u cw; cw.x = pk2(st[0], st[1]); cw.y = pk2(st[2], st[3]); cw.z = pk2(st[4], st[5]); cw.w = pk2(st[6], st[7]);
                *(v4u*)(UC + ((size_t)(chain * 32 + c) * 4096 + within) * 8) = cw;
                if (within == 0) SC[(size_t)(chain * 32 + c) * 4 + 2] = m;
                const float mn = fmaxf(bt[k] + m, ml[k]), dC = __expf(bt[k] + m - mn), dU = __expf(ml[k] - mn);
                const float uu[8] = {bflo(uw[k].x), bfhi(uw[k].x), bflo(uw[k].y), bfhi(uw[k].y), bflo(uw[k].z), bfhi(uw[k].z), bflo(uw[k].w), bfhi(uw[k].w)};
#pragma unroll
                for (int i = 0; i < 8; ++i) st[i] = dC * st[i] + dU * uu[i];
                m = mn; } } }
    for (int nid = gtid; nid < 32 * 128; nid += nthreads) { const int chain = nid >> 7, d = nid & 127, dir = chain & 1; float st = 0.f, m = 0.f;
#pragma unroll 1
        for (int s0 = 0; s0 < ML_NC; s0 += 8) { float uu[8], bt[8], ml[8];
#pragma unroll
            for (int k = 0; k < 8; ++k) { const int c = dir ? ML_NC - 1 - (s0 + k) : s0 + k; const float* sc = SC + (size_t)(chain * 32 + c) * 4; bt[k] = sc[0]; ml[k] = sc[1]; uu[k] = NU[(size_t)(chain * 32 + c) * 128 + d]; }
#pragma unroll
            for (int k = 0; k < 8; ++k) { const int c = dir ? ML_NC - 1 - (s0 + k) : s0 + k; NU[(size_t)(chain * 32 + c) * 128 + d] = st;
                const float mn = fmaxf(bt[k] + m, ml[k]); st = __expf(bt[k] + m - mn) * st + __expf(ml[k] - mn) * uu[k]; m = mn; } } }
}

__device__ __forceinline__ void mlstm_m3_unit(int u, const float* cw, const float* cb, const bf16* P, const float* GATES, const bf16* UC, const float* NU, const float* SC, const float* mlg, const float* RSNA, bf16* MIX, LAS unsigned char* lds, int tid_, int wave) {
    int tid = tid_; asm volatile("" : "+v"(tid)); const int lane = tid & 63;
    const int c = u & 31, h = (u >> 5) & 3, b = u >> 7; const int t0 = b * SEQ + c * ML_L;
    LAS float* AR = (LAS float*)(lds + ML_AR);
    LAS float* CS = AR; LAS float* RR = AR + 256; LAS float* INTER = AR + 512; LAS float* EM = AR + 768; LAS float* ALPHA = AR + 1024; LAS float* SS = AR + 1280;
    const int g = lane >> 4, lc = lane & 15;
    const int chain0 = (b * 4 + h) * 2;
    __syncthreads();
    if (wave < 2) { const int dir = wave; int s0, s1; float i0, i1, b0, b1, btot;
        chunk_gates(GATES, t0, h, dir, lane, s0, s1, i0, i1, b0, b1, btot);
        const float cs0 = i0 - b0, cs1 = i1 - b1;
        float pmx = fmaxf(cs0, cs1);
#pragma unroll
        for (int o = 1; o < 64; o <<= 1) pmx = fmaxf(pmx, shfl_up_f(pmx, o, lane, -3.0e38f));
        const float ex = shfl_up_f(pmx, 1, lane, -3.0e38f);
        const float pm0 = fmaxf(ex, cs0), pm1 = fmaxf(pm0, cs1);
        const float m_in = SC[(size_t)((chain0 + dir) * 32 + c) * 4 + 2];
        const float M0 = b0 + fmaxf(m_in, pm0), M1 = b1 + fmaxf(m_in, pm1);
        CS[dir * 128 + s0] = cs0; CS[dir * 128 + s1] = cs1; RR[dir * 128 + s0] = b0 - M0; RR[dir * 128 + s1] = b1 - M1;
        INTER[dir * 128 + s0] = __expf(b0 + m_in - M0); INTER[dir * 128 + s1] = __expf(b1 + m_in - M1); EM[dir * 128 + s0] = __expf(-M0); EM[dir * 128 + s1] = __expf(-M1); }
    { const int s0 = 4 * (tid >> 4), ch = tid & 15; float x4[4][8];
      conv_chunk4(P, cw, cb, b, c * ML_L + s0, h * 128 + ch * 8, x4);
      const float qs = 0.08838834764831845f;
#pragma unroll
      for (int i = 0; i < 4; ++i) { v4u oq; oq.x = pk2(x4[i][0] * qs, x4[i][1] * qs); oq.y = pk2(x4[i][2] * qs, x4[i][3] * qs); oq.z = pk2(x4[i][4] * qs, x4[i][5] * qs); oq.w = pk2(x4[i][6] * qs, x4[i][7] * qs);
          *(LAS v4u*)(lds + ML_T0 + (s0 + i) * KP + ch * 16) = oq; }
      conv_chunk4(P, cw, cb, b, c * ML_L + s0, 512 + h * 128 + ch * 8, x4);
#pragma unroll
      for (int i = 0; i < 4; ++i) { v4u ok; ok.x = pk2(x4[i][0], x4[i][1]); ok.y = pk2(x4[i][2], x4[i][3]); ok.z = pk2(x4[i][4], x4[i][5]); ok.w = pk2(x4[i][6], x4[i][7]);
          *(LAS v4u*)(lds + ML_T1 + (s0 + i) * KP + ch * 16) = ok; } }
#pragma unroll
    for (int i = 0; i < 8; ++i) { const int id = tid + 512 * i, s = id >> 5, ch = id & 31;
        *(LAS v4u*)(lds + ML_V + s * VP + ch * 16) = *(const v4u*)(P + (size_t)(t0 + s) * NPROJ + C_MLV + h * 256 + ch * 8); }
    __syncthreads();
    f32x4 S[8], qn = (f32x4){0.f, 0.f, 0.f, 0.f};
#pragma unroll
    for (int nb = 0; nb < 8; ++nb) S[nb] = (f32x4){0.f, 0.f, 0.f, 0.f};
#pragma unroll
    for (int ks = 0; ks < 4; ++ks) { const bf16x8v a = frag_row(lds + ML_T0, KP, 16 * wave, 32 * ks, lane);
        bf16x8v nf = (bf16x8v){0, 0, 0, 0, 0, 0, 0, 0};
        if (lc < 2) { const float* np = NU + (size_t)((chain0 + lc) * 32 + c) * 128 + 32 * ks + 8 * g; const f32x4 n0 = *(const f32x4*)np, n1 = *(const f32x4*)(np + 4);
            const unsigned w0 = pk2(n0[0], n0[1]), w1 = pk2(n0[2], n0[3]), w2 = pk2(n1[0], n1[1]), w3 = pk2(n1[2], n1[3]);
            nf = (bf16x8v){(short)(w0 & 0xffff), (short)(w0 >> 16), (short)(w1 & 0xffff), (short)(w1 >> 16), (short)(w2 & 0xffff), (short)(w2 >> 16), (short)(w3 & 0xffff), (short)(w3 >> 16)}; }
        qn = __builtin_amdgcn_mfma_f32_16x16x32_bf16(a, nf, qn, 0, 0, 0);
#pragma unroll
        for (int nb = 0; nb < 8; ++nb) { const bf16x8v kb = frag_row(lds + ML_T1, KP, 16 * nb, 32 * ks, lane); S[nb] = __builtin_amdgcn_mfma_f32_16x16x32_bf16(a, kb, S[nb], 0, 0, 0); } }
    float csf[8], csb[8];
#pragma unroll
    for (int nb = 0; nb < 8; ++nb) { csf[nb] = CS[16 * nb + lc]; csb[nb] = CS[128 + 16 * nb + lc]; }
    float pc[8][4];
#pragma unroll
    for (int r = 0; r < 4; ++r) { const int j = 16 * wave + 4 * g + r; const float Rf = RR[j], Rb = RR[128 + j];
        const float qnf = __shfl(qn[r], 16 * g), qnb = __shfl(qn[r], 16 * g + 1);
        float sf[8], sb[8], rsf = 0.f, rsb = 0.f;
#pragma unroll
        for (int nb = 0; nb < 8; ++nb) { const int s = 16 * nb + lc; const float wf = s <= j ? __expf(Rf + csf[nb]) : 0.f, wb = s >= j ? __expf(Rb + csb[nb]) : 0.f;
            sf[nb] = S[nb][r] * wf; sb[nb] = S[nb][r] * wb; rsf += sf[nb]; rsb += sb[nb]; }
        rsf = row16_sum(rsf); rsb = row16_sum(rsb);
        const float inf_ = INTER[j], inb_ = INTER[128 + j];
        const float ivf = __builtin_amdgcn_rcpf(fmaxf(fabsf(inf_ * qnf + rsf), EM[j])), ivb = __builtin_amdgcn_rcpf(fmaxf(fabsf(inb_ * qnb + rsb), EM[128 + j]));
#pragma unroll
        for (int nb = 0; nb < 8; ++nb) pc[nb][r] = sf[nb] * ivf + sb[nb] * ivb;
        if (lc == 0) { ALPHA[j] = inf_ * ivf; ALPHA[128 + j] = inb_ * ivb; } }
    __syncthreads();
#pragma unroll
    for (int r = 0; r < 4; ++r) { const int j = 16 * wave + 4 * g + r;
#pragma unroll
        for (int nb = 0; nb < 8; ++nb) *(LAS unsigned short*)(lds + ML_T1 + j * KP + (16 * nb + lc) * 2) = (unsigned short)f2bf(pc[nb][r]); }
    __syncthreads();
    f32x4 acc[2][8], acc2[2][8];
#pragma unroll
    for (int mb = 0; mb < 2; ++mb)
#pragma unroll
        for (int nb = 0; nb < 8; ++nb) { acc[mb][nb] = (f32x4){0.f, 0.f, 0.f, 0.f}; acc2[mb][nb] = (f32x4){0.f, 0.f, 0.f, 0.f}; }
    const bf16* ucf = UC + (size_t)((chain0 + 0) * 32 + c) * 32768 + (size_t)(32 * wave + lc) * 128 + 8 * g;
    const bf16* ucb = UC + (size_t)((chain0 + 1) * 32 + c) * 32768 + (size_t)(32 * wave + lc) * 128 + 8 * g;
#pragma unroll
    for (int ks = 0; ks < 4; ++ks) {
        const bf16x8v af0 = *(const bf16x8v*)(ucf + 32 * ks), af1 = *(const bf16x8v*)(ucf + 16 * 128 + 32 * ks), ab0 = *(const bf16x8v*)(ucb + 32 * ks), ab1 = *(const bf16x8v*)(ucb + 16 * 128 + 32 * ks);
#pragma unroll
        for (int nb = 0; nb < 8; ++nb) { const bf16x8v qb = frag_row(lds + ML_T0, KP, 16 * nb, 32 * ks, lane);
            acc[0][nb] = __builtin_amdgcn_mfma_f32_16x16x32_bf16(af0, qb, acc[0][nb], 0, 0, 0); acc[1][nb] = __builtin_amdgcn_mfma_f32_16x16x32_bf16(af1, qb, acc[1][nb], 0, 0, 0);
            acc2[0][nb] = __builtin_amdgcn_mfma_f32_16x16x32_bf16(ab0, qb, acc2[0][nb], 0, 0, 0); acc2[1][nb] = __builtin_amdgcn_mfma_f32_16x16x32_bf16(ab1, qb, acc2[1][nb], 0, 0, 0); } }
#pragma unroll
    for (int nb = 0; nb < 8; ++nb) { const float af = ALPHA[16 * nb + lc], ab = ALPHA[128 + 16 * nb + lc];
        acc[0][nb] = acc[0][nb] * af + acc2[0][nb] * ab; acc[1][nb] = acc[1][nb] * af + acc2[1][nb] * ab; }
#pragma unroll
    for (int ks = 0; ks < 4; ++ks) {
        const bf16x8v v0 = frag_tr(lds + ML_V, VP, 32 * ks, 32 * wave, lane), v1 = frag_tr(lds + ML_V, VP, 32 * ks, 32 * wave + 16, lane);
#pragma unroll
        for (int nb = 0; nb < 8; ++nb) { const bf16x8v pb = frag_row(lds + ML_T1, KP, 16 * nb, 32 * ks, lane);
            acc[0][nb] = __builtin_amdgcn_mfma_f32_16x16x32_bf16(v0, pb, acc[0][nb], 0, 0, 0); acc[1][nb] = __builtin_amdgcn_mfma_f32_16x16x32_bf16(v1, pb, acc[1][nb], 0, 0, 0); } }
    v2u ogate[2][8]; f32x4 gg2[2];
#pragma unroll
    for (int mb = 0; mb < 2; ++mb) { gg2[mb] = *(const f32x4*)(mlg + h * 256 + 32 * wave + 16 * mb + 4 * g);
#pragma unroll
        for (int nb = 0; nb < 8; ++nb) ogate[mb][nb] = *(const v2u*)(P + (size_t)(t0 + 16 * nb + lc) * NPROJ + C_MLO + h * 256 + 32 * wave + 16 * mb + 4 * g); }
    float rsna[8];
#pragma unroll
    for (int nb = 0; nb < 8; ++nb) rsna[nb] = RSNA[t0 + 16 * nb + lc];
#pragma unroll
    for (int nb = 0; nb < 8; ++nb) { float ss = 0.f;
#pragma unroll
        for (int mb = 0; mb < 2; ++mb) ss += (acc[mb][nb][0] * acc[mb][nb][0] + acc[mb][nb][1] * acc[mb][nb][1]) + (acc[mb][nb][2] * acc[mb][nb][2] + acc[mb][nb][3] * acc[mb][nb][3]);
        ss = rows4_sum(ss);
        if (g == 0) SS[wave * 128 + 16 * nb + lc] = ss; }
    __syncthreads();
#pragma unroll
    for (int nb = 0; nb < 8; ++nb) { const int j = 16 * nb + lc; float tot = 0.f;
#pragma unroll
        for (int w = 0; w < 8; ++w) tot += SS[w * 128 + j];
        const float rstd = __builtin_amdgcn_rsqf(tot * (1.0f / 256.0f) + EPS) * __builtin_amdgcn_rcpf(rsna[nb]);
#pragma unroll
        for (int mb = 0; mb < 2; ++mb) { const int e0 = 32 * wave + 16 * mb + 4 * g; const size_t t = (size_t)(t0 + j);
            const v2u ow = ogate[mb][nb]; const f32x4 gg = gg2[mb];
            const float o[4] = {bflo(ow.x), bfhi(ow.x), bflo(ow.y), bfhi(ow.y)}; float rr[4];
#pragma unroll
            for (int r = 0; r < 4; ++r) rr[r] = acc[mb][nb][r] * rstd * gg[r] * __builtin_amdgcn_rcpf(1.0f + __expf(-o[r]));
            v2u w; w.x = pk2(rr[0], rr[1]); w.y = pk2(rr[2], rr[3]);
            *(v2u*)(MIX + t * D + 1024 + h * 256 + e0) = w; } }
}


#ifndef NA_PROBE
#define NA_PROBE 0
#endif
constexpr int NA_TILE = 64 * KP, NA_BUF = 2 * NA_TILE, NA_RPB = 2 * NA_BUF;
static_assert(NA_RPB + 15 * 128 * 4 <= ML_END, "LDS map");
__device__ __forceinline__ bf16x8v frag_tr2(LAS unsigned char* tile, int pitch, int row0, int row1, int n0, int lane) {
    const int q = (lane & 15) >> 2, p = lane & 3;
    const s16x4 lo = lds_tr(tile + (row0 + q) * pitch + (n0 + 4 * p) * 2), hi = lds_tr(tile + (row1 + q) * pitch + (n0 + 4 * p) * 2);
    return (bf16x8v){lo[0], lo[1], lo[2], lo[3], hi[0], hi[1], hi[2], hi[3]};
}
__device__ __forceinline__ void na_unit(int u, const bf16* P, const float* rpb, bf16* MIX, float* SSQ, LAS unsigned char* lds, int tid_, int wave) {
    int tid = tid_; asm volatile("" : "+v"(tid)); const int lane = tid & 63, g = lane >> 4, lc = lane & 15;
    const int r4 = u & 15, h = (u >> 4) & 7, b = u >> 7;
    const int r0 = 4 * r4, r = r0 + (wave >> 1), qh = wave & 1;
    const int rs = min(max(r - 4, 0), 56), rs0 = min(max(r0 - 4, 0), 56), nk = min(max(r0 + 3 - 4, 0), 56) + 8 - rs0;
    LAS float* RPB = (LAS float*)(lds + NA_RPB);
    const int sA = tid >> 4, chA = tid & 15, sB = sA + 32;
    const bf16* gsrc = P + ((size_t)b * SEQ + rs0 * 64) * NPROJ + h * 128 + chA * 8;
    v4u pk0, pk1, pv0, pv1;
#define NA_LOAD(j) do { const bf16* s_ = gsrc + (size_t)(j) * 64 * NPROJ; pk0 = *(const v4u*)(s_ + (size_t)sA * NPROJ + C_NAK); pk1 = *(const v4u*)(s_ + (size_t)sB * NPROJ + C_NAK); \
        pv0 = *(const v4u*)(s_ + (size_t)sA * NPROJ + C_NAV); pv1 = *(const v4u*)(s_ + (size_t)sB * NPROJ + C_NAV); } while (0)
#define NA_STORE(buf) do { LAS unsigned char* t_ = lds + (buf) * NA_BUF; *(LAS v4u*)(t_ + sA * KP + chA * 16) = pk0; *(LAS v4u*)(t_ + sB * KP + chA * 16) = pk1; \
        *(LAS v4u*)(t_ + NA_TILE + sA * KP + chA * 16) = pv0; *(LAS v4u*)(t_ + NA_TILE + sB * KP + chA * 16) = pv1; } while (0)
    NA_LOAD(0);
    __syncthreads();
    for (int i = tid; i < 15 * 128; i += 512) { const int dr = i >> 7, x = (i & 127) - 48; RPB[i] = (x >= 0 && x < 31) ? rpb[h * 465 + dr * 31 + x] * 1.4426950408889634f : 0.f; }
    NA_STORE(0);
    bf16x8v qf[2][4]; int cq[2], cs[2], boff[2]; float m[2], l[2]; f32x4 O[2][8]; f32x4 madd[2][4];
#pragma unroll
    for (int qi = 0; qi < 2; ++qi) { cq[qi] = 32 * qh + 16 * qi + lc; cs[qi] = min(max(cq[qi] - 8, 0), 48); m[qi] = -1.0e30f; l[qi] = 0.f; boff[qi] = 63 - cq[qi] + 4 * g;
#pragma unroll
        for (int kb = 0; kb < 4; ++kb)
#pragma unroll
            for (int rr = 0; rr < 4; ++rr) { const int kc = 16 * kb + 4 * g + rr; madd[qi][kb][rr] = (kc >= cs[qi] && kc < cs[qi] + 16) ? 0.f : -1.0e30f; }
        const bf16* qp = P + ((size_t)b * SEQ + r * 64 + cq[qi]) * NPROJ + C_NAQ + h * 128 + 8 * g;
#pragma unroll
        for (int ks = 0; ks < 4; ++ks) qf[qi][ks] = *(const bf16x8v*)(qp + 32 * ks);
#pragma unroll
        for (int db = 0; db < 8; ++db) O[qi][db] = (f32x4){0.f, 0.f, 0.f, 0.f}; }
    __syncthreads();
#pragma unroll 1
    for (int j = 0; j < nk; ++j) {
        const int kr = rs0 + j;
        if (j + 1 < nk) NA_LOAD(j + 1);
        if (kr >= rs && kr < rs + 8) {
            LAS unsigned char* Kt = lds + (j & 1) * NA_BUF; LAS unsigned char* Vt = Kt + NA_TILE;
            const LAS float* brow = RPB + (kr - r + 7) * 128;
            const int kb0a = qh ? 1 : 0, kb1a = qh ? 3 : 1, kb0b = qh ? 2 : 0, kb1b = qh ? 3 : 2;
            f32x4 s[2][4];
#if NA_PROBE == 1
            for (int prb = 0; prb < 2; ++prb) { asm volatile("" ::: "memory");
#else
            {
#endif
#pragma unroll
            for (int kb = 0; kb < 4; ++kb) { s[0][kb] = (f32x4){0.f, 0.f, 0.f, 0.f}; s[1][kb] = (f32x4){0.f, 0.f, 0.f, 0.f}; }
#pragma unroll
            for (int kb = 0; kb < 4; ++kb) { const bool ua = kb >= kb0a && kb <= kb1a, ub = kb >= kb0b && kb <= kb1b;
                if (ua || ub) {
#pragma unroll
                    for (int ks = 0; ks < 4; ++ks) { const bf16x8v ka = frag_row(Kt, KP, 16 * kb, 32 * ks, lane);
                        if (ua) s[0][kb] = __builtin_amdgcn_mfma_f32_16x16x32_bf16(ka, qf[0][ks], s[0][kb], 0, 0, 0);
                        if (ub) s[1][kb] = __builtin_amdgcn_mfma_f32_16x16x32_bf16(ka, qf[1][ks], s[1][kb], 0, 0, 0); } } }
            }
            bf16x8v pb[2][2];
#pragma unroll
            for (int qi = 0; qi < 2; ++qi) {
                const int k0 = qi ? kb0b : kb0a, k1 = qi ? kb1b : kb1a; const LAS float* bq = brow + boff[qi];
                float mx = -1.0e30f;
#pragma unroll
                for (int kb = 0; kb < 4; ++kb) if (kb >= k0 && kb <= k1) {
#pragma unroll
                    for (int rr = 0; rr < 4; ++rr) { const float v = s[qi][kb][rr] * 0.12753785f + bq[16 * kb + rr] + madd[qi][kb][rr]; s[qi][kb][rr] = v; mx = fmaxf(mx, v); } }
                mx = rows4_max(mx);
                const float mn = fmaxf(m[qi], mx); float ls = 0.f;
#pragma unroll
                for (int kb = 0; kb < 4; ++kb) { if (kb >= k0 && kb <= k1) {
#pragma unroll
                    for (int rr = 0; rr < 4; ++rr) { const float p = __builtin_amdgcn_exp2f(s[qi][kb][rr] - mn); s[qi][kb][rr] = p; ls += p; } } else s[qi][kb] = (f32x4){0.f, 0.f, 0.f, 0.f}; }
                ls = rows4_sum(ls);
                if (!__all(mn == m[qi])) { const float corr = __builtin_amdgcn_exp2f(m[qi] - mn); l[qi] *= corr;
#pragma unroll
                    for (int db = 0; db < 8; ++db) O[qi][db] = O[qi][db] * corr; }
                l[qi] += ls; m[qi] = mn;
#pragma unroll
                for (int t = 0; t < 2; ++t) { v4u pw; pw.x = pk2(s[qi][2 * t][0], s[qi][2 * t][1]); pw.y = pk2(s[qi][2 * t][2], s[qi][2 * t][3]); pw.z = pk2(s[qi][2 * t + 1][0], s[qi][2 * t + 1][1]); pw.w = pk2(s[qi][2 * t + 1][2], s[qi][2 * t + 1][3]);
                    pb[qi][t] = __builtin_bit_cast(bf16x8v, pw); }
            }
#if NA_PROBE == 2
            for (int prb = 0; prb < 2; ++prb) { asm volatile("" ::: "memory"); if (prb) { pb[0][0] = pb[0][1] = pb[1][0] = pb[1][1] = (bf16x8v){0, 0, 0, 0, 0, 0, 0, 0}; }
#else
            {
#endif
#pragma unroll
            for (int t = 0; t < 2; ++t) { const bool ua = 2 * t + 1 >= kb0a && 2 * t <= kb1a, ub = 2 * t + 1 >= kb0b && 2 * t <= kb1b;
                if (ua || ub) {
#pragma unroll
                    for (int db = 0; db < 8; ++db) { const bf16x8v va = frag_tr2(Vt, KP, 32 * t + 4 * g, 32 * t + 16 + 4 * g, 16 * db, lane);
                        if (ua) O[0][db] = __builtin_amdgcn_mfma_f32_16x16x32_bf16(va, pb[0][t], O[0][db], 0, 0, 0);
                        if (ub) O[1][db] = __builtin_amdgcn_mfma_f32_16x16x32_bf16(va, pb[1][t], O[1][db], 0, 0, 0); } } }
            }
        }
#if NA_PROBE == 4
        if (j + 1 < nk) { NA_STORE((j + 1) & 1); asm volatile("" ::: "memory"); }
#endif
#if NA_PROBE == 5
        __syncthreads();
#endif
        if (j + 1 < nk) NA_STORE((j + 1) & 1);
        __syncthreads();
    }
#pragma unroll
    for (int qi = 0; qi < 2; ++qi) { const float inv = 1.0f / l[qi]; const size_t t = (size_t)b * SEQ + r * 64 + cq[qi]; bf16* op = MIX + t * D + h * 128 + 4 * g; float ss = 0.f;
#pragma unroll
        for (int db = 0; db < 8; ++db) { const f32x4 o = O[qi][db] * inv; ss += (o[0] * o[0] + o[1] * o[1]) + (o[2] * o[2] + o[3] * o[3]); v2u w; w.x = pk2(o[0], o[1]); w.y = pk2(o[2], o[3]); *(v2u*)(op + 16 * db) = w; }
        ss = rows4_sum(ss);
        if (g == 0) SSQ[t * 8 + h] = ss; }
#undef NA_LOAD
#undef NA_STORE
}


constexpr int NWAVES = 8;
#ifndef NCONV
#define NCONV 96
#endif
constexpr int RING_BYTES = 131072;
constexpr int LDSCTL_OFF = ML_END, MISC_OFF = LDSCTL_OFF + 320;
constexpr int LDS_BYTES = LDSCTL_OFF + 1024;
static_assert(ML_END >= RING_BYTES && LDS_BYTES <= 163840, "LDS map");
constexpr int CW_BAR = 4096;
constexpr size_t CTL_ZERO_BYTES = 65536;
static_assert((CW_BAR + XCD_BAR_WORDS) * 4 <= (int)CTL_ZERO_BYTES, "barrier words inside the memset region");

struct MKArgs { const float* in[16]; float* out; unsigned char* ws; };
__global__ void __launch_bounds__(NWAVES * 64, 2) mk_fwd(MKArgs args) {
    extern __shared__ __attribute__((aligned(16))) unsigned char lds_raw[];
    LAS unsigned char* lds = (LAS unsigned char*)lds_raw;
    volatile LAS unsigned* MISC = (volatile LAS unsigned*)(lds + MISC_OFF);
    const int tid = threadIdx.x, lane0 = tid & 63, wave = __builtin_amdgcn_readfirstlane(tid >> 6);
    const int G = gridDim.x; const int bx = blockIdx.x; const int vcu = (G % 8 == 0) ? (bx % 8) * (G / 8) + bx / 8 : bx;
    const int gw0 = vcu * NWAVES + wave, ngw = G * NWAVES;
    unsigned char* ws = args.ws;
    for (int u = tid; u < (LDS_BYTES - LDSCTL_OFF) / 4; u += NWAVES * 64) ((LAS unsigned*)(lds + LDSCTL_OFF))[u] = 0u;
    __syncthreads();
    XcdBarrier bar = xcd_barrier_post((unsigned*)(ws + WS_CTL) + CW_BAR, MISC + 8);
#define GRID_BAR() do { XcdBarrier b_ = bar; asm volatile("" : "+s"(b_.bar), "+s"(b_.x)); xcd_barrier(b_); } while (0)
    const float* x = args.in[0]; const float* norm_mix_g = args.in[1]; const float* w_in = args.in[2]; const float* b_gates = args.in[3];
    const float* conv_w = args.in[4]; const float* conv_b = args.in[5]; const float* na_rpb = args.in[6]; const float* na_norm_g = args.in[7];
    const float* ml_norm_g = args.in[8]; const float* w_out = args.in[9]; const float* norm_ffn_g = args.in[10]; const float* w_router = args.in[11];
    const float* w_gate = args.in[12]; const float* w_up = args.in[13]; const float* w_down = args.in[14]; const float* final_norm_g = args.in[15];
#define WSPTRS(wsl, Xl) float* X = (Xl); float* RSTD = (float*)((wsl) + WS_RSTD); float* GATES = (float*)((wsl) + WS_GATES); float* AFF = (float*)((wsl) + WS_AFF); int* TOK = (int*)((wsl) + WS_TOK); float* GATEV = (float*)((wsl) + WS_GATEV); int* SEL = (int*)((wsl) + WS_SEL); \
    bf16* XB = (bf16*)((wsl) + WS_XB); bf16* MIX = (bf16*)((wsl) + WS_MIX); bf16* P = (bf16*)((wsl) + WS_P); bf16* NAO = (bf16*)((wsl) + WS_NAO); bf16* ACT = (bf16*)((wsl) + WS_ACT); bf16* Y = (bf16*)((wsl) + WS_Y); \
    (void)X; (void)RSTD; (void)GATES; (void)AFF; (void)TOK; (void)GATEV; (void)SEL; (void)XB; (void)MIX; (void)P; (void)NAO; (void)ACT; (void)Y;
#define LAUNDER(p) asm volatile("" : "+s"(p))
#ifndef REP_MASK
#define REP_MASK 0
#endif
#if (REP_MASK >> 0) & 1
#define REP0 for (int rep_ = 0; rep_ < 2; ++rep_)
#else
#define REP0
#endif
#if (REP_MASK >> 1) & 1
#define REP1 for (int rep_ = 0; rep_ < 2; ++rep_)
#else
#define REP1
#endif
#if (REP_MASK >> 2) & 1
#define REP2 for (int rep_ = 0; rep_ < 2; ++rep_)
#else
#define REP2
#endif
#if (REP_MASK >> 3) & 1
#define REP3 for (int rep_ = 0; rep_ < 2; ++rep_)
#else
#define REP3
#endif
#if (REP_MASK >> 4) & 1
#define REP4 for (int rep_ = 0; rep_ < 2; ++rep_)
#else
#define REP4
#endif
#if (REP_MASK >> 5) & 1
#define REP5 for (int rep_ = 0; rep_ < 2; ++rep_)
#else
#define REP5
#endif
#if (REP_MASK >> 6) & 1
#define REP6 for (int rep_ = 0; rep_ < 2; ++rep_)
#else
#define REP6
#endif
#if (REP_MASK >> 7) & 1
#define REP7 for (int rep_ = 0; rep_ < 2; ++rep_)
#else
#define REP7
#endif
#if (REP_MASK >> 8) & 1
#define REP8 for (int rep_ = 0; rep_ < 2; ++rep_)
#else
#define REP8
#endif
#if (REP_MASK >> 9) & 1
#define REP9 for (int rep_ = 0; rep_ < 2; ++rep_)
#else
#define REP9
#endif
#if (REP_MASK >> 10) & 1
#define REP10 for (int rep_ = 0; rep_ < 2; ++rep_)
#else
#define REP10
#endif
#if (REP_MASK >> 11) & 1
#define REP11 for (int rep_ = 0; rep_ < 2; ++rep_)
#else
#define REP11
#endif
#if (REP_MASK >> 12) & 1
#define REP12 for (int rep_ = 0; rep_ < 2; ++rep_)
#else
#define REP12
#endif
#if (REP_MASK >> 13) & 1
#define REP13 for (int rep_ = 0; rep_ < 2; ++rep_)
#else
#define REP13
#endif

    { WSPTRS(ws, args.out)
      const int lane = lane0, gw = gw0;
    REP0 { ConvArgs ca; ca.w_in = w_in; ca.w_out = w_out; ca.w_gate = w_gate; ca.w_up = w_up; ca.w_down = w_down; ca.norm_mix_g = norm_mix_g; ca.norm_ffn_g = norm_ffn_g; ca.na_norm_g = na_norm_g; ca.ws = ws;
      LAS float* scr = (LAS float*)(lds + wave * CONV_SCR_BYTES);
      if (G == 256) convert_stream(ca, gw, ngw, CI_IN, scr, lane);
      else convert_stream(ca, gw, ngw, DEPTH * CI_LAYER, scr, lane); }
    { bf16* W16F = (bf16*)(ws + WS_W16F_OFF);
      for (int it = gw; it < DEPTH * 2 * 64; it += ngw) { const int mi = it >> 6, s = it & 63, l = mi >> 1;
          if (mi & 1) w16f_item(w_router + (size_t)l * D * NE, NE, norm_ffn_g + l * D, W16F + (size_t)mi * 32768, s, lane);
          else w16f_item(w_in + (size_t)l * D * NIN + C_GATES, NIN, norm_mix_g + l * D, W16F + (size_t)mi * 32768, s, lane); } }
    GRID_BAR();
    REP1 { RowArgs a; a.src32 = x; a.srcb = nullptr; a.sel = nullptr; a.Y = nullptr; a.XB = XB; a.XB8 = ws + WS_XB8; a.RSTD = RSTD; a.g = norm_mix_g; a.W16F = (const bf16*)(ws + WS_W16F_OFF); a.bias = b_gates; a.GATES = GATES; a.AFF = AFF; a.out = X; a.mode = 0; a.wrxb = 1;
      for (int grp = gw; grp < MTOK / 8; grp += ngw) rowpass_group<true>(a, grp, lane); } }
    GRID_BAR();

    for (int l = 0; l < DEPTH; ++l) {
        unsigned char* wsl = ws; float* Xl = args.out; LAUNDER(wsl); LAUNDER(Xl);
        WSPTRS(wsl, Xl)
        int lane = lane0, gw = gw0; asm volatile("" : "+v"(lane)); LAUNDER(gw);
        const bf16* WinT = (const bf16*)(wsl + WS_WIN) + (size_t)l * NPROJ * D; const bf16* WoutT = (const bf16*)(wsl + WS_WOUT) + (size_t)l * D * D;
        const bf16* WguT = (const bf16*)(wsl + WS_WGU) + (size_t)l * NE * 2048 * D; const bf16* WdT = (const bf16*)(wsl + WS_WD) + (size_t)l * NE * D * DE;
        const int Gg = (l == 0 && G == 256) ? G - NCONV : G;
        if (bx >= Gg) { ConvArgs ca; ca.w_in = w_in; ca.w_out = w_out; ca.w_gate = w_gate; ca.w_up = w_up; ca.w_down = w_down; ca.norm_mix_g = norm_mix_g; ca.norm_ffn_g = norm_ffn_g; ca.na_norm_g = na_norm_g; ca.ws = wsl;
          convert_stream(ca, CI_IN + (bx - Gg) * NWAVES + wave, NCONV * NWAVES, DEPTH * CI_LAYER, (LAS float*)(lds + wave * CONV_SCR_BYTES), lane); }
        else {
        REP2 { pg8::Gemm g{XB, WinT, MTOK, NPROJ16, D, 0}; pg8::StaticOrder S; S.init(MTOK, NPROJ16, Gg, bx); pg8::EpiRowScaleBf16 E{P, RSTD, nullptr, NPROJ, 0, 1.0f, 0};
          pg8::gemm_phase<pg8::EpiRowScaleBf16, pg8::StaticOrder, true, true>(lds, g, S, E); }
        { pg8::Gemm g{(const bf16*)(wsl + WS_XB8), (const bf16*)(wsl + WS_WIN + ((size_t)l * NPROJ + NPROJ16) * D * 2), MTOK, NPROJ - NPROJ16, D / 2, 0}; pg8::StaticOrder S; S.init(MTOK, NPROJ - NPROJ16, Gg, bx);
          pg8::EpiRowScaleBf16 E{P + NPROJ16, RSTD, nullptr, NPROJ, 0, 1.0f / W8_SCALE, 0};
          pg8::gemm_phase<pg8::EpiRowScaleBf16, pg8::StaticOrder, true, true, true>(lds, g, S, E); }
        }
        GRID_BAR();
        REP4 for (int u = vcu; u < 512; u += G) na_unit(u, P, na_rpb + (size_t)l * 8 * 15 * 31, MIX, (float*)(wsl + WS_SSQ), lds, tid, wave);
        { bf16* UC = (bf16*)(wsl + WS_UC); float* NU = (float*)(wsl + WS_NU); float* SC = (float*)(wsl + WS_SC); const float* cwl = conv_w + (size_t)l * 5 * 1024; const float* cbl = conv_b + l * 1024;
          int tidl = tid; asm volatile("" : "+v"(tidl));
          REP5 for (int u = bx; u < 512; u += G) mlstm_m1_unit(u, cwl, cbl, P, GATES, UC, NU, SC, lds, tidl, wave);
          GRID_BAR();
          mlstm_m2(UC, NU, SC, vcu * 512 + tidl, G * 512);
          { const float* ssq = (const float*)(wsl + WS_SSQ); float* rsna = (float*)(wsl + WS_RSNA);
            for (int t = vcu * 512 + tidl; t < MTOK; t += G * 512) { const f32x4 s0 = *(const f32x4*)(ssq + (size_t)t * 8), s1 = *(const f32x4*)(ssq + (size_t)t * 8 + 4);
                rsna[t] = 1.0f / sqrtf(((s0[0] + s0[1]) + (s0[2] + s0[3]) + (s1[0] + s1[1]) + (s1[2] + s1[3])) * (1.0f / 1024.0f) + EPS); } }
          GRID_BAR();
          REP7 for (int u = bx; u < 512; u += G) mlstm_m3_unit(u, cwl, cbl, P, GATES, UC, NU, SC, ml_norm_g + l * 1024, (const float*)(wsl + WS_RSNA), MIX, lds, tidl, wave); }
        GRID_BAR();
#if (REP_MASK >> 8) & 1
        for (int rep_ = 0; rep_ < 2; ++rep_)
#endif
        { pg8::Gemm g{MIX, WoutT, MTOK, D, D, 0}; pg8::StaticOrder S; S.init(MTOK, D, G, bx); pg8::EpiResidBf16 E{XB, (const float*)(wsl + WS_RSNA), D, 0};
#if (REP_MASK >> 8) & 1
          if (rep_ == 0) E.XB = P;
#endif
          pg8::gemm_phase<pg8::EpiResidBf16, pg8::StaticOrder, true, true>(lds, g, S, E); }
        GRID_BAR();
        REP9 { RowArgs a; a.src32 = nullptr; a.srcb = XB; a.sel = nullptr; a.Y = nullptr; a.XB = XB; a.XB8 = wsl + WS_XB8; a.RSTD = RSTD; a.g = norm_ffn_g + l * D; a.W16F = (const bf16*)(wsl + WS_W16F_OFF) + (size_t)(2 * l + 1) * 32768; a.bias = b_gates; a.GATES = GATES; a.AFF = AFF; a.out = X; a.mode = 1; a.wrxb = 0;
          for (int grp = gw; grp < MTOK / 8; grp += ngw) rowpass_group<false>(a, grp, lane); }
        GRID_BAR();
        REP10 for (int be = bx; be < BATCH * NE; be += G) topk_unit(be, AFF, TOK, GATEV, SEL, (LAS int*)lds);
        GRID_BAR();
        REP12 { pg8::Gemm g{(const bf16*)(wsl + WS_XB8), (const bf16*)(wsl + WS_WGU + (size_t)l * NE * 2048 * D), MR, 2048, D / 2, 0}; pg8::GroupedGatherOrder S{TOK, G, bx};
          pg8::EpiSwiGLU8 E{(unsigned char*)ACT, RSTD, TOK, DE, 8, 1.0f / W8_SCALE, 0};
          pg8::gemm_phase_gather<pg8::EpiSwiGLU8, pg8::GroupedGatherOrder, true, true, true>(lds, g, S, E); }
        GRID_BAR();
        REP13 { pg8::Gemm g{ACT, (const bf16*)(wsl + WS_WD + (size_t)l * NE * D * DE), MR, 2048, DE / 2, 0}; pg8::GroupedOrder S{nullptr, G, bx}; pg8::EpiRowScaleF8 E{(unsigned char*)Y, GATEV, D, 8, Y8_SCALE / W8_SCALE, 0};
          pg8::gemm_phase<pg8::EpiRowScaleF8, pg8::GroupedOrder, true, true, true>(lds, g, S, E); }
        GRID_BAR();
        { RowArgs a; a.src32 = nullptr; a.srcb = XB; a.sel = SEL; a.Y = (const unsigned char*)Y; a.XB = XB; a.XB8 = wsl + WS_XB8; a.RSTD = RSTD; a.bias = b_gates + (l + 1 < DEPTH ? (l + 1) * 16 : 0); a.GATES = GATES; a.AFF = AFF; a.out = X; a.wrxb = 1;
          a.W16F = (const bf16*)(wsl + WS_W16F_OFF) + (size_t)(2 * (l + 1 < DEPTH ? l + 1 : 0)) * 32768;
          if (l + 1 < DEPTH) { a.g = norm_mix_g + (l + 1) * D; a.mode = 0; }
          else { a.g = final_norm_g; a.mode = 2; }
          for (int grp = gw; grp < MTOK / 8; grp += ngw) rowpass_group<false>(a, grp, lane); }
        if (l + 1 < DEPTH) GRID_BAR();
    }
#undef GRID_BAR
#undef WSPTRS
}

extern "C" void kernel_launch(void* const* d_in, const int* in_sizes, int n_in, void* d_out, int out_size, void* d_ws, size_t ws_size, hipStream_t stream) {
    static int grid = 0;
    if (grid == 0) {
        if (n_in != 16 || ws_size < WS_END) { fprintf(stderr, "kernel_launch: unexpected n_in %d or ws_size %zu\n", n_in, ws_size); grid = -1; return; }
        int dev = 0, cus = 0, per_cu = 0;
        if (hipGetDevice(&dev) != hipSuccess || hipDeviceGetAttribute(&cus, hipDeviceAttributeMultiprocessorCount, dev) != hipSuccess) { grid = -1; return; }
        if (hipFuncSetAttribute((const void*)mk_fwd, hipFuncAttributeMaxDynamicSharedMemorySize, LDS_BYTES) != hipSuccess) { fprintf(stderr, "kernel_launch: hipFuncSetAttribute failed\n"); grid = -1; return; }
        if (hipOccupancyMaxActiveBlocksPerMultiprocessor(&per_cu, (const void*)mk_fwd, NWAVES * 64, LDS_BYTES) != hipSuccess || per_cu < 1) fprintf(stderr, "kernel_launch: occupancy query reports %d blocks per CU\n", per_cu);
        (void)hipGetLastError();
        grid = cus;
    }
    if (grid < 0) return;
    if (hipMemsetAsync((char*)d_ws + WS_CTL, 0, CTL_ZERO_BYTES, stream) != hipSuccess) return;
    MKArgs a; memset(&a, 0, sizeof(a));
    for (int i = 0; i < 16; ++i) a.in[i] = (const float*)d_in[i];
    a.out = (float*)d_out; a.ws = (unsigned char*)d_ws;
    hipLaunchKernelGGL(mk_fwd, dim3(grid), dim3(NWAVES * 64), LDS_BYTES, stream, a);
}
```

```cpp
#include <hip/hip_runtime.h>
#include <stdint.h>
#include <stdio.h>
#include <string.h>

namespace pg8 {
#define PG8_LAS __attribute__((address_space(3)))
typedef unsigned short bf16_t;
typedef short bf16x8 __attribute__((ext_vector_type(8)));
typedef float f32x4 __attribute__((ext_vector_type(4)));
typedef unsigned u32x4 __attribute__((ext_vector_type(4)));
typedef int v4i32 __attribute__((ext_vector_type(4)));
typedef int v8i32 __attribute__((ext_vector_type(8)));
constexpr int BM = 256, BK = 64, HALF = 128, HTB = HALF * BK * 2  , STAGE_BYTES = 8 * HTB, NXCD = 8, WGM = 8;

__host__ __device__ __forceinline__ int lds_byte(int r, int c) { const int st = (r >> 4) * 2 + (c >> 5), rr = r & 15, cc = c & 31, ob = rr * 64 + cc * 2; return st * 1024 + (ob ^ (((ob >> 9) & 1) << 5)); }
__host__ __device__ __forceinline__ void stage_rc(int b, int& R, int& C) { const int st = b / 1024, sb = b % 1024, swz = sb ^ (((sb >> 9) & 1) << 5); R = (st >> 1) * 16 + swz / 64; C = (st & 1) * 32 + (swz % 64) / 2; }
__host__ __device__ __forceinline__ int perm32(int rho) { const int n = rho >> 4, i = rho & 15; return 8 * (i >> 2) + 4 * n + (i & 3); }

struct Unit { int pm, pn; };
struct Gemm { const bf16_t* A; const bf16_t* Bt; int M, N, K, pad; };

struct StaticOrder {
    static constexpr bool GATHER = false;
    int nM, nN, nwg, G, c, pad;
    __host__ __device__ void init(int M, int N, int G_, int c_) { nM = M / BM; nN = N / BM; nwg = nM * nN; G = G_; c = c_; pad = 0; }
    __host__ __device__ bool next(int i, Unit& u) const {
        const long L = (long)i * G + c; if (L >= nwg) return false;
        int wgid = (int)L; { const int q = nwg / NXCD, r = nwg % NXCD, xcd = wgid % NXCD, off = wgid / NXCD; wgid = (xcd < r ? xcd * (q + 1) : r * (q + 1) + (xcd - r) * q) + off; }
        const int nig = WGM * nN, gid = wgid / nig, fm = gid * WGM, gsz = (nM - fm) < WGM ? (nM - fm) : WGM;
        u.pm = fm + ((wgid % nig) % gsz); u.pn = (wgid % nig) / gsz; return true;
    }
    __device__ __forceinline__ void a_ready(const Unit&) const {}
    __device__ __forceinline__ void done(const Unit&) const {}
};


__device__ __forceinline__ unsigned cvt_pk_bf16(float lo, float hi) { unsigned r; asm volatile("v_cvt_pk_bf16_f32 %0, %1, %2" : "=v"(r) : "v"(lo), "v"(hi)); return r; }
typedef unsigned u32x2 __attribute__((ext_vector_type(2)));

struct EpiRowScaleBf16 {
    static constexpr bool PERM = true, AFTER_DRAIN = false;
    bf16_t* O; const float* rowscale; const int* rowmap; int ldc; int pn_mod; float mul; int pad;
    __device__ __forceinline__ void pre(const Unit& u, int wr, int fr, float (&rs)[8]) const {
#pragma unroll
        for (int i = 0; i < 8; ++i) { const int row = u.pm * BM + wr * 64 + fr + (i >> 2) * HALF + (i & 3) * 16; rs[i] = rowscale ? rowscale[rowmap ? rowmap[row] : row] : 1.0f; } }
    __device__ __forceinline__ void operator()(const f32x4 (&acc)[2][2][4][2], const Unit& u, int wr, int wc, int fr, int fq, const float (&rs)[8]) const {
        const int row0 = u.pm * BM + wr * 64 + fr; const int pnl = pn_mod ? (u.pn % pn_mod) : u.pn;
        const int col0 = pnl * BM + wc * 32 + 8 * fq;
#pragma unroll
        for (int ai = 0; ai < 2; ++ai)
#pragma unroll
            for (int m = 0; m < 4; ++m) { const int row = row0 + ai * HALF + m * 16; const float sc = rs[4 * ai + m] * mul;
                bf16_t* rowp = O + (size_t)row * ldc + col0;
#pragma unroll
                for (int bj = 0; bj < 2; ++bj) { const f32x4 v0 = acc[ai][bj][m][0] * sc, v1 = acc[ai][bj][m][1] * sc;
                    u32x4 w; w.x = cvt_pk_bf16(v0[0], v0[1]); w.y = cvt_pk_bf16(v0[2], v0[3]); w.z = cvt_pk_bf16(v1[0], v1[1]); w.w = cvt_pk_bf16(v1[2], v1[3]);
                    *(u32x4*)(rowp + bj * HALF) = w; } }
    }
};
__device__ __forceinline__ unsigned pk4_fp8(float a, float b, float c, float d) { int p = __builtin_amdgcn_cvt_pk_fp8_f32(a, b, 0, false); p = __builtin_amdgcn_cvt_pk_fp8_f32(c, d, p, true); return (unsigned)p; }
struct EpiSwiGLU8 {
    static constexpr bool PERM = false, AFTER_DRAIN = false;
    unsigned char* O; const float* rowscale; const int* rowmap; int ldc; int pn_mod; float mul; int pad;
    __device__ __forceinline__ void pre(const Unit& u, int wr, int fr, float (&rs)[8]) const {
#pragma unroll
        for (int i = 0; i < 8; ++i) { const int row = u.pm * BM + wr * 64 + fr + (i >> 2) * HALF + (i & 3) * 16; rs[i] = rowscale[rowmap[row]]; } }
    __device__ __forceinline__ void operator()(const f32x4 (&acc)[2][2][4][2], const Unit& u, int wr, int wc, int fr, int fq, const float (&rs)[8]) const {
        const int row0 = u.pm * BM + wr * 64 + fr; const int pnl = u.pn % pn_mod;
        const int col0 = pnl * 128 + wc * 16 + 4 * fq;
#pragma unroll
        for (int ai = 0; ai < 2; ++ai)
#pragma unroll
            for (int m = 0; m < 4; ++m) { const int row = row0 + ai * HALF + m * 16; const float sc = rs[4 * ai + m] * mul;
                unsigned char* rowp = O + (size_t)row * ldc + col0;
#pragma unroll
                for (int bj = 0; bj < 2; ++bj) { const f32x4 a = acc[ai][bj][m][0] * sc, up = acc[ai][bj][m][1] * sc; f32x4 r;
#pragma unroll
                    for (int j = 0; j < 4; ++j) r[j] = a[j] * up[j] * __builtin_amdgcn_rcpf(1.0f + __builtin_amdgcn_exp2f(-1.4426950408889634f * a[j]));
                    *(unsigned*)(rowp + bj * 64) = pk4_fp8(r[0], r[1], r[2], r[3]); } }
    }
};

struct EpiRowScaleF8 {
    static constexpr bool PERM = true, AFTER_DRAIN = false;
    unsigned char* O; const float* rowscale; int ldc; int pn_mod; float mul; int pad;
    __device__ __forceinline__ void pre(const Unit& u, int wr, int fr, float (&rs)[8]) const {
#pragma unroll
        for (int i = 0; i < 8; ++i) rs[i] = rowscale[u.pm * BM + wr * 64 + fr + (i >> 2) * HALF + (i & 3) * 16]; }
    __device__ __forceinline__ void operator()(const f32x4 (&acc)[2][2][4][2], const Unit& u, int wr, int wc, int fr, int fq, const float (&rs)[8]) const {
        const int row0 = u.pm * BM + wr * 64 + fr; const int pnl = pn_mod ? (u.pn % pn_mod) : u.pn;
        const int col0 = pnl * BM + wc * 32 + 8 * fq;
#pragma unroll
        for (int ai = 0; ai < 2; ++ai)
#pragma unroll
            for (int m = 0; m < 4; ++m) { const int row = row0 + ai * HALF + m * 16; const float sc = rs[4 * ai + m] * mul;
                unsigned char* rowp = O + (size_t)row * ldc + col0;
#pragma unroll
                for (int bj = 0; bj < 2; ++bj) { const f32x4 v0 = acc[ai][bj][m][0] * sc, v1 = acc[ai][bj][m][1] * sc;
                    u32x2 w; w.x = pk4_fp8(v0[0], v0[1], v0[2], v0[3]); w.y = pk4_fp8(v1[0], v1[1], v1[2], v1[3]);
                    *(u32x2*)(rowp + bj * HALF) = w; } }
    }
};

struct EpiResidBf16 {
    static constexpr bool PERM = true, AFTER_DRAIN = false;
    bf16_t* XB; const float* rowscale; int ldc; int pad;
    __device__ __forceinline__ void pre(const Unit& u, int wr, int fr, float (&rs)[8]) const {
#pragma unroll
        for (int i = 0; i < 8; ++i) rs[i] = rowscale[u.pm * BM + wr * 64 + fr + (i >> 2) * HALF + (i & 3) * 16]; }
    __device__ __forceinline__ void operator()(const f32x4 (&acc)[2][2][4][2], const Unit& u, int wr, int wc, int fr, int fq, const float (&rs)[8]) const {
        const int row0 = u.pm * BM + wr * 64 + fr, col0 = u.pn * BM + wc * 32 + 8 * fq;
#pragma unroll
        for (int ai = 0; ai < 2; ++ai) {
            u32x4 xin[4][2];
#pragma unroll
            for (int m = 0; m < 4; ++m)
#pragma unroll
                for (int bj = 0; bj < 2; ++bj) xin[m][bj] = *(const u32x4*)(XB + (size_t)(row0 + ai * HALF + m * 16) * ldc + col0 + bj * HALF);
#pragma unroll
            for (int m = 0; m < 4; ++m) { const int row = row0 + ai * HALF + m * 16; const float sc = rs[4 * ai + m]; bf16_t* rowp = XB + (size_t)row * ldc + col0;
#pragma unroll
                for (int bj = 0; bj < 2; ++bj) { const u32x4 x = xin[m][bj]; const f32x4 v0 = acc[ai][bj][m][0] * sc, v1 = acc[ai][bj][m][1] * sc;
                    u32x4 w; w.x = cvt_pk_bf16(__uint_as_float(x.x << 16) + v0[0], __uint_as_float(x.x & 0xffff0000u) + v0[1]); w.y = cvt_pk_bf16(__uint_as_float(x.y << 16) + v0[2], __uint_as_float(x.y & 0xffff0000u) + v0[3]);
                    w.z = cvt_pk_bf16(__uint_as_float(x.z << 16) + v1[0], __uint_as_float(x.z & 0xffff0000u) + v1[1]); w.w = cvt_pk_bf16(__uint_as_float(x.w << 16) + v1[2], __uint_as_float(x.w & 0xffff0000u) + v1[3]);
                    *(u32x4*)(rowp + bj * HALF) = w; } } }
    }
};
template <bool GATHER_> struct GroupedOrderT {
    static constexpr bool GATHER = GATHER_;
    const int* rowmap; int G, c;
    __device__ __forceinline__ bool next(int i, Unit& u) const {
        const int L = i * G + c; if (L >= 1024) return false;
        const int e = L >> 6, w = L & 63; u.pm = e * 8 + (w & 7); u.pn = e * 8 + (w >> 3); return true;
    }
    __device__ __forceinline__ void a_ready(const Unit&) const {}
    __device__ __forceinline__ void done(const Unit&) const {}
};
typedef GroupedOrderT<false> GroupedOrder; typedef GroupedOrderT<true> GroupedGatherOrder;
template <class Epi, class Sched, bool ALIGN_EPI = false, bool SP2 = false, bool F8 = false>
__device__ __forceinline__ void gemm_phase(PG8_LAS unsigned char* lds, const Gemm g, const Sched& S, const Epi& E) {
    int tid_ = threadIdx.x; asm volatile("" : "+v"(tid_));
    const int tid = tid_, wid = __builtin_amdgcn_readfirstlane(tid >> 6), lane = tid & 63, wr = wid >> 2, wc = wid & 3, fr = lane & 15, fq = lane >> 4;
    const int K = g.K, nt = K / BK;
    unsigned voffA[2], voffB[2];
#pragma unroll
    for (int i = 0; i < 2; ++i) { int R, C; stage_rc(tid * 16 + i * 8192, R, C); const int Rb = Epi::PERM ? ((R & ~31) + perm32(R & 31)) : R;
        voffA[i] = (unsigned)(R * K + C) * 2u; voffB[i] = (unsigned)(Rb * K + C) * 2u; }
    const size_t kstep = (size_t)(BK * 2);
    const size_t hstep = (size_t)HALF * K * 2;
    const size_t tstep = 2 * hstep;
    const unsigned ldsw = (unsigned)wid * 1024u;
    const int aoff = lds_byte(wr * 64 + fr, fq * 8), boff = lds_byte(wc * 32 + fr, fq * 8);
#define PG8_SA(b, h) (((b) * 2 + (h)) * HTB)
#define PG8_SB(b, h) ((4 + (b) * 2 + (h)) * HTB)
#define PG8_STAGE(bufoff, gbase, voff) do { _Pragma("unroll") for (int _i = 0; _i < 2; ++_i) \
        __builtin_amdgcn_global_load_lds((const unsigned*)((const char*)(gbase) + (voff)[_i]), (PG8_LAS unsigned*)(lds + (bufoff) + ldsw + _i * 8192), 16, 0, 0); } while (0)
#define PG8_LDA(dst, b, h) do { if constexpr (F8) { _Pragma("unroll") for (int m = 0; m < 4; ++m) dst##8[m] = __builtin_shufflevector(*(const PG8_LAS v4i32*)(lds + PG8_SA(b, h) + aoff + m * 2048), *(const PG8_LAS v4i32*)(lds + PG8_SA(b, h) + aoff + m * 2048 + 1024), 0, 1, 2, 3, 4, 5, 6, 7); } \
    else { _Pragma("unroll") for (int m = 0; m < 4; ++m) _Pragma("unroll") for (int k = 0; k < 2; ++k) dst[m][k] = *(const PG8_LAS bf16x8*)(lds + PG8_SA(b, h) + aoff + m * 2048 + k * 1024); } } while (0)
#define PG8_LDB(dst, b, h) do { if constexpr (F8) { _Pragma("unroll") for (int n = 0; n < 2; ++n) dst##8[n] = __builtin_shufflevector(*(const PG8_LAS v4i32*)(lds + PG8_SB(b, h) + boff + n * 2048), *(const PG8_LAS v4i32*)(lds + PG8_SB(b, h) + boff + n * 2048 + 1024), 0, 1, 2, 3, 4, 5, 6, 7); } \
    else { _Pragma("unroll") for (int n = 0; n < 2; ++n) _Pragma("unroll") for (int k = 0; k < 2; ++k) dst[n][k] = *(const PG8_LAS bf16x8*)(lds + PG8_SB(b, h) + boff + n * 2048 + k * 1024); } } while (0)
#define PG8_MMA(ai, bj, At, Bt) do { __builtin_amdgcn_s_setprio(1); _Pragma("unroll") for (int m = 0; m < 4; ++m) _Pragma("unroll") for (int n = 0; n < 2; ++n) { \
        if constexpr (F8) asm volatile("v_mfma_f32_16x16x128_f8f6f4 %0, %1, %2, %0" : "+v"(acc[ai][bj][m][n]) : "v"(Bt##8[n]), "v"(At##8[m]));   \
        else { _Pragma("unroll") for (int k = 0; k < 2; ++k) acc[ai][bj][m][n] = __builtin_amdgcn_mfma_f32_16x16x32_bf16(Bt[n][k], At[m][k], acc[ai][bj][m][n], 0, 0, 0); } } \
        __builtin_amdgcn_s_setprio(0); } while (0)
#define PG8_WAIT_V(n) asm volatile("s_waitcnt vmcnt(" #n ")" ::: "memory")
#define PG8_WAIT_L(n) asm volatile("s_waitcnt lgkmcnt(" #n ")" ::: "memory")
#define PG8_BAR __builtin_amdgcn_s_barrier()
#define PG8_SCHED __builtin_amdgcn_sched_barrier(0)
    Unit cur, nxt; int ui = 0;
    if (!S.next(0, cur)) return;
    f32x4 acc[2][2][4][2];
#pragma unroll
    for (int a = 0; a < 2; ++a)
#pragma unroll
        for (int b = 0; b < 2; ++b)
#pragma unroll
            for (int m = 0; m < 4; ++m)
#pragma unroll
                for (int n = 0; n < 2; ++n) acc[a][b][m][n] = (f32x4){0.f, 0.f, 0.f, 0.f};
    bf16x8 At[4][2], B0[2][2], B1[2][2]; v8i32 At8[4], B08[2], B18[2];
    const char* cA = (const char*)g.A + (size_t)cur.pm * tstep; const char* cB = (const char*)g.Bt + (size_t)cur.pn * tstep;
    float rs[8];
    E.pre(cur, wr, fr, rs);
    S.a_ready(cur);
    if constexpr (SP2) {
        PG8_STAGE(PG8_SB(0, 0), cB, voffB); PG8_STAGE(PG8_SB(0, 1), cB + hstep, voffB); PG8_STAGE(PG8_SA(0, 0), cA, voffA); PG8_STAGE(PG8_SA(0, 1), cA + hstep, voffA);
        if (wr == 1) PG8_BAR;
        PG8_WAIT_V(2); PG8_BAR;
        PG8_STAGE(PG8_SB(1, 0), cB + kstep, voffB); PG8_STAGE(PG8_SA(1, 0), cA + kstep, voffA); PG8_STAGE(PG8_SB(1, 1), cB + hstep + kstep, voffB);
        PG8_WAIT_V(6); PG8_BAR;
    } else {
        PG8_STAGE(PG8_SB(0, 0), cB, voffB); PG8_STAGE(PG8_SA(0, 0), cA, voffA); PG8_STAGE(PG8_SB(0, 1), cB + hstep, voffB); PG8_STAGE(PG8_SA(0, 1), cA + hstep, voffA);
        if (wr == 1) PG8_BAR;
        PG8_WAIT_V(4); PG8_BAR;
        PG8_STAGE(PG8_SB(1, 0), cB + kstep, voffB); PG8_STAGE(PG8_SA(1, 0), cA + kstep, voffA); PG8_STAGE(PG8_SB(1, 1), cB + hstep + kstep, voffB);
        PG8_WAIT_V(6); PG8_BAR;
    }
    for (;;) {
        const bool has_next = S.next(ui + 1, nxt);
        const char* nA = has_next ? (const char*)g.A + (size_t)nxt.pm * tstep : cA; const char* nB = has_next ? (const char*)g.Bt + (size_t)nxt.pn * tstep : cB;
        for (int t = 0; t < nt; t += 2) {
            const bool last = (t == nt - 2);
            const char* a1 = cA + (size_t)(t + 1) * kstep;
            const char* a2 = last ? nA : cA + (size_t)(t + 2) * kstep; const char* b2 = last ? nB : cB + (size_t)(t + 2) * kstep;
            const char* a3 = a2 + kstep; const char* b3 = b2 + kstep;
            if (last && has_next) S.a_ready(nxt);
            if constexpr (SP2) {
            PG8_LDB(B0, 0, 0); PG8_LDB(B1, 0, 1); PG8_SCHED; PG8_LDA(At, 0, 0); PG8_STAGE(PG8_SA(1, 1), a1 + hstep, voffA);
            PG8_WAIT_V(8); PG8_WAIT_L(0); PG8_BAR; PG8_MMA(0, 0, At, B0); PG8_MMA(0, 1, At, B1); PG8_BAR; PG8_SCHED;
            PG8_LDA(At, 0, 1); PG8_STAGE(PG8_SB(0, 0), b2, voffB); PG8_STAGE(PG8_SB(0, 1), b2 + hstep, voffB); PG8_STAGE(PG8_SA(0, 0), a2, voffA);
            PG8_WAIT_V(8); PG8_WAIT_L(0); PG8_BAR; PG8_MMA(1, 0, At, B0); PG8_MMA(1, 1, At, B1); PG8_BAR; PG8_SCHED;
            PG8_LDB(B0, 1, 0); PG8_LDB(B1, 1, 1); PG8_SCHED; PG8_LDA(At, 1, 0); PG8_STAGE(PG8_SA(0, 1), a2 + hstep, voffA);
            PG8_WAIT_V(8); PG8_WAIT_L(0); PG8_BAR; PG8_MMA(0, 0, At, B0); PG8_MMA(0, 1, At, B1); PG8_BAR; PG8_SCHED;
            PG8_LDA(At, 1, 1); PG8_STAGE(PG8_SB(1, 0), b3, voffB); PG8_STAGE(PG8_SB(1, 1), b3 + hstep, voffB); PG8_STAGE(PG8_SA(1, 0), a3, voffA);
            PG8_WAIT_V(8); PG8_WAIT_L(0); PG8_BAR; PG8_MMA(1, 0, At, B0); PG8_MMA(1, 1, At, B1); PG8_BAR; PG8_SCHED;
            } else {
            PG8_LDB(B0, 0, 0); PG8_SCHED; PG8_LDA(At, 0, 0); PG8_STAGE(PG8_SA(1, 1), a1 + hstep, voffA);
            PG8_WAIT_L(8); PG8_BAR; PG8_WAIT_L(0); PG8_MMA(0, 0, At, B0); PG8_BAR; PG8_SCHED;
            PG8_LDB(B1, 0, 1); PG8_STAGE(PG8_SB(0, 0), b2, voffB);
            PG8_BAR; PG8_WAIT_L(0); PG8_MMA(0, 1, At, B1); PG8_BAR;
            PG8_LDA(At, 0, 1); PG8_STAGE(PG8_SA(0, 0), a2, voffA);
            PG8_BAR; PG8_WAIT_L(0); PG8_MMA(1, 0, At, B0); PG8_BAR; PG8_SCHED;
            PG8_STAGE(PG8_SB(0, 1), b2 + hstep, voffB);
            PG8_WAIT_V(6); PG8_BAR; PG8_MMA(1, 1, At, B1); PG8_BAR;
            PG8_LDB(B0, 1, 0); PG8_SCHED; PG8_LDA(At, 1, 0); PG8_STAGE(PG8_SA(0, 1), a2 + hstep, voffA);
            PG8_WAIT_L(8); PG8_BAR; PG8_WAIT_L(0); PG8_MMA(0, 0, At, B0); PG8_BAR; PG8_SCHED;
            PG8_LDB(B1, 1, 1); PG8_STAGE(PG8_SB(1, 0), b3, voffB);
            PG8_BAR; PG8_WAIT_L(0); PG8_MMA(0, 1, At, B1); PG8_BAR;
            PG8_LDA(At, 1, 1); PG8_STAGE(PG8_SA(1, 0), a3, voffA);
            PG8_BAR; PG8_WAIT_L(0); PG8_MMA(1, 0, At, B0); PG8_BAR; PG8_SCHED;
            PG8_STAGE(PG8_SB(1, 1), b3 + hstep, voffB);
            PG8_WAIT_V(6); PG8_BAR; PG8_MMA(1, 1, At, B1); PG8_BAR;
            }
        }
        if constexpr (F8) asm volatile("s_nop 15\n\ts_nop 15" ::: "memory");
        if constexpr (ALIGN_EPI) { if (wr == 0) PG8_BAR; }
        if constexpr (!Epi::AFTER_DRAIN) { E(acc, cur, wr, wc, fr, fq, rs); S.done(cur); }
        if (!has_next) break;
#pragma unroll
        for (int a = 0; a < 2; ++a)
#pragma unroll
            for (int b = 0; b < 2; ++b)
#pragma unroll
                for (int m = 0; m < 4; ++m)
#pragma unroll
                    for (int n = 0; n < 2; ++n) acc[a][b][m][n] = (f32x4){0.f, 0.f, 0.f, 0.f};
        cur = nxt; cA = nA; cB = nB; ++ui;
        E.pre(cur, wr, fr, rs);
        if constexpr (ALIGN_EPI) { if (wr == 1) PG8_BAR; }
    }
    PG8_WAIT_V(0);
    if constexpr (!ALIGN_EPI) { if (wr == 0) PG8_BAR; }
    PG8_BAR;
    if constexpr (Epi::AFTER_DRAIN) { E.fused(acc, cur, wr, wc, fr, fq, lds, wid, lane); S.done(cur); }
#undef PG8_SA
#undef PG8_SB
#undef PG8_STAGE
#undef PG8_LDA
#undef PG8_LDB
#undef PG8_MMA
#undef PG8_WAIT_V
#undef PG8_WAIT_L
#undef PG8_BAR
#undef PG8_SCHED
}

template <class Epi, class Sched, bool ALIGN_EPI = false, bool SP2 = false, bool F8 = false>
__device__ __forceinline__ void gemm_phase_gather(PG8_LAS unsigned char* lds, const Gemm g, const Sched& S, const Epi& E) {
    int tid_ = threadIdx.x; asm volatile("" : "+v"(tid_));
    const int tid = tid_, wid = __builtin_amdgcn_readfirstlane(tid >> 6), lane = tid & 63, wr = wid >> 2, wc = wid & 3, fr = lane & 15, fq = lane >> 4;
    static_assert(SP2 || !Sched::GATHER, "gathered A rows: SP2 loop only");
    const int K = g.K, nt = K / BK;
    unsigned voffA[2], voffB[2];
#pragma unroll
    for (int i = 0; i < 2; ++i) { int R, C; stage_rc(tid * 16 + i * 8192, R, C); const int Rb = Epi::PERM ? ((R & ~31) + perm32(R & 31)) : R;
        voffA[i] = (unsigned)(R * K + C) * 2u; voffB[i] = (unsigned)(Rb * K + C) * 2u; }
    constexpr bool GATHER = Sched::GATHER;
    int RA[2], CA[2];
#pragma unroll
    for (int i = 0; i < 2; ++i) stage_rc(tid * 16 + i * 8192, RA[i], CA[i]);
    const size_t kstep = (size_t)(BK * 2);
    const size_t hstep = (size_t)HALF * K * 2;
    const size_t tstep = 2 * hstep;
    const unsigned ldsw = (unsigned)wid * 1024u;
    const int aoff = lds_byte(wr * 64 + fr, fq * 8), boff = lds_byte(wc * 32 + fr, fq * 8);
#define PG8_SA(b, h) (((b) * 2 + (h)) * HTB)
#define PG8_SB(b, h) ((4 + (b) * 2 + (h)) * HTB)
#define PG8_STAGE(bufoff, gbase, voff) do { _Pragma("unroll") for (int _i = 0; _i < 2; ++_i) \
        __builtin_amdgcn_global_load_lds((const unsigned*)((const char*)(gbase) + (voff)[_i]), (PG8_LAS unsigned*)(lds + (bufoff) + ldsw + _i * 8192), 16, 0, 0); } while (0)
#define PG8_LDA(dst, b, h) do { if constexpr (F8) { _Pragma("unroll") for (int m = 0; m < 4; ++m) dst##8[m] = __builtin_shufflevector(*(const PG8_LAS v4i32*)(lds + PG8_SA(b, h) + aoff + m * 2048), *(const PG8_LAS v4i32*)(lds + PG8_SA(b, h) + aoff + m * 2048 + 1024), 0, 1, 2, 3, 4, 5, 6, 7); } \
    else { _Pragma("unroll") for (int m = 0; m < 4; ++m) _Pragma("unroll") for (int k = 0; k < 2; ++k) dst[m][k] = *(const PG8_LAS bf16x8*)(lds + PG8_SA(b, h) + aoff + m * 2048 + k * 1024); } } while (0)
#define PG8_LDB(dst, b, h) do { if constexpr (F8) { _Pragma("unroll") for (int n = 0; n < 2; ++n) dst##8[n] = __builtin_shufflevector(*(const PG8_LAS v4i32*)(lds + PG8_SB(b, h) + boff + n * 2048), *(const PG8_LAS v4i32*)(lds + PG8_SB(b, h) + boff + n * 2048 + 1024), 0, 1, 2, 3, 4, 5, 6, 7); } \
    else { _Pragma("unroll") for (int n = 0; n < 2; ++n) _Pragma("unroll") for (int k = 0; k < 2; ++k) dst[n][k] = *(const PG8_LAS bf16x8*)(lds + PG8_SB(b, h) + boff + n * 2048 + k * 1024); } } while (0)
#define PG8_MMA(ai, bj, At, Bt) do { __builtin_amdgcn_s_setprio(1); _Pragma("unroll") for (int m = 0; m < 4; ++m) _Pragma("unroll") for (int n = 0; n < 2; ++n) { \
        if constexpr (F8) asm volatile("v_mfma_f32_16x16x128_f8f6f4 %0, %1, %2, %0" : "+v"(acc[ai][bj][m][n]) : "v"(Bt##8[n]), "v"(At##8[m]));   \
        else { _Pragma("unroll") for (int k = 0; k < 2; ++k) acc[ai][bj][m][n] = __builtin_amdgcn_mfma_f32_16x16x32_bf16(Bt[n][k], At[m][k], acc[ai][bj][m][n], 0, 0, 0); } } \
        __builtin_amdgcn_s_setprio(0); } while (0)
#define PG8_WAIT_V(n) asm volatile("s_waitcnt vmcnt(" #n ")" ::: "memory")
#define PG8_WAIT_L(n) asm volatile("s_waitcnt lgkmcnt(" #n ")" ::: "memory")
#define PG8_BAR __builtin_amdgcn_s_barrier()
#define PG8_SCHED __builtin_amdgcn_sched_barrier(0)
    Unit cur, nxt; int ui = 0;
    if (!S.next(0, cur)) return;
    f32x4 acc[2][2][4][2];
#pragma unroll
    for (int a = 0; a < 2; ++a)
#pragma unroll
        for (int b = 0; b < 2; ++b)
#pragma unroll
            for (int m = 0; m < 4; ++m)
#pragma unroll
                for (int n = 0; n < 2; ++n) acc[a][b][m][n] = (f32x4){0.f, 0.f, 0.f, 0.f};
    bf16x8 At[4][2], B0[2][2], B1[2][2]; v8i32 At8[4], B08[2], B18[2];
    const char* cA = GATHER ? (const char*)g.A : (const char*)g.A + (size_t)cur.pm * tstep; const char* cB = (const char*)g.Bt + (size_t)cur.pn * tstep;
    unsigned offC[2][2], offN[2][2];
#define PG8_SETOFF(o, u) do { _Pragma("unroll") for (int _h = 0; _h < 2; ++_h) _Pragma("unroll") for (int _i = 0; _i < 2; ++_i) { \
        if constexpr (GATHER) o[_h][_i] = (unsigned)S.rowmap[(u).pm * BM + _h * HALF + RA[_i]] * (unsigned)(K * 2) + (unsigned)(CA[_i] * 2); \
        else o[_h][_i] = voffA[_i] + (unsigned)(_h * (int)hstep); } } while (0)
    PG8_SETOFF(offC, cur);
#pragma unroll
    for (int _h = 0; _h < 2; ++_h) { offN[_h][0] = offC[_h][0]; offN[_h][1] = offC[_h][1]; }
    float rs[8];
    E.pre(cur, wr, fr, rs);
    S.a_ready(cur);
    if constexpr (SP2) {
        PG8_STAGE(PG8_SB(0, 0), cB, voffB); PG8_STAGE(PG8_SB(0, 1), cB + hstep, voffB); PG8_STAGE(PG8_SA(0, 0), cA, offC[0]); PG8_STAGE(PG8_SA(0, 1), cA, offC[1]);
        if (wr == 1) PG8_BAR;
        PG8_WAIT_V(2); PG8_BAR;
        PG8_STAGE(PG8_SB(1, 0), cB + kstep, voffB); PG8_STAGE(PG8_SA(1, 0), cA + kstep, offC[0]); PG8_STAGE(PG8_SB(1, 1), cB + hstep + kstep, voffB);
        PG8_WAIT_V(6); PG8_BAR;
    } else {
        PG8_STAGE(PG8_SB(0, 0), cB, voffB); PG8_STAGE(PG8_SA(0, 0), cA, voffA); PG8_STAGE(PG8_SB(0, 1), cB + hstep, voffB); PG8_STAGE(PG8_SA(0, 1), cA + hstep, voffA);
        if (wr == 1) PG8_BAR;
        PG8_WAIT_V(4); PG8_BAR;
        PG8_STAGE(PG8_SB(1, 0), cB + kstep, voffB); PG8_STAGE(PG8_SA(1, 0), cA + kstep, voffA); PG8_STAGE(PG8_SB(1, 1), cB + hstep + kstep, voffB);
        PG8_WAIT_V(6); PG8_BAR;
    }
    for (;;) {
        const bool has_next = S.next(ui + 1, nxt);
        const char* nA = GATHER ? cA : (has_next ? (const char*)g.A + (size_t)nxt.pm * tstep : cA); const char* nB = has_next ? (const char*)g.Bt + (size_t)nxt.pn * tstep : cB;
        if constexpr (GATHER) { if (has_next) PG8_SETOFF(offN, nxt); }
        for (int t = 0; t < nt; t += 2) {
            const bool last = (t == nt - 2);
            const char* a1 = cA + (size_t)(t + 1) * kstep;
            const char* a2 = last ? nA : cA + (size_t)(t + 2) * kstep; const char* b2 = last ? nB : cB + (size_t)(t + 2) * kstep;
            const char* a3 = a2 + kstep; const char* b3 = b2 + kstep;
            if (last && has_next) S.a_ready(nxt);
            unsigned o2[2][2];
#pragma unroll
            for (int _h = 0; _h < 2; ++_h)
#pragma unroll
                for (int _i = 0; _i < 2; ++_i) o2[_h][_i] = (GATHER && last) ? offN[_h][_i] : offC[_h][_i];
            if constexpr (SP2) {
            PG8_LDB(B0, 0, 0); PG8_LDB(B1, 0, 1); PG8_SCHED; PG8_LDA(At, 0, 0); PG8_STAGE(PG8_SA(1, 1), a1, offC[1]);
            PG8_WAIT_V(8); PG8_WAIT_L(0); PG8_BAR; PG8_MMA(0, 0, At, B0); PG8_MMA(0, 1, At, B1); PG8_BAR; PG8_SCHED;
            PG8_LDA(At, 0, 1); PG8_STAGE(PG8_SB(0, 0), b2, voffB); PG8_STAGE(PG8_SB(0, 1), b2 + hstep, voffB); PG8_STAGE(PG8_SA(0, 0), a2, o2[0]);
            PG8_WAIT_V(8); PG8_WAIT_L(0); PG8_BAR; PG8_MMA(1, 0, At, B0); PG8_MMA(1, 1, At, B1); PG8_BAR; PG8_SCHED;
            PG8_LDB(B0, 1, 0); PG8_LDB(B1, 1, 1); PG8_SCHED; PG8_LDA(At, 1, 0); PG8_STAGE(PG8_SA(0, 1), a2, o2[1]);
            PG8_WAIT_V(8); PG8_WAIT_L(0); PG8_BAR; PG8_MMA(0, 0, At, B0); PG8_MMA(0, 1, At, B1); PG8_BAR; PG8_SCHED;
            PG8_LDA(At, 1, 1); PG8_STAGE(PG8_SB(1, 0), b3, voffB); PG8_STAGE(PG8_SB(1, 1), b3 + hstep, voffB); PG8_STAGE(PG8_SA(1, 0), a3, o2[0]);
            PG8_WAIT_V(8); PG8_WAIT_L(0); PG8_BAR; PG8_MMA(1, 0, At, B0); PG8_MMA(1, 1, At, B1); PG8_BAR; PG8_SCHED;
            } else {
            PG8_LDB(B0, 0, 0); PG8_SCHED; PG8_LDA(At, 0, 0); PG8_STAGE(PG8_SA(1, 1), a1 + hstep, voffA);
            PG8_WAIT_L(8); PG8_BAR; PG8_WAIT_L(0); PG8_MMA(0, 0, At, B0); PG8_BAR; PG8_SCHED;
            PG8_LDB(B1, 0, 1); PG8_STAGE(PG8_SB(0, 0), b2, voffB);
            PG8_BAR; PG8_WAIT_L(0); PG8_MMA(0, 1, At, B1); PG8_BAR;
            PG8_LDA(At, 0, 1); PG8_STAGE(PG8_SA(0, 0), a2, voffA);
            PG8_BAR; PG8_WAIT_L(0); PG8_MMA(1, 0, At, B0); PG8_BAR; PG8_SCHED;
            PG8_STAGE(PG8_SB(0, 1), b2 + hstep, voffB);
            PG8_WAIT_V(6); PG8_BAR; PG8_MMA(1, 1, At, B1); PG8_BAR;
            PG8_LDB(B0, 1, 0); PG8_SCHED; PG8_LDA(At, 1, 0); PG8_STAGE(PG8_SA(0, 1), a2 + hstep, voffA);
            PG8_WAIT_L(8); PG8_BAR; PG8_WAIT_L(0); PG8_MMA(0, 0, At, B0); PG8_BAR; PG8_SCHED;
            PG8_LDB(B1, 1, 1); PG8_STAGE(PG8_SB(1, 0), b3, voffB);
            PG8_BAR; PG8_WAIT_L(0); PG8_MMA(0, 1, At, B1); PG8_BAR;
            PG8_LDA(At, 1, 1); PG8_STAGE(PG8_SA(1, 0), a3, voffA);
            PG8_BAR; PG8_WAIT_L(0); PG8_MMA(1, 0, At, B0); PG8_BAR; PG8_SCHED;
            PG8_STAGE(PG8_SB(1, 1), b3 + hstep, voffB);
            PG8_WAIT_V(6); PG8_BAR; PG8_MMA(1, 1, At, B1); PG8_BAR;
            }
        }
        if constexpr (F8) asm volatile("s_nop 15\n\ts_nop 15" ::: "memory");
        if constexpr (ALIGN_EPI) { if (wr == 0) PG8_BAR; }
        if constexpr (!Epi::AFTER_DRAIN) { E(acc, cur, wr, wc, fr, fq, rs); S.done(cur); }
        if (!has_next) break;
#pragma unroll
        for (int a = 0; a < 2; ++a)
#pragma unroll
            for (int b = 0; b < 2; ++b)
#pragma unroll
                for (int m = 0; m < 4; ++m)
#pragma unroll
                    for (int n = 0; n < 2; ++n) acc[a][b][m][n] = (f32x4){0.f, 0.f, 0.f, 0.f};
        cur = nxt; cA = nA; cB = nB; ++ui;
        E.pre(cur, wr, fr, rs);
#pragma unroll
        for (int _h = 0; _h < 2; ++_h) { offC[_h][0] = offN[_h][0]; offC[_h][1] = offN[_h][1]; }
        if constexpr (ALIGN_EPI) { if (wr == 1) PG8_BAR; }
    }
    PG8_WAIT_V(0);
    if constexpr (!ALIGN_EPI) { if (wr == 0) PG8_BAR; }
    PG8_BAR;
    if constexpr (Epi::AFTER_DRAIN) { E.fused(acc, cur, wr, wc, fr, fq, lds, wid, lane); S.done(cur); }
#undef PG8_SETOFF
#undef PG8_SA
#undef PG8_SB
#undef PG8_STAGE
#undef PG8_LDA
#undef PG8_LDB
#undef PG8_MMA
#undef PG8_WAIT_V
#undef PG8_WAIT_L
#undef PG8_BAR
#undef PG8_SCHED
}
}

constexpr int D = 2048, BATCH = 4, SEQ = 4096, MTOK = BATCH * SEQ, DEPTH = 2;
constexpr int NIN = 6160, NPROJ = 6144;
constexpr int C_NAQ = 0, C_NAK = 1024, C_NAV = 2048, C_MLQ = 3072, C_MLK = 3584, C_MLV = 4096, C_MLO = 5120, C_GATES = 6144;
constexpr int NE = 16, CAP = 512, DE = 1024, MR = NE * BATCH * CAP;
constexpr float EPS = 1e-6f;

typedef unsigned short bf16;
typedef float f32x4 __attribute__((ext_vector_type(4)));
typedef unsigned v4u __attribute__((ext_vector_type(4)));
typedef unsigned v2u __attribute__((ext_vector_type(2)));
#define LAS __attribute__((address_space(3)))
typedef short bf16x8v __attribute__((ext_vector_type(8)));
typedef short s16x4 __attribute__((ext_vector_type(4)));
constexpr size_t WS_XB8 = 968 * (size_t)(1u << 20);
constexpr size_t WS_SSQ = 6 * (size_t)(1u << 20) + 512 * 1024;
constexpr size_t WS_RSNA = 7 * (size_t)(1u << 20) + 64 * 1024;
constexpr size_t WS_W16F_OFF = 7 * (1u << 20) + 256 * 1024;

constexpr size_t MiB = 1u << 20;
constexpr size_t WS_CTL = 0;
constexpr size_t WS_RSTD = 1 * MiB;
constexpr size_t WS_GATES = 2 * MiB;
constexpr size_t WS_AFF = 3 * MiB;
constexpr size_t WS_TOK = 4 * MiB;
constexpr size_t WS_GATEV = 4 * MiB + 512 * 1024;
constexpr size_t WS_SEL = 5 * MiB;
constexpr size_t WS_WIN = 8 * MiB;
constexpr size_t WS_WOUT = 56 * MiB;
constexpr size_t WS_WGU = 72 * MiB;
constexpr size_t WS_WD = 328 * MiB;
constexpr size_t WS_XB = 456 * MiB;
constexpr size_t WS_MIX = 520 * MiB;
constexpr size_t WS_P = 584 * MiB;
constexpr size_t WS_NAO = 776 * MiB;
constexpr size_t WS_HF = 840 * MiB;
constexpr size_t WS_ACT = 712 * MiB;
constexpr size_t WS_Y = 776 * MiB;
constexpr size_t WS_END = 1000 * MiB;

__device__ __forceinline__ unsigned f2bf(float f) { unsigned u = __builtin_bit_cast(unsigned, f); return (u + 0x7fffu + ((u >> 16) & 1u)) >> 16; }
__device__ __forceinline__ unsigned pk2(float lo, float hi) { return f2bf(lo) | (f2bf(hi) << 16); }
typedef float pk_f32x2 __attribute__((ext_vector_type(2)));
typedef __bf16 pk_bf16x2 __attribute__((ext_vector_type(2)));
__device__ __forceinline__ unsigned pk2n(float lo, float hi) { const pk_f32x2 v = {lo, hi}; return __builtin_bit_cast(unsigned, __builtin_convertvector(v, pk_bf16x2)); }
__device__ __forceinline__ unsigned f2bfn(float f) { return pk2n(f, f) & 0xffffu; }
__device__ __forceinline__ float bf2f(unsigned short b) { return __builtin_bit_cast(float, ((unsigned)b) << 16); }
__device__ __forceinline__ float bflo(unsigned w) { return __builtin_bit_cast(float, w << 16); }
__device__ __forceinline__ float bfhi(unsigned w) { return __builtin_bit_cast(float, w & 0xffff0000u); }
__device__ __forceinline__ float row_ror(float v, int n) { return n == 8 ? __uint_as_float(__builtin_amdgcn_update_dpp(0, __float_as_uint(v), 0x128, 0xf, 0xf, false)) : n == 4 ? __uint_as_float(__builtin_amdgcn_update_dpp(0, __float_as_uint(v), 0x124, 0xf, 0xf, false))
        : n == 2 ? __uint_as_float(__builtin_amdgcn_update_dpp(0, __float_as_uint(v), 0x122, 0xf, 0xf, false)) : __uint_as_float(__builtin_amdgcn_update_dpp(0, __float_as_uint(v), 0x121, 0xf, 0xf, false)); }
__device__ __forceinline__ float row16_sum(float v) { v += row_ror(v, 8); v += row_ror(v, 4); v += row_ror(v, 2); v += row_ror(v, 1); return v; }
__device__ __forceinline__ float row16_max(float v) { v = fmaxf(v, row_ror(v, 8)); v = fmaxf(v, row_ror(v, 4)); v = fmaxf(v, row_ror(v, 2)); v = fmaxf(v, row_ror(v, 1)); return v; }
__device__ __forceinline__ float rows4_sum(float v) {
    auto a = __builtin_amdgcn_permlane16_swap(__float_as_uint(v), __float_as_uint(v), false, false); v = __uint_as_float(a[0]) + __uint_as_float(a[1]);
    auto b = __builtin_amdgcn_permlane32_swap(__float_as_uint(v), __float_as_uint(v), false, false); return __uint_as_float(b[0]) + __uint_as_float(b[1]); }
__device__ __forceinline__ float rows4_max(float v) {
    auto a = __builtin_amdgcn_permlane16_swap(__float_as_uint(v), __float_as_uint(v), false, false); v = fmaxf(__uint_as_float(a[0]), __uint_as_float(a[1]));
    auto b = __builtin_amdgcn_permlane32_swap(__float_as_uint(v), __float_as_uint(v), false, false); return fmaxf(__uint_as_float(b[0]), __uint_as_float(b[1])); }
__device__ __forceinline__ float wave_sum(float v) { return rows4_sum(row16_sum(v)); }
__device__ __forceinline__ float wave_max(float v) { return rows4_max(row16_max(v)); }

struct ConvItem { const float* W; const float* gk; bf16* WT; int ldw, K, k0, n0, dmode, f8; float wmul; };
template <class T> __device__ __forceinline__ T* uni_ptr(T* p) { const unsigned long long v = (unsigned long long)p;
    const unsigned lo = __builtin_amdgcn_readfirstlane((unsigned)v), hi = __builtin_amdgcn_readfirstlane((unsigned)(v >> 32)); return (T*)(((unsigned long long)hi << 32) | lo); }
__device__ __forceinline__ void ti_load(const ConvItem& d, int lane, f32x4 (&wv)[16], f32x4 (&gv)[2]) {
    const int r4 = lane >> 4, c4 = (lane & 15) * 4;
    const float* gp = uni_ptr(d.gk ? d.gk + d.k0 : d.W);
    const unsigned gvo = 32u * (lane & 7);
    asm volatile("global_load_dwordx4 %0, %1, %2" : "=v"(gv[0]) : "v"(gvo), "s"(gp) : "memory");
    asm volatile("global_load_dwordx4 %0, %1, %2 offset:16" : "=v"(gv[1]) : "v"(gvo), "s"(gp) : "memory");
    const unsigned voff = (unsigned)(r4 * d.ldw + c4) * 4u;
#pragma unroll
    for (int i = 0; i < 16; ++i) { const float* p = uni_ptr(d.W + (size_t)(d.k0 + 4 * i) * d.ldw + d.n0); asm volatile("global_load_dwordx4 %0, %1, %2" : "=v"(wv[i]) : "v"(voff), "s"(p) : "memory"); }
}
template <int N> __device__ __forceinline__ void ti_wait(f32x4 (&wv)[16], f32x4 (&gv)[2]) {
    asm volatile("s_waitcnt vmcnt(%18)" : "+v"(wv[0]), "+v"(wv[1]), "+v"(wv[2]), "+v"(wv[3]), "+v"(wv[4]), "+v"(wv[5]), "+v"(wv[6]), "+v"(wv[7]), "+v"(wv[8]), "+v"(wv[9]), "+v"(wv[10]), "+v"(wv[11]),
                 "+v"(wv[12]), "+v"(wv[13]), "+v"(wv[14]), "+v"(wv[15]), "+v"(gv[0]), "+v"(gv[1]) : "n"(N) : "memory");
}
__device__ __forceinline__ unsigned cvt2bf(float lo, float hi) { unsigned r; asm("v_cvt_pk_bf16_f32 %0, %1, %2" : "=v"(r) : "v"(lo), "v"(hi)); return r; }
__device__ __forceinline__ void ti_finish(const ConvItem& d, int lane, const f32x4 (&wv)[16], const f32x4 (&gv)[2], LAS float* scr) {
    const int r4 = lane >> 4, c4 = (lane & 15) * 4;
#pragma unroll
    for (int i = 0; i < 16; ++i) { const int kk = 4 * i + r4; LAS float* p = scr + kk * 65 + c4; p[0] = wv[i][0]; p[1] = wv[i][1]; p[2] = wv[i][2]; p[3] = wv[i][3]; }
    asm volatile("s_waitcnt lgkmcnt(0)" ::: "memory");
    const int c = lane & 7; const float wmul = d.wmul;
    const bool hg = d.gk != nullptr;
    const float m0 = (hg ? gv[0][0] : 1.f) * wmul, m1 = (hg ? gv[0][1] : 1.f) * wmul, m2 = (hg ? gv[0][2] : 1.f) * wmul, m3 = (hg ? gv[0][3] : 1.f) * wmul,
                m4 = (hg ? gv[1][0] : 1.f) * wmul, m5 = (hg ? gv[1][1] : 1.f) * wmul, m6 = (hg ? gv[1][2] : 1.f) * wmul, m7 = (hg ? gv[1][3] : 1.f) * wmul;
    const int es = d.f8 ? 1 : 2;
    const unsigned svo = (unsigned)((lane >> 3) * d.K + 8 * c) * (unsigned)es;
    const int rb0 = d.dmode == 0 ? d.n0 : ((d.n0 >> 4) * 32 + (d.dmode == 2 ? 16 : 0));
    const LAS float* s0 = scr + (8 * c) * 65 + (lane >> 3);
#pragma unroll
    for (int j = 0; j < 8; ++j) { const LAS float* s = s0 + 8 * j;
        const int rb = rb0 + (d.dmode == 0 ? 8 * j : 32 * (j >> 1) + 8 * (j & 1));
        unsigned char* sp = uni_ptr((unsigned char*)d.WT + ((size_t)rb * d.K + d.k0) * es);
        const float y0 = s[0 * 65] * m0, y1 = s[1 * 65] * m1, y2 = s[2 * 65] * m2, y3 = s[3 * 65] * m3, y4 = s[4 * 65] * m4, y5 = s[5 * 65] * m5, y6 = s[6 * 65] * m6, y7 = s[7 * 65] * m7;
        if (d.f8) { v2u o8; int p = __builtin_amdgcn_cvt_pk_fp8_f32(y0, y1, 0, false); p = __builtin_amdgcn_cvt_pk_fp8_f32(y2, y3, p, true); o8.x = (unsigned)p;
            p = __builtin_amdgcn_cvt_pk_fp8_f32(y4, y5, 0, false); p = __builtin_amdgcn_cvt_pk_fp8_f32(y6, y7, p, true); o8.y = (unsigned)p;
            asm volatile("global_store_dwordx2 %0, %1, %2" : : "v"(svo), "v"(o8), "s"(sp) : "memory"); }
        else { v4u o; o.x = cvt2bf(y0, y1); o.y = cvt2bf(y2, y3); o.z = cvt2bf(y4, y5); o.w = cvt2bf(y6, y7);
            asm volatile("global_store_dwordx4 %0, %1, %2" : : "v"(svo), "v"(o), "s"(sp) : "memory"); } }
    asm volatile("s_waitcnt lgkmcnt(0)" ::: "memory");
}
constexpr int CONV_SCR_BYTES = 64 * 65 * 4;
constexpr float Y8_SCALE = 16.0f;
typedef float f32x2 __attribute__((ext_vector_type(2)));
constexpr int NPROJ16 = 5120;
constexpr float W8_SCALE = 64.0f;
struct ConvArgs { const float *w_in, *w_out, *w_gate, *w_up, *w_down, *norm_mix_g, *norm_ffn_g, *na_norm_g; unsigned char* ws; };
constexpr int CI_IN = 32 * 96, CI_OUT = 32 * 32, CI_G = 16 * 32 * 16, CI_D = 16 * 16 * 32, CI_LAYER = CI_IN + CI_OUT + 2 * CI_G + CI_D;
__device__ __forceinline__ ConvItem convert_decode(const ConvArgs& a, int it) {
    ConvItem d; d.f8 = 0; d.wmul = 1.0f; d.gk = nullptr; d.dmode = 0; d.K = D;
    const int l = it / CI_LAYER; int r = it % CI_LAYER;
    if (r < CI_IN) { const int kb = r / 96, nb = r % 96; d.ldw = NIN; d.gk = a.norm_mix_g + l * D; d.k0 = 64 * kb;
        if (64 * nb < NPROJ16) { d.W = a.w_in + (size_t)l * D * NIN; d.WT = (bf16*)(a.ws + WS_WIN) + (size_t)l * NPROJ * D; d.n0 = 64 * nb; }
        else { d.W = a.w_in + (size_t)l * D * NIN + NPROJ16; d.WT = (bf16*)(a.ws + WS_WIN + ((size_t)l * NPROJ + NPROJ16) * D * 2); d.n0 = 64 * nb - NPROJ16; d.f8 = 1; d.wmul = W8_SCALE; }
        return d; }
    r -= CI_IN;
    if (r < CI_OUT) { const int kb = r / 32, nb = r % 32; d.W = a.w_out + (size_t)l * D * D; d.ldw = D; if (64 * kb < 1024) d.gk = a.na_norm_g + l * 1024;
        d.WT = (bf16*)(a.ws + WS_WOUT) + (size_t)l * D * D; d.k0 = 64 * kb; d.n0 = 64 * nb; return d; }
    r -= CI_OUT;
    if (r < 2 * CI_G) { const int up = r >= CI_G; if (up) r -= CI_G; const int e = r / 512, q = r % 512, kb = q / 16, nb = q % 16;
        d.W = (up ? a.w_up : a.w_gate) + ((size_t)l * NE + e) * D * DE; d.ldw = DE; d.gk = a.norm_ffn_g + l * D; d.WT = (bf16*)(a.ws + WS_WGU + ((size_t)l * NE + e) * 2048 * D); d.k0 = 64 * kb; d.n0 = 64 * nb; d.dmode = up ? 2 : 1; d.f8 = 1; d.wmul = W8_SCALE; return d; }
    r -= 2 * CI_G;
    { const int e = r / 512, q = r % 512, kb = q / 32, nb = q % 32; d.W = a.w_down + ((size_t)l * NE + e) * DE * D; d.ldw = D; d.WT = (bf16*)(a.ws + WS_WD + ((size_t)l * NE + e) * D * DE); d.K = DE; d.k0 = 64 * kb; d.n0 = 64 * nb; d.f8 = 1; d.wmul = W8_SCALE; return d; }
}
__device__ __forceinline__ void convert_stream(const ConvArgs& a, int first_, int stride, int end, LAS float* scr, int lane) {
    const int first = __builtin_amdgcn_readfirstlane(first_);
    if (first >= end) return;
    const int n = (end - first + stride - 1) / stride, last = first + (n - 1) * stride;
    f32x4 w0[16], w1[16], g0[2], g1[2]; ConvItem d0 = convert_decode(a, first), d1 = convert_decode(a, min(first + stride, last)); ti_load(d0, lane, w0, g0); ti_load(d1, lane, w1, g1);
    ti_wait<18>(w0, g0); ti_finish(d0, lane, w0, g0, scr);
    d0 = convert_decode(a, min(first + 2 * stride, last)); ti_load(d0, lane, w0, g0);
#pragma unroll 1
    for (int it = first + stride; it <= last; it += 2 * stride) {
        ti_wait<26>(w1, g1); ti_finish(d1, lane, w1, g1, scr);
        d1 = convert_decode(a, min(it + 2 * stride, last)); ti_load(d1, lane, w1, g1);
        ti_wait<26>(w0, g0); ti_finish(d0, lane, w0, g0, scr);
        d0 = convert_decode(a, min(it + 3 * stride, last)); ti_load(d0, lane, w0, g0);
    }
    asm volatile("s_waitcnt vmcnt(0)" : "+v"(w0[0]), "+v"(w0[1]), "+v"(w0[2]), "+v"(w0[3]), "+v"(w0[4]), "+v"(w0[5]), "+v"(w0[6]), "+v"(w0[7]), "+v"(w0[8]), "+v"(w0[9]), "+v"(w0[10]), "+v"(w0[11]),
                 "+v"(w0[12]), "+v"(w0[13]), "+v"(w0[14]), "+v"(w0[15]), "+v"(g0[0]), "+v"(g0[1]), "+v"(g1[0]), "+v"(g1[1]) : : "memory");
    asm volatile("" : "+v"(w1[0]), "+v"(w1[1]), "+v"(w1[2]), "+v"(w1[3]), "+v"(w1[4]), "+v"(w1[5]), "+v"(w1[6]), "+v"(w1[7]), "+v"(w1[8]), "+v"(w1[9]), "+v"(w1[10]), "+v"(w1[11]),
                 "+v"(w1[12]), "+v"(w1[13]), "+v"(w1[14]), "+v"(w1[15]) : : "memory");
}
#define XB_TMO      128
#define XB_XCNT(j)  (256  + 64 * (j))
#define XB_XSUB(j)  (1280 + 64 * (j))
#define XB_XGEN(j)  (2304 + 64 * (j))
#define XB_TOP      3328
#define XB_TOPGEN   3392
#define XCD_BAR_WORDS 3456
#define XB_SPIN_CAP (1u << 18)

__device__ __forceinline__ unsigned xb_ld(unsigned* p)              { return __hip_atomic_load(p, __ATOMIC_RELAXED, __HIP_MEMORY_SCOPE_AGENT); }
__device__ __forceinline__ unsigned xb_add(unsigned* p, unsigned v) { return __hip_atomic_fetch_add(p, v, __ATOMIC_RELAXED, __HIP_MEMORY_SCOPE_AGENT); }
__device__ __forceinline__ unsigned xb_xcc_id() { return (unsigned)__builtin_amdgcn_s_getreg((3 << 11) | 20) & 0xFu; }
#define XB_SPIN(cond, bar) do { unsigned _sp = 0; while (cond) { __builtin_amdgcn_s_sleep(1); \
    if ((++_sp & 255u) == 0u) { if (xb_ld(&(bar)[XB_TMO])) break; if (_sp > XB_SPIN_CAP) { atomicAdd(&(bar)[XB_TMO], 1u); break; } } } } while (0)

struct XcdBarrier {
    unsigned* bar; unsigned x;
    volatile LAS unsigned* st;
};

__device__ __forceinline__ XcdBarrier xcd_barrier_post(unsigned* bar, volatile LAS unsigned* st) {
    XcdBarrier b; b.bar = bar; b.x = xb_xcc_id(); b.st = st;
    if (threadIdx.x == 0) (void)xb_add(&bar[XB_XCNT(b.x)], 1u);
    return b;
}
__device__ __forceinline__ void xcd_barrier_complete(unsigned* bar, unsigned x, unsigned& nloc, unsigned& nx) {
    const unsigned G = gridDim.x * gridDim.y * gridDim.z;
    unsigned sum, cnt, mine, sp = 0u;
    for (;;) {
        sum = 0u; cnt = 0u; mine = 0u;
#pragma unroll
        for (unsigned j = 0; j < 16; ++j) { const unsigned c = xb_ld(&bar[XB_XCNT(j)]); sum += c; cnt += (c > 0u) ? 1u : 0u; mine = (j == x) ? c : mine; }
        if (sum == G) break;
        __builtin_amdgcn_s_sleep(1);
        if ((++sp & 255u) == 0u) { if (xb_ld(&bar[XB_TMO])) break; if (sp > XB_SPIN_CAP) { atomicAdd(&bar[XB_TMO], 1u); break; } }
    }
    nloc = mine > 0u ? mine : 1u; nx = cnt > 0u ? cnt : 1u;
}

__device__ __forceinline__ void xcd_barrier(const XcdBarrier& b) {
    asm volatile("s_waitcnt vmcnt(0)" ::: "memory");
    __syncthreads();
    if (threadIdx.x == 0) {
        unsigned* bar = b.bar;
        __builtin_amdgcn_s_waitcnt(0);
        unsigned nloc = b.st[0], nx = b.st[1];
        if (nloc == 0u) { xcd_barrier_complete(bar, b.x, nloc, nx); b.st[0] = nloc; b.st[1] = nx; }
        const unsigned old = xb_add(&bar[XB_XSUB(b.x)], 1u);
        const unsigned gen = old / nloc;
        if (old + 1u == (gen + 1u) * nloc) {
            __builtin_amdgcn_fence(__ATOMIC_RELEASE, "agent");
            asm volatile("s_waitcnt vmcnt(0)" ::: "memory");
            const unsigned og = xb_add(&bar[XB_TOP], 1u);
            const unsigned tg = og / nx;
            if (og + 1u == (tg + 1u) * nx) xb_add(&bar[XB_TOPGEN], 1u);
            else XB_SPIN(xb_ld(&bar[XB_TOPGEN]) == tg, bar);
            __builtin_amdgcn_fence(__ATOMIC_ACQUIRE, "agent");
            xb_add(&bar[XB_XGEN(b.x)], 1u);
            asm volatile("s_waitcnt vmcnt(0)" ::: "memory");
        } else {
            XB_SPIN(xb_ld(&bar[XB_XGEN(b.x)]) == gen, bar);
            __builtin_amdgcn_fence(__ATOMIC_ACQUIRE, "agent");
            asm volatile("s_waitcnt vmcnt(0)" ::: "memory");
        }
    }
    __syncthreads();
}

struct RowArgs { const float* src32; const bf16* srcb; const int* sel; const unsigned char* Y; bf16* XB; unsigned char* XB8; float* RSTD; const float* g; const bf16* W16F; const float* bias; float* GATES; float* AFF; float* out; int mode; int wrxb; };
__device__ __forceinline__ void rowpass_finish(const RowArgs& a, int row, int rr, int s0, int s1, f32x4 (&v)[8], int lane) {
    const int b = row / SEQ;
    if (a.sel) {
        const int sw = rr < 4 ? s0 : s1;
        { int yw[16][8]; int cc[16];
#pragma unroll
            for (int k = 0; k < 16; ++k) { const int e = k; cc[k] = __builtin_amdgcn_readlane(sw, ((rr & 3) << 4) + e);
                if (cc[k] >= 0) { const unsigned char* y = a.Y + (size_t)(e * 2048 + b * 512 + cc[k]) * D + 4 * lane;
#pragma unroll
                    for (int j = 0; j < 8; ++j) yw[k][j] = *(const int*)(y + 256 * j); } }
#pragma unroll
            for (int k = 0; k < 16; ++k) if (cc[k] >= 0) {
#pragma unroll
                for (int j = 0; j < 8; ++j) { const f32x2 lo = __builtin_amdgcn_cvt_pk_f32_fp8(yw[k][j], false), hi = __builtin_amdgcn_cvt_pk_f32_fp8(yw[k][j], true);
                    v[j][0] += lo[0] * (1.0f / Y8_SCALE); v[j][1] += lo[1] * (1.0f / Y8_SCALE); v[j][2] += hi[0] * (1.0f / Y8_SCALE); v[j][3] += hi[1] * (1.0f / Y8_SCALE); } } }
    }
    float ss = 0.f;
#pragma unroll
    for (int j = 0; j < 8; ++j) ss += (v[j][0] * v[j][0] + v[j][1] * v[j][1]) + (v[j][2] * v[j][2] + v[j][3] * v[j][3]);
    ss = wave_sum(ss);
    const float rstd = 1.0f / sqrtf(ss * (1.0f / D) + EPS);
    if (a.mode == 2) {
#pragma unroll
        for (int j = 0; j < 8; ++j) { const f32x4 g = *(const f32x4*)(a.g + 4 * lane + 256 * j); *(f32x4*)(a.out + (size_t)row * D + 4 * lane + 256 * j) = v[j] * rstd * g; }
        return;
    }
    if (a.wrxb) {
#pragma unroll
        for (int j = 0; j < 8; ++j) { v2u w; w.x = pk2n(v[j][0], v[j][1]); w.y = pk2n(v[j][2], v[j][3]); *(v2u*)(a.XB + (size_t)row * D + 4 * lane + 256 * j) = w; } }
    if (a.XB8) {
#pragma unroll
        for (int j = 0; j < 8; ++j) *(unsigned*)(a.XB8 + (size_t)row * D + 4 * lane + 256 * j) = pg8::pk4_fp8(v[j][0], v[j][1], v[j][2], v[j][3]); }
    if (lane == 0) a.RSTD[row] = rstd;
}
template <bool SRC32> __device__ __forceinline__ void rowpass_group(const RowArgs& a, int grp, int lane_) {
    int lane = lane_; asm volatile("" : "+v"(lane));
    int s0 = -1, s1 = -1; if (a.sel) { s0 = a.sel[grp * 128 + lane]; s1 = a.sel[grp * 128 + 64 + lane]; }
    f32x4 v[8];
    if constexpr (SRC32) {
        f32x4 vn[8];
#pragma unroll
        for (int j = 0; j < 8; ++j) v[j] = *(const f32x4*)(a.src32 + (size_t)(8 * grp) * D + 4 * lane + 256 * j);
#pragma unroll 1
        for (int rr = 0; rr < 8; ++rr) { const int row = 8 * grp + rr;
            if (rr < 7) {
#pragma unroll
                for (int j = 0; j < 8; ++j) vn[j] = *(const f32x4*)(a.src32 + (size_t)(row + 1) * D + 4 * lane + 256 * j); }
            rowpass_finish(a, row, rr, s0, s1, v, lane);
#pragma unroll
            for (int j = 0; j < 8; ++j) v[j] = vn[j]; }
    } else if (!a.sel) {
        v2u w[8][8];
#pragma unroll
        for (int rr = 0; rr < 8; ++rr)
#pragma unroll
            for (int j = 0; j < 8; ++j) w[rr][j] = *(const v2u*)(a.srcb + (size_t)(8 * grp + rr) * D + 4 * lane + 256 * j);
#pragma unroll
        for (int rr = 0; rr < 8; ++rr) {
#pragma unroll
            for (int j = 0; j < 8; ++j) v[j] = (f32x4){bflo(w[rr][j].x), bfhi(w[rr][j].x), bflo(w[rr][j].y), bfhi(w[rr][j].y)};
            rowpass_finish(a, 8 * grp + rr, rr, s0, s1, v, lane); }
    } else {
        v2u w[8], wn[8];
#pragma unroll
        for (int j = 0; j < 8; ++j) w[j] = *(const v2u*)(a.srcb + (size_t)(8 * grp) * D + 4 * lane + 256 * j);
#pragma unroll 1
        for (int rr = 0; rr < 8; ++rr) { const int row = 8 * grp + rr;
            if (rr < 7) {
#pragma unroll
                for (int j = 0; j < 8; ++j) wn[j] = *(const v2u*)(a.srcb + (size_t)(row + 1) * D + 4 * lane + 256 * j); }
#pragma unroll
            for (int j = 0; j < 8; ++j) v[j] = (f32x4){bflo(w[j].x), bfhi(w[j].x), bflo(w[j].y), bfhi(w[j].y)};
            rowpass_finish(a, row, rr, s0, s1, v, lane);
#pragma unroll
            for (int j = 0; j < 8; ++j) w[j] = wn[j]; }
    }
    if (a.mode == 2) return;
    asm volatile("s_waitcnt vmcnt(0)" ::: "memory");
    const int g = lane >> 4, lc = lane & 15;
    f32x4 acc = (f32x4){0.f, 0.f, 0.f, 0.f};
    const bf16* xr = a.XB + (size_t)(8 * grp + (lc & 7)) * D + 8 * g; const bf16* wf = a.W16F + lane * 8;
    { bf16x8v fa[2][8], fb[2][8]; const bf16x8v zero8 = (bf16x8v){0, 0, 0, 0, 0, 0, 0, 0};
#pragma unroll
      for (int s = 0; s < 8; ++s) { fa[0][s] = *(const bf16x8v*)(xr + 32 * s); fb[0][s] = *(const bf16x8v*)(wf + s * 512); }
#pragma unroll
      for (int q = 0; q < 8; ++q) {
          if (q < 7) {
#pragma unroll
              for (int s = 0; s < 8; ++s) { fa[(q + 1) & 1][s] = *(const bf16x8v*)(xr + 32 * (8 * (q + 1) + s)); fb[(q + 1) & 1][s] = *(const bf16x8v*)(wf + (8 * (q + 1) + s) * 512); } }
#pragma unroll
          for (int s = 0; s < 8; ++s) acc = __builtin_amdgcn_mfma_f32_16x16x32_bf16(lc >= 8 ? zero8 : fa[q & 1][s], fb[q & 1][s], acc, 0, 0, 0); } }
    float rs[4];
#pragma unroll
    for (int r = 0; r < 4; ++r) rs[r] = a.RSTD[8 * grp + 4 * (g & 1) + r];
    if (a.mode == 0) { const float bs = a.bias[lc];
#pragma unroll
        for (int r = 0; r < 4; ++r) { const float rstd = rs[r]; if (g < 2) a.GATES[(size_t)(8 * grp + 4 * g + r) * 16 + lc] = acc[r] * rstd + bs; } }
    else {
#pragma unroll
        for (int r = 0; r < 4; ++r) { const float rstd = rs[r]; const float lg = acc[r] * rstd; float mx = lg;
#pragma unroll
            for (int o = 1; o < 16; o <<= 1) mx = fmaxf(mx, __shfl_xor(mx, o));
            const float p = __expf(lg - mx); float sum = p;
#pragma unroll
            for (int o = 1; o < 16; o <<= 1) sum += __shfl_xor(sum, o);
            const int row = 8 * grp + 4 * g + r; if (g < 2) a.AFF[((size_t)(row / SEQ) * NE + lc) * SEQ + (row % SEQ)] = p / sum; } }
}
__device__ __forceinline__ void w16f_item(const float* W, int ldw, const float* gk, bf16* WF, int s, int lane) {
    const int g = lane >> 4, lc = lane & 15; float v[8];
#pragma unroll
    for (int i = 0; i < 8; ++i) { const int k = 32 * s + 8 * g + i; v[i] = W[(size_t)k * ldw + lc] * gk[k]; }
    v4u o; o.x = pk2n(v[0], v[1]); o.y = pk2n(v[2], v[3]); o.z = pk2n(v[4], v[5]); o.w = pk2n(v[6], v[7]);
    *(v4u*)(WF + (size_t)(s * 64 + lane) * 8) = o;
}

__device__ __forceinline__ void na_norm_item(const bf16* NAO, const float* g, bf16* MIX, int t, int lane) {
    f32x4 v[4]; float ss = 0.f;
#pragma unroll
    for (int j = 0; j < 4; ++j) { const v2u w = *(const v2u*)(NAO + (size_t)t * 1024 + 4 * lane + 256 * j); v[j] = (f32x4){bflo(w.x), bfhi(w.x), bflo(w.y), bfhi(w.y)}; ss += (v[j][0] * v[j][0] + v[j][1] * v[j][1]) + (v[j][2] * v[j][2] + v[j][3] * v[j][3]); }
    const float rstd = 1.0f / sqrtf(wave_sum(ss) * (1.0f / 1024.0f) + EPS);
#pragma unroll
    for (int j = 0; j < 4; ++j) { const f32x4 gg = *(const f32x4*)(g + 4 * lane + 256 * j); const f32x4 o = v[j] * rstd * gg; v2u w; w.x = pk2n(o[0], o[1]); w.y = pk2n(o[2], o[3]);
        *(v2u*)(MIX + (size_t)t * D + 4 * lane + 256 * j) = w; }
}

__device__ __forceinline__ int block_sum_512(int v, LAS int* red, int wave, int lane) {
#pragma unroll
    for (int o = 1; o < 64; o <<= 1) v += __shfl_xor(v, o);
    __syncthreads();
    if (lane == 0) red[wave] = v;
    __syncthreads();
    int s = 0;
#pragma unroll
    for (int w = 0; w < 8; ++w) s += red[w];
    return s;
}
__device__ __forceinline__ int block_excl_scan_512(int v, LAS int* red, int wave, int lane) {
    int inc = v;
#pragma unroll
    for (int o = 1; o < 64; o <<= 1) { const int t = __shfl_up(inc, o); if (lane >= o) inc += t; }
    __syncthreads();
    if (lane == 63) red[wave] = inc;
    __syncthreads();
    int base = 0;
#pragma unroll
    for (int w = 0; w < 8; ++w) base += (w < wave) ? red[w] : 0;
    return base + inc - v;
}
__device__ __forceinline__ void topk_unit(int be, const float* AFF, int* TOK, float* GATEV, int* SEL, LAS int* red) {
    int tid_ = threadIdx.x; asm volatile("" : "+v"(tid_)); const int tid = tid_, lane = tid & 63, wave = tid >> 6;
    const int b = be >> 4, e = be & 15;
    const float* a = AFF + (size_t)be * SEQ + tid * 8;
    const f32x4 a0 = *(const f32x4*)a, a1 = *(const f32x4*)(a + 4);
    unsigned key[8] = {__float_as_uint(a0.x), __float_as_uint(a0.y), __float_as_uint(a0.z), __float_as_uint(a0.w),
                       __float_as_uint(a1.x), __float_as_uint(a1.y), __float_as_uint(a1.z), __float_as_uint(a1.w)};
    LAS int* hist = red + 16;
    unsigned T = 0u; int need = CAP;
#pragma unroll 1
    for (int pass = 0; pass < 4; ++pass) { const int shift = 24 - 8 * pass; const unsigned mhi = pass == 0 ? 0u : (0xFFFFFFFFu << (shift + 8));
        __syncthreads();
        if (tid < 256) hist[tid] = 0;
        __syncthreads();
#pragma unroll
        for (int i = 0; i < 8; ++i) if ((key[i] & mhi) == T) (void)__hip_atomic_fetch_add(&hist[(key[i] >> shift) & 255u], 1, __ATOMIC_RELAXED, __HIP_MEMORY_SCOPE_WORKGROUP);
        __syncthreads();
        if (wave == 0) { const int c0 = hist[4 * lane], c1 = hist[4 * lane + 1], c2 = hist[4 * lane + 2], c3 = hist[4 * lane + 3]; const int t = c0 + c1 + c2 + c3; int inc = t;
#pragma unroll
            for (int o = 1; o < 64; o <<= 1) { const int v = __shfl_down(inc, o); if (lane + o < 64) inc += v; }
            const int ab3 = inc - t, ab2 = ab3 + c3, ab1 = ab2 + c2, ab0 = ab1 + c1;
            if (ab3 < need && need <= ab3 + c3) { red[8] = 4 * lane + 3; red[9] = ab3; }
            if (ab2 < need && need <= ab2 + c2) { red[8] = 4 * lane + 2; red[9] = ab2; }
            if (ab1 < need && need <= ab1 + c1) { red[8] = 4 * lane + 1; red[9] = ab1; }
            if (ab0 < need && need <= ab0 + c0) { red[8] = 4 * lane + 0; red[9] = ab0; } }
        __syncthreads();
        T |= (unsigned)red[8] << shift; need -= red[9]; }
    int ceq = 0;
#pragma unroll
    for (int i = 0; i < 8; ++i) ceq += key[i] == T ? 1 : 0;
    const int need_eq = need;
    int eqrank = block_excl_scan_512(ceq, red, wave, lane);
    int selm = 0, csel = 0;
#pragma unroll
    for (int i = 0; i < 8; ++i) { bool sel = key[i] > T; if (key[i] == T) { sel = eqrank < need_eq; ++eqrank; } if (sel) { selm |= 1 << i; ++csel; } }
    int slot = block_excl_scan_512(csel, red, wave, lane);
#pragma unroll
    for (int i = 0; i < 8; ++i) { const int sidx = tid * 8 + i; const int tok = b * SEQ + sidx;
        if (selm & (1 << i)) { const int R = e * 2048 + b * 512 + slot; TOK[R] = tok; GATEV[R] = __uint_as_float(key[i]); SEL[tok * 16 + e] = slot; ++slot; }
        else SEL[tok * 16 + e] = -1; }
    __syncthreads();
}

typedef short bf16x8v __attribute__((ext_vector_type(8)));
typedef short s16x4 __attribute__((ext_vector_type(4)));
constexpr int ML_L = 128, ML_NC = SEQ / ML_L;
constexpr int KP = 272, VP = 528;
constexpr int ML_T0 = 0, ML_T1 = 128 * KP, ML_V = 2 * 128 * KP;
constexpr int ML_AR = ML_V + 128 * VP;
constexpr int ML_END = ML_AR + 24 * 512;
static_assert(ML_AR % 16 == 0, "LDS map");
constexpr size_t WS_UC = WS_HF;
constexpr size_t WS_NU = 6 * MiB;
constexpr size_t WS_SC = 7 * MiB;

__device__ __forceinline__ s16x4 lds_tr(LAS unsigned char* p) { return __builtin_amdgcn_ds_read_tr16_b64_v4i16((LAS s16x4*)p); }
__device__ __forceinline__ bf16x8v frag_tr(LAS unsigned char* tile, int pitch, int k0, int n0, int lane) {
    const int g = lane >> 4, q = (lane & 15) >> 2, p = lane & 3;
    LAS unsigned char* a = tile + (k0 + 8 * g + q) * pitch + (n0 + 4 * p) * 2;
    const s16x4 lo = lds_tr(a), hi = lds_tr(a + 4 * pitch);
    return (bf16x8v){lo[0], lo[1], lo[2], lo[3], hi[0], hi[1], hi[2], hi[3]};
}
__device__ __forceinline__ bf16x8v frag_row(LAS unsigned char* tile, int pitch, int m0, int k0, int lane) {
    return *(LAS bf16x8v*)(tile + (m0 + (lane & 15)) * pitch + (k0 + 8 * (lane >> 4)) * 2);
}
__device__ __forceinline__ float log_sigmoid_f(float f) { return fminf(f, 0.f) - log1pf(__expf(-fabsf(f))); }
__device__ __forceinline__ float shfl_up_f(float v, int o, int lane, float ident) { const float t = __shfl_up(v, o); return lane >= o ? t : ident; }

__device__ __forceinline__ void chunk_gates(const float* GATES, int t0, int h, int dir, int lane, int& s0, int& s1, float& i0, float& i1, float& b0, float& b1, float& btot) {
    const int p0 = 2 * lane, p1 = p0 + 1; s0 = dir ? 127 - p0 : p0; s1 = dir ? 127 - p1 : p1;
    const int icol = dir * 8 + h, fcol = icol + 4;
    const float* gp = GATES + (size_t)t0 * 16;
    const float f0 = log_sigmoid_f(gp[s0 * 16 + fcol]), f1 = log_sigmoid_f(gp[s1 * 16 + fcol]);
    i0 = gp[s0 * 16 + icol]; i1 = gp[s1 * 16 + icol];
    const float s = f0 + f1; float inc = s;
#pragma unroll
    for (int o = 1; o < 64; o <<= 1) inc += shfl_up_f(inc, o, lane, 0.f);
    const float excl = inc - s; b0 = excl + f0; b1 = excl + s; btot = __shfl(inc, 63);
}


__device__ __forceinline__ void conv_chunk4(const bf16* P, const float* cw, const float* cb, int b, int sq0, int chan0, float (&o)[4][8]) {
    const bf16* pc = P + ((size_t)b * SEQ + sq0) * NPROJ + C_MLQ + chan0;
    v4u w[8];
#pragma unroll
    for (int j = 0; j < 8; ++j) { const int ss = sq0 + j - 2; w[j] = (ss >= 0 && ss < SEQ) ? *(const v4u*)(pc + (ptrdiff_t)(j - 2) * NPROJ) : (v4u){0u, 0u, 0u, 0u}; }
    const f32x4 b0 = *(const f32x4*)(cb + chan0), b1 = *(const f32x4*)(cb + chan0 + 4);
#pragma unroll
    for (int t = 0; t < 4; ++t) { o[t][0] = b0[0]; o[t][1] = b0[1]; o[t][2] = b0[2]; o[t][3] = b0[3]; o[t][4] = b1[0]; o[t][5] = b1[1]; o[t][6] = b1[2]; o[t][7] = b1[3]; }
#pragma unroll
    for (int j = 0; j < 5; ++j) { const f32x4 c0 = *(const f32x4*)(cw + j * 1024 + chan0), c1 = *(const f32x4*)(cw + j * 1024 + chan0 + 4);
#pragma unroll
        for (int t = 0; t < 4; ++t) { const v4u x = w[t + j];
            o[t][0] += c0[0] * bflo(x.x); o[t][1] += c0[1] * bfhi(x.x); o[t][2] += c0[2] * bflo(x.y); o[t][3] += c0[3] * bfhi(x.y);
            o[t][4] += c1[0] * bflo(x.z); o[t][5] += c1[1] * bfhi(x.z); o[t][6] += c1[2] * bflo(x.w); o[t][7] += c1[3] * bfhi(x.w); } }
#pragma unroll
    for (int t = 0; t < 4; ++t)
#pragma unroll
        for (int i = 0; i < 8; ++i) o[t][i] = o[t][i] * __builtin_amdgcn_rcpf(1.0f + __expf(-o[t][i]));
}

__device__ __forceinline__ void mlstm_m1_unit(int u, const float* cw, const float* cb, const bf16* P, const float* GATES, bf16* UC, float* NU, float* SC, LAS unsigned char* lds, int tid_, int wave) {
    int tid = tid_; asm volatile("" : "+v"(tid)); const int lane = tid & 63;
    const int c = u & 31, h = (u >> 5) & 3, b = u >> 7; const int t0 = b * SEQ + c * ML_L;
    LAS float* WK = (LAS float*)(lds + ML_AR);
    LAS float* NRED = WK + 256;
    __syncthreads();
    if (wave < 2) { const int dir = wave; int s0, s1; float i0, i1, b0, b1, btot;
        chunk_gates(GATES, t0, h, dir, lane, s0, s1, i0, i1, b0, b1, btot);
        const float g0 = btot - b0 + i0, g1 = btot - b1 + i1; const float mloc = wave_max(fmaxf(g0, g1));
        WK[dir * 128 + s0] = __expf(g0 - mloc); WK[dir * 128 + s1] = __expf(g1 - mloc);
        if (lane == 0) { float* sc = SC + (size_t)((((b * 4 + h) * 2 + dir) * 32) + c) * 4; sc[0] = btot; sc[1] = mloc; } }
#pragma unroll
    for (int i = 0; i < 8; ++i) { const int id = tid + 512 * i, s = id >> 5, ch = id & 31;
        *(LAS v4u*)(lds + ML_V + s * VP + ch * 16) = *(const v4u*)(P + (size_t)(t0 + s) * NPROJ + C_MLV + h * 256 + ch * 8); }
    float k4[4][8]; conv_chunk4(P, cw, cb, b, c * ML_L + 4 * (tid >> 4), 512 + h * 128 + (tid & 15) * 8, k4);
    __syncthreads();
    { float nf[8], nb[8];
#pragma unroll
      for (int j = 0; j < 8; ++j) { nf[j] = 0.f; nb[j] = 0.f; }
#pragma unroll
      for (int i = 0; i < 4; ++i) { const int s = 4 * (tid >> 4) + i, ch = tid & 15; const float (&k)[8] = k4[i];
        const float wf = WK[s], wb = WK[128 + s];
        v4u of, ob; of.x = pk2n(k[0] * wf, k[1] * wf); of.y = pk2n(k[2] * wf, k[3] * wf); of.z = pk2n(k[4] * wf, k[5] * wf); of.w = pk2n(k[6] * wf, k[7] * wf);
        ob.x = pk2n(k[0] * wb, k[1] * wb); ob.y = pk2n(k[2] * wb, k[3] * wb); ob.z = pk2n(k[4] * wb, k[5] * wb); ob.w = pk2n(k[6] * wb, k[7] * wb);
        *(LAS v4u*)(lds + ML_T0 + s * KP + ch * 16) = of; *(LAS v4u*)(lds + ML_T1 + s * KP + ch * 16) = ob;
#pragma unroll
        for (int j = 0; j < 8; ++j) { nf[j] += k[j] * wf; nb[j] += k[j] * wb; } }
#pragma unroll
      for (int j = 0; j < 8; ++j) { nf[j] += __shfl_xor(nf[j], 16); nf[j] += __shfl_xor(nf[j], 32); nb[j] += __shfl_xor(nb[j], 16); nb[j] += __shfl_xor(nb[j], 32); }
      if ((lane >> 4) == 0) {
#pragma unroll
          for (int j = 0; j < 8; ++j) { NRED[wave * 256 + (lane & 15) * 8 + j] = nf[j]; NRED[wave * 256 + 128 + (lane & 15) * 8 + j] = nb[j]; } } }
    __syncthreads();
    if (tid < 256) { const int dir = tid >> 7, d = tid & 127; float sum = 0.f;
#pragma unroll
        for (int w = 0; w < 8; ++w) sum += NRED[w * 256 + tid];
        NU[(size_t)((((b * 4 + h) * 2 + dir) * 32) + c) * 128 + d] = sum; }
    const int g = lane >> 4;
#pragma unroll 1
    for (int dir = 0; dir < 2; ++dir) {
        LAS unsigned char* Kt = lds + (dir ? ML_T1 : ML_T0);
        f32x4 acc[8][2];
#pragma unroll
        for (int mb = 0; mb < 8; ++mb) { acc[mb][0] = (f32x4){0.f, 0.f, 0.f, 0.f}; acc[mb][1] = (f32x4){0.f, 0.f, 0.f, 0.f}; }
#pragma unroll
        for (int ks = 0; ks < 4; ++ks) {
            const bf16x8v b0 = frag_tr(lds + ML_V, VP, 32 * ks, 32 * wave, lane), b1 = frag_tr(lds + ML_V, VP, 32 * ks, 32 * wave + 16, lane);
#pragma unroll
            for (int mb = 0; mb < 8; ++mb) { const bf16x8v a = frag_tr(Kt, KP, 32 * ks, 16 * mb, lane);
                acc[mb][0] = __builtin_amdgcn_mfma_f32_16x16x32_bf16(a, b0, acc[mb][0], 0, 0, 0); acc[mb][1] = __builtin_amdgcn_mfma_f32_16x16x32_bf16(a, b1, acc[mb][1], 0, 0, 0); } }
        bf16* uc = UC + (size_t)((((b * 4 + h) * 2 + dir) * 32) + c) * 32768;
#pragma unroll
        for (int mb = 0; mb < 8; ++mb)
#pragma unroll
            for (int nb = 0; nb < 2; ++nb) { const int e = 32 * wave + 16 * nb + (lane & 15), d0 = 16 * mb + 4 * g; v2u w; w.x = pk2n(acc[mb][nb][0], acc[mb][nb][1]); w.y = pk2n(acc[mb][nb][2], acc[mb][nb][3]);
                *(v2u*)(uc + e * 128 + d0) = w; }
    }
}

__device__ __forceinline__ void mlstm_m2(bf16* UC, float* NU, float* SC, int gtid, int nthreads) {
    const bool merged = nthreads == 32 * 4096;
    const bool hn = merged && (gtid & 511) < 16; const int nid = (gtid >> 9) * 16 + (gtid & 15); const int nchain = nid >> 7, nd = nid & 127, ndir = nchain & 1;
    float stn = 0.f, mnn = 0.f;
    for (int vid = gtid; vid < 32 * 4096; vid += nthreads) { const int chain = vid >> 12, within = vid & 4095, dir = chain & 1;
        float st[8]; float m = 0.f;
#pragma unroll
        for (int i = 0; i < 8; ++i) st[i] = 0.f;
#pragma unroll 1
        for (int s0 = 0; s0 < ML_NC; s0 += 8) {
            v4u uw[8]; float bt[8], ml[8]; float uun[8], btn[8], mln[8];
#pragma unroll
            for (int k = 0; k < 8; ++k) { const int c = dir ? ML_NC - 1 - (s0 + k) : s0 + k; const float* sc = SC + (size_t)(chain * 32 + c) * 4; bt[k] = sc[0]; ml[k] = sc[1];
                uw[k] = *(const v4u*)(UC + ((size_t)(chain * 32 + c) * 4096 + within) * 8); }
            if (hn) {
#pragma unroll
                for (int k = 0; k < 8; ++k) { const int c = ndir ? ML_NC - 1 - (s0 + k) : s0 + k; const float* sc = SC + (size_t)(nchain * 32 + c) * 4; btn[k] = sc[0]; mln[k] = sc[1]; uun[k] = NU[(size_t)(nchain * 32 + c) * 128 + nd]; } }
#pragma unroll
            for (int k = 0; k < 8; ++k) { const int c = dir ? ML_NC - 1 - (s0 + k) : s0 + k;
                v4u cw; cw.x = pk2(st[0], st[1]); cw.y = pk2(st[2], st[3]); cw.z = pk2(st[4], st[5]); cw.w = pk2(st[6], st[7]);
                *(v4u*)(UC + ((size_t)(chain * 32 + c) * 4096 + within) * 8) = cw;
                if (within == 0) SC[(size_t)(chain * 32 + c) * 4 + 2] = m;
                const float mn = fmaxf(bt[k] + m, ml[k]), dC = __expf(bt[k] + m - mn), dU = __expf(ml[k] - mn);
                const float uu[8] = {bflo(uw[k].x), bfhi(uw[k].x), bflo(uw[k].y), bfhi(uw[k].y), bflo(uw[k].z), bfhi(uw[k].z), bflo(uw[k].w), bfhi(uw[k].w)};
#pragma unroll
                for (int i = 0; i < 8; ++i) st[i] = dC * st[i] + dU * uu[i];
                m = mn; }
            if (hn) {
#pragma unroll
                for (int k = 0; k < 8; ++k) { const int c = ndir ? ML_NC - 1 - (s0 + k) : s0 + k; NU[(size_t)(nchain * 32 + c) * 128 + nd] = stn;
                    const float mn = fmaxf(btn[k] + mnn, mln[k]); stn = __expf(btn[k] + mnn - mn) * stn + __expf(mln[k] - mn) * uun[k]; mnn = mn; } } } }
    if (!merged)
    for (int nid2 = gtid; nid2 < 32 * 128; nid2 += nthreads) { const int chain = nid2 >> 7, d = nid2 & 127, dir = chain & 1; float st = 0.f, m = 0.f;
#pragma unroll 1
        for (int s0 = 0; s0 < ML_NC; s0 += 8) { float uu[8], bt[8], ml[8];
#pragma unroll
            for (int k = 0; k < 8; ++k) { const int c = dir ? ML_NC - 1 - (s0 + k) : s0 + k; const float* sc = SC + (size_t)(chain * 32 + c) * 4; bt[k] = sc[0]; ml[k] = sc[1]; uu[k] = NU[(size_t)(chain * 32 + c) * 128 + d]; }
#pragma unroll
            for (int k = 0; k < 8; ++k) { const int c = dir ? ML_NC - 1 - (s0 + k) : s0 + k; NU[(size_t)(chain * 32 + c) * 128 + d] = st;
                const float mn = fmaxf(bt[k] + m, ml[k]); st = __expf(bt[k] + m - mn) * st + __expf(ml[k] - mn) * uu[k]; m = mn; } } }
}

__device__ __forceinline__ void mlstm_m3_unit(int u, const float* cw, const float* cb, const bf16* P, const float* GATES, const bf16* UC, const float* NU, const float* SC, const float* mlg, const float* RSNA, bf16* MIX, LAS unsigned char* lds, int tid_, int wave) {
    int tid = tid_; asm volatile("" : "+v"(tid)); const int lane = tid & 63;
    const int c = u & 31, h = (u >> 5) & 3, b = u >> 7; const int t0 = b * SEQ + c * ML_L;
    LAS float* AR = (LAS float*)(lds + ML_AR);
    LAS float* CS = AR; LAS float* RR = AR + 256; LAS float* INTER = AR + 512; LAS float* EM = AR + 768; LAS float* ALPHA = AR + 1024; LAS float* SS = AR + 1280;
    const int g = lane >> 4, lc = lane & 15;
    const int chain0 = (b * 4 + h) * 2;
    __syncthreads();
    if (wave < 2) { const int dir = wave; int s0, s1; float i0, i1, b0, b1, btot;
        chunk_gates(GATES, t0, h, dir, lane, s0, s1, i0, i1, b0, b1, btot);
        const float cs0 = i0 - b0, cs1 = i1 - b1;
        float pmx = fmaxf(cs0, cs1);
#pragma unroll
        for (int o = 1; o < 64; o <<= 1) pmx = fmaxf(pmx, shfl_up_f(pmx, o, lane, -3.0e38f));
        const float ex = shfl_up_f(pmx, 1, lane, -3.0e38f);
        const float pm0 = fmaxf(ex, cs0), pm1 = fmaxf(pm0, cs1);
        const float m_in = SC[(size_t)((chain0 + dir) * 32 + c) * 4 + 2];
        const float M0 = b0 + fmaxf(m_in, pm0), M1 = b1 + fmaxf(m_in, pm1);
        CS[dir * 128 + s0] = cs0; CS[dir * 128 + s1] = cs1; RR[dir * 128 + s0] = b0 - M0; RR[dir * 128 + s1] = b1 - M1;
        INTER[dir * 128 + s0] = __expf(b0 + m_in - M0); INTER[dir * 128 + s1] = __expf(b1 + m_in - M1); EM[dir * 128 + s0] = __expf(-M0); EM[dir * 128 + s1] = __expf(-M1); }
    { const int s0 = 4 * (tid >> 4), ch = tid & 15; float x4[4][8];
      conv_chunk4(P, cw, cb, b, c * ML_L + s0, h * 128 + ch * 8, x4);
      const float qs = 0.08838834764831845f;
#pragma unroll
      for (int i = 0; i < 4; ++i) { v4u oq; oq.x = pk2n(x4[i][0] * qs, x4[i][1] * qs); oq.y = pk2n(x4[i][2] * qs, x4[i][3] * qs); oq.z = pk2n(x4[i][4] * qs, x4[i][5] * qs); oq.w = pk2n(x4[i][6] * qs, x4[i][7] * qs);
          *(LAS v4u*)(lds + ML_T0 + (s0 + i) * KP + ch * 16) = oq; }
      conv_chunk4(P, cw, cb, b, c * ML_L + s0, 512 + h * 128 + ch * 8, x4);
#pragma unroll
      for (int i = 0; i < 4; ++i) { v4u ok; ok.x = pk2n(x4[i][0], x4[i][1]); ok.y = pk2n(x4[i][2], x4[i][3]); ok.z = pk2n(x4[i][4], x4[i][5]); ok.w = pk2n(x4[i][6], x4[i][7]);
          *(LAS v4u*)(lds + ML_T1 + (s0 + i) * KP + ch * 16) = ok; } }
#pragma unroll
    for (int i = 0; i < 8; ++i) { const int id = tid + 512 * i, s = id >> 5, ch = id & 31;
        *(LAS v4u*)(lds + ML_V + s * VP + ch * 16) = *(const v4u*)(P + (size_t)(t0 + s) * NPROJ + C_MLV + h * 256 + ch * 8); }
    __syncthreads();
    f32x4 S[8], qn = (f32x4){0.f, 0.f, 0.f, 0.f};
#pragma unroll
    for (int nb = 0; nb < 8; ++nb) S[nb] = (f32x4){0.f, 0.f, 0.f, 0.f};
#pragma unroll
    for (int ks = 0; ks < 4; ++ks) { const bf16x8v a = frag_row(lds + ML_T0, KP, 16 * wave, 32 * ks, lane);
        bf16x8v nf = (bf16x8v){0, 0, 0, 0, 0, 0, 0, 0};
        if (lc < 2) { const float* np = NU + (size_t)((chain0 + lc) * 32 + c) * 128 + 32 * ks + 8 * g; const f32x4 n0 = *(const f32x4*)np, n1 = *(const f32x4*)(np + 4);
            const unsigned w0 = pk2(n0[0], n0[1]), w1 = pk2(n0[2], n0[3]), w2 = pk2(n1[0], n1[1]), w3 = pk2(n1[2], n1[3]);
            nf = (bf16x8v){(short)(w0 & 0xffff), (short)(w0 >> 16), (short)(w1 & 0xffff), (short)(w1 >> 16), (short)(w2 & 0xffff), (short)(w2 >> 16), (short)(w3 & 0xffff), (short)(w3 >> 16)}; }
        qn = __builtin_amdgcn_mfma_f32_16x16x32_bf16(a, nf, qn, 0, 0, 0);
#pragma unroll
        for (int nb = 0; nb < 8; ++nb) { const bf16x8v kb = frag_row(lds + ML_T1, KP, 16 * nb, 32 * ks, lane); S[nb] = __builtin_amdgcn_mfma_f32_16x16x32_bf16(a, kb, S[nb], 0, 0, 0); } }
    const bf16* ucf = UC + (size_t)((chain0 + 0) * 32 + c) * 32768 + (size_t)(32 * wave + lc) * 128 + 8 * g;
    const bf16* ucb = UC + (size_t)((chain0 + 1) * 32 + c) * 32768 + (size_t)(32 * wave + lc) * 128 + 8 * g;
    bf16x8v uf0[4], uf1[4], ub0[4], ub1[4];
#pragma unroll
    for (int ks = 0; ks < 4; ++ks) { uf0[ks] = *(const bf16x8v*)(ucf + 32 * ks); uf1[ks] = *(const bf16x8v*)(ucf + 16 * 128 + 32 * ks); ub0[ks] = *(const bf16x8v*)(ucb + 32 * ks); ub1[ks] = *(const bf16x8v*)(ucb + 16 * 128 + 32 * ks); }
    float csf[8], csb[8];
#pragma unroll
    for (int nb = 0; nb < 8; ++nb) { csf[nb] = CS[16 * nb + lc]; csb[nb] = CS[128 + 16 * nb + lc]; }
    float pc[8][4];
#pragma unroll
    for (int r = 0; r < 4; ++r) { const int j = 16 * wave + 4 * g + r; const float Rf = RR[j], Rb = RR[128 + j];
        const float qnf = __shfl(qn[r], 16 * g), qnb = __shfl(qn[r], 16 * g + 1);
        float sf[8], sb[8], rsf = 0.f, rsb = 0.f;
#pragma unroll
        for (int nb = 0; nb < 8; ++nb) { const int s = 16 * nb + lc; const float wf = s <= j ? __expf(Rf + csf[nb]) : 0.f, wb = s >= j ? __expf(Rb + csb[nb]) : 0.f;
            sf[nb] = S[nb][r] * wf; sb[nb] = S[nb][r] * wb; rsf += sf[nb]; rsb += sb[nb]; }
        rsf = row16_sum(rsf); rsb = row16_sum(rsb);
        const float inf_ = INTER[j], inb_ = INTER[128 + j];
        const float ivf = __builtin_amdgcn_rcpf(fmaxf(fabsf(inf_ * qnf + rsf), EM[j])), ivb = __builtin_amdgcn_rcpf(fmaxf(fabsf(inb_ * qnb + rsb), EM[128 + j]));
#pragma unroll
        for (int nb = 0; nb < 8; ++nb) pc[nb][r] = sf[nb] * ivf + sb[nb] * ivb;
        if (lc == 0) { ALPHA[j] = inf_ * ivf; ALPHA[128 + j] = inb_ * ivb; } }
    __syncthreads();
#pragma unroll
    for (int r = 0; r < 4; ++r) { const int j = 16 * wave + 4 * g + r;
#pragma unroll
        for (int nb = 0; nb < 8; ++nb) *(LAS unsigned short*)(lds + ML_T1 + j * KP + (16 * nb + lc) * 2) = (unsigned short)f2bf(pc[nb][r]); }
    __syncthreads();
    f32x4 acc[2][8], acc2[2][8];
#pragma unroll
    for (int mb = 0; mb < 2; ++mb)
#pragma unroll
        for (int nb = 0; nb < 8; ++nb) { acc[mb][nb] = (f32x4){0.f, 0.f, 0.f, 0.f}; acc2[mb][nb] = (f32x4){0.f, 0.f, 0.f, 0.f}; }
#pragma unroll
    for (int ks = 0; ks < 4; ++ks) {
        const bf16x8v af0 = uf0[ks], af1 = uf1[ks], ab0 = ub0[ks], ab1 = ub1[ks];
#pragma unroll
        for (int nb = 0; nb < 8; ++nb) { const bf16x8v qb = frag_row(lds + ML_T0, KP, 16 * nb, 32 * ks, lane);
            acc[0][nb] = __builtin_amdgcn_mfma_f32_16x16x32_bf16(af0, qb, acc[0][nb], 0, 0, 0); acc[1][nb] = __builtin_amdgcn_mfma_f32_16x16x32_bf16(af1, qb, acc[1][nb], 0, 0, 0);
            acc2[0][nb] = __builtin_amdgcn_mfma_f32_16x16x32_bf16(ab0, qb, acc2[0][nb], 0, 0, 0); acc2[1][nb] = __builtin_amdgcn_mfma_f32_16x16x32_bf16(ab1, qb, acc2[1][nb], 0, 0, 0); } }
#pragma unroll
    for (int nb = 0; nb < 8; ++nb) { const float af = ALPHA[16 * nb + lc], ab = ALPHA[128 + 16 * nb + lc];
        acc[0][nb] = acc[0][nb] * af + acc2[0][nb] * ab; acc[1][nb] = acc[1][nb] * af + acc2[1][nb] * ab; }
#pragma unroll
    for (int ks = 0; ks < 4; ++ks) {
        const bf16x8v v0 = frag_tr(lds + ML_V, VP, 32 * ks, 32 * wave, lane), v1 = frag_tr(lds + ML_V, VP, 32 * ks, 32 * wave + 16, lane);
#pragma unroll
        for (int nb = 0; nb < 8; ++nb) { const bf16x8v pb = frag_row(lds + ML_T1, KP, 16 * nb, 32 * ks, lane);
            acc[0][nb] = __builtin_amdgcn_mfma_f32_16x16x32_bf16(v0, pb, acc[0][nb], 0, 0, 0); acc[1][nb] = __builtin_amdgcn_mfma_f32_16x16x32_bf16(v1, pb, acc[1][nb], 0, 0, 0); } }
    v2u ogate[2][8]; f32x4 gg2[2];
#pragma unroll
    for (int mb = 0; mb < 2; ++mb) { gg2[mb] = *(const f32x4*)(mlg + h * 256 + 32 * wave + 16 * mb + 4 * g);
#pragma unroll
        for (int nb = 0; nb < 8; ++nb) ogate[mb][nb] = *(const v2u*)(P + (size_t)(t0 + 16 * nb + lc) * NPROJ + C_MLO + h * 256 + 32 * wave + 16 * mb + 4 * g); }
    float rsna[8];
#pragma unroll
    for (int nb = 0; nb < 8; ++nb) rsna[nb] = RSNA[t0 + 16 * nb + lc];
#pragma unroll
    for (int nb = 0; nb < 8; ++nb) { float ss = 0.f;
#pragma unroll
        for (int mb = 0; mb < 2; ++mb) ss += (acc[mb][nb][0] * acc[mb][nb][0] + acc[mb][nb][1] * acc[mb][nb][1]) + (acc[mb][nb][2] * acc[mb][nb][2] + acc[mb][nb][3] * acc[mb][nb][3]);
        ss = rows4_sum(ss);
        if (g == 0) SS[wave * 128 + 16 * nb + lc] = ss; }
    __syncthreads();
#pragma unroll
    for (int nb = 0; nb < 8; ++nb) { const int j = 16 * nb + lc; float tot = 0.f;
#pragma unroll
        for (int w = 0; w < 8; ++w) tot += SS[w * 128 + j];
        const float rstd = __builtin_amdgcn_rsqf(tot * (1.0f / 256.0f) + EPS) * __builtin_amdgcn_rcpf(rsna[nb]);
#pragma unroll
        for (int mb = 0; mb < 2; ++mb) { const int e0 = 32 * wave + 16 * mb + 4 * g; const size_t t = (size_t)(t0 + j);
            const v2u ow = ogate[mb][nb]; const f32x4 gg = gg2[mb];
            const float o[4] = {bflo(ow.x), bfhi(ow.x), bflo(ow.y), bfhi(ow.y)}; float rr[4];
#pragma unroll
            for (int r = 0; r < 4; ++r) rr[r] = acc[mb][nb][r] * rstd * gg[r] * __builtin_amdgcn_rcpf(1.0f + __expf(-o[r]));
            v2u w; w.x = pk2n(rr[0], rr[1]); w.y = pk2n(rr[2], rr[3]);
            *(v2u*)(MIX + t * D + 1024 + h * 256 + e0) = w; } }
}


#ifndef NA_PROBE
#define NA_PROBE 0
#endif
constexpr int NA_TILE = 64 * KP, NA_BUF = 2 * NA_TILE, NA_RPB = 2 * NA_BUF;
static_assert(NA_RPB + 15 * 128 * 4 <= ML_END, "LDS map");
__device__ __forceinline__ bf16x8v frag_tr2(LAS unsigned char* tile, int pitch, int row0, int row1, int n0, int lane) {
    const int q = (lane & 15) >> 2, p = lane & 3;
    const s16x4 lo = lds_tr(tile + (row0 + q) * pitch + (n0 + 4 * p) * 2), hi = lds_tr(tile + (row1 + q) * pitch + (n0 + 4 * p) * 2);
    return (bf16x8v){lo[0], lo[1], lo[2], lo[3], hi[0], hi[1], hi[2], hi[3]};
}
__device__ __forceinline__ void na_unit(int u, const bf16* P, const float* rpb, bf16* MIX, float* SSQ, LAS unsigned char* lds, int tid_, int wave) {
    int tid = tid_; asm volatile("" : "+v"(tid)); const int lane = tid & 63, g = lane >> 4, lc = lane & 15;
    const int r4 = u & 15, h = (u >> 4) & 7, b = u >> 7;
    const int r0 = 4 * r4, r = r0 + (wave >> 1), qh = wave & 1;
    const int rs = min(max(r - 4, 0), 56), rs0 = min(max(r0 - 4, 0), 56), nk = min(max(r0 + 3 - 4, 0), 56) + 8 - rs0;
    LAS float* RPB = (LAS float*)(lds + NA_RPB);
    const int sA = tid >> 4, chA = tid & 15, sB = sA + 32;
    const bf16* gsrc = P + ((size_t)b * SEQ + rs0 * 64) * NPROJ + h * 128 + chA * 8;
    v4u ak0, ak1, av0, av1, bk0, bk1, bv0, bv1;
    const unsigned oK0 = (unsigned)(sA * NPROJ + C_NAK) * 2u, oK1 = (unsigned)(sB * NPROJ + C_NAK) * 2u, oV0 = (unsigned)(sA * NPROJ + C_NAV) * 2u, oV1 = (unsigned)(sB * NPROJ + C_NAV) * 2u;
#define NA_LOADS(j, k0_, k1_, v0_, v1_) do { const bf16* s_ = uni_ptr(gsrc_u + (size_t)min((j), nk - 1) * 64 * NPROJ); \
        asm volatile("global_load_dwordx4 %0, %1, %2" : "=v"(k0_) : "v"(oK0 + chb), "s"(s_) : "memory"); asm volatile("global_load_dwordx4 %0, %1, %2" : "=v"(k1_) : "v"(oK1 + chb), "s"(s_) : "memory"); \
        asm volatile("global_load_dwordx4 %0, %1, %2" : "=v"(v0_) : "v"(oV0 + chb), "s"(s_) : "memory"); asm volatile("global_load_dwordx4 %0, %1, %2" : "=v"(v1_) : "v"(oV1 + chb), "s"(s_) : "memory"); } while (0)
#define NA_WAIT(N, k0_, k1_, v0_, v1_) asm volatile("s_waitcnt vmcnt(" #N ")" : "+v"(k0_), "+v"(k1_), "+v"(v0_), "+v"(v1_) : : "memory")
#define NA_STORES(buf, k0_, k1_, v0_, v1_) do { LAS unsigned char* t_ = lds + (buf) * NA_BUF; *(LAS v4u*)(t_ + sA * KP + chA * 16) = k0_; *(LAS v4u*)(t_ + sB * KP + chA * 16) = k1_; \
        *(LAS v4u*)(t_ + NA_TILE + sA * KP + chA * 16) = v0_; *(LAS v4u*)(t_ + NA_TILE + sB * KP + chA * 16) = v1_; } while (0)
    const bf16* gsrc_u = P + ((size_t)b * SEQ + rs0 * 64) * NPROJ + h * 128; const unsigned chb = (unsigned)chA * 16u;
    NA_LOADS(0, ak0, ak1, av0, av1); NA_LOADS(1, bk0, bk1, bv0, bv1);
    __syncthreads();
    for (int i = tid; i < 15 * 128; i += 512) { const int dr = i >> 7, x = (i & 127) - 48; RPB[i] = (x >= 0 && x < 31) ? rpb[h * 465 + dr * 31 + x] * 1.4426950408889634f : 0.f; }
    NA_WAIT(4, ak0, ak1, av0, av1); NA_STORES(0, ak0, ak1, av0, av1);
    bf16x8v qf[2][4]; int cq[2], cs[2], boff[2]; float m[2], l[2]; f32x4 O[2][8]; f32x4 madd[2][4];
#pragma unroll
    for (int qi = 0; qi < 2; ++qi) { cq[qi] = 32 * qh + 16 * qi + lc; cs[qi] = min(max(cq[qi] - 8, 0), 48); m[qi] = -1.0e30f; l[qi] = 0.f; boff[qi] = 63 - cq[qi] + 4 * g;
#pragma unroll
        for (int kb = 0; kb < 4; ++kb)
#pragma unroll
            for (int rr = 0; rr < 4; ++rr) { const int kc = 16 * kb + 4 * g + rr; madd[qi][kb][rr] = (kc >= cs[qi] && kc < cs[qi] + 16) ? 0.f : -1.0e30f; }
        const bf16* qp = P + ((size_t)b * SEQ + r * 64 + cq[qi]) * NPROJ + C_NAQ + h * 128 + 8 * g;
#pragma unroll
        for (int ks = 0; ks < 4; ++ks) qf[qi][ks] = *(const bf16x8v*)(qp + 32 * ks);
#pragma unroll
        for (int db = 0; db < 8; ++db) O[qi][db] = (f32x4){0.f, 0.f, 0.f, 0.f}; }
    __builtin_amdgcn_s_waitcnt(0x0F70);
    __syncthreads();
    auto na_step = [&](int j) { const int kr = rs0 + j;
        if (kr >= rs && kr < rs + 8) {
            LAS unsigned char* Kt = lds + (j & 1) * NA_BUF; LAS unsigned char* Vt = Kt + NA_TILE;
            const LAS float* brow = RPB + (kr - r + 7) * 128;
            const int kb0a = qh ? 1 : 0, kb1a = qh ? 3 : 1, kb0b = qh ? 2 : 0, kb1b = qh ? 3 : 2;
            f32x4 s[2][4];
#if NA_PROBE == 1
            for (int prb = 0; prb < 2; ++prb) { asm volatile("" ::: "memory");
#else
            {
#endif
#pragma unroll
            for (int kb = 0; kb < 4; ++kb) { s[0][kb] = (f32x4){0.f, 0.f, 0.f, 0.f}; s[1][kb] = (f32x4){0.f, 0.f, 0.f, 0.f}; }
#pragma unroll
            for (int kb = 0; kb < 4; ++kb) { const bool ua = kb >= kb0a && kb <= kb1a, ub = kb >= kb0b && kb <= kb1b;
                if (ua || ub) {
#pragma unroll
                    for (int ks = 0; ks < 4; ++ks) { const bf16x8v ka = frag_row(Kt, KP, 16 * kb, 32 * ks, lane);
                        if (ua) s[0][kb] = __builtin_amdgcn_mfma_f32_16x16x32_bf16(ka, qf[0][ks], s[0][kb], 0, 0, 0);
                        if (ub) s[1][kb] = __builtin_amdgcn_mfma_f32_16x16x32_bf16(ka, qf[1][ks], s[1][kb], 0, 0, 0); } } }
            }
            bf16x8v pb[2][2];
#pragma unroll
            for (int qi = 0; qi < 2; ++qi) {
                const int k0 = qi ? kb0b : kb0a, k1 = qi ? kb1b : kb1a; const LAS float* bq = brow + boff[qi];
                float mx = -1.0e30f;
#pragma unroll
                for (int kb = 0; kb < 4; ++kb) if (kb >= k0 && kb <= k1) {
#pragma unroll
                    for (int rr = 0; rr < 4; ++rr) { const float v = s[qi][kb][rr] * 0.12753785f + bq[16 * kb + rr] + madd[qi][kb][rr]; s[qi][kb][rr] = v; mx = fmaxf(mx, v); } }
                mx = rows4_max(mx);
                const float mn = fmaxf(m[qi], mx); float ls = 0.f;
#pragma unroll
                for (int kb = 0; kb < 4; ++kb) { if (kb >= k0 && kb <= k1) {
#pragma unroll
                    for (int rr = 0; rr < 4; ++rr) { const float p = __builtin_amdgcn_exp2f(s[qi][kb][rr] - mn); s[qi][kb][rr] = p; ls += p; } } else s[qi][kb] = (f32x4){0.f, 0.f, 0.f, 0.f}; }
                ls = rows4_sum(ls);
                if (!__all(mn == m[qi])) { const float corr = __builtin_amdgcn_exp2f(m[qi] - mn); l[qi] *= corr;
#pragma unroll
                    for (int db = 0; db < 8; ++db) O[qi][db] = O[qi][db] * corr; }
                l[qi] += ls; m[qi] = mn;
#pragma unroll
                for (int t = 0; t < 2; ++t) { v4u pw; pw.x = pk2(s[qi][2 * t][0], s[qi][2 * t][1]); pw.y = pk2(s[qi][2 * t][2], s[qi][2 * t][3]); pw.z = pk2(s[qi][2 * t + 1][0], s[qi][2 * t + 1][1]); pw.w = pk2(s[qi][2 * t + 1][2], s[qi][2 * t + 1][3]);
                    pb[qi][t] = __builtin_bit_cast(bf16x8v, pw); }
            }
#if NA_PROBE == 2
            for (int prb = 0; prb < 2; ++prb) { asm volatile("" ::: "memory"); if (prb) { pb[0][0] = pb[0][1] = pb[1][0] = pb[1][1] = (bf16x8v){0, 0, 0, 0, 0, 0, 0, 0}; }
#else
            {
#endif
#pragma unroll
            for (int t = 0; t < 2; ++t) { const bool ua = 2 * t + 1 >= kb0a && 2 * t <= kb1a, ub = 2 * t + 1 >= kb0b && 2 * t <= kb1b;
                if (ua || ub) {
#pragma unroll
                    for (int db = 0; db < 8; ++db) { const bf16x8v va = frag_tr2(Vt, KP, 32 * t + 4 * g, 32 * t + 16 + 4 * g, 16 * db, lane);
                        if (ua) O[0][db] = __builtin_amdgcn_mfma_f32_16x16x32_bf16(va, pb[0][t], O[0][db], 0, 0, 0);
                        if (ub) O[1][db] = __builtin_amdgcn_mfma_f32_16x16x32_bf16(va, pb[1][t], O[1][db], 0, 0, 0); } } }
            }
        }
    };
#pragma unroll 1
    for (int j = 0; j < nk; j += 2) {
        NA_LOADS(j + 2, ak0, ak1, av0, av1);
        na_step(j);
        NA_WAIT(4, bk0, bk1, bv0, bv1); NA_STORES(1, bk0, bk1, bv0, bv1);
        __syncthreads();
        NA_LOADS(j + 3, bk0, bk1, bv0, bv1);
        na_step(j + 1);
        NA_WAIT(4, ak0, ak1, av0, av1); NA_STORES(0, ak0, ak1, av0, av1);
        __syncthreads();
    }
    asm volatile("s_waitcnt vmcnt(0)" : "+v"(ak0), "+v"(ak1), "+v"(av0), "+v"(av1), "+v"(bk0), "+v"(bk1), "+v"(bv0), "+v"(bv1) : : "memory");
#pragma unroll
    for (int qi = 0; qi < 2; ++qi) { const float inv = 1.0f / l[qi]; const size_t t = (size_t)b * SEQ + r * 64 + cq[qi]; bf16* op = MIX + t * D + h * 128 + 4 * g; float ss = 0.f;
#pragma unroll
        for (int db = 0; db < 8; ++db) { const f32x4 o = O[qi][db] * inv; ss += (o[0] * o[0] + o[1] * o[1]) + (o[2] * o[2] + o[3] * o[3]); v2u w; w.x = pk2(o[0], o[1]); w.y = pk2(o[2], o[3]); *(v2u*)(op + 16 * db) = w; }
        ss = rows4_sum(ss);
        if (g == 0) SSQ[t * 8 + h] = ss; }
#undef NA_LOADS
#undef NA_WAIT
#undef NA_STORES
}


constexpr int NWAVES = 8;
#ifndef NCONV
#define NCONV 96
#endif
constexpr int RING_BYTES = 131072;
constexpr int LDSCTL_OFF = ML_END, MISC_OFF = LDSCTL_OFF + 320;
constexpr int LDS_BYTES = LDSCTL_OFF + 1024;
static_assert(ML_END >= RING_BYTES && LDS_BYTES <= 163840, "LDS map");
constexpr int CW_BAR = 4096;
constexpr size_t CTL_ZERO_BYTES = 65536;
static_assert((CW_BAR + XCD_BAR_WORDS) * 4 <= (int)CTL_ZERO_BYTES, "barrier words inside the memset region");

struct MKArgs { const float* in[16]; float* out; unsigned char* ws; };
__global__ void __launch_bounds__(NWAVES * 64, 2) mk_fwd(MKArgs args) {
    extern __shared__ __attribute__((aligned(16))) unsigned char lds_raw[];
    LAS unsigned char* lds = (LAS unsigned char*)lds_raw;
    volatile LAS unsigned* MISC = (volatile LAS unsigned*)(lds + MISC_OFF);
    const int tid = threadIdx.x, lane0 = tid & 63, wave = __builtin_amdgcn_readfirstlane(tid >> 6);
    const int G = gridDim.x; const int bx = blockIdx.x; const int vcu = (G % 8 == 0) ? (bx % 8) * (G / 8) + bx / 8 : bx;
    const int gw0 = vcu * NWAVES + wave, ngw = G * NWAVES;
    unsigned char* ws = args.ws;
    for (int u = tid; u < (LDS_BYTES - LDSCTL_OFF) / 4; u += NWAVES * 64) ((LAS unsigned*)(lds + LDSCTL_OFF))[u] = 0u;
    __syncthreads();
    XcdBarrier bar = xcd_barrier_post((unsigned*)(ws + WS_CTL) + CW_BAR, MISC + 8);
#define GRID_BAR() do { XcdBarrier b_ = bar; asm volatile("" : "+s"(b_.bar), "+s"(b_.x)); xcd_barrier(b_); } while (0)
    const float* x = args.in[0]; const float* norm_mix_g = args.in[1]; const float* w_in = args.in[2]; const float* b_gates = args.in[3];
    const float* conv_w = args.in[4]; const float* conv_b = args.in[5]; const float* na_rpb = args.in[6]; const float* na_norm_g = args.in[7];
    const float* ml_norm_g = args.in[8]; const float* w_out = args.in[9]; const float* norm_ffn_g = args.in[10]; const float* w_router = args.in[11];
    const float* w_gate = args.in[12]; const float* w_up = args.in[13]; const float* w_down = args.in[14]; const float* final_norm_g = args.in[15];
#define WSPTRS(wsl, Xl) float* X = (Xl); float* RSTD = (float*)((wsl) + WS_RSTD); float* GATES = (float*)((wsl) + WS_GATES); float* AFF = (float*)((wsl) + WS_AFF); int* TOK = (int*)((wsl) + WS_TOK); float* GATEV = (float*)((wsl) + WS_GATEV); int* SEL = (int*)((wsl) + WS_SEL); \
    bf16* XB = (bf16*)((wsl) + WS_XB); bf16* MIX = (bf16*)((wsl) + WS_MIX); bf16* P = (bf16*)((wsl) + WS_P); bf16* NAO = (bf16*)((wsl) + WS_NAO); bf16* ACT = (bf16*)((wsl) + WS_ACT); bf16* Y = (bf16*)((wsl) + WS_Y); \
    (void)X; (void)RSTD; (void)GATES; (void)AFF; (void)TOK; (void)GATEV; (void)SEL; (void)XB; (void)MIX; (void)P; (void)NAO; (void)ACT; (void)Y;
#define LAUNDER(p) asm volatile("" : "+s"(p))
#define LAUNDER_GPTR(T, p) do { __attribute__((address_space(1))) T* g_ = (__attribute__((address_space(1))) T*)(p); asm volatile("" : "+s"(g_)); (p) = (T*)g_; } while (0)
#ifndef REP_MASK
#define REP_MASK 0
#endif
#if (REP_MASK >> 0) & 1
#define REP0 for (int rep_ = 0; rep_ < 2; ++rep_)
#else
#define REP0
#endif
#if (REP_MASK >> 1) & 1
#define REP1 for (int rep_ = 0; rep_ < 2; ++rep_)
#else
#define REP1
#endif
#if (REP_MASK >> 2) & 1
#define REP2 for (int rep_ = 0; rep_ < 2; ++rep_)
#else
#define REP2
#endif
#if (REP_MASK >> 3) & 1
#define REP3 for (int rep_ = 0; rep_ < 2; ++rep_)
#else
#define REP3
#endif
#if (REP_MASK >> 4) & 1
#define REP4 for (int rep_ = 0; rep_ < 2; ++rep_)
#else
#define REP4
#endif
#if (REP_MASK >> 5) & 1
#define REP5 for (int rep_ = 0; rep_ < 2; ++rep_)
#else
#define REP5
#endif
#if (REP_MASK >> 6) & 1
#define REP6 for (int rep_ = 0; rep_ < 2; ++rep_)
#else
#define REP6
#endif
#if (REP_MASK >> 7) & 1
#define REP7 for (int rep_ = 0; rep_ < 2; ++rep_)
#else
#define REP7
#endif
#if (REP_MASK >> 8) & 1
#define REP8 for (int rep_ = 0; rep_ < 2; ++rep_)
#else
#define REP8
#endif
#if (REP_MASK >> 9) & 1
#define REP9 for (int rep_ = 0; rep_ < 2; ++rep_)
#else
#define REP9
#endif
#if (REP_MASK >> 10) & 1
#define REP10 for (int rep_ = 0; rep_ < 2; ++rep_)
#else
#define REP10
#endif
#if (REP_MASK >> 11) & 1
#define REP11 for (int rep_ = 0; rep_ < 2; ++rep_)
#else
#define REP11
#endif
#if (REP_MASK >> 12) & 1
#define REP12 for (int rep_ = 0; rep_ < 2; ++rep_)
#else
#define REP12
#endif
#if (REP_MASK >> 13) & 1
#define REP13 for (int rep_ = 0; rep_ < 2; ++rep_)
#else
#define REP13
#endif

    { WSPTRS(ws, args.out)
      const int lane = lane0, gw = gw0;
    REP0 { ConvArgs ca; ca.w_in = w_in; ca.w_out = w_out; ca.w_gate = w_gate; ca.w_up = w_up; ca.w_down = w_down; ca.norm_mix_g = norm_mix_g; ca.norm_ffn_g = norm_ffn_g; ca.na_norm_g = na_norm_g; ca.ws = ws;
      LAS float* scr = (LAS float*)(lds + wave * CONV_SCR_BYTES);
      if (G == 256) convert_stream(ca, gw, ngw, CI_IN, scr, lane);
      else convert_stream(ca, gw, ngw, DEPTH * CI_LAYER, scr, lane); }
    { bf16* W16F = (bf16*)(ws + WS_W16F_OFF);
      for (int it = gw; it < DEPTH * 2 * 64; it += ngw) { const int mi = it >> 6, s = it & 63, l = mi >> 1;
          if (mi & 1) w16f_item(w_router + (size_t)l * D * NE, NE, norm_ffn_g + l * D, W16F + (size_t)mi * 32768, s, lane);
          else w16f_item(w_in + (size_t)l * D * NIN + C_GATES, NIN, norm_mix_g + l * D, W16F + (size_t)mi * 32768, s, lane); } }
    GRID_BAR();
    REP1 { RowArgs a; a.src32 = x; a.srcb = nullptr; a.sel = nullptr; a.Y = nullptr; a.XB = XB; a.XB8 = ws + WS_XB8; a.RSTD = RSTD; a.g = norm_mix_g; a.W16F = (const bf16*)(ws + WS_W16F_OFF); a.bias = b_gates; a.GATES = GATES; a.AFF = AFF; a.out = X; a.mode = 0; a.wrxb = 1;
      for (int grp = gw; grp < MTOK / 8; grp += ngw) rowpass_group<true>(a, grp, lane); } }
    GRID_BAR();

    for (int l = 0; l < DEPTH; ++l) {
        unsigned char* wsl = ws; float* Xl = args.out; LAUNDER_GPTR(unsigned char, wsl); LAUNDER_GPTR(float, Xl);
        WSPTRS(wsl, Xl)
        int lane = lane0, gw = gw0; asm volatile("" : "+v"(lane)); LAUNDER(gw);
        const bf16* WinT = (const bf16*)(wsl + WS_WIN) + (size_t)l * NPROJ * D; const bf16* WoutT = (const bf16*)(wsl + WS_WOUT) + (size_t)l * D * D;
        const bf16* WguT = (const bf16*)(wsl + WS_WGU) + (size_t)l * NE * 2048 * D; const bf16* WdT = (const bf16*)(wsl + WS_WD) + (size_t)l * NE * D * DE;
        const int Gg = (l == 0 && G == 256) ? G - NCONV : G;
        if (bx >= Gg) { ConvArgs ca; ca.w_in = w_in; ca.w_out = w_out; ca.w_gate = w_gate; ca.w_up = w_up; ca.w_down = w_down; ca.norm_mix_g = norm_mix_g; ca.norm_ffn_g = norm_ffn_g; ca.na_norm_g = na_norm_g; ca.ws = wsl;
          convert_stream(ca, CI_IN + (bx - Gg) * NWAVES + wave, NCONV * NWAVES, DEPTH * CI_LAYER, (LAS float*)(lds + wave * CONV_SCR_BYTES), lane); }
        else {
        REP2 { pg8::Gemm g{XB, WinT, MTOK, NPROJ16, D, 0}; pg8::StaticOrder S; S.init(MTOK, NPROJ16, Gg, bx); pg8::EpiRowScaleBf16 E{P, RSTD, nullptr, NPROJ, 0, 1.0f, 0};
          pg8::gemm_phase<pg8::EpiRowScaleBf16, pg8::StaticOrder, true, true>(lds, g, S, E); }
        { pg8::Gemm g{(const bf16*)(wsl + WS_XB8), (const bf16*)(wsl + WS_WIN + ((size_t)l * NPROJ + NPROJ16) * D * 2), MTOK, NPROJ - NPROJ16, D / 2, 0}; pg8::StaticOrder S; S.init(MTOK, NPROJ - NPROJ16, Gg, bx);
          pg8::EpiRowScaleBf16 E{P + NPROJ16, RSTD, nullptr, NPROJ, 0, 1.0f / W8_SCALE, 0};
          pg8::gemm_phase<pg8::EpiRowScaleBf16, pg8::StaticOrder, true, true, true>(lds, g, S, E); }
        }
        GRID_BAR();
        REP4 for (int u = vcu; u < 512; u += G) na_unit(u, P, na_rpb + (size_t)l * 8 * 15 * 31, MIX, (float*)(wsl + WS_SSQ), lds, tid, wave);
        { bf16* UC = (bf16*)(wsl + WS_UC); float* NU = (float*)(wsl + WS_NU); float* SC = (float*)(wsl + WS_SC); const float* cwl = conv_w + (size_t)l * 5 * 1024; const float* cbl = conv_b + l * 1024;
          int tidl = tid; asm volatile("" : "+v"(tidl));
          REP5 for (int u = bx; u < 512; u += G) mlstm_m1_unit(u, cwl, cbl, P, GATES, UC, NU, SC, lds, tidl, wave);
          GRID_BAR();
          mlstm_m2(UC, NU, SC, vcu * 512 + tidl, G * 512);
          { const float* ssq = (const float*)(wsl + WS_SSQ); float* rsna = (float*)(wsl + WS_RSNA);
            for (int t = vcu * 512 + tidl; t < MTOK; t += G * 512) { const f32x4 s0 = *(const f32x4*)(ssq + (size_t)t * 8), s1 = *(const f32x4*)(ssq + (size_t)t * 8 + 4);
                rsna[t] = 1.0f / sqrtf(((s0[0] + s0[1]) + (s0[2] + s0[3]) + (s1[0] + s1[1]) + (s1[2] + s1[3])) * (1.0f / 1024.0f) + EPS); } }
          GRID_BAR();
          REP7 for (int u = bx; u < 512; u += G) mlstm_m3_unit(u, cwl, cbl, P, GATES, UC, NU, SC, ml_norm_g + l * 1024, (const float*)(wsl + WS_RSNA), MIX, lds, tidl, wave); }
        GRID_BAR();
#if (REP_MASK >> 8) & 1
        for (int rep_ = 0; rep_ < 2; ++rep_)
#endif
        { pg8::Gemm g{MIX, WoutT, MTOK, D, D, 0}; pg8::StaticOrder S; S.init(MTOK, D, G, bx); pg8::EpiResidBf16 E{XB, (const float*)(wsl + WS_RSNA), D, 0};
#if (REP_MASK >> 8) & 1
          if (rep_ == 0) E.XB = P;
#endif
          pg8::gemm_phase<pg8::EpiResidBf16, pg8::StaticOrder, true, true>(lds, g, S, E); }
        GRID_BAR();
        REP9 { RowArgs a; a.src32 = nullptr; a.srcb = XB; a.sel = nullptr; a.Y = nullptr; a.XB = XB; a.XB8 = wsl + WS_XB8; a.RSTD = RSTD; a.g = norm_ffn_g + l * D; a.W16F = (const bf16*)(wsl + WS_W16F_OFF) + (size_t)(2 * l + 1) * 32768; a.bias = b_gates; a.GATES = GATES; a.AFF = AFF; a.out = X; a.mode = 1; a.wrxb = 0;
          for (int grp = gw; grp < MTOK / 8; grp += ngw) rowpass_group<false>(a, grp, lane); }
        GRID_BAR();
        REP10 for (int be = bx; be < BATCH * NE; be += G) topk_unit(be, AFF, TOK, GATEV, SEL, (LAS int*)lds);
        GRID_BAR();
        REP12 { pg8::Gemm g{(const bf16*)(wsl + WS_XB8), (const bf16*)(wsl + WS_WGU + (size_t)l * NE * 2048 * D), MR, 2048, D / 2, 0}; pg8::GroupedGatherOrder S{TOK, G, bx};
          pg8::EpiSwiGLU8 E{(unsigned char*)ACT, RSTD, TOK, DE, 8, 1.0f / W8_SCALE, 0};
          pg8::gemm_phase_gather<pg8::EpiSwiGLU8, pg8::GroupedGatherOrder, true, true, true>(lds, g, S, E); }
        GRID_BAR();
        REP13 { pg8::Gemm g{ACT, (const bf16*)(wsl + WS_WD + (size_t)l * NE * D * DE), MR, 2048, DE / 2, 0}; pg8::GroupedOrder S{nullptr, G, bx}; pg8::EpiRowScaleF8 E{(unsigned char*)Y, GATEV, D, 8, Y8_SCALE / W8_SCALE, 0};
          pg8::gemm_phase<pg8::EpiRowScaleF8, pg8::GroupedOrder, true, true, true>(lds, g, S, E); }
        GRID_BAR();
        { RowArgs a; a.src32 = nullptr; a.srcb = XB; a.sel = SEL; a.Y = (const unsigned char*)Y; a.XB = XB; a.XB8 = wsl + WS_XB8; a.RSTD = RSTD; a.bias = b_gates + (l + 1 < DEPTH ? (l + 1) * 16 : 0); a.GATES = GATES; a.AFF = AFF; a.out = X; a.wrxb = 1;
          a.W16F = (const bf16*)(wsl + WS_W16F_OFF) + (size_t)(2 * (l + 1 < DEPTH ? l + 1 : 0)) * 32768;
          if (l + 1 < DEPTH) { a.g = norm_mix_g + (l + 1) * D; a.mode = 0; }
          else { a.g = final_norm_g; a.mode = 2; }
          for (int grp = gw; grp < MTOK / 8; grp += ngw) rowpass_group<false>(a, grp, lane); }
        if (l + 1 < DEPTH) GRID_BAR();
    }
#undef GRID_BAR
#undef WSPTRS
}

extern "C" void kernel_launch(void* const* d_in, const int* in_sizes, int n_in, void* d_out, int out_size, void* d_ws, size_t ws_size, hipStream_t stream) {
    static int grid = 0;
    if (grid == 0) {
        if (n_in != 16 || ws_size < WS_END) { fprintf(stderr, "kernel_launch: unexpected n_in %d or ws_size %zu\n", n_in, ws_size); grid = -1; return; }
        int dev = 0, cus = 0, per_cu = 0;
        if (hipGetDevice(&dev) != hipSuccess || hipDeviceGetAttribute(&cus, hipDeviceAttributeMultiprocessorCount, dev) != hipSuccess) { grid = -1; return; }
        if (hipFuncSetAttribute((const void*)mk_fwd, hipFuncAttributeMaxDynamicSharedMemorySize, LDS_BYTES) != hipSuccess) { fprintf(stderr, "kernel_launch: hipFuncSetAttribute failed\n"); grid = -1; return; }
        if (hipOccupancyMaxActiveBlocksPerMultiprocessor(&per_cu, (const void*)mk_fwd, NWAVES * 64, LDS_BYTES) != hipSuccess || per_cu < 1) fprintf(stderr, "kernel_launch: occupancy query reports %d blocks per CU\n", per_cu);
        (void)hipGetLastError();
        grid = cus;
    }
    if (grid < 0) return;
    if (hipMemsetAsync((char*)d_ws + WS_CTL, 0, CTL_ZERO_BYTES, stream) != hipSuccess) return;
    MKArgs a; memset(&a, 0, sizeof(a));
    for (int i = 0; i < 16; ++i) a.in[i] = (const float*)d_in[i];
    a.out = (float*)d_out; a.ws = (unsigned char*)d_ws;
    hipLaunchKernelGGL(mk_fwd, dim3(grid), dim3(NWAVES * 64), LDS_BYTES, stream, a);
}
```
